# Optimizing an MI355X kernel written in HIP

```python
import math
import jax, jax.numpy as jnp
from jax import lax
import numpy as np

D_MODEL = 2048
BATCH = 4
SEQ = 2048
DEPTH = 2
DEC_BATCH = 128
DEC_SEQ = 8
PAST_LEN = 16384
PAGE_SIZE = 128

MIX_WIDTH = D_MODEL
M_WIDTH = MIX_WIDTH // 2
M_HEADS = 4
M_DK = M_WIDTH // M_HEADS
M_DV = M_WIDTH // M_HEADS
S_WIDTH = MIX_WIDTH - M_WIDTH
S_HEADDIM = 64
S_HEADS = S_WIDTH // S_HEADDIM
S_GROUPS = 2
S_STATE = 128
S_CONV = 4
S_CONV_DIM = S_WIDTH + 2 * S_GROUPS * S_STATE
D_FF = ((8 * D_MODEL) // 3 + 127) // 128 * 128
FFN_CONV = 3
CHUNK = 64
ALPHA = (2 * DEPTH) ** 0.25
BETA = (8 * DEPTH) ** -0.25
LN_EPS = 1e-5
GN_EPS = 1e-6
SPLIT_SIZES = (M_WIDTH, M_WIDTH, M_WIDTH, M_WIDTH, M_HEADS, M_HEADS, S_WIDTH, S_CONV_DIM, S_HEADS)
IN_DIM = M_WIDTH * 4 + M_HEADS * 2 + S_WIDTH + S_CONV_DIM + S_HEADS

kernel_name = 'hymba_mlstm_ssd_convffn_deepnorm_step'


def split_columns(u, sizes):
    idx = []
    acc = 0
    for s in sizes[:-1]:
        acc += s
        idx.append(acc)
    return jnp.split(u, idx, axis=-1)


def layer_norm(x, g, b):
    xf = x.astype(jnp.float32)
    mu = jnp.mean(xf, axis=-1, keepdims=True)
    var = jnp.mean(jnp.square(xf - mu), axis=-1, keepdims=True)
    return ((xf - mu) * lax.rsqrt(var + LN_EPS) * g + b).astype(x.dtype)


def causal_dwconv(xp, w, bias):
    K = w.shape[0]
    T = xp.shape[1] - K + 1
    out = xp[:, 0:T] * w[0]
    for j in range(1, K):
        out = out + xp[:, j:j + T] * w[j]
    return out + bias


def chunk_len(T):
    return CHUNK if T % CHUNK == 0 else T


def to_chunks(a, L):
    B, T = a.shape[0], a.shape[1]
    return jnp.moveaxis(a.reshape((B, T // L, L) + a.shape[2:]), 1, 0)


def from_chunks(a):
    nc, B, L = a.shape[0], a.shape[1], a.shape[2]
    return jnp.moveaxis(a, 0, 1).reshape((B, nc * L) + a.shape[3:])


def mlstm_chunk(carry, inp):
    C, n, m = carry
    q, k, v, ig, lf = inp
    L = q.shape[1]
    causal = jnp.tril(jnp.ones((L, L), dtype=bool))[None, :, :, None]
    b = jnp.cumsum(lf, axis=1)
    log_w = jnp.where(causal, b[:, :, None, :] - b[:, None, :, :] + ig[:, None, :, :], -jnp.inf)
    log_inter = b + m[:, None, :]
    m_t = jnp.maximum(log_inter, jnp.max(log_w, axis=2))
    w_intra = jnp.exp(log_w - m_t[:, :, None, :])
    w_inter = jnp.exp(log_inter - m_t)
    s = jnp.einsum('bthd,bshd->btsh', q, k) * w_intra
    num = jnp.einsum('btsh,bshe->bthe', s, v) + w_inter[..., None] * jnp.einsum('bthd,bhde->bthe', q, C)
    den = jnp.sum(s, axis=2) + w_inter * jnp.einsum('bthd,bhd->bth', q, n)
    h = num / jnp.maximum(jnp.abs(den), jnp.exp(-m_t))[..., None]
    m_end = m_t[:, -1]
    w_end = jnp.exp(b[:, -1:, :] - b + ig - m_end[:, None, :])
    decay = jnp.exp(b[:, -1] + m - m_end)
    C_new = decay[..., None, None] * C + jnp.einsum('bsh,bshd,bshe->bhde', w_end, k, v)
    n_new = decay[..., None] * n + jnp.einsum('bsh,bshd->bhd', w_end, k)
    return (C_new, n_new, m_end), h


def mlstm_mixer(q, k, v, o_pre, i_pre, f_pre, b_i, b_f, norm_w, C0, n0, m0):
    f32 = jnp.float32
    B, T = q.shape[0], q.shape[1]
    q = q.reshape(B, T, M_HEADS, M_DK).astype(f32)
    k = k.reshape(B, T, M_HEADS, M_DK).astype(f32) * (M_DK ** -0.5)
    v = v.reshape(B, T, M_HEADS, M_DV).astype(f32)
    ig = (i_pre + b_i).astype(f32)
    lf = jax.nn.log_sigmoid((f_pre + b_f).astype(f32))
    L = chunk_len(T)
    xs = (to_chunks(q, L), to_chunks(k, L), to_chunks(v, L), to_chunks(ig, L), to_chunks(lf, L))
    (C, n, m), h = lax.scan(mlstm_chunk, (C0.astype(f32), n0.astype(f32), m0.astype(f32)), xs)
    h = from_chunks(h)
    mu = jnp.mean(h, axis=-1, keepdims=True)
    var = jnp.mean(jnp.square(h - mu), axis=-1, keepdims=True)
    hn = ((h - mu) * lax.rsqrt(var + GN_EPS)).reshape(B, T, M_WIDTH) * norm_w.astype(f32)
    out = hn * jax.nn.sigmoid(o_pre.astype(f32))
    return out, C, n, m


def ssd_chunk(S, inp):
    xs, dt, a, Bm, Cm = inp
    L = xs.shape[1]
    causal = jnp.tril(jnp.ones((L, L), dtype=bool))[None, :, :, None, None]
    b = jnp.cumsum(a, axis=1)
    decay = jnp.exp(jnp.where(causal, b[:, :, None] - b[:, None], -jnp.inf))
    cb = jnp.einsum('btgn,bsgn->btsg', Cm, Bm)
    mw = cb[..., None] * decay * dt[:, None]
    y = jnp.einsum('btsgh,bsghp->btghp', mw, xs) + jnp.exp(b)[..., None] * jnp.einsum('btgn,bghpn->btghp', Cm, S)
    w_end = jnp.exp(b[:, -1:] - b) * dt
    S_new = jnp.exp(b[:, -1])[..., None, None] * S + jnp.einsum('bsgh,bsgn,bsghp->bghpn', w_end, Bm, xs)
    return S_new, y


def ssd_mixer(z, xbc, dt_pre, conv_w, conv_b, dt_bias, A_log, D_skip, norm_w, S0, conv0):
    f32 = jnp.float32
    B, T = z.shape[0], z.shape[1]
    HG = S_HEADS // S_GROUPS
    xp = jnp.concatenate([conv0.astype(xbc.dtype), xbc], axis=1)
    conv_new = xp[:, -(S_CONV - 1):]
    xbc = jax.nn.silu(causal_dwconv(xp, conv_w, conv_b)).astype(f32)
    xs, Bm, Cm = jnp.split(xbc, [S_WIDTH, S_WIDTH + S_GROUPS * S_STATE], axis=-1)
    xs = xs.reshape(B, T, S_GROUPS, HG, S_HEADDIM)
    Bm = Bm.reshape(B, T, S_GROUPS, S_STATE)
    Cm = Cm.reshape(B, T, S_GROUPS, S_STATE)
    dt = jax.nn.softplus(dt_pre.astype(f32) + dt_bias.astype(f32)).reshape(B, T, S_GROUPS, HG)
    A = -jnp.exp(A_log.astype(f32)).reshape(S_GROUPS, HG)
    a = dt * A
    L = chunk_len(T)
    S0 = S0.astype(f32).reshape(B, S_GROUPS, HG, S_HEADDIM, S_STATE)
    inp = (to_chunks(xs, L), to_chunks(dt, L), to_chunks(a, L), to_chunks(Bm, L), to_chunks(Cm, L))
    S, y = lax.scan(ssd_chunk, S0, inp)
    y = from_chunks(y) + D_skip.astype(f32).reshape(S_GROUPS, HG)[..., None] * xs
    g = (y.reshape(B, T, S_WIDTH) * jax.nn.silu(z.astype(f32))).reshape(B, T, S_GROUPS, S_WIDTH // S_GROUPS)
    g = g * lax.rsqrt(jnp.mean(jnp.square(g), axis=-1, keepdims=True) + GN_EPS)
    out = g.reshape(B, T, S_WIDTH) * norm_w.astype(f32)
    return out, S.reshape(B, S_HEADS, S_HEADDIM, S_STATE), conv_new


def conv_ffn(x, w_up, conv_w, conv_b, w_down, buf):
    up = x @ w_up
    xp = jnp.concatenate([buf.astype(up.dtype), up], axis=1)
    buf_new = xp[:, -(FFN_CONV - 1):]
    c = causal_dwconv(xp, conv_w, conv_b)
    g, val = jnp.split(c, 2, axis=-1)
    return (jax.nn.silu(g) * val) @ w_down, buf_new


def layer(x, st, p):
    C0, n0, m0, S0, sconv0, fconv0 = st
    (w_in, b_i, b_f, m_norm_w, s_conv_w, s_conv_b, dt_bias, A_log, D_skip, s_norm_w, w_out,
     ln1_g, ln1_b, w_up, f_conv_w, f_conv_b, w_down, ln2_g, ln2_b) = p
    u = x @ w_in
    q, k, v, o_pre, i_pre, f_pre, z, xbc, dt_pre = split_columns(u, SPLIT_SIZES)
    h_m, C, n, m = mlstm_mixer(q, k, v, o_pre, i_pre, f_pre, b_i, b_f, m_norm_w, C0, n0, m0)
    h_s, S, sconv = ssd_mixer(z, xbc, dt_pre, s_conv_w, s_conv_b, dt_bias, A_log, D_skip, s_norm_w, S0, sconv0)
    mix = jnp.concatenate([h_m, h_s], axis=-1).astype(x.dtype) @ w_out
    x = layer_norm(ALPHA * x + mix, ln1_g, ln1_b)
    f, fconv = conv_ffn(x, w_up, f_conv_w, f_conv_b, w_down, fconv0)
    x = layer_norm(ALPHA * x + f, ln2_g, ln2_b)
    return x, (C, n, m, S, sconv, fconv)


def trunk(x, states, params):
    new = [[] for _ in states]
    for l in range(DEPTH):
        st_l = tuple(s[l] for s in states)
        p_l = tuple(w[l] for w in params)
        x, ns = layer(x, st_l, p_l)
        for j in range(len(ns)):
            new[j].append(ns[j])
    return x, tuple(jnp.stack(a, axis=0) for a in new)


def setup_inputs(seed: int = 0) -> dict:
    key = jax.random.key(seed)
    ks = iter(jax.random.split(key, 40))
    f32 = jnp.float32

    def nrm(shape, scale):
        return scale * jax.random.normal(next(ks), shape, f32)

    x_prompt = nrm((BATCH, SEQ, D_MODEL), 1.0)
    x_sample = nrm((DEC_BATCH, DEC_SEQ, D_MODEL), 1.0)
    state_mlstm_C = nrm((DEPTH, DEC_BATCH, M_HEADS, M_DK, M_DV), 0.5)
    state_mlstm_n = nrm((DEPTH, DEC_BATCH, M_HEADS, M_DK), 0.5)
    state_mlstm_m = nrm((DEPTH, DEC_BATCH, M_HEADS), 1.0)
    state_ssm = nrm((DEPTH, DEC_BATCH, S_HEADS, S_HEADDIM, S_STATE), 0.5)
    state_ssm_conv = nrm((DEPTH, DEC_BATCH, S_CONV - 1, S_CONV_DIM), 1.0)
    state_ffn_conv = nrm((DEPTH, DEC_BATCH, FFN_CONV - 1, 2 * D_FF), 1.0)
    w_in = nrm((DEPTH, D_MODEL, IN_DIM), D_MODEL ** -0.5)
    mlstm_b_i = nrm((DEPTH, M_HEADS), 0.1)
    mlstm_b_f = jnp.linspace(3.0, 6.0, M_HEADS, dtype=f32)[None, :] + nrm((DEPTH, M_HEADS), 0.1)
    mlstm_norm_w = 1.0 + nrm((DEPTH, M_WIDTH), 0.02)
    ssm_conv_w = nrm((DEPTH, S_CONV, S_CONV_DIM), S_CONV ** -0.5)
    ssm_conv_b = nrm((DEPTH, S_CONV_DIM), 0.02)
    dt0 = jnp.exp(jax.random.uniform(next(ks), (DEPTH, S_HEADS), f32, math.log(1e-3), math.log(1e-1)))
    ssm_dt_bias = dt0 + jnp.log(-jnp.expm1(-dt0))
    ssm_A_log = jnp.log(jax.random.uniform(next(ks), (DEPTH, S_HEADS), f32, 1.0, 16.0))
    ssm_D = 1.0 + nrm((DEPTH, S_HEADS), 0.1)
    ssm_norm_w = 1.0 + nrm((DEPTH, S_WIDTH), 0.02)
    w_out = nrm((DEPTH, MIX_WIDTH, D_MODEL), BETA * MIX_WIDTH ** -0.5)
    ln1_g = 1.0 + nrm((DEPTH, D_MODEL), 0.02)
    ln1_b = nrm((DEPTH, D_MODEL), 0.02)
    ffn_w_up = nrm((DEPTH, D_MODEL, 2 * D_FF), D_MODEL ** -0.5)
    ffn_conv_w = nrm((DEPTH, FFN_CONV, 2 * D_FF), FFN_CONV ** -0.5)
    ffn_conv_b = nrm((DEPTH, 2 * D_FF), 0.02)
    ffn_w_down = nrm((DEPTH, D_FF, D_MODEL), BETA * D_FF ** -0.5)
    ln2_g = 1.0 + nrm((DEPTH, D_MODEL), 0.02)
    ln2_b = nrm((DEPTH, D_MODEL), 0.02)
    return {'x_prompt': x_prompt, 'x_sample': x_sample,
            'state_mlstm_C': state_mlstm_C, 'state_mlstm_n': state_mlstm_n, 'state_mlstm_m': state_mlstm_m,
            'state_ssm': state_ssm, 'state_ssm_conv': state_ssm_conv, 'state_ffn_conv': state_ffn_conv,
            'w_in': w_in, 'mlstm_b_i': mlstm_b_i, 'mlstm_b_f': mlstm_b_f, 'mlstm_norm_w': mlstm_norm_w,
            'ssm_conv_w': ssm_conv_w, 'ssm_conv_b': ssm_conv_b, 'ssm_dt_bias': ssm_dt_bias,
            'ssm_A_log': ssm_A_log, 'ssm_D': ssm_D, 'ssm_norm_w': ssm_norm_w, 'w_out': w_out,
            'ln1_g': ln1_g, 'ln1_b': ln1_b, 'ffn_w_up': ffn_w_up, 'ffn_conv_w': ffn_conv_w,
            'ffn_conv_b': ffn_conv_b, 'ffn_w_down': ffn_w_down, 'ln2_g': ln2_g, 'ln2_b': ln2_b}


def reference(x_prompt, x_sample, state_mlstm_C, state_mlstm_n, state_mlstm_m, state_ssm, state_ssm_conv,
              state_ffn_conv, w_in, mlstm_b_i, mlstm_b_f, mlstm_norm_w, ssm_conv_w, ssm_conv_b, ssm_dt_bias,
              ssm_A_log, ssm_D, ssm_norm_w, w_out, ln1_g, ln1_b, ffn_w_up, ffn_conv_w, ffn_conv_b,
              ffn_w_down, ln2_g, ln2_b):
    params = (w_in, mlstm_b_i, mlstm_b_f, mlstm_norm_w, ssm_conv_w, ssm_conv_b, ssm_dt_bias, ssm_A_log,
              ssm_D, ssm_norm_w, w_out, ln1_g, ln1_b, ffn_w_up, ffn_conv_w, ffn_conv_b, ffn_w_down,
              ln2_g, ln2_b)
    f32 = jnp.float32
    B = x_prompt.shape[0]
    zero_states = (jnp.zeros((DEPTH, B, M_HEADS, M_DK, M_DV), f32),
                   jnp.zeros((DEPTH, B, M_HEADS, M_DK), f32),
                   jnp.zeros((DEPTH, B, M_HEADS), f32),
                   jnp.zeros((DEPTH, B, S_HEADS, S_HEADDIM, S_STATE), f32),
                   jnp.zeros((DEPTH, B, S_CONV - 1, S_CONV_DIM), x_prompt.dtype),
                   jnp.zeros((DEPTH, B, FFN_CONV - 1, 2 * D_FF), x_prompt.dtype))
    y_prompt, (p_C, p_n, p_m, p_ssm, p_sconv, p_fconv) = trunk(x_prompt, zero_states, params)
    past = (state_mlstm_C, state_mlstm_n, state_mlstm_m, state_ssm, state_ssm_conv, state_ffn_conv)
    y_sample, (s_C, s_n, s_m, s_ssm, s_sconv, s_fconv) = trunk(x_sample, past, params)
    return (y_prompt, y_sample, p_C, p_n, p_m, p_ssm, p_sconv, p_fconv,
            s_C, s_n, s_m, s_ssm, s_sconv, s_fconv)
```

```cpp
#include <hip/hip_runtime.h>
#include <hip/hip_cooperative_groups.h>
#include <cstdio>
namespace cg = cooperative_groups;

#ifndef MK_MULTI
#define MK_MULTI 0
#endif

#define DEV __device__ __forceinline__
#define LAS __attribute__((address_space(3)))
typedef unsigned short bf16_t;
typedef short bf16x8 __attribute__((ext_vector_type(8)));
typedef float f32x4 __attribute__((ext_vector_type(4)));
typedef float f32x2 __attribute__((ext_vector_type(2)));
typedef unsigned u32x4 __attribute__((ext_vector_type(4)));
typedef unsigned u32x2 __attribute__((ext_vector_type(2)));

constexpr int D = 2048, NPR = 8192, NSM = 1024, NTOK = 9216, INP = 6912, IN_DIM = 6680, DFF = 5504, DFF2 = 11008;
constexpr int UQ = 0, UK = 1024, UV = 2048, UO = 3072, UZ = 4096, UXS = 5120, UIG = 6656, UFG = 6660, UDT = 6664;
constexpr int NTHR = 512;
constexpr int LDS_BYTES = 136 * 1024;
constexpr float ALPHA = 1.41421356237309515f;

constexpr size_t O_YP = 0;
constexpr size_t O_YS = O_YP + (size_t)4 * 2048 * 2048;
constexpr size_t O_PC = O_YS + (size_t)128 * 8 * 2048;
constexpr size_t O_PN = O_PC + (size_t)2 * 4 * 4 * 256 * 256;
constexpr size_t O_PM = O_PN + (size_t)2 * 4 * 4 * 256;
constexpr size_t O_PS = O_PM + (size_t)2 * 4 * 4;
constexpr size_t O_PSC = O_PS + (size_t)2 * 4 * 16 * 64 * 128;
constexpr size_t O_PFC = O_PSC + (size_t)2 * 4 * 3 * 1536;
constexpr size_t O_SC = O_PFC + (size_t)2 * 4 * 2 * DFF2;
constexpr size_t O_SN = O_SC + (size_t)2 * 128 * 4 * 256 * 256;
constexpr size_t O_SM = O_SN + (size_t)2 * 128 * 4 * 256;
constexpr size_t O_SS = O_SM + (size_t)2 * 128 * 4;
constexpr size_t O_SSC = O_SS + (size_t)2 * 128 * 16 * 64 * 128;
constexpr size_t O_SFC = O_SSC + (size_t)2 * 128 * 3 * 1536;

constexpr size_t WS_WIN = 0;
constexpr size_t WS_WOUT = WS_WIN + (size_t)2 * INP * D * 2;
constexpr size_t WS_WUP = WS_WOUT + (size_t)2 * D * D * 2;
constexpr size_t WS_WDN = WS_WUP + (size_t)2 * DFF2 * D * 2;
constexpr size_t WS_XB = WS_WDN + (size_t)2 * D * DFF * 2;
constexpr size_t WS_XF = WS_XB + (size_t)NTOK * D * 2;
constexpr size_t WS_U = WS_XF + (size_t)NTOK * D * 4;
constexpr size_t WS_MIXIN = WS_U + (size_t)NTOK * INP * 2;
constexpr size_t WS_MIXF = WS_MIXIN + (size_t)NTOK * D * 2;
constexpr size_t WS_UP = WS_MIXF + (size_t)NTOK * D * 4;
constexpr size_t WS_ACT = WS_UP + (size_t)NTOK * DFF2 * 2;
constexpr size_t WS_SMALL = WS_ACT + (size_t)NTOK * DFF * 2;
constexpr size_t WS_DBUF = WS_UP;
constexpr size_t WS_SBUF = WS_UP + (size_t)512 * 65536 * 4;
constexpr size_t WS_CT = WS_ACT;
constexpr size_t WS_ST = WS_ACT + (size_t)512 * 65536 * 2;
static_assert(WS_SBUF + (size_t)2048 * 8192 * 4 <= WS_ACT, "alias");
static_assert(WS_ST + (size_t)2048 * 8192 * 2 <= WS_SMALL, "alias");
constexpr size_t WS_NLOC = WS_SMALL;
constexpr size_t WS_NST = WS_NLOC + (size_t)512 * 256 * 4;
constexpr size_t WS_GSTAT = WS_NST + (size_t)512 * 256 * 4;
constexpr size_t WS_MST = WS_GSTAT + 4096;
constexpr size_t WS_SBSUM = WS_MST + 4096;
constexpr size_t WS_END = WS_SBSUM + 8192;

struct P {
    const float* x_prompt; const float* x_sample; const float* st_C; const float* st_n; const float* st_m; const float* st_ssm; const float* st_sconv; const float* st_fconv;
    const float* w_in; const float* b_i; const float* b_f; const float* m_norm_w; const float* s_conv_w; const float* s_conv_b; const float* dt_bias; const float* A_log; const float* D_skip;
    const float* s_norm_w; const float* w_out; const float* ln1_g; const float* ln1_b; const float* w_up; const float* f_conv_w; const float* f_conv_b; const float* w_down; const float* ln2_g; const float* ln2_b;
    float* out; unsigned char* ws; int ph_lo, ph_hi;
};

DEV float bf2f(bf16_t v) { return __uint_as_float(((unsigned)v) << 16); }
DEV bf16_t f2bf(float f) { unsigned u = __float_as_uint(f); u += 0x7FFFu + ((u >> 16) & 1u); return (bf16_t)(u >> 16); }
DEV unsigned pk2(float lo, float hi) { return (unsigned)f2bf(lo) | ((unsigned)f2bf(hi) << 16); }
DEV float bflo(unsigned w) { return __uint_as_float(w << 16); }
DEV float bfhi(unsigned w) { return __uint_as_float(w & 0xffff0000u); }
DEV float sigmoidf_(float x) { return 1.0f / (1.0f + expf(-x)); }
DEV float siluf_(float x) { return x * sigmoidf_(x); }
DEV float softplusf_(float x) { return fmaxf(x, 0.f) + log1pf(expf(-fabsf(x))); }
DEV float logsigf_(float x) { return fminf(x, 0.f) - log1pf(expf(-fabsf(x))); }
DEV float wave_sum(float v) {
#pragma unroll
    for (int o = 32; o >= 1; o >>= 1) v += __shfl_xor(v, o);
    return v; }
DEV float wave_max(float v) {
#pragma unroll
    for (int o = 32; o >= 1; o >>= 1) v = fmaxf(v, __shfl_xor(v, o));
    return v; }
DEV float wave_incl_sum(float v, int lane) {
#pragma unroll
    for (int o = 1; o < 64; o <<= 1) { float t = __shfl_up(v, o); if (lane >= o) v += t; }
    return v; }
DEV float wave_incl_max(float v, int lane) {
#pragma unroll
    for (int o = 1; o < 64; o <<= 1) { float t = __shfl_up(v, o); if (lane >= o) v = fmaxf(v, t); }
    return v; }
DEV f32x4 mfma16(bf16x8 a, bf16x8 b, f32x4 c) { return __builtin_amdgcn_mfma_f32_16x16x32_bf16(a, b, c, 0, 0, 0); }
DEV void unpack8(uint4 x, float (&f)[8]) { f[0] = bflo(x.x); f[1] = bfhi(x.x); f[2] = bflo(x.y); f[3] = bfhi(x.y); f[4] = bflo(x.z); f[5] = bfhi(x.z); f[6] = bflo(x.w); f[7] = bfhi(x.w); }

namespace pg8 {
constexpr int BM = 256, BK = 64, HALF = 128, HTB = HALF * BK * 2, STAGE_BYTES = 8 * HTB, NXCD = 8, WGM = 8;
DEV int lds_byte(int r, int c) { const int st = (r >> 4) * 2 + (c >> 5), rr = r & 15, cc = c & 31, ob = rr * 64 + cc * 2; return st * 1024 + (ob ^ (((ob >> 9) & 1) << 5)); }
DEV void stage_rc(int b, int& R, int& C) { const int st = b / 1024, sb = b % 1024, swz = sb ^ (((sb >> 9) & 1) << 5); R = (st >> 1) * 16 + swz / 64; C = (st & 1) * 32 + (swz % 64) / 2; }
DEV int perm32(int rho) { const int n = rho >> 4, i = rho & 15; return 8 * (i >> 2) + 4 * n + (i & 3); }
struct Unit { int pm, pn; };
struct Gemm { const bf16_t* A; const bf16_t* Bt; int M, N, K; };
struct StaticOrder {
    int nM, nN, nwg, G, c;
    DEV void init(int M, int N, int G_, int c_) { nM = M / BM; nN = N / BM; nwg = nM * nN; G = G_; c = c_; }
    DEV bool next(int i, Unit& u) const {
        const long L = (long)i * G + c; if (L >= nwg) return false;
        int wgid = (int)L; { const int q = nwg / NXCD, r = nwg % NXCD, xcd = wgid % NXCD, off = wgid / NXCD; wgid = (xcd < r ? xcd * (q + 1) : r * (q + 1) + (xcd - r) * q) + off; }
        const int nig = WGM * nN, gid = wgid / nig, fm = gid * WGM, gsz = (nM - fm) < WGM ? (nM - fm) : WGM;
        u.pm = fm + ((wgid % nig) % gsz); u.pn = (wgid % nig) / gsz; return true;
    }
};
DEV unsigned cvt_pk_bf16(float lo, float hi) { unsigned r; asm volatile("v_cvt_pk_bf16_f32 %0, %1, %2" : "=v"(r) : "v"(lo), "v"(hi)); return r; }
struct EpiF32 {
    static constexpr bool PERM = false;
    float* C; int ldc;
    DEV void operator()(const f32x4 (&acc)[2][2][4][2], const Unit& u, int wr, int wc, int fr, int fq) const {
        const int row0 = u.pm * BM + wr * 64 + fr, col0 = u.pn * BM + wc * 32 + 4 * fq;
#pragma unroll
        for (int ai = 0; ai < 2; ++ai)
#pragma unroll
            for (int m = 0; m < 4; ++m) { float* rowp = C + (size_t)(row0 + ai * HALF + m * 16) * ldc + col0;
#pragma unroll
                for (int bj = 0; bj < 2; ++bj)
#pragma unroll
                    for (int n = 0; n < 2; ++n) *(f32x4*)(rowp + bj * HALF + n * 16) = acc[ai][bj][m][n]; }
    }
};
struct EpiBf16 {
    static constexpr bool PERM = true;
    bf16_t* O; int ldc;
    DEV void operator()(const f32x4 (&acc)[2][2][4][2], const Unit& u, int wr, int wc, int fr, int fq) const {
        const int row0 = u.pm * BM + wr * 64 + fr; const int col0 = u.pn * BM + wc * 32 + 8 * fq;
#pragma unroll
        for (int ai = 0; ai < 2; ++ai)
#pragma unroll
            for (int m = 0; m < 4; ++m) { bf16_t* rowp = O + (size_t)(row0 + ai * HALF + m * 16) * ldc + col0;
#pragma unroll
                for (int bj = 0; bj < 2; ++bj) { const f32x4 v0 = acc[ai][bj][m][0], v1 = acc[ai][bj][m][1];
                    u32x4 w; w.x = cvt_pk_bf16(v0[0], v0[1]); w.y = cvt_pk_bf16(v0[2], v0[3]); w.z = cvt_pk_bf16(v1[0], v1[1]); w.w = cvt_pk_bf16(v1[2], v1[3]);
                    *(u32x4*)(rowp + bj * HALF) = w; } }
    }
};

template <class Epi>
DEV void gemm_phase(LAS unsigned char* lds, const Gemm g, const StaticOrder& S, const Epi& E) {
    int tid_ = threadIdx.x; asm volatile("" : "+v"(tid_)); const int tid = tid_, wid = __builtin_amdgcn_readfirstlane(tid >> 6), lane = tid & 63, wr = wid >> 2, wc = wid & 3, fr = lane & 15, fq = lane >> 4;
    const int K = g.K, nt = K / BK;
    unsigned voffA[2], voffB[2];
#pragma unroll
    for (int i = 0; i < 2; ++i) { int R, C; stage_rc(tid * 16 + i * 8192, R, C); const int Rb = Epi::PERM ? ((R & ~31) + perm32(R & 31)) : R;
        voffA[i] = (unsigned)(R * K + C) * 2u; voffB[i] = (unsigned)(Rb * K + C) * 2u; }
    const size_t kstep = (size_t)(BK * 2);
    const size_t hstep = (size_t)HALF * K * 2;
    const size_t tstep = 2 * hstep;
    const unsigned ldsw = (unsigned)wid * 1024u;
    const int aoff = lds_byte(wr * 64 + fr, fq * 8), boff = lds_byte(wc * 32 + fr, fq * 8);
#define PG8_SA(b, h) (((b) * 2 + (h)) * HTB)
#define PG8_SB(b, h) ((4 + (b) * 2 + (h)) * HTB)
#define PG8_STAGE(bufoff, gbase, voff) do { _Pragma("unroll") for (int _i = 0; _i < 2; ++_i) \
        __builtin_amdgcn_global_load_lds((const unsigned*)((const char*)(gbase) + (voff)[_i]), (LAS unsigned*)(lds + (bufoff) + ldsw + _i * 8192), 16, 0, 0); } while (0)
#define PG8_LDA(dst, b, h) do { _Pragma("unroll") for (int m = 0; m < 4; ++m) _Pragma("unroll") for (int k = 0; k < 2; ++k) dst[m][k] = *(const LAS bf16x8*)(lds + PG8_SA(b, h) + aoff + m * 2048 + k * 1024); } while (0)
#define PG8_LDB(dst, b, h) do { _Pragma("unroll") for (int n = 0; n < 2; ++n) _Pragma("unroll") for (int k = 0; k < 2; ++k) dst[n][k] = *(const LAS bf16x8*)(lds + PG8_SB(b, h) + boff + n * 2048 + k * 1024); } while (0)
#define PG8_MMA(ai, bj, At, Bt) do { __builtin_amdgcn_s_setprio(1); _Pragma("unroll") for (int m = 0; m < 4; ++m) _Pragma("unroll") for (int n = 0; n < 2; ++n) _Pragma("unroll") for (int k = 0; k < 2; ++k) \
        acc[ai][bj][m][n] = __builtin_amdgcn_mfma_f32_16x16x32_bf16(Bt[n][k], At[m][k], acc[ai][bj][m][n], 0, 0, 0); __builtin_amdgcn_s_setprio(0); } while (0)
#define PG8_WAIT_V(n) asm volatile("s_waitcnt vmcnt(" #n ")" ::: "memory")
#define PG8_WAIT_L(n) asm volatile("s_waitcnt lgkmcnt(" #n ")" ::: "memory")
#define PG8_BAR __builtin_amdgcn_s_barrier()
#define PG8_SCHED __builtin_amdgcn_sched_barrier(0)
    Unit cur, nxt; int ui = 0;
    if (!S.next(0, cur)) return;
    f32x4 acc[2][2][4][2];
#pragma unroll
    for (int a = 0; a < 2; ++a)
#pragma unroll
        for (int b = 0; b < 2; ++b)
#pragma unroll
            for (int m = 0; m < 4; ++m)
#pragma unroll
                for (int n = 0; n < 2; ++n) acc[a][b][m][n] = (f32x4){0.f, 0.f, 0.f, 0.f};
    bf16x8 At[4][2], B0[2][2], B1[2][2];
    const char* cA = (const char*)g.A + (size_t)cur.pm * tstep; const char* cB = (const char*)g.Bt + (size_t)cur.pn * tstep;
    PG8_STAGE(PG8_SB(0, 0), cB, voffB); PG8_STAGE(PG8_SA(0, 0), cA, voffA); PG8_STAGE(PG8_SB(0, 1), cB + hstep, voffB); PG8_STAGE(PG8_SA(0, 1), cA + hstep, voffA);
    if (wr == 1) PG8_BAR;
    PG8_WAIT_V(4); PG8_BAR;
    PG8_STAGE(PG8_SB(1, 0), cB + kstep, voffB); PG8_STAGE(PG8_SA(1, 0), cA + kstep, voffA); PG8_STAGE(PG8_SB(1, 1), cB + hstep + kstep, voffB);
    PG8_WAIT_V(6); PG8_BAR;
    for (;;) {
        const bool has_next = S.next(ui + 1, nxt);
        const char* nA = has_next ? (const char*)g.A + (size_t)nxt.pm * tstep : cA; const char* nB = has_next ? (const char*)g.Bt + (size_t)nxt.pn * tstep : cB;
        for (int t = 0; t < nt; t += 2) {
            const bool last = (t == nt - 2);
            const char* a1 = cA + (size_t)(t + 1) * kstep;
            const char* a2 = last ? nA : cA + (size_t)(t + 2) * kstep; const char* b2 = last ? nB : cB + (size_t)(t + 2) * kstep;
            const char* a3 = a2 + kstep; const char* b3 = b2 + kstep;
            PG8_LDB(B0, 0, 0); PG8_SCHED; PG8_LDA(At, 0, 0); PG8_STAGE(PG8_SA(1, 1), a1 + hstep, voffA);
            PG8_WAIT_L(8); PG8_BAR; PG8_WAIT_L(0); PG8_MMA(0, 0, At, B0); PG8_BAR; PG8_SCHED;
            PG8_LDB(B1, 0, 1); PG8_STAGE(PG8_SB(0, 0), b2, voffB);
            PG8_BAR; PG8_WAIT_L(0); PG8_MMA(0, 1, At, B1); PG8_BAR;
            PG8_LDA(At, 0, 1); PG8_STAGE(PG8_SA(0, 0), a2, voffA);
            PG8_BAR; PG8_WAIT_L(0); PG8_MMA(1, 0, At, B0); PG8_BAR; PG8_SCHED;
            PG8_STAGE(PG8_SB(0, 1), b2 + hstep, voffB);
            PG8_WAIT_V(6); PG8_BAR; PG8_MMA(1, 1, At, B1); PG8_BAR;
            PG8_LDB(B0, 1, 0); PG8_SCHED; PG8_LDA(At, 1, 0); PG8_STAGE(PG8_SA(0, 1), a2 + hstep, voffA);
            PG8_WAIT_L(8); PG8_BAR; PG8_WAIT_L(0); PG8_MMA(0, 0, At, B0); PG8_BAR; PG8_SCHED;
            PG8_LDB(B1, 1, 1); PG8_STAGE(PG8_SB(1, 0), b3, voffB);
            PG8_BAR; PG8_WAIT_L(0); PG8_MMA(0, 1, At, B1); PG8_BAR;
            PG8_LDA(At, 1, 1); PG8_STAGE(PG8_SA(1, 0), a3, voffA);
            PG8_BAR; PG8_WAIT_L(0); PG8_MMA(1, 0, At, B0); PG8_BAR; PG8_SCHED;
            PG8_STAGE(PG8_SB(1, 1), b3 + hstep, voffB);
            PG8_WAIT_V(6); PG8_BAR; PG8_MMA(1, 1, At, B1); PG8_BAR;
        }
        E(acc, cur, wr, wc, fr, fq);
        if (!has_next) break;
#pragma unroll
        for (int a = 0; a < 2; ++a)
#pragma unroll
            for (int b = 0; b < 2; ++b)
#pragma unroll
                for (int m = 0; m < 4; ++m)
#pragma unroll
                    for (int n = 0; n < 2; ++n) acc[a][b][m][n] = (f32x4){0.f, 0.f, 0.f, 0.f};
        cur = nxt; cA = nA; cB = nB; ++ui;
    }
    PG8_WAIT_V(0);
    if (wr == 0) PG8_BAR;
    PG8_BAR;
#undef PG8_SA
#undef PG8_SB
#undef PG8_STAGE
#undef PG8_LDA
#undef PG8_LDB
#undef PG8_MMA
#undef PG8_WAIT_V
#undef PG8_WAIT_L
#undef PG8_BAR
#undef PG8_SCHED
}
}

DEV int win_srccol(int n) { return n < 4096 ? n : (n < 6656 ? n + 8 : (n < 6664 ? n - 2560 : (n < 6680 ? n : -1))); }
DEV void transpose_tile(const float* __restrict__ src, int srcN, bf16_t* __restrict__ dst, int K, int n0, int k0, int mode, float* tile) {
    const int tid = threadIdx.x;
#pragma unroll
    for (int i = 0; i < 2; ++i) {
        const int kk = (tid >> 4) + 32 * i, nn4 = (tid & 15) * 4, n = n0 + nn4;
        const int sc = mode ? win_srccol(n) : n;
        f32x4 v = (f32x4){0.f, 0.f, 0.f, 0.f};
        if (sc >= 0) v = *(const f32x4*)(src + (size_t)(k0 + kk) * srcN + sc);
        if (mode && n >= 1024 && n < 2048) v = v * 0.0625f;
        tile[kk * 65 + nn4 + 0] = v[0]; tile[kk * 65 + nn4 + 1] = v[1]; tile[kk * 65 + nn4 + 2] = v[2]; tile[kk * 65 + nn4 + 3] = v[3];
    }
    __syncthreads();
    {
        const int nn = tid >> 3, kk8 = (tid & 7) * 8;
        u32x4 w;
        w.x = pk2(tile[(kk8 + 0) * 65 + nn], tile[(kk8 + 1) * 65 + nn]); w.y = pk2(tile[(kk8 + 2) * 65 + nn], tile[(kk8 + 3) * 65 + nn]);
        w.z = pk2(tile[(kk8 + 4) * 65 + nn], tile[(kk8 + 5) * 65 + nn]); w.w = pk2(tile[(kk8 + 6) * 65 + nn], tile[(kk8 + 7) * 65 + nn]);
        *(u32x4*)(dst + (size_t)(n0 + nn) * K + k0 + kk8) = w;
    }
    __syncthreads();
}
DEV void phase_prologue(const P& p, unsigned char* lds) {
    float* tile = (float*)lds;
    constexpr int T_WIN = (INP / 64) * (D / 64), T_WOUT = (D / 64) * (D / 64), T_WUP = (DFF2 / 64) * (D / 64), T_WDN = (D / 64) * (DFF / 64);
    constexpr int T_L = T_WIN + T_WOUT + T_WUP + T_WDN, T_X = NTOK * D / 4096;
    const int total = 2 * T_L + T_X;
    for (int u = blockIdx.x; u < total; u += gridDim.x) {
        if (u < 2 * T_L) {
            const int l = u / T_L; int r = u % T_L;
            if (r < T_WIN) { const int nt = r / (D / 64), kt = r % (D / 64);
                transpose_tile(p.w_in + (size_t)l * D * IN_DIM, IN_DIM, (bf16_t*)(p.ws + WS_WIN) + (size_t)l * INP * D, D, nt * 64, kt * 64, 1, tile); }
            else if ((r -= T_WIN) < T_WOUT) { const int nt = r / (D / 64), kt = r % (D / 64);
                transpose_tile(p.w_out + (size_t)l * D * D, D, (bf16_t*)(p.ws + WS_WOUT) + (size_t)l * D * D, D, nt * 64, kt * 64, 0, tile); }
            else if ((r -= T_WOUT) < T_WUP) { const int nt = r / (D / 64), kt = r % (D / 64);
                transpose_tile(p.w_up + (size_t)l * D * DFF2, DFF2, (bf16_t*)(p.ws + WS_WUP) + (size_t)l * DFF2 * D, D, nt * 64, kt * 64, 0, tile); }
            else { r -= T_WUP; const int nt = r / (DFF / 64), kt = r % (DFF / 64);
                transpose_tile(p.w_down + (size_t)l * DFF * D, D, (bf16_t*)(p.ws + WS_WDN) + (size_t)l * D * DFF, DFF, nt * 64, kt * 64, 0, tile); }
        } else {
            const size_t e = (size_t)(u - 2 * T_L) * 4096 + threadIdx.x * 8;
            const float* s = e < (size_t)NPR * D ? p.x_prompt + e : p.x_sample + (e - (size_t)NPR * D);
            const f32x4 a = *(const f32x4*)s, b = *(const f32x4*)(s + 4);
            u32x4 w; w.x = pk2(a[0], a[1]); w.y = pk2(a[2], a[3]); w.z = pk2(b[0], b[1]); w.w = pk2(b[2], b[3]);
            *(u32x4*)((bf16_t*)(p.ws + WS_XB) + e) = w;
        }
    }
}

DEV void mlstm_local(const P& p, int l, int unit, unsigned char* lds) {
    const int bh = unit >> 5, c = unit & 31, b = bh >> 2, h = bh & 3;
    int tid_ = threadIdx.x; asm volatile("" : "+v"(tid_)); const int tid = tid_, lane = tid & 63, w = tid >> 6, fr = lane & 15, fq = lane >> 4;
    const bf16_t* U = (const bf16_t*)(p.ws + WS_U) + (size_t)(b * 2048 + c * 64) * INP;
    float* wsh = (float*)lds;
    bf16_t* KWt = (bf16_t*)(lds + 1024);
    bf16_t* Vt = KWt + 256 * 72;
    float* gstat = (float*)(p.ws + WS_GSTAT);
    if (w == 0) {
        const float ig = bf2f(U[(size_t)lane * INP + UIG + h]) + p.b_i[l * 4 + h];
        const float lf = logsigf_(bf2f(U[(size_t)lane * INP + UFG + h]) + p.b_f[l * 4 + h]);
        const float bs = wave_incl_sum(lf, lane);
        const float a = ig - bs;
        const float amax = wave_max(a);
        const float bsum = __shfl(bs, 63);
        wsh[lane] = expf(a - amax);
        if (lane == 0) { gstat[(bh * 32 + c) * 2] = bsum; gstat[(bh * 32 + c) * 2 + 1] = bsum + amax; }
    }
    __syncthreads();
#pragma unroll
    for (int i = 0; i < 4; ++i) {
        const int it = tid + 512 * i, s = it >> 5, d8 = (it & 31) * 8;
        const uint4 kv = *(const uint4*)(U + (size_t)s * INP + UK + h * 256 + d8);
        const uint4 vv = *(const uint4*)(U + (size_t)s * INP + UV + h * 256 + d8);
        const float ws_ = wsh[s];
        float kf[8]; unpack8(kv, kf);
        const unsigned vw[4] = {vv.x, vv.y, vv.z, vv.w};
#pragma unroll
        for (int j = 0; j < 8; ++j) {
            KWt[(d8 + j) * 72 + s] = f2bf(kf[j] * ws_);
            Vt[(d8 + j) * 72 + s] = (bf16_t)((j & 1) ? (vw[j >> 1] >> 16) : (vw[j >> 1] & 0xffffu));
        }
    }
    __syncthreads();
    if (tid < 256) { float a = 0.f; for (int s = 0; s < 64; ++s) a += bf2f(KWt[tid * 72 + s]); ((float*)(p.ws + WS_NLOC))[(size_t)(bh * 32 + c) * 256 + tid] = a; }
    f32x4 acc[2][16];
#pragma unroll
    for (int m = 0; m < 2; ++m)
#pragma unroll
        for (int n = 0; n < 16; ++n) acc[m][n] = (f32x4){0.f, 0.f, 0.f, 0.f};
#pragma unroll
    for (int k0 = 0; k0 < 64; k0 += 32) {
        bf16x8 a[2];
#pragma unroll
        for (int m = 0; m < 2; ++m) a[m] = *(const bf16x8*)(Vt + (32 * w + 16 * m + fr) * 72 + k0 + fq * 8);
#pragma unroll
        for (int n = 0; n < 16; ++n) {
            const bf16x8 bb = *(const bf16x8*)(KWt + (16 * n + fr) * 72 + k0 + fq * 8);
#pragma unroll
            for (int m = 0; m < 2; ++m) acc[m][n] = mfma16(a[m], bb, acc[m][n]);
        }
    }
    float* Dp = (float*)(p.ws + WS_DBUF) + (size_t)(bh * 32 + c) * 65536;
#pragma unroll
    for (int m = 0; m < 2; ++m)
#pragma unroll
        for (int n = 0; n < 16; ++n)
#pragma unroll
            for (int j = 0; j < 4; ++j) Dp[(32 * w + 16 * m + fq * 4 + j) * 256 + 16 * n + fr] = acc[m][n][j];
    __syncthreads();
}

DEV void mlstm_scan(const P& p, int l, int unit, unsigned char* lds) {
    int tid_ = threadIdx.x; asm volatile("" : "+v"(tid_)); const int bh = unit >> 4, slab = unit & 15, tid = tid_;
    float* fA = (float*)lds; float* fB = fA + 32;
    const float* gstat = (const float*)(p.ws + WS_GSTAT);
    if (tid == 0) {
        float m = 0.f;
        for (int c = 0; c < 32; ++c) {
            const float bsum = gstat[(bh * 32 + c) * 2], mloc = gstat[(bh * 32 + c) * 2 + 1];
            const float mn = fmaxf(bsum + m, mloc);
            fA[c] = expf(bsum + m - mn); fB[c] = expf(mloc - mn); m = mn;
            if (slab == 0) ((float*)(p.ws + WS_MST))[bh * 32 + c] = mn;
        }
        if (slab == 0) p.out[O_PM + l * 16 + bh] = m;
    }
    __syncthreads();
    const size_t e0 = (size_t)slab * 4096 + tid * 8;
    float run[8];
#pragma unroll
    for (int i = 0; i < 8; ++i) run[i] = 0.f;
    const float* Dp = (const float*)(p.ws + WS_DBUF) + (size_t)bh * 32 * 65536 + e0;
    bf16_t* Cp = (bf16_t*)(p.ws + WS_CT) + (size_t)bh * 32 * 65536 + e0;
    for (int c = 0; c < 32; ++c) {
        const f32x4 x0 = *(const f32x4*)(Dp + (size_t)c * 65536), x1 = *(const f32x4*)(Dp + (size_t)c * 65536 + 4);
        const float a = fA[c], bq = fB[c];
#pragma unroll
        for (int i = 0; i < 4; ++i) { run[i] = a * run[i] + bq * x0[i]; run[4 + i] = a * run[4 + i] + bq * x1[i]; }
        u32x4 wv; wv.x = pk2(run[0], run[1]); wv.y = pk2(run[2], run[3]); wv.z = pk2(run[4], run[5]); wv.w = pk2(run[6], run[7]);
        *(u32x4*)(Cp + (size_t)c * 65536) = wv;
    }
    {
        float* o = p.out + O_PC + (size_t)(l * 16 + bh) * 65536;
        const int e = (int)(e0 >> 8), d0 = (int)(e0 & 255);
#pragma unroll
        for (int i = 0; i < 8; ++i) o[(d0 + i) * 256 + e] = run[i];
    }
    if (slab == 0 && tid < 256) {
        float r = 0.f;
        const float* nl = (const float*)(p.ws + WS_NLOC) + (size_t)bh * 32 * 256 + tid;
        float* ns = (float*)(p.ws + WS_NST) + (size_t)bh * 32 * 256 + tid;
        for (int c = 0; c < 32; ++c) { r = fA[c] * r + fB[c] * nl[c * 256]; ns[c * 256] = r; }
        p.out[O_PN + (size_t)(l * 16 + bh) * 256 + tid] = r;
    }
    __syncthreads();
}

DEV void ssd_scan(const P& p, int l, int unit, unsigned char* lds) {
    int tid_ = threadIdx.x; asm volatile("" : "+v"(tid_)); const int bhd = unit >> 1, slab = unit & 1, tid = tid_;
    float* dec = (float*)lds;
    if (tid < 32) dec[tid] = expf(((const float*)(p.ws + WS_SBSUM))[bhd * 32 + tid]);
    __syncthreads();
    const size_t e0 = (size_t)slab * 4096 + tid * 8;
    float run[8];
#pragma unroll
    for (int i = 0; i < 8; ++i) run[i] = 0.f;
    const float* Sp = (const float*)(p.ws + WS_SBUF) + (size_t)bhd * 32 * 8192 + e0;
    bf16_t* Tp = (bf16_t*)(p.ws + WS_ST) + (size_t)bhd * 32 * 8192 + e0;
    for (int c = 0; c < 32; ++c) {
        const f32x4 x0 = *(const f32x4*)(Sp + (size_t)c * 8192), x1 = *(const f32x4*)(Sp + (size_t)c * 8192 + 4);
        const float a = dec[c];
#pragma unroll
        for (int i = 0; i < 4; ++i) { run[i] = a * run[i] + x0[i]; run[4 + i] = a * run[4 + i] + x1[i]; }
        u32x4 wv; wv.x = pk2(run[0], run[1]); wv.y = pk2(run[2], run[3]); wv.z = pk2(run[4], run[5]); wv.w = pk2(run[6], run[7]);
        *(u32x4*)(Tp + (size_t)c * 8192) = wv;
    }
    float* o = p.out + O_PS + (size_t)(l * 64 + bhd) * 8192 + e0;
    *(f32x4*)o = (f32x4){run[0], run[1], run[2], run[3]}; *(f32x4*)(o + 4) = (f32x4){run[4], run[5], run[6], run[7]};
    __syncthreads();
}

DEV void convstate_copy(const P& p, int l, int unit) {
    const bf16_t* Ub = (const bf16_t*)(p.ws + WS_U);
    for (int i = threadIdx.x; i < 3 * 1536; i += NTHR) {
        const int j = i / 1536, ch = i % 1536;
        if (unit < 4) p.out[O_PSC + ((size_t)(l * 4 + unit) * 3 + j) * 1536 + ch] = bf2f(Ub[(size_t)(unit * 2048 + 2045 + j) * INP + UXS + ch]);
        else { const int b = unit - 4; p.out[O_SSC + ((size_t)(l * 128 + b) * 3 + j) * 1536 + ch] = bf2f(Ub[(size_t)(NPR + b * 8 + 5 + j) * INP + UXS + ch]); }
    }
}

DEV void mlstm_out(const P& p, int l, int unit, unsigned char* lds) {
    const int bh = unit >> 5, c = unit & 31, b = bh >> 2, h = bh & 3;
    int tid_ = threadIdx.x; asm volatile("" : "+v"(tid_)); const int tid = tid_, lane = tid & 63, w = tid >> 6, fr = lane & 15, fq = lane >> 4;
    const int r0 = b * 2048 + c * 64;
    const bf16_t* U = (const bf16_t*)(p.ws + WS_U) + (size_t)r0 * INP;
    bf16_t* Qs = (bf16_t*)lds;
    bf16_t* Ks = Qs + 64 * 264;
    bf16_t* Vt = Ks + 64 * 264;
    bf16_t* Ss = Vt + 256 * 72;
    float* fl = (float*)(lds + 113664);
    float* bsh = fl; float* ash = fl + 64; float* mth = fl + 128; float* wint = fl + 192; float* rdn = fl + 256; float* qn = fl + 320; float* nprev = fl + 384; float* red = fl + 640;
    float* stat = fl + 1152;
    if (w == 0) {
        const float ig = bf2f(U[(size_t)lane * INP + UIG + h]) + p.b_i[l * 4 + h];
        const float lf = logsigf_(bf2f(U[(size_t)lane * INP + UFG + h]) + p.b_f[l * 4 + h]);
        const float bs = wave_incl_sum(lf, lane);
        const float a = ig - bs;
        const float cm = wave_incl_max(a, lane);
        const float mprev = c > 0 ? ((const float*)(p.ws + WS_MST))[bh * 32 + c - 1] : 0.f;
        const float mt = bs + fmaxf(mprev, cm);
        bsh[lane] = bs; ash[lane] = a; mth[lane] = mt; wint[lane] = expf(bs + mprev - mt);
    }
    if (tid >= 256) { const int d = tid - 256; nprev[d] = c > 0 ? ((const float*)(p.ws + WS_NST))[(size_t)(bh * 32 + c - 1) * 256 + d] : 0.f; }
#pragma unroll
    for (int i = 0; i < 4; ++i) {
        const int it = tid + 512 * i, s = it >> 5, d8 = (it & 31) * 8;
        *(uint4*)(Qs + s * 264 + d8) = *(const uint4*)(U + (size_t)s * INP + UQ + h * 256 + d8);
        *(uint4*)(Ks + s * 264 + d8) = *(const uint4*)(U + (size_t)s * INP + UK + h * 256 + d8);
        const uint4 vv = *(const uint4*)(U + (size_t)s * INP + UV + h * 256 + d8);
        const unsigned vw[4] = {vv.x, vv.y, vv.z, vv.w};
#pragma unroll
        for (int j = 0; j < 8; ++j) Vt[(d8 + j) * 72 + s] = (bf16_t)((j & 1) ? (vw[j >> 1] >> 16) : (vw[j >> 1] & 0xffffu));
    }
    __syncthreads();
    {
        const int mt_ = w >> 1, nt0 = (w & 1) * 2;
        f32x4 sacc[2] = {(f32x4){0.f, 0.f, 0.f, 0.f}, (f32x4){0.f, 0.f, 0.f, 0.f}};
#pragma unroll
        for (int k0 = 0; k0 < 256; k0 += 32) {
            const bf16x8 a = *(const bf16x8*)(Qs + (16 * mt_ + fr) * 264 + k0 + fq * 8);
#pragma unroll
            for (int n = 0; n < 2; ++n) { const bf16x8 bb = *(const bf16x8*)(Ks + (16 * (nt0 + n) + fr) * 264 + k0 + fq * 8); sacc[n] = mfma16(a, bb, sacc[n]); }
        }
#pragma unroll
        for (int n = 0; n < 2; ++n)
#pragma unroll
            for (int j = 0; j < 4; ++j) {
                const int t = 16 * mt_ + fq * 4 + j, s = 16 * (nt0 + n) + fr;
                const float val = (s <= t) ? sacc[n][j] * expf(bsh[t] - mth[t] + ash[s]) : 0.f;
                Ss[t * 72 + s] = f2bf(val);
            }
        const int t = tid >> 3, part = tid & 7;
        float a = 0.f;
        for (int d = part * 32; d < part * 32 + 32; ++d) a += bf2f(Qs[t * 264 + d]) * nprev[d];
        a += __shfl_xor(a, 1); a += __shfl_xor(a, 2); a += __shfl_xor(a, 4);
        if (part == 0) qn[t] = a;
    }
    __syncthreads();
    if (tid < 64) {
        float di = 0.f;
        for (int s = 0; s < 64; ++s) di += bf2f(Ss[tid * 72 + s]);
        const float den = di + wint[tid] * qn[tid];
        rdn[tid] = 1.0f / fmaxf(fabsf(den), expf(-mth[tid]));
    }
    const int e0 = 32 * w;
    f32x4 acc1[4][2], acc2[4][2];
#pragma unroll
    for (int m = 0; m < 4; ++m)
#pragma unroll
        for (int n = 0; n < 2; ++n) { acc1[m][n] = (f32x4){0.f, 0.f, 0.f, 0.f}; acc2[m][n] = (f32x4){0.f, 0.f, 0.f, 0.f}; }
#pragma unroll
    for (int k0 = 0; k0 < 64; k0 += 32) {
        bf16x8 a[4];
#pragma unroll
        for (int m = 0; m < 4; ++m) a[m] = *(const bf16x8*)(Ss + (16 * m + fr) * 72 + k0 + fq * 8);
#pragma unroll
        for (int n = 0; n < 2; ++n) { const bf16x8 bb = *(const bf16x8*)(Vt + (e0 + 16 * n + fr) * 72 + k0 + fq * 8);
#pragma unroll
            for (int m = 0; m < 4; ++m) acc1[m][n] = mfma16(a[m], bb, acc1[m][n]); }
    }
    if (c > 0) {
        const bf16_t* CTp = (const bf16_t*)(p.ws + WS_CT) + (size_t)(bh * 32 + c - 1) * 65536;
#pragma unroll 2
        for (int k0 = 0; k0 < 256; k0 += 32) {
            bf16x8 a[4];
#pragma unroll
            for (int m = 0; m < 4; ++m) a[m] = *(const bf16x8*)(Qs + (16 * m + fr) * 264 + k0 + fq * 8);
#pragma unroll
            for (int n = 0; n < 2; ++n) { const bf16x8 bb = *(const bf16x8*)(CTp + (size_t)(e0 + 16 * n + fr) * 256 + k0 + fq * 8);
#pragma unroll
                for (int m = 0; m < 4; ++m) acc2[m][n] = mfma16(a[m], bb, acc2[m][n]); }
        }
    }
    __syncthreads();
#pragma unroll
    for (int m = 0; m < 4; ++m)
#pragma unroll
        for (int j = 0; j < 4; ++j) {
            const int t = 16 * m + fq * 4 + j;
            const float wi = wint[t], rd = rdn[t];
            float s = 0.f;
#pragma unroll
            for (int n = 0; n < 2; ++n) { const float hv = (acc1[m][n][j] + wi * acc2[m][n][j]) * rd; acc1[m][n][j] = hv; s += hv; }
            s += __shfl_xor(s, 1); s += __shfl_xor(s, 2); s += __shfl_xor(s, 4); s += __shfl_xor(s, 8);
            if (fr == 0) red[t * 8 + w] = s;
        }
    __syncthreads();
    if (tid < 64) { float s = 0.f;
#pragma unroll
        for (int i = 0; i < 8; ++i) s += red[tid * 8 + i];
        stat[tid] = s * (1.0f / 256.0f); }
    __syncthreads();
#pragma unroll
    for (int m = 0; m < 4; ++m)
#pragma unroll
        for (int j = 0; j < 4; ++j) {
            const int t = 16 * m + fq * 4 + j;
            const float mu = stat[t];
            float s = 0.f;
#pragma unroll
            for (int n = 0; n < 2; ++n) { const float dv = acc1[m][n][j] - mu; acc1[m][n][j] = dv; s += dv * dv; }
            s += __shfl_xor(s, 1); s += __shfl_xor(s, 2); s += __shfl_xor(s, 4); s += __shfl_xor(s, 8);
            if (fr == 0) red[t * 8 + w] = s;
        }
    __syncthreads();
    if (tid < 64) { float s = 0.f;
#pragma unroll
        for (int i = 0; i < 8; ++i) s += red[tid * 8 + i];
        stat[64 + tid] = rsqrtf(s * (1.0f / 256.0f) + 1e-6f); }
    __syncthreads();
    bf16_t* MX = (bf16_t*)(p.ws + WS_MIXIN);
#pragma unroll
    for (int m = 0; m < 4; ++m)
#pragma unroll
        for (int j = 0; j < 4; ++j) {
            const int t = 16 * m + fq * 4 + j;
            const float rs = stat[64 + t];
#pragma unroll
            for (int n = 0; n < 2; ++n) {
                const int e = e0 + 16 * n + fr;
                const float o = bf2f(U[(size_t)t * INP + UO + h * 256 + e]);
                MX[(size_t)(r0 + t) * D + h * 256 + e] = f2bf(acc1[m][n][j] * rs * p.m_norm_w[l * 1024 + h * 256 + e] * sigmoidf_(o));
            }
        }
    __syncthreads();
}

DEV void ssd_conv8(const bf16_t* Urow, int tpos, const float* cw, const float* cb, int ch8, float (&o)[8]) {
    const f32x4 b0 = *(const f32x4*)(cb + ch8), b1 = *(const f32x4*)(cb + ch8 + 4);
    o[0] = b0[0]; o[1] = b0[1]; o[2] = b0[2]; o[3] = b0[3]; o[4] = b1[0]; o[5] = b1[1]; o[6] = b1[2]; o[7] = b1[3];
#pragma unroll
    for (int j = 0; j < 4; ++j) {
        const int back = 3 - j;
        if (tpos - back >= 0) {
            const uint4 x = *(const uint4*)(Urow - (size_t)back * INP + UXS + ch8);
            float xf[8]; unpack8(x, xf);
            const f32x4 w0 = *(const f32x4*)(cw + j * 1536 + ch8), w1 = *(const f32x4*)(cw + j * 1536 + ch8 + 4);
            o[0] += w0[0] * xf[0]; o[1] += w0[1] * xf[1]; o[2] += w0[2] * xf[2]; o[3] += w0[3] * xf[3];
            o[4] += w1[0] * xf[4]; o[5] += w1[1] * xf[5]; o[6] += w1[2] * xf[6]; o[7] += w1[3] * xf[7];
        }
    }
#pragma unroll
    for (int i = 0; i < 8; ++i) o[i] = siluf_(o[i]);
}

DEV void ssd_local(const P& p, int l, int unit, unsigned char* lds) {
    const int b = unit >> 6, g = (unit >> 5) & 1, c = unit & 31;
    int tid_ = threadIdx.x; asm volatile("" : "+v"(tid_)); const int tid = tid_, lane = tid & 63, w = tid >> 6, fr = lane & 15, fq = lane >> 4;
    const int r0 = b * 2048 + c * 64;
    const bf16_t* U = (const bf16_t*)(p.ws + WS_U) + (size_t)r0 * INP;
    bf16_t* XWt = (bf16_t*)lds;
    bf16_t* BmT = XWt + 512 * 72;
    float* wsh = (float*)(lds + 92160);
    {
        const int head = g * 8 + w;
        const float dt = softplusf_(bf2f(U[(size_t)lane * INP + UDT + head]) + p.dt_bias[l * 16 + head]);
        const float a = -expf(p.A_log[l * 16 + head]) * dt;
        const float bs = wave_incl_sum(a, lane);
        const float bL = __shfl(bs, 63);
        wsh[w * 64 + lane] = expf(bL - bs) * dt;
        if (lane == 0) ((float*)(p.ws + WS_SBSUM))[(b * 16 + head) * 32 + c] = bL;
    }
    __syncthreads();
    const float* cw = p.s_conv_w + (size_t)l * 4 * 1536; const float* cb = p.s_conv_b + (size_t)l * 1536;
    for (int i = 0; i < 10; ++i) {
        const int it = tid + 512 * i, tlo = it & 7, gsub = (it >> 3) & 7, blk = it >> 6, tb = blk & 7, gb = blk >> 3;
        const int t = tb * 8 + tlo, gidx = gb * 8 + gsub;
        const int ch8 = gidx < 64 ? g * 512 + gidx * 8 : 1024 + g * 128 + (gidx - 64) * 8;
        float v[8];
        ssd_conv8(U + (size_t)t * INP, c * 64 + t, cw, cb, ch8, v);
        if (gidx < 64) { const float sc = wsh[(gidx >> 3) * 64 + t];
#pragma unroll
            for (int k = 0; k < 8; ++k) XWt[(gidx * 8 + k) * 72 + t] = f2bf(v[k] * sc); }
        else {
#pragma unroll
            for (int k = 0; k < 8; ++k) BmT[((gidx - 64) * 8 + k) * 72 + t] = f2bf(v[k]); }
    }
    __syncthreads();
    f32x4 acc[4][8];
#pragma unroll
    for (int m = 0; m < 4; ++m)
#pragma unroll
        for (int n = 0; n < 8; ++n) acc[m][n] = (f32x4){0.f, 0.f, 0.f, 0.f};
#pragma unroll
    for (int k0 = 0; k0 < 64; k0 += 32) {
        bf16x8 a[4];
#pragma unroll
        for (int m = 0; m < 4; ++m) a[m] = *(const bf16x8*)(XWt + (64 * w + 16 * m + fr) * 72 + k0 + fq * 8);
#pragma unroll
        for (int n = 0; n < 8; ++n) { const bf16x8 bb = *(const bf16x8*)(BmT + (16 * n + fr) * 72 + k0 + fq * 8);
#pragma unroll
            for (int m = 0; m < 4; ++m) acc[m][n] = mfma16(a[m], bb, acc[m][n]); }
    }
    float* Sp = (float*)(p.ws + WS_SBUF) + (size_t)((b * 16 + g * 8 + w) * 32 + c) * 8192;
#pragma unroll
    for (int m = 0; m < 4; ++m)
#pragma unroll
        for (int n = 0; n < 8; ++n)
#pragma unroll
            for (int j = 0; j < 4; ++j) Sp[(16 * m + fq * 4 + j) * 128 + 16 * n + fr] = acc[m][n][j];
    __syncthreads();
}

DEV void ssd_out(const P& p, int l, int unit, unsigned char* lds) {
    const int b = unit >> 6, g = (unit >> 5) & 1, c = unit & 31;
    int tid_ = threadIdx.x; asm volatile("" : "+v"(tid_)); const int tid = tid_, lane = tid & 63, w = tid >> 6, fr = lane & 15, fq = lane >> 4;
    const int r0 = b * 2048 + c * 64;
    const bf16_t* U = (const bf16_t*)(p.ws + WS_U) + (size_t)r0 * INP;
    bf16_t* XsT = (bf16_t*)lds;
    bf16_t* Bm = XsT + 512 * 72;
    bf16_t* Cm = Bm + 64 * 136;
    float* CB = (float*)(lds + 108544);
    float* bsh = (float*)(lds + 125952);
    float* dtsh = bsh + 512;
    float* red = dtsh + 512;
    float* stat = red + 512;
    const int head = g * 8 + w;
    {
        const float dt = softplusf_(bf2f(U[(size_t)lane * INP + UDT + head]) + p.dt_bias[l * 16 + head]);
        const float a = -expf(p.A_log[l * 16 + head]) * dt;
        const float bs = wave_incl_sum(a, lane);
        bsh[w * 64 + lane] = bs; dtsh[w * 64 + lane] = dt;
    }
    const float* cw = p.s_conv_w + (size_t)l * 4 * 1536; const float* cb = p.s_conv_b + (size_t)l * 1536;
    for (int i = 0; i < 12; ++i) {
        const int it = tid + 512 * i, tlo = it & 7, gsub = (it >> 3) & 7, blk = it >> 6, tb = blk & 7, gb = blk >> 3;
        const int t = tb * 8 + tlo, gidx = gb * 8 + gsub;
        const int ch8 = gidx < 64 ? g * 512 + gidx * 8 : (gidx < 80 ? 1024 + g * 128 + (gidx - 64) * 8 : 1280 + g * 128 + (gidx - 80) * 8);
        float v[8];
        ssd_conv8(U + (size_t)t * INP, c * 64 + t, cw, cb, ch8, v);
        if (gidx < 64) {
#pragma unroll
            for (int k = 0; k < 8; ++k) XsT[(gidx * 8 + k) * 72 + t] = f2bf(v[k]); }
        else {
            u32x4 wv; wv.x = pk2(v[0], v[1]); wv.y = pk2(v[2], v[3]); wv.z = pk2(v[4], v[5]); wv.w = pk2(v[6], v[7]);
            if (gidx < 80) *(u32x4*)(Bm + t * 136 + (gidx - 64) * 8) = wv; else *(u32x4*)(Cm + t * 136 + (gidx - 80) * 8) = wv; }
    }
    __syncthreads();
    {
        const int mt_ = w >> 1, nt0 = (w & 1) * 2;
        f32x4 cacc[2] = {(f32x4){0.f, 0.f, 0.f, 0.f}, (f32x4){0.f, 0.f, 0.f, 0.f}};
#pragma unroll
        for (int k0 = 0; k0 < 128; k0 += 32) {
            const bf16x8 a = *(const bf16x8*)(Cm + (16 * mt_ + fr) * 136 + k0 + fq * 8);
#pragma unroll
            for (int n = 0; n < 2; ++n) { const bf16x8 bb = *(const bf16x8*)(Bm + (16 * (nt0 + n) + fr) * 136 + k0 + fq * 8); cacc[n] = mfma16(a, bb, cacc[n]); }
        }
#pragma unroll
        for (int n = 0; n < 2; ++n)
#pragma unroll
            for (int j = 0; j < 4; ++j) CB[(16 * mt_ + fq * 4 + j) * 68 + 16 * (nt0 + n) + fr] = cacc[n][j];
    }
    __syncthreads();
    f32x4 acc1[4][4], acc2[4][4];
#pragma unroll
    for (int m = 0; m < 4; ++m)
#pragma unroll
        for (int n = 0; n < 4; ++n) { acc1[m][n] = (f32x4){0.f, 0.f, 0.f, 0.f}; acc2[m][n] = (f32x4){0.f, 0.f, 0.f, 0.f}; }
#pragma unroll
    for (int m = 0; m < 4; ++m)
#pragma unroll
        for (int ks = 0; ks < 2; ++ks) {
            if (ks * 32 > 16 * m + 15) continue;
            const int t = 16 * m + fr, s0 = 32 * ks + fq * 8;
            const float bt = bsh[w * 64 + t];
            const f32x4 c0 = *(const f32x4*)(CB + t * 68 + s0), c1 = *(const f32x4*)(CB + t * 68 + s0 + 4);
            float mv[8];
#pragma unroll
            for (int i = 0; i < 8; ++i) { const int s = s0 + i; const float cv = i < 4 ? c0[i & 3] : c1[i & 3];
                mv[i] = (s <= t) ? cv * expf(bt - bsh[w * 64 + s]) * dtsh[w * 64 + s] : 0.f; }
            union { u32x4 u; bf16x8 v; } af;
            af.u.x = pk2(mv[0], mv[1]); af.u.y = pk2(mv[2], mv[3]); af.u.z = pk2(mv[4], mv[5]); af.u.w = pk2(mv[6], mv[7]);
#pragma unroll
            for (int n = 0; n < 4; ++n) { const bf16x8 bb = *(const bf16x8*)(XsT + (64 * w + 16 * n + fr) * 72 + 32 * ks + fq * 8); acc1[m][n] = mfma16(af.v, bb, acc1[m][n]); }
        }
    if (c > 0) {
        const bf16_t* STp = (const bf16_t*)(p.ws + WS_ST) + (size_t)((b * 16 + head) * 32 + c - 1) * 8192;
#pragma unroll
        for (int k0 = 0; k0 < 128; k0 += 32) {
            bf16x8 a[4];
#pragma unroll
            for (int m = 0; m < 4; ++m) a[m] = *(const bf16x8*)(Cm + (16 * m + fr) * 136 + k0 + fq * 8);
#pragma unroll
            for (int n = 0; n < 4; ++n) { const bf16x8 bb = *(const bf16x8*)(STp + (16 * n + fr) * 128 + k0 + fq * 8);
#pragma unroll
                for (int m = 0; m < 4; ++m) acc2[m][n] = mfma16(a[m], bb, acc2[m][n]); }
        }
    }
    const float dsk = p.D_skip[l * 16 + head];
#pragma unroll
    for (int m = 0; m < 4; ++m)
#pragma unroll
        for (int j = 0; j < 4; ++j) {
            const int t = 16 * m + fq * 4 + j;
            const float eb = expf(bsh[w * 64 + t]);
            float s = 0.f;
#pragma unroll
            for (int n = 0; n < 4; ++n) {
                const int pp = 16 * n + fr;
                const float y = acc1[m][n][j] + eb * acc2[m][n][j] + dsk * bf2f(XsT[(64 * w + pp) * 72 + t]);
                const float z = bf2f(U[(size_t)t * INP + UZ + g * 512 + w * 64 + pp]);
                const float gt = y * siluf_(z);
                acc1[m][n][j] = gt; s += gt * gt;
            }
            s += __shfl_xor(s, 1); s += __shfl_xor(s, 2); s += __shfl_xor(s, 4); s += __shfl_xor(s, 8);
            if (fr == 0) red[t * 8 + w] = s;
        }
    __syncthreads();
    if (tid < 64) { float s = 0.f;
#pragma unroll
        for (int i = 0; i < 8; ++i) s += red[tid * 8 + i];
        stat[tid] = rsqrtf(s * (1.0f / 512.0f) + 1e-6f); }
    __syncthreads();
    bf16_t* MX = (bf16_t*)(p.ws + WS_MIXIN);
#pragma unroll
    for (int m = 0; m < 4; ++m)
#pragma unroll
        for (int j = 0; j < 4; ++j) {
            const int t = 16 * m + fq * 4 + j;
            const float rs = stat[t];
#pragma unroll
            for (int n = 0; n < 4; ++n) {
                const int ch = g * 512 + w * 64 + 16 * n + fr;
                MX[(size_t)(r0 + t) * D + 1024 + ch] = f2bf(acc1[m][n][j] * rs * p.s_norm_w[l * 1024 + ch]);
            }
        }
    __syncthreads();
}

DEV void smp_mlstm(const P& p, int l, int unit, unsigned char* lds) {
    const int b = unit >> 2, h = unit & 3;
    int tid_ = threadIdx.x; asm volatile("" : "+v"(tid_)); const int tid = tid_, lane = tid & 63, w = tid >> 6;
    const int r0 = NPR + b * 8;
    const bf16_t* U = (const bf16_t*)(p.ws + WS_U) + (size_t)r0 * INP;
    float* qn = (float*)lds; float* kn = qn + 2048; float* vn = kn + 2048; float* qT = vn + 2048; float* kwT = qT + 2048; float* sc = kwT + 2048; float* red = sc + 256;
    const size_t sidx = (size_t)(l * 128 + b) * 4 + h;
    const float* C0 = p.st_C + sidx * 65536; const float* n0 = p.st_n + sidx * 256;
    float* Cout = p.out + O_SC + sidx * 65536;
    if (tid == 0) {
        const float m0 = p.st_m[sidx];
        float bs = 0.f, cm = -INFINITY, mt = 0.f;
        for (int t = 0; t < 8; ++t) {
            const float ig = bf2f(U[(size_t)t * INP + UIG + h]) + p.b_i[l * 4 + h];
            const float lf = logsigf_(bf2f(U[(size_t)t * INP + UFG + h]) + p.b_f[l * 4 + h]);
            bs += lf; const float a = ig - bs; cm = fmaxf(cm, a); mt = bs + fmaxf(m0, cm);
            sc[32 + t] = mt; sc[t] = expf(bs + m0 - mt); sc[40 + t] = a; sc[48 + t] = bs;
        }
        for (int s = 0; s < 8; ++s) sc[16 + s] = expf(bs + sc[40 + s] - mt);
        sc[24] = expf(bs + m0 - mt);
        p.out[O_SM + sidx] = mt;
    }
    __syncthreads();
#pragma unroll
    for (int i = 0; i < 4; ++i) {
        const int idx = tid + 512 * i, t = idx >> 8, d = idx & 255;
        const float q = bf2f(U[(size_t)t * INP + UQ + h * 256 + d]), k = bf2f(U[(size_t)t * INP + UK + h * 256 + d]), v = bf2f(U[(size_t)t * INP + UV + h * 256 + d]);
        qn[t * 256 + d] = q; kn[t * 256 + d] = k; vn[t * 256 + d] = v; qT[d * 8 + t] = q; kwT[d * 8 + t] = k * sc[16 + t];
    }
    __syncthreads();
    {
        const int t = w;
        const f32x4 qv = *(const f32x4*)(qn + t * 256 + lane * 4);
        float dot[9];
#pragma unroll
        for (int s = 0; s < 8; ++s) { const f32x4 kv = *(const f32x4*)(kn + s * 256 + lane * 4); dot[s] = qv[0] * kv[0] + qv[1] * kv[1] + qv[2] * kv[2] + qv[3] * kv[3]; }
        { const f32x4 nv = *(const f32x4*)(n0 + lane * 4); dot[8] = qv[0] * nv[0] + qv[1] * nv[1] + qv[2] * nv[2] + qv[3] * nv[3]; }
#pragma unroll
        for (int s = 0; s < 9; ++s) dot[s] = wave_sum(dot[s]);
        float den = 0.f;
#pragma unroll
        for (int s = 0; s < 8; ++s) { const float sv = (s <= t) ? dot[s] * expf(sc[48 + t] - sc[32 + t] + sc[40 + s]) : 0.f; den += sv; if (lane == 0) sc[64 + t * 8 + s] = sv; }
        den += sc[t] * dot[8];
        if (lane == 0) sc[8 + t] = 1.0f / fmaxf(fabsf(den), expf(-sc[32 + t]));
    }
    if (tid < 256) {
        float a = sc[24] * n0[tid];
#pragma unroll
        for (int s = 0; s < 8; ++s) a += kwT[tid * 8 + s];
        p.out[O_SN + sidx * 256 + tid] = a;
    }
    const int e4 = lane * 4;
    f32x4 num[8], vv[8];
#pragma unroll
    for (int t = 0; t < 8; ++t) { num[t] = (f32x4){0.f, 0.f, 0.f, 0.f}; vv[t] = *(const f32x4*)(vn + t * 256 + e4); }
    const float decay = sc[24];
#pragma unroll 4
    for (int i = 0; i < 32; ++i) {
        const int d = w + 8 * i;
        const f32x4 cc = *(const f32x4*)(C0 + (size_t)d * 256 + e4);
        const f32x4 q0 = *(const f32x4*)(qT + d * 8), q1 = *(const f32x4*)(qT + d * 8 + 4), k0 = *(const f32x4*)(kwT + d * 8), k1 = *(const f32x4*)(kwT + d * 8 + 4);
        f32x4 cn = cc * decay;
#pragma unroll
        for (int t = 0; t < 4; ++t) { num[t] += cc * q0[t]; num[4 + t] += cc * q1[t]; cn += vv[t] * k0[t]; cn += vv[4 + t] * k1[t]; }
        *(f32x4*)(Cout + (size_t)d * 256 + e4) = cn;
    }
#pragma unroll
    for (int t = 0; t < 8; ++t) *(f32x4*)(red + (w * 8 + t) * 256 + e4) = num[t];
    __syncthreads();
    {
        const int t = w;
        f32x4 hv = (f32x4){0.f, 0.f, 0.f, 0.f};
#pragma unroll
        for (int ww = 0; ww < 8; ++ww) hv += *(const f32x4*)(red + (ww * 8 + t) * 256 + e4);
        hv = hv * sc[t];
#pragma unroll
        for (int s = 0; s < 8; ++s) hv += vv[s] * sc[64 + t * 8 + s];
        hv = hv * sc[8 + t];
        const float mu = wave_sum(hv[0] + hv[1] + hv[2] + hv[3]) * (1.0f / 256.0f);
        const f32x4 dv = hv - mu;
        const float var = wave_sum(dv[0] * dv[0] + dv[1] * dv[1] + dv[2] * dv[2] + dv[3] * dv[3]) * (1.0f / 256.0f);
        const float rs = rsqrtf(var + 1e-6f);
        const uint2 ov = *(const uint2*)(U + (size_t)t * INP + UO + h * 256 + e4);
        const f32x4 nw = *(const f32x4*)(p.m_norm_w + l * 1024 + h * 256 + e4);
        const float o0 = dv[0] * rs * nw[0] * sigmoidf_(bflo(ov.x)), o1 = dv[1] * rs * nw[1] * sigmoidf_(bfhi(ov.x));
        const float o2 = dv[2] * rs * nw[2] * sigmoidf_(bflo(ov.y)), o3 = dv[3] * rs * nw[3] * sigmoidf_(bfhi(ov.y));
        u32x2 wv; wv.x = pk2(o0, o1); wv.y = pk2(o2, o3);
        *(u32x2*)((bf16_t*)(p.ws + WS_MIXIN) + (size_t)(r0 + t) * D + h * 256 + e4) = wv;
    }
    __syncthreads();
}

DEV void smp_ssd(const P& p, int l, int unit, unsigned char* lds) {
    const int b = unit >> 1, g = unit & 1;
    int tid_ = threadIdx.x; asm volatile("" : "+v"(tid_)); const int tid = tid_, lane = tid & 63, w = tid >> 6, fr = lane & 15, fq = lane >> 4;
    const int r0 = NPR + b * 8;
    const bf16_t* U = (const bf16_t*)(p.ws + WS_U) + (size_t)r0 * INP;
    float* xs = (float*)lds;
    float* xwT = xs + 4096;
    float* Bmf = xwT + 4096;
    float* CBs = Bmf + 1024;
    float* bsh = CBs + 64;
    float* dtsh = bsh + 64;
    float* bLs = dtsh + 64;
    float* MW = bLs + 64;
    float* red = MW + 512;
    float* stat = red + 64;
    bf16_t* Cmb = (bf16_t*)(stat + 64);
    if (tid < 64) {
        const int hd = tid >> 3, t = tid & 7, head = g * 8 + hd;
        const float A = -expf(p.A_log[l * 16 + head]), dtb = p.dt_bias[l * 16 + head];
        float bs = 0.f, bL = 0.f, dtt = 0.f;
        for (int s = 0; s < 8; ++s) { const float dt = softplusf_(bf2f(U[(size_t)s * INP + UDT + head]) + dtb); bL += dt * A; if (s <= t) bs += dt * A; if (s == t) dtt = dt; }
        bsh[hd * 8 + t] = bs; dtsh[hd * 8 + t] = dtt; if (t == 0) bLs[hd] = bL;
    }
    for (int i = tid; i < 8 * 136 / 2; i += NTHR) ((unsigned*)(Cmb + 8 * 136))[i] = 0u;
    const float* cw = p.s_conv_w + (size_t)l * 4 * 1536; const float* cb = p.s_conv_b + (size_t)l * 1536;
    const float* cv0 = p.st_sconv + (size_t)(l * 128 + b) * 3 * 1536;
    for (int i = 0; i < 2; ++i) {
        const int it = tid + 512 * i;
        if (it < 768) {
            const int t = it / 96, gidx = it % 96;
            const int ch8 = gidx < 64 ? g * 512 + gidx * 8 : (gidx < 80 ? 1024 + g * 128 + (gidx - 64) * 8 : 1280 + g * 128 + (gidx - 80) * 8);
            float o[8];
            { const f32x4 b0 = *(const f32x4*)(cb + ch8), b1 = *(const f32x4*)(cb + ch8 + 4); o[0] = b0[0]; o[1] = b0[1]; o[2] = b0[2]; o[3] = b0[3]; o[4] = b1[0]; o[5] = b1[1]; o[6] = b1[2]; o[7] = b1[3]; }
#pragma unroll
            for (int j = 0; j < 4; ++j) {
                const int idx = t + j;
                float xf[8];
                if (idx < 3) { const f32x4 a0 = *(const f32x4*)(cv0 + idx * 1536 + ch8), a1 = *(const f32x4*)(cv0 + idx * 1536 + ch8 + 4);
                    xf[0] = a0[0]; xf[1] = a0[1]; xf[2] = a0[2]; xf[3] = a0[3]; xf[4] = a1[0]; xf[5] = a1[1]; xf[6] = a1[2]; xf[7] = a1[3]; }
                else { const uint4 x = *(const uint4*)(U + (size_t)(idx - 3) * INP + UXS + ch8); unpack8(x, xf); }
                const f32x4 w0 = *(const f32x4*)(cw + j * 1536 + ch8), w1 = *(const f32x4*)(cw + j * 1536 + ch8 + 4);
                o[0] += w0[0] * xf[0]; o[1] += w0[1] * xf[1]; o[2] += w0[2] * xf[2]; o[3] += w0[3] * xf[3];
                o[4] += w1[0] * xf[4]; o[5] += w1[1] * xf[5]; o[6] += w1[2] * xf[6]; o[7] += w1[3] * xf[7];
            }
#pragma unroll
            for (int k = 0; k < 8; ++k) o[k] = siluf_(o[k]);
            if (gidx < 64) {
#pragma unroll
                for (int k = 0; k < 8; ++k) xs[t * 512 + gidx * 8 + k] = o[k]; }
            else if (gidx < 80) {
#pragma unroll
                for (int k = 0; k < 8; ++k) Bmf[t * 128 + (gidx - 64) * 8 + k] = o[k]; }
            else { u32x4 wv; wv.x = pk2(o[0], o[1]); wv.y = pk2(o[2], o[3]); wv.z = pk2(o[4], o[5]); wv.w = pk2(o[6], o[7]); *(u32x4*)(Cmb + t * 136 + (gidx - 80) * 8) = wv; }
        }
    }
    __syncthreads();
#pragma unroll
    for (int i = 0; i < 8; ++i) {
        const int idx = tid + 512 * i, hp = idx >> 3, s = idx & 7, hd = hp >> 6;
        xwT[hp * 8 + s] = xs[s * 512 + hp] * expf(bLs[hd] - bsh[hd * 8 + s]) * dtsh[hd * 8 + s];
    }
    if (tid < 64) {
        const int t = tid >> 3, s = tid & 7; float a = 0.f;
        for (int n = 0; n < 128; ++n) a += bf2f(Cmb[t * 136 + n]) * Bmf[s * 128 + n];
        CBs[t * 8 + s] = a;
    }
    __syncthreads();
    { const int hd = tid >> 6, t = (tid >> 3) & 7, s = tid & 7;
      MW[tid] = (s <= t) ? CBs[t * 8 + s] * expf(bsh[hd * 8 + t] - bsh[hd * 8 + s]) * dtsh[hd * 8 + s] : 0.f; }
    __syncthreads();
    const int head = g * 8 + w;
    const size_t sidx = (size_t)(l * 128 + b) * 16 + head;
    const float* S0 = p.st_ssm + sidx * 8192; float* So = p.out + O_SS + sidx * 8192;
    const float dA = expf(bLs[w]);
    f32x4 acc[4];
#pragma unroll
    for (int nt = 0; nt < 4; ++nt) {
        acc[nt] = (f32x4){0.f, 0.f, 0.f, 0.f};
        const int pp = 16 * nt + fr;
        const f32x4 xw0 = *(const f32x4*)(xwT + (64 * w + pp) * 8), xw1 = *(const f32x4*)(xwT + (64 * w + pp) * 8 + 4);
#pragma unroll 1
        for (int ks = 0; ks < 4; ++ks) {
            const int n0 = 32 * ks + fq * 8;
            const f32x4 s0 = *(const f32x4*)(S0 + pp * 128 + n0), s1 = *(const f32x4*)(S0 + pp * 128 + n0 + 4);
            union { u32x4 u; bf16x8 v; } bfr;
            bfr.u.x = pk2(s0[0], s0[1]); bfr.u.y = pk2(s0[2], s0[3]); bfr.u.z = pk2(s1[0], s1[1]); bfr.u.w = pk2(s1[2], s1[3]);
            const bf16x8 af = *(const bf16x8*)(Cmb + fr * 136 + n0);
            acc[nt] = mfma16(af, bfr.v, acc[nt]);
            f32x4 o0 = s0 * dA, o1 = s1 * dA;
#pragma unroll
            for (int s = 0; s < 8; ++s) {
                const float xv = s < 4 ? xw0[s & 3] : xw1[s & 3];
                const f32x4 bm0 = *(const f32x4*)(Bmf + s * 128 + n0), bm1 = *(const f32x4*)(Bmf + s * 128 + n0 + 4);
                o0 += bm0 * xv; o1 += bm1 * xv;
            }
            *(f32x4*)(So + pp * 128 + n0) = o0; *(f32x4*)(So + pp * 128 + n0 + 4) = o1;
        }
    }
    const float dsk = p.D_skip[l * 16 + head];
    float gts[4][4];
#pragma unroll
    for (int j = 0; j < 4; ++j) {
        const int t = (fq & 1) * 4 + j;
        const float eb = expf(bsh[w * 8 + t]);
        float ssq = 0.f;
#pragma unroll
        for (int nt = 0; nt < 4; ++nt) {
            const int hp = 64 * w + 16 * nt + fr;
            float y = eb * acc[nt][j] + dsk * xs[t * 512 + hp];
#pragma unroll
            for (int s = 0; s < 8; ++s) y += MW[(w * 8 + t) * 8 + s] * xs[s * 512 + hp];
            const float z = bf2f(U[(size_t)t * INP + UZ + g * 512 + hp]);
            const float gt = y * siluf_(z);
            gts[nt][j] = gt; ssq += gt * gt;
        }
        ssq += __shfl_xor(ssq, 1); ssq += __shfl_xor(ssq, 2); ssq += __shfl_xor(ssq, 4); ssq += __shfl_xor(ssq, 8);
        if (fr == 0 && fq < 2) red[t * 8 + w] = ssq;
    }
    __syncthreads();
    if (tid < 8) { float s = 0.f;
#pragma unroll
        for (int i = 0; i < 8; ++i) s += red[tid * 8 + i];
        stat[tid] = rsqrtf(s * (1.0f / 512.0f) + 1e-6f); }
    __syncthreads();
    if (fq < 2) {
        bf16_t* MX = (bf16_t*)(p.ws + WS_MIXIN);
#pragma unroll
        for (int j = 0; j < 4; ++j) {
            const int t = fq * 4 + j;
#pragma unroll
            for (int nt = 0; nt < 4; ++nt) {
                const int ch = g * 512 + 64 * w + 16 * nt + fr;
                MX[(size_t)(r0 + t) * D + 1024 + ch] = f2bf(gts[nt][j] * stat[t] * p.s_norm_w[l * 1024 + ch]);
            }
        }
    }
    __syncthreads();
}

DEV void phase_ln(const P& p, int l, int which) {
    const int lane = threadIdx.x & 63, w = threadIdx.x >> 6;
    const float* gam = (which ? p.ln2_g : p.ln1_g) + l * D; const float* bet = (which ? p.ln2_b : p.ln1_b) + l * D;
    const float* mix = (const float*)(p.ws + WS_MIXF);
    float* xf = (float*)(p.ws + WS_XF); bf16_t* xb = (bf16_t*)(p.ws + WS_XB);
    const bool first = (l == 0 && which == 0), lastp = (l == 1 && which == 1);
    for (int r = blockIdx.x * 8 + w; r < NTOK; r += gridDim.x * 8) {
        const float* src = first ? (r < NPR ? p.x_prompt + (size_t)r * D : p.x_sample + (size_t)(r - NPR) * D) : xf + (size_t)r * D;
        float* dst = lastp ? p.out + (size_t)r * D : xf + (size_t)r * D;
        f32x4 y[8]; float s = 0.f;
#pragma unroll
        for (int i = 0; i < 8; ++i) { const int cidx = i * 256 + lane * 4; y[i] = *(const f32x4*)(src + cidx) * ALPHA + *(const f32x4*)(mix + (size_t)r * D + cidx); s += (y[i][0] + y[i][1]) + (y[i][2] + y[i][3]); }
        const float mu = wave_sum(s) * (1.0f / D);
        float q = 0.f;
#pragma unroll
        for (int i = 0; i < 8; ++i) { y[i] = y[i] - mu; q += (y[i][0] * y[i][0] + y[i][1] * y[i][1]) + (y[i][2] * y[i][2] + y[i][3] * y[i][3]); }
        const float rs = rsqrtf(wave_sum(q) * (1.0f / D) + 1e-5f);
#pragma unroll
        for (int i = 0; i < 8; ++i) { const int cidx = i * 256 + lane * 4;
            const f32x4 o = y[i] * rs * *(const f32x4*)(gam + cidx) + *(const f32x4*)(bet + cidx);
            *(f32x4*)(dst + cidx) = o;
            u32x2 wv; wv.x = pk2(o[0], o[1]); wv.y = pk2(o[2], o[3]);
            *(u32x2*)(xb + (size_t)r * D + cidx) = wv; }
    }
}

DEV void phase_ffn_gate(const P& p, int l) {
    const bf16_t* up = (const bf16_t*)(p.ws + WS_UP); bf16_t* act = (bf16_t*)(p.ws + WS_ACT);
    const float* fw = p.f_conv_w + (size_t)l * 3 * DFF2; const float* fb = p.f_conv_b + (size_t)l * DFF2;
    const int total = NTOK * (DFF / 8);
    for (int it = blockIdx.x * NTHR + threadIdx.x; it < total; it += gridDim.x * NTHR) {
        const int r = it / (DFF / 8), j8 = (it % (DFF / 8)) * 8;
        const bool smp = r >= NPR; const int t = smp ? ((r - NPR) & 7) : (r & 2047); const int sb = (r - NPR) >> 3;
        float ag[8], av[8];
        { const f32x4 a0 = *(const f32x4*)(fb + j8), a1 = *(const f32x4*)(fb + j8 + 4), c0 = *(const f32x4*)(fb + DFF + j8), c1 = *(const f32x4*)(fb + DFF + j8 + 4);
#pragma unroll
          for (int i = 0; i < 4; ++i) { ag[i] = a0[i]; ag[4 + i] = a1[i]; av[i] = c0[i]; av[4 + i] = c1[i]; } }
#pragma unroll
        for (int k = 0; k < 3; ++k) {
            const int back = 2 - k;
            float xg[8], xv[8];
            if (t - back >= 0) { unpack8(*(const uint4*)(up + (size_t)(r - back) * DFF2 + j8), xg); unpack8(*(const uint4*)(up + (size_t)(r - back) * DFF2 + DFF + j8), xv); }
            else if (smp) { const float* bp = p.st_fconv + ((size_t)(l * 128 + sb) * 2 + (t + k)) * DFF2;
                const f32x4 a0 = *(const f32x4*)(bp + j8), a1 = *(const f32x4*)(bp + j8 + 4), c0 = *(const f32x4*)(bp + DFF + j8), c1 = *(const f32x4*)(bp + DFF + j8 + 4);
#pragma unroll
                for (int i = 0; i < 4; ++i) { xg[i] = a0[i]; xg[4 + i] = a1[i]; xv[i] = c0[i]; xv[4 + i] = c1[i]; } }
            else continue;
            const f32x4 g0 = *(const f32x4*)(fw + k * DFF2 + j8), g1 = *(const f32x4*)(fw + k * DFF2 + j8 + 4), v0 = *(const f32x4*)(fw + k * DFF2 + DFF + j8), v1 = *(const f32x4*)(fw + k * DFF2 + DFF + j8 + 4);
#pragma unroll
            for (int i = 0; i < 4; ++i) { ag[i] += g0[i] * xg[i]; ag[4 + i] += g1[i] * xg[4 + i]; av[i] += v0[i] * xv[i]; av[4 + i] += v1[i] * xv[4 + i]; }
        }
        u32x4 wv;
        wv.x = pk2(siluf_(ag[0]) * av[0], siluf_(ag[1]) * av[1]); wv.y = pk2(siluf_(ag[2]) * av[2], siluf_(ag[3]) * av[3]);
        wv.z = pk2(siluf_(ag[4]) * av[4], siluf_(ag[5]) * av[5]); wv.w = pk2(siluf_(ag[6]) * av[6], siluf_(ag[7]) * av[7]);
        *(u32x4*)(act + (size_t)r * DFF + j8) = wv;
    }
    const int tot2 = 132 * 2 * (DFF2 / 8);
    for (int it = blockIdx.x * NTHR + threadIdx.x; it < tot2; it += gridDim.x * NTHR) {
        const int c8 = (it % (DFF2 / 8)) * 8, rr = it / (DFF2 / 8), j = rr & 1, sq = rr >> 1;
        float* o; size_t row;
        if (sq < 4) { o = p.out + O_PFC + ((size_t)(l * 4 + sq) * 2 + j) * DFF2 + c8; row = (size_t)sq * 2048 + 2046 + j; }
        else { const int b = sq - 4; o = p.out + O_SFC + ((size_t)(l * 128 + b) * 2 + j) * DFF2 + c8; row = (size_t)NPR + b * 8 + 6 + j; }
        float xf[8]; unpack8(*(const uint4*)(up + row * DFF2 + c8), xf);
        *(f32x4*)o = (f32x4){xf[0], xf[1], xf[2], xf[3]}; *(f32x4*)(o + 4) = (f32x4){xf[4], xf[5], xf[6], xf[7]};
    }
}

constexpr int NPHASE = 21;
DEV void run_phase(const P& p, int l, int q, unsigned char* lds) {
    if (q == 0) {
        pg8::Gemm g{(const bf16_t*)(p.ws + WS_XB), (const bf16_t*)(p.ws + WS_WIN) + (size_t)l * INP * D, NTOK, INP, D};
        pg8::StaticOrder S; S.init(NTOK, INP, gridDim.x, blockIdx.x);
        pg8::EpiBf16 E{(bf16_t*)(p.ws + WS_U), INP};
        pg8::gemm_phase<pg8::EpiBf16>((LAS unsigned char*)lds, g, S, E);
    } else if (q == 1) {
        for (int u = blockIdx.x; u < 512; u += gridDim.x) smp_mlstm(p, l, u, lds);
        for (int u = blockIdx.x; u < 256; u += gridDim.x) smp_ssd(p, l, u, lds);
        for (int u = blockIdx.x; u < 512; u += gridDim.x) mlstm_local(p, l, u, lds);
        for (int u = blockIdx.x; u < 256; u += gridDim.x) ssd_local(p, l, u, lds);
    } else if (q == 2) {
        for (int u = blockIdx.x; u < 256; u += gridDim.x) mlstm_scan(p, l, u, lds);
        for (int u = blockIdx.x; u < 128; u += gridDim.x) ssd_scan(p, l, u, lds);
        for (int u = blockIdx.x; u < 132; u += gridDim.x) convstate_copy(p, l, u);
    } else if (q == 3) {
        for (int u = blockIdx.x; u < 512; u += gridDim.x) mlstm_out(p, l, u, lds);
        for (int u = blockIdx.x; u < 256; u += gridDim.x) ssd_out(p, l, u, lds);
    } else if (q == 4) {
        pg8::Gemm g{(const bf16_t*)(p.ws + WS_MIXIN), (const bf16_t*)(p.ws + WS_WOUT) + (size_t)l * D * D, NTOK, D, D};
        pg8::StaticOrder S; S.init(NTOK, D, gridDim.x, blockIdx.x);
        pg8::EpiF32 E{(float*)(p.ws + WS_MIXF), D};
        pg8::gemm_phase<pg8::EpiF32>((LAS unsigned char*)lds, g, S, E);
    } else if (q == 5) {
        phase_ln(p, l, 0);
    } else if (q == 6) {
        pg8::Gemm g{(const bf16_t*)(p.ws + WS_XB), (const bf16_t*)(p.ws + WS_WUP) + (size_t)l * DFF2 * D, NTOK, DFF2, D};
        pg8::StaticOrder S; S.init(NTOK, DFF2, gridDim.x, blockIdx.x);
        pg8::EpiBf16 E{(bf16_t*)(p.ws + WS_UP), DFF2};
        pg8::gemm_phase<pg8::EpiBf16>((LAS unsigned char*)lds, g, S, E);
    } else if (q == 7) {
        phase_ffn_gate(p, l);
    } else if (q == 8) {
        pg8::Gemm g{(const bf16_t*)(p.ws + WS_ACT), (const bf16_t*)(p.ws + WS_WDN) + (size_t)l * D * DFF, NTOK, D, DFF};
        pg8::StaticOrder S; S.init(NTOK, D, gridDim.x, blockIdx.x);
        pg8::EpiF32 E{(float*)(p.ws + WS_MIXF), D};
        pg8::gemm_phase<pg8::EpiF32>((LAS unsigned char*)lds, g, S, E);
    } else {
        phase_ln(p, l, 1);
    }
}
#if MK_MULTI
template <int Q> __global__ void __launch_bounds__(NTHR, 2) k_phase(P p) {
    extern __shared__ __attribute__((aligned(16))) unsigned char lds[];
    if (Q < 0) phase_prologue(p, lds); else run_phase(p, p.ph_lo, Q, lds);
}
#else
__global__ void __launch_bounds__(NTHR, 2) mk_fwd(P p) {
    extern __shared__ __attribute__((aligned(16))) unsigned char lds[];
    cg::grid_group grid = cg::this_grid();
    phase_prologue(p, lds);
#pragma unroll 1
    for (int l = 0; l < 2; ++l) {
        grid.sync(); run_phase(p, l, 0, lds);
        grid.sync(); run_phase(p, l, 1, lds);
        grid.sync(); run_phase(p, l, 2, lds);
        grid.sync(); run_phase(p, l, 3, lds);
        grid.sync(); run_phase(p, l, 4, lds);
        grid.sync(); run_phase(p, l, 5, lds);
        grid.sync(); run_phase(p, l, 6, lds);
        grid.sync(); run_phase(p, l, 7, lds);
        grid.sync(); run_phase(p, l, 8, lds);
        grid.sync(); run_phase(p, l, 9, lds);
    }
}
#endif

extern "C" void kernel_launch(void* const* d_in, const int* in_sizes, int n_in, void* d_out, int out_size, void* d_ws, size_t ws_size, hipStream_t stream) {
    static int grid = 0;
    if (grid == 0) {
        if (n_in != 27 || ws_size < WS_END) { fprintf(stderr, "kernel_launch: unexpected n_in %d or ws_size %zu (need %zu)\n", n_in, ws_size, (size_t)WS_END); grid = -1; return; }
        int dev = 0, cus = 0, per_cu = 0;
        hipGetDevice(&dev);
        hipDeviceGetAttribute(&cus, hipDeviceAttributeMultiprocessorCount, dev);
#if MK_MULTI
        const void* fns[11] = {(const void*)k_phase<-1>, (const void*)k_phase<0>, (const void*)k_phase<1>, (const void*)k_phase<2>, (const void*)k_phase<3>, (const void*)k_phase<4>, (const void*)k_phase<5>,
                               (const void*)k_phase<6>, (const void*)k_phase<7>, (const void*)k_phase<8>, (const void*)k_phase<9>};
        for (int i = 0; i < 11; ++i) if (hipFuncSetAttribute(fns[i], hipFuncAttributeMaxDynamicSharedMemorySize, LDS_BYTES) != hipSuccess) { fprintf(stderr, "kernel_launch: hipFuncSetAttribute failed\n"); grid = -1; return; }
#else
        if (hipFuncSetAttribute((const void*)mk_fwd, hipFuncAttributeMaxDynamicSharedMemorySize, LDS_BYTES) != hipSuccess) { fprintf(stderr, "kernel_launch: hipFuncSetAttribute failed\n"); grid = -1; return; }
        hipOccupancyMaxActiveBlocksPerMultiprocessor(&per_cu, (const void*)mk_fwd, NTHR, LDS_BYTES);
        (void)hipGetLastError();
#endif
        (void)per_cu;
        grid = cus * 1;
    }
    if (grid < 0) return;
    P p{};
    const float** pp = (const float**)&p;
    for (int i = 0; i < 27; ++i) pp[i] = (const float*)d_in[i];
    p.out = (float*)d_out; p.ws = (unsigned char*)d_ws;
#if MK_MULTI
    p.ph_lo = 0; p.ph_hi = 0;
    hipLaunchKernelGGL(k_phase<-1>, dim3(grid), dim3(NTHR), LDS_BYTES, stream, p);
    for (int l = 0; l < 2; ++l) {
        p.ph_lo = l;
        hipLaunchKernelGGL(k_phase<0>, dim3(grid), dim3(NTHR), LDS_BYTES, stream, p);
        hipLaunchKernelGGL(k_phase<1>, dim3(grid), dim3(NTHR), LDS_BYTES, stream, p);
        hipLaunchKernelGGL(k_phase<2>, dim3(grid), dim3(NTHR), LDS_BYTES, stream, p);
        hipLaunchKernelGGL(k_phase<3>, dim3(grid), dim3(NTHR), LDS_BYTES, stream, p);
        hipLaunchKernelGGL(k_phase<4>, dim3(grid), dim3(NTHR), LDS_BYTES, stream, p);
        hipLaunchKernelGGL(k_phase<5>, dim3(grid), dim3(NTHR), LDS_BYTES, stream, p);
        hipLaunchKernelGGL(k_phase<6>, dim3(grid), dim3(NTHR), LDS_BYTES, stream, p);
        hipLaunchKernelGGL(k_phase<7>, dim3(grid), dim3(NTHR), LDS_BYTES, stream, p);
        hipLaunchKernelGGL(k_phase<8>, dim3(grid), dim3(NTHR), LDS_BYTES, stream, p);
        hipLaunchKernelGGL(k_phase<9>, dim3(grid), dim3(NTHR), LDS_BYTES, stream, p);
    }
#else
    p.ph_lo = 0; p.ph_hi = NPHASE;
    void* args[] = {&p};
    hipError_t e = hipLaunchCooperativeKernel((const void*)mk_fwd, dim3(grid), dim3(NTHR), args, LDS_BYTES, stream);
    if (e != hipSuccess) fprintf(stderr, "cooperative launch failed: %s (grid %d)\n", hipGetErrorString(e), grid);
#endif
}
```

```cpp
#include <hip/hip_runtime.h>
#include <hip/hip_cooperative_groups.h>
#include <cstdio>
namespace cg = cooperative_groups;

#ifndef MK_MULTI
#define MK_MULTI 0
#endif
#ifndef PROBE_REP
#define PROBE_REP -99
#endif
#ifndef PROBE_SYNCS
#define PROBE_SYNCS 0
#endif

#define DEV __device__ __forceinline__
#define LAS __attribute__((address_space(3)))
typedef unsigned short bf16_t;
typedef short bf16x8 __attribute__((ext_vector_type(8)));
typedef float f32x4 __attribute__((ext_vector_type(4)));
typedef float f32x2 __attribute__((ext_vector_type(2)));
typedef unsigned u32x4 __attribute__((ext_vector_type(4)));
typedef unsigned u32x2 __attribute__((ext_vector_type(2)));

constexpr int D = 2048, NPR = 8192, NSM = 1024, NTOK = 9216, INP = 6912, IN_DIM = 6680, DFF = 5504, DFF2 = 11008;
constexpr int UQ = 0, UK = 1024, UV = 2048, UO = 3072, UZ = 4096, UXS = 5120, UIG = 6656, UFG = 6660, UDT = 6664;
constexpr int NTHR = 512;
constexpr int LDS_BYTES = 136 * 1024;
constexpr float ALPHA = 1.41421356237309515f;

constexpr size_t O_YP = 0;
constexpr size_t O_YS = O_YP + (size_t)4 * 2048 * 2048;
constexpr size_t O_PC = O_YS + (size_t)128 * 8 * 2048;
constexpr size_t O_PN = O_PC + (size_t)2 * 4 * 4 * 256 * 256;
constexpr size_t O_PM = O_PN + (size_t)2 * 4 * 4 * 256;
constexpr size_t O_PS = O_PM + (size_t)2 * 4 * 4;
constexpr size_t O_PSC = O_PS + (size_t)2 * 4 * 16 * 64 * 128;
constexpr size_t O_PFC = O_PSC + (size_t)2 * 4 * 3 * 1536;
constexpr size_t O_SC = O_PFC + (size_t)2 * 4 * 2 * DFF2;
constexpr size_t O_SN = O_SC + (size_t)2 * 128 * 4 * 256 * 256;
constexpr size_t O_SM = O_SN + (size_t)2 * 128 * 4 * 256;
constexpr size_t O_SS = O_SM + (size_t)2 * 128 * 4;
constexpr size_t O_SSC = O_SS + (size_t)2 * 128 * 16 * 64 * 128;
constexpr size_t O_SFC = O_SSC + (size_t)2 * 128 * 3 * 1536;

constexpr size_t WS_WIN = 0;
constexpr size_t WS_WOUT = WS_WIN + (size_t)2 * INP * D * 2;
constexpr size_t WS_WUP = WS_WOUT + (size_t)2 * D * D * 2;
constexpr size_t WS_WDN = WS_WUP + (size_t)2 * DFF2 * D * 2;
constexpr size_t WS_XB = WS_WDN + (size_t)2 * D * DFF * 2;
constexpr size_t WS_XF = WS_XB + (size_t)NTOK * D * 2;
constexpr size_t WS_U = WS_XF + (size_t)NTOK * D * 4;
constexpr size_t WS_MIXIN = WS_U + (size_t)NTOK * INP * 2;
constexpr size_t WS_MIXF = WS_MIXIN + (size_t)NTOK * D * 2;
constexpr size_t WS_UP = WS_MIXF + (size_t)NTOK * D * 4;
constexpr size_t WS_ACT = WS_UP + (size_t)NTOK * DFF2 * 2;
constexpr size_t WS_SMALL = WS_ACT + (size_t)NTOK * DFF * 2;
constexpr size_t WS_DBUF = WS_UP;
constexpr size_t WS_SBUF = WS_UP + (size_t)512 * 65536 * 4;
constexpr size_t WS_CT = WS_ACT;
constexpr size_t WS_ST = WS_ACT + (size_t)512 * 65536 * 2;
static_assert(WS_SBUF + (size_t)2048 * 8192 * 4 <= WS_ACT, "alias");
static_assert(WS_ST + (size_t)2048 * 8192 * 2 <= WS_SMALL, "alias");
constexpr size_t WS_NLOC = WS_SMALL;
constexpr size_t WS_NST = WS_NLOC + (size_t)512 * 256 * 4;
constexpr size_t WS_GSTAT = WS_NST + (size_t)512 * 256 * 4;
constexpr size_t WS_MST = WS_GSTAT + 4096;
constexpr size_t WS_SBSUM = WS_MST + 4096;
constexpr size_t WS_BAR = WS_SBSUM + 8192;
constexpr size_t WS_END = WS_BAR + 16384;

struct P {
    const float* x_prompt; const float* x_sample; const float* st_C; const float* st_n; const float* st_m; const float* st_ssm; const float* st_sconv; const float* st_fconv;
    const float* w_in; const float* b_i; const float* b_f; const float* m_norm_w; const float* s_conv_w; const float* s_conv_b; const float* dt_bias; const float* A_log; const float* D_skip;
    const float* s_norm_w; const float* w_out; const float* ln1_g; const float* ln1_b; const float* w_up; const float* f_conv_w; const float* f_conv_b; const float* w_down; const float* ln2_g; const float* ln2_b;
    float* out; unsigned char* ws; int ph_lo, ph_hi;
};

DEV float bf2f(bf16_t v) { return __uint_as_float(((unsigned)v) << 16); }
DEV bf16_t f2bf(float f) { unsigned u = __float_as_uint(f); u += 0x7FFFu + ((u >> 16) & 1u); return (bf16_t)(u >> 16); }
DEV unsigned pk2(float lo, float hi) { return (unsigned)f2bf(lo) | ((unsigned)f2bf(hi) << 16); }
DEV float bflo(unsigned w) { return __uint_as_float(w << 16); }
DEV float bfhi(unsigned w) { return __uint_as_float(w & 0xffff0000u); }
DEV float sigmoidf_(float x) { return 1.0f / (1.0f + expf(-x)); }
DEV float siluf_(float x) { return x * sigmoidf_(x); }
DEV float softplusf_(float x) { return fmaxf(x, 0.f) + log1pf(expf(-fabsf(x))); }
DEV float logsigf_(float x) { return fminf(x, 0.f) - log1pf(expf(-fabsf(x))); }
DEV float wave_sum(float v) {
#pragma unroll
    for (int o = 32; o >= 1; o >>= 1) v += __shfl_xor(v, o);
    return v; }
DEV float wave_max(float v) {
#pragma unroll
    for (int o = 32; o >= 1; o >>= 1) v = fmaxf(v, __shfl_xor(v, o));
    return v; }
DEV float wave_incl_sum(float v, int lane) {
#pragma unroll
    for (int o = 1; o < 64; o <<= 1) { float t = __shfl_up(v, o); if (lane >= o) v += t; }
    return v; }
DEV float wave_incl_max(float v, int lane) {
#pragma unroll
    for (int o = 1; o < 64; o <<= 1) { float t = __shfl_up(v, o); if (lane >= o) v = fmaxf(v, t); }
    return v; }
DEV f32x4 mfma16(bf16x8 a, bf16x8 b, f32x4 c) { return __builtin_amdgcn_mfma_f32_16x16x32_bf16(a, b, c, 0, 0, 0); }
DEV void unpack8(uint4 x, float (&f)[8]) { f[0] = bflo(x.x); f[1] = bfhi(x.x); f[2] = bflo(x.y); f[3] = bfhi(x.y); f[4] = bflo(x.z); f[5] = bfhi(x.z); f[6] = bflo(x.w); f[7] = bfhi(x.w); }

namespace pg8 {
constexpr int BM = 256, BK = 64, HALF = 128, HTB = HALF * BK * 2, STAGE_BYTES = 8 * HTB, NXCD = 8, WGM = 8;
DEV int lds_byte(int r, int c) { const int st = (r >> 4) * 2 + (c >> 5), rr = r & 15, cc = c & 31, ob = rr * 64 + cc * 2; return st * 1024 + (ob ^ (((ob >> 9) & 1) << 5)); }
DEV void stage_rc(int b, int& R, int& C) { const int st = b / 1024, sb = b % 1024, swz = sb ^ (((sb >> 9) & 1) << 5); R = (st >> 1) * 16 + swz / 64; C = (st & 1) * 32 + (swz % 64) / 2; }
DEV int perm32(int rho) { const int n = rho >> 4, i = rho & 15; return 8 * (i >> 2) + 4 * n + (i & 3); }
struct Unit { int pm, pn; };
struct Gemm { const bf16_t* A; const bf16_t* Bt; int M, N, K; };
struct StaticOrder {
    int nM, nN, nwg, G, c;
    DEV void init(int M, int N, int G_, int c_) { nM = M / BM; nN = N / BM; nwg = nM * nN; G = G_; c = c_; }
    DEV bool next(int i, Unit& u) const {
        const long L = (long)i * G + c; if (L >= nwg) return false;
        int wgid = (int)L; { const int q = nwg / NXCD, r = nwg % NXCD, xcd = wgid % NXCD, off = wgid / NXCD; wgid = (xcd < r ? xcd * (q + 1) : r * (q + 1) + (xcd - r) * q) + off; }
        const int nig = WGM * nN, gid = wgid / nig, fm = gid * WGM, gsz = (nM - fm) < WGM ? (nM - fm) : WGM;
        u.pm = fm + ((wgid % nig) % gsz); u.pn = (wgid % nig) / gsz; return true;
    }
};
DEV unsigned cvt_pk_bf16(float lo, float hi) { unsigned r; asm volatile("v_cvt_pk_bf16_f32 %0, %1, %2" : "=v"(r) : "v"(lo), "v"(hi)); return r; }
struct EpiF32 {
    static constexpr bool PERM = false;
    float* C; int ldc;
    DEV void operator()(const f32x4 (&acc)[2][2][4][2], const Unit& u, int wr, int wc, int fr, int fq) const {
        const int row0 = u.pm * BM + wr * 64 + fr, col0 = u.pn * BM + wc * 32 + 4 * fq;
#pragma unroll
        for (int ai = 0; ai < 2; ++ai)
#pragma unroll
            for (int m = 0; m < 4; ++m) { float* rowp = C + (size_t)(row0 + ai * HALF + m * 16) * ldc + col0;
#pragma unroll
                for (int bj = 0; bj < 2; ++bj)
#pragma unroll
                    for (int n = 0; n < 2; ++n) *(f32x4*)(rowp + bj * HALF + n * 16) = acc[ai][bj][m][n]; }
    }
};
struct EpiBf16 {
    static constexpr bool PERM = true;
    bf16_t* O; int ldc;
    DEV void operator()(const f32x4 (&acc)[2][2][4][2], const Unit& u, int wr, int wc, int fr, int fq) const {
        const int row0 = u.pm * BM + wr * 64 + fr; const int col0 = u.pn * BM + wc * 32 + 8 * fq;
#pragma unroll
        for (int ai = 0; ai < 2; ++ai)
#pragma unroll
            for (int m = 0; m < 4; ++m) { bf16_t* rowp = O + (size_t)(row0 + ai * HALF + m * 16) * ldc + col0;
#pragma unroll
                for (int bj = 0; bj < 2; ++bj) { const f32x4 v0 = acc[ai][bj][m][0], v1 = acc[ai][bj][m][1];
                    u32x4 w; w.x = cvt_pk_bf16(v0[0], v0[1]); w.y = cvt_pk_bf16(v0[2], v0[3]); w.z = cvt_pk_bf16(v1[0], v1[1]); w.w = cvt_pk_bf16(v1[2], v1[3]);
                    *(u32x4*)(rowp + bj * HALF) = w; } }
    }
};

template <class Epi>
DEV void gemm_phase(LAS unsigned char* lds, const Gemm g, const StaticOrder& S, const Epi& E) {
    int tid_ = threadIdx.x; asm volatile("" : "+v"(tid_)); const int tid = tid_, wid = __builtin_amdgcn_readfirstlane(tid >> 6), lane = tid & 63, wr = wid >> 2, wc = wid & 3, fr = lane & 15, fq = lane >> 4;
    const int K = g.K, nt = K / BK;
    unsigned voffA[2], voffB[2];
#pragma unroll
    for (int i = 0; i < 2; ++i) { int R, C; stage_rc(tid * 16 + i * 8192, R, C); const int Rb = Epi::PERM ? ((R & ~31) + perm32(R & 31)) : R;
        voffA[i] = (unsigned)(R * K + C) * 2u; voffB[i] = (unsigned)(Rb * K + C) * 2u; }
    const size_t kstep = (size_t)(BK * 2);
    const size_t hstep = (size_t)HALF * K * 2;
    const size_t tstep = 2 * hstep;
    const unsigned ldsw = (unsigned)wid * 1024u;
    const int aoff = lds_byte(wr * 64 + fr, fq * 8), boff = lds_byte(wc * 32 + fr, fq * 8);
#define PG8_SA(b, h) (((b) * 2 + (h)) * HTB)
#define PG8_SB(b, h) ((4 + (b) * 2 + (h)) * HTB)
#define PG8_STAGE(bufoff, gbase, voff) do { _Pragma("unroll") for (int _i = 0; _i < 2; ++_i) \
        __builtin_amdgcn_global_load_lds((const unsigned*)((const char*)(gbase) + (voff)[_i]), (LAS unsigned*)(lds + (bufoff) + ldsw + _i * 8192), 16, 0, 0); } while (0)
#define PG8_LDA(dst, b, h) do { _Pragma("unroll") for (int m = 0; m < 4; ++m) _Pragma("unroll") for (int k = 0; k < 2; ++k) dst[m][k] = *(const LAS bf16x8*)(lds + PG8_SA(b, h) + aoff + m * 2048 + k * 1024); } while (0)
#define PG8_LDB(dst, b, h) do { _Pragma("unroll") for (int n = 0; n < 2; ++n) _Pragma("unroll") for (int k = 0; k < 2; ++k) dst[n][k] = *(const LAS bf16x8*)(lds + PG8_SB(b, h) + boff + n * 2048 + k * 1024); } while (0)
#define PG8_MMA(ai, bj, At, Bt) do { __builtin_amdgcn_s_setprio(1); _Pragma("unroll") for (int m = 0; m < 4; ++m) _Pragma("unroll") for (int n = 0; n < 2; ++n) _Pragma("unroll") for (int k = 0; k < 2; ++k) \
        acc[ai][bj][m][n] = __builtin_amdgcn_mfma_f32_16x16x32_bf16(Bt[n][k], At[m][k], acc[ai][bj][m][n], 0, 0, 0); __builtin_amdgcn_s_setprio(0); } while (0)
#define PG8_WAIT_V(n) asm volatile("s_waitcnt vmcnt(" #n ")" ::: "memory")
#define PG8_WAIT_L(n) asm volatile("s_waitcnt lgkmcnt(" #n ")" ::: "memory")
#define PG8_BAR __builtin_amdgcn_s_barrier()
#define PG8_SCHED __builtin_amdgcn_sched_barrier(0)
    Unit cur, nxt; int ui = 0;
    if (!S.next(0, cur)) return;
    f32x4 acc[2][2][4][2];
#pragma unroll
    for (int a = 0; a < 2; ++a)
#pragma unroll
        for (int b = 0; b < 2; ++b)
#pragma unroll
            for (int m = 0; m < 4; ++m)
#pragma unroll
                for (int n = 0; n < 2; ++n) acc[a][b][m][n] = (f32x4){0.f, 0.f, 0.f, 0.f};
    bf16x8 At[4][2], B0[2][2], B1[2][2];
    const char* cA = (const char*)g.A + (size_t)cur.pm * tstep; const char* cB = (const char*)g.Bt + (size_t)cur.pn * tstep;
    PG8_STAGE(PG8_SB(0, 0), cB, voffB); PG8_STAGE(PG8_SA(0, 0), cA, voffA); PG8_STAGE(PG8_SB(0, 1), cB + hstep, voffB); PG8_STAGE(PG8_SA(0, 1), cA + hstep, voffA);
    if (wr == 1) PG8_BAR;
    PG8_WAIT_V(4); PG8_BAR;
    PG8_STAGE(PG8_SB(1, 0), cB + kstep, voffB); PG8_STAGE(PG8_SA(1, 0), cA + kstep, voffA); PG8_STAGE(PG8_SB(1, 1), cB + hstep + kstep, voffB);
    PG8_WAIT_V(6); PG8_BAR;
    for (;;) {
        const bool has_next = S.next(ui + 1, nxt);
        const char* nA = has_next ? (const char*)g.A + (size_t)nxt.pm * tstep : cA; const char* nB = has_next ? (const char*)g.Bt + (size_t)nxt.pn * tstep : cB;
        for (int t = 0; t < nt; t += 2) {
            const bool last = (t == nt - 2);
            const char* a1 = cA + (size_t)(t + 1) * kstep;
            const char* a2 = last ? nA : cA + (size_t)(t + 2) * kstep; const char* b2 = last ? nB : cB + (size_t)(t + 2) * kstep;
            const char* a3 = a2 + kstep; const char* b3 = b2 + kstep;
            PG8_LDB(B0, 0, 0); PG8_SCHED; PG8_LDA(At, 0, 0); PG8_STAGE(PG8_SA(1, 1), a1 + hstep, voffA);
            PG8_WAIT_L(8); PG8_BAR; PG8_WAIT_L(0); PG8_MMA(0, 0, At, B0); PG8_BAR; PG8_SCHED;
            PG8_LDB(B1, 0, 1); PG8_STAGE(PG8_SB(0, 0), b2, voffB);
            PG8_BAR; PG8_WAIT_L(0); PG8_MMA(0, 1, At, B1); PG8_BAR;
            PG8_LDA(At, 0, 1); PG8_STAGE(PG8_SA(0, 0), a2, voffA);
            PG8_BAR; PG8_WAIT_L(0); PG8_MMA(1, 0, At, B0); PG8_BAR; PG8_SCHED;
            PG8_STAGE(PG8_SB(0, 1), b2 + hstep, voffB);
            PG8_WAIT_V(6); PG8_BAR; PG8_MMA(1, 1, At, B1); PG8_BAR;
            PG8_LDB(B0, 1, 0); PG8_SCHED; PG8_LDA(At, 1, 0); PG8_STAGE(PG8_SA(0, 1), a2 + hstep, voffA);
            PG8_WAIT_L(8); PG8_BAR; PG8_WAIT_L(0); PG8_MMA(0, 0, At, B0); PG8_BAR; PG8_SCHED;
            PG8_LDB(B1, 1, 1); PG8_STAGE(PG8_SB(1, 0), b3, voffB);
            PG8_BAR; PG8_WAIT_L(0); PG8_MMA(0, 1, At, B1); PG8_BAR;
            PG8_LDA(At, 1, 1); PG8_STAGE(PG8_SA(1, 0), a3, voffA);
            PG8_BAR; PG8_WAIT_L(0); PG8_MMA(1, 0, At, B0); PG8_BAR; PG8_SCHED;
            PG8_STAGE(PG8_SB(1, 1), b3 + hstep, voffB);
            PG8_WAIT_V(6); PG8_BAR; PG8_MMA(1, 1, At, B1); PG8_BAR;
        }
        E(acc, cur, wr, wc, fr, fq);
        if (!has_next) break;
#pragma unroll
        for (int a = 0; a < 2; ++a)
#pragma unroll
            for (int b = 0; b < 2; ++b)
#pragma unroll
                for (int m = 0; m < 4; ++m)
#pragma unroll
                    for (int n = 0; n < 2; ++n) acc[a][b][m][n] = (f32x4){0.f, 0.f, 0.f, 0.f};
        cur = nxt; cA = nA; cB = nB; ++ui;
    }
    PG8_WAIT_V(0);
    if (wr == 0) PG8_BAR;
    PG8_BAR;
#undef PG8_SA
#undef PG8_SB
#undef PG8_STAGE
#undef PG8_LDA
#undef PG8_LDB
#undef PG8_MMA
#undef PG8_WAIT_V
#undef PG8_WAIT_L
#undef PG8_BAR
#undef PG8_SCHED
}
}

DEV int win_srccol(int n) { return n < 4096 ? n : (n < 6656 ? n + 8 : (n < 6664 ? n - 2560 : (n < 6680 ? n : -1))); }
DEV void transpose_tile(const float* __restrict__ src, int srcN, bf16_t* __restrict__ dst, int K, int n0, int k0, int mode, float* tile) {
    const int tid = threadIdx.x;
#pragma unroll
    for (int i = 0; i < 2; ++i) {
        const int kk = (tid >> 4) + 32 * i, nn4 = (tid & 15) * 4, n = n0 + nn4;
        const int sc = mode ? win_srccol(n) : n;
        f32x4 v = (f32x4){0.f, 0.f, 0.f, 0.f};
        if (sc >= 0) v = *(const f32x4*)(src + (size_t)(k0 + kk) * srcN + sc);
        if (mode && n >= 1024 && n < 2048) v = v * 0.0625f;
        tile[kk * 65 + nn4 + 0] = v[0]; tile[kk * 65 + nn4 + 1] = v[1]; tile[kk * 65 + nn4 + 2] = v[2]; tile[kk * 65 + nn4 + 3] = v[3];
    }
    __syncthreads();
    {
        const int nn = tid >> 3, kk8 = (tid & 7) * 8;
        u32x4 w;
        w.x = pk2(tile[(kk8 + 0) * 65 + nn], tile[(kk8 + 1) * 65 + nn]); w.y = pk2(tile[(kk8 + 2) * 65 + nn], tile[(kk8 + 3) * 65 + nn]);
        w.z = pk2(tile[(kk8 + 4) * 65 + nn], tile[(kk8 + 5) * 65 + nn]); w.w = pk2(tile[(kk8 + 6) * 65 + nn], tile[(kk8 + 7) * 65 + nn]);
        *(u32x4*)(dst + (size_t)(n0 + nn) * K + k0 + kk8) = w;
    }
    __syncthreads();
}
DEV void phase_prologue(const P& p, unsigned char* lds) {
    float* tile = (float*)lds;
    constexpr int T_WIN = (INP / 64) * (D / 64), T_WOUT = (D / 64) * (D / 64), T_WUP = (DFF2 / 64) * (D / 64), T_WDN = (D / 64) * (DFF / 64);
    constexpr int T_L = T_WIN + T_WOUT + T_WUP + T_WDN, T_X = NTOK * D / 4096;
    const int total = 2 * T_L + T_X;
    for (int u = blockIdx.x; u < total; u += gridDim.x) {
        if (u < 2 * T_L) {
            const int l = u / T_L; int r = u % T_L;
            if (r < T_WIN) { const int nt = r / (D / 64), kt = r % (D / 64);
                transpose_tile(p.w_in + (size_t)l * D * IN_DIM, IN_DIM, (bf16_t*)(p.ws + WS_WIN) + (size_t)l * INP * D, D, nt * 64, kt * 64, 1, tile); }
            else if ((r -= T_WIN) < T_WOUT) { const int nt = r / (D / 64), kt = r % (D / 64);
                transpose_tile(p.w_out + (size_t)l * D * D, D, (bf16_t*)(p.ws + WS_WOUT) + (size_t)l * D * D, D, nt * 64, kt * 64, 0, tile); }
            else if ((r -= T_WOUT) < T_WUP) { const int nt = r / (D / 64), kt = r % (D / 64);
                transpose_tile(p.w_up + (size_t)l * D * DFF2, DFF2, (bf16_t*)(p.ws + WS_WUP) + (size_t)l * DFF2 * D, D, nt * 64, kt * 64, 0, tile); }
            else { r -= T_WUP; const int nt = r / (DFF / 64), kt = r % (DFF / 64);
                transpose_tile(p.w_down + (size_t)l * DFF * D, D, (bf16_t*)(p.ws + WS_WDN) + (size_t)l * D * DFF, DFF, nt * 64, kt * 64, 0, tile); }
        } else {
            const size_t e = (size_t)(u - 2 * T_L) * 4096 + threadIdx.x * 8;
            const float* s = e < (size_t)NPR * D ? p.x_prompt + e : p.x_sample + (e - (size_t)NPR * D);
            const f32x4 a = *(const f32x4*)s, b = *(const f32x4*)(s + 4);
            u32x4 w; w.x = pk2(a[0], a[1]); w.y = pk2(a[2], a[3]); w.z = pk2(b[0], b[1]); w.w = pk2(b[2], b[3]);
            *(u32x4*)((bf16_t*)(p.ws + WS_XB) + e) = w;
        }
    }
}

DEV void mlstm_local(const P& p, int l, int unit, unsigned char* lds) {
    const int bh = unit >> 5, c = unit & 31, b = bh >> 2, h = bh & 3;
    int tid_ = threadIdx.x; asm volatile("" : "+v"(tid_)); const int tid = tid_, lane = tid & 63, w = tid >> 6, fr = lane & 15, fq = lane >> 4;
    const bf16_t* U = (const bf16_t*)(p.ws + WS_U) + (size_t)(b * 2048 + c * 64) * INP;
    float* wsh = (float*)lds;
    bf16_t* KWt = (bf16_t*)(lds + 1024);
    bf16_t* Vt = KWt + 256 * 72;
    float* gstat = (float*)(p.ws + WS_GSTAT);
    if (w == 0) {
        const float ig = bf2f(U[(size_t)lane * INP + UIG + h]) + p.b_i[l * 4 + h];
        const float lf = logsigf_(bf2f(U[(size_t)lane * INP + UFG + h]) + p.b_f[l * 4 + h]);
        const float bs = wave_incl_sum(lf, lane);
        const float a = ig - bs;
        const float amax = wave_max(a);
        const float bsum = __shfl(bs, 63);
        wsh[lane] = expf(a - amax);
        if (lane == 0) { gstat[(bh * 32 + c) * 2] = bsum; gstat[(bh * 32 + c) * 2 + 1] = bsum + amax; }
    }
    __syncthreads();
#pragma unroll
    for (int i = 0; i < 4; ++i) {
        const int it = tid + 512 * i, s = it >> 5, d8 = (it & 31) * 8;
        const uint4 kv = *(const uint4*)(U + (size_t)s * INP + UK + h * 256 + d8);
        const uint4 vv = *(const uint4*)(U + (size_t)s * INP + UV + h * 256 + d8);
        const float ws_ = wsh[s];
        float kf[8]; unpack8(kv, kf);
        const unsigned vw[4] = {vv.x, vv.y, vv.z, vv.w};
#pragma unroll
        for (int j = 0; j < 8; ++j) {
            KWt[(d8 + j) * 72 + s] = f2bf(kf[j] * ws_);
            Vt[(d8 + j) * 72 + s] = (bf16_t)((j & 1) ? (vw[j >> 1] >> 16) : (vw[j >> 1] & 0xffffu));
        }
    }
    __syncthreads();
    if (tid < 256) { float a = 0.f; for (int s = 0; s < 64; ++s) a += bf2f(KWt[tid * 72 + s]); ((float*)(p.ws + WS_NLOC))[(size_t)(bh * 32 + c) * 256 + tid] = a; }
    f32x4 acc[2][16];
#pragma unroll
    for (int m = 0; m < 2; ++m)
#pragma unroll
        for (int n = 0; n < 16; ++n) acc[m][n] = (f32x4){0.f, 0.f, 0.f, 0.f};
#pragma unroll
    for (int k0 = 0; k0 < 64; k0 += 32) {
        bf16x8 a[2];
#pragma unroll
        for (int m = 0; m < 2; ++m) a[m] = *(const bf16x8*)(Vt + (32 * w + 16 * m + fr) * 72 + k0 + fq * 8);
#pragma unroll
        for (int n = 0; n < 16; ++n) {
            const bf16x8 bb = *(const bf16x8*)(KWt + (16 * n + fr) * 72 + k0 + fq * 8);
#pragma unroll
            for (int m = 0; m < 2; ++m) acc[m][n] = mfma16(a[m], bb, acc[m][n]);
        }
    }
    float* Dp = (float*)(p.ws + WS_DBUF) + (size_t)(bh * 32 + c) * 65536;
#pragma unroll
    for (int m = 0; m < 2; ++m)
#pragma unroll
        for (int n = 0; n < 16; ++n)
#pragma unroll
            for (int j = 0; j < 4; ++j) Dp[(32 * w + 16 * m + fq * 4 + j) * 256 + 16 * n + fr] = acc[m][n][j];
    __syncthreads();
}

DEV void mlstm_scan(const P& p, int l, int unit, unsigned char* lds) {
    int tid_ = threadIdx.x; asm volatile("" : "+v"(tid_)); const int bh = unit >> 4, slab = unit & 15, tid = tid_;
    float* fA = (float*)lds; float* fB = fA + 32;
    const float* gstat = (const float*)(p.ws + WS_GSTAT);
    if (tid == 0) {
        float m = 0.f;
        for (int c = 0; c < 32; ++c) {
            const float bsum = gstat[(bh * 32 + c) * 2], mloc = gstat[(bh * 32 + c) * 2 + 1];
            const float mn = fmaxf(bsum + m, mloc);
            fA[c] = expf(bsum + m - mn); fB[c] = expf(mloc - mn); m = mn;
            if (slab == 0) ((float*)(p.ws + WS_MST))[bh * 32 + c] = mn;
        }
        if (slab == 0) p.out[O_PM + l * 16 + bh] = m;
    }
    __syncthreads();
    const size_t e0 = (size_t)slab * 4096 + tid * 8;
    float run[8];
#pragma unroll
    for (int i = 0; i < 8; ++i) run[i] = 0.f;
    const float* Dp = (const float*)(p.ws + WS_DBUF) + (size_t)bh * 32 * 65536 + e0;
    bf16_t* Cp = (bf16_t*)(p.ws + WS_CT) + (size_t)bh * 32 * 65536 + e0;
    for (int c = 0; c < 32; ++c) {
        const f32x4 x0 = *(const f32x4*)(Dp + (size_t)c * 65536), x1 = *(const f32x4*)(Dp + (size_t)c * 65536 + 4);
        const float a = fA[c], bq = fB[c];
#pragma unroll
        for (int i = 0; i < 4; ++i) { run[i] = a * run[i] + bq * x0[i]; run[4 + i] = a * run[4 + i] + bq * x1[i]; }
        u32x4 wv; wv.x = pk2(run[0], run[1]); wv.y = pk2(run[2], run[3]); wv.z = pk2(run[4], run[5]); wv.w = pk2(run[6], run[7]);
        *(u32x4*)(Cp + (size_t)c * 65536) = wv;
    }
    {
        float* o = p.out + O_PC + (size_t)(l * 16 + bh) * 65536;
        const int e = (int)(e0 >> 8), d0 = (int)(e0 & 255);
#pragma unroll
        for (int i = 0; i < 8; ++i) o[(d0 + i) * 256 + e] = run[i];
    }
    if (slab == 0 && tid < 256) {
        float r = 0.f;
        const float* nl = (const float*)(p.ws + WS_NLOC) + (size_t)bh * 32 * 256 + tid;
        float* ns = (float*)(p.ws + WS_NST) + (size_t)bh * 32 * 256 + tid;
        for (int c = 0; c < 32; ++c) { r = fA[c] * r + fB[c] * nl[c * 256]; ns[c * 256] = r; }
        p.out[O_PN + (size_t)(l * 16 + bh) * 256 + tid] = r;
    }
    __syncthreads();
}

DEV void ssd_scan(const P& p, int l, int unit, unsigned char* lds) {
    int tid_ = threadIdx.x; asm volatile("" : "+v"(tid_)); const int bhd = unit >> 1, slab = unit & 1, tid = tid_;
    float* dec = (float*)lds;
    if (tid < 32) dec[tid] = expf(((const float*)(p.ws + WS_SBSUM))[bhd * 32 + tid]);
    __syncthreads();
    const size_t e0 = (size_t)slab * 4096 + tid * 8;
    float run[8];
#pragma unroll
    for (int i = 0; i < 8; ++i) run[i] = 0.f;
    const float* Sp = (const float*)(p.ws + WS_SBUF) + (size_t)bhd * 32 * 8192 + e0;
    bf16_t* Tp = (bf16_t*)(p.ws + WS_ST) + (size_t)bhd * 32 * 8192 + e0;
    for (int c = 0; c < 32; ++c) {
        const f32x4 x0 = *(const f32x4*)(Sp + (size_t)c * 8192), x1 = *(const f32x4*)(Sp + (size_t)c * 8192 + 4);
        const float a = dec[c];
#pragma unroll
        for (int i = 0; i < 4; ++i) { run[i] = a * run[i] + x0[i]; run[4 + i] = a * run[4 + i] + x1[i]; }
        u32x4 wv; wv.x = pk2(run[0], run[1]); wv.y = pk2(run[2], run[3]); wv.z = pk2(run[4], run[5]); wv.w = pk2(run[6], run[7]);
        *(u32x4*)(Tp + (size_t)c * 8192) = wv;
    }
    float* o = p.out + O_PS + (size_t)(l * 64 + bhd) * 8192 + e0;
    *(f32x4*)o = (f32x4){run[0], run[1], run[2], run[3]}; *(f32x4*)(o + 4) = (f32x4){run[4], run[5], run[6], run[7]};
    __syncthreads();
}

DEV void convstate_copy(const P& p, int l, int unit) {
    const bf16_t* Ub = (const bf16_t*)(p.ws + WS_U);
    for (int i = threadIdx.x; i < 3 * 1536; i += NTHR) {
        const int j = i / 1536, ch = i % 1536;
        if (unit < 4) p.out[O_PSC + ((size_t)(l * 4 + unit) * 3 + j) * 1536 + ch] = bf2f(Ub[(size_t)(unit * 2048 + 2045 + j) * INP + UXS + ch]);
        else { const int b = unit - 4; p.out[O_SSC + ((size_t)(l * 128 + b) * 3 + j) * 1536 + ch] = bf2f(Ub[(size_t)(NPR + b * 8 + 5 + j) * INP + UXS + ch]); }
    }
}

DEV void mlstm_out(const P& p, int l, int unit, unsigned char* lds) {
    const int bh = unit >> 5, c = unit & 31, b = bh >> 2, h = bh & 3;
    int tid_ = threadIdx.x; asm volatile("" : "+v"(tid_)); const int tid = tid_, lane = tid & 63, w = tid >> 6, fr = lane & 15, fq = lane >> 4;
    const int r0 = b * 2048 + c * 64;
    const bf16_t* U = (const bf16_t*)(p.ws + WS_U) + (size_t)r0 * INP;
    bf16_t* Qs = (bf16_t*)lds;
    bf16_t* Ks = Qs + 64 * 264;
    bf16_t* Vt = Ks + 64 * 264;
    bf16_t* Ss = Vt + 256 * 72;
    float* fl = (float*)(lds + 113664);
    float* bsh = fl; float* ash = fl + 64; float* mth = fl + 128; float* wint = fl + 192; float* rdn = fl + 256; float* qn = fl + 320; float* nprev = fl + 384; float* red = fl + 640;
    float* stat = fl + 1152;
    if (w == 0) {
        const float ig = bf2f(U[(size_t)lane * INP + UIG + h]) + p.b_i[l * 4 + h];
        const float lf = logsigf_(bf2f(U[(size_t)lane * INP + UFG + h]) + p.b_f[l * 4 + h]);
        const float bs = wave_incl_sum(lf, lane);
        const float a = ig - bs;
        const float cm = wave_incl_max(a, lane);
        const float mprev = c > 0 ? ((const float*)(p.ws + WS_MST))[bh * 32 + c - 1] : 0.f;
        const float mt = bs + fmaxf(mprev, cm);
        bsh[lane] = bs; ash[lane] = a; mth[lane] = mt; wint[lane] = expf(bs + mprev - mt);
    }
    if (tid >= 256) { const int d = tid - 256; nprev[d] = c > 0 ? ((const float*)(p.ws + WS_NST))[(size_t)(bh * 32 + c - 1) * 256 + d] : 0.f; }
#pragma unroll
    for (int i = 0; i < 4; ++i) {
        const int it = tid + 512 * i, s = it >> 5, d8 = (it & 31) * 8;
        *(uint4*)(Qs + s * 264 + d8) = *(const uint4*)(U + (size_t)s * INP + UQ + h * 256 + d8);
        *(uint4*)(Ks + s * 264 + d8) = *(const uint4*)(U + (size_t)s * INP + UK + h * 256 + d8);
        const uint4 vv = *(const uint4*)(U + (size_t)s * INP + UV + h * 256 + d8);
        const unsigned vw[4] = {vv.x, vv.y, vv.z, vv.w};
#pragma unroll
        for (int j = 0; j < 8; ++j) Vt[(d8 + j) * 72 + s] = (bf16_t)((j & 1) ? (vw[j >> 1] >> 16) : (vw[j >> 1] & 0xffffu));
    }
    __syncthreads();
    {
        const int mt_ = w >> 1, nt0 = (w & 1) * 2;
        f32x4 sacc[2] = {(f32x4){0.f, 0.f, 0.f, 0.f}, (f32x4){0.f, 0.f, 0.f, 0.f}};
#pragma unroll
        for (int k0 = 0; k0 < 256; k0 += 32) {
            const bf16x8 a = *(const bf16x8*)(Qs + (16 * mt_ + fr) * 264 + k0 + fq * 8);
#pragma unroll
            for (int n = 0; n < 2; ++n) { const bf16x8 bb = *(const bf16x8*)(Ks + (16 * (nt0 + n) + fr) * 264 + k0 + fq * 8); sacc[n] = mfma16(a, bb, sacc[n]); }
        }
#pragma unroll
        for (int n = 0; n < 2; ++n)
#pragma unroll
            for (int j = 0; j < 4; ++j) {
                const int t = 16 * mt_ + fq * 4 + j, s = 16 * (nt0 + n) + fr;
                const float val = (s <= t) ? sacc[n][j] * expf(bsh[t] - mth[t] + ash[s]) : 0.f;
                Ss[t * 72 + s] = f2bf(val);
            }
        const int t = tid >> 3, part = tid & 7;
        float a = 0.f;
        for (int d = part * 32; d < part * 32 + 32; ++d) a += bf2f(Qs[t * 264 + d]) * nprev[d];
        a += __shfl_xor(a, 1); a += __shfl_xor(a, 2); a += __shfl_xor(a, 4);
        if (part == 0) qn[t] = a;
    }
    __syncthreads();
    if (tid < 64) {
        float di = 0.f;
        for (int s = 0; s < 64; ++s) di += bf2f(Ss[tid * 72 + s]);
        const float den = di + wint[tid] * qn[tid];
        rdn[tid] = 1.0f / fmaxf(fabsf(den), expf(-mth[tid]));
    }
    const int e0 = 32 * w;
    f32x4 acc1[4][2], acc2[4][2];
#pragma unroll
    for (int m = 0; m < 4; ++m)
#pragma unroll
        for (int n = 0; n < 2; ++n) { acc1[m][n] = (f32x4){0.f, 0.f, 0.f, 0.f}; acc2[m][n] = (f32x4){0.f, 0.f, 0.f, 0.f}; }
#pragma unroll
    for (int k0 = 0; k0 < 64; k0 += 32) {
        bf16x8 a[4];
#pragma unroll
        for (int m = 0; m < 4; ++m) a[m] = *(const bf16x8*)(Ss + (16 * m + fr) * 72 + k0 + fq * 8);
#pragma unroll
        for (int n = 0; n < 2; ++n) { const bf16x8 bb = *(const bf16x8*)(Vt + (e0 + 16 * n + fr) * 72 + k0 + fq * 8);
#pragma unroll
            for (int m = 0; m < 4; ++m) acc1[m][n] = mfma16(a[m], bb, acc1[m][n]); }
    }
    if (c > 0) {
        const bf16_t* CTp = (const bf16_t*)(p.ws + WS_CT) + (size_t)(bh * 32 + c - 1) * 65536;
#pragma unroll 2
        for (int k0 = 0; k0 < 256; k0 += 32) {
            bf16x8 a[4];
#pragma unroll
            for (int m = 0; m < 4; ++m) a[m] = *(const bf16x8*)(Qs + (16 * m + fr) * 264 + k0 + fq * 8);
#pragma unroll
            for (int n = 0; n < 2; ++n) { const bf16x8 bb = *(const bf16x8*)(CTp + (size_t)(e0 + 16 * n + fr) * 256 + k0 + fq * 8);
#pragma unroll
                for (int m = 0; m < 4; ++m) acc2[m][n] = mfma16(a[m], bb, acc2[m][n]); }
        }
    }
    __syncthreads();
#pragma unroll
    for (int m = 0; m < 4; ++m)
#pragma unroll
        for (int j = 0; j < 4; ++j) {
            const int t = 16 * m + fq * 4 + j;
            const float wi = wint[t], rd = rdn[t];
            float s = 0.f;
#pragma unroll
            for (int n = 0; n < 2; ++n) { const float hv = (acc1[m][n][j] + wi * acc2[m][n][j]) * rd; acc1[m][n][j] = hv; s += hv; }
            s += __shfl_xor(s, 1); s += __shfl_xor(s, 2); s += __shfl_xor(s, 4); s += __shfl_xor(s, 8);
            if (fr == 0) red[t * 8 + w] = s;
        }
    __syncthreads();
    if (tid < 64) { float s = 0.f;
#pragma unroll
        for (int i = 0; i < 8; ++i) s += red[tid * 8 + i];
        stat[tid] = s * (1.0f / 256.0f); }
    __syncthreads();
#pragma unroll
    for (int m = 0; m < 4; ++m)
#pragma unroll
        for (int j = 0; j < 4; ++j) {
            const int t = 16 * m + fq * 4 + j;
            const float mu = stat[t];
            float s = 0.f;
#pragma unroll
            for (int n = 0; n < 2; ++n) { const float dv = acc1[m][n][j] - mu; acc1[m][n][j] = dv; s += dv * dv; }
            s += __shfl_xor(s, 1); s += __shfl_xor(s, 2); s += __shfl_xor(s, 4); s += __shfl_xor(s, 8);
            if (fr == 0) red[t * 8 + w] = s;
        }
    __syncthreads();
    if (tid < 64) { float s = 0.f;
#pragma unroll
        for (int i = 0; i < 8; ++i) s += red[tid * 8 + i];
        stat[64 + tid] = rsqrtf(s * (1.0f / 256.0f) + 1e-6f); }
    __syncthreads();
    bf16_t* MX = (bf16_t*)(p.ws + WS_MIXIN);
#pragma unroll
    for (int m = 0; m < 4; ++m)
#pragma unroll
        for (int j = 0; j < 4; ++j) {
            const int t = 16 * m + fq * 4 + j;
            const float rs = stat[64 + t];
#pragma unroll
            for (int n = 0; n < 2; ++n) {
                const int e = e0 + 16 * n + fr;
                const float o = bf2f(U[(size_t)t * INP + UO + h * 256 + e]);
                MX[(size_t)(r0 + t) * D + h * 256 + e] = f2bf(acc1[m][n][j] * rs * p.m_norm_w[l * 1024 + h * 256 + e] * sigmoidf_(o));
            }
        }
    __syncthreads();
}

DEV void ssd_conv8(const bf16_t* Urow, int tpos, const float* cw, const float* cb, int ch8, float (&o)[8]) {
    const f32x4 b0 = *(const f32x4*)(cb + ch8), b1 = *(const f32x4*)(cb + ch8 + 4);
    o[0] = b0[0]; o[1] = b0[1]; o[2] = b0[2]; o[3] = b0[3]; o[4] = b1[0]; o[5] = b1[1]; o[6] = b1[2]; o[7] = b1[3];
#pragma unroll
    for (int j = 0; j < 4; ++j) {
        const int back = 3 - j;
        if (tpos - back >= 0) {
            const uint4 x = *(const uint4*)(Urow - (size_t)back * INP + UXS + ch8);
            float xf[8]; unpack8(x, xf);
            const f32x4 w0 = *(const f32x4*)(cw + j * 1536 + ch8), w1 = *(const f32x4*)(cw + j * 1536 + ch8 + 4);
            o[0] += w0[0] * xf[0]; o[1] += w0[1] * xf[1]; o[2] += w0[2] * xf[2]; o[3] += w0[3] * xf[3];
            o[4] += w1[0] * xf[4]; o[5] += w1[1] * xf[5]; o[6] += w1[2] * xf[6]; o[7] += w1[3] * xf[7];
        }
    }
#pragma unroll
    for (int i = 0; i < 8; ++i) o[i] = siluf_(o[i]);
}

DEV void ssd_local(const P& p, int l, int unit, unsigned char* lds) {
    const int b = unit >> 6, g = (unit >> 5) & 1, c = unit & 31;
    int tid_ = threadIdx.x; asm volatile("" : "+v"(tid_)); const int tid = tid_, lane = tid & 63, w = tid >> 6, fr = lane & 15, fq = lane >> 4;
    const int r0 = b * 2048 + c * 64;
    const bf16_t* U = (const bf16_t*)(p.ws + WS_U) + (size_t)r0 * INP;
    bf16_t* XWt = (bf16_t*)lds;
    bf16_t* BmT = XWt + 512 * 72;
    float* wsh = (float*)(lds + 92160);
    {
        const int head = g * 8 + w;
        const float dt = softplusf_(bf2f(U[(size_t)lane * INP + UDT + head]) + p.dt_bias[l * 16 + head]);
        const float a = -expf(p.A_log[l * 16 + head]) * dt;
        const float bs = wave_incl_sum(a, lane);
        const float bL = __shfl(bs, 63);
        wsh[w * 64 + lane] = expf(bL - bs) * dt;
        if (lane == 0) ((float*)(p.ws + WS_SBSUM))[(b * 16 + head) * 32 + c] = bL;
    }
    __syncthreads();
    const float* cw = p.s_conv_w + (size_t)l * 4 * 1536; const float* cb = p.s_conv_b + (size_t)l * 1536;
    for (int i = 0; i < 10; ++i) {
        const int it = tid + 512 * i, tlo = it & 7, gsub = (it >> 3) & 7, blk = it >> 6, tb = blk & 7, gb = blk >> 3;
        const int t = tb * 8 + tlo, gidx = gb * 8 + gsub;
        const int ch8 = gidx < 64 ? g * 512 + gidx * 8 : 1024 + g * 128 + (gidx - 64) * 8;
        float v[8];
        ssd_conv8(U + (size_t)t * INP, c * 64 + t, cw, cb, ch8, v);
        if (gidx < 64) { const float sc = wsh[(gidx >> 3) * 64 + t];
#pragma unroll
            for (int k = 0; k < 8; ++k) XWt[(gidx * 8 + k) * 72 + t] = f2bf(v[k] * sc); }
        else {
#pragma unroll
            for (int k = 0; k < 8; ++k) BmT[((gidx - 64) * 8 + k) * 72 + t] = f2bf(v[k]); }
    }
    __syncthreads();
    f32x4 acc[4][8];
#pragma unroll
    for (int m = 0; m < 4; ++m)
#pragma unroll
        for (int n = 0; n < 8; ++n) acc[m][n] = (f32x4){0.f, 0.f, 0.f, 0.f};
#pragma unroll
    for (int k0 = 0; k0 < 64; k0 += 32) {
        bf16x8 a[4];
#pragma unroll
        for (int m = 0; m < 4; ++m) a[m] = *(const bf16x8*)(XWt + (64 * w + 16 * m + fr) * 72 + k0 + fq * 8);
#pragma unroll
        for (int n = 0; n < 8; ++n) { const bf16x8 bb = *(const bf16x8*)(BmT + (16 * n + fr) * 72 + k0 + fq * 8);
#pragma unroll
            for (int m = 0; m < 4; ++m) acc[m][n] = mfma16(a[m], bb, acc[m][n]); }
    }
    float* Sp = (float*)(p.ws + WS_SBUF) + (size_t)((b * 16 + g * 8 + w) * 32 + c) * 8192;
#pragma unroll
    for (int m = 0; m < 4; ++m)
#pragma unroll
        for (int n = 0; n < 8; ++n)
#pragma unroll
            for (int j = 0; j < 4; ++j) Sp[(16 * m + fq * 4 + j) * 128 + 16 * n + fr] = acc[m][n][j];
    __syncthreads();
}

DEV void ssd_out(const P& p, int l, int unit, unsigned char* lds) {
    const int b = unit >> 6, g = (unit >> 5) & 1, c = unit & 31;
    int tid_ = threadIdx.x; asm volatile("" : "+v"(tid_)); const int tid = tid_, lane = tid & 63, w = tid >> 6, fr = lane & 15, fq = lane >> 4;
    const int r0 = b * 2048 + c * 64;
    const bf16_t* U = (const bf16_t*)(p.ws + WS_U) + (size_t)r0 * INP;
    bf16_t* XsT = (bf16_t*)lds;
    bf16_t* Bm = XsT + 512 * 72;
    bf16_t* Cm = Bm + 64 * 136;
    float* CB = (float*)(lds + 108544);
    float* bsh = (float*)(lds + 125952);
    float* dtsh = bsh + 512;
    float* red = dtsh + 512;
    float* stat = red + 512;
    const int head = g * 8 + w;
    {
        const float dt = softplusf_(bf2f(U[(size_t)lane * INP + UDT + head]) + p.dt_bias[l * 16 + head]);
        const float a = -expf(p.A_log[l * 16 + head]) * dt;
        const float bs = wave_incl_sum(a, lane);
        bsh[w * 64 + lane] = bs; dtsh[w * 64 + lane] = dt;
    }
    const float* cw = p.s_conv_w + (size_t)l * 4 * 1536; const float* cb = p.s_conv_b + (size_t)l * 1536;
    for (int i = 0; i < 12; ++i) {
        const int it = tid + 512 * i, tlo = it & 7, gsub = (it >> 3) & 7, blk = it >> 6, tb = blk & 7, gb = blk >> 3;
        const int t = tb * 8 + tlo, gidx = gb * 8 + gsub;
        const int ch8 = gidx < 64 ? g * 512 + gidx * 8 : (gidx < 80 ? 1024 + g * 128 + (gidx - 64) * 8 : 1280 + g * 128 + (gidx - 80) * 8);
        float v[8];
        ssd_conv8(U + (size_t)t * INP, c * 64 + t, cw, cb, ch8, v);
        if (gidx < 64) {
#pragma unroll
            for (int k = 0; k < 8; ++k) XsT[(gidx * 8 + k) * 72 + t] = f2bf(v[k]); }
        else {
            u32x4 wv; wv.x = pk2(v[0], v[1]); wv.y = pk2(v[2], v[3]); wv.z = pk2(v[4], v[5]); wv.w = pk2(v[6], v[7]);
            if (gidx < 80) *(u32x4*)(Bm + t * 136 + (gidx - 64) * 8) = wv; else *(u32x4*)(Cm + t * 136 + (gidx - 80) * 8) = wv; }
    }
    __syncthreads();
    {
        const int mt_ = w >> 1, nt0 = (w & 1) * 2;
        f32x4 cacc[2] = {(f32x4){0.f, 0.f, 0.f, 0.f}, (f32x4){0.f, 0.f, 0.f, 0.f}};
#pragma unroll
        for (int k0 = 0; k0 < 128; k0 += 32) {
            const bf16x8 a = *(const bf16x8*)(Cm + (16 * mt_ + fr) * 136 + k0 + fq * 8);
#pragma unroll
            for (int n = 0; n < 2; ++n) { const bf16x8 bb = *(const bf16x8*)(Bm + (16 * (nt0 + n) + fr) * 136 + k0 + fq * 8); cacc[n] = mfma16(a, bb, cacc[n]); }
        }
#pragma unroll
        for (int n = 0; n < 2; ++n)
#pragma unroll
            for (int j = 0; j < 4; ++j) CB[(16 * mt_ + fq * 4 + j) * 68 + 16 * (nt0 + n) + fr] = cacc[n][j];
    }
    __syncthreads();
    f32x4 acc1[4][4], acc2[4][4];
#pragma unroll
    for (int m = 0; m < 4; ++m)
#pragma unroll
        for (int n = 0; n < 4; ++n) { acc1[m][n] = (f32x4){0.f, 0.f, 0.f, 0.f}; acc2[m][n] = (f32x4){0.f, 0.f, 0.f, 0.f}; }
#pragma unroll
    for (int m = 0; m < 4; ++m)
#pragma unroll
        for (int ks = 0; ks < 2; ++ks) {
            if (ks * 32 > 16 * m + 15) continue;
            const int t = 16 * m + fr, s0 = 32 * ks + fq * 8;
            const float bt = bsh[w * 64 + t];
            const f32x4 c0 = *(const f32x4*)(CB + t * 68 + s0), c1 = *(const f32x4*)(CB + t * 68 + s0 + 4);
            float mv[8];
#pragma unroll
            for (int i = 0; i < 8; ++i) { const int s = s0 + i; const float cv = i < 4 ? c0[i & 3] : c1[i & 3];
                mv[i] = (s <= t) ? cv * expf(bt - bsh[w * 64 + s]) * dtsh[w * 64 + s] : 0.f; }
            union { u32x4 u; bf16x8 v; } af;
            af.u.x = pk2(mv[0], mv[1]); af.u.y = pk2(mv[2], mv[3]); af.u.z = pk2(mv[4], mv[5]); af.u.w = pk2(mv[6], mv[7]);
#pragma unroll
            for (int n = 0; n < 4; ++n) { const bf16x8 bb = *(const bf16x8*)(XsT + (64 * w + 16 * n + fr) * 72 + 32 * ks + fq * 8); acc1[m][n] = mfma16(af.v, bb, acc1[m][n]); }
        }
    if (c > 0) {
        const bf16_t* STp = (const bf16_t*)(p.ws + WS_ST) + (size_t)((b * 16 + head) * 32 + c - 1) * 8192;
#pragma unroll
        for (int k0 = 0; k0 < 128; k0 += 32) {
            bf16x8 a[4];
#pragma unroll
            for (int m = 0; m < 4; ++m) a[m] = *(const bf16x8*)(Cm + (16 * m + fr) * 136 + k0 + fq * 8);
#pragma unroll
            for (int n = 0; n < 4; ++n) { const bf16x8 bb = *(const bf16x8*)(STp + (16 * n + fr) * 128 + k0 + fq * 8);
#pragma unroll
                for (int m = 0; m < 4; ++m) acc2[m][n] = mfma16(a[m], bb, acc2[m][n]); }
        }
    }
    const float dsk = p.D_skip[l * 16 + head];
#pragma unroll
    for (int m = 0; m < 4; ++m)
#pragma unroll
        for (int j = 0; j < 4; ++j) {
            const int t = 16 * m + fq * 4 + j;
            const float eb = expf(bsh[w * 64 + t]);
            float s = 0.f;
#pragma unroll
            for (int n = 0; n < 4; ++n) {
                const int pp = 16 * n + fr;
                const float y = acc1[m][n][j] + eb * acc2[m][n][j] + dsk * bf2f(XsT[(64 * w + pp) * 72 + t]);
                const float z = bf2f(U[(size_t)t * INP + UZ + g * 512 + w * 64 + pp]);
                const float gt = y * siluf_(z);
                acc1[m][n][j] = gt; s += gt * gt;
            }
            s += __shfl_xor(s, 1); s += __shfl_xor(s, 2); s += __shfl_xor(s, 4); s += __shfl_xor(s, 8);
            if (fr == 0) red[t * 8 + w] = s;
        }
    __syncthreads();
    if (tid < 64) { float s = 0.f;
#pragma unroll
        for (int i = 0; i < 8; ++i) s += red[tid * 8 + i];
        stat[tid] = rsqrtf(s * (1.0f / 512.0f) + 1e-6f); }
    __syncthreads();
    bf16_t* MX = (bf16_t*)(p.ws + WS_MIXIN);
#pragma unroll
    for (int m = 0; m < 4; ++m)
#pragma unroll
        for (int j = 0; j < 4; ++j) {
            const int t = 16 * m + fq * 4 + j;
            const float rs = stat[t];
#pragma unroll
            for (int n = 0; n < 4; ++n) {
                const int ch = g * 512 + w * 64 + 16 * n + fr;
                MX[(size_t)(r0 + t) * D + 1024 + ch] = f2bf(acc1[m][n][j] * rs * p.s_norm_w[l * 1024 + ch]);
            }
        }
    __syncthreads();
}

DEV void smp_mlstm(const P& p, int l, int unit, unsigned char* lds) {
    const int b = unit >> 2, h = unit & 3;
    int tid_ = threadIdx.x; asm volatile("" : "+v"(tid_)); const int tid = tid_, lane = tid & 63, w = tid >> 6;
    const int r0 = NPR + b * 8;
    const bf16_t* U = (const bf16_t*)(p.ws + WS_U) + (size_t)r0 * INP;
    float* qn = (float*)lds; float* kn = qn + 2048; float* vn = kn + 2048; float* qT = vn + 2048; float* kwT = qT + 2048; float* sc = kwT + 2048; float* red = sc + 256;
    const size_t sidx = (size_t)(l * 128 + b) * 4 + h;
    const float* C0 = p.st_C + sidx * 65536; const float* n0 = p.st_n + sidx * 256;
    float* Cout = p.out + O_SC + sidx * 65536;
    if (tid == 0) {
        const float m0 = p.st_m[sidx];
        float bs = 0.f, cm = -INFINITY, mt = 0.f;
        for (int t = 0; t < 8; ++t) {
            const float ig = bf2f(U[(size_t)t * INP + UIG + h]) + p.b_i[l * 4 + h];
            const float lf = logsigf_(bf2f(U[(size_t)t * INP + UFG + h]) + p.b_f[l * 4 + h]);
            bs += lf; const float a = ig - bs; cm = fmaxf(cm, a); mt = bs + fmaxf(m0, cm);
            sc[32 + t] = mt; sc[t] = expf(bs + m0 - mt); sc[40 + t] = a; sc[48 + t] = bs;
        }
        for (int s = 0; s < 8; ++s) sc[16 + s] = expf(bs + sc[40 + s] - mt);
        sc[24] = expf(bs + m0 - mt);
        p.out[O_SM + sidx] = mt;
    }
    __syncthreads();
#pragma unroll
    for (int i = 0; i < 4; ++i) {
        const int idx = tid + 512 * i, t = idx >> 8, d = idx & 255;
        const float q = bf2f(U[(size_t)t * INP + UQ + h * 256 + d]), k = bf2f(U[(size_t)t * INP + UK + h * 256 + d]), v = bf2f(U[(size_t)t * INP + UV + h * 256 + d]);
        qn[t * 256 + d] = q; kn[t * 256 + d] = k; vn[t * 256 + d] = v; qT[d * 8 + t] = q; kwT[d * 8 + t] = k * sc[16 + t];
    }
    __syncthreads();
    {
        const int t = w;
        const f32x4 qv = *(const f32x4*)(qn + t * 256 + lane * 4);
        float dot[9];
#pragma unroll
        for (int s = 0; s < 8; ++s) { const f32x4 kv = *(const f32x4*)(kn + s * 256 + lane * 4); dot[s] = qv[0] * kv[0] + qv[1] * kv[1] + qv[2] * kv[2] + qv[3] * kv[3]; }
        { const f32x4 nv = *(const f32x4*)(n0 + lane * 4); dot[8] = qv[0] * nv[0] + qv[1] * nv[1] + qv[2] * nv[2] + qv[3] * nv[3]; }
#pragma unroll
        for (int s = 0; s < 9; ++s) dot[s] = wave_sum(dot[s]);
        float den = 0.f;
#pragma unroll
        for (int s = 0; s < 8; ++s) { const float sv = (s <= t) ? dot[s] * expf(sc[48 + t] - sc[32 + t] + sc[40 + s]) : 0.f; den += sv; if (lane == 0) sc[64 + t * 8 + s] = sv; }
        den += sc[t] * dot[8];
        if (lane == 0) sc[8 + t] = 1.0f / fmaxf(fabsf(den), expf(-sc[32 + t]));
    }
    if (tid < 256) {
        float a = sc[24] * n0[tid];
#pragma unroll
        for (int s = 0; s < 8; ++s) a += kwT[tid * 8 + s];
        p.out[O_SN + sidx * 256 + tid] = a;
    }
    const int e4 = lane * 4;
    f32x4 num[8], vv[8];
#pragma unroll
    for (int t = 0; t < 8; ++t) { num[t] = (f32x4){0.f, 0.f, 0.f, 0.f}; vv[t] = *(const f32x4*)(vn + t * 256 + e4); }
    const float decay = sc[24];
#pragma unroll 4
    for (int i = 0; i < 32; ++i) {
        const int d = w + 8 * i;
        const f32x4 cc = *(const f32x4*)(C0 + (size_t)d * 256 + e4);
        const f32x4 q0 = *(const f32x4*)(qT + d * 8), q1 = *(const f32x4*)(qT + d * 8 + 4), k0 = *(const f32x4*)(kwT + d * 8), k1 = *(const f32x4*)(kwT + d * 8 + 4);
        f32x4 cn = cc * decay;
#pragma unroll
        for (int t = 0; t < 4; ++t) { num[t] += cc * q0[t]; num[4 + t] += cc * q1[t]; cn += vv[t] * k0[t]; cn += vv[4 + t] * k1[t]; }
        *(f32x4*)(Cout + (size_t)d * 256 + e4) = cn;
    }
#pragma unroll
    for (int t = 0; t < 8; ++t) *(f32x4*)(red + (w * 8 + t) * 256 + e4) = num[t];
    __syncthreads();
    {
        const int t = w;
        f32x4 hv = (f32x4){0.f, 0.f, 0.f, 0.f};
#pragma unroll
        for (int ww = 0; ww < 8; ++ww) hv += *(const f32x4*)(red + (ww * 8 + t) * 256 + e4);
        hv = hv * sc[t];
#pragma unroll
        for (int s = 0; s < 8; ++s) hv += vv[s] * sc[64 + t * 8 + s];
        hv = hv * sc[8 + t];
        const float mu = wave_sum(hv[0] + hv[1] + hv[2] + hv[3]) * (1.0f / 256.0f);
        const f32x4 dv = hv - mu;
        const float var = wave_sum(dv[0] * dv[0] + dv[1] * dv[1] + dv[2] * dv[2] + dv[3] * dv[3]) * (1.0f / 256.0f);
        const float rs = rsqrtf(var + 1e-6f);
        const uint2 ov = *(const uint2*)(U + (size_t)t * INP + UO + h * 256 + e4);
        const f32x4 nw = *(const f32x4*)(p.m_norm_w + l * 1024 + h * 256 + e4);
        const float o0 = dv[0] * rs * nw[0] * sigmoidf_(bflo(ov.x)), o1 = dv[1] * rs * nw[1] * sigmoidf_(bfhi(ov.x));
        const float o2 = dv[2] * rs * nw[2] * sigmoidf_(bflo(ov.y)), o3 = dv[3] * rs * nw[3] * sigmoidf_(bfhi(ov.y));
        u32x2 wv; wv.x = pk2(o0, o1); wv.y = pk2(o2, o3);
        *(u32x2*)((bf16_t*)(p.ws + WS_MIXIN) + (size_t)(r0 + t) * D + h * 256 + e4) = wv;
    }
    __syncthreads();
}

DEV void smp_ssd(const P& p, int l, int unit, unsigned char* lds) {
    const int b = unit >> 1, g = unit & 1;
    int tid_ = threadIdx.x; asm volatile("" : "+v"(tid_)); const int tid = tid_, lane = tid & 63, w = tid >> 6, fr = lane & 15, fq = lane >> 4;
    const int r0 = NPR + b * 8;
    const bf16_t* U = (const bf16_t*)(p.ws + WS_U) + (size_t)r0 * INP;
    float* xs = (float*)lds;
    float* xwT = xs + 4096;
    float* Bmf = xwT + 4096;
    float* CBs = Bmf + 1024;
    float* bsh = CBs + 64;
    float* dtsh = bsh + 64;
    float* bLs = dtsh + 64;
    float* MW = bLs + 64;
    float* red = MW + 512;
    float* stat = red + 64;
    bf16_t* Cmb = (bf16_t*)(stat + 64);
    if (tid < 64) {
        const int hd = tid >> 3, t = tid & 7, head = g * 8 + hd;
        const float A = -expf(p.A_log[l * 16 + head]), dtb = p.dt_bias[l * 16 + head];
        float bs = 0.f, bL = 0.f, dtt = 0.f;
        for (int s = 0; s < 8; ++s) { const float dt = softplusf_(bf2f(U[(size_t)s * INP + UDT + head]) + dtb); bL += dt * A; if (s <= t) bs += dt * A; if (s == t) dtt = dt; }
        bsh[hd * 8 + t] = bs; dtsh[hd * 8 + t] = dtt; if (t == 0) bLs[hd] = bL;
    }
    for (int i = tid; i < 8 * 136 / 2; i += NTHR) ((unsigned*)(Cmb + 8 * 136))[i] = 0u;
    const float* cw = p.s_conv_w + (size_t)l * 4 * 1536; const float* cb = p.s_conv_b + (size_t)l * 1536;
    const float* cv0 = p.st_sconv + (size_t)(l * 128 + b) * 3 * 1536;
    for (int i = 0; i < 2; ++i) {
        const int it = tid + 512 * i;
        if (it < 768) {
            const int t = it / 96, gidx = it % 96;
            const int ch8 = gidx < 64 ? g * 512 + gidx * 8 : (gidx < 80 ? 1024 + g * 128 + (gidx - 64) * 8 : 1280 + g * 128 + (gidx - 80) * 8);
            float o[8];
            { const f32x4 b0 = *(const f32x4*)(cb + ch8), b1 = *(const f32x4*)(cb + ch8 + 4); o[0] = b0[0]; o[1] = b0[1]; o[2] = b0[2]; o[3] = b0[3]; o[4] = b1[0]; o[5] = b1[1]; o[6] = b1[2]; o[7] = b1[3]; }
#pragma unroll
            for (int j = 0; j < 4; ++j) {
                const int idx = t + j;
                float xf[8];
                if (idx < 3) { const f32x4 a0 = *(const f32x4*)(cv0 + idx * 1536 + ch8), a1 = *(const f32x4*)(cv0 + idx * 1536 + ch8 + 4);
                    xf[0] = a0[0]; xf[1] = a0[1]; xf[2] = a0[2]; xf[3] = a0[3]; xf[4] = a1[0]; xf[5] = a1[1]; xf[6] = a1[2]; xf[7] = a1[3]; }
                else { const uint4 x = *(const uint4*)(U + (size_t)(idx - 3) * INP + UXS + ch8); unpack8(x, xf); }
                const f32x4 w0 = *(const f32x4*)(cw + j * 1536 + ch8), w1 = *(const f32x4*)(cw + j * 1536 + ch8 + 4);
                o[0] += w0[0] * xf[0]; o[1] += w0[1] * xf[1]; o[2] += w0[2] * xf[2]; o[3] += w0[3] * xf[3];
                o[4] += w1[0] * xf[4]; o[5] += w1[1] * xf[5]; o[6] += w1[2] * xf[6]; o[7] += w1[3] * xf[7];
            }
#pragma unroll
            for (int k = 0; k < 8; ++k) o[k] = siluf_(o[k]);
            if (gidx < 64) {
#pragma unroll
                for (int k = 0; k < 8; ++k) xs[t * 512 + gidx * 8 + k] = o[k]; }
            else if (gidx < 80) {
#pragma unroll
                for (int k = 0; k < 8; ++k) Bmf[t * 128 + (gidx - 64) * 8 + k] = o[k]; }
            else { u32x4 wv; wv.x = pk2(o[0], o[1]); wv.y = pk2(o[2], o[3]); wv.z = pk2(o[4], o[5]); wv.w = pk2(o[6], o[7]); *(u32x4*)(Cmb + t * 136 + (gidx - 80) * 8) = wv; }
        }
    }
    __syncthreads();
#pragma unroll
    for (int i = 0; i < 8; ++i) {
        const int idx = tid + 512 * i, hp = idx >> 3, s = idx & 7, hd = hp >> 6;
        xwT[hp * 8 + s] = xs[s * 512 + hp] * expf(bLs[hd] - bsh[hd * 8 + s]) * dtsh[hd * 8 + s];
    }
    if (tid < 64) {
        const int t = tid >> 3, s = tid & 7; float a = 0.f;
        for (int n = 0; n < 128; ++n) a += bf2f(Cmb[t * 136 + n]) * Bmf[s * 128 + n];
        CBs[t * 8 + s] = a;
    }
    __syncthreads();
    { const int hd = tid >> 6, t = (tid >> 3) & 7, s = tid & 7;
      MW[tid] = (s <= t) ? CBs[t * 8 + s] * expf(bsh[hd * 8 + t] - bsh[hd * 8 + s]) * dtsh[hd * 8 + s] : 0.f; }
    __syncthreads();
    const int head = g * 8 + w;
    const size_t sidx = (size_t)(l * 128 + b) * 16 + head;
    const float* S0 = p.st_ssm + sidx * 8192; float* So = p.out + O_SS + sidx * 8192;
    const float dA = expf(bLs[w]);
    f32x4 acc[4];
#pragma unroll
    for (int nt = 0; nt < 4; ++nt) {
        acc[nt] = (f32x4){0.f, 0.f, 0.f, 0.f};
        const int pp = 16 * nt + fr;
        const f32x4 xw0 = *(const f32x4*)(xwT + (64 * w + pp) * 8), xw1 = *(const f32x4*)(xwT + (64 * w + pp) * 8 + 4);
#pragma unroll 1
        for (int ks = 0; ks < 4; ++ks) {
            const int n0 = 32 * ks + fq * 8;
            const f32x4 s0 = *(const f32x4*)(S0 + pp * 128 + n0), s1 = *(const f32x4*)(S0 + pp * 128 + n0 + 4);
            union { u32x4 u; bf16x8 v; } bfr;
            bfr.u.x = pk2(s0[0], s0[1]); bfr.u.y = pk2(s0[2], s0[3]); bfr.u.z = pk2(s1[0], s1[1]); bfr.u.w = pk2(s1[2], s1[3]);
            const bf16x8 af = *(const bf16x8*)(Cmb + fr * 136 + n0);
            acc[nt] = mfma16(af, bfr.v, acc[nt]);
            f32x4 o0 = s0 * dA, o1 = s1 * dA;
#pragma unroll
            for (int s = 0; s < 8; ++s) {
                const float xv = s < 4 ? xw0[s & 3] : xw1[s & 3];
                const f32x4 bm0 = *(const f32x4*)(Bmf + s * 128 + n0), bm1 = *(const f32x4*)(Bmf + s * 128 + n0 + 4);
                o0 += bm0 * xv; o1 += bm1 * xv;
            }
            *(f32x4*)(So + pp * 128 + n0) = o0; *(f32x4*)(So + pp * 128 + n0 + 4) = o1;
        }
    }
    const float dsk = p.D_skip[l * 16 + head];
    float gts[4][4];
#pragma unroll
    for (int j = 0; j < 4; ++j) {
        const int t = (fq & 1) * 4 + j;
        const float eb = expf(bsh[w * 8 + t]);
        float ssq = 0.f;
#pragma unroll
        for (int nt = 0; nt < 4; ++nt) {
            const int hp = 64 * w + 16 * nt + fr;
            float y = eb * acc[nt][j] + dsk * xs[t * 512 + hp];
#pragma unroll
            for (int s = 0; s < 8; ++s) y += MW[(w * 8 + t) * 8 + s] * xs[s * 512 + hp];
            const float z = bf2f(U[(size_t)t * INP + UZ + g * 512 + hp]);
            const float gt = y * siluf_(z);
            gts[nt][j] = gt; ssq += gt * gt;
        }
        ssq += __shfl_xor(ssq, 1); ssq += __shfl_xor(ssq, 2); ssq += __shfl_xor(ssq, 4); ssq += __shfl_xor(ssq, 8);
        if (fr == 0 && fq < 2) red[t * 8 + w] = ssq;
    }
    __syncthreads();
    if (tid < 8) { float s = 0.f;
#pragma unroll
        for (int i = 0; i < 8; ++i) s += red[tid * 8 + i];
        stat[tid] = rsqrtf(s * (1.0f / 512.0f) + 1e-6f); }
    __syncthreads();
    if (fq < 2) {
        bf16_t* MX = (bf16_t*)(p.ws + WS_MIXIN);
#pragma unroll
        for (int j = 0; j < 4; ++j) {
            const int t = fq * 4 + j;
#pragma unroll
            for (int nt = 0; nt < 4; ++nt) {
                const int ch = g * 512 + 64 * w + 16 * nt + fr;
                MX[(size_t)(r0 + t) * D + 1024 + ch] = f2bf(gts[nt][j] * stat[t] * p.s_norm_w[l * 1024 + ch]);
            }
        }
    }
    __syncthreads();
}

DEV void phase_ln(const P& p, int l, int which) {
    const int lane = threadIdx.x & 63, w = threadIdx.x >> 6;
    const float* gam = (which ? p.ln2_g : p.ln1_g) + l * D; const float* bet = (which ? p.ln2_b : p.ln1_b) + l * D;
    const float* mix = (const float*)(p.ws + WS_MIXF);
    float* xf = (float*)(p.ws + WS_XF); bf16_t* xb = (bf16_t*)(p.ws + WS_XB);
    const bool first = (l == 0 && which == 0), lastp = (l == 1 && which == 1);
    for (int r = blockIdx.x * 8 + w; r < NTOK; r += gridDim.x * 8) {
        const float* src = first ? (r < NPR ? p.x_prompt + (size_t)r * D : p.x_sample + (size_t)(r - NPR) * D) : xf + (size_t)r * D;
        float* dst = lastp ? p.out + (size_t)r * D : xf + (size_t)r * D;
        f32x4 y[8]; float s = 0.f;
#pragma unroll
        for (int i = 0; i < 8; ++i) { const int cidx = i * 256 + lane * 4; y[i] = *(const f32x4*)(src + cidx) * ALPHA + *(const f32x4*)(mix + (size_t)r * D + cidx); s += (y[i][0] + y[i][1]) + (y[i][2] + y[i][3]); }
        const float mu = wave_sum(s) * (1.0f / D);
        float q = 0.f;
#pragma unroll
        for (int i = 0; i < 8; ++i) { y[i] = y[i] - mu; q += (y[i][0] * y[i][0] + y[i][1] * y[i][1]) + (y[i][2] * y[i][2] + y[i][3] * y[i][3]); }
        const float rs = rsqrtf(wave_sum(q) * (1.0f / D) + 1e-5f);
#pragma unroll
        for (int i = 0; i < 8; ++i) { const int cidx = i * 256 + lane * 4;
            const f32x4 o = y[i] * rs * *(const f32x4*)(gam + cidx) + *(const f32x4*)(bet + cidx);
            *(f32x4*)(dst + cidx) = o;
            u32x2 wv; wv.x = pk2(o[0], o[1]); wv.y = pk2(o[2], o[3]);
            *(u32x2*)(xb + (size_t)r * D + cidx) = wv; }
    }
}

DEV void phase_ffn_gate(const P& p, int l) {
    const bf16_t* up = (const bf16_t*)(p.ws + WS_UP); bf16_t* act = (bf16_t*)(p.ws + WS_ACT);
    const float* fw = p.f_conv_w + (size_t)l * 3 * DFF2; const float* fb = p.f_conv_b + (size_t)l * DFF2;
    const int total = NTOK * (DFF / 8);
    for (int it = blockIdx.x * NTHR + threadIdx.x; it < total; it += gridDim.x * NTHR) {
        const int r = it / (DFF / 8), j8 = (it % (DFF / 8)) * 8;
        const bool smp = r >= NPR; const int t = smp ? ((r - NPR) & 7) : (r & 2047); const int sb = (r - NPR) >> 3;
        float ag[8], av[8];
        { const f32x4 a0 = *(const f32x4*)(fb + j8), a1 = *(const f32x4*)(fb + j8 + 4), c0 = *(const f32x4*)(fb + DFF + j8), c1 = *(const f32x4*)(fb + DFF + j8 + 4);
#pragma unroll
          for (int i = 0; i < 4; ++i) { ag[i] = a0[i]; ag[4 + i] = a1[i]; av[i] = c0[i]; av[4 + i] = c1[i]; } }
#pragma unroll
        for (int k = 0; k < 3; ++k) {
            const int back = 2 - k;
            float xg[8], xv[8];
            if (t - back >= 0) { unpack8(*(const uint4*)(up + (size_t)(r - back) * DFF2 + j8), xg); unpack8(*(const uint4*)(up + (size_t)(r - back) * DFF2 + DFF + j8), xv); }
            else if (smp) { const float* bp = p.st_fconv + ((size_t)(l * 128 + sb) * 2 + (t + k)) * DFF2;
                const f32x4 a0 = *(const f32x4*)(bp + j8), a1 = *(const f32x4*)(bp + j8 + 4), c0 = *(const f32x4*)(bp + DFF + j8), c1 = *(const f32x4*)(bp + DFF + j8 + 4);
#pragma unroll
                for (int i = 0; i < 4; ++i) { xg[i] = a0[i]; xg[4 + i] = a1[i]; xv[i] = c0[i]; xv[4 + i] = c1[i]; } }
            else continue;
            const f32x4 g0 = *(const f32x4*)(fw + k * DFF2 + j8), g1 = *(const f32x4*)(fw + k * DFF2 + j8 + 4), v0 = *(const f32x4*)(fw + k * DFF2 + DFF + j8), v1 = *(const f32x4*)(fw + k * DFF2 + DFF + j8 + 4);
#pragma unroll
            for (int i = 0; i < 4; ++i) { ag[i] += g0[i] * xg[i]; ag[4 + i] += g1[i] * xg[4 + i]; av[i] += v0[i] * xv[i]; av[4 + i] += v1[i] * xv[4 + i]; }
        }
        u32x4 wv;
        wv.x = pk2(siluf_(ag[0]) * av[0], siluf_(ag[1]) * av[1]); wv.y = pk2(siluf_(ag[2]) * av[2], siluf_(ag[3]) * av[3]);
        wv.z = pk2(siluf_(ag[4]) * av[4], siluf_(ag[5]) * av[5]); wv.w = pk2(siluf_(ag[6]) * av[6], siluf_(ag[7]) * av[7]);
        *(u32x4*)(act + (size_t)r * DFF + j8) = wv;
    }
    const int tot2 = 132 * 2 * (DFF2 / 8);
    for (int it = blockIdx.x * NTHR + threadIdx.x; it < tot2; it += gridDim.x * NTHR) {
        const int c8 = (it % (DFF2 / 8)) * 8, rr = it / (DFF2 / 8), j = rr & 1, sq = rr >> 1;
        float* o; size_t row;
        if (sq < 4) { o = p.out + O_PFC + ((size_t)(l * 4 + sq) * 2 + j) * DFF2 + c8; row = (size_t)sq * 2048 + 2046 + j; }
        else { const int b = sq - 4; o = p.out + O_SFC + ((size_t)(l * 128 + b) * 2 + j) * DFF2 + c8; row = (size_t)NPR + b * 8 + 6 + j; }
        float xf[8]; unpack8(*(const uint4*)(up + row * DFF2 + c8), xf);
        *(f32x4*)o = (f32x4){xf[0], xf[1], xf[2], xf[3]}; *(f32x4*)(o + 4) = (f32x4){xf[4], xf[5], xf[6], xf[7]};
    }
}


#define XB_TMO      128
#define XB_XCNT(j)  (256  + 64 * (j))
#define XB_XSUB(j)  (1280 + 64 * (j))
#define XB_XGEN(j)  (2304 + 64 * (j))
#define XB_TOP      3328
#define XB_TOPGEN   3392
#define XCD_BAR_WORDS 3456
#define XB_SPIN_CAP (1u << 20)
DEV unsigned xb_ld(unsigned* p)              { return __hip_atomic_load(p, __ATOMIC_RELAXED, __HIP_MEMORY_SCOPE_AGENT); }
DEV unsigned xb_add(unsigned* p, unsigned v) { return __hip_atomic_fetch_add(p, v, __ATOMIC_RELAXED, __HIP_MEMORY_SCOPE_AGENT); }
DEV unsigned xb_xcc_id() { return (unsigned)__builtin_amdgcn_s_getreg((3 << 11) | 20) & 0xFu; }
#define XB_SPIN(cond, bar) do { unsigned _sp = 0; while (cond) { __builtin_amdgcn_s_sleep(1); \
    if ((++_sp & 255u) == 0u) { if (xb_ld(&(bar)[XB_TMO])) break; if (_sp > XB_SPIN_CAP) { atomicAdd(&(bar)[XB_TMO], 1u); break; } } } } while (0)
struct XcdBarrier { unsigned* bar; unsigned x; volatile LAS unsigned* st; };
DEV XcdBarrier xcd_barrier_post(unsigned* bar, volatile LAS unsigned* st) {
    XcdBarrier b; b.bar = bar; b.x = xb_xcc_id(); b.st = st;
    if (threadIdx.x == 0) (void)xb_add(&bar[XB_XCNT(b.x)], 1u);
    return b;
}
DEV void xcd_barrier_complete(unsigned* bar, unsigned x, unsigned& nloc, unsigned& nx) {
    const unsigned G = gridDim.x * gridDim.y * gridDim.z;
    unsigned sum, cnt, mine, sp = 0u;
    for (;;) {
        sum = 0u; cnt = 0u; mine = 0u;
#pragma unroll
        for (unsigned j = 0; j < 16; ++j) { const unsigned c = xb_ld(&bar[XB_XCNT(j)]); sum += c; cnt += (c > 0u) ? 1u : 0u; mine = (j == x) ? c : mine; }
        if (sum == G) break;
        __builtin_amdgcn_s_sleep(1);
        if ((++sp & 255u) == 0u) { if (xb_ld(&bar[XB_TMO])) break; if (sp > XB_SPIN_CAP) { atomicAdd(&bar[XB_TMO], 1u); break; } }
    }
    nloc = mine > 0u ? mine : 1u; nx = cnt > 0u ? cnt : 1u;
}
DEV void xcd_barrier(const XcdBarrier& b) {
    asm volatile("s_waitcnt vmcnt(0)" ::: "memory");
    __syncthreads();
    if (threadIdx.x == 0) {
        unsigned* bar = b.bar;
        __builtin_amdgcn_s_waitcnt(0);
        unsigned nloc = b.st[0], nx = b.st[1];
        if (nloc == 0u) { xcd_barrier_complete(bar, b.x, nloc, nx); b.st[0] = nloc; b.st[1] = nx; }
        const unsigned old = xb_add(&bar[XB_XSUB(b.x)], 1u);
        const unsigned gen = old / nloc;
        if (old + 1u == (gen + 1u) * nloc) {
            __builtin_amdgcn_fence(__ATOMIC_RELEASE, "agent");
            asm volatile("s_waitcnt vmcnt(0)" ::: "memory");
            const unsigned og = xb_add(&bar[XB_TOP], 1u);
            const unsigned tg = og / nx;
            if (og + 1u == (tg + 1u) * nx) xb_add(&bar[XB_TOPGEN], 1u);
            else XB_SPIN(xb_ld(&bar[XB_TOPGEN]) == tg, bar);
            __builtin_amdgcn_fence(__ATOMIC_ACQUIRE, "agent");
            xb_add(&bar[XB_XGEN(b.x)], 1u);
            asm volatile("s_waitcnt vmcnt(0)" ::: "memory");
        } else {
            XB_SPIN(xb_ld(&bar[XB_XGEN(b.x)]) == gen, bar);
            __builtin_amdgcn_fence(__ATOMIC_ACQUIRE, "agent");
            asm volatile("s_waitcnt vmcnt(0)" ::: "memory");
        }
    }
    __syncthreads();
}

constexpr int NPHASE = 21;
DEV void run_phase(const P& p, int l, int q, unsigned char* lds) {
    int bid = blockIdx.x, G = gridDim.x; asm volatile("" : "+s"(bid), "+s"(G));
    if (q == 0) {
        pg8::Gemm g{(const bf16_t*)(p.ws + WS_XB), (const bf16_t*)(p.ws + WS_WIN) + (size_t)l * INP * D, NTOK, INP, D};
        pg8::StaticOrder S; S.init(NTOK, INP, G, bid);
        pg8::EpiBf16 E{(bf16_t*)(p.ws + WS_U), INP};
        pg8::gemm_phase<pg8::EpiBf16>((LAS unsigned char*)lds, g, S, E);
    } else if (q == 1) {
        for (int u = bid; u < 512; u += G) smp_mlstm(p, l, u, lds);
        for (int u = bid; u < 256; u += G) smp_ssd(p, l, u, lds);
        for (int u = bid; u < 512; u += G) mlstm_local(p, l, u, lds);
        for (int u = bid; u < 256; u += G) ssd_local(p, l, u, lds);
    } else if (q == 2) {
        for (int u = bid; u < 256; u += G) mlstm_scan(p, l, u, lds);
        for (int u = bid; u < 128; u += G) ssd_scan(p, l, u, lds);
        for (int u = bid; u < 132; u += G) convstate_copy(p, l, u);
    } else if (q == 3) {
        for (int u = bid; u < 512; u += G) mlstm_out(p, l, u, lds);
        for (int u = bid; u < 256; u += G) ssd_out(p, l, u, lds);
    } else if (q == 4) {
        pg8::Gemm g{(const bf16_t*)(p.ws + WS_MIXIN), (const bf16_t*)(p.ws + WS_WOUT) + (size_t)l * D * D, NTOK, D, D};
        pg8::StaticOrder S; S.init(NTOK, D, G, bid);
        pg8::EpiF32 E{(float*)(p.ws + WS_MIXF), D};
        pg8::gemm_phase<pg8::EpiF32>((LAS unsigned char*)lds, g, S, E);
    } else if (q == 5) {
        phase_ln(p, l, 0);
    } else if (q == 6) {
        pg8::Gemm g{(const bf16_t*)(p.ws + WS_XB), (const bf16_t*)(p.ws + WS_WUP) + (size_t)l * DFF2 * D, NTOK, DFF2, D};
        pg8::StaticOrder S; S.init(NTOK, DFF2, G, bid);
        pg8::EpiBf16 E{(bf16_t*)(p.ws + WS_UP), DFF2};
        pg8::gemm_phase<pg8::EpiBf16>((LAS unsigned char*)lds, g, S, E);
    } else if (q == 7) {
        phase_ffn_gate(p, l);
    } else if (q == 8) {
        pg8::Gemm g{(const bf16_t*)(p.ws + WS_ACT), (const bf16_t*)(p.ws + WS_WDN) + (size_t)l * D * DFF, NTOK, D, DFF};
        pg8::StaticOrder S; S.init(NTOK, D, G, bid);
        pg8::EpiF32 E{(float*)(p.ws + WS_MIXF), D};
        pg8::gemm_phase<pg8::EpiF32>((LAS unsigned char*)lds, g, S, E);
    } else {
        phase_ln(p, l, 1);
    }
}
#if MK_MULTI
template <int Q> __global__ void __launch_bounds__(NTHR, 2) k_phase(P p) {
    extern __shared__ __attribute__((aligned(16))) unsigned char lds[];
    if (Q < 0) phase_prologue(p, lds); else run_phase(p, p.ph_lo, Q, lds);
}
#else
__global__ void __launch_bounds__(NTHR, 2) mk_fwd(P p) {
    extern __shared__ __attribute__((aligned(16))) unsigned char lds[];
    cg::grid_group grid = cg::this_grid();
    if (p.ph_hi < 0) grid.sync();
    if (threadIdx.x < 4) ((unsigned*)(lds + LDS_BYTES - 16))[threadIdx.x] = 0u;
    __syncthreads();
    (void)xcd_barrier_post((unsigned*)(p.ws + WS_BAR), (volatile LAS unsigned*)(lds + LDS_BYTES - 16));
#define GSYNC() do { XcdBarrier b_; b_.bar = (unsigned*)(p.ws + WS_BAR); b_.x = xb_xcc_id(); b_.st = (volatile LAS unsigned*)(lds + LDS_BYTES - 16); xcd_barrier(b_); } while (0)
    phase_prologue(p, lds);
#pragma unroll 1
    for (int l = 0; l < 2; ++l) {
        GSYNC(); run_phase(p, l, 0, lds);
        GSYNC(); run_phase(p, l, 1, lds);
        GSYNC(); run_phase(p, l, 2, lds);
        GSYNC(); run_phase(p, l, 3, lds);
        GSYNC(); run_phase(p, l, 4, lds);
        GSYNC(); run_phase(p, l, 5, lds);
        GSYNC(); run_phase(p, l, 6, lds);
        GSYNC(); run_phase(p, l, 7, lds);
        GSYNC(); run_phase(p, l, 8, lds);
        GSYNC(); run_phase(p, l, 9, lds);
    }
    for (int i = 0; i < PROBE_SYNCS; ++i) GSYNC();
}
#endif

extern "C" void kernel_launch(void* const* d_in, const int* in_sizes, int n_in, void* d_out, int out_size, void* d_ws, size_t ws_size, hipStream_t stream) {
    static int grid = 0;
    if (grid == 0) {
        if (n_in != 27 || ws_size < WS_END) { fprintf(stderr, "kernel_launch: unexpected n_in %d or ws_size %zu (need %zu)\n", n_in, ws_size, (size_t)WS_END); grid = -1; return; }
        int dev = 0, cus = 0, per_cu = 0;
        hipGetDevice(&dev);
        hipDeviceGetAttribute(&cus, hipDeviceAttributeMultiprocessorCount, dev);
#if MK_MULTI
        const void* fns[11] = {(const void*)k_phase<-1>, (const void*)k_phase<0>, (const void*)k_phase<1>, (const void*)k_phase<2>, (const void*)k_phase<3>, (const void*)k_phase<4>, (const void*)k_phase<5>,
                               (const void*)k_phase<6>, (const void*)k_phase<7>, (const void*)k_phase<8>, (const void*)k_phase<9>};
        for (int i = 0; i < 11; ++i) if (hipFuncSetAttribute(fns[i], hipFuncAttributeMaxDynamicSharedMemorySize, LDS_BYTES) != hipSuccess) { fprintf(stderr, "kernel_launch: hipFuncSetAttribute failed\n"); grid = -1; return; }
#else
        if (hipFuncSetAttribute((const void*)mk_fwd, hipFuncAttributeMaxDynamicSharedMemorySize, LDS_BYTES) != hipSuccess) { fprintf(stderr, "kernel_launch: hipFuncSetAttribute failed\n"); grid = -1; return; }
        hipOccupancyMaxActiveBlocksPerMultiprocessor(&per_cu, (const void*)mk_fwd, NTHR, LDS_BYTES);
        (void)hipGetLastError();
#endif
        (void)per_cu;
        grid = cus * 1;
    }
    if (grid < 0) return;
    P p{};
    const float** pp = (const float**)&p;
    for (int i = 0; i < 27; ++i) pp[i] = (const float*)d_in[i];
    p.out = (float*)d_out; p.ws = (unsigned char*)d_ws;
#if MK_MULTI
    p.ph_lo = 0; p.ph_hi = 0;
    if (PROBE_REP == -1) hipLaunchKernelGGL(k_phase<-1>, dim3(grid), dim3(NTHR), LDS_BYTES, stream, p);
    hipLaunchKernelGGL(k_phase<-1>, dim3(grid), dim3(NTHR), LDS_BYTES, stream, p);
    for (int l = 0; l < 2; ++l) {
        p.ph_lo = l;
        for (int rep = 0; rep < 1 + ((PROBE_REP == 0) || (PROBE_REP == 100 && (0 == 0 || 0 == 4 || 0 == 6 || 0 == 8))); ++rep) hipLaunchKernelGGL(k_phase<0>, dim3(grid), dim3(NTHR), LDS_BYTES, stream, p);
        for (int rep = 0; rep < 1 + ((PROBE_REP == 1) || (PROBE_REP == 100 && (1 == 0 || 1 == 4 || 1 == 6 || 1 == 8))); ++rep) hipLaunchKernelGGL(k_phase<1>, dim3(grid), dim3(NTHR), LDS_BYTES, stream, p);
        for (int rep = 0; rep < 1 + ((PROBE_REP == 2) || (PROBE_REP == 100 && (2 == 0 || 2 == 4 || 2 == 6 || 2 == 8))); ++rep) hipLaunchKernelGGL(k_phase<2>, dim3(grid), dim3(NTHR), LDS_BYTES, stream, p);
        for (int rep = 0; rep < 1 + ((PROBE_REP == 3) || (PROBE_REP == 100 && (3 == 0 || 3 == 4 || 3 == 6 || 3 == 8))); ++rep) hipLaunchKernelGGL(k_phase<3>, dim3(grid), dim3(NTHR), LDS_BYTES, stream, p);
        for (int rep = 0; rep < 1 + ((PROBE_REP == 4) || (PROBE_REP == 100 && (4 == 0 || 4 == 4 || 4 == 6 || 4 == 8))); ++rep) hipLaunchKernelGGL(k_phase<4>, dim3(grid), dim3(NTHR), LDS_BYTES, stream, p);
        for (int rep = 0; rep < 1 + ((PROBE_REP == 5) || (PROBE_REP == 100 && (5 == 0 || 5 == 4 || 5 == 6 || 5 == 8))); ++rep) hipLaunchKernelGGL(k_phase<5>, dim3(grid), dim3(NTHR), LDS_BYTES, stream, p);
        for (int rep = 0; rep < 1 + ((PROBE_REP == 6) || (PROBE_REP == 100 && (6 == 0 || 6 == 4 || 6 == 6 || 6 == 8))); ++rep) hipLaunchKernelGGL(k_phase<6>, dim3(grid), dim3(NTHR), LDS_BYTES, stream, p);
        for (int rep = 0; rep < 1 + ((PROBE_REP == 7) || (PROBE_REP == 100 && (7 == 0 || 7 == 4 || 7 == 6 || 7 == 8))); ++rep) hipLaunchKernelGGL(k_phase<7>, dim3(grid), dim3(NTHR), LDS_BYTES, stream, p);
        for (int rep = 0; rep < 1 + ((PROBE_REP == 8) || (PROBE_REP == 100 && (8 == 0 || 8 == 4 || 8 == 6 || 8 == 8))); ++rep) hipLaunchKernelGGL(k_phase<8>, dim3(grid), dim3(NTHR), LDS_BYTES, stream, p);
        for (int rep = 0; rep < 1 + ((PROBE_REP == 9) || (PROBE_REP == 100 && (9 == 0 || 9 == 4 || 9 == 6 || 9 == 8))); ++rep) hipLaunchKernelGGL(k_phase<9>, dim3(grid), dim3(NTHR), LDS_BYTES, stream, p);
    }
#else
    p.ph_lo = 0; p.ph_hi = NPHASE;
    if (hipMemsetAsync((char*)d_ws + WS_BAR, 0, 16384, stream) != hipSuccess) { fprintf(stderr, "kernel_launch: memset failed\n"); return; }
    void* args[] = {&p};
    hipError_t e = hipLaunchCooperativeKernel((const void*)mk_fwd, dim3(grid), dim3(NTHR), args, LDS_BYTES, stream);
    if (e != hipSuccess) fprintf(stderr, "cooperative launch failed: %s (grid %d)\n", hipGetErrorString(e), grid);
#endif
}
```

```cpp
#include <hip/hip_runtime.h>
#include <hip/hip_cooperative_groups.h>
#include <cstdio>
namespace cg = cooperative_groups;

#ifndef MK_MULTI
#define MK_MULTI 0
#endif
#ifndef PROBE_REP
#define PROBE_REP -99
#endif
#ifndef PROBE_SYNCS
#define PROBE_SYNCS 0
#endif

#define DEV __device__ __forceinline__
#define LAS __attribute__((address_space(3)))
typedef unsigned short bf16_t;
typedef short bf16x8 __attribute__((ext_vector_type(8)));
typedef float f32x4 __attribute__((ext_vector_type(4)));
typedef float f32x2 __attribute__((ext_vector_type(2)));
typedef unsigned u32x4 __attribute__((ext_vector_type(4)));
typedef unsigned u32x2 __attribute__((ext_vector_type(2)));

constexpr int D = 2048, NPR = 8192, NSM = 1024, NTOK = 9216, INP = 6912, IN_DIM = 6680, DFF = 5504, DFF2 = 11008;
constexpr int UQ = 0, UK = 1024, UV = 2048, UO = 3072, UZ = 4096, UXS = 5120, UIG = 6656, UFG = 6660, UDT = 6664;
constexpr int NTHR = 512;
constexpr int LDS_BYTES = 136 * 1024;
constexpr float ALPHA = 1.41421356237309515f;

constexpr size_t O_YP = 0;
constexpr size_t O_YS = O_YP + (size_t)4 * 2048 * 2048;
constexpr size_t O_PC = O_YS + (size_t)128 * 8 * 2048;
constexpr size_t O_PN = O_PC + (size_t)2 * 4 * 4 * 256 * 256;
constexpr size_t O_PM = O_PN + (size_t)2 * 4 * 4 * 256;
constexpr size_t O_PS = O_PM + (size_t)2 * 4 * 4;
constexpr size_t O_PSC = O_PS + (size_t)2 * 4 * 16 * 64 * 128;
constexpr size_t O_PFC = O_PSC + (size_t)2 * 4 * 3 * 1536;
constexpr size_t O_SC = O_PFC + (size_t)2 * 4 * 2 * DFF2;
constexpr size_t O_SN = O_SC + (size_t)2 * 128 * 4 * 256 * 256;
constexpr size_t O_SM = O_SN + (size_t)2 * 128 * 4 * 256;
constexpr size_t O_SS = O_SM + (size_t)2 * 128 * 4;
constexpr size_t O_SSC = O_SS + (size_t)2 * 128 * 16 * 64 * 128;
constexpr size_t O_SFC = O_SSC + (size_t)2 * 128 * 3 * 1536;

constexpr size_t WS_WIN = 0;
constexpr size_t WS_WOUT = WS_WIN + (size_t)2 * INP * D * 2;
constexpr size_t WS_WUP = WS_WOUT + (size_t)2 * D * D * 2;
constexpr size_t WS_WDN = WS_WUP + (size_t)2 * DFF2 * D * 2;
constexpr size_t WS_XB = WS_WDN + (size_t)2 * D * DFF * 2;
constexpr size_t WS_XF = WS_XB + (size_t)NTOK * D * 2;
constexpr size_t WS_U = WS_XF + (size_t)NTOK * D * 4;
constexpr size_t WS_MIXIN = WS_U + (size_t)NTOK * INP * 2;
constexpr size_t WS_MIXF = WS_MIXIN + (size_t)NTOK * D * 2;
constexpr size_t WS_UP = WS_MIXF + (size_t)NTOK * D * 4;
constexpr size_t WS_ACT = WS_UP + (size_t)NTOK * DFF2 * 2;
constexpr size_t WS_PART = WS_ACT + (size_t)NTOK * DFF * 2;
constexpr size_t WS_SMALL = WS_PART + (size_t)8 * NSM * D * 4;
constexpr size_t WS_DBUF = WS_UP;
constexpr size_t WS_SBUF = WS_UP + (size_t)512 * 65536 * 4;
constexpr size_t WS_CT = WS_ACT;
constexpr size_t WS_ST = WS_ACT + (size_t)512 * 65536 * 2;
static_assert(WS_SBUF + (size_t)2048 * 8192 * 4 <= WS_ACT, "alias");
static_assert(WS_ST + (size_t)2048 * 8192 * 2 <= WS_PART, "alias");
constexpr size_t WS_NLOC = WS_SMALL;
constexpr size_t WS_NST = WS_NLOC + (size_t)512 * 256 * 4;
constexpr size_t WS_GSTAT = WS_NST + (size_t)512 * 256 * 4;
constexpr size_t WS_MST = WS_GSTAT + 4096;
constexpr size_t WS_SBSUM = WS_MST + 4096;
constexpr size_t WS_BAR = WS_SBSUM + 8192;
constexpr size_t WS_END = WS_BAR + 16384;

struct P {
    const float* x_prompt; const float* x_sample; const float* st_C; const float* st_n; const float* st_m; const float* st_ssm; const float* st_sconv; const float* st_fconv;
    const float* w_in; const float* b_i; const float* b_f; const float* m_norm_w; const float* s_conv_w; const float* s_conv_b; const float* dt_bias; const float* A_log; const float* D_skip;
    const float* s_norm_w; const float* w_out; const float* ln1_g; const float* ln1_b; const float* w_up; const float* f_conv_w; const float* f_conv_b; const float* w_down; const float* ln2_g; const float* ln2_b;
    float* out; unsigned char* ws; int ph_lo, ph_hi;
};

DEV float bf2f(bf16_t v) { return __uint_as_float(((unsigned)v) << 16); }
DEV bf16_t f2bf(float f) { unsigned u = __float_as_uint(f); u += 0x7FFFu + ((u >> 16) & 1u); return (bf16_t)(u >> 16); }
DEV unsigned pk2(float lo, float hi) { return (unsigned)f2bf(lo) | ((unsigned)f2bf(hi) << 16); }
DEV float bflo(unsigned w) { return __uint_as_float(w << 16); }
DEV float bfhi(unsigned w) { return __uint_as_float(w & 0xffff0000u); }
DEV float sigmoidf_(float x) { return __builtin_amdgcn_rcpf(1.0f + __expf(-x)); }
DEV float siluf_(float x) { return x * sigmoidf_(x); }
DEV float softplusf_(float x) { return fmaxf(x, 0.f) + log1pf(expf(-fabsf(x))); }
DEV float logsigf_(float x) { return fminf(x, 0.f) - log1pf(expf(-fabsf(x))); }
DEV float wave_sum(float v) {
#pragma unroll
    for (int o = 32; o >= 1; o >>= 1) v += __shfl_xor(v, o);
    return v; }
DEV float wave_max(float v) {
#pragma unroll
    for (int o = 32; o >= 1; o >>= 1) v = fmaxf(v, __shfl_xor(v, o));
    return v; }
DEV float wave_incl_sum(float v, int lane) {
#pragma unroll
    for (int o = 1; o < 64; o <<= 1) { float t = __shfl_up(v, o); if (lane >= o) v += t; }
    return v; }
DEV float wave_incl_max(float v, int lane) {
#pragma unroll
    for (int o = 1; o < 64; o <<= 1) { float t = __shfl_up(v, o); if (lane >= o) v = fmaxf(v, t); }
    return v; }
DEV f32x4 mfma16(bf16x8 a, bf16x8 b, f32x4 c) { return __builtin_amdgcn_mfma_f32_16x16x32_bf16(a, b, c, 0, 0, 0); }
DEV void unpack8(uint4 x, float (&f)[8]) { f[0] = bflo(x.x); f[1] = bfhi(x.x); f[2] = bflo(x.y); f[3] = bfhi(x.y); f[4] = bflo(x.z); f[5] = bfhi(x.z); f[6] = bflo(x.w); f[7] = bfhi(x.w); }

namespace pg8 {
constexpr int BM = 256, BK = 64, HALF = 128, HTB = HALF * BK * 2, STAGE_BYTES = 8 * HTB, NXCD = 8, WGM = 8;
DEV int lds_byte(int r, int c) { const int st = (r >> 4) * 2 + (c >> 5), rr = r & 15, cc = c & 31, ob = rr * 64 + cc * 2; return st * 1024 + (ob ^ (((ob >> 9) & 1) << 5)); }
DEV void stage_rc(int b, int& R, int& C) { const int st = b / 1024, sb = b % 1024, swz = sb ^ (((sb >> 9) & 1) << 5); R = (st >> 1) * 16 + swz / 64; C = (st & 1) * 32 + (swz % 64) / 2; }
DEV int perm32(int rho) { const int n = rho >> 4, i = rho & 15; return 8 * (i >> 2) + 4 * n + (i & 3); }
struct Unit { int pm, pn, k0, nt, ks; };
struct Gemm { const bf16_t* A; const bf16_t* Bt; int M, N, K; };
struct StaticOrder {
    int nM, nN, nwg, G, c, ntk;
    DEV void init(int M, int N, int K, int G_, int c_) { nM = M / BM; nN = N / BM; nwg = nM * nN; G = G_; c = c_; ntk = K / BK; }
    DEV bool next(int i, Unit& u) const {
        const long L = (long)i * G + c; if (L >= nwg) return false;
        int wgid = (int)L; { const int q = nwg / NXCD, r = nwg % NXCD, xcd = wgid % NXCD, off = wgid / NXCD; wgid = (xcd < r ? xcd * (q + 1) : r * (q + 1) + (xcd - r) * q) + off; }
        const int nig = WGM * nN, gid = wgid / nig, fm = gid * WGM, gsz = (nM - fm) < WGM ? (nM - fm) : WGM;
        u.pm = fm + ((wgid % nig) % gsz); u.pn = (wgid % nig) / gsz; u.k0 = 0; u.nt = ntk; u.ks = -1; return true;
    }
};
struct TailSplitOrder {
    StaticOrder so; int c, ntk;
    DEV void init(int K, int c_) { so.init(NPR, D, K, 256, c_); c = c_; ntk = K / BK; }
    DEV bool next(int i, Unit& u) const {
        if (i == 0) return so.next(0, u);
        if (i > 1) return false;
        const int tt = c >> 3, ks = c & 7; u.pm = 32 + (tt >> 3); u.pn = tt & 7; u.ks = ks;
        const int pairs = ntk >> 1, base = pairs >> 3, rem = pairs & 7;
        const int p0 = ks * base + (ks < rem ? ks : rem), np = base + (ks < rem ? 1 : 0);
        u.k0 = p0 * 128; u.nt = np * 2; return true;
    }
};
DEV unsigned cvt_pk_bf16(float lo, float hi) { unsigned r; asm volatile("v_cvt_pk_bf16_f32 %0, %1, %2" : "=v"(r) : "v"(lo), "v"(hi)); return r; }
struct EpiF32 {
    static constexpr bool PERM = false;
    float* C; int ldc; float* part;
    DEV void operator()(const f32x4 (&acc)[2][2][4][2], const Unit& u, int wr, int wc, int fr, int fq) const {
        const int row0 = u.pm * BM + wr * 64 + fr, col0 = u.pn * BM + wc * 32 + 4 * fq;
        float* Cb = u.ks < 0 ? C : part + (size_t)u.ks * NSM * D - (size_t)NPR * ldc;
#pragma unroll
        for (int ai = 0; ai < 2; ++ai)
#pragma unroll
            for (int m = 0; m < 4; ++m) { float* rowp = Cb + (size_t)(row0 + ai * HALF + m * 16) * ldc + col0;
#pragma unroll
                for (int bj = 0; bj < 2; ++bj)
#pragma unroll
                    for (int n = 0; n < 2; ++n) *(f32x4*)(rowp + bj * HALF + n * 16) = acc[ai][bj][m][n]; }
    }
};
struct EpiBf16 {
    static constexpr bool PERM = true;
    bf16_t* O; int ldc;
    DEV void operator()(const f32x4 (&acc)[2][2][4][2], const Unit& u, int wr, int wc, int fr, int fq) const {
        const int row0 = u.pm * BM + wr * 64 + fr; const int col0 = u.pn * BM + wc * 32 + 8 * fq;
#pragma unroll
        for (int ai = 0; ai < 2; ++ai)
#pragma unroll
            for (int m = 0; m < 4; ++m) { bf16_t* rowp = O + (size_t)(row0 + ai * HALF + m * 16) * ldc + col0;
#pragma unroll
                for (int bj = 0; bj < 2; ++bj) { const f32x4 v0 = acc[ai][bj][m][0], v1 = acc[ai][bj][m][1];
                    u32x4 w; w.x = cvt_pk_bf16(v0[0], v0[1]); w.y = cvt_pk_bf16(v0[2], v0[3]); w.z = cvt_pk_bf16(v1[0], v1[1]); w.w = cvt_pk_bf16(v1[2], v1[3]);
                    *(u32x4*)(rowp + bj * HALF) = w; } }
    }
};

template <class Epi, class Sched>
DEV void gemm_phase(LAS unsigned char* lds, const Gemm g, const Sched& S, const Epi& E) {
    int tid_ = threadIdx.x; asm volatile("" : "+v"(tid_)); const int tid = tid_, wid = __builtin_amdgcn_readfirstlane(tid >> 6), lane = tid & 63, wr = wid >> 2, wc = wid & 3, fr = lane & 15, fq = lane >> 4;
    const int K = g.K;
    unsigned voffA[2], voffB[2];
#pragma unroll
    for (int i = 0; i < 2; ++i) { int R, C; stage_rc(tid * 16 + i * 8192, R, C); const int Rb = Epi::PERM ? ((R & ~31) + perm32(R & 31)) : R;
        voffA[i] = (unsigned)(R * K + C) * 2u; voffB[i] = (unsigned)(Rb * K + C) * 2u; }
    const size_t kstep = (size_t)(BK * 2);
    const size_t hstep = (size_t)HALF * K * 2;
    const size_t tstep = 2 * hstep;
    const unsigned ldsw = (unsigned)wid * 1024u;
    const int aoff = lds_byte(wr * 64 + fr, fq * 8), boff = lds_byte(wc * 32 + fr, fq * 8);
#define PG8_SA(b, h) (((b) * 2 + (h)) * HTB)
#define PG8_SB(b, h) ((4 + (b) * 2 + (h)) * HTB)
#define PG8_STAGE(bufoff, gbase, voff) do { _Pragma("unroll") for (int _i = 0; _i < 2; ++_i) \
        __builtin_amdgcn_global_load_lds((const unsigned*)((const char*)(gbase) + (voff)[_i]), (LAS unsigned*)(lds + (bufoff) + ldsw + _i * 8192), 16, 0, 0); } while (0)
#define PG8_LDA(dst, b, h) do { _Pragma("unroll") for (int m = 0; m < 4; ++m) _Pragma("unroll") for (int k = 0; k < 2; ++k) dst[m][k] = *(const LAS bf16x8*)(lds + PG8_SA(b, h) + aoff + m * 2048 + k * 1024); } while (0)
#define PG8_LDB(dst, b, h) do { _Pragma("unroll") for (int n = 0; n < 2; ++n) _Pragma("unroll") for (int k = 0; k < 2; ++k) dst[n][k] = *(const LAS bf16x8*)(lds + PG8_SB(b, h) + boff + n * 2048 + k * 1024); } while (0)
#define PG8_MMA(ai, bj, At, Bt) do { __builtin_amdgcn_s_setprio(1); _Pragma("unroll") for (int m = 0; m < 4; ++m) _Pragma("unroll") for (int n = 0; n < 2; ++n) _Pragma("unroll") for (int k = 0; k < 2; ++k) \
        acc[ai][bj][m][n] = __builtin_amdgcn_mfma_f32_16x16x32_bf16(Bt[n][k], At[m][k], acc[ai][bj][m][n], 0, 0, 0); __builtin_amdgcn_s_setprio(0); } while (0)
#define PG8_WAIT_V(n) asm volatile("s_waitcnt vmcnt(" #n ")" ::: "memory")
#define PG8_WAIT_L(n) asm volatile("s_waitcnt lgkmcnt(" #n ")" ::: "memory")
#define PG8_BAR __builtin_amdgcn_s_barrier()
#define PG8_SCHED __builtin_amdgcn_sched_barrier(0)
    Unit cur, nxt; int ui = 0;
    if (!S.next(0, cur)) return;
    f32x4 acc[2][2][4][2];
#pragma unroll
    for (int a = 0; a < 2; ++a)
#pragma unroll
        for (int b = 0; b < 2; ++b)
#pragma unroll
            for (int m = 0; m < 4; ++m)
#pragma unroll
                for (int n = 0; n < 2; ++n) acc[a][b][m][n] = (f32x4){0.f, 0.f, 0.f, 0.f};
    bf16x8 At[4][2], B0[2][2], B1[2][2];
    const char* cA = (const char*)g.A + (size_t)cur.pm * tstep + (size_t)cur.k0 * 2; const char* cB = (const char*)g.Bt + (size_t)cur.pn * tstep + (size_t)cur.k0 * 2;
    PG8_STAGE(PG8_SB(0, 0), cB, voffB); PG8_STAGE(PG8_SA(0, 0), cA, voffA); PG8_STAGE(PG8_SB(0, 1), cB + hstep, voffB); PG8_STAGE(PG8_SA(0, 1), cA + hstep, voffA);
    if (wr == 1) PG8_BAR;
    PG8_WAIT_V(4); PG8_BAR;
    PG8_STAGE(PG8_SB(1, 0), cB + kstep, voffB); PG8_STAGE(PG8_SA(1, 0), cA + kstep, voffA); PG8_STAGE(PG8_SB(1, 1), cB + hstep + kstep, voffB);
    PG8_WAIT_V(6); PG8_BAR;
    for (;;) {
        const bool has_next = S.next(ui + 1, nxt);
        const char* nA = has_next ? (const char*)g.A + (size_t)nxt.pm * tstep + (size_t)nxt.k0 * 2 : cA; const char* nB = has_next ? (const char*)g.Bt + (size_t)nxt.pn * tstep + (size_t)nxt.k0 * 2 : cB;
        const int nt = cur.nt;
        for (int t = 0; t < nt; t += 2) {
            const bool last = (t == nt - 2);
            const char* a1 = cA + (size_t)(t + 1) * kstep;
            const char* a2 = last ? nA : cA + (size_t)(t + 2) * kstep; const char* b2 = last ? nB : cB + (size_t)(t + 2) * kstep;
            const char* a3 = a2 + kstep; const char* b3 = b2 + kstep;
            PG8_LDB(B0, 0, 0); PG8_SCHED; PG8_LDA(At, 0, 0); PG8_STAGE(PG8_SA(1, 1), a1 + hstep, voffA);
            PG8_WAIT_L(8); PG8_BAR; PG8_WAIT_L(0); PG8_MMA(0, 0, At, B0); PG8_BAR; PG8_SCHED;
            PG8_LDB(B1, 0, 1); PG8_STAGE(PG8_SB(0, 0), b2, voffB);
            PG8_BAR; PG8_WAIT_L(0); PG8_MMA(0, 1, At, B1); PG8_BAR;
            PG8_LDA(At, 0, 1); PG8_STAGE(PG8_SA(0, 0), a2, voffA);
            PG8_BAR; PG8_WAIT_L(0); PG8_MMA(1, 0, At, B0); PG8_BAR; PG8_SCHED;
            PG8_STAGE(PG8_SB(0, 1), b2 + hstep, voffB);
            PG8_WAIT_V(6); PG8_BAR; PG8_MMA(1, 1, At, B1); PG8_BAR;
            PG8_LDB(B0, 1, 0); PG8_SCHED; PG8_LDA(At, 1, 0); PG8_STAGE(PG8_SA(0, 1), a2 + hstep, voffA);
            PG8_WAIT_L(8); PG8_BAR; PG8_WAIT_L(0); PG8_MMA(0, 0, At, B0); PG8_BAR; PG8_SCHED;
            PG8_LDB(B1, 1, 1); PG8_STAGE(PG8_SB(1, 0), b3, voffB);
            PG8_BAR; PG8_WAIT_L(0); PG8_MMA(0, 1, At, B1); PG8_BAR;
            PG8_LDA(At, 1, 1); PG8_STAGE(PG8_SA(1, 0), a3, voffA);
            PG8_BAR; PG8_WAIT_L(0); PG8_MMA(1, 0, At, B0); PG8_BAR; PG8_SCHED;
            PG8_STAGE(PG8_SB(1, 1), b3 + hstep, voffB);
            PG8_WAIT_V(6); PG8_BAR; PG8_MMA(1, 1, At, B1); PG8_BAR;
        }
        E(acc, cur, wr, wc, fr, fq);
        if (!has_next) break;
#pragma unroll
        for (int a = 0; a < 2; ++a)
#pragma unroll
            for (int b = 0; b < 2; ++b)
#pragma unroll
                for (int m = 0; m < 4; ++m)
#pragma unroll
                    for (int n = 0; n < 2; ++n) acc[a][b][m][n] = (f32x4){0.f, 0.f, 0.f, 0.f};
        cur = nxt; cA = nA; cB = nB; ++ui;
    }
    PG8_WAIT_V(0);
    if (wr == 0) PG8_BAR;
    PG8_BAR;
#undef PG8_SA
#undef PG8_SB
#undef PG8_STAGE
#undef PG8_LDA
#undef PG8_LDB
#undef PG8_MMA
#undef PG8_WAIT_V
#undef PG8_WAIT_L
#undef PG8_BAR
#undef PG8_SCHED
}
}

DEV int win_srccol(int n) { return n < 4096 ? n : (n < 6656 ? n + 8 : (n < 6664 ? n - 2560 : (n < 6680 ? n : -1))); }
DEV void transpose_tile(const float* __restrict__ src, int srcN, bf16_t* __restrict__ dst, int K, int n0, int k0, int mode, float* tile) {
    const int tid = threadIdx.x;
#pragma unroll
    for (int i = 0; i < 2; ++i) {
        const int kk = (tid >> 4) + 32 * i, nn4 = (tid & 15) * 4, n = n0 + nn4;
        const int sc = mode ? win_srccol(n) : n;
        f32x4 v = (f32x4){0.f, 0.f, 0.f, 0.f};
        if (sc >= 0) v = *(const f32x4*)(src + (size_t)(k0 + kk) * srcN + sc);
        if (mode && n >= 1024 && n < 2048) v = v * 0.0625f;
        tile[kk * 65 + nn4 + 0] = v[0]; tile[kk * 65 + nn4 + 1] = v[1]; tile[kk * 65 + nn4 + 2] = v[2]; tile[kk * 65 + nn4 + 3] = v[3];
    }
    __syncthreads();
    {
        const int nn = tid >> 3, kk8 = (tid & 7) * 8;
        u32x4 w;
        w.x = pk2(tile[(kk8 + 0) * 65 + nn], tile[(kk8 + 1) * 65 + nn]); w.y = pk2(tile[(kk8 + 2) * 65 + nn], tile[(kk8 + 3) * 65 + nn]);
        w.z = pk2(tile[(kk8 + 4) * 65 + nn], tile[(kk8 + 5) * 65 + nn]); w.w = pk2(tile[(kk8 + 6) * 65 + nn], tile[(kk8 + 7) * 65 + nn]);
        *(u32x4*)(dst + (size_t)(n0 + nn) * K + k0 + kk8) = w;
    }
    __syncthreads();
}
DEV void phase_prologue(const P& p, unsigned char* lds) {
    float* tile = (float*)lds;
    constexpr int T_WIN = (INP / 64) * (D / 64), T_WOUT = (D / 64) * (D / 64), T_WUP = (DFF2 / 64) * (D / 64), T_WDN = (D / 64) * (DFF / 64);
    constexpr int T_L = T_WIN + T_WOUT + T_WUP + T_WDN, T_X = NTOK * D / 4096;
    const int total = 2 * T_L + T_X;
    for (int u = blockIdx.x; u < total; u += gridDim.x) {
        if (u < 2 * T_L) {
            const int l = u / T_L; int r = u % T_L;
            if (r < T_WIN) { const int nt = r / (D / 64), kt = r % (D / 64);
                transpose_tile(p.w_in + (size_t)l * D * IN_DIM, IN_DIM, (bf16_t*)(p.ws + WS_WIN) + (size_t)l * INP * D, D, nt * 64, kt * 64, 1, tile); }
            else if ((r -= T_WIN) < T_WOUT) { const int nt = r / (D / 64), kt = r % (D / 64);
                transpose_tile(p.w_out + (size_t)l * D * D, D, (bf16_t*)(p.ws + WS_WOUT) + (size_t)l * D * D, D, nt * 64, kt * 64, 0, tile); }
            else if ((r -= T_WOUT) < T_WUP) { const int nt = r / (D / 64), kt = r % (D / 64);
                transpose_tile(p.w_up + (size_t)l * D * DFF2, DFF2, (bf16_t*)(p.ws + WS_WUP) + (size_t)l * DFF2 * D, D, nt * 64, kt * 64, 0, tile); }
            else { r -= T_WUP; const int nt = r / (DFF / 64), kt = r % (DFF / 64);
                transpose_tile(p.w_down + (size_t)l * DFF * D, D, (bf16_t*)(p.ws + WS_WDN) + (size_t)l * D * DFF, DFF, nt * 64, kt * 64, 0, tile); }
        } else {
            const size_t e = (size_t)(u - 2 * T_L) * 4096 + threadIdx.x * 8;
            const float* s = e < (size_t)NPR * D ? p.x_prompt + e : p.x_sample + (e - (size_t)NPR * D);
            const f32x4 a = *(const f32x4*)s, b = *(const f32x4*)(s + 4);
            u32x4 w; w.x = pk2(a[0], a[1]); w.y = pk2(a[2], a[3]); w.z = pk2(b[0], b[1]); w.w = pk2(b[2], b[3]);
            *(u32x4*)((bf16_t*)(p.ws + WS_XB) + e) = w;
        }
    }
}

DEV void mlstm_local(const P& p, int l, int unit, unsigned char* lds) {
    const int bh = unit >> 5, c = unit & 31, b = bh >> 2, h = bh & 3;
    int tid_ = threadIdx.x; asm volatile("" : "+v"(tid_)); const int tid = tid_, lane = tid & 63, w = tid >> 6, fr = lane & 15, fq = lane >> 4;
    const bf16_t* U = (const bf16_t*)(p.ws + WS_U) + (size_t)(b * 2048 + c * 64) * INP;
    float* wsh = (float*)lds;
    bf16_t* KWt = (bf16_t*)(lds + 1024);
    bf16_t* Vt = KWt + 256 * 72;
    float* gstat = (float*)(p.ws + WS_GSTAT);
    if (w == 0) {
        const float ig = bf2f(U[(size_t)lane * INP + UIG + h]) + p.b_i[l * 4 + h];
        const float lf = logsigf_(bf2f(U[(size_t)lane * INP + UFG + h]) + p.b_f[l * 4 + h]);
        const float bs = wave_incl_sum(lf, lane);
        const float a = ig - bs;
        const float amax = wave_max(a);
        const float bsum = __shfl(bs, 63);
        wsh[lane] = expf(a - amax);
        if (lane == 0) { gstat[(bh * 32 + c) * 2] = bsum; gstat[(bh * 32 + c) * 2 + 1] = bsum + amax; }
    }
    __syncthreads();
#pragma unroll
    for (int i = 0; i < 4; ++i) {
        const int it = tid + 512 * i, s = it >> 5, d8 = (it & 31) * 8;
        const uint4 kv = *(const uint4*)(U + (size_t)s * INP + UK + h * 256 + d8);
        const uint4 vv = *(const uint4*)(U + (size_t)s * INP + UV + h * 256 + d8);
        const float ws_ = wsh[s];
        float kf[8]; unpack8(kv, kf);
        const unsigned vw[4] = {vv.x, vv.y, vv.z, vv.w};
#pragma unroll
        for (int j = 0; j < 8; ++j) {
            KWt[(d8 + j) * 72 + s] = f2bf(kf[j] * ws_);
            Vt[(d8 + j) * 72 + s] = (bf16_t)((j & 1) ? (vw[j >> 1] >> 16) : (vw[j >> 1] & 0xffffu));
        }
    }
    __syncthreads();
    if (tid < 256) { float a = 0.f; for (int s = 0; s < 64; ++s) a += bf2f(KWt[tid * 72 + s]); ((float*)(p.ws + WS_NLOC))[(size_t)(bh * 32 + c) * 256 + tid] = a; }
    f32x4 acc[2][16];
#pragma unroll
    for (int m = 0; m < 2; ++m)
#pragma unroll
        for (int n = 0; n < 16; ++n) acc[m][n] = (f32x4){0.f, 0.f, 0.f, 0.f};
#pragma unroll
    for (int k0 = 0; k0 < 64; k0 += 32) {
        bf16x8 a[2];
#pragma unroll
        for (int m = 0; m < 2; ++m) a[m] = *(const bf16x8*)(Vt + (32 * w + 16 * m + fr) * 72 + k0 + fq * 8);
#pragma unroll
        for (int n = 0; n < 16; ++n) {
            const bf16x8 bb = *(const bf16x8*)(KWt + (16 * n + fr) * 72 + k0 + fq * 8);
#pragma unroll
            for (int m = 0; m < 2; ++m) acc[m][n] = mfma16(a[m], bb, acc[m][n]);
        }
    }
    float* Dp = (float*)(p.ws + WS_DBUF) + (size_t)(bh * 32 + c) * 65536;
#pragma unroll
    for (int m = 0; m < 2; ++m)
#pragma unroll
        for (int n = 0; n < 16; ++n)
#pragma unroll
            for (int j = 0; j < 4; ++j) Dp[(32 * w + 16 * m + fq * 4 + j) * 256 + 16 * n + fr] = acc[m][n][j];
    __syncthreads();
}

DEV void mlstm_scan(const P& p, int l, int unit, unsigned char* lds) {
    int tid_ = threadIdx.x; asm volatile("" : "+v"(tid_)); const int bh = unit >> 4, slab = unit & 15, tid = tid_;
    float* fA = (float*)lds; float* fB = fA + 32;
    const float* gstat = (const float*)(p.ws + WS_GSTAT);
    if (tid == 0) {
        float m = 0.f;
        for (int c = 0; c < 32; ++c) {
            const float bsum = gstat[(bh * 32 + c) * 2], mloc = gstat[(bh * 32 + c) * 2 + 1];
            const float mn = fmaxf(bsum + m, mloc);
            fA[c] = expf(bsum + m - mn); fB[c] = expf(mloc - mn); m = mn;
            if (slab == 0) ((float*)(p.ws + WS_MST))[bh * 32 + c] = mn;
        }
        if (slab == 0) p.out[O_PM + l * 16 + bh] = m;
    }
    __syncthreads();
    const size_t e0 = (size_t)slab * 4096 + tid * 8;
    float run[8];
#pragma unroll
    for (int i = 0; i < 8; ++i) run[i] = 0.f;
    const float* Dp = (const float*)(p.ws + WS_DBUF) + (size_t)bh * 32 * 65536 + e0;
    bf16_t* Cp = (bf16_t*)(p.ws + WS_CT) + (size_t)bh * 32 * 65536 + e0;
    for (int c = 0; c < 32; ++c) {
        const f32x4 x0 = *(const f32x4*)(Dp + (size_t)c * 65536), x1 = *(const f32x4*)(Dp + (size_t)c * 65536 + 4);
        const float a = fA[c], bq = fB[c];
#pragma unroll
        for (int i = 0; i < 4; ++i) { run[i] = a * run[i] + bq * x0[i]; run[4 + i] = a * run[4 + i] + bq * x1[i]; }
        u32x4 wv; wv.x = pk2(run[0], run[1]); wv.y = pk2(run[2], run[3]); wv.z = pk2(run[4], run[5]); wv.w = pk2(run[6], run[7]);
        *(u32x4*)(Cp + (size_t)c * 65536) = wv;
    }
    {
        float* o = p.out + O_PC + (size_t)(l * 16 + bh) * 65536;
        const int e = (int)(e0 >> 8), d0 = (int)(e0 & 255);
#pragma unroll
        for (int i = 0; i < 8; ++i) o[(d0 + i) * 256 + e] = run[i];
    }
    if (slab == 0 && tid < 256) {
        float r = 0.f;
        const float* nl = (const float*)(p.ws + WS_NLOC) + (size_t)bh * 32 * 256 + tid;
        float* ns = (float*)(p.ws + WS_NST) + (size_t)bh * 32 * 256 + tid;
        for (int c = 0; c < 32; ++c) { r = fA[c] * r + fB[c] * nl[c * 256]; ns[c * 256] = r; }
        p.out[O_PN + (size_t)(l * 16 + bh) * 256 + tid] = r;
    }
    __syncthreads();
}

DEV void ssd_scan(const P& p, int l, int unit, unsigned char* lds) {
    int tid_ = threadIdx.x; asm volatile("" : "+v"(tid_)); const int bhd = unit >> 1, slab = unit & 1, tid = tid_;
    float* dec = (float*)lds;
    if (tid < 32) dec[tid] = expf(((const float*)(p.ws + WS_SBSUM))[bhd * 32 + tid]);
    __syncthreads();
    const size_t e0 = (size_t)slab * 4096 + tid * 8;
    float run[8];
#pragma unroll
    for (int i = 0; i < 8; ++i) run[i] = 0.f;
    const float* Sp = (const float*)(p.ws + WS_SBUF) + (size_t)bhd * 32 * 8192 + e0;
    bf16_t* Tp = (bf16_t*)(p.ws + WS_ST) + (size_t)bhd * 32 * 8192 + e0;
    for (int c = 0; c < 32; ++c) {
        const f32x4 x0 = *(const f32x4*)(Sp + (size_t)c * 8192), x1 = *(const f32x4*)(Sp + (size_t)c * 8192 + 4);
        const float a = dec[c];
#pragma unroll
        for (int i = 0; i < 4; ++i) { run[i] = a * run[i] + x0[i]; run[4 + i] = a * run[4 + i] + x1[i]; }
        u32x4 wv; wv.x = pk2(run[0], run[1]); wv.y = pk2(run[2], run[3]); wv.z = pk2(run[4], run[5]); wv.w = pk2(run[6], run[7]);
        *(u32x4*)(Tp + (size_t)c * 8192) = wv;
    }
    float* o = p.out + O_PS + (size_t)(l * 64 + bhd) * 8192 + e0;
    *(f32x4*)o = (f32x4){run[0], run[1], run[2], run[3]}; *(f32x4*)(o + 4) = (f32x4){run[4], run[5], run[6], run[7]};
    __syncthreads();
}

DEV void convstate_copy(const P& p, int l, int unit) {
    const bf16_t* Ub = (const bf16_t*)(p.ws + WS_U);
    for (int i = threadIdx.x; i < 3 * 1536; i += NTHR) {
        const int j = i / 1536, ch = i % 1536;
        if (unit < 4) p.out[O_PSC + ((size_t)(l * 4 + unit) * 3 + j) * 1536 + ch] = bf2f(Ub[(size_t)(unit * 2048 + 2045 + j) * INP + UXS + ch]);
        else { const int b = unit - 4; p.out[O_SSC + ((size_t)(l * 128 + b) * 3 + j) * 1536 + ch] = bf2f(Ub[(size_t)(NPR + b * 8 + 5 + j) * INP + UXS + ch]); }
    }
}

DEV void mlstm_out(const P& p, int l, int unit, unsigned char* lds) {
    const int bh = unit >> 5, c = unit & 31, b = bh >> 2, h = bh & 3;
    int tid_ = threadIdx.x; asm volatile("" : "+v"(tid_)); const int tid = tid_, lane = tid & 63, w = tid >> 6, fr = lane & 15, fq = lane >> 4;
    const int r0 = b * 2048 + c * 64;
    const bf16_t* U = (const bf16_t*)(p.ws + WS_U) + (size_t)r0 * INP;
    bf16_t* Qs = (bf16_t*)lds;
    bf16_t* Ks = Qs + 64 * 264;
    bf16_t* Vt = Ks + 64 * 264;
    bf16_t* Ss = Vt + 256 * 72;
    float* fl = (float*)(lds + 113664);
    float* bsh = fl; float* ash = fl + 64; float* mth = fl + 128; float* wint = fl + 192; float* rdn = fl + 256; float* qn = fl + 320; float* nprev = fl + 384; float* red = fl + 640;
    float* stat = fl + 1152;
    if (w == 0) {
        const float ig = bf2f(U[(size_t)lane * INP + UIG + h]) + p.b_i[l * 4 + h];
        const float lf = logsigf_(bf2f(U[(size_t)lane * INP + UFG + h]) + p.b_f[l * 4 + h]);
        const float bs = wave_incl_sum(lf, lane);
        const float a = ig - bs;
        const float cm = wave_incl_max(a, lane);
        const float mprev = c > 0 ? ((const float*)(p.ws + WS_MST))[bh * 32 + c - 1] : 0.f;
        const float mt = bs + fmaxf(mprev, cm);
        bsh[lane] = bs; ash[lane] = a; mth[lane] = mt; wint[lane] = expf(bs + mprev - mt);
    }
    if (tid >= 256) { const int d = tid - 256; nprev[d] = c > 0 ? ((const float*)(p.ws + WS_NST))[(size_t)(bh * 32 + c - 1) * 256 + d] : 0.f; }
#pragma unroll
    for (int i = 0; i < 4; ++i) {
        const int it = tid + 512 * i, s = it >> 5, d8 = (it & 31) * 8;
        *(uint4*)(Qs + s * 264 + d8) = *(const uint4*)(U + (size_t)s * INP + UQ + h * 256 + d8);
        *(uint4*)(Ks + s * 264 + d8) = *(const uint4*)(U + (size_t)s * INP + UK + h * 256 + d8);
        const uint4 vv = *(const uint4*)(U + (size_t)s * INP + UV + h * 256 + d8);
        const unsigned vw[4] = {vv.x, vv.y, vv.z, vv.w};
#pragma unroll
        for (int j = 0; j < 8; ++j) Vt[(d8 + j) * 72 + s] = (bf16_t)((j & 1) ? (vw[j >> 1] >> 16) : (vw[j >> 1] & 0xffffu));
    }
    __syncthreads();
    {
        const int mt_ = w >> 1, nt0 = (w & 1) * 2;
        f32x4 sacc[2] = {(f32x4){0.f, 0.f, 0.f, 0.f}, (f32x4){0.f, 0.f, 0.f, 0.f}};
#pragma unroll
        for (int k0 = 0; k0 < 256; k0 += 32) {
            const bf16x8 a = *(const bf16x8*)(Qs + (16 * mt_ + fr) * 264 + k0 + fq * 8);
#pragma unroll
            for (int n = 0; n < 2; ++n) { const bf16x8 bb = *(const bf16x8*)(Ks + (16 * (nt0 + n) + fr) * 264 + k0 + fq * 8); sacc[n] = mfma16(a, bb, sacc[n]); }
        }
#pragma unroll
        for (int n = 0; n < 2; ++n)
#pragma unroll
            for (int j = 0; j < 4; ++j) {
                const int t = 16 * mt_ + fq * 4 + j, s = 16 * (nt0 + n) + fr;
                const float val = (s <= t) ? sacc[n][j] * expf(bsh[t] - mth[t] + ash[s]) : 0.f;
                Ss[t * 72 + s] = f2bf(val);
            }
        const int t = tid >> 3, part = tid & 7;
        float a = 0.f;
        for (int d = part * 32; d < part * 32 + 32; ++d) a += bf2f(Qs[t * 264 + d]) * nprev[d];
        a += __shfl_xor(a, 1); a += __shfl_xor(a, 2); a += __shfl_xor(a, 4);
        if (part == 0) qn[t] = a;
    }
    __syncthreads();
    if (tid < 64) {
        float di = 0.f;
        for (int s = 0; s < 64; ++s) di += bf2f(Ss[tid * 72 + s]);
        const float den = di + wint[tid] * qn[tid];
        rdn[tid] = 1.0f / fmaxf(fabsf(den), expf(-mth[tid]));
    }
    const int e0 = 32 * w;
    f32x4 acc1[4][2], acc2[4][2];
#pragma unroll
    for (int m = 0; m < 4; ++m)
#pragma unroll
        for (int n = 0; n < 2; ++n) { acc1[m][n] = (f32x4){0.f, 0.f, 0.f, 0.f}; acc2[m][n] = (f32x4){0.f, 0.f, 0.f, 0.f}; }
#pragma unroll
    for (int k0 = 0; k0 < 64; k0 += 32) {
        bf16x8 a[4];
#pragma unroll
        for (int m = 0; m < 4; ++m) a[m] = *(const bf16x8*)(Ss + (16 * m + fr) * 72 + k0 + fq * 8);
#pragma unroll
        for (int n = 0; n < 2; ++n) { const bf16x8 bb = *(const bf16x8*)(Vt + (e0 + 16 * n + fr) * 72 + k0 + fq * 8);
#pragma unroll
            for (int m = 0; m < 4; ++m) acc1[m][n] = mfma16(a[m], bb, acc1[m][n]); }
    }
    if (c > 0) {
        const bf16_t* CTp = (const bf16_t*)(p.ws + WS_CT) + (size_t)(bh * 32 + c - 1) * 65536;
#pragma unroll 2
        for (int k0 = 0; k0 < 256; k0 += 32) {
            bf16x8 a[4];
#pragma unroll
            for (int m = 0; m < 4; ++m) a[m] = *(const bf16x8*)(Qs + (16 * m + fr) * 264 + k0 + fq * 8);
#pragma unroll
            for (int n = 0; n < 2; ++n) { const bf16x8 bb = *(const bf16x8*)(CTp + (size_t)(e0 + 16 * n + fr) * 256 + k0 + fq * 8);
#pragma unroll
                for (int m = 0; m < 4; ++m) acc2[m][n] = mfma16(a[m], bb, acc2[m][n]); }
        }
    }
    __syncthreads();
#pragma unroll
    for (int m = 0; m < 4; ++m)
#pragma unroll
        for (int j = 0; j < 4; ++j) {
            const int t = 16 * m + fq * 4 + j;
            const float wi = wint[t], rd = rdn[t];
            float s = 0.f;
#pragma unroll
            for (int n = 0; n < 2; ++n) { const float hv = (acc1[m][n][j] + wi * acc2[m][n][j]) * rd; acc1[m][n][j] = hv; s += hv; }
            s += __shfl_xor(s, 1); s += __shfl_xor(s, 2); s += __shfl_xor(s, 4); s += __shfl_xor(s, 8);
            if (fr == 0) red[t * 8 + w] = s;
        }
    __syncthreads();
    if (tid < 64) { float s = 0.f;
#pragma unroll
        for (int i = 0; i < 8; ++i) s += red[tid * 8 + i];
        stat[tid] = s * (1.0f / 256.0f); }
    __syncthreads();
#pragma unroll
    for (int m = 0; m < 4; ++m)
#pragma unroll
        for (int j = 0; j < 4; ++j) {
            const int t = 16 * m + fq * 4 + j;
            const float mu = stat[t];
            float s = 0.f;
#pragma unroll
            for (int n = 0; n < 2; ++n) { const float dv = acc1[m][n][j] - mu; acc1[m][n][j] = dv; s += dv * dv; }
            s += __shfl_xor(s, 1); s += __shfl_xor(s, 2); s += __shfl_xor(s, 4); s += __shfl_xor(s, 8);
            if (fr == 0) red[t * 8 + w] = s;
        }
    __syncthreads();
    if (tid < 64) { float s = 0.f;
#pragma unroll
        for (int i = 0; i < 8; ++i) s += red[tid * 8 + i];
        stat[64 + tid] = rsqrtf(s * (1.0f / 256.0f) + 1e-6f); }
    __syncthreads();
    bf16_t* MX = (bf16_t*)(p.ws + WS_MIXIN);
#pragma unroll
    for (int m = 0; m < 4; ++m)
#pragma unroll
        for (int j = 0; j < 4; ++j) {
            const int t = 16 * m + fq * 4 + j;
            const float rs = stat[64 + t];
#pragma unroll
            for (int n = 0; n < 2; ++n) {
                const int e = e0 + 16 * n + fr;
                const float o = bf2f(U[(size_t)t * INP + UO + h * 256 + e]);
                MX[(size_t)(r0 + t) * D + h * 256 + e] = f2bf(acc1[m][n][j] * rs * p.m_norm_w[l * 1024 + h * 256 + e] * sigmoidf_(o));
            }
        }
    __syncthreads();
}

DEV void ssd_conv8(const bf16_t* Urow, int tpos, const float* cw, const float* cb, int ch8, float (&o)[8]) {
    const f32x4 b0 = *(const f32x4*)(cb + ch8), b1 = *(const f32x4*)(cb + ch8 + 4);
    o[0] = b0[0]; o[1] = b0[1]; o[2] = b0[2]; o[3] = b0[3]; o[4] = b1[0]; o[5] = b1[1]; o[6] = b1[2]; o[7] = b1[3];
#pragma unroll
    for (int j = 0; j < 4; ++j) {
        const int back = 3 - j;
        if (tpos - back >= 0) {
            const uint4 x = *(const uint4*)(Urow - (size_t)back * INP + UXS + ch8);
            float xf[8]; unpack8(x, xf);
            const f32x4 w0 = *(const f32x4*)(cw + j * 1536 + ch8), w1 = *(const f32x4*)(cw + j * 1536 + ch8 + 4);
            o[0] += w0[0] * xf[0]; o[1] += w0[1] * xf[1]; o[2] += w0[2] * xf[2]; o[3] += w0[3] * xf[3];
            o[4] += w1[0] * xf[4]; o[5] += w1[1] * xf[5]; o[6] += w1[2] * xf[6]; o[7] += w1[3] * xf[7];
        }
    }
#pragma unroll
    for (int i = 0; i < 8; ++i) o[i] = siluf_(o[i]);
}

DEV void ssd_local(const P& p, int l, int unit, unsigned char* lds) {
    const int b = unit >> 6, g = (unit >> 5) & 1, c = unit & 31;
    int tid_ = threadIdx.x; asm volatile("" : "+v"(tid_)); const int tid = tid_, lane = tid & 63, w = tid >> 6, fr = lane & 15, fq = lane >> 4;
    const int r0 = b * 2048 + c * 64;
    const bf16_t* U = (const bf16_t*)(p.ws + WS_U) + (size_t)r0 * INP;
    bf16_t* XWt = (bf16_t*)lds;
    bf16_t* BmT = XWt + 512 * 72;
    float* wsh = (float*)(lds + 92160);
    {
        const int head = g * 8 + w;
        const float dt = softplusf_(bf2f(U[(size_t)lane * INP + UDT + head]) + p.dt_bias[l * 16 + head]);
        const float a = -expf(p.A_log[l * 16 + head]) * dt;
        const float bs = wave_incl_sum(a, lane);
        const float bL = __shfl(bs, 63);
        wsh[w * 64 + lane] = expf(bL - bs) * dt;
        if (lane == 0) ((float*)(p.ws + WS_SBSUM))[(b * 16 + head) * 32 + c] = bL;
    }
    __syncthreads();
    const float* cw = p.s_conv_w + (size_t)l * 4 * 1536; const float* cb = p.s_conv_b + (size_t)l * 1536;
    for (int i = 0; i < 10; ++i) {
        const int it = tid + 512 * i, tlo = it & 7, gsub = (it >> 3) & 7, blk = it >> 6, tb = blk & 7, gb = blk >> 3;
        const int t = tb * 8 + tlo, gidx = gb * 8 + gsub;
        const int ch8 = gidx < 64 ? g * 512 + gidx * 8 : 1024 + g * 128 + (gidx - 64) * 8;
        float v[8];
        ssd_conv8(U + (size_t)t * INP, c * 64 + t, cw, cb, ch8, v);
        if (gidx < 64) { const float sc = wsh[(gidx >> 3) * 64 + t];
#pragma unroll
            for (int k = 0; k < 8; ++k) XWt[(gidx * 8 + k) * 72 + t] = f2bf(v[k] * sc); }
        else {
#pragma unroll
            for (int k = 0; k < 8; ++k) BmT[((gidx - 64) * 8 + k) * 72 + t] = f2bf(v[k]); }
    }
    __syncthreads();
    f32x4 acc[4][8];
#pragma unroll
    for (int m = 0; m < 4; ++m)
#pragma unroll
        for (int n = 0; n < 8; ++n) acc[m][n] = (f32x4){0.f, 0.f, 0.f, 0.f};
#pragma unroll
    for (int k0 = 0; k0 < 64; k0 += 32) {
        bf16x8 a[4];
#pragma unroll
        for (int m = 0; m < 4; ++m) a[m] = *(const bf16x8*)(XWt + (64 * w + 16 * m + fr) * 72 + k0 + fq * 8);
#pragma unroll
        for (int n = 0; n < 8; ++n) { const bf16x8 bb = *(const bf16x8*)(BmT + (16 * n + fr) * 72 + k0 + fq * 8);
#pragma unroll
            for (int m = 0; m < 4; ++m) acc[m][n] = mfma16(a[m], bb, acc[m][n]); }
    }
    float* Sp = (float*)(p.ws + WS_SBUF) + (size_t)((b * 16 + g * 8 + w) * 32 + c) * 8192;
#pragma unroll
    for (int m = 0; m < 4; ++m)
#pragma unroll
        for (int n = 0; n < 8; ++n)
#pragma unroll
            for (int j = 0; j < 4; ++j) Sp[(16 * m + fq * 4 + j) * 128 + 16 * n + fr] = acc[m][n][j];
    __syncthreads();
}

DEV void ssd_out(const P& p, int l, int unit, unsigned char* lds) {
    const int b = unit >> 6, g = (unit >> 5) & 1, c = unit & 31;
    int tid_ = threadIdx.x; asm volatile("" : "+v"(tid_)); const int tid = tid_, lane = tid & 63, w = tid >> 6, fr = lane & 15, fq = lane >> 4;
    const int r0 = b * 2048 + c * 64;
    const bf16_t* U = (const bf16_t*)(p.ws + WS_U) + (size_t)r0 * INP;
    bf16_t* XsT = (bf16_t*)lds;
    bf16_t* Bm = XsT + 512 * 72;
    bf16_t* Cm = Bm + 64 * 136;
    float* CB = (float*)(lds + 108544);
    float* bsh = (float*)(lds + 125952);
    float* dtsh = bsh + 512;
    float* red = dtsh + 512;
    float* stat = red + 512;
    const int head = g * 8 + w;
    {
        const float dt = softplusf_(bf2f(U[(size_t)lane * INP + UDT + head]) + p.dt_bias[l * 16 + head]);
        const float a = -expf(p.A_log[l * 16 + head]) * dt;
        const float bs = wave_incl_sum(a, lane);
        bsh[w * 64 + lane] = bs; dtsh[w * 64 + lane] = dt;
    }
    const float* cw = p.s_conv_w + (size_t)l * 4 * 1536; const float* cb = p.s_conv_b + (size_t)l * 1536;
    for (int i = 0; i < 12; ++i) {
        const int it = tid + 512 * i, tlo = it & 7, gsub = (it >> 3) & 7, blk = it >> 6, tb = blk & 7, gb = blk >> 3;
        const int t = tb * 8 + tlo, gidx = gb * 8 + gsub;
        const int ch8 = gidx < 64 ? g * 512 + gidx * 8 : (gidx < 80 ? 1024 + g * 128 + (gidx - 64) * 8 : 1280 + g * 128 + (gidx - 80) * 8);
        float v[8];
        ssd_conv8(U + (size_t)t * INP, c * 64 + t, cw, cb, ch8, v);
        if (gidx < 64) {
#pragma unroll
            for (int k = 0; k < 8; ++k) XsT[(gidx * 8 + k) * 72 + t] = f2bf(v[k]); }
        else {
            u32x4 wv; wv.x = pk2(v[0], v[1]); wv.y = pk2(v[2], v[3]); wv.z = pk2(v[4], v[5]); wv.w = pk2(v[6], v[7]);
            if (gidx < 80) *(u32x4*)(Bm + t * 136 + (gidx - 64) * 8) = wv; else *(u32x4*)(Cm + t * 136 + (gidx - 80) * 8) = wv; }
    }
    __syncthreads();
    {
        const int mt_ = w >> 1, nt0 = (w & 1) * 2;
        f32x4 cacc[2] = {(f32x4){0.f, 0.f, 0.f, 0.f}, (f32x4){0.f, 0.f, 0.f, 0.f}};
#pragma unroll
        for (int k0 = 0; k0 < 128; k0 += 32) {
            const bf16x8 a = *(const bf16x8*)(Cm + (16 * mt_ + fr) * 136 + k0 + fq * 8);
#pragma unroll
            for (int n = 0; n < 2; ++n) { const bf16x8 bb = *(const bf16x8*)(Bm + (16 * (nt0 + n) + fr) * 136 + k0 + fq * 8); cacc[n] = mfma16(a, bb, cacc[n]); }
        }
#pragma unroll
        for (int n = 0; n < 2; ++n)
#pragma unroll
            for (int j = 0; j < 4; ++j) CB[(16 * mt_ + fq * 4 + j) * 68 + 16 * (nt0 + n) + fr] = cacc[n][j];
    }
    __syncthreads();
    f32x4 acc1[4][4], acc2[4][4];
#pragma unroll
    for (int m = 0; m < 4; ++m)
#pragma unroll
        for (int n = 0; n < 4; ++n) { acc1[m][n] = (f32x4){0.f, 0.f, 0.f, 0.f}; acc2[m][n] = (f32x4){0.f, 0.f, 0.f, 0.f}; }
#pragma unroll
    for (int m = 0; m < 4; ++m)
#pragma unroll
        for (int ks = 0; ks < 2; ++ks) {
            if (ks * 32 > 16 * m + 15) continue;
            const int t = 16 * m + fr, s0 = 32 * ks + fq * 8;
            const float bt = bsh[w * 64 + t];
            const f32x4 c0 = *(const f32x4*)(CB + t * 68 + s0), c1 = *(const f32x4*)(CB + t * 68 + s0 + 4);
            float mv[8];
#pragma unroll
            for (int i = 0; i < 8; ++i) { const int s = s0 + i; const float cv = i < 4 ? c0[i & 3] : c1[i & 3];
                mv[i] = (s <= t) ? cv * expf(bt - bsh[w * 64 + s]) * dtsh[w * 64 + s] : 0.f; }
            union { u32x4 u; bf16x8 v; } af;
            af.u.x = pk2(mv[0], mv[1]); af.u.y = pk2(mv[2], mv[3]); af.u.z = pk2(mv[4], mv[5]); af.u.w = pk2(mv[6], mv[7]);
#pragma unroll
            for (int n = 0; n < 4; ++n) { const bf16x8 bb = *(const bf16x8*)(XsT + (64 * w + 16 * n + fr) * 72 + 32 * ks + fq * 8); acc1[m][n] = mfma16(af.v, bb, acc1[m][n]); }
        }
    if (c > 0) {
        const bf16_t* STp = (const bf16_t*)(p.ws + WS_ST) + (size_t)((b * 16 + head) * 32 + c - 1) * 8192;
#pragma unroll
        for (int k0 = 0; k0 < 128; k0 += 32) {
            bf16x8 a[4];
#pragma unroll
            for (int m = 0; m < 4; ++m) a[m] = *(const bf16x8*)(Cm + (16 * m + fr) * 136 + k0 + fq * 8);
#pragma unroll
            for (int n = 0; n < 4; ++n) { const bf16x8 bb = *(const bf16x8*)(STp + (16 * n + fr) * 128 + k0 + fq * 8);
#pragma unroll
                for (int m = 0; m < 4; ++m) acc2[m][n] = mfma16(a[m], bb, acc2[m][n]); }
        }
    }
    const float dsk = p.D_skip[l * 16 + head];
#pragma unroll
    for (int m = 0; m < 4; ++m)
#pragma unroll
        for (int j = 0; j < 4; ++j) {
            const int t = 16 * m + fq * 4 + j;
            const float eb = expf(bsh[w * 64 + t]);
            float s = 0.f;
#pragma unroll
            for (int n = 0; n < 4; ++n) {
                const int pp = 16 * n + fr;
                const float y = acc1[m][n][j] + eb * acc2[m][n][j] + dsk * bf2f(XsT[(64 * w + pp) * 72 + t]);
                const float z = bf2f(U[(size_t)t * INP + UZ + g * 512 + w * 64 + pp]);
                const float gt = y * siluf_(z);
                acc1[m][n][j] = gt; s += gt * gt;
            }
            s += __shfl_xor(s, 1); s += __shfl_xor(s, 2); s += __shfl_xor(s, 4); s += __shfl_xor(s, 8);
            if (fr == 0) red[t * 8 + w] = s;
        }
    __syncthreads();
    if (tid < 64) { float s = 0.f;
#pragma unroll
        for (int i = 0; i < 8; ++i) s += red[tid * 8 + i];
        stat[tid] = rsqrtf(s * (1.0f / 512.0f) + 1e-6f); }
    __syncthreads();
    bf16_t* MX = (bf16_t*)(p.ws + WS_MIXIN);
#pragma unroll
    for (int m = 0; m < 4; ++m)
#pragma unroll
        for (int j = 0; j < 4; ++j) {
            const int t = 16 * m + fq * 4 + j;
            const float rs = stat[t];
#pragma unroll
            for (int n = 0; n < 4; ++n) {
                const int ch = g * 512 + w * 64 + 16 * n + fr;
                MX[(size_t)(r0 + t) * D + 1024 + ch] = f2bf(acc1[m][n][j] * rs * p.s_norm_w[l * 1024 + ch]);
            }
        }
    __syncthreads();
}

DEV void smp_mlstm(const P& p, int l, int unit, unsigned char* lds) {
    const int b = unit >> 2, h = unit & 3;
    int tid_ = threadIdx.x; asm volatile("" : "+v"(tid_)); const int tid = tid_, lane = tid & 63, w = tid >> 6;
    const int r0 = NPR + b * 8;
    const bf16_t* U = (const bf16_t*)(p.ws + WS_U) + (size_t)r0 * INP;
    float* qn = (float*)lds; float* kn = qn + 2048; float* vn = kn + 2048; float* qT = vn + 2048; float* kwT = qT + 2048; float* sc = kwT + 2048; float* red = sc + 256;
    const size_t sidx = (size_t)(l * 128 + b) * 4 + h;
    const float* C0 = p.st_C + sidx * 65536; const float* n0 = p.st_n + sidx * 256;
    float* Cout = p.out + O_SC + sidx * 65536;
    if (tid == 0) {
        const float m0 = p.st_m[sidx];
        float bs = 0.f, cm = -INFINITY, mt = 0.f;
        for (int t = 0; t < 8; ++t) {
            const float ig = bf2f(U[(size_t)t * INP + UIG + h]) + p.b_i[l * 4 + h];
            const float lf = logsigf_(bf2f(U[(size_t)t * INP + UFG + h]) + p.b_f[l * 4 + h]);
            bs += lf; const float a = ig - bs; cm = fmaxf(cm, a); mt = bs + fmaxf(m0, cm);
            sc[32 + t] = mt; sc[t] = expf(bs + m0 - mt); sc[40 + t] = a; sc[48 + t] = bs;
        }
        for (int s = 0; s < 8; ++s) sc[16 + s] = expf(bs + sc[40 + s] - mt);
        sc[24] = expf(bs + m0 - mt);
        p.out[O_SM + sidx] = mt;
    }
    __syncthreads();
#pragma unroll
    for (int i = 0; i < 4; ++i) {
        const int idx = tid + 512 * i, t = idx >> 8, d = idx & 255;
        const float q = bf2f(U[(size_t)t * INP + UQ + h * 256 + d]), k = bf2f(U[(size_t)t * INP + UK + h * 256 + d]), v = bf2f(U[(size_t)t * INP + UV + h * 256 + d]);
        qn[t * 256 + d] = q; kn[t * 256 + d] = k; vn[t * 256 + d] = v; qT[d * 8 + t] = q; kwT[d * 8 + t] = k * sc[16 + t];
    }
    __syncthreads();
    {
        const int t = w;
        const f32x4 qv = *(const f32x4*)(qn + t * 256 + lane * 4);
        float dot[9];
#pragma unroll
        for (int s = 0; s < 8; ++s) { const f32x4 kv = *(const f32x4*)(kn + s * 256 + lane * 4); dot[s] = qv[0] * kv[0] + qv[1] * kv[1] + qv[2] * kv[2] + qv[3] * kv[3]; }
        { const f32x4 nv = *(const f32x4*)(n0 + lane * 4); dot[8] = qv[0] * nv[0] + qv[1] * nv[1] + qv[2] * nv[2] + qv[3] * nv[3]; }
#pragma unroll
        for (int s = 0; s < 9; ++s) dot[s] = wave_sum(dot[s]);
        float den = 0.f;
#pragma unroll
        for (int s = 0; s < 8; ++s) { const float sv = (s <= t) ? dot[s] * expf(sc[48 + t] - sc[32 + t] + sc[40 + s]) : 0.f; den += sv; if (lane == 0) sc[64 + t * 8 + s] = sv; }
        den += sc[t] * dot[8];
        if (lane == 0) sc[8 + t] = 1.0f / fmaxf(fabsf(den), expf(-sc[32 + t]));
    }
    if (tid < 256) {
        float a = sc[24] * n0[tid];
#pragma unroll
        for (int s = 0; s < 8; ++s) a += kwT[tid * 8 + s];
        p.out[O_SN + sidx * 256 + tid] = a;
    }
    const int e4 = lane * 4;
    f32x4 num[8], vv[8];
#pragma unroll
    for (int t = 0; t < 8; ++t) { num[t] = (f32x4){0.f, 0.f, 0.f, 0.f}; vv[t] = *(const f32x4*)(vn + t * 256 + e4); }
    const float decay = sc[24];
#pragma unroll 4
    for (int i = 0; i < 32; ++i) {
        const int d = w + 8 * i;
        const f32x4 cc = *(const f32x4*)(C0 + (size_t)d * 256 + e4);
        const f32x4 q0 = *(const f32x4*)(qT + d * 8), q1 = *(const f32x4*)(qT + d * 8 + 4), k0 = *(const f32x4*)(kwT + d * 8), k1 = *(const f32x4*)(kwT + d * 8 + 4);
        f32x4 cn = cc * decay;
#pragma unroll
        for (int t = 0; t < 4; ++t) { num[t] += cc * q0[t]; num[4 + t] += cc * q1[t]; cn += vv[t] * k0[t]; cn += vv[4 + t] * k1[t]; }
        *(f32x4*)(Cout + (size_t)d * 256 + e4) = cn;
    }
#pragma unroll
    for (int t = 0; t < 8; ++t) *(f32x4*)(red + (w * 8 + t) * 256 + e4) = num[t];
    __syncthreads();
    {
        const int t = w;
        f32x4 hv = (f32x4){0.f, 0.f, 0.f, 0.f};
#pragma unroll
        for (int ww = 0; ww < 8; ++ww) hv += *(const f32x4*)(red + (ww * 8 + t) * 256 + e4);
        hv = hv * sc[t];
#pragma unroll
        for (int s = 0; s < 8; ++s) hv += vv[s] * sc[64 + t * 8 + s];
        hv = hv * sc[8 + t];
        const float mu = wave_sum(hv[0] + hv[1] + hv[2] + hv[3]) * (1.0f / 256.0f);
        const f32x4 dv = hv - mu;
        const float var = wave_sum(dv[0] * dv[0] + dv[1] * dv[1] + dv[2] * dv[2] + dv[3] * dv[3]) * (1.0f / 256.0f);
        const float rs = rsqrtf(var + 1e-6f);
        const uint2 ov = *(const uint2*)(U + (size_t)t * INP + UO + h * 256 + e4);
        const f32x4 nw = *(const f32x4*)(p.m_norm_w + l * 1024 + h * 256 + e4);
        const float o0 = dv[0] * rs * nw[0] * sigmoidf_(bflo(ov.x)), o1 = dv[1] * rs * nw[1] * sigmoidf_(bfhi(ov.x));
        const float o2 = dv[2] * rs * nw[2] * sigmoidf_(bflo(ov.y)), o3 = dv[3] * rs * nw[3] * sigmoidf_(bfhi(ov.y));
        u32x2 wv; wv.x = pk2(o0, o1); wv.y = pk2(o2, o3);
        *(u32x2*)((bf16_t*)(p.ws + WS_MIXIN) + (size_t)(r0 + t) * D + h * 256 + e4) = wv;
    }
    __syncthreads();
}

DEV void smp_ssd(const P& p, int l, int unit, unsigned char* lds) {
    const int b = unit >> 1, g = unit & 1;
    int tid_ = threadIdx.x; asm volatile("" : "+v"(tid_)); const int tid = tid_, lane = tid & 63, w = tid >> 6, fr = lane & 15, fq = lane >> 4;
    const int r0 = NPR + b * 8;
    const bf16_t* U = (const bf16_t*)(p.ws + WS_U) + (size_t)r0 * INP;
    float* xs = (float*)lds;
    float* xwT = xs + 4096;
    float* Bmf = xwT + 4096;
    float* CBs = Bmf + 1024;
    float* bsh = CBs + 64;
    float* dtsh = bsh + 64;
    float* bLs = dtsh + 64;
    float* MW = bLs + 64;
    float* red = MW + 512;
    float* stat = red + 64;
    bf16_t* Cmb = (bf16_t*)(stat + 64);
    if (tid < 64) {
        const int hd = tid >> 3, t = tid & 7, head = g * 8 + hd;
        const float A = -expf(p.A_log[l * 16 + head]), dtb = p.dt_bias[l * 16 + head];
        float bs = 0.f, bL = 0.f, dtt = 0.f;
        for (int s = 0; s < 8; ++s) { const float dt = softplusf_(bf2f(U[(size_t)s * INP + UDT + head]) + dtb); bL += dt * A; if (s <= t) bs += dt * A; if (s == t) dtt = dt; }
        bsh[hd * 8 + t] = bs; dtsh[hd * 8 + t] = dtt; if (t == 0) bLs[hd] = bL;
    }
    for (int i = tid; i < 8 * 136 / 2; i += NTHR) ((unsigned*)(Cmb + 8 * 136))[i] = 0u;
    const float* cw = p.s_conv_w + (size_t)l * 4 * 1536; const float* cb = p.s_conv_b + (size_t)l * 1536;
    const float* cv0 = p.st_sconv + (size_t)(l * 128 + b) * 3 * 1536;
    for (int i = 0; i < 2; ++i) {
        const int it = tid + 512 * i;
        if (it < 768) {
            const int t = it / 96, gidx = it % 96;
            const int ch8 = gidx < 64 ? g * 512 + gidx * 8 : (gidx < 80 ? 1024 + g * 128 + (gidx - 64) * 8 : 1280 + g * 128 + (gidx - 80) * 8);
            float o[8];
            { const f32x4 b0 = *(const f32x4*)(cb + ch8), b1 = *(const f32x4*)(cb + ch8 + 4); o[0] = b0[0]; o[1] = b0[1]; o[2] = b0[2]; o[3] = b0[3]; o[4] = b1[0]; o[5] = b1[1]; o[6] = b1[2]; o[7] = b1[3]; }
#pragma unroll
            for (int j = 0; j < 4; ++j) {
                const int idx = t + j;
                float xf[8];
                if (idx < 3) { const f32x4 a0 = *(const f32x4*)(cv0 + idx * 1536 + ch8), a1 = *(const f32x4*)(cv0 + idx * 1536 + ch8 + 4);
                    xf[0] = a0[0]; xf[1] = a0[1]; xf[2] = a0[2]; xf[3] = a0[3]; xf[4] = a1[0]; xf[5] = a1[1]; xf[6] = a1[2]; xf[7] = a1[3]; }
                else { const uint4 x = *(const uint4*)(U + (size_t)(idx - 3) * INP + UXS + ch8); unpack8(x, xf); }
                const f32x4 w0 = *(const f32x4*)(cw + j * 1536 + ch8), w1 = *(const f32x4*)(cw + j * 1536 + ch8 + 4);
                o[0] += w0[0] * xf[0]; o[1] += w0[1] * xf[1]; o[2] += w0[2] * xf[2]; o[3] += w0[3] * xf[3];
                o[4] += w1[0] * xf[4]; o[5] += w1[1] * xf[5]; o[6] += w1[2] * xf[6]; o[7] += w1[3] * xf[7];
            }
#pragma unroll
            for (int k = 0; k < 8; ++k) o[k] = siluf_(o[k]);
            if (gidx < 64) {
#pragma unroll
                for (int k = 0; k < 8; ++k) xs[t * 512 + gidx * 8 + k] = o[k]; }
            else if (gidx < 80) {
#pragma unroll
                for (int k = 0; k < 8; ++k) Bmf[t * 128 + (gidx - 64) * 8 + k] = o[k]; }
            else { u32x4 wv; wv.x = pk2(o[0], o[1]); wv.y = pk2(o[2], o[3]); wv.z = pk2(o[4], o[5]); wv.w = pk2(o[6], o[7]); *(u32x4*)(Cmb + t * 136 + (gidx - 80) * 8) = wv; }
        }
    }
    __syncthreads();
#pragma unroll
    for (int i = 0; i < 8; ++i) {
        const int idx = tid + 512 * i, hp = idx >> 3, s = idx & 7, hd = hp >> 6;
        xwT[hp * 8 + s] = xs[s * 512 + hp] * expf(bLs[hd] - bsh[hd * 8 + s]) * dtsh[hd * 8 + s];
    }
    if (tid < 64) {
        const int t = tid >> 3, s = tid & 7; float a = 0.f;
        for (int n = 0; n < 128; ++n) a += bf2f(Cmb[t * 136 + n]) * Bmf[s * 128 + n];
        CBs[t * 8 + s] = a;
    }
    __syncthreads();
    { const int hd = tid >> 6, t = (tid >> 3) & 7, s = tid & 7;
      MW[tid] = (s <= t) ? CBs[t * 8 + s] * expf(bsh[hd * 8 + t] - bsh[hd * 8 + s]) * dtsh[hd * 8 + s] : 0.f; }
    __syncthreads();
    const int head = g * 8 + w;
    const size_t sidx = (size_t)(l * 128 + b) * 16 + head;
    const float* S0 = p.st_ssm + sidx * 8192; float* So = p.out + O_SS + sidx * 8192;
    const float dA = expf(bLs[w]);
    f32x4 acc[4];
#pragma unroll
    for (int nt = 0; nt < 4; ++nt) {
        acc[nt] = (f32x4){0.f, 0.f, 0.f, 0.f};
        const int pp = 16 * nt + fr;
        const f32x4 xw0 = *(const f32x4*)(xwT + (64 * w + pp) * 8), xw1 = *(const f32x4*)(xwT + (64 * w + pp) * 8 + 4);
#pragma unroll 1
        for (int ks = 0; ks < 4; ++ks) {
            const int n0 = 32 * ks + fq * 8;
            const f32x4 s0 = *(const f32x4*)(S0 + pp * 128 + n0), s1 = *(const f32x4*)(S0 + pp * 128 + n0 + 4);
            union { u32x4 u; bf16x8 v; } bfr;
            bfr.u.x = pk2(s0[0], s0[1]); bfr.u.y = pk2(s0[2], s0[3]); bfr.u.z = pk2(s1[0], s1[1]); bfr.u.w = pk2(s1[2], s1[3]);
            const bf16x8 af = *(const bf16x8*)(Cmb + fr * 136 + n0);
            acc[nt] = mfma16(af, bfr.v, acc[nt]);
            f32x4 o0 = s0 * dA, o1 = s1 * dA;
#pragma unroll
            for (int s = 0; s < 8; ++s) {
                const float xv = s < 4 ? xw0[s & 3] : xw1[s & 3];
                const f32x4 bm0 = *(const f32x4*)(Bmf + s * 128 + n0), bm1 = *(const f32x4*)(Bmf + s * 128 + n0 + 4);
                o0 += bm0 * xv; o1 += bm1 * xv;
            }
            *(f32x4*)(So + pp * 128 + n0) = o0; *(f32x4*)(So + pp * 128 + n0 + 4) = o1;
        }
    }
    const float dsk = p.D_skip[l * 16 + head];
    float gts[4][4];
#pragma unroll
    for (int j = 0; j < 4; ++j) {
        const int t = (fq & 1) * 4 + j;
        const float eb = expf(bsh[w * 8 + t]);
        float ssq = 0.f;
#pragma unroll
        for (int nt = 0; nt < 4; ++nt) {
            const int hp = 64 * w + 16 * nt + fr;
            float y = eb * acc[nt][j] + dsk * xs[t * 512 + hp];
#pragma unroll
            for (int s = 0; s < 8; ++s) y += MW[(w * 8 + t) * 8 + s] * xs[s * 512 + hp];
            const float z = bf2f(U[(size_t)t * INP + UZ + g * 512 + hp]);
            const float gt = y * siluf_(z);
            gts[nt][j] = gt; ssq += gt * gt;
        }
        ssq += __shfl_xor(ssq, 1); ssq += __shfl_xor(ssq, 2); ssq += __shfl_xor(ssq, 4); ssq += __shfl_xor(ssq, 8);
        if (fr == 0 && fq < 2) red[t * 8 + w] = ssq;
    }
    __syncthreads();
    if (tid < 8) { float s = 0.f;
#pragma unroll
        for (int i = 0; i < 8; ++i) s += red[tid * 8 + i];
        stat[tid] = rsqrtf(s * (1.0f / 512.0f) + 1e-6f); }
    __syncthreads();
    if (fq < 2) {
        bf16_t* MX = (bf16_t*)(p.ws + WS_MIXIN);
#pragma unroll
        for (int j = 0; j < 4; ++j) {
            const int t = fq * 4 + j;
#pragma unroll
            for (int nt = 0; nt < 4; ++nt) {
                const int ch = g * 512 + 64 * w + 16 * nt + fr;
                MX[(size_t)(r0 + t) * D + 1024 + ch] = f2bf(gts[nt][j] * stat[t] * p.s_norm_w[l * 1024 + ch]);
            }
        }
    }
    __syncthreads();
}

DEV void phase_ln(const P& p, int l, int which) {
    const int lane = threadIdx.x & 63, w = threadIdx.x >> 6;
    const float* gam = (which ? p.ln2_g : p.ln1_g) + l * D; const float* bet = (which ? p.ln2_b : p.ln1_b) + l * D;
    const float* mix = (const float*)(p.ws + WS_MIXF);
    float* xf = (float*)(p.ws + WS_XF); bf16_t* xb = (bf16_t*)(p.ws + WS_XB);
    const bool first = (l == 0 && which == 0), lastp = (l == 1 && which == 1), split = (gridDim.x == 256);
    for (int r = blockIdx.x * 8 + w; r < NTOK; r += gridDim.x * 8) {
        const float* src = first ? (r < NPR ? p.x_prompt + (size_t)r * D : p.x_sample + (size_t)(r - NPR) * D) : xf + (size_t)r * D;
        float* dst = lastp ? p.out + (size_t)r * D : xf + (size_t)r * D;
        f32x4 y[8]; float s = 0.f;
#pragma unroll
        for (int i = 0; i < 8; ++i) { const int cidx = i * 256 + lane * 4;
            f32x4 mv;
            if (split && r >= NPR) { const float* pp = (const float*)(p.ws + WS_PART) + (size_t)(r - NPR) * D + cidx; mv = *(const f32x4*)pp;
#pragma unroll
                for (int k = 1; k < 8; ++k) mv += *(const f32x4*)(pp + (size_t)k * NSM * D); }
            else mv = *(const f32x4*)(mix + (size_t)r * D + cidx);
            y[i] = *(const f32x4*)(src + cidx) * ALPHA + mv; s += (y[i][0] + y[i][1]) + (y[i][2] + y[i][3]); }
        const float mu = wave_sum(s) * (1.0f / D);
        float q = 0.f;
#pragma unroll
        for (int i = 0; i < 8; ++i) { y[i] = y[i] - mu; q += (y[i][0] * y[i][0] + y[i][1] * y[i][1]) + (y[i][2] * y[i][2] + y[i][3] * y[i][3]); }
        const float rs = rsqrtf(wave_sum(q) * (1.0f / D) + 1e-5f);
#pragma unroll
        for (int i = 0; i < 8; ++i) { const int cidx = i * 256 + lane * 4;
            const f32x4 o = y[i] * rs * *(const f32x4*)(gam + cidx) + *(const f32x4*)(bet + cidx);
            *(f32x4*)(dst + cidx) = o;
            u32x2 wv; wv.x = pk2(o[0], o[1]); wv.y = pk2(o[2], o[3]);
            *(u32x2*)(xb + (size_t)r * D + cidx) = wv; }
    }
}

DEV void phase_ffn_gate(const P& p, int l) {
    const bf16_t* up = (const bf16_t*)(p.ws + WS_UP); bf16_t* act = (bf16_t*)(p.ws + WS_ACT);
    const float* fw = p.f_conv_w + (size_t)l * 3 * DFF2; const float* fb = p.f_conv_b + (size_t)l * DFF2;
    const int total = (NTOK / 8) * (DFF / 8);
    for (int it = blockIdx.x * NTHR + threadIdx.x; it < total; it += gridDim.x * NTHR) {
        const int rb = it / (DFF / 8), j8 = (it % (DFF / 8)) * 8, r0 = rb * 8;
        const bool smp = r0 >= NPR; const int t0 = smp ? 0 : (r0 & 2047); const int sb = (r0 - NPR) >> 3;
        float wg[3][8], wv[3][8], bg[8], bv[8];
#pragma unroll
        for (int k = 0; k < 3; ++k) {
            const f32x4 a0 = *(const f32x4*)(fw + k * DFF2 + j8), a1 = *(const f32x4*)(fw + k * DFF2 + j8 + 4), c0 = *(const f32x4*)(fw + k * DFF2 + DFF + j8), c1 = *(const f32x4*)(fw + k * DFF2 + DFF + j8 + 4);
#pragma unroll
            for (int i = 0; i < 4; ++i) { wg[k][i] = a0[i]; wg[k][4 + i] = a1[i]; wv[k][i] = c0[i]; wv[k][4 + i] = c1[i]; }
        }
        { const f32x4 a0 = *(const f32x4*)(fb + j8), a1 = *(const f32x4*)(fb + j8 + 4), c0 = *(const f32x4*)(fb + DFF + j8), c1 = *(const f32x4*)(fb + DFF + j8 + 4);
#pragma unroll
          for (int i = 0; i < 4; ++i) { bg[i] = a0[i]; bg[4 + i] = a1[i]; bv[i] = c0[i]; bv[4 + i] = c1[i]; } }
        float g0[8], g1[8], v0[8], v1[8];
        if (t0 > 0) {
            unpack8(*(const uint4*)(up + (size_t)(r0 - 2) * DFF2 + j8), g0); unpack8(*(const uint4*)(up + (size_t)(r0 - 2) * DFF2 + DFF + j8), v0);
            unpack8(*(const uint4*)(up + (size_t)(r0 - 1) * DFF2 + j8), g1); unpack8(*(const uint4*)(up + (size_t)(r0 - 1) * DFF2 + DFF + j8), v1);
        } else if (smp) {
            const float* bp = p.st_fconv + (size_t)(l * 128 + sb) * 2 * DFF2;
            const f32x4 a0 = *(const f32x4*)(bp + j8), a1 = *(const f32x4*)(bp + j8 + 4), c0 = *(const f32x4*)(bp + DFF + j8), c1 = *(const f32x4*)(bp + DFF + j8 + 4);
            const f32x4 d0 = *(const f32x4*)(bp + DFF2 + j8), d1 = *(const f32x4*)(bp + DFF2 + j8 + 4), e0 = *(const f32x4*)(bp + DFF2 + DFF + j8), e1 = *(const f32x4*)(bp + DFF2 + DFF + j8 + 4);
#pragma unroll
            for (int i = 0; i < 4; ++i) { g0[i] = a0[i]; g0[4 + i] = a1[i]; v0[i] = c0[i]; v0[4 + i] = c1[i]; g1[i] = d0[i]; g1[4 + i] = d1[i]; v1[i] = e0[i]; v1[4 + i] = e1[i]; }
        } else {
#pragma unroll
            for (int i = 0; i < 8; ++i) { g0[i] = 0.f; g1[i] = 0.f; v0[i] = 0.f; v1[i] = 0.f; }
        }
#pragma unroll
        for (int rr = 0; rr < 8; ++rr) {
            float g2[8], v2[8];
            unpack8(*(const uint4*)(up + (size_t)(r0 + rr) * DFF2 + j8), g2); unpack8(*(const uint4*)(up + (size_t)(r0 + rr) * DFF2 + DFF + j8), v2);
            float o[8];
#pragma unroll
            for (int i = 0; i < 8; ++i) {
                const float ag = bg[i] + wg[0][i] * g0[i] + wg[1][i] * g1[i] + wg[2][i] * g2[i];
                const float av = bv[i] + wv[0][i] * v0[i] + wv[1][i] * v1[i] + wv[2][i] * v2[i];
                o[i] = ag * __builtin_amdgcn_rcpf(1.0f + __expf(-ag)) * av;
                g0[i] = g1[i]; g1[i] = g2[i]; v0[i] = v1[i]; v1[i] = v2[i];
            }
            u32x4 wv4; wv4.x = pk2(o[0], o[1]); wv4.y = pk2(o[2], o[3]); wv4.z = pk2(o[4], o[5]); wv4.w = pk2(o[6], o[7]);
            *(u32x4*)(act + (size_t)(r0 + rr) * DFF + j8) = wv4;
        }
    }
    const int tot2 = 132 * 2 * (DFF2 / 8);
    for (int it = blockIdx.x * NTHR + threadIdx.x; it < tot2; it += gridDim.x * NTHR) {
        const int c8 = (it % (DFF2 / 8)) * 8, rr = it / (DFF2 / 8), j = rr & 1, sq = rr >> 1;
        float* o; size_t row;
        if (sq < 4) { o = p.out + O_PFC + ((size_t)(l * 4 + sq) * 2 + j) * DFF2 + c8; row = (size_t)sq * 2048 + 2046 + j; }
        else { const int b = sq - 4; o = p.out + O_SFC + ((size_t)(l * 128 + b) * 2 + j) * DFF2 + c8; row = (size_t)NPR + b * 8 + 6 + j; }
        float xf[8]; unpack8(*(const uint4*)(up + row * DFF2 + c8), xf);
        *(f32x4*)o = (f32x4){xf[0], xf[1], xf[2], xf[3]}; *(f32x4*)(o + 4) = (f32x4){xf[4], xf[5], xf[6], xf[7]};
    }
}


#define XB_TMO      128
#define XB_XCNT(j)  (256  + 64 * (j))
#define XB_XSUB(j)  (1280 + 64 * (j))
#define XB_XGEN(j)  (2304 + 64 * (j))
#define XB_TOP      3328
#define XB_TOPGEN   3392
#define XCD_BAR_WORDS 3456
#define XB_SPIN_CAP (1u << 20)
DEV unsigned xb_ld(unsigned* p)              { return __hip_atomic_load(p, __ATOMIC_RELAXED, __HIP_MEMORY_SCOPE_AGENT); }
DEV unsigned xb_add(unsigned* p, unsigned v) { return __hip_atomic_fetch_add(p, v, __ATOMIC_RELAXED, __HIP_MEMORY_SCOPE_AGENT); }
DEV unsigned xb_xcc_id() { return (unsigned)__builtin_amdgcn_s_getreg((3 << 11) | 20) & 0xFu; }
#define XB_SPIN(cond, bar) do { unsigned _sp = 0; while (cond) { __builtin_amdgcn_s_sleep(1); \
    if ((++_sp & 255u) == 0u) { if (xb_ld(&(bar)[XB_TMO])) break; if (_sp > XB_SPIN_CAP) { atomicAdd(&(bar)[XB_TMO], 1u); break; } } } } while (0)
struct XcdBarrier { unsigned* bar; unsigned x; volatile LAS unsigned* st; };
DEV XcdBarrier xcd_barrier_post(unsigned* bar, volatile LAS unsigned* st) {
    XcdBarrier b; b.bar = bar; b.x = xb_xcc_id(); b.st = st;
    if (threadIdx.x == 0) (void)xb_add(&bar[XB_XCNT(b.x)], 1u);
    return b;
}
DEV void xcd_barrier_complete(unsigned* bar, unsigned x, unsigned& nloc, unsigned& nx) {
    const unsigned G = gridDim.x * gridDim.y * gridDim.z;
    unsigned sum, cnt, mine, sp = 0u;
    for (;;) {
        sum = 0u; cnt = 0u; mine = 0u;
#pragma unroll
        for (unsigned j = 0; j < 16; ++j) { const unsigned c = xb_ld(&bar[XB_XCNT(j)]); sum += c; cnt += (c > 0u) ? 1u : 0u; mine = (j == x) ? c : mine; }
        if (sum == G) break;
        __builtin_amdgcn_s_sleep(1);
        if ((++sp & 255u) == 0u) { if (xb_ld(&bar[XB_TMO])) break; if (sp > XB_SPIN_CAP) { atomicAdd(&bar[XB_TMO], 1u); break; } }
    }
    nloc = mine > 0u ? mine : 1u; nx = cnt > 0u ? cnt : 1u;
}
DEV void xcd_barrier(const XcdBarrier& b) {
    asm volatile("s_waitcnt vmcnt(0)" ::: "memory");
    __syncthreads();
    if (threadIdx.x == 0) {
        unsigned* bar = b.bar;
        __builtin_amdgcn_s_waitcnt(0);
        unsigned nloc = b.st[0], nx = b.st[1];
        if (nloc == 0u) { xcd_barrier_complete(bar, b.x, nloc, nx); b.st[0] = nloc; b.st[1] = nx; }
        const unsigned old = xb_add(&bar[XB_XSUB(b.x)], 1u);
        const unsigned gen = old / nloc;
        if (old + 1u == (gen + 1u) * nloc) {
            __builtin_amdgcn_fence(__ATOMIC_RELEASE, "agent");
            asm volatile("s_waitcnt vmcnt(0)" ::: "memory");
            const unsigned og = xb_add(&bar[XB_TOP], 1u);
            const unsigned tg = og / nx;
            if (og + 1u == (tg + 1u) * nx) xb_add(&bar[XB_TOPGEN], 1u);
            else XB_SPIN(xb_ld(&bar[XB_TOPGEN]) == tg, bar);
            __builtin_amdgcn_fence(__ATOMIC_ACQUIRE, "agent");
            xb_add(&bar[XB_XGEN(b.x)], 1u);
            asm volatile("s_waitcnt vmcnt(0)" ::: "memory");
        } else {
            XB_SPIN(xb_ld(&bar[XB_XGEN(b.x)]) == gen, bar);
            __builtin_amdgcn_fence(__ATOMIC_ACQUIRE, "agent");
            asm volatile("s_waitcnt vmcnt(0)" ::: "memory");
        }
    }
    __syncthreads();
}

constexpr int NPHASE = 21;
DEV void run_phase(const P& p, int l, int q, unsigned char* lds) {
    int bid = blockIdx.x, G = gridDim.x; asm volatile("" : "+s"(bid), "+s"(G));
    if (q == 0) {
        pg8::Gemm g{(const bf16_t*)(p.ws + WS_XB), (const bf16_t*)(p.ws + WS_WIN) + (size_t)l * INP * D, NTOK, INP, D};
        pg8::StaticOrder S; S.init(NTOK, INP, D, G, bid);
        pg8::EpiBf16 E{(bf16_t*)(p.ws + WS_U), INP};
        pg8::gemm_phase<pg8::EpiBf16, pg8::StaticOrder>((LAS unsigned char*)lds, g, S, E);
    } else if (q == 1) {
        for (int u = bid; u < 512; u += G) smp_mlstm(p, l, u, lds);
        for (int u = bid; u < 256; u += G) smp_ssd(p, l, u, lds);
        for (int u = bid; u < 512; u += G) mlstm_local(p, l, u, lds);
        for (int u = bid; u < 256; u += G) ssd_local(p, l, u, lds);
    } else if (q == 2) {
        for (int u = bid; u < 256; u += G) mlstm_scan(p, l, u, lds);
        for (int u = bid; u < 128; u += G) ssd_scan(p, l, u, lds);
        for (int u = bid; u < 132; u += G) convstate_copy(p, l, u);
    } else if (q == 3) {
        for (int u = bid; u < 512; u += G) mlstm_out(p, l, u, lds);
        for (int u = bid; u < 256; u += G) ssd_out(p, l, u, lds);
    } else if (q == 4) {
        pg8::Gemm g{(const bf16_t*)(p.ws + WS_MIXIN), (const bf16_t*)(p.ws + WS_WOUT) + (size_t)l * D * D, NTOK, D, D};
        pg8::EpiF32 E{(float*)(p.ws + WS_MIXF), D, (float*)(p.ws + WS_PART)};
        if (G == 256) { pg8::TailSplitOrder S; S.init(D, bid); pg8::gemm_phase<pg8::EpiF32, pg8::TailSplitOrder>((LAS unsigned char*)lds, g, S, E); }
        else { pg8::StaticOrder S; S.init(NTOK, D, D, G, bid); pg8::gemm_phase<pg8::EpiF32, pg8::StaticOrder>((LAS unsigned char*)lds, g, S, E); }
    } else if (q == 5) {
        phase_ln(p, l, 0);
    } else if (q == 6) {
        pg8::Gemm g{(const bf16_t*)(p.ws + WS_XB), (const bf16_t*)(p.ws + WS_WUP) + (size_t)l * DFF2 * D, NTOK, DFF2, D};
        pg8::StaticOrder S; S.init(NTOK, DFF2, D, G, bid);
        pg8::EpiBf16 E{(bf16_t*)(p.ws + WS_UP), DFF2};
        pg8::gemm_phase<pg8::EpiBf16, pg8::StaticOrder>((LAS unsigned char*)lds, g, S, E);
    } else if (q == 7) {
        phase_ffn_gate(p, l);
    } else if (q == 8) {
        pg8::Gemm g{(const bf16_t*)(p.ws + WS_ACT), (const bf16_t*)(p.ws + WS_WDN) + (size_t)l * D * DFF, NTOK, D, DFF};
        pg8::EpiF32 E{(float*)(p.ws + WS_MIXF), D, (float*)(p.ws + WS_PART)};
        if (G == 256) { pg8::TailSplitOrder S; S.init(DFF, bid); pg8::gemm_phase<pg8::EpiF32, pg8::TailSplitOrder>((LAS unsigned char*)lds, g, S, E); }
        else { pg8::StaticOrder S; S.init(NTOK, D, DFF, G, bid); pg8::gemm_phase<pg8::EpiF32, pg8::StaticOrder>((LAS unsigned char*)lds, g, S, E); }
    } else {
        phase_ln(p, l, 1);
    }
}
#if MK_MULTI
template <int Q> __global__ void __launch_bounds__(NTHR, 2) k_phase(P p) {
    extern __shared__ __attribute__((aligned(16))) unsigned char lds[];
    if (Q < 0) phase_prologue(p, lds); else run_phase(p, p.ph_lo, Q, lds);
}
#else
__global__ void __launch_bounds__(NTHR, 2) mk_fwd(P p) {
    extern __shared__ __attribute__((aligned(16))) unsigned char lds[];
    cg::grid_group grid = cg::this_grid();
    if (p.ph_hi < 0) grid.sync();
    if (threadIdx.x < 4) ((unsigned*)(lds + LDS_BYTES - 16))[threadIdx.x] = 0u;
    __syncthreads();
    (void)xcd_barrier_post((unsigned*)(p.ws + WS_BAR), (volatile LAS unsigned*)(lds + LDS_BYTES - 16));
#define GSYNC() do { XcdBarrier b_; b_.bar = (unsigned*)(p.ws + WS_BAR); b_.x = xb_xcc_id(); b_.st = (volatile LAS unsigned*)(lds + LDS_BYTES - 16); xcd_barrier(b_); } while (0)
    phase_prologue(p, lds);
#pragma unroll 1
    for (int l = 0; l < 2; ++l) {
        GSYNC(); run_phase(p, l, 0, lds);
        GSYNC(); run_phase(p, l, 1, lds);
        GSYNC(); run_phase(p, l, 2, lds);
        GSYNC(); run_phase(p, l, 3, lds);
        GSYNC(); run_phase(p, l, 4, lds);
        GSYNC(); run_phase(p, l, 5, lds);
        GSYNC(); run_phase(p, l, 6, lds);
        GSYNC(); run_phase(p, l, 7, lds);
        GSYNC(); run_phase(p, l, 8, lds);
        GSYNC(); run_phase(p, l, 9, lds);
    }
    for (int i = 0; i < PROBE_SYNCS; ++i) GSYNC();
}
#endif

extern "C" void kernel_launch(void* const* d_in, const int* in_sizes, int n_in, void* d_out, int out_size, void* d_ws, size_t ws_size, hipStream_t stream) {
    static int grid = 0;
    if (grid == 0) {
        if (n_in != 27 || ws_size < WS_END) { fprintf(stderr, "kernel_launch: unexpected n_in %d or ws_size %zu (need %zu)\n", n_in, ws_size, (size_t)WS_END); grid = -1; return; }
        int dev = 0, cus = 0, per_cu = 0;
        hipGetDevice(&dev);
        hipDeviceGetAttribute(&cus, hipDeviceAttributeMultiprocessorCount, dev);
#if MK_MULTI
        const void* fns[11] = {(const void*)k_phase<-1>, (const void*)k_phase<0>, (const void*)k_phase<1>, (const void*)k_phase<2>, (const void*)k_phase<3>, (const void*)k_phase<4>, (const void*)k_phase<5>,
                               (const void*)k_phase<6>, (const void*)k_phase<7>, (const void*)k_phase<8>, (const void*)k_phase<9>};
        for (int i = 0; i < 11; ++i) if (hipFuncSetAttribute(fns[i], hipFuncAttributeMaxDynamicSharedMemorySize, LDS_BYTES) != hipSuccess) { fprintf(stderr, "kernel_launch: hipFuncSetAttribute failed\n"); grid = -1; return; }
#else
        if (hipFuncSetAttribute((const void*)mk_fwd, hipFuncAttributeMaxDynamicSharedMemorySize, LDS_BYTES) != hipSuccess) { fprintf(stderr, "kernel_launch: hipFuncSetAttribute failed\n"); grid = -1; return; }
        hipOccupancyMaxActiveBlocksPerMultiprocessor(&per_cu, (const void*)mk_fwd, NTHR, LDS_BYTES);
        (void)hipGetLastError();
#endif
        (void)per_cu;
        grid = cus * 1;
    }
    if (grid < 0) return;
    P p{};
    const float** pp = (const float**)&p;
    for (int i = 0; i < 27; ++i) pp[i] = (const float*)d_in[i];
    p.out = (float*)d_out; p.ws = (unsigned char*)d_ws;
#if MK_MULTI
    p.ph_lo = 0; p.ph_hi = 0;
    if (PROBE_REP == -1) hipLaunchKernelGGL(k_phase<-1>, dim3(grid), dim3(NTHR), LDS_BYTES, stream, p);
    hipLaunchKernelGGL(k_phase<-1>, dim3(grid), dim3(NTHR), LDS_BYTES, stream, p);
    for (int l = 0; l < 2; ++l) {
        p.ph_lo = l;
        for (int rep = 0; rep < 1 + ((PROBE_REP == 0) || (PROBE_REP == 100 && (0 == 0 || 0 == 4 || 0 == 6 || 0 == 8))); ++rep) hipLaunchKernelGGL(k_phase<0>, dim3(grid), dim3(NTHR), LDS_BYTES, stream, p);
        for (int rep = 0; rep < 1 + ((PROBE_REP == 1) || (PROBE_REP == 100 && (1 == 0 || 1 == 4 || 1 == 6 || 1 == 8))); ++rep) hipLaunchKernelGGL(k_phase<1>, dim3(grid), dim3(NTHR), LDS_BYTES, stream, p);
        for (int rep = 0; rep < 1 + ((PROBE_REP == 2) || (PROBE_REP == 100 && (2 == 0 || 2 == 4 || 2 == 6 || 2 == 8))); ++rep) hipLaunchKernelGGL(k_phase<2>, dim3(grid), dim3(NTHR), LDS_BYTES, stream, p);
        for (int rep = 0; rep < 1 + ((PROBE_REP == 3) || (PROBE_REP == 100 && (3 == 0 || 3 == 4 || 3 == 6 || 3 == 8))); ++rep) hipLaunchKernelGGL(k_phase<3>, dim3(grid), dim3(NTHR), LDS_BYTES, stream, p);
        for (int rep = 0; rep < 1 + ((PROBE_REP == 4) || (PROBE_REP == 100 && (4 == 0 || 4 == 4 || 4 == 6 || 4 == 8))); ++rep) hipLaunchKernelGGL(k_phase<4>, dim3(grid), dim3(NTHR), LDS_BYTES, stream, p);
        for (int rep = 0; rep < 1 + ((PROBE_REP == 5) || (PROBE_REP == 100 && (5 == 0 || 5 == 4 || 5 == 6 || 5 == 8))); ++rep) hipLaunchKernelGGL(k_phase<5>, dim3(grid), dim3(NTHR), LDS_BYTES, stream, p);
        for (int rep = 0; rep < 1 + ((PROBE_REP == 6) || (PROBE_REP == 100 && (6 == 0 || 6 == 4 || 6 == 6 || 6 == 8))); ++rep) hipLaunchKernelGGL(k_phase<6>, dim3(grid), dim3(NTHR), LDS_BYTES, stream, p);
        for (int rep = 0; rep < 1 + ((PROBE_REP == 7) || (PROBE_REP == 100 && (7 == 0 || 7 == 4 || 7 == 6 || 7 == 8))); ++rep) hipLaunchKernelGGL(k_phase<7>, dim3(grid), dim3(NTHR), LDS_BYTES, stream, p);
        for (int rep = 0; rep < 1 + ((PROBE_REP == 8) || (PROBE_REP == 100 && (8 == 0 || 8 == 4 || 8 == 6 || 8 == 8))); ++rep) hipLaunchKernelGGL(k_phase<8>, dim3(grid), dim3(NTHR), LDS_BYTES, stream, p);
        for (int rep = 0; rep < 1 + ((PROBE_REP == 9) || (PROBE_REP == 100 && (9 == 0 || 9 == 4 || 9 == 6 || 9 == 8))); ++rep) hipLaunchKernelGGL(k_phase<9>, dim3(grid), dim3(NTHR), LDS_BYTES, stream, p);
    }
#else
    p.ph_lo = 0; p.ph_hi = NPHASE;
    if (hipMemsetAsync((char*)d_ws + WS_BAR, 0, 16384, stream) != hipSuccess) { fprintf(stderr, "kernel_launch: memset failed\n"); return; }
    void* args[] = {&p};
    hipError_t e = hipLaunchCooperativeKernel((const void*)mk_fwd, dim3(grid), dim3(NTHR), args, LDS_BYTES, stream);
    if (e != hipSuccess) fprintf(stderr, "cooperative launch failed: %s (grid %d)\n", hipGetErrorString(e), grid);
#endif
}
```

```cpp
#include <hip/hip_runtime.h>
#include <hip/hip_cooperative_groups.h>
#include <cstdio>
namespace cg = cooperative_groups;

#ifndef MK_MULTI
#define MK_MULTI 0
#endif
#ifndef PROBE_REP
#define PROBE_REP -99
#endif
#ifndef PROBE_SYNCS
#define PROBE_SYNCS 0
#endif

#define DEV __device__ __forceinline__
#define LAS __attribute__((address_space(3)))
typedef unsigned short bf16_t;
typedef short bf16x8 __attribute__((ext_vector_type(8)));
typedef float f32x4 __attribute__((ext_vector_type(4)));
typedef float f32x2 __attribute__((ext_vector_type(2)));
typedef unsigned u32x4 __attribute__((ext_vector_type(4)));
typedef unsigned u32x2 __attribute__((ext_vector_type(2)));

constexpr int D = 2048, NPR = 8192, NSM = 1024, NTOK = 9216, INP = 6912, IN_DIM = 6680, DFF = 5504, DFF2 = 11008;
constexpr int UQ = 0, UK = 1024, UV = 2048, UO = 3072, UZ = 4096, UXS = 5120, UIG = 6656, UFG = 6660, UDT = 6664;
constexpr int NTHR = 512;
constexpr int LDS_BYTES = 136 * 1024;
constexpr float ALPHA = 1.41421356237309515f;

constexpr size_t O_YP = 0;
constexpr size_t O_YS = O_YP + (size_t)4 * 2048 * 2048;
constexpr size_t O_PC = O_YS + (size_t)128 * 8 * 2048;
constexpr size_t O_PN = O_PC + (size_t)2 * 4 * 4 * 256 * 256;
constexpr size_t O_PM = O_PN + (size_t)2 * 4 * 4 * 256;
constexpr size_t O_PS = O_PM + (size_t)2 * 4 * 4;
constexpr size_t O_PSC = O_PS + (size_t)2 * 4 * 16 * 64 * 128;
constexpr size_t O_PFC = O_PSC + (size_t)2 * 4 * 3 * 1536;
constexpr size_t O_SC = O_PFC + (size_t)2 * 4 * 2 * DFF2;
constexpr size_t O_SN = O_SC + (size_t)2 * 128 * 4 * 256 * 256;
constexpr size_t O_SM = O_SN + (size_t)2 * 128 * 4 * 256;
constexpr size_t O_SS = O_SM + (size_t)2 * 128 * 4;
constexpr size_t O_SSC = O_SS + (size_t)2 * 128 * 16 * 64 * 128;
constexpr size_t O_SFC = O_SSC + (size_t)2 * 128 * 3 * 1536;

constexpr size_t WS_WIN = 0;
constexpr size_t WS_WOUT = WS_WIN + (size_t)2 * INP * D * 2;
constexpr size_t WS_WUP = WS_WOUT + (size_t)2 * D * D * 2;
constexpr size_t WS_WDN = WS_WUP + (size_t)2 * DFF2 * D * 2;
constexpr size_t WS_XB = WS_WDN + (size_t)2 * D * DFF * 2;
constexpr size_t WS_XF = WS_XB + (size_t)NTOK * D * 2;
constexpr size_t WS_U = WS_XF + (size_t)NTOK * D * 4;
constexpr size_t WS_MIXIN = WS_U + (size_t)NTOK * INP * 2;
constexpr size_t WS_MIXF = WS_MIXIN + (size_t)NTOK * D * 2;
constexpr size_t WS_UP = WS_MIXF + (size_t)NTOK * D * 4;
constexpr size_t WS_ACT = WS_UP + (size_t)NTOK * DFF2 * 2;
constexpr size_t WS_PART = WS_ACT + (size_t)NTOK * DFF * 2;
constexpr size_t WS_SMALL = WS_PART + (size_t)8 * NSM * D * 4;
constexpr size_t WS_DBUF = WS_UP;
constexpr size_t WS_SBUF = WS_UP + (size_t)512 * 65536 * 4;
constexpr size_t WS_CT = WS_ACT;
constexpr size_t WS_ST = WS_ACT + (size_t)512 * 65536 * 2;
static_assert(WS_SBUF + (size_t)2048 * 8192 * 4 <= WS_ACT, "alias");
static_assert(WS_ST + (size_t)2048 * 8192 * 2 <= WS_PART, "alias");
constexpr size_t WS_NLOC = WS_SMALL;
constexpr size_t WS_NST = WS_NLOC + (size_t)512 * 256 * 4;
constexpr size_t WS_GSTAT = WS_NST + (size_t)512 * 256 * 4;
constexpr size_t WS_MST = WS_GSTAT + 4096;
constexpr size_t WS_SBSUM = WS_MST + 4096;
constexpr size_t WS_BAR = WS_SBSUM + 8192;
constexpr size_t WS_END = WS_BAR + 16384;

struct P {
    const float* x_prompt; const float* x_sample; const float* st_C; const float* st_n; const float* st_m; const float* st_ssm; const float* st_sconv; const float* st_fconv;
    const float* w_in; const float* b_i; const float* b_f; const float* m_norm_w; const float* s_conv_w; const float* s_conv_b; const float* dt_bias; const float* A_log; const float* D_skip;
    const float* s_norm_w; const float* w_out; const float* ln1_g; const float* ln1_b; const float* w_up; const float* f_conv_w; const float* f_conv_b; const float* w_down; const float* ln2_g; const float* ln2_b;
    float* out; unsigned char* ws; int ph_lo, ph_hi;
};

DEV float bf2f(bf16_t v) { return __uint_as_float(((unsigned)v) << 16); }
DEV bf16_t f2bf(float f) { unsigned u = __float_as_uint(f); u += 0x7FFFu + ((u >> 16) & 1u); return (bf16_t)(u >> 16); }
DEV unsigned pk2(float lo, float hi) { return (unsigned)f2bf(lo) | ((unsigned)f2bf(hi) << 16); }
DEV float bflo(unsigned w) { return __uint_as_float(w << 16); }
DEV float bfhi(unsigned w) { return __uint_as_float(w & 0xffff0000u); }
DEV float sigmoidf_(float x) { return __builtin_amdgcn_rcpf(1.0f + __expf(-x)); }
DEV float siluf_(float x) { return x * sigmoidf_(x); }
DEV float softplusf_(float x) { return fmaxf(x, 0.f) + log1pf(expf(-fabsf(x))); }
DEV float logsigf_(float x) { return fminf(x, 0.f) - log1pf(expf(-fabsf(x))); }
DEV float wave_sum(float v) {
#pragma unroll
    for (int o = 32; o >= 1; o >>= 1) v += __shfl_xor(v, o);
    return v; }
DEV float wave_max(float v) {
#pragma unroll
    for (int o = 32; o >= 1; o >>= 1) v = fmaxf(v, __shfl_xor(v, o));
    return v; }
DEV float wave_incl_sum(float v, int lane) {
#pragma unroll
    for (int o = 1; o < 64; o <<= 1) { float t = __shfl_up(v, o); if (lane >= o) v += t; }
    return v; }
DEV float wave_incl_max(float v, int lane) {
#pragma unroll
    for (int o = 1; o < 64; o <<= 1) { float t = __shfl_up(v, o); if (lane >= o) v = fmaxf(v, t); }
    return v; }
DEV f32x4 mfma16(bf16x8 a, bf16x8 b, f32x4 c) { return __builtin_amdgcn_mfma_f32_16x16x32_bf16(a, b, c, 0, 0, 0); }
DEV void unpack8(uint4 x, float (&f)[8]) { f[0] = bflo(x.x); f[1] = bfhi(x.x); f[2] = bflo(x.y); f[3] = bfhi(x.y); f[4] = bflo(x.z); f[5] = bfhi(x.z); f[6] = bflo(x.w); f[7] = bfhi(x.w); }

typedef short s16x4 __attribute__((ext_vector_type(4)));
DEV bf16x8 tr_frag(const bf16_t* T, int pitch, int krow0, int col0, int lane) {
    const int g = lane >> 4, q = (lane & 15) >> 2, pl = lane & 3;
    const bf16_t* a0 = T + (krow0 + 8 * g + q) * pitch + col0 + 4 * pl;
    const s16x4 lo = __builtin_amdgcn_ds_read_tr16_b64_v4i16((LAS s16x4*)a0);
    const s16x4 hi = __builtin_amdgcn_ds_read_tr16_b64_v4i16((LAS s16x4*)(a0 + 4 * pitch));
    return (bf16x8){lo[0], lo[1], lo[2], lo[3], hi[0], hi[1], hi[2], hi[3]};
}

namespace pg8 {
constexpr int BM = 256, BK = 64, HALF = 128, HTB = HALF * BK * 2, STAGE_BYTES = 8 * HTB, NXCD = 8, WGM = 8;
DEV int lds_byte(int r, int c) { const int st = (r >> 4) * 2 + (c >> 5), rr = r & 15, cc = c & 31, ob = rr * 64 + cc * 2; return st * 1024 + (ob ^ (((ob >> 9) & 1) << 5)); }
DEV void stage_rc(int b, int& R, int& C) { const int st = b / 1024, sb = b % 1024, swz = sb ^ (((sb >> 9) & 1) << 5); R = (st >> 1) * 16 + swz / 64; C = (st & 1) * 32 + (swz % 64) / 2; }
DEV int perm32(int rho) { const int n = rho >> 4, i = rho & 15; return 8 * (i >> 2) + 4 * n + (i & 3); }
struct Unit { int pm, pn, k0, nt, ks; };
struct Gemm { const bf16_t* A; const bf16_t* Bt; int M, N, K; };
struct StaticOrder {
    int nM, nN, nwg, G, c, ntk;
    DEV void init(int M, int N, int K, int G_, int c_) { nM = M / BM; nN = N / BM; nwg = nM * nN; G = G_; c = c_; ntk = K / BK; }
    DEV bool next(int i, Unit& u) const {
        const long L = (long)i * G + c; if (L >= nwg) return false;
        int wgid = (int)L; { const int q = nwg / NXCD, r = nwg % NXCD, xcd = wgid % NXCD, off = wgid / NXCD; wgid = (xcd < r ? xcd * (q + 1) : r * (q + 1) + (xcd - r) * q) + off; }
        const int nig = WGM * nN, gid = wgid / nig, fm = gid * WGM, gsz = (nM - fm) < WGM ? (nM - fm) : WGM;
        u.pm = fm + ((wgid % nig) % gsz); u.pn = (wgid % nig) / gsz; u.k0 = 0; u.nt = ntk; u.ks = -1; return true;
    }
};
struct TailSplitOrder {
    StaticOrder so; int c, ntk;
    DEV void init(int K, int c_) { so.init(NPR, D, K, 256, c_); c = c_; ntk = K / BK; }
    DEV bool next(int i, Unit& u) const {
        if (i == 0) return so.next(0, u);
        if (i > 1) return false;
        const int tt = c >> 3, ks = c & 7; u.pm = 32 + (tt >> 3); u.pn = tt & 7; u.ks = ks;
        const int pairs = ntk >> 1, base = pairs >> 3, rem = pairs & 7;
        const int p0 = ks * base + (ks < rem ? ks : rem), np = base + (ks < rem ? 1 : 0);
        u.k0 = p0 * 128; u.nt = np * 2; return true;
    }
};
DEV unsigned cvt_pk_bf16(float lo, float hi) { unsigned r; asm volatile("v_cvt_pk_bf16_f32 %0, %1, %2" : "=v"(r) : "v"(lo), "v"(hi)); return r; }
struct EpiF32 {
    static constexpr bool PERM = false;
    float* C; int ldc; float* part;
    DEV void operator()(const f32x4 (&acc)[2][2][4][2], const Unit& u, int wr, int wc, int fr, int fq) const {
        const int row0 = u.pm * BM + wr * 64 + fr, col0 = u.pn * BM + wc * 32 + 4 * fq;
        float* Cb = u.ks < 0 ? C : part + (size_t)u.ks * NSM * D - (size_t)NPR * ldc;
#pragma unroll
        for (int ai = 0; ai < 2; ++ai)
#pragma unroll
            for (int m = 0; m < 4; ++m) { float* rowp = Cb + (size_t)(row0 + ai * HALF + m * 16) * ldc + col0;
#pragma unroll
                for (int bj = 0; bj < 2; ++bj)
#pragma unroll
                    for (int n = 0; n < 2; ++n) *(f32x4*)(rowp + bj * HALF + n * 16) = acc[ai][bj][m][n]; }
    }
};
struct EpiBf16 {
    static constexpr bool PERM = true;
    bf16_t* O; int ldc;
    DEV void operator()(const f32x4 (&acc)[2][2][4][2], const Unit& u, int wr, int wc, int fr, int fq) const {
        const int row0 = u.pm * BM + wr * 64 + fr; const int col0 = u.pn * BM + wc * 32 + 8 * fq;
#pragma unroll
        for (int ai = 0; ai < 2; ++ai)
#pragma unroll
            for (int m = 0; m < 4; ++m) { bf16_t* rowp = O + (size_t)(row0 + ai * HALF + m * 16) * ldc + col0;
#pragma unroll
                for (int bj = 0; bj < 2; ++bj) { const f32x4 v0 = acc[ai][bj][m][0], v1 = acc[ai][bj][m][1];
                    u32x4 w; w.x = cvt_pk_bf16(v0[0], v0[1]); w.y = cvt_pk_bf16(v0[2], v0[3]); w.z = cvt_pk_bf16(v1[0], v1[1]); w.w = cvt_pk_bf16(v1[2], v1[3]);
                    *(u32x4*)(rowp + bj * HALF) = w; } }
    }
};

template <class Epi, class Sched>
DEV void gemm_phase(LAS unsigned char* lds, const Gemm g, const Sched& S, const Epi& E) {
    int tid_ = threadIdx.x; asm volatile("" : "+v"(tid_)); const int tid = tid_, wid = __builtin_amdgcn_readfirstlane(tid >> 6), lane = tid & 63, wr = wid >> 2, wc = wid & 3, fr = lane & 15, fq = lane >> 4;
    const int K = g.K;
    unsigned voffA[2], voffB[2];
#pragma unroll
    for (int i = 0; i < 2; ++i) { int R, C; stage_rc(tid * 16 + i * 8192, R, C); const int Rb = Epi::PERM ? ((R & ~31) + perm32(R & 31)) : R;
        voffA[i] = (unsigned)(R * K + C) * 2u; voffB[i] = (unsigned)(Rb * K + C) * 2u; }
    const size_t kstep = (size_t)(BK * 2);
    const size_t hstep = (size_t)HALF * K * 2;
    const size_t tstep = 2 * hstep;
    const unsigned ldsw = (unsigned)wid * 1024u;
    const int aoff = lds_byte(wr * 64 + fr, fq * 8), boff = lds_byte(wc * 32 + fr, fq * 8);
#define PG8_SA(b, h) (((b) * 2 + (h)) * HTB)
#define PG8_SB(b, h) ((4 + (b) * 2 + (h)) * HTB)
#define PG8_STAGE(bufoff, gbase, voff) do { _Pragma("unroll") for (int _i = 0; _i < 2; ++_i) \
        __builtin_amdgcn_global_load_lds((const unsigned*)((const char*)(gbase) + (voff)[_i]), (LAS unsigned*)(lds + (bufoff) + ldsw + _i * 8192), 16, 0, 0); } while (0)
#define PG8_LDA(dst, b, h) do { _Pragma("unroll") for (int m = 0; m < 4; ++m) _Pragma("unroll") for (int k = 0; k < 2; ++k) dst[m][k] = *(const LAS bf16x8*)(lds + PG8_SA(b, h) + aoff + m * 2048 + k * 1024); } while (0)
#define PG8_LDB(dst, b, h) do { _Pragma("unroll") for (int n = 0; n < 2; ++n) _Pragma("unroll") for (int k = 0; k < 2; ++k) dst[n][k] = *(const LAS bf16x8*)(lds + PG8_SB(b, h) + boff + n * 2048 + k * 1024); } while (0)
#define PG8_MMA(ai, bj, At, Bt) do { __builtin_amdgcn_s_setprio(1); _Pragma("unroll") for (int m = 0; m < 4; ++m) _Pragma("unroll") for (int n = 0; n < 2; ++n) _Pragma("unroll") for (int k = 0; k < 2; ++k) \
        acc[ai][bj][m][n] = __builtin_amdgcn_mfma_f32_16x16x32_bf16(Bt[n][k], At[m][k], acc[ai][bj][m][n], 0, 0, 0); __builtin_amdgcn_s_setprio(0); } while (0)
#define PG8_WAIT_V(n) asm volatile("s_waitcnt vmcnt(" #n ")" ::: "memory")
#define PG8_WAIT_L(n) asm volatile("s_waitcnt lgkmcnt(" #n ")" ::: "memory")
#define PG8_BAR __builtin_amdgcn_s_barrier()
#define PG8_SCHED __builtin_amdgcn_sched_barrier(0)
    Unit cur, nxt; int ui = 0;
    if (!S.next(0, cur)) return;
    f32x4 acc[2][2][4][2];
#pragma unroll
    for (int a = 0; a < 2; ++a)
#pragma unroll
        for (int b = 0; b < 2; ++b)
#pragma unroll
            for (int m = 0; m < 4; ++m)
#pragma unroll
                for (int n = 0; n < 2; ++n) acc[a][b][m][n] = (f32x4){0.f, 0.f, 0.f, 0.f};
    bf16x8 At[4][2], B0[2][2], B1[2][2];
    const char* cA = (const char*)g.A + (size_t)cur.pm * tstep + (size_t)cur.k0 * 2; const char* cB = (const char*)g.Bt + (size_t)cur.pn * tstep + (size_t)cur.k0 * 2;
    PG8_STAGE(PG8_SB(0, 0), cB, voffB); PG8_STAGE(PG8_SA(0, 0), cA, voffA); PG8_STAGE(PG8_SB(0, 1), cB + hstep, voffB); PG8_STAGE(PG8_SA(0, 1), cA + hstep, voffA);
    if (wr == 1) PG8_BAR;
    PG8_WAIT_V(4); PG8_BAR;
    PG8_STAGE(PG8_SB(1, 0), cB + kstep, voffB); PG8_STAGE(PG8_SA(1, 0), cA + kstep, voffA); PG8_STAGE(PG8_SB(1, 1), cB + hstep + kstep, voffB);
    PG8_WAIT_V(6); PG8_BAR;
    for (;;) {
        const bool has_next = S.next(ui + 1, nxt);
        const char* nA = has_next ? (const char*)g.A + (size_t)nxt.pm * tstep + (size_t)nxt.k0 * 2 : cA; const char* nB = has_next ? (const char*)g.Bt + (size_t)nxt.pn * tstep + (size_t)nxt.k0 * 2 : cB;
        const int nt = cur.nt;
        for (int t = 0; t < nt; t += 2) {
            const bool last = (t == nt - 2);
            const char* a1 = cA + (size_t)(t + 1) * kstep;
            const char* a2 = last ? nA : cA + (size_t)(t + 2) * kstep; const char* b2 = last ? nB : cB + (size_t)(t + 2) * kstep;
            const char* a3 = a2 + kstep; const char* b3 = b2 + kstep;
            PG8_LDB(B0, 0, 0); PG8_SCHED; PG8_LDA(At, 0, 0); PG8_STAGE(PG8_SA(1, 1), a1 + hstep, voffA);
            PG8_WAIT_L(8); PG8_BAR; PG8_WAIT_L(0); PG8_MMA(0, 0, At, B0); PG8_BAR; PG8_SCHED;
            PG8_LDB(B1, 0, 1); PG8_STAGE(PG8_SB(0, 0), b2, voffB);
            PG8_BAR; PG8_WAIT_L(0); PG8_MMA(0, 1, At, B1); PG8_BAR;
            PG8_LDA(At, 0, 1); PG8_STAGE(PG8_SA(0, 0), a2, voffA);
            PG8_BAR; PG8_WAIT_L(0); PG8_MMA(1, 0, At, B0); PG8_BAR; PG8_SCHED;
            PG8_STAGE(PG8_SB(0, 1), b2 + hstep, voffB);
            PG8_WAIT_V(6); PG8_BAR; PG8_MMA(1, 1, At, B1); PG8_BAR;
            PG8_LDB(B0, 1, 0); PG8_SCHED; PG8_LDA(At, 1, 0); PG8_STAGE(PG8_SA(0, 1), a2 + hstep, voffA);
            PG8_WAIT_L(8); PG8_BAR; PG8_WAIT_L(0); PG8_MMA(0, 0, At, B0); PG8_BAR; PG8_SCHED;
            PG8_LDB(B1, 1, 1); PG8_STAGE(PG8_SB(1, 0), b3, voffB);
            PG8_BAR; PG8_WAIT_L(0); PG8_MMA(0, 1, At, B1); PG8_BAR;
            PG8_LDA(At, 1, 1); PG8_STAGE(PG8_SA(1, 0), a3, voffA);
            PG8_BAR; PG8_WAIT_L(0); PG8_MMA(1, 0, At, B0); PG8_BAR; PG8_SCHED;
            PG8_STAGE(PG8_SB(1, 1), b3 + hstep, voffB);
            PG8_WAIT_V(6); PG8_BAR; PG8_MMA(1, 1, At, B1); PG8_BAR;
        }
        E(acc, cur, wr, wc, fr, fq);
        if (!has_next) break;
#pragma unroll
        for (int a = 0; a < 2; ++a)
#pragma unroll
            for (int b = 0; b < 2; ++b)
#pragma unroll
                for (int m = 0; m < 4; ++m)
#pragma unroll
                    for (int n = 0; n < 2; ++n) acc[a][b][m][n] = (f32x4){0.f, 0.f, 0.f, 0.f};
        cur = nxt; cA = nA; cB = nB; ++ui;
    }
    PG8_WAIT_V(0);
    if (wr == 0) PG8_BAR;
    PG8_BAR;
#undef PG8_SA
#undef PG8_SB
#undef PG8_STAGE
#undef PG8_LDA
#undef PG8_LDB
#undef PG8_MMA
#undef PG8_WAIT_V
#undef PG8_WAIT_L
#undef PG8_BAR
#undef PG8_SCHED
}
}

DEV int win_srccol(int n) { return n < 4096 ? n : (n < 6656 ? n + 8 : (n < 6664 ? n - 2560 : (n < 6680 ? n : -1))); }
DEV void transpose_tile(const float* __restrict__ src, int srcN, bf16_t* __restrict__ dst, int K, int n0, int k0, int mode, float* tile) {
    const int tid = threadIdx.x;
#pragma unroll
    for (int i = 0; i < 2; ++i) {
        const int kk = (tid >> 4) + 32 * i, nn4 = (tid & 15) * 4, n = n0 + nn4;
        const int sc = mode ? win_srccol(n) : n;
        f32x4 v = (f32x4){0.f, 0.f, 0.f, 0.f};
        if (sc >= 0) v = *(const f32x4*)(src + (size_t)(k0 + kk) * srcN + sc);
        if (mode && n >= 1024 && n < 2048) v = v * 0.0625f;
        tile[kk * 65 + nn4 + 0] = v[0]; tile[kk * 65 + nn4 + 1] = v[1]; tile[kk * 65 + nn4 + 2] = v[2]; tile[kk * 65 + nn4 + 3] = v[3];
    }
    __syncthreads();
    {
        const int nn = tid >> 3, kk8 = (tid & 7) * 8;
        u32x4 w;
        w.x = pk2(tile[(kk8 + 0) * 65 + nn], tile[(kk8 + 1) * 65 + nn]); w.y = pk2(tile[(kk8 + 2) * 65 + nn], tile[(kk8 + 3) * 65 + nn]);
        w.z = pk2(tile[(kk8 + 4) * 65 + nn], tile[(kk8 + 5) * 65 + nn]); w.w = pk2(tile[(kk8 + 6) * 65 + nn], tile[(kk8 + 7) * 65 + nn]);
        *(u32x4*)(dst + (size_t)(n0 + nn) * K + k0 + kk8) = w;
    }
    __syncthreads();
}
DEV void phase_prologue(const P& p, unsigned char* lds) {
    float* tile = (float*)lds;
    constexpr int T_WIN = (INP / 64) * (D / 64), T_WOUT = (D / 64) * (D / 64), T_WUP = (DFF2 / 64) * (D / 64), T_WDN = (D / 64) * (DFF / 64);
    constexpr int T_L = T_WIN + T_WOUT + T_WUP + T_WDN, T_X = NTOK * D / 4096;
    const int total = 2 * T_L + T_X;
    for (int u = blockIdx.x; u < total; u += gridDim.x) {
        if (u < 2 * T_L) {
            const int l = u / T_L; int r = u % T_L;
            if (r < T_WIN) { const int nt = r / (D / 64), kt = r % (D / 64);
                transpose_tile(p.w_in + (size_t)l * D * IN_DIM, IN_DIM, (bf16_t*)(p.ws + WS_WIN) + (size_t)l * INP * D, D, nt * 64, kt * 64, 1, tile); }
            else if ((r -= T_WIN) < T_WOUT) { const int nt = r / (D / 64), kt = r % (D / 64);
                transpose_tile(p.w_out + (size_t)l * D * D, D, (bf16_t*)(p.ws + WS_WOUT) + (size_t)l * D * D, D, nt * 64, kt * 64, 0, tile); }
            else if ((r -= T_WOUT) < T_WUP) { const int nt = r / (D / 64), kt = r % (D / 64);
                transpose_tile(p.w_up + (size_t)l * D * DFF2, DFF2, (bf16_t*)(p.ws + WS_WUP) + (size_t)l * DFF2 * D, D, nt * 64, kt * 64, 0, tile); }
            else { r -= T_WUP; const int nt = r / (DFF / 64), kt = r % (DFF / 64);
                transpose_tile(p.w_down + (size_t)l * DFF * D, D, (bf16_t*)(p.ws + WS_WDN) + (size_t)l * D * DFF, DFF, nt * 64, kt * 64, 0, tile); }
        } else {
            const size_t e = (size_t)(u - 2 * T_L) * 4096 + threadIdx.x * 8;
            const float* s = e < (size_t)NPR * D ? p.x_prompt + e : p.x_sample + (e - (size_t)NPR * D);
            const f32x4 a = *(const f32x4*)s, b = *(const f32x4*)(s + 4);
            u32x4 w; w.x = pk2(a[0], a[1]); w.y = pk2(a[2], a[3]); w.z = pk2(b[0], b[1]); w.w = pk2(b[2], b[3]);
            *(u32x4*)((bf16_t*)(p.ws + WS_XB) + e) = w;
        }
    }
}

DEV void mlstm_local(const P& p, int l, int unit, unsigned char* lds) {
    const int bh = unit >> 5, c = unit & 31, b = bh >> 2, h = bh & 3;
    int tid_ = threadIdx.x; asm volatile("" : "+v"(tid_)); const int tid = tid_, lane = tid & 63, w = tid >> 6, fr = lane & 15, fq = lane >> 4;
    const bf16_t* U = (const bf16_t*)(p.ws + WS_U) + (size_t)(b * 2048 + c * 64) * INP;
    float* wsh = (float*)lds;
    bf16_t* KW = (bf16_t*)(lds + 1024);
    bf16_t* V = KW + 64 * 272;
    float* gstat = (float*)(p.ws + WS_GSTAT);
    if (w == 0) {
        const float ig = bf2f(U[(size_t)lane * INP + UIG + h]) + p.b_i[l * 4 + h];
        const float lf = logsigf_(bf2f(U[(size_t)lane * INP + UFG + h]) + p.b_f[l * 4 + h]);
        const float bs = wave_incl_sum(lf, lane);
        const float a = ig - bs;
        const float amax = wave_max(a);
        const float bsum = __shfl(bs, 63);
        wsh[lane] = expf(a - amax);
        if (lane == 0) { gstat[(bh * 32 + c) * 2] = bsum; gstat[(bh * 32 + c) * 2 + 1] = bsum + amax; }
    }
    __syncthreads();
#pragma unroll
    for (int i = 0; i < 4; ++i) {
        const int it = tid + 512 * i, s_ = it >> 5, d8 = (it & 31) * 8;
        const uint4 kv = *(const uint4*)(U + (size_t)s_ * INP + UK + h * 256 + d8);
        const uint4 vv = *(const uint4*)(U + (size_t)s_ * INP + UV + h * 256 + d8);
        const float ws_ = wsh[s_];
        float kf[8]; unpack8(kv, kf);
        u32x4 kw; kw.x = pk2(kf[0] * ws_, kf[1] * ws_); kw.y = pk2(kf[2] * ws_, kf[3] * ws_); kw.z = pk2(kf[4] * ws_, kf[5] * ws_); kw.w = pk2(kf[6] * ws_, kf[7] * ws_);
        *(u32x4*)(KW + s_ * 272 + d8) = kw;
        *(uint4*)(V + s_ * 272 + d8) = vv;
    }
    __syncthreads();
    if (tid < 256) { float a = 0.f; for (int s_ = 0; s_ < 64; ++s_) a += bf2f(KW[s_ * 272 + tid]); ((float*)(p.ws + WS_NLOC))[(size_t)(bh * 32 + c) * 256 + tid] = a; }
    f32x4 acc[2][16];
#pragma unroll
    for (int m = 0; m < 2; ++m)
#pragma unroll
        for (int n = 0; n < 16; ++n) acc[m][n] = (f32x4){0.f, 0.f, 0.f, 0.f};
#pragma unroll
    for (int ks = 0; ks < 2; ++ks) {
        bf16x8 vf[2];
#pragma unroll
        for (int m = 0; m < 2; ++m) vf[m] = tr_frag(V, 272, 32 * ks, 32 * w + 16 * m, lane);
#pragma unroll
        for (int n = 0; n < 16; ++n) {
            const bf16x8 kf = tr_frag(KW, 272, 32 * ks, 16 * n, lane);
#pragma unroll
            for (int m = 0; m < 2; ++m) acc[m][n] = mfma16(kf, vf[m], acc[m][n]);
        }
    }
    bf16_t* Dp = (bf16_t*)(p.ws + WS_DBUF) + (size_t)(bh * 32 + c) * 65536;
#pragma unroll
    for (int m = 0; m < 2; ++m)
#pragma unroll
        for (int n = 0; n < 16; ++n) { u32x2 wv; wv.x = pk2(acc[m][n][0], acc[m][n][1]); wv.y = pk2(acc[m][n][2], acc[m][n][3]);
            *(u32x2*)(Dp + (32 * w + 16 * m + fr) * 256 + 16 * n + fq * 4) = wv; }
    __syncthreads();
}

DEV void mlstm_scan(const P& p, int l, int unit, unsigned char* lds) {
    int tid_ = threadIdx.x; asm volatile("" : "+v"(tid_)); const int bh = unit >> 4, slab = unit & 15, tid = tid_;
    float* fA = (float*)lds; float* fB = fA + 32;
    const float* gstat = (const float*)(p.ws + WS_GSTAT);
    if (tid == 0) {
        float m = 0.f;
        for (int c = 0; c < 32; ++c) {
            const float bsum = gstat[(bh * 32 + c) * 2], mloc = gstat[(bh * 32 + c) * 2 + 1];
            const float mn = fmaxf(bsum + m, mloc);
            fA[c] = expf(bsum + m - mn); fB[c] = expf(mloc - mn); m = mn;
            if (slab == 0) ((float*)(p.ws + WS_MST))[bh * 32 + c] = mn;
        }
        if (slab == 0) p.out[O_PM + l * 16 + bh] = m;
    }
    __syncthreads();
    const size_t e0 = (size_t)slab * 4096 + tid * 8;
    float run[8];
#pragma unroll
    for (int i = 0; i < 8; ++i) run[i] = 0.f;
    const bf16_t* Dp = (const bf16_t*)(p.ws + WS_DBUF) + (size_t)bh * 32 * 65536 + e0;
    bf16_t* Cp = (bf16_t*)(p.ws + WS_CT) + (size_t)bh * 32 * 65536 + e0;
#pragma unroll 1
    for (int cb = 0; cb < 32; cb += 8) {
        uint4 xx[8];
#pragma unroll
        for (int j = 0; j < 8; ++j) xx[j] = *(const uint4*)(Dp + (size_t)(cb + j) * 65536);
#pragma unroll
        for (int j = 0; j < 8; ++j) {
            const int c = cb + j;
            const float a = fA[c], bq = fB[c];
            float xf[8]; unpack8(xx[j], xf);
#pragma unroll
            for (int i = 0; i < 8; ++i) run[i] = a * run[i] + bq * xf[i];
            u32x4 wv; wv.x = pk2(run[0], run[1]); wv.y = pk2(run[2], run[3]); wv.z = pk2(run[4], run[5]); wv.w = pk2(run[6], run[7]);
            *(u32x4*)(Cp + (size_t)c * 65536) = wv;
        }
    }
    {
        float* o = p.out + O_PC + (size_t)(l * 16 + bh) * 65536;
        const int e = (int)(e0 >> 8), d0 = (int)(e0 & 255);
#pragma unroll
        for (int i = 0; i < 8; ++i) o[(d0 + i) * 256 + e] = run[i];
    }
    if (slab == 0 && tid < 256) {
        float r = 0.f;
        const float* nl = (const float*)(p.ws + WS_NLOC) + (size_t)bh * 32 * 256 + tid;
        float* ns = (float*)(p.ws + WS_NST) + (size_t)bh * 32 * 256 + tid;
        for (int c = 0; c < 32; ++c) { r = fA[c] * r + fB[c] * nl[c * 256]; ns[c * 256] = r; }
        p.out[O_PN + (size_t)(l * 16 + bh) * 256 + tid] = r;
    }
    __syncthreads();
}

DEV void ssd_scan(const P& p, int l, int unit, unsigned char* lds) {
    int tid_ = threadIdx.x; asm volatile("" : "+v"(tid_)); const int bhd = unit >> 1, slab = unit & 1, tid = tid_;
    float* dec = (float*)lds;
    if (tid < 32) dec[tid] = expf(((const float*)(p.ws + WS_SBSUM))[bhd * 32 + tid]);
    __syncthreads();
    const size_t e0 = (size_t)slab * 4096 + tid * 8;
    float run[8];
#pragma unroll
    for (int i = 0; i < 8; ++i) run[i] = 0.f;
    const float* Sp = (const float*)(p.ws + WS_SBUF) + (size_t)bhd * 32 * 8192 + e0;
    bf16_t* Tp = (bf16_t*)(p.ws + WS_ST) + (size_t)bhd * 32 * 8192 + e0;
#pragma unroll 1
    for (int cb = 0; cb < 32; cb += 8) {
        f32x4 xx[8][2];
#pragma unroll
        for (int j = 0; j < 8; ++j) { xx[j][0] = __builtin_nontemporal_load((const f32x4*)(Sp + (size_t)(cb + j) * 8192)); xx[j][1] = __builtin_nontemporal_load((const f32x4*)(Sp + (size_t)(cb + j) * 8192 + 4)); }
#pragma unroll
        for (int j = 0; j < 8; ++j) {
            const int c = cb + j;
            const float a = dec[c];
#pragma unroll
            for (int i = 0; i < 4; ++i) { run[i] = a * run[i] + xx[j][0][i]; run[4 + i] = a * run[4 + i] + xx[j][1][i]; }
            u32x4 wv; wv.x = pk2(run[0], run[1]); wv.y = pk2(run[2], run[3]); wv.z = pk2(run[4], run[5]); wv.w = pk2(run[6], run[7]);
            *(u32x4*)(Tp + (size_t)c * 8192) = wv;
        }
    }
    float* o = p.out + O_PS + (size_t)(l * 64 + bhd) * 8192 + e0;
    *(f32x4*)o = (f32x4){run[0], run[1], run[2], run[3]}; *(f32x4*)(o + 4) = (f32x4){run[4], run[5], run[6], run[7]};
    __syncthreads();
}

DEV void convstate_copy(const P& p, int l, int unit) {
    const bf16_t* Ub = (const bf16_t*)(p.ws + WS_U);
    for (int i = threadIdx.x; i < 3 * 1536; i += NTHR) {
        const int j = i / 1536, ch = i % 1536;
        if (unit < 4) p.out[O_PSC + ((size_t)(l * 4 + unit) * 3 + j) * 1536 + ch] = bf2f(Ub[(size_t)(unit * 2048 + 2045 + j) * INP + UXS + ch]);
        else { const int b = unit - 4; p.out[O_SSC + ((size_t)(l * 128 + b) * 3 + j) * 1536 + ch] = bf2f(Ub[(size_t)(NPR + b * 8 + 5 + j) * INP + UXS + ch]); }
    }
}

DEV void mlstm_out(const P& p, int l, int unit, unsigned char* lds) {
    const int bh = unit >> 5, c = unit & 31, b = bh >> 2, h = bh & 3;
    int tid_ = threadIdx.x; asm volatile("" : "+v"(tid_)); const int tid = tid_, lane = tid & 63, w = tid >> 6, fr = lane & 15, fq = lane >> 4;
    const int r0 = b * 2048 + c * 64;
    const bf16_t* U = (const bf16_t*)(p.ws + WS_U) + (size_t)r0 * INP;
    bf16_t* Qs = (bf16_t*)lds;
    bf16_t* Ks = Qs + 64 * 264;
    bf16_t* V = Ks + 64 * 264;
    bf16_t* Ss = V + 64 * 272;
    float* fl = (float*)(lds + 113664);
    float* bsh = fl; float* ash = fl + 64; float* mth = fl + 128; float* wint = fl + 192; float* rdn = fl + 256; float* qn = fl + 320; float* nprev = fl + 384; float* red = fl + 640;
    float* stat = fl + 1152;
    if (w == 0) {
        const float ig = bf2f(U[(size_t)lane * INP + UIG + h]) + p.b_i[l * 4 + h];
        const float lf = logsigf_(bf2f(U[(size_t)lane * INP + UFG + h]) + p.b_f[l * 4 + h]);
        const float bs = wave_incl_sum(lf, lane);
        const float a = ig - bs;
        const float cm = wave_incl_max(a, lane);
        const float mprev = c > 0 ? ((const float*)(p.ws + WS_MST))[bh * 32 + c - 1] : 0.f;
        const float mt = bs + fmaxf(mprev, cm);
        bsh[lane] = bs; ash[lane] = a; mth[lane] = mt; wint[lane] = expf(bs + mprev - mt);
    }
    if (tid >= 256) { const int d = tid - 256; nprev[d] = c > 0 ? ((const float*)(p.ws + WS_NST))[(size_t)(bh * 32 + c - 1) * 256 + d] : 0.f; }
#pragma unroll
    for (int i = 0; i < 4; ++i) {
        const int it = tid + 512 * i, s_ = it >> 5, d8 = (it & 31) * 8;
        *(uint4*)(Qs + s_ * 264 + d8) = *(const uint4*)(U + (size_t)s_ * INP + UQ + h * 256 + d8);
        *(uint4*)(Ks + s_ * 264 + d8) = *(const uint4*)(U + (size_t)s_ * INP + UK + h * 256 + d8);
        *(uint4*)(V + s_ * 272 + d8) = *(const uint4*)(U + (size_t)s_ * INP + UV + h * 256 + d8);
    }
    __syncthreads();
    {
        const int mt_ = w >> 1, nt0 = (w & 1) * 2;
        f32x4 sacc[2] = {(f32x4){0.f, 0.f, 0.f, 0.f}, (f32x4){0.f, 0.f, 0.f, 0.f}};
#pragma unroll
        for (int k0 = 0; k0 < 256; k0 += 32) {
            const bf16x8 a = *(const bf16x8*)(Qs + (16 * mt_ + fr) * 264 + k0 + fq * 8);
#pragma unroll
            for (int n = 0; n < 2; ++n) { const bf16x8 bb = *(const bf16x8*)(Ks + (16 * (nt0 + n) + fr) * 264 + k0 + fq * 8); sacc[n] = mfma16(a, bb, sacc[n]); }
        }
#pragma unroll
        for (int n = 0; n < 2; ++n)
#pragma unroll
            for (int j = 0; j < 4; ++j) {
                const int t = 16 * mt_ + fq * 4 + j, s_ = 16 * (nt0 + n) + fr;
                const float val = (s_ <= t) ? sacc[n][j] * expf(bsh[t] - mth[t] + ash[s_]) : 0.f;
                Ss[t * 72 + s_] = f2bf(val);
            }
        const int t = tid >> 3, part = tid & 7;
        float a = 0.f;
        for (int d = part * 32; d < part * 32 + 32; ++d) a += bf2f(Qs[t * 264 + d]) * nprev[d];
        a += __shfl_xor(a, 1); a += __shfl_xor(a, 2); a += __shfl_xor(a, 4);
        if (part == 0) qn[t] = a;
    }
    __syncthreads();
    if (tid < 64) {
        float di = 0.f;
        for (int s_ = 0; s_ < 64; ++s_) di += bf2f(Ss[tid * 72 + s_]);
        const float den = di + wint[tid] * qn[tid];
        rdn[tid] = 1.0f / fmaxf(fabsf(den), expf(-mth[tid]));
    }
    const int e0 = 32 * w;
    f32x4 acc1[4][2], acc2[4][2];
#pragma unroll
    for (int m = 0; m < 4; ++m)
#pragma unroll
        for (int n = 0; n < 2; ++n) { acc1[m][n] = (f32x4){0.f, 0.f, 0.f, 0.f}; acc2[m][n] = (f32x4){0.f, 0.f, 0.f, 0.f}; }
#pragma unroll
    for (int ks = 0; ks < 2; ++ks) {
        bf16x8 sf[4];
#pragma unroll
        for (int m = 0; m < 4; ++m) sf[m] = *(const bf16x8*)(Ss + (16 * m + fr) * 72 + 32 * ks + fq * 8);
#pragma unroll
        for (int n = 0; n < 2; ++n) { const bf16x8 vf = tr_frag(V, 272, 32 * ks, e0 + 16 * n, lane);
#pragma unroll
            for (int m = 0; m < 4; ++m) acc1[m][n] = mfma16(vf, sf[m], acc1[m][n]); }
    }
    if (c > 0) {
        const bf16_t* CTp = (const bf16_t*)(p.ws + WS_CT) + (size_t)(bh * 32 + c - 1) * 65536;
#pragma unroll 2
        for (int k0 = 0; k0 < 256; k0 += 32) {
            bf16x8 a[4];
#pragma unroll
            for (int m = 0; m < 4; ++m) a[m] = *(const bf16x8*)(Qs + (16 * m + fr) * 264 + k0 + fq * 8);
#pragma unroll
            for (int n = 0; n < 2; ++n) { const bf16x8 cf = *(const bf16x8*)(CTp + (size_t)(e0 + 16 * n + fr) * 256 + k0 + fq * 8);
#pragma unroll
                for (int m = 0; m < 4; ++m) acc2[m][n] = mfma16(cf, a[m], acc2[m][n]); }
        }
    }
    __syncthreads();
#pragma unroll
    for (int m = 0; m < 4; ++m) {
        const int t = 16 * m + fr;
        const float wi = wint[t], rd = rdn[t];
        float sm = 0.f;
#pragma unroll
        for (int n = 0; n < 2; ++n)
#pragma unroll
            for (int j = 0; j < 4; ++j) { const float hv = (acc1[m][n][j] + wi * acc2[m][n][j]) * rd; acc1[m][n][j] = hv; sm += hv; }
        sm += __shfl_xor(sm, 16); sm += __shfl_xor(sm, 32);
        if (fq == 0) red[t * 8 + w] = sm;
    }
    __syncthreads();
    if (tid < 64) { float sm = 0.f;
#pragma unroll
        for (int i = 0; i < 8; ++i) sm += red[tid * 8 + i];
        stat[tid] = sm * (1.0f / 256.0f); }
    __syncthreads();
#pragma unroll
    for (int m = 0; m < 4; ++m) {
        const int t = 16 * m + fr;
        const float mu = stat[t];
        float sm = 0.f;
#pragma unroll
        for (int n = 0; n < 2; ++n)
#pragma unroll
            for (int j = 0; j < 4; ++j) { const float dv = acc1[m][n][j] - mu; acc1[m][n][j] = dv; sm += dv * dv; }
        sm += __shfl_xor(sm, 16); sm += __shfl_xor(sm, 32);
        if (fq == 0) red[t * 8 + w] = sm;
    }
    __syncthreads();
    if (tid < 64) { float sm = 0.f;
#pragma unroll
        for (int i = 0; i < 8; ++i) sm += red[tid * 8 + i];
        stat[64 + tid] = rsqrtf(sm * (1.0f / 256.0f) + 1e-6f); }
    __syncthreads();
    bf16_t* MX = (bf16_t*)(p.ws + WS_MIXIN);
#pragma unroll
    for (int m = 0; m < 4; ++m) {
        const int t = 16 * m + fr;
        const float rs = stat[64 + t];
#pragma unroll
        for (int n = 0; n < 2; ++n) {
            const int e4 = e0 + 16 * n + fq * 4;
            const uint2 ov = *(const uint2*)(U + (size_t)t * INP + UO + h * 256 + e4);
            const f32x4 nw = *(const f32x4*)(p.m_norm_w + l * 1024 + h * 256 + e4);
            u32x2 wv;
            wv.x = pk2(acc1[m][n][0] * rs * nw[0] * sigmoidf_(bflo(ov.x)), acc1[m][n][1] * rs * nw[1] * sigmoidf_(bfhi(ov.x)));
            wv.y = pk2(acc1[m][n][2] * rs * nw[2] * sigmoidf_(bflo(ov.y)), acc1[m][n][3] * rs * nw[3] * sigmoidf_(bfhi(ov.y)));
            *(u32x2*)(MX + (size_t)(r0 + t) * D + h * 256 + e4) = wv;
        }
    }
    __syncthreads();
}

DEV void ssd_conv8(const bf16_t* Urow, int tpos, const float* cw, const float* cb, int ch8, float (&o)[8]) {
    const f32x4 b0 = *(const f32x4*)(cb + ch8), b1 = *(const f32x4*)(cb + ch8 + 4);
    o[0] = b0[0]; o[1] = b0[1]; o[2] = b0[2]; o[3] = b0[3]; o[4] = b1[0]; o[5] = b1[1]; o[6] = b1[2]; o[7] = b1[3];
#pragma unroll
    for (int j = 0; j < 4; ++j) {
        const int back = 3 - j;
        if (tpos - back >= 0) {
            const uint4 x = *(const uint4*)(Urow - (size_t)back * INP + UXS + ch8);
            float xf[8]; unpack8(x, xf);
            const f32x4 w0 = *(const f32x4*)(cw + j * 1536 + ch8), w1 = *(const f32x4*)(cw + j * 1536 + ch8 + 4);
            o[0] += w0[0] * xf[0]; o[1] += w0[1] * xf[1]; o[2] += w0[2] * xf[2]; o[3] += w0[3] * xf[3];
            o[4] += w1[0] * xf[4]; o[5] += w1[1] * xf[5]; o[6] += w1[2] * xf[6]; o[7] += w1[3] * xf[7];
        }
    }
#pragma unroll
    for (int i = 0; i < 8; ++i) o[i] = siluf_(o[i]);
}

DEV void ssd_local(const P& p, int l, int unit, unsigned char* lds) {
    const int b = unit >> 6, g = (unit >> 5) & 1, c = unit & 31;
    int tid_ = threadIdx.x; asm volatile("" : "+v"(tid_)); const int tid = tid_, lane = tid & 63, w = tid >> 6, fr = lane & 15, fq = lane >> 4;
    const int r0 = b * 2048 + c * 64;
    const bf16_t* U = (const bf16_t*)(p.ws + WS_U) + (size_t)r0 * INP;
    bf16_t* XW = (bf16_t*)lds;
    bf16_t* Bmn = XW + 64 * 528;
    float* wsh = (float*)(lds + 86016);
    {
        const int head = g * 8 + w;
        const float dt = softplusf_(bf2f(U[(size_t)lane * INP + UDT + head]) + p.dt_bias[l * 16 + head]);
        const float a = -expf(p.A_log[l * 16 + head]) * dt;
        const float bs = wave_incl_sum(a, lane);
        const float bL = __shfl(bs, 63);
        wsh[w * 64 + lane] = expf(bL - bs) * dt;
        if (lane == 0) ((float*)(p.ws + WS_SBSUM))[(b * 16 + head) * 32 + c] = bL;
    }
    __syncthreads();
    const float* cw = p.s_conv_w + (size_t)l * 4 * 1536; const float* cb = p.s_conv_b + (size_t)l * 1536;
    for (int i = 0; i < 10; ++i) {
        const int it = tid + 512 * i, t = it / 80, gidx = it % 80;
        const int ch8 = gidx < 64 ? g * 512 + gidx * 8 : 1024 + g * 128 + (gidx - 64) * 8;
        float v[8];
        ssd_conv8(U + (size_t)t * INP, c * 64 + t, cw, cb, ch8, v);
        if (gidx < 64) { const float sc = wsh[(gidx >> 3) * 64 + t];
            u32x4 wv; wv.x = pk2(v[0] * sc, v[1] * sc); wv.y = pk2(v[2] * sc, v[3] * sc); wv.z = pk2(v[4] * sc, v[5] * sc); wv.w = pk2(v[6] * sc, v[7] * sc);
            *(u32x4*)(XW + t * 528 + gidx * 8) = wv; }
        else { u32x4 wv; wv.x = pk2(v[0], v[1]); wv.y = pk2(v[2], v[3]); wv.z = pk2(v[4], v[5]); wv.w = pk2(v[6], v[7]);
            *(u32x4*)(Bmn + t * 144 + (gidx - 64) * 8) = wv; }
    }
    __syncthreads();
    f32x4 acc[4][8];
#pragma unroll
    for (int m = 0; m < 4; ++m)
#pragma unroll
        for (int n = 0; n < 8; ++n) acc[m][n] = (f32x4){0.f, 0.f, 0.f, 0.f};
#pragma unroll
    for (int ks = 0; ks < 2; ++ks) {
        bf16x8 xf[4];
#pragma unroll
        for (int m = 0; m < 4; ++m) xf[m] = tr_frag(XW, 528, 32 * ks, 64 * w + 16 * m, lane);
#pragma unroll
        for (int n = 0; n < 8; ++n) { const bf16x8 bf_ = tr_frag(Bmn, 144, 32 * ks, 16 * n, lane);
#pragma unroll
            for (int m = 0; m < 4; ++m) acc[m][n] = mfma16(bf_, xf[m], acc[m][n]); }
    }
    float* Sp = (float*)(p.ws + WS_SBUF) + (size_t)((b * 16 + g * 8 + w) * 32 + c) * 8192;
#pragma unroll
    for (int m = 0; m < 4; ++m)
#pragma unroll
        for (int n = 0; n < 8; ++n) *(f32x4*)(Sp + (16 * m + fr) * 128 + 16 * n + fq * 4) = acc[m][n];
    __syncthreads();
}

DEV void ssd_out(const P& p, int l, int unit, unsigned char* lds) {
    const int b = unit >> 6, g = (unit >> 5) & 1, c = unit & 31;
    int tid_ = threadIdx.x; asm volatile("" : "+v"(tid_)); const int tid = tid_, lane = tid & 63, w = tid >> 6, fr = lane & 15, fq = lane >> 4;
    const int r0 = b * 2048 + c * 64;
    const bf16_t* U = (const bf16_t*)(p.ws + WS_U) + (size_t)r0 * INP;
    bf16_t* Xs = (bf16_t*)lds;
    bf16_t* Bm = Xs + 64 * 528;
    bf16_t* Cm = Bm + 64 * 136;
    float* CB = (float*)(lds + 102400);
    float* bsh = (float*)(lds + 119808);
    float* dtsh = bsh + 512;
    float* red = dtsh + 512;
    float* stat = red + 512;
    const int head = g * 8 + w;
    {
        const float dt = softplusf_(bf2f(U[(size_t)lane * INP + UDT + head]) + p.dt_bias[l * 16 + head]);
        const float a = -expf(p.A_log[l * 16 + head]) * dt;
        const float bs = wave_incl_sum(a, lane);
        bsh[w * 64 + lane] = bs; dtsh[w * 64 + lane] = dt;
    }
    const float* cw = p.s_conv_w + (size_t)l * 4 * 1536; const float* cb = p.s_conv_b + (size_t)l * 1536;
    for (int i = 0; i < 12; ++i) {
        const int it = tid + 512 * i, t = it / 96, gidx = it % 96;
        const int ch8 = gidx < 64 ? g * 512 + gidx * 8 : (gidx < 80 ? 1024 + g * 128 + (gidx - 64) * 8 : 1280 + g * 128 + (gidx - 80) * 8);
        float v[8];
        ssd_conv8(U + (size_t)t * INP, c * 64 + t, cw, cb, ch8, v);
        u32x4 wv; wv.x = pk2(v[0], v[1]); wv.y = pk2(v[2], v[3]); wv.z = pk2(v[4], v[5]); wv.w = pk2(v[6], v[7]);
        if (gidx < 64) *(u32x4*)(Xs + t * 528 + gidx * 8) = wv;
        else if (gidx < 80) *(u32x4*)(Bm + t * 136 + (gidx - 64) * 8) = wv;
        else *(u32x4*)(Cm + t * 136 + (gidx - 80) * 8) = wv;
    }
    __syncthreads();
    {
        const int mt_ = w >> 1, nt0 = (w & 1) * 2;
        f32x4 cacc[2] = {(f32x4){0.f, 0.f, 0.f, 0.f}, (f32x4){0.f, 0.f, 0.f, 0.f}};
#pragma unroll
        for (int k0 = 0; k0 < 128; k0 += 32) {
            const bf16x8 a = *(const bf16x8*)(Cm + (16 * mt_ + fr) * 136 + k0 + fq * 8);
#pragma unroll
            for (int n = 0; n < 2; ++n) { const bf16x8 bb = *(const bf16x8*)(Bm + (16 * (nt0 + n) + fr) * 136 + k0 + fq * 8); cacc[n] = mfma16(a, bb, cacc[n]); }
        }
#pragma unroll
        for (int n = 0; n < 2; ++n)
#pragma unroll
            for (int j = 0; j < 4; ++j) CB[(16 * mt_ + fq * 4 + j) * 68 + 16 * (nt0 + n) + fr] = cacc[n][j];
    }
    __syncthreads();
    f32x4 acc1[4][4], acc2[4][4];
#pragma unroll
    for (int m = 0; m < 4; ++m)
#pragma unroll
        for (int n = 0; n < 4; ++n) { acc1[m][n] = (f32x4){0.f, 0.f, 0.f, 0.f}; acc2[m][n] = (f32x4){0.f, 0.f, 0.f, 0.f}; }
#pragma unroll
    for (int ks = 0; ks < 2; ++ks) {
        bf16x8 xf[4];
#pragma unroll
        for (int n = 0; n < 4; ++n) xf[n] = tr_frag(Xs, 528, 32 * ks, 64 * w + 16 * n, lane);
#pragma unroll
        for (int m = 0; m < 4; ++m) {
            if (ks * 32 > 16 * m + 15) continue;
            const int t = 16 * m + fr, s0 = 32 * ks + fq * 8;
            const float bt = bsh[w * 64 + t];
            const f32x4 c0 = *(const f32x4*)(CB + t * 68 + s0), c1 = *(const f32x4*)(CB + t * 68 + s0 + 4);
            float mv[8];
#pragma unroll
            for (int i = 0; i < 8; ++i) { const int s_ = s0 + i; const float cv = i < 4 ? c0[i & 3] : c1[i & 3];
                mv[i] = (s_ <= t) ? cv * expf(bt - bsh[w * 64 + s_]) * dtsh[w * 64 + s_] : 0.f; }
            union { u32x4 u; bf16x8 v; } af;
            af.u.x = pk2(mv[0], mv[1]); af.u.y = pk2(mv[2], mv[3]); af.u.z = pk2(mv[4], mv[5]); af.u.w = pk2(mv[6], mv[7]);
#pragma unroll
            for (int n = 0; n < 4; ++n) acc1[m][n] = mfma16(xf[n], af.v, acc1[m][n]);
        }
    }
    if (c > 0) {
        const bf16_t* STp = (const bf16_t*)(p.ws + WS_ST) + (size_t)((b * 16 + head) * 32 + c - 1) * 8192;
#pragma unroll
        for (int k0 = 0; k0 < 128; k0 += 32) {
            bf16x8 a[4];
#pragma unroll
            for (int m = 0; m < 4; ++m) a[m] = *(const bf16x8*)(Cm + (16 * m + fr) * 136 + k0 + fq * 8);
#pragma unroll
            for (int n = 0; n < 4; ++n) { const bf16x8 sf = *(const bf16x8*)(STp + (16 * n + fr) * 128 + k0 + fq * 8);
#pragma unroll
                for (int m = 0; m < 4; ++m) acc2[m][n] = mfma16(sf, a[m], acc2[m][n]); }
        }
    }
    const float dsk = p.D_skip[l * 16 + head];
#pragma unroll
    for (int m = 0; m < 4; ++m) {
        const int t = 16 * m + fr;
        const float eb = expf(bsh[w * 64 + t]);
        float sm = 0.f;
#pragma unroll
        for (int n = 0; n < 4; ++n) {
            const int pp4 = 16 * n + fq * 4;
            const uint2 xv = *(const uint2*)(Xs + t * 528 + 64 * w + pp4);
            const uint2 zv = *(const uint2*)(U + (size_t)t * INP + UZ + g * 512 + w * 64 + pp4);
            const float xs4[4] = {bflo(xv.x), bfhi(xv.x), bflo(xv.y), bfhi(xv.y)};
            const float z4[4] = {bflo(zv.x), bfhi(zv.x), bflo(zv.y), bfhi(zv.y)};
#pragma unroll
            for (int j = 0; j < 4; ++j) {
                const float y = acc1[m][n][j] + eb * acc2[m][n][j] + dsk * xs4[j];
                const float gt = y * z4[j] * sigmoidf_(z4[j]);
                acc1[m][n][j] = gt; sm += gt * gt;
            }
        }
        sm += __shfl_xor(sm, 16); sm += __shfl_xor(sm, 32);
        if (fq == 0) red[t * 8 + w] = sm;
    }
    __syncthreads();
    if (tid < 64) { float sm = 0.f;
#pragma unroll
        for (int i = 0; i < 8; ++i) sm += red[tid * 8 + i];
        stat[tid] = rsqrtf(sm * (1.0f / 512.0f) + 1e-6f); }
    __syncthreads();
    bf16_t* MX = (bf16_t*)(p.ws + WS_MIXIN);
#pragma unroll
    for (int m = 0; m < 4; ++m) {
        const int t = 16 * m + fr;
        const float rs = stat[t];
#pragma unroll
        for (int n = 0; n < 4; ++n) {
            const int ch = g * 512 + w * 64 + 16 * n + fq * 4;
            const f32x4 nw = *(const f32x4*)(p.s_norm_w + l * 1024 + ch);
            u32x2 wv; wv.x = pk2(acc1[m][n][0] * rs * nw[0], acc1[m][n][1] * rs * nw[1]); wv.y = pk2(acc1[m][n][2] * rs * nw[2], acc1[m][n][3] * rs * nw[3]);
            *(u32x2*)(MX + (size_t)(r0 + t) * D + 1024 + ch) = wv;
        }
    }
    __syncthreads();
}

DEV void smp_mlstm(const P& p, int l, int unit, unsigned char* lds) {
    const int b = unit >> 2, h = unit & 3;
    int tid_ = threadIdx.x; asm volatile("" : "+v"(tid_)); const int tid = tid_, lane = tid & 63, w = tid >> 6;
    const int r0 = NPR + b * 8;
    const bf16_t* U = (const bf16_t*)(p.ws + WS_U) + (size_t)r0 * INP;
    float* qn = (float*)lds; float* kn = qn + 2048; float* vn = kn + 2048; float* qT = vn + 2048; float* kwT = qT + 2048; float* sc = kwT + 2048; float* red = sc + 256;
    const size_t sidx = (size_t)(l * 128 + b) * 4 + h;
    const float* C0 = p.st_C + sidx * 65536; const float* n0 = p.st_n + sidx * 256;
    float* Cout = p.out + O_SC + sidx * 65536;
    if (tid == 0) {
        const float m0 = p.st_m[sidx];
        float bs = 0.f, cm = -INFINITY, mt = 0.f;
        for (int t = 0; t < 8; ++t) {
            const float ig = bf2f(U[(size_t)t * INP + UIG + h]) + p.b_i[l * 4 + h];
            const float lf = logsigf_(bf2f(U[(size_t)t * INP + UFG + h]) + p.b_f[l * 4 + h]);
            bs += lf; const float a = ig - bs; cm = fmaxf(cm, a); mt = bs + fmaxf(m0, cm);
            sc[32 + t] = mt; sc[t] = expf(bs + m0 - mt); sc[40 + t] = a; sc[48 + t] = bs;
        }
        for (int s = 0; s < 8; ++s) sc[16 + s] = expf(bs + sc[40 + s] - mt);
        sc[24] = expf(bs + m0 - mt);
        p.out[O_SM + sidx] = mt;
    }
    __syncthreads();
#pragma unroll
    for (int i = 0; i < 4; ++i) {
        const int idx = tid + 512 * i, t = idx >> 8, d = idx & 255;
        const float q = bf2f(U[(size_t)t * INP + UQ + h * 256 + d]), k = bf2f(U[(size_t)t * INP + UK + h * 256 + d]), v = bf2f(U[(size_t)t * INP + UV + h * 256 + d]);
        qn[t * 256 + d] = q; kn[t * 256 + d] = k; vn[t * 256 + d] = v; qT[d * 8 + t] = q; kwT[d * 8 + t] = k * sc[16 + t];
    }
    __syncthreads();
    {
        const int t = w;
        const f32x4 qv = *(const f32x4*)(qn + t * 256 + lane * 4);
        float dot[9];
#pragma unroll
        for (int s = 0; s < 8; ++s) { const f32x4 kv = *(const f32x4*)(kn + s * 256 + lane * 4); dot[s] = qv[0] * kv[0] + qv[1] * kv[1] + qv[2] * kv[2] + qv[3] * kv[3]; }
        { const f32x4 nv = *(const f32x4*)(n0 + lane * 4); dot[8] = qv[0] * nv[0] + qv[1] * nv[1] + qv[2] * nv[2] + qv[3] * nv[3]; }
#pragma unroll
        for (int s = 0; s < 9; ++s) dot[s] = wave_sum(dot[s]);
        float den = 0.f;
#pragma unroll
        for (int s = 0; s < 8; ++s) { const float sv = (s <= t) ? dot[s] * expf(sc[48 + t] - sc[32 + t] + sc[40 + s]) : 0.f; den += sv; if (lane == 0) sc[64 + t * 8 + s] = sv; }
        den += sc[t] * dot[8];
        if (lane == 0) sc[8 + t] = 1.0f / fmaxf(fabsf(den), expf(-sc[32 + t]));
    }
    if (tid < 256) {
        float a = sc[24] * n0[tid];
#pragma unroll
        for (int s = 0; s < 8; ++s) a += kwT[tid * 8 + s];
        p.out[O_SN + sidx * 256 + tid] = a;
    }
    const int e4 = lane * 4;
    f32x4 num[8], vv[8];
#pragma unroll
    for (int t = 0; t < 8; ++t) { num[t] = (f32x4){0.f, 0.f, 0.f, 0.f}; vv[t] = *(const f32x4*)(vn + t * 256 + e4); }
    const float decay = sc[24];
#pragma unroll 1
    for (int ib = 0; ib < 4; ++ib) {
        f32x4 cc[8];
#pragma unroll
        for (int j = 0; j < 8; ++j) cc[j] = __builtin_nontemporal_load((const f32x4*)(C0 + (size_t)(w + 8 * (ib * 8 + j)) * 256 + e4));
#pragma unroll
        for (int j = 0; j < 8; ++j) {
            const int d = w + 8 * (ib * 8 + j);
            const f32x4 q0 = *(const f32x4*)(qT + d * 8), q1 = *(const f32x4*)(qT + d * 8 + 4), k0 = *(const f32x4*)(kwT + d * 8), k1 = *(const f32x4*)(kwT + d * 8 + 4);
            f32x4 cn = cc[j] * decay;
#pragma unroll
            for (int t = 0; t < 4; ++t) { num[t] += cc[j] * q0[t]; num[4 + t] += cc[j] * q1[t]; cn += vv[t] * k0[t]; cn += vv[4 + t] * k1[t]; }
            __builtin_nontemporal_store(cn, (f32x4*)(Cout + (size_t)d * 256 + e4));
        }
    }
#pragma unroll
    for (int t = 0; t < 8; ++t) *(f32x4*)(red + (w * 8 + t) * 256 + e4) = num[t];
    __syncthreads();
    {
        const int t = w;
        f32x4 hv = (f32x4){0.f, 0.f, 0.f, 0.f};
#pragma unroll
        for (int ww = 0; ww < 8; ++ww) hv += *(const f32x4*)(red + (ww * 8 + t) * 256 + e4);
        hv = hv * sc[t];
#pragma unroll
        for (int s = 0; s < 8; ++s) hv += vv[s] * sc[64 + t * 8 + s];
        hv = hv * sc[8 + t];
        const float mu = wave_sum(hv[0] + hv[1] + hv[2] + hv[3]) * (1.0f / 256.0f);
        const f32x4 dv = hv - mu;
        const float var = wave_sum(dv[0] * dv[0] + dv[1] * dv[1] + dv[2] * dv[2] + dv[3] * dv[3]) * (1.0f / 256.0f);
        const float rs = rsqrtf(var + 1e-6f);
        const uint2 ov = *(const uint2*)(U + (size_t)t * INP + UO + h * 256 + e4);
        const f32x4 nw = *(const f32x4*)(p.m_norm_w + l * 1024 + h * 256 + e4);
        const float o0 = dv[0] * rs * nw[0] * sigmoidf_(bflo(ov.x)), o1 = dv[1] * rs * nw[1] * sigmoidf_(bfhi(ov.x));
        const float o2 = dv[2] * rs * nw[2] * sigmoidf_(bflo(ov.y)), o3 = dv[3] * rs * nw[3] * sigmoidf_(bfhi(ov.y));
        u32x2 wv; wv.x = pk2(o0, o1); wv.y = pk2(o2, o3);
        *(u32x2*)((bf16_t*)(p.ws + WS_MIXIN) + (size_t)(r0 + t) * D + h * 256 + e4) = wv;
    }
    __syncthreads();
}

DEV void smp_ssd(const P& p, int l, int unit, unsigned char* lds) {
    const int b = unit >> 1, g = unit & 1;
    int tid_ = threadIdx.x; asm volatile("" : "+v"(tid_)); const int tid = tid_, lane = tid & 63, w = tid >> 6, fr = lane & 15, fq = lane >> 4;
    const int r0 = NPR + b * 8;
    const bf16_t* U = (const bf16_t*)(p.ws + WS_U) + (size_t)r0 * INP;
    float* xs = (float*)lds;
    float* xwT = xs + 4096;
    float* Bmf = xwT + 4096;
    float* CBs = Bmf + 1024;
    float* bsh = CBs + 64;
    float* dtsh = bsh + 64;
    float* bLs = dtsh + 64;
    float* MW = bLs + 64;
    float* red = MW + 512;
    float* stat = red + 64;
    bf16_t* Cmb = (bf16_t*)(stat + 64);
    if (tid < 64) {
        const int hd = tid >> 3, t = tid & 7, head = g * 8 + hd;
        const float A = -expf(p.A_log[l * 16 + head]), dtb = p.dt_bias[l * 16 + head];
        float bs = 0.f, bL = 0.f, dtt = 0.f;
        for (int s = 0; s < 8; ++s) { const float dt = softplusf_(bf2f(U[(size_t)s * INP + UDT + head]) + dtb); bL += dt * A; if (s <= t) bs += dt * A; if (s == t) dtt = dt; }
        bsh[hd * 8 + t] = bs; dtsh[hd * 8 + t] = dtt; if (t == 0) bLs[hd] = bL;
    }
    for (int i = tid; i < 8 * 136 / 2; i += NTHR) ((unsigned*)(Cmb + 8 * 136))[i] = 0u;
    const float* cw = p.s_conv_w + (size_t)l * 4 * 1536; const float* cb = p.s_conv_b + (size_t)l * 1536;
    const float* cv0 = p.st_sconv + (size_t)(l * 128 + b) * 3 * 1536;
    for (int i = 0; i < 2; ++i) {
        const int it = tid + 512 * i;
        if (it < 768) {
            const int t = it / 96, gidx = it % 96;
            const int ch8 = gidx < 64 ? g * 512 + gidx * 8 : (gidx < 80 ? 1024 + g * 128 + (gidx - 64) * 8 : 1280 + g * 128 + (gidx - 80) * 8);
            float o[8];
            { const f32x4 b0 = *(const f32x4*)(cb + ch8), b1 = *(const f32x4*)(cb + ch8 + 4); o[0] = b0[0]; o[1] = b0[1]; o[2] = b0[2]; o[3] = b0[3]; o[4] = b1[0]; o[5] = b1[1]; o[6] = b1[2]; o[7] = b1[3]; }
#pragma unroll
            for (int j = 0; j < 4; ++j) {
                const int idx = t + j;
                float xf[8];
                if (idx < 3) { const f32x4 a0 = *(const f32x4*)(cv0 + idx * 1536 + ch8), a1 = *(const f32x4*)(cv0 + idx * 1536 + ch8 + 4);
                    xf[0] = a0[0]; xf[1] = a0[1]; xf[2] = a0[2]; xf[3] = a0[3]; xf[4] = a1[0]; xf[5] = a1[1]; xf[6] = a1[2]; xf[7] = a1[3]; }
                else { const uint4 x = *(const uint4*)(U + (size_t)(idx - 3) * INP + UXS + ch8); unpack8(x, xf); }
                const f32x4 w0 = *(const f32x4*)(cw + j * 1536 + ch8), w1 = *(const f32x4*)(cw + j * 1536 + ch8 + 4);
                o[0] += w0[0] * xf[0]; o[1] += w0[1] * xf[1]; o[2] += w0[2] * xf[2]; o[3] += w0[3] * xf[3];
                o[4] += w1[0] * xf[4]; o[5] += w1[1] * xf[5]; o[6] += w1[2] * xf[6]; o[7] += w1[3] * xf[7];
            }
#pragma unroll
            for (int k = 0; k < 8; ++k) o[k] = siluf_(o[k]);
            if (gidx < 64) {
#pragma unroll
                for (int k = 0; k < 8; ++k) xs[t * 512 + gidx * 8 + k] = o[k]; }
            else if (gidx < 80) {
#pragma unroll
                for (int k = 0; k < 8; ++k) Bmf[t * 128 + (gidx - 64) * 8 + k] = o[k]; }
            else { u32x4 wv; wv.x = pk2(o[0], o[1]); wv.y = pk2(o[2], o[3]); wv.z = pk2(o[4], o[5]); wv.w = pk2(o[6], o[7]); *(u32x4*)(Cmb + t * 136 + (gidx - 80) * 8) = wv; }
        }
    }
    __syncthreads();
#pragma unroll
    for (int i = 0; i < 8; ++i) {
        const int idx = tid + 512 * i, hp = idx >> 3, s = idx & 7, hd = hp >> 6;
        xwT[hp * 8 + s] = xs[s * 512 + hp] * expf(bLs[hd] - bsh[hd * 8 + s]) * dtsh[hd * 8 + s];
    }
    if (tid < 64) {
        const int t = tid >> 3, s = tid & 7; float a = 0.f;
        for (int n = 0; n < 128; ++n) a += bf2f(Cmb[t * 136 + n]) * Bmf[s * 128 + n];
        CBs[t * 8 + s] = a;
    }
    __syncthreads();
    { const int hd = tid >> 6, t = (tid >> 3) & 7, s = tid & 7;
      MW[tid] = (s <= t) ? CBs[t * 8 + s] * expf(bsh[hd * 8 + t] - bsh[hd * 8 + s]) * dtsh[hd * 8 + s] : 0.f; }
    __syncthreads();
    const int head = g * 8 + w;
    const size_t sidx = (size_t)(l * 128 + b) * 16 + head;
    const float* S0 = p.st_ssm + sidx * 8192; float* So = p.out + O_SS + sidx * 8192;
    const float dA = expf(bLs[w]);
    f32x4 acc[4];
#pragma unroll
    for (int nt = 0; nt < 4; ++nt) {
        acc[nt] = (f32x4){0.f, 0.f, 0.f, 0.f};
        const int pp = 16 * nt + fr;
        const f32x4 xw0 = *(const f32x4*)(xwT + (64 * w + pp) * 8), xw1 = *(const f32x4*)(xwT + (64 * w + pp) * 8 + 4);
        f32x4 sv[4][2];
#pragma unroll
        for (int ks = 0; ks < 4; ++ks) { sv[ks][0] = __builtin_nontemporal_load((const f32x4*)(S0 + pp * 128 + 32 * ks + fq * 8)); sv[ks][1] = __builtin_nontemporal_load((const f32x4*)(S0 + pp * 128 + 32 * ks + fq * 8 + 4)); }
#pragma unroll
        for (int ks = 0; ks < 4; ++ks) {
            const int n0 = 32 * ks + fq * 8;
            const f32x4 s0 = sv[ks][0], s1 = sv[ks][1];
            union { u32x4 u; bf16x8 v; } bfr;
            bfr.u.x = pk2(s0[0], s0[1]); bfr.u.y = pk2(s0[2], s0[3]); bfr.u.z = pk2(s1[0], s1[1]); bfr.u.w = pk2(s1[2], s1[3]);
            const bf16x8 af = *(const bf16x8*)(Cmb + fr * 136 + n0);
            acc[nt] = mfma16(af, bfr.v, acc[nt]);
            f32x4 o0 = s0 * dA, o1 = s1 * dA;
#pragma unroll
            for (int s = 0; s < 8; ++s) {
                const float xv = s < 4 ? xw0[s & 3] : xw1[s & 3];
                const f32x4 bm0 = *(const f32x4*)(Bmf + s * 128 + n0), bm1 = *(const f32x4*)(Bmf + s * 128 + n0 + 4);
                o0 += bm0 * xv; o1 += bm1 * xv;
            }
            __builtin_nontemporal_store(o0, (f32x4*)(So + pp * 128 + n0)); __builtin_nontemporal_store(o1, (f32x4*)(So + pp * 128 + n0 + 4));
        }
        asm volatile("" ::: "memory");
    }
    const float dsk = p.D_skip[l * 16 + head];
    float gts[4][4];
#pragma unroll
    for (int j = 0; j < 4; ++j) {
        const int t = (fq & 1) * 4 + j;
        const float eb = expf(bsh[w * 8 + t]);
        float ssq = 0.f;
#pragma unroll
        for (int nt = 0; nt < 4; ++nt) {
            const int hp = 64 * w + 16 * nt + fr;
            float y = eb * acc[nt][j] + dsk * xs[t * 512 + hp];
#pragma unroll
            for (int s = 0; s < 8; ++s) y += MW[(w * 8 + t) * 8 + s] * xs[s * 512 + hp];
            const float z = bf2f(U[(size_t)t * INP + UZ + g * 512 + hp]);
            const float gt = y * siluf_(z);
            gts[nt][j] = gt; ssq += gt * gt;
        }
        ssq += __shfl_xor(ssq, 1); ssq += __shfl_xor(ssq, 2); ssq += __shfl_xor(ssq, 4); ssq += __shfl_xor(ssq, 8);
        if (fr == 0 && fq < 2) red[t * 8 + w] = ssq;
    }
    __syncthreads();
    if (tid < 8) { float s = 0.f;
#pragma unroll
        for (int i = 0; i < 8; ++i) s += red[tid * 8 + i];
        stat[tid] = rsqrtf(s * (1.0f / 512.0f) + 1e-6f); }
    __syncthreads();
    if (fq < 2) {
        bf16_t* MX = (bf16_t*)(p.ws + WS_MIXIN);
#pragma unroll
        for (int j = 0; j < 4; ++j) {
            const int t = fq * 4 + j;
#pragma unroll
            for (int nt = 0; nt < 4; ++nt) {
                const int ch = g * 512 + 64 * w + 16 * nt + fr;
                MX[(size_t)(r0 + t) * D + 1024 + ch] = f2bf(gts[nt][j] * stat[t] * p.s_norm_w[l * 1024 + ch]);
            }
        }
    }
    __syncthreads();
}

DEV void phase_ln(const P& p, int l, int which) {
    const int lane = threadIdx.x & 63, w = threadIdx.x >> 6;
    const float* gam = (which ? p.ln2_g : p.ln1_g) + l * D; const float* bet = (which ? p.ln2_b : p.ln1_b) + l * D;
    const float* mix = (const float*)(p.ws + WS_MIXF);
    float* xf = (float*)(p.ws + WS_XF); bf16_t* xb = (bf16_t*)(p.ws + WS_XB);
    const bool first = (l == 0 && which == 0), lastp = (l == 1 && which == 1), split = (gridDim.x == 256);
    for (int r = blockIdx.x * 8 + w; r < NTOK; r += gridDim.x * 8) {
        const float* src = first ? (r < NPR ? p.x_prompt + (size_t)r * D : p.x_sample + (size_t)(r - NPR) * D) : xf + (size_t)r * D;
        float* dst = lastp ? p.out + (size_t)r * D : xf + (size_t)r * D;
        f32x4 y[8]; float s = 0.f;
#pragma unroll
        for (int i = 0; i < 8; ++i) { const int cidx = i * 256 + lane * 4;
            f32x4 mv;
            if (split && r >= NPR) { const float* pp = (const float*)(p.ws + WS_PART) + (size_t)(r - NPR) * D + cidx; mv = *(const f32x4*)pp;
#pragma unroll
                for (int k = 1; k < 8; ++k) mv += *(const f32x4*)(pp + (size_t)k * NSM * D); }
            else mv = *(const f32x4*)(mix + (size_t)r * D + cidx);
            y[i] = *(const f32x4*)(src + cidx) * ALPHA + mv; s += (y[i][0] + y[i][1]) + (y[i][2] + y[i][3]); }
        const float mu = wave_sum(s) * (1.0f / D);
        float q = 0.f;
#pragma unroll
        for (int i = 0; i < 8; ++i) { y[i] = y[i] - mu; q += (y[i][0] * y[i][0] + y[i][1] * y[i][1]) + (y[i][2] * y[i][2] + y[i][3] * y[i][3]); }
        const float rs = rsqrtf(wave_sum(q) * (1.0f / D) + 1e-5f);
#pragma unroll
        for (int i = 0; i < 8; ++i) { const int cidx = i * 256 + lane * 4;
            const f32x4 o = y[i] * rs * *(const f32x4*)(gam + cidx) + *(const f32x4*)(bet + cidx);
            *(f32x4*)(dst + cidx) = o;
            u32x2 wv; wv.x = pk2(o[0], o[1]); wv.y = pk2(o[2], o[3]);
            *(u32x2*)(xb + (size_t)r * D + cidx) = wv; }
    }
}

DEV void phase_ffn_gate(const P& p, int l) {
    const bf16_t* up = (const bf16_t*)(p.ws + WS_UP); bf16_t* act = (bf16_t*)(p.ws + WS_ACT);
    const float* fw = p.f_conv_w + (size_t)l * 3 * DFF2; const float* fb = p.f_conv_b + (size_t)l * DFF2;
    const int total = (NTOK / 8) * (DFF / 8);
    for (int it = blockIdx.x * NTHR + threadIdx.x; it < total; it += gridDim.x * NTHR) {
        const int rb = it / (DFF / 8), j8 = (it % (DFF / 8)) * 8, r0 = rb * 8;
        const bool smp = r0 >= NPR; const int t0 = smp ? 0 : (r0 & 2047); const int sb = (r0 - NPR) >> 3;
        float wg[3][8], wv[3][8], bg[8], bv[8];
#pragma unroll
        for (int k = 0; k < 3; ++k) {
            const f32x4 a0 = *(const f32x4*)(fw + k * DFF2 + j8), a1 = *(const f32x4*)(fw + k * DFF2 + j8 + 4), c0 = *(const f32x4*)(fw + k * DFF2 + DFF + j8), c1 = *(const f32x4*)(fw + k * DFF2 + DFF + j8 + 4);
#pragma unroll
            for (int i = 0; i < 4; ++i) { wg[k][i] = a0[i]; wg[k][4 + i] = a1[i]; wv[k][i] = c0[i]; wv[k][4 + i] = c1[i]; }
        }
        { const f32x4 a0 = *(const f32x4*)(fb + j8), a1 = *(const f32x4*)(fb + j8 + 4), c0 = *(const f32x4*)(fb + DFF + j8), c1 = *(const f32x4*)(fb + DFF + j8 + 4);
#pragma unroll
          for (int i = 0; i < 4; ++i) { bg[i] = a0[i]; bg[4 + i] = a1[i]; bv[i] = c0[i]; bv[4 + i] = c1[i]; } }
        float g0[8], g1[8], v0[8], v1[8];
        if (t0 > 0) {
            unpack8(*(const uint4*)(up + (size_t)(r0 - 2) * DFF2 + j8), g0); unpack8(*(const uint4*)(up + (size_t)(r0 - 2) * DFF2 + DFF + j8), v0);
            unpack8(*(const uint4*)(up + (size_t)(r0 - 1) * DFF2 + j8), g1); unpack8(*(const uint4*)(up + (size_t)(r0 - 1) * DFF2 + DFF + j8), v1);
        } else if (smp) {
            const float* bp = p.st_fconv + (size_t)(l * 128 + sb) * 2 * DFF2;
            const f32x4 a0 = *(const f32x4*)(bp + j8), a1 = *(const f32x4*)(bp + j8 + 4), c0 = *(const f32x4*)(bp + DFF + j8), c1 = *(const f32x4*)(bp + DFF + j8 + 4);
            const f32x4 d0 = *(const f32x4*)(bp + DFF2 + j8), d1 = *(const f32x4*)(bp + DFF2 + j8 + 4), e0 = *(const f32x4*)(bp + DFF2 + DFF + j8), e1 = *(const f32x4*)(bp + DFF2 + DFF + j8 + 4);
#pragma unroll
            for (int i = 0; i < 4; ++i) { g0[i] = a0[i]; g0[4 + i] = a1[i]; v0[i] = c0[i]; v0[4 + i] = c1[i]; g1[i] = d0[i]; g1[4 + i] = d1[i]; v1[i] = e0[i]; v1[4 + i] = e1[i]; }
        } else {
#pragma unroll
            for (int i = 0; i < 8; ++i) { g0[i] = 0.f; g1[i] = 0.f; v0[i] = 0.f; v1[i] = 0.f; }
        }
#pragma unroll
        for (int rr = 0; rr < 8; ++rr) {
            float g2[8], v2[8];
            unpack8(*(const uint4*)(up + (size_t)(r0 + rr) * DFF2 + j8), g2); unpack8(*(const uint4*)(up + (size_t)(r0 + rr) * DFF2 + DFF + j8), v2);
            float o[8];
#pragma unroll
            for (int i = 0; i < 8; ++i) {
                const float ag = bg[i] + wg[0][i] * g0[i] + wg[1][i] * g1[i] + wg[2][i] * g2[i];
                const float av = bv[i] + wv[0][i] * v0[i] + wv[1][i] * v1[i] + wv[2][i] * v2[i];
                o[i] = ag * __builtin_amdgcn_rcpf(1.0f + __expf(-ag)) * av;
                g0[i] = g1[i]; g1[i] = g2[i]; v0[i] = v1[i]; v1[i] = v2[i];
            }
            u32x4 wv4; wv4.x = pk2(o[0], o[1]); wv4.y = pk2(o[2], o[3]); wv4.z = pk2(o[4], o[5]); wv4.w = pk2(o[6], o[7]);
            *(u32x4*)(act + (size_t)(r0 + rr) * DFF + j8) = wv4;
        }
    }
    const int tot2 = 132 * 2 * (DFF2 / 8);
    for (int it = blockIdx.x * NTHR + threadIdx.x; it < tot2; it += gridDim.x * NTHR) {
        const int c8 = (it % (DFF2 / 8)) * 8, rr = it / (DFF2 / 8), j = rr & 1, sq = rr >> 1;
        float* o; size_t row;
        if (sq < 4) { o = p.out + O_PFC + ((size_t)(l * 4 + sq) * 2 + j) * DFF2 + c8; row = (size_t)sq * 2048 + 2046 + j; }
        else { const int b = sq - 4; o = p.out + O_SFC + ((size_t)(l * 128 + b) * 2 + j) * DFF2 + c8; row = (size_t)NPR + b * 8 + 6 + j; }
        float xf[8]; unpack8(*(const uint4*)(up + row * DFF2 + c8), xf);
        *(f32x4*)o = (f32x4){xf[0], xf[1], xf[2], xf[3]}; *(f32x4*)(o + 4) = (f32x4){xf[4], xf[5], xf[6], xf[7]};
    }
}


#define XB_TMO      128
#define XB_XCNT(j)  (256  + 64 * (j))
#define XB_XSUB(j)  (1280 + 64 * (j))
#define XB_XGEN(j)  (2304 + 64 * (j))
#define XB_TOP      3328
#define XB_TOPGEN   3392
#define XCD_BAR_WORDS 3456
#define XB_SPIN_CAP (1u << 20)
DEV unsigned xb_ld(unsigned* p)              { return __hip_atomic_load(p, __ATOMIC_RELAXED, __HIP_MEMORY_SCOPE_AGENT); }
DEV unsigned xb_add(unsigned* p, unsigned v) { return __hip_atomic_fetch_add(p, v, __ATOMIC_RELAXED, __HIP_MEMORY_SCOPE_AGENT); }
DEV unsigned xb_xcc_id() { return (unsigned)__builtin_amdgcn_s_getreg((3 << 11) | 20) & 0xFu; }
#define XB_SPIN(cond, bar) do { unsigned _sp = 0; while (cond) { __builtin_amdgcn_s_sleep(1); \
    if ((++_sp & 255u) == 0u) { if (xb_ld(&(bar)[XB_TMO])) break; if (_sp > XB_SPIN_CAP) { atomicAdd(&(bar)[XB_TMO], 1u); break; } } } } while (0)
struct XcdBarrier { unsigned* bar; unsigned x; volatile LAS unsigned* st; };
DEV XcdBarrier xcd_barrier_post(unsigned* bar, volatile LAS unsigned* st) {
    XcdBarrier b; b.bar = bar; b.x = xb_xcc_id(); b.st = st;
    if (threadIdx.x == 0) (void)xb_add(&bar[XB_XCNT(b.x)], 1u);
    return b;
}
DEV void xcd_barrier_complete(unsigned* bar, unsigned x, unsigned& nloc, unsigned& nx) {
    const unsigned G = gridDim.x * gridDim.y * gridDim.z;
    unsigned sum, cnt, mine, sp = 0u;
    for (;;) {
        sum = 0u; cnt = 0u; mine = 0u;
#pragma unroll
        for (unsigned j = 0; j < 16; ++j) { const unsigned c = xb_ld(&bar[XB_XCNT(j)]); sum += c; cnt += (c > 0u) ? 1u : 0u; mine = (j == x) ? c : mine; }
        if (sum == G) break;
        __builtin_amdgcn_s_sleep(1);
        if ((++sp & 255u) == 0u) { if (xb_ld(&bar[XB_TMO])) break; if (sp > XB_SPIN_CAP) { atomicAdd(&bar[XB_TMO], 1u); break; } }
    }
    nloc = mine > 0u ? mine : 1u; nx = cnt > 0u ? cnt : 1u;
}
DEV void xcd_barrier(const XcdBarrier& b) {
    asm volatile("s_waitcnt vmcnt(0)" ::: "memory");
    __syncthreads();
    if (threadIdx.x == 0) {
        unsigned* bar = b.bar;
        __builtin_amdgcn_s_waitcnt(0);
        unsigned nloc = b.st[0], nx = b.st[1];
        if (nloc == 0u) { xcd_barrier_complete(bar, b.x, nloc, nx); b.st[0] = nloc; b.st[1] = nx; }
        const unsigned old = xb_add(&bar[XB_XSUB(b.x)], 1u);
        const unsigned gen = old / nloc;
        if (old + 1u == (gen + 1u) * nloc) {
            __builtin_amdgcn_fence(__ATOMIC_RELEASE, "agent");
            asm volatile("s_waitcnt vmcnt(0)" ::: "memory");
            const unsigned og = xb_add(&bar[XB_TOP], 1u);
            const unsigned tg = og / nx;
            if (og + 1u == (tg + 1u) * nx) xb_add(&bar[XB_TOPGEN], 1u);
            else XB_SPIN(xb_ld(&bar[XB_TOPGEN]) == tg, bar);
            __builtin_amdgcn_fence(__ATOMIC_ACQUIRE, "agent");
            xb_add(&bar[XB_XGEN(b.x)], 1u);
            asm volatile("s_waitcnt vmcnt(0)" ::: "memory");
        } else {
            XB_SPIN(xb_ld(&bar[XB_XGEN(b.x)]) == gen, bar);
            __builtin_amdgcn_fence(__ATOMIC_ACQUIRE, "agent");
            asm volatile("s_waitcnt vmcnt(0)" ::: "memory");
        }
    }
    __syncthreads();
}

constexpr int NPHASE = 21;
DEV void run_phase(const P& p, int l, int q, unsigned char* lds) {
    int bid = blockIdx.x, G = gridDim.x; asm volatile("" : "+s"(bid), "+s"(G));
    if (q == 0) {
        pg8::Gemm g{(const bf16_t*)(p.ws + WS_XB), (const bf16_t*)(p.ws + WS_WIN) + (size_t)l * INP * D, NTOK, INP, D};
        pg8::StaticOrder S; S.init(NTOK, INP, D, G, bid);
        pg8::EpiBf16 E{(bf16_t*)(p.ws + WS_U), INP};
        pg8::gemm_phase<pg8::EpiBf16, pg8::StaticOrder>((LAS unsigned char*)lds, g, S, E);
    } else if (q == 1) {
        const int par = bid & 1;
#pragma unroll 1
        for (int half = 0; half < 2; ++half) {
            if ((half ^ par) == 0) {
                for (int u = bid; u < 512; u += G) smp_mlstm(p, l, u, lds);
                for (int u = bid; u < 256; u += G) smp_ssd(p, l, u, lds);
            } else {
                for (int u = bid; u < 512; u += G) mlstm_local(p, l, u, lds);
                for (int u = bid; u < 256; u += G) ssd_local(p, l, u, lds);
            }
        }
    } else if (q == 2) {
        for (int u = bid; u < 256; u += G) mlstm_scan(p, l, u, lds);
        for (int u = bid; u < 128; u += G) ssd_scan(p, l, u, lds);
        for (int u = bid; u < 132; u += G) convstate_copy(p, l, u);
    } else if (q == 3) {
        for (int u = bid; u < 512; u += G) mlstm_out(p, l, u, lds);
        for (int u = bid; u < 256; u += G) ssd_out(p, l, u, lds);
    } else if (q == 4) {
        pg8::Gemm g{(const bf16_t*)(p.ws + WS_MIXIN), (const bf16_t*)(p.ws + WS_WOUT) + (size_t)l * D * D, NTOK, D, D};
        pg8::EpiF32 E{(float*)(p.ws + WS_MIXF), D, (float*)(p.ws + WS_PART)};
        if (G == 256) { pg8::TailSplitOrder S; S.init(D, bid); pg8::gemm_phase<pg8::EpiF32, pg8::TailSplitOrder>((LAS unsigned char*)lds, g, S, E); }
        else { pg8::StaticOrder S; S.init(NTOK, D, D, G, bid); pg8::gemm_phase<pg8::EpiF32, pg8::StaticOrder>((LAS unsigned char*)lds, g, S, E); }
    } else if (q == 5) {
        phase_ln(p, l, 0);
    } else if (q == 6) {
        pg8::Gemm g{(const bf16_t*)(p.ws + WS_XB), (const bf16_t*)(p.ws + WS_WUP) + (size_t)l * DFF2 * D, NTOK, DFF2, D};
        pg8::StaticOrder S; S.init(NTOK, DFF2, D, G, bid);
        pg8::EpiBf16 E{(bf16_t*)(p.ws + WS_UP), DFF2};
        pg8::gemm_phase<pg8::EpiBf16, pg8::StaticOrder>((LAS unsigned char*)lds, g, S, E);
    } else if (q == 7) {
        phase_ffn_gate(p, l);
    } else if (q == 8) {
        pg8::Gemm g{(const bf16_t*)(p.ws + WS_ACT), (const bf16_t*)(p.ws + WS_WDN) + (size_t)l * D * DFF, NTOK, D, DFF};
        pg8::EpiF32 E{(float*)(p.ws + WS_MIXF), D, (float*)(p.ws + WS_PART)};
        if (G == 256) { pg8::TailSplitOrder S; S.init(DFF, bid); pg8::gemm_phase<pg8::EpiF32, pg8::TailSplitOrder>((LAS unsigned char*)lds, g, S, E); }
        else { pg8::StaticOrder S; S.init(NTOK, D, DFF, G, bid); pg8::gemm_phase<pg8::EpiF32, pg8::StaticOrder>((LAS unsigned char*)lds, g, S, E); }
    } else {
        phase_ln(p, l, 1);
    }
}
#if MK_MULTI
template <int T> __global__ void __launch_bounds__(NTHR, 2) k_unit(P p) {
    extern __shared__ __attribute__((aligned(16))) unsigned char lds[];
    const int l = p.ph_lo; int bid = blockIdx.x, G = gridDim.x;
    if (T == 11) for (int u = bid; u < 512; u += G) smp_mlstm(p, l, u, lds);
    if (T == 12) for (int u = bid; u < 256; u += G) smp_ssd(p, l, u, lds);
    if (T == 13) for (int u = bid; u < 512; u += G) mlstm_local(p, l, u, lds);
    if (T == 14) for (int u = bid; u < 256; u += G) ssd_local(p, l, u, lds);
    if (T == 31) for (int u = bid; u < 512; u += G) mlstm_out(p, l, u, lds);
    if (T == 32) for (int u = bid; u < 256; u += G) ssd_out(p, l, u, lds);
    if (T == 21) for (int u = bid; u < 256; u += G) mlstm_scan(p, l, u, lds);
    if (T == 22) for (int u = bid; u < 128; u += G) ssd_scan(p, l, u, lds);
}
template <int Q> __global__ void __launch_bounds__(NTHR, 2) k_phase(P p) {
    extern __shared__ __attribute__((aligned(16))) unsigned char lds[];
    if (Q < 0) phase_prologue(p, lds); else run_phase(p, p.ph_lo, Q, lds);
}
#else
__global__ void __launch_bounds__(NTHR, 2) mk_fwd(P p) {
    extern __shared__ __attribute__((aligned(16))) unsigned char lds[];
    cg::grid_group grid = cg::this_grid();
    if (p.ph_hi < 0) grid.sync();
    if (threadIdx.x < 4) ((unsigned*)(lds + LDS_BYTES - 16))[threadIdx.x] = 0u;
    __syncthreads();
    (void)xcd_barrier_post((unsigned*)(p.ws + WS_BAR), (volatile LAS unsigned*)(lds + LDS_BYTES - 16));
#define GSYNC() do { XcdBarrier b_; b_.bar = (unsigned*)(p.ws + WS_BAR); b_.x = xb_xcc_id(); b_.st = (volatile LAS unsigned*)(lds + LDS_BYTES - 16); xcd_barrier(b_); } while (0)
    phase_prologue(p, lds);
#pragma unroll 1
    for (int l = 0; l < 2; ++l) {
        GSYNC(); run_phase(p, l, 0, lds);
        GSYNC(); run_phase(p, l, 1, lds);
        GSYNC(); run_phase(p, l, 2, lds);
        GSYNC(); run_phase(p, l, 3, lds);
        GSYNC(); run_phase(p, l, 4, lds);
        GSYNC(); run_phase(p, l, 5, lds);
        GSYNC(); run_phase(p, l, 6, lds);
        GSYNC(); run_phase(p, l, 7, lds);
        GSYNC(); run_phase(p, l, 8, lds);
        GSYNC(); run_phase(p, l, 9, lds);
    }
    for (int i = 0; i < PROBE_SYNCS; ++i) GSYNC();
}
#endif

extern "C" void kernel_launch(void* const* d_in, const int* in_sizes, int n_in, void* d_out, int out_size, void* d_ws, size_t ws_size, hipStream_t stream) {
    static int grid = 0;
    if (grid == 0) {
        if (n_in != 27 || ws_size < WS_END) { fprintf(stderr, "kernel_launch: unexpected n_in %d or ws_size %zu (need %zu)\n", n_in, ws_size, (size_t)WS_END); grid = -1; return; }
        int dev = 0, cus = 0, per_cu = 0;
        hipGetDevice(&dev);
        hipDeviceGetAttribute(&cus, hipDeviceAttributeMultiprocessorCount, dev);
#if MK_MULTI
        const void* fns[11] = {(const void*)k_phase<-1>, (const void*)k_phase<0>, (const void*)k_phase<1>, (const void*)k_phase<2>, (const void*)k_phase<3>, (const void*)k_phase<4>, (const void*)k_phase<5>,
                               (const void*)k_phase<6>, (const void*)k_phase<7>, (const void*)k_phase<8>, (const void*)k_phase<9>};
        for (int i = 0; i < 11; ++i) if (hipFuncSetAttribute(fns[i], hipFuncAttributeMaxDynamicSharedMemorySize, LDS_BYTES) != hipSuccess) { fprintf(stderr, "kernel_launch: hipFuncSetAttribute failed\n"); grid = -1; return; }
#else
        if (hipFuncSetAttribute((const void*)mk_fwd, hipFuncAttributeMaxDynamicSharedMemorySize, LDS_BYTES) != hipSuccess) { fprintf(stderr, "kernel_launch: hipFuncSetAttribute failed\n"); grid = -1; return; }
        hipOccupancyMaxActiveBlocksPerMultiprocessor(&per_cu, (const void*)mk_fwd, NTHR, LDS_BYTES);
        (void)hipGetLastError();
#endif
        (void)per_cu;
        grid = cus * 1;
    }
    if (grid < 0) return;
    P p{};
    const float** pp = (const float**)&p;
    for (int i = 0; i < 27; ++i) pp[i] = (const float*)d_in[i];
    p.out = (float*)d_out; p.ws = (unsigned char*)d_ws;
#if MK_MULTI
    p.ph_lo = 0; p.ph_hi = 0;
    if (PROBE_REP == -1) hipLaunchKernelGGL(k_phase<-1>, dim3(grid), dim3(NTHR), LDS_BYTES, stream, p);
    hipLaunchKernelGGL(k_phase<-1>, dim3(grid), dim3(NTHR), LDS_BYTES, stream, p);
    for (int l = 0; l < 2; ++l) {
        p.ph_lo = l;
        for (int rep = 0; rep < 1 + ((PROBE_REP == 0) || (PROBE_REP == 100 && (0 == 0 || 0 == 4 || 0 == 6 || 0 == 8))); ++rep) hipLaunchKernelGGL(k_phase<0>, dim3(grid), dim3(NTHR), LDS_BYTES, stream, p);
        for (int rep = 0; rep < 1 + ((PROBE_REP == 1) || (PROBE_REP == 100 && (1 == 0 || 1 == 4 || 1 == 6 || 1 == 8))); ++rep) hipLaunchKernelGGL(k_phase<1>, dim3(grid), dim3(NTHR), LDS_BYTES, stream, p);
        for (int rep = 0; rep < 1 + ((PROBE_REP == 2) || (PROBE_REP == 100 && (2 == 0 || 2 == 4 || 2 == 6 || 2 == 8))); ++rep) hipLaunchKernelGGL(k_phase<2>, dim3(grid), dim3(NTHR), LDS_BYTES, stream, p);
        for (int rep = 0; rep < 1 + ((PROBE_REP == 3) || (PROBE_REP == 100 && (3 == 0 || 3 == 4 || 3 == 6 || 3 == 8))); ++rep) hipLaunchKernelGGL(k_phase<3>, dim3(grid), dim3(NTHR), LDS_BYTES, stream, p);
        if (PROBE_REP == 11 || PROBE_REP == 12 || PROBE_REP == 13 || PROBE_REP == 14 || PROBE_REP == 31 || PROBE_REP == 32 || PROBE_REP == 21 || PROBE_REP == 22) {
            hipFuncSetAttribute((const void*)k_unit<PROBE_REP>, hipFuncAttributeMaxDynamicSharedMemorySize, LDS_BYTES);
            hipLaunchKernelGGL(k_unit<PROBE_REP>, dim3(grid), dim3(NTHR), LDS_BYTES, stream, p);
        }
        for (int rep = 0; rep < 1 + ((PROBE_REP == 4) || (PROBE_REP == 100 && (4 == 0 || 4 == 4 || 4 == 6 || 4 == 8))); ++rep) hipLaunchKernelGGL(k_phase<4>, dim3(grid), dim3(NTHR), LDS_BYTES, stream, p);
        for (int rep = 0; rep < 1 + ((PROBE_REP == 5) || (PROBE_REP == 100 && (5 == 0 || 5 == 4 || 5 == 6 || 5 == 8))); ++rep) hipLaunchKernelGGL(k_phase<5>, dim3(grid), dim3(NTHR), LDS_BYTES, stream, p);
        for (int rep = 0; rep < 1 + ((PROBE_REP == 6) || (PROBE_REP == 100 && (6 == 0 || 6 == 4 || 6 == 6 || 6 == 8))); ++rep) hipLaunchKernelGGL(k_phase<6>, dim3(grid), dim3(NTHR), LDS_BYTES, stream, p);
        for (int rep = 0; rep < 1 + ((PROBE_REP == 7) || (PROBE_REP == 100 && (7 == 0 || 7 == 4 || 7 == 6 || 7 == 8))); ++rep) hipLaunchKernelGGL(k_phase<7>, dim3(grid), dim3(NTHR), LDS_BYTES, stream, p);
        for (int rep = 0; rep < 1 + ((PROBE_REP == 8) || (PROBE_REP == 100 && (8 == 0 || 8 == 4 || 8 == 6 || 8 == 8))); ++rep) hipLaunchKernelGGL(k_phase<8>, dim3(grid), dim3(NTHR), LDS_BYTES, stream, p);
        for (int rep = 0; rep < 1 + ((PROBE_REP == 9) || (PROBE_REP == 100 && (9 == 0 || 9 == 4 || 9 == 6 || 9 == 8))); ++rep) hipLaunchKernelGGL(k_phase<9>, dim3(grid), dim3(NTHR), LDS_BYTES, stream, p);
    }
#else
    p.ph_lo = 0; p.ph_hi = NPHASE;
    if (hipMemsetAsync((char*)d_ws + WS_BAR, 0, 16384, stream) != hipSuccess) { fprintf(stderr, "kernel_launch: memset failed\n"); return; }
    void* args[] = {&p};
    hipError_t e = hipLaunchCooperativeKernel((const void*)mk_fwd, dim3(grid), dim3(NTHR), args, LDS_BYTES, stream);
    if (e != hipSuccess) fprintf(stderr, "cooperative launch failed: %s (grid %d)\n", hipGetErrorString(e), grid);
#endif
}
```

```cpp
#include <hip/hip_runtime.h>
#include <hip/hip_cooperative_groups.h>
#include <cstdio>
namespace cg = cooperative_groups;

#ifndef MK_MULTI
#define MK_MULTI 0
#endif
#ifndef PROBE_REP
#define PROBE_REP -99
#endif
#ifndef PROBE_SYNCS
#define PROBE_SYNCS 0
#endif

#define DEV __device__ __forceinline__
#define LAS __attribute__((address_space(3)))
typedef unsigned short bf16_t;
typedef short bf16x8 __attribute__((ext_vector_type(8)));
typedef float f32x4 __attribute__((ext_vector_type(4)));
typedef float f32x2 __attribute__((ext_vector_type(2)));
typedef unsigned u32x4 __attribute__((ext_vector_type(4)));
typedef unsigned u32x2 __attribute__((ext_vector_type(2)));

constexpr int D = 2048, NPR = 8192, NSM = 1024, NTOK = 9216, INP = 6912, IN_DIM = 6680, DFF = 5504, DFF2 = 11008;
constexpr int UQ = 0, UK = 1024, UV = 2048, UO = 3072, UZ = 4096, UXS = 5120, UIG = 6656, UFG = 6660, UDT = 6664;
constexpr int NTHR = 512;
constexpr int LDS_BYTES = 136 * 1024;
constexpr float ALPHA = 1.41421356237309515f;

constexpr size_t O_YP = 0;
constexpr size_t O_YS = O_YP + (size_t)4 * 2048 * 2048;
constexpr size_t O_PC = O_YS + (size_t)128 * 8 * 2048;
constexpr size_t O_PN = O_PC + (size_t)2 * 4 * 4 * 256 * 256;
constexpr size_t O_PM = O_PN + (size_t)2 * 4 * 4 * 256;
constexpr size_t O_PS = O_PM + (size_t)2 * 4 * 4;
constexpr size_t O_PSC = O_PS + (size_t)2 * 4 * 16 * 64 * 128;
constexpr size_t O_PFC = O_PSC + (size_t)2 * 4 * 3 * 1536;
constexpr size_t O_SC = O_PFC + (size_t)2 * 4 * 2 * DFF2;
constexpr size_t O_SN = O_SC + (size_t)2 * 128 * 4 * 256 * 256;
constexpr size_t O_SM = O_SN + (size_t)2 * 128 * 4 * 256;
constexpr size_t O_SS = O_SM + (size_t)2 * 128 * 4;
constexpr size_t O_SSC = O_SS + (size_t)2 * 128 * 16 * 64 * 128;
constexpr size_t O_SFC = O_SSC + (size_t)2 * 128 * 3 * 1536;

constexpr size_t WS_WIN = 0;
constexpr size_t WS_WOUT = WS_WIN + (size_t)2 * INP * D * 2;
constexpr size_t WS_WUP = WS_WOUT + (size_t)2 * D * D * 2;
constexpr size_t WS_WDN = WS_WUP + (size_t)2 * DFF2 * D * 2;
constexpr size_t WS_XB = WS_WDN + (size_t)2 * D * DFF * 2;
constexpr size_t WS_XF = WS_XB + (size_t)NTOK * D * 2;
constexpr size_t WS_U = WS_XF + (size_t)NTOK * D * 4;
constexpr size_t WS_MIXIN = WS_U + (size_t)NTOK * INP * 2;
constexpr size_t WS_MIXF = WS_MIXIN + (size_t)NTOK * D * 2;
constexpr size_t WS_UP = WS_MIXF + (size_t)NTOK * D * 4;
constexpr size_t WS_ACT = WS_UP + (size_t)NTOK * DFF2 * 2;
constexpr size_t WS_PART = WS_ACT + (size_t)NTOK * DFF * 2;
constexpr size_t WS_SMALL = WS_PART + (size_t)8 * NSM * D * 4;
constexpr size_t WS_DBUF = WS_UP;
constexpr size_t WS_SBUF = WS_UP + (size_t)512 * 65536 * 4;
constexpr size_t WS_CT = WS_ACT;
constexpr size_t WS_ST = WS_ACT + (size_t)512 * 65536 * 2;
static_assert(WS_SBUF + (size_t)2048 * 8192 * 4 <= WS_ACT, "alias");
static_assert(WS_ST + (size_t)2048 * 8192 * 2 <= WS_PART, "alias");
constexpr size_t WS_NLOC = WS_SMALL;
constexpr size_t WS_NST = WS_NLOC + (size_t)512 * 256 * 4;
constexpr size_t WS_GSTAT = WS_NST + (size_t)512 * 256 * 4;
constexpr size_t WS_MST = WS_GSTAT + 4096;
constexpr size_t WS_SBSUM = WS_MST + 4096;
constexpr size_t WS_BAR = WS_SBSUM + 8192;
constexpr size_t WS_END = WS_BAR + 16384;

struct P {
    const float* x_prompt; const float* x_sample; const float* st_C; const float* st_n; const float* st_m; const float* st_ssm; const float* st_sconv; const float* st_fconv;
    const float* w_in; const float* b_i; const float* b_f; const float* m_norm_w; const float* s_conv_w; const float* s_conv_b; const float* dt_bias; const float* A_log; const float* D_skip;
    const float* s_norm_w; const float* w_out; const float* ln1_g; const float* ln1_b; const float* w_up; const float* f_conv_w; const float* f_conv_b; const float* w_down; const float* ln2_g; const float* ln2_b;
    float* out; unsigned char* ws; int ph_lo, ph_hi;
};

DEV float bf2f(bf16_t v) { return __uint_as_float(((unsigned)v) << 16); }
DEV bf16_t f2bf(float f) { unsigned u = __float_as_uint(f); u += 0x7FFFu + ((u >> 16) & 1u); return (bf16_t)(u >> 16); }
DEV unsigned pk2(float lo, float hi) { return (unsigned)f2bf(lo) | ((unsigned)f2bf(hi) << 16); }
DEV float bflo(unsigned w) { return __uint_as_float(w << 16); }
DEV float bfhi(unsigned w) { return __uint_as_float(w & 0xffff0000u); }
DEV float sigmoidf_(float x) { return __builtin_amdgcn_rcpf(1.0f + __expf(-x)); }
DEV float siluf_(float x) { return x * sigmoidf_(x); }
DEV float softplusf_(float x) { return fmaxf(x, 0.f) + log1pf(expf(-fabsf(x))); }
DEV float logsigf_(float x) { return fminf(x, 0.f) - log1pf(expf(-fabsf(x))); }
DEV float wave_sum(float v) {
#pragma unroll
    for (int o = 32; o >= 1; o >>= 1) v += __shfl_xor(v, o);
    return v; }
DEV float wave_max(float v) {
#pragma unroll
    for (int o = 32; o >= 1; o >>= 1) v = fmaxf(v, __shfl_xor(v, o));
    return v; }
DEV float wave_incl_sum(float v, int lane) {
#pragma unroll
    for (int o = 1; o < 64; o <<= 1) { float t = __shfl_up(v, o); if (lane >= o) v += t; }
    return v; }
DEV float wave_incl_max(float v, int lane) {
#pragma unroll
    for (int o = 1; o < 64; o <<= 1) { float t = __shfl_up(v, o); if (lane >= o) v = fmaxf(v, t); }
    return v; }
DEV f32x4 mfma16(bf16x8 a, bf16x8 b, f32x4 c) { return __builtin_amdgcn_mfma_f32_16x16x32_bf16(a, b, c, 0, 0, 0); }
DEV void unpack8(uint4 x, float (&f)[8]) { f[0] = bflo(x.x); f[1] = bfhi(x.x); f[2] = bflo(x.y); f[3] = bfhi(x.y); f[4] = bflo(x.z); f[5] = bfhi(x.z); f[6] = bflo(x.w); f[7] = bfhi(x.w); }

typedef short s16x4 __attribute__((ext_vector_type(4)));
DEV bf16x8 tr_frag(const bf16_t* T, int pitch, int krow0, int col0, int lane) {
    const int g = lane >> 4, q = (lane & 15) >> 2, pl = lane & 3;
    const bf16_t* a0 = T + (krow0 + 8 * g + q) * pitch + col0 + 4 * pl;
    const s16x4 lo = __builtin_amdgcn_ds_read_tr16_b64_v4i16((LAS s16x4*)a0);
    const s16x4 hi = __builtin_amdgcn_ds_read_tr16_b64_v4i16((LAS s16x4*)(a0 + 4 * pitch));
    return (bf16x8){lo[0], lo[1], lo[2], lo[3], hi[0], hi[1], hi[2], hi[3]};
}

namespace pg8 {
constexpr int BM = 256, BK = 64, HALF = 128, HTB = HALF * BK * 2, STAGE_BYTES = 8 * HTB, NXCD = 8, WGM = 8;
DEV int lds_byte(int r, int c) { const int st = (r >> 4) * 2 + (c >> 5), rr = r & 15, cc = c & 31, ob = rr * 64 + cc * 2; return st * 1024 + (ob ^ (((ob >> 9) & 1) << 5)); }
DEV void stage_rc(int b, int& R, int& C) { const int st = b / 1024, sb = b % 1024, swz = sb ^ (((sb >> 9) & 1) << 5); R = (st >> 1) * 16 + swz / 64; C = (st & 1) * 32 + (swz % 64) / 2; }
DEV int perm32(int rho) { const int n = rho >> 4, i = rho & 15; return 8 * (i >> 2) + 4 * n + (i & 3); }
struct Unit { int pm, pn, k0, nt, ks; };
struct Gemm { const bf16_t* A; const bf16_t* Bt; int M, N, K; };
struct StaticOrder {
    int nM, nN, nwg, G, c, ntk;
    DEV void init(int M, int N, int K, int G_, int c_) { nM = M / BM; nN = N / BM; nwg = nM * nN; G = G_; c = c_; ntk = K / BK; }
    DEV bool next(int i, Unit& u) const {
        u.pm = 0; u.pn = 0; u.k0 = 0; u.nt = 4; u.ks = -1;
        const long L = (long)i * G + c; if (L >= nwg) return false;
        int wgid = (int)L; { const int q = nwg / NXCD, r = nwg % NXCD, xcd = wgid % NXCD, off = wgid / NXCD; wgid = (xcd < r ? xcd * (q + 1) : r * (q + 1) + (xcd - r) * q) + off; }
        const int nig = WGM * nN, gid = wgid / nig, fm = gid * WGM, gsz = (nM - fm) < WGM ? (nM - fm) : WGM;
        u.pm = fm + ((wgid % nig) % gsz); u.pn = (wgid % nig) / gsz; u.k0 = 0; u.nt = ntk; u.ks = -1; return true;
    }
};
struct TailSplitOrder {
    StaticOrder so; int c, ntk;
    DEV void init(int K, int c_) { so.init(NPR, D, K, 256, c_); c = c_; ntk = K / BK; }
    DEV bool next(int i, Unit& u) const {
        u.pm = 0; u.pn = 0; u.k0 = 0; u.nt = 4; u.ks = -1;
        if (i == 0) return so.next(0, u);
        if (i > 1) return false;
        const int tt = c >> 3, ks = c & 7; u.pm = 32 + (tt >> 3); u.pn = tt & 7; u.ks = ks;
        const int pairs = ntk >> 1, base = pairs >> 3, rem = pairs & 7;
        const int p0 = ks * base + (ks < rem ? ks : rem), np = base + (ks < rem ? 1 : 0);
        u.k0 = p0 * 128; u.nt = np * 2; return true;
    }
};
DEV unsigned cvt_pk_bf16(float lo, float hi) { unsigned r; asm volatile("v_cvt_pk_bf16_f32 %0, %1, %2" : "=v"(r) : "v"(lo), "v"(hi)); return r; }
struct EpiF32 {
    static constexpr bool PERM = false;
    float* C; int ldc; float* part;
    DEV void operator()(const f32x4 (&acc)[2][2][4][2], const Unit& u, int wr, int wc, int fr, int fq) const {
        const int row0 = u.pm * BM + wr * 64 + fr, col0 = u.pn * BM + wc * 32 + 4 * fq;
        float* Cb = u.ks < 0 ? C : part + (size_t)u.ks * NSM * D - (size_t)NPR * ldc;
#pragma unroll
        for (int ai = 0; ai < 2; ++ai)
#pragma unroll
            for (int m = 0; m < 4; ++m) { float* rowp = Cb + (size_t)(row0 + ai * HALF + m * 16) * ldc + col0;
#pragma unroll
                for (int bj = 0; bj < 2; ++bj)
#pragma unroll
                    for (int n = 0; n < 2; ++n) *(f32x4*)(rowp + bj * HALF + n * 16) = acc[ai][bj][m][n]; }
    }
};
struct EpiBf16 {
    static constexpr bool PERM = true;
    bf16_t* O; int ldc; float* part;
    DEV void operator()(const f32x4 (&acc)[2][2][4][2], const Unit& u, int wr, int wc, int fr, int fq) const {
        const int row0 = u.pm * BM + wr * 64 + fr; const int col0 = u.pn * BM + wc * 32 + 8 * fq;
        if (u.ks >= 0) {
            float* pb = part + (size_t)u.ks * NSM * ldc + (size_t)(row0 - NPR) * ldc + col0;
#pragma unroll
            for (int ai = 0; ai < 2; ++ai)
#pragma unroll
                for (int m = 0; m < 4; ++m)
#pragma unroll
                    for (int bj = 0; bj < 2; ++bj) { float* q = pb + (size_t)(ai * HALF + m * 16) * ldc + bj * HALF; *(f32x4*)q = acc[ai][bj][m][0]; *(f32x4*)(q + 4) = acc[ai][bj][m][1]; }
            return;
        }
#pragma unroll
        for (int ai = 0; ai < 2; ++ai)
#pragma unroll
            for (int m = 0; m < 4; ++m) { bf16_t* rowp = O + (size_t)(row0 + ai * HALF + m * 16) * ldc + col0;
#pragma unroll
                for (int bj = 0; bj < 2; ++bj) { const f32x4 v0 = acc[ai][bj][m][0], v1 = acc[ai][bj][m][1];
                    u32x4 w; w.x = cvt_pk_bf16(v0[0], v0[1]); w.y = cvt_pk_bf16(v0[2], v0[3]); w.z = cvt_pk_bf16(v1[0], v1[1]); w.w = cvt_pk_bf16(v1[2], v1[3]);
                    *(u32x4*)(rowp + bj * HALF) = w; } }
    }
};

template <class Epi, class Sched>
DEV void gemm_phase(LAS unsigned char* lds, const Gemm g, const Sched& S, const Epi& E) {
    int tid_ = threadIdx.x; asm volatile("" : "+v"(tid_)); const int tid = tid_, wid = __builtin_amdgcn_readfirstlane(tid >> 6), lane = tid & 63, wr = wid >> 2, wc = wid & 3, fr = lane & 15, fq = lane >> 4;
    const int K = g.K;
    unsigned voffA[2], voffB[2];
#pragma unroll
    for (int i = 0; i < 2; ++i) { int R, C; stage_rc(tid * 16 + i * 8192, R, C); const int Rb = Epi::PERM ? ((R & ~31) + perm32(R & 31)) : R;
        voffA[i] = (unsigned)(R * K + C) * 2u; voffB[i] = (unsigned)(Rb * K + C) * 2u; }
    const size_t kstep = (size_t)(BK * 2);
    const size_t hstep = (size_t)HALF * K * 2;
    const size_t tstep = 2 * hstep;
    const unsigned ldsw = (unsigned)wid * 1024u;
    const int aoff = lds_byte(wr * 64 + fr, fq * 8), boff = lds_byte(wc * 32 + fr, fq * 8);
#define PG8_SA(b, h) (((b) * 2 + (h)) * HTB)
#define PG8_SB(b, h) ((4 + (b) * 2 + (h)) * HTB)
#define PG8_STAGE(bufoff, gbase, voff) do { _Pragma("unroll") for (int _i = 0; _i < 2; ++_i) \
        __builtin_amdgcn_global_load_lds((const unsigned*)((const char*)(gbase) + (voff)[_i]), (LAS unsigned*)(lds + (bufoff) + ldsw + _i * 8192), 16, 0, 0); } while (0)
#define PG8_LDA(dst, b, h) do { _Pragma("unroll") for (int m = 0; m < 4; ++m) _Pragma("unroll") for (int k = 0; k < 2; ++k) dst[m][k] = *(const LAS bf16x8*)(lds + PG8_SA(b, h) + aoff + m * 2048 + k * 1024); } while (0)
#define PG8_LDB(dst, b, h) do { _Pragma("unroll") for (int n = 0; n < 2; ++n) _Pragma("unroll") for (int k = 0; k < 2; ++k) dst[n][k] = *(const LAS bf16x8*)(lds + PG8_SB(b, h) + boff + n * 2048 + k * 1024); } while (0)
#define PG8_MMA(ai, bj, At, Bt) do { __builtin_amdgcn_s_setprio(1); _Pragma("unroll") for (int m = 0; m < 4; ++m) _Pragma("unroll") for (int n = 0; n < 2; ++n) _Pragma("unroll") for (int k = 0; k < 2; ++k) \
        acc[ai][bj][m][n] = __builtin_amdgcn_mfma_f32_16x16x32_bf16(Bt[n][k], At[m][k], acc[ai][bj][m][n], 0, 0, 0); __builtin_amdgcn_s_setprio(0); } while (0)
#define PG8_WAIT_V(n) asm volatile("s_waitcnt vmcnt(" #n ")" ::: "memory")
#define PG8_WAIT_L(n) asm volatile("s_waitcnt lgkmcnt(" #n ")" ::: "memory")
#define PG8_BAR __builtin_amdgcn_s_barrier()
#define PG8_SCHED __builtin_amdgcn_sched_barrier(0)
    Unit cur, nxt; int ui = 0;
    if (!S.next(0, cur)) return;
    f32x4 acc[2][2][4][2];
#pragma unroll
    for (int a = 0; a < 2; ++a)
#pragma unroll
        for (int b = 0; b < 2; ++b)
#pragma unroll
            for (int m = 0; m < 4; ++m)
#pragma unroll
                for (int n = 0; n < 2; ++n) acc[a][b][m][n] = (f32x4){0.f, 0.f, 0.f, 0.f};
    bf16x8 At[4][2], B0[2][2], B1[2][2];
    const char* cA = (const char*)g.A + (size_t)cur.pm * tstep + (size_t)cur.k0 * 2; const char* cB = (const char*)g.Bt + (size_t)cur.pn * tstep + (size_t)cur.k0 * 2;
    PG8_STAGE(PG8_SB(0, 0), cB, voffB); PG8_STAGE(PG8_SA(0, 0), cA, voffA); PG8_STAGE(PG8_SB(0, 1), cB + hstep, voffB); PG8_STAGE(PG8_SA(0, 1), cA + hstep, voffA);
    if (wr == 1) PG8_BAR;
    PG8_WAIT_V(4); PG8_BAR;
    PG8_STAGE(PG8_SB(1, 0), cB + kstep, voffB); PG8_STAGE(PG8_SA(1, 0), cA + kstep, voffA); PG8_STAGE(PG8_SB(1, 1), cB + hstep + kstep, voffB);
    PG8_WAIT_V(6); PG8_BAR;
    for (;;) {
        const bool has_next = S.next(ui + 1, nxt);
        const char* nA = has_next ? (const char*)g.A + (size_t)nxt.pm * tstep + (size_t)nxt.k0 * 2 : cA; const char* nB = has_next ? (const char*)g.Bt + (size_t)nxt.pn * tstep + (size_t)nxt.k0 * 2 : cB;
        const int nt = cur.nt;
        for (int t = 0; t < nt; t += 2) {
            const bool last = (t == nt - 2);
            const char* a1 = cA + (size_t)(t + 1) * kstep;
            const char* a2 = last ? nA : cA + (size_t)(t + 2) * kstep; const char* b2 = last ? nB : cB + (size_t)(t + 2) * kstep;
            const char* a3 = a2 + kstep; const char* b3 = b2 + kstep;
            PG8_LDB(B0, 0, 0); PG8_SCHED; PG8_LDA(At, 0, 0); PG8_STAGE(PG8_SA(1, 1), a1 + hstep, voffA);
            PG8_WAIT_L(8); PG8_BAR; PG8_WAIT_L(0); PG8_MMA(0, 0, At, B0); PG8_BAR; PG8_SCHED;
            PG8_LDB(B1, 0, 1); PG8_STAGE(PG8_SB(0, 0), b2, voffB);
            PG8_BAR; PG8_WAIT_L(0); PG8_MMA(0, 1, At, B1); PG8_BAR;
            PG8_LDA(At, 0, 1); PG8_STAGE(PG8_SA(0, 0), a2, voffA);
            PG8_BAR; PG8_WAIT_L(0); PG8_MMA(1, 0, At, B0); PG8_BAR; PG8_SCHED;
            PG8_STAGE(PG8_SB(0, 1), b2 + hstep, voffB);
            PG8_WAIT_V(6); PG8_BAR; PG8_MMA(1, 1, At, B1); PG8_BAR;
            PG8_LDB(B0, 1, 0); PG8_SCHED; PG8_LDA(At, 1, 0); PG8_STAGE(PG8_SA(0, 1), a2 + hstep, voffA);
            PG8_WAIT_L(8); PG8_BAR; PG8_WAIT_L(0); PG8_MMA(0, 0, At, B0); PG8_BAR; PG8_SCHED;
            PG8_LDB(B1, 1, 1); PG8_STAGE(PG8_SB(1, 0), b3, voffB);
            PG8_BAR; PG8_WAIT_L(0); PG8_MMA(0, 1, At, B1); PG8_BAR;
            PG8_LDA(At, 1, 1); PG8_STAGE(PG8_SA(1, 0), a3, voffA);
            PG8_BAR; PG8_WAIT_L(0); PG8_MMA(1, 0, At, B0); PG8_BAR; PG8_SCHED;
            PG8_STAGE(PG8_SB(1, 1), b3 + hstep, voffB);
            PG8_WAIT_V(6); PG8_BAR; PG8_MMA(1, 1, At, B1); PG8_BAR;
        }
        E(acc, cur, wr, wc, fr, fq);
        if (!has_next) break;
#pragma unroll
        for (int a = 0; a < 2; ++a)
#pragma unroll
            for (int b = 0; b < 2; ++b)
#pragma unroll
                for (int m = 0; m < 4; ++m)
#pragma unroll
                    for (int n = 0; n < 2; ++n) acc[a][b][m][n] = (f32x4){0.f, 0.f, 0.f, 0.f};
        cur = nxt; cA = nA; cB = nB; ++ui;
    }
    PG8_WAIT_V(0);
    if (wr == 0) PG8_BAR;
    PG8_BAR;
#undef PG8_SA
#undef PG8_SB
#undef PG8_STAGE
#undef PG8_LDA
#undef PG8_LDB
#undef PG8_MMA
#undef PG8_WAIT_V
#undef PG8_WAIT_L
#undef PG8_BAR
#undef PG8_SCHED
}
}

DEV int win_srccol(int n) { return n < 4096 ? n : (n < 6656 ? n + 8 : (n < 6664 ? n - 2560 : (n < 6680 ? n : -1))); }
DEV void transpose_tile(const float* __restrict__ src, int srcN, bf16_t* __restrict__ dst, int K, int n0, int k0, int mode, float* tile) {
    const int tid = threadIdx.x;
#pragma unroll
    for (int i = 0; i < 2; ++i) {
        const int kk = (tid >> 4) + 32 * i, nn4 = (tid & 15) * 4, n = n0 + nn4;
        const int sc = mode ? win_srccol(n) : n;
        f32x4 v = (f32x4){0.f, 0.f, 0.f, 0.f};
        if (sc >= 0) v = *(const f32x4*)(src + (size_t)(k0 + kk) * srcN + sc);
        if (mode && n >= 1024 && n < 2048) v = v * 0.0625f;
        tile[kk * 65 + nn4 + 0] = v[0]; tile[kk * 65 + nn4 + 1] = v[1]; tile[kk * 65 + nn4 + 2] = v[2]; tile[kk * 65 + nn4 + 3] = v[3];
    }
    __syncthreads();
    {
        const int nn = tid >> 3, kk8 = (tid & 7) * 8;
        u32x4 w;
        w.x = pk2(tile[(kk8 + 0) * 65 + nn], tile[(kk8 + 1) * 65 + nn]); w.y = pk2(tile[(kk8 + 2) * 65 + nn], tile[(kk8 + 3) * 65 + nn]);
        w.z = pk2(tile[(kk8 + 4) * 65 + nn], tile[(kk8 + 5) * 65 + nn]); w.w = pk2(tile[(kk8 + 6) * 65 + nn], tile[(kk8 + 7) * 65 + nn]);
        *(u32x4*)(dst + (size_t)(n0 + nn) * K + k0 + kk8) = w;
    }
    __syncthreads();
}
DEV void phase_prologue(const P& p, unsigned char* lds) {
    float* tile = (float*)lds;
    constexpr int T_WIN = (INP / 64) * (D / 64), T_WOUT = (D / 64) * (D / 64), T_WUP = (DFF2 / 64) * (D / 64), T_WDN = (D / 64) * (DFF / 64);
    constexpr int T_L = T_WIN + T_WOUT + T_WUP + T_WDN, T_X = NTOK * D / 4096;
    const int total = 2 * T_L + T_X;
    for (int u = blockIdx.x; u < total; u += gridDim.x) {
        if (u < 2 * T_L) {
            const int l = u / T_L; int r = u % T_L;
            if (r < T_WIN) { const int nt = r / (D / 64), kt = r % (D / 64);
                transpose_tile(p.w_in + (size_t)l * D * IN_DIM, IN_DIM, (bf16_t*)(p.ws + WS_WIN) + (size_t)l * INP * D, D, nt * 64, kt * 64, 1, tile); }
            else if ((r -= T_WIN) < T_WOUT) { const int nt = r / (D / 64), kt = r % (D / 64);
                transpose_tile(p.w_out + (size_t)l * D * D, D, (bf16_t*)(p.ws + WS_WOUT) + (size_t)l * D * D, D, nt * 64, kt * 64, 0, tile); }
            else if ((r -= T_WOUT) < T_WUP) { const int nt = r / (D / 64), kt = r % (D / 64);
                transpose_tile(p.w_up + (size_t)l * D * DFF2, DFF2, (bf16_t*)(p.ws + WS_WUP) + (size_t)l * DFF2 * D, D, nt * 64, kt * 64, 0, tile); }
            else { r -= T_WUP; const int nt = r / (DFF / 64), kt = r % (DFF / 64);
                transpose_tile(p.w_down + (size_t)l * DFF * D, D, (bf16_t*)(p.ws + WS_WDN) + (size_t)l * D * DFF, DFF, nt * 64, kt * 64, 0, tile); }
        } else {
            const size_t e = (size_t)(u - 2 * T_L) * 4096 + threadIdx.x * 8;
            const float* s = e < (size_t)NPR * D ? p.x_prompt + e : p.x_sample + (e - (size_t)NPR * D);
            const f32x4 a = *(const f32x4*)s, b = *(const f32x4*)(s + 4);
            u32x4 w; w.x = pk2(a[0], a[1]); w.y = pk2(a[2], a[3]); w.z = pk2(b[0], b[1]); w.w = pk2(b[2], b[3]);
            *(u32x4*)((bf16_t*)(p.ws + WS_XB) + e) = w;
        }
    }
}

DEV void mlstm_local(const P& p, int l, int unit, unsigned char* lds) {
    const int bh = unit >> 5, c = unit & 31, b = bh >> 2, h = bh & 3;
    int tid_ = threadIdx.x; asm volatile("" : "+v"(tid_)); const int tid = tid_, lane = tid & 63, w = tid >> 6, fr = lane & 15, fq = lane >> 4;
    const bf16_t* U = (const bf16_t*)(p.ws + WS_U) + (size_t)(b * 2048 + c * 64) * INP;
    float* wsh = (float*)lds;
    bf16_t* KW = (bf16_t*)(lds + 1024);
    bf16_t* V = KW + 64 * 272;
    float* gstat = (float*)(p.ws + WS_GSTAT);
    if (w == 0) {
        const float ig = bf2f(U[(size_t)lane * INP + UIG + h]) + p.b_i[l * 4 + h];
        const float lf = logsigf_(bf2f(U[(size_t)lane * INP + UFG + h]) + p.b_f[l * 4 + h]);
        const float bs = wave_incl_sum(lf, lane);
        const float a = ig - bs;
        const float amax = wave_max(a);
        const float bsum = __shfl(bs, 63);
        wsh[lane] = expf(a - amax);
        if (lane == 0) { gstat[(bh * 32 + c) * 2] = bsum; gstat[(bh * 32 + c) * 2 + 1] = bsum + amax; }
    }
    __syncthreads();
#pragma unroll
    for (int i = 0; i < 4; ++i) {
        const int it = tid + 512 * i, s_ = it >> 5, d8 = (it & 31) * 8;
        const uint4 kv = *(const uint4*)(U + (size_t)s_ * INP + UK + h * 256 + d8);
        const uint4 vv = *(const uint4*)(U + (size_t)s_ * INP + UV + h * 256 + d8);
        const float ws_ = wsh[s_];
        float kf[8]; unpack8(kv, kf);
        u32x4 kw; kw.x = pk2(kf[0] * ws_, kf[1] * ws_); kw.y = pk2(kf[2] * ws_, kf[3] * ws_); kw.z = pk2(kf[4] * ws_, kf[5] * ws_); kw.w = pk2(kf[6] * ws_, kf[7] * ws_);
        *(u32x4*)(KW + s_ * 272 + d8) = kw;
        *(uint4*)(V + s_ * 272 + d8) = vv;
    }
    __syncthreads();
    if (tid < 256) { float a = 0.f; for (int s_ = 0; s_ < 64; ++s_) a += bf2f(KW[s_ * 272 + tid]); ((float*)(p.ws + WS_NLOC))[(size_t)(bh * 32 + c) * 256 + tid] = a; }
    f32x4 acc[2][16];
#pragma unroll
    for (int m = 0; m < 2; ++m)
#pragma unroll
        for (int n = 0; n < 16; ++n) acc[m][n] = (f32x4){0.f, 0.f, 0.f, 0.f};
#pragma unroll
    for (int ks = 0; ks < 2; ++ks) {
        bf16x8 vf[2];
#pragma unroll
        for (int m = 0; m < 2; ++m) vf[m] = tr_frag(V, 272, 32 * ks, 32 * w + 16 * m, lane);
#pragma unroll
        for (int n = 0; n < 16; ++n) {
            const bf16x8 kf = tr_frag(KW, 272, 32 * ks, 16 * n, lane);
#pragma unroll
            for (int m = 0; m < 2; ++m) acc[m][n] = mfma16(kf, vf[m], acc[m][n]);
        }
    }
    bf16_t* Dp = (bf16_t*)(p.ws + WS_DBUF) + (size_t)(bh * 32 + c) * 65536;
#pragma unroll
    for (int m = 0; m < 2; ++m)
#pragma unroll
        for (int n = 0; n < 16; ++n) { u32x2 wv; wv.x = pk2(acc[m][n][0], acc[m][n][1]); wv.y = pk2(acc[m][n][2], acc[m][n][3]);
            *(u32x2*)(Dp + (32 * w + 16 * m + fr) * 256 + 16 * n + fq * 4) = wv; }
    __syncthreads();
}

DEV void mlstm_scan(const P& p, int l, int unit, unsigned char* lds) {
    int tid_ = threadIdx.x; asm volatile("" : "+v"(tid_)); const int bh = unit >> 4, slab = unit & 15, tid = tid_;
    float* fA = (float*)lds; float* fB = fA + 32;
    const float* gstat = (const float*)(p.ws + WS_GSTAT);
    if (tid == 0) {
        float m = 0.f;
        for (int c = 0; c < 32; ++c) {
            const float bsum = gstat[(bh * 32 + c) * 2], mloc = gstat[(bh * 32 + c) * 2 + 1];
            const float mn = fmaxf(bsum + m, mloc);
            fA[c] = expf(bsum + m - mn); fB[c] = expf(mloc - mn); m = mn;
            if (slab == 0) ((float*)(p.ws + WS_MST))[bh * 32 + c] = mn;
        }
        if (slab == 0) p.out[O_PM + l * 16 + bh] = m;
    }
    __syncthreads();
    const size_t e0 = (size_t)slab * 4096 + tid * 8;
    float run[8];
#pragma unroll
    for (int i = 0; i < 8; ++i) run[i] = 0.f;
    const bf16_t* Dp = (const bf16_t*)(p.ws + WS_DBUF) + (size_t)bh * 32 * 65536 + e0;
    bf16_t* Cp = (bf16_t*)(p.ws + WS_CT) + (size_t)bh * 32 * 65536 + e0;
#pragma unroll 1
    for (int cb = 0; cb < 32; cb += 8) {
        uint4 xx[8];
#pragma unroll
        for (int j = 0; j < 8; ++j) xx[j] = *(const uint4*)(Dp + (size_t)(cb + j) * 65536);
#pragma unroll
        for (int j = 0; j < 8; ++j) {
            const int c = cb + j;
            const float a = fA[c], bq = fB[c];
            float xf[8]; unpack8(xx[j], xf);
#pragma unroll
            for (int i = 0; i < 8; ++i) run[i] = a * run[i] + bq * xf[i];
            u32x4 wv; wv.x = pk2(run[0], run[1]); wv.y = pk2(run[2], run[3]); wv.z = pk2(run[4], run[5]); wv.w = pk2(run[6], run[7]);
            *(u32x4*)(Cp + (size_t)c * 65536) = wv;
        }
    }
    {
        float* o = p.out + O_PC + (size_t)(l * 16 + bh) * 65536;
        const int e = (int)(e0 >> 8), d0 = (int)(e0 & 255);
#pragma unroll
        for (int i = 0; i < 8; ++i) o[(d0 + i) * 256 + e] = run[i];
    }
    if (slab == 0 && tid < 256) {
        float r = 0.f;
        const float* nl = (const float*)(p.ws + WS_NLOC) + (size_t)bh * 32 * 256 + tid;
        float* ns = (float*)(p.ws + WS_NST) + (size_t)bh * 32 * 256 + tid;
        for (int c = 0; c < 32; ++c) { r = fA[c] * r + fB[c] * nl[c * 256]; ns[c * 256] = r; }
        p.out[O_PN + (size_t)(l * 16 + bh) * 256 + tid] = r;
    }
    __syncthreads();
}

DEV void ssd_scan(const P& p, int l, int unit, unsigned char* lds) {
    int tid_ = threadIdx.x; asm volatile("" : "+v"(tid_)); const int bhd = unit >> 1, slab = unit & 1, tid = tid_;
    float* dec = (float*)lds;
    if (tid < 32) dec[tid] = expf(((const float*)(p.ws + WS_SBSUM))[bhd * 32 + tid]);
    __syncthreads();
    const size_t e0 = (size_t)slab * 4096 + tid * 8;
    float run[8];
#pragma unroll
    for (int i = 0; i < 8; ++i) run[i] = 0.f;
    const float* Sp = (const float*)(p.ws + WS_SBUF) + (size_t)bhd * 32 * 8192 + e0;
    bf16_t* Tp = (bf16_t*)(p.ws + WS_ST) + (size_t)bhd * 32 * 8192 + e0;
#pragma unroll 1
    for (int cb = 0; cb < 32; cb += 8) {
        f32x4 xx[8][2];
#pragma unroll
        for (int j = 0; j < 8; ++j) { xx[j][0] = __builtin_nontemporal_load((const f32x4*)(Sp + (size_t)(cb + j) * 8192)); xx[j][1] = __builtin_nontemporal_load((const f32x4*)(Sp + (size_t)(cb + j) * 8192 + 4)); }
#pragma unroll
        for (int j = 0; j < 8; ++j) {
            const int c = cb + j;
            const float a = dec[c];
#pragma unroll
            for (int i = 0; i < 4; ++i) { run[i] = a * run[i] + xx[j][0][i]; run[4 + i] = a * run[4 + i] + xx[j][1][i]; }
            u32x4 wv; wv.x = pk2(run[0], run[1]); wv.y = pk2(run[2], run[3]); wv.z = pk2(run[4], run[5]); wv.w = pk2(run[6], run[7]);
            *(u32x4*)(Tp + (size_t)c * 8192) = wv;
        }
    }
    float* o = p.out + O_PS + (size_t)(l * 64 + bhd) * 8192 + e0;
    *(f32x4*)o = (f32x4){run[0], run[1], run[2], run[3]}; *(f32x4*)(o + 4) = (f32x4){run[4], run[5], run[6], run[7]};
    __syncthreads();
}

DEV void convstate_copy(const P& p, int l, int unit) {
    const bf16_t* Ub = (const bf16_t*)(p.ws + WS_U);
    int tid_ = threadIdx.x; asm volatile("" : "+v"(tid_));
    for (int i = tid_; i < 3 * 1536; i += NTHR) {
        const int j = i / 1536, ch = i % 1536;
        if (unit < 4) p.out[O_PSC + ((size_t)(l * 4 + unit) * 3 + j) * 1536 + ch] = bf2f(Ub[(size_t)(unit * 2048 + 2045 + j) * INP + UXS + ch]);
        else { const int b = unit - 4; p.out[O_SSC + ((size_t)(l * 128 + b) * 3 + j) * 1536 + ch] = bf2f(Ub[(size_t)(NPR + b * 8 + 5 + j) * INP + UXS + ch]); }
    }
}

DEV void mlstm_out(const P& p, int l, int unit, unsigned char* lds) {
    const int bh = unit >> 5, c = unit & 31, b = bh >> 2, h = bh & 3;
    int tid_ = threadIdx.x; asm volatile("" : "+v"(tid_)); const int tid = tid_, lane = tid & 63, w = tid >> 6, fr = lane & 15, fq = lane >> 4;
    const int r0 = b * 2048 + c * 64;
    const bf16_t* U = (const bf16_t*)(p.ws + WS_U) + (size_t)r0 * INP;
    bf16_t* Qs = (bf16_t*)lds;
    bf16_t* Ks = Qs + 64 * 264;
    bf16_t* V = Ks + 64 * 264;
    bf16_t* Ss = V + 64 * 272;
    float* fl = (float*)(lds + 113664);
    float* bsh = fl; float* ash = fl + 64; float* mth = fl + 128; float* wint = fl + 192; float* rdn = fl + 256; float* qn = fl + 320; float* nprev = fl + 384; float* red = fl + 640;
    float* stat = fl + 1152;
    if (w == 0) {
        const float ig = bf2f(U[(size_t)lane * INP + UIG + h]) + p.b_i[l * 4 + h];
        const float lf = logsigf_(bf2f(U[(size_t)lane * INP + UFG + h]) + p.b_f[l * 4 + h]);
        const float bs = wave_incl_sum(lf, lane);
        const float a = ig - bs;
        const float cm = wave_incl_max(a, lane);
        const float mprev = c > 0 ? ((const float*)(p.ws + WS_MST))[bh * 32 + c - 1] : 0.f;
        const float mt = bs + fmaxf(mprev, cm);
        bsh[lane] = bs; ash[lane] = a; mth[lane] = mt; wint[lane] = expf(bs + mprev - mt);
    }
    if (tid >= 256) { const int d = tid - 256; nprev[d] = c > 0 ? ((const float*)(p.ws + WS_NST))[(size_t)(bh * 32 + c - 1) * 256 + d] : 0.f; }
#pragma unroll
    for (int i = 0; i < 4; ++i) {
        const int it = tid + 512 * i, s_ = it >> 5, d8 = (it & 31) * 8;
        *(uint4*)(Qs + s_ * 264 + d8) = *(const uint4*)(U + (size_t)s_ * INP + UQ + h * 256 + d8);
        *(uint4*)(Ks + s_ * 264 + d8) = *(const uint4*)(U + (size_t)s_ * INP + UK + h * 256 + d8);
        *(uint4*)(V + s_ * 272 + d8) = *(const uint4*)(U + (size_t)s_ * INP + UV + h * 256 + d8);
    }
    __syncthreads();
    {
        const int mt_ = w >> 1, nt0 = (w & 1) * 2;
        f32x4 sacc[2] = {(f32x4){0.f, 0.f, 0.f, 0.f}, (f32x4){0.f, 0.f, 0.f, 0.f}};
#pragma unroll
        for (int k0 = 0; k0 < 256; k0 += 32) {
            const bf16x8 a = *(const bf16x8*)(Qs + (16 * mt_ + fr) * 264 + k0 + fq * 8);
#pragma unroll
            for (int n = 0; n < 2; ++n) { const bf16x8 bb = *(const bf16x8*)(Ks + (16 * (nt0 + n) + fr) * 264 + k0 + fq * 8); sacc[n] = mfma16(a, bb, sacc[n]); }
        }
#pragma unroll
        for (int n = 0; n < 2; ++n)
#pragma unroll
            for (int j = 0; j < 4; ++j) {
                const int t = 16 * mt_ + fq * 4 + j, s_ = 16 * (nt0 + n) + fr;
                const float val = (s_ <= t) ? sacc[n][j] * expf(bsh[t] - mth[t] + ash[s_]) : 0.f;
                Ss[t * 72 + s_] = f2bf(val);
            }
        const int t = tid >> 3, part = tid & 7;
        float a = 0.f;
        for (int d = part * 32; d < part * 32 + 32; ++d) a += bf2f(Qs[t * 264 + d]) * nprev[d];
        a += __shfl_xor(a, 1); a += __shfl_xor(a, 2); a += __shfl_xor(a, 4);
        if (part == 0) qn[t] = a;
    }
    __syncthreads();
    if (tid < 64) {
        float di = 0.f;
        for (int s_ = 0; s_ < 64; ++s_) di += bf2f(Ss[tid * 72 + s_]);
        const float den = di + wint[tid] * qn[tid];
        rdn[tid] = 1.0f / fmaxf(fabsf(den), expf(-mth[tid]));
    }
    const int e0 = 32 * w;
    f32x4 acc1[4][2], acc2[4][2];
#pragma unroll
    for (int m = 0; m < 4; ++m)
#pragma unroll
        for (int n = 0; n < 2; ++n) { acc1[m][n] = (f32x4){0.f, 0.f, 0.f, 0.f}; acc2[m][n] = (f32x4){0.f, 0.f, 0.f, 0.f}; }
#pragma unroll
    for (int ks = 0; ks < 2; ++ks) {
        bf16x8 sf[4];
#pragma unroll
        for (int m = 0; m < 4; ++m) sf[m] = *(const bf16x8*)(Ss + (16 * m + fr) * 72 + 32 * ks + fq * 8);
#pragma unroll
        for (int n = 0; n < 2; ++n) { const bf16x8 vf = tr_frag(V, 272, 32 * ks, e0 + 16 * n, lane);
#pragma unroll
            for (int m = 0; m < 4; ++m) acc1[m][n] = mfma16(vf, sf[m], acc1[m][n]); }
    }
    if (c > 0) {
        const bf16_t* CTp = (const bf16_t*)(p.ws + WS_CT) + (size_t)(bh * 32 + c - 1) * 65536;
#pragma unroll 2
        for (int k0 = 0; k0 < 256; k0 += 32) {
            bf16x8 a[4];
#pragma unroll
            for (int m = 0; m < 4; ++m) a[m] = *(const bf16x8*)(Qs + (16 * m + fr) * 264 + k0 + fq * 8);
#pragma unroll
            for (int n = 0; n < 2; ++n) { const bf16x8 cf = *(const bf16x8*)(CTp + (size_t)(e0 + 16 * n + fr) * 256 + k0 + fq * 8);
#pragma unroll
                for (int m = 0; m < 4; ++m) acc2[m][n] = mfma16(cf, a[m], acc2[m][n]); }
        }
    }
    __syncthreads();
#pragma unroll
    for (int m = 0; m < 4; ++m) {
        const int t = 16 * m + fr;
        const float wi = wint[t], rd = rdn[t];
        float sm = 0.f;
#pragma unroll
        for (int n = 0; n < 2; ++n)
#pragma unroll
            for (int j = 0; j < 4; ++j) { const float hv = (acc1[m][n][j] + wi * acc2[m][n][j]) * rd; acc1[m][n][j] = hv; sm += hv; }
        sm += __shfl_xor(sm, 16); sm += __shfl_xor(sm, 32);
        if (fq == 0) red[t * 8 + w] = sm;
    }
    __syncthreads();
    if (tid < 64) { float sm = 0.f;
#pragma unroll
        for (int i = 0; i < 8; ++i) sm += red[tid * 8 + i];
        stat[tid] = sm * (1.0f / 256.0f); }
    __syncthreads();
#pragma unroll
    for (int m = 0; m < 4; ++m) {
        const int t = 16 * m + fr;
        const float mu = stat[t];
        float sm = 0.f;
#pragma unroll
        for (int n = 0; n < 2; ++n)
#pragma unroll
            for (int j = 0; j < 4; ++j) { const float dv = acc1[m][n][j] - mu; acc1[m][n][j] = dv; sm += dv * dv; }
        sm += __shfl_xor(sm, 16); sm += __shfl_xor(sm, 32);
        if (fq == 0) red[t * 8 + w] = sm;
    }
    __syncthreads();
    if (tid < 64) { float sm = 0.f;
#pragma unroll
        for (int i = 0; i < 8; ++i) sm += red[tid * 8 + i];
        stat[64 + tid] = rsqrtf(sm * (1.0f / 256.0f) + 1e-6f); }
    __syncthreads();
    bf16_t* MX = (bf16_t*)(p.ws + WS_MIXIN);
#pragma unroll
    for (int m = 0; m < 4; ++m) {
        const int t = 16 * m + fr;
        const float rs = stat[64 + t];
#pragma unroll
        for (int n = 0; n < 2; ++n) {
            const int e4 = e0 + 16 * n + fq * 4;
            const uint2 ov = *(const uint2*)(U + (size_t)t * INP + UO + h * 256 + e4);
            const f32x4 nw = *(const f32x4*)(p.m_norm_w + l * 1024 + h * 256 + e4);
            u32x2 wv;
            wv.x = pk2(acc1[m][n][0] * rs * nw[0] * sigmoidf_(bflo(ov.x)), acc1[m][n][1] * rs * nw[1] * sigmoidf_(bfhi(ov.x)));
            wv.y = pk2(acc1[m][n][2] * rs * nw[2] * sigmoidf_(bflo(ov.y)), acc1[m][n][3] * rs * nw[3] * sigmoidf_(bfhi(ov.y)));
            *(u32x2*)(MX + (size_t)(r0 + t) * D + h * 256 + e4) = wv;
        }
    }
    __syncthreads();
}

DEV void ssd_conv8(const bf16_t* Urow, int tpos, const float* cw, const float* cb, int ch8, float (&o)[8]) {
    const f32x4 b0 = *(const f32x4*)(cb + ch8), b1 = *(const f32x4*)(cb + ch8 + 4);
    o[0] = b0[0]; o[1] = b0[1]; o[2] = b0[2]; o[3] = b0[3]; o[4] = b1[0]; o[5] = b1[1]; o[6] = b1[2]; o[7] = b1[3];
#pragma unroll
    for (int j = 0; j < 4; ++j) {
        const int back = 3 - j;
        if (tpos - back >= 0) {
            const uint4 x = *(const uint4*)(Urow - (size_t)back * INP + UXS + ch8);
            float xf[8]; unpack8(x, xf);
            const f32x4 w0 = *(const f32x4*)(cw + j * 1536 + ch8), w1 = *(const f32x4*)(cw + j * 1536 + ch8 + 4);
            o[0] += w0[0] * xf[0]; o[1] += w0[1] * xf[1]; o[2] += w0[2] * xf[2]; o[3] += w0[3] * xf[3];
            o[4] += w1[0] * xf[4]; o[5] += w1[1] * xf[5]; o[6] += w1[2] * xf[6]; o[7] += w1[3] * xf[7];
        }
    }
#pragma unroll
    for (int i = 0; i < 8; ++i) o[i] = siluf_(o[i]);
}

DEV void ssd_local(const P& p, int l, int unit, unsigned char* lds) {
    const int b = unit >> 6, g = (unit >> 5) & 1, c = unit & 31;
    int tid_ = threadIdx.x; asm volatile("" : "+v"(tid_)); const int tid = tid_, lane = tid & 63, w = tid >> 6, fr = lane & 15, fq = lane >> 4;
    const int r0 = b * 2048 + c * 64;
    const bf16_t* U = (const bf16_t*)(p.ws + WS_U) + (size_t)r0 * INP;
    bf16_t* XW = (bf16_t*)lds;
    bf16_t* Bmn = XW + 64 * 528;
    float* wsh = (float*)(lds + 86016);
    {
        const int head = g * 8 + w;
        const float dt = softplusf_(bf2f(U[(size_t)lane * INP + UDT + head]) + p.dt_bias[l * 16 + head]);
        const float a = -expf(p.A_log[l * 16 + head]) * dt;
        const float bs = wave_incl_sum(a, lane);
        const float bL = __shfl(bs, 63);
        wsh[w * 64 + lane] = expf(bL - bs) * dt;
        if (lane == 0) ((float*)(p.ws + WS_SBSUM))[(b * 16 + head) * 32 + c] = bL;
    }
    __syncthreads();
    const float* cw = p.s_conv_w + (size_t)l * 4 * 1536; const float* cb = p.s_conv_b + (size_t)l * 1536;
    for (int i = 0; i < 10; ++i) {
        const int it = tid + 512 * i, t = it / 80, gidx = it % 80;
        const int ch8 = gidx < 64 ? g * 512 + gidx * 8 : 1024 + g * 128 + (gidx - 64) * 8;
        float v[8];
        ssd_conv8(U + (size_t)t * INP, c * 64 + t, cw, cb, ch8, v);
        if (gidx < 64) { const float sc = wsh[(gidx >> 3) * 64 + t];
            u32x4 wv; wv.x = pk2(v[0] * sc, v[1] * sc); wv.y = pk2(v[2] * sc, v[3] * sc); wv.z = pk2(v[4] * sc, v[5] * sc); wv.w = pk2(v[6] * sc, v[7] * sc);
            *(u32x4*)(XW + t * 528 + gidx * 8) = wv; }
        else { u32x4 wv; wv.x = pk2(v[0], v[1]); wv.y = pk2(v[2], v[3]); wv.z = pk2(v[4], v[5]); wv.w = pk2(v[6], v[7]);
            *(u32x4*)(Bmn + t * 144 + (gidx - 64) * 8) = wv; }
    }
    __syncthreads();
    f32x4 acc[4][8];
#pragma unroll
    for (int m = 0; m < 4; ++m)
#pragma unroll
        for (int n = 0; n < 8; ++n) acc[m][n] = (f32x4){0.f, 0.f, 0.f, 0.f};
#pragma unroll
    for (int ks = 0; ks < 2; ++ks) {
        bf16x8 xf[4];
#pragma unroll
        for (int m = 0; m < 4; ++m) xf[m] = tr_frag(XW, 528, 32 * ks, 64 * w + 16 * m, lane);
#pragma unroll
        for (int n = 0; n < 8; ++n) { const bf16x8 bf_ = tr_frag(Bmn, 144, 32 * ks, 16 * n, lane);
#pragma unroll
            for (int m = 0; m < 4; ++m) acc[m][n] = mfma16(bf_, xf[m], acc[m][n]); }
    }
    float* Sp = (float*)(p.ws + WS_SBUF) + (size_t)((b * 16 + g * 8 + w) * 32 + c) * 8192;
#pragma unroll
    for (int m = 0; m < 4; ++m)
#pragma unroll
        for (int n = 0; n < 8; ++n) *(f32x4*)(Sp + (16 * m + fr) * 128 + 16 * n + fq * 4) = acc[m][n];
    __syncthreads();
}

DEV void ssd_out(const P& p, int l, int unit, unsigned char* lds) {
    const int b = unit >> 6, g = (unit >> 5) & 1, c = unit & 31;
    int tid_ = threadIdx.x; asm volatile("" : "+v"(tid_)); const int tid = tid_, lane = tid & 63, w = tid >> 6, fr = lane & 15, fq = lane >> 4;
    const int r0 = b * 2048 + c * 64;
    const bf16_t* U = (const bf16_t*)(p.ws + WS_U) + (size_t)r0 * INP;
    bf16_t* Xs = (bf16_t*)lds;
    bf16_t* Bm = Xs + 64 * 528;
    bf16_t* Cm = Bm + 64 * 136;
    float* CB = (float*)(lds + 102400);
    float* bsh = (float*)(lds + 119808);
    float* dtsh = bsh + 512;
    float* red = dtsh + 512;
    float* stat = red + 512;
    const int head = g * 8 + w;
    {
        const float dt = softplusf_(bf2f(U[(size_t)lane * INP + UDT + head]) + p.dt_bias[l * 16 + head]);
        const float a = -expf(p.A_log[l * 16 + head]) * dt;
        const float bs = wave_incl_sum(a, lane);
        bsh[w * 64 + lane] = bs; dtsh[w * 64 + lane] = dt;
    }
    const float* cw = p.s_conv_w + (size_t)l * 4 * 1536; const float* cb = p.s_conv_b + (size_t)l * 1536;
    for (int i = 0; i < 12; ++i) {
        const int it = tid + 512 * i, t = it / 96, gidx = it % 96;
        const int ch8 = gidx < 64 ? g * 512 + gidx * 8 : (gidx < 80 ? 1024 + g * 128 + (gidx - 64) * 8 : 1280 + g * 128 + (gidx - 80) * 8);
        float v[8];
        ssd_conv8(U + (size_t)t * INP, c * 64 + t, cw, cb, ch8, v);
        u32x4 wv; wv.x = pk2(v[0], v[1]); wv.y = pk2(v[2], v[3]); wv.z = pk2(v[4], v[5]); wv.w = pk2(v[6], v[7]);
        if (gidx < 64) *(u32x4*)(Xs + t * 528 + gidx * 8) = wv;
        else if (gidx < 80) *(u32x4*)(Bm + t * 136 + (gidx - 64) * 8) = wv;
        else *(u32x4*)(Cm + t * 136 + (gidx - 80) * 8) = wv;
    }
    __syncthreads();
    {
        const int mt_ = w >> 1, nt0 = (w & 1) * 2;
        f32x4 cacc[2] = {(f32x4){0.f, 0.f, 0.f, 0.f}, (f32x4){0.f, 0.f, 0.f, 0.f}};
#pragma unroll
        for (int k0 = 0; k0 < 128; k0 += 32) {
            const bf16x8 a = *(const bf16x8*)(Cm + (16 * mt_ + fr) * 136 + k0 + fq * 8);
#pragma unroll
            for (int n = 0; n < 2; ++n) { const bf16x8 bb = *(const bf16x8*)(Bm + (16 * (nt0 + n) + fr) * 136 + k0 + fq * 8); cacc[n] = mfma16(a, bb, cacc[n]); }
        }
#pragma unroll
        for (int n = 0; n < 2; ++n)
#pragma unroll
            for (int j = 0; j < 4; ++j) CB[(16 * mt_ + fq * 4 + j) * 68 + 16 * (nt0 + n) + fr] = cacc[n][j];
    }
    __syncthreads();
    f32x4 acc1[4][4], acc2[4][4];
#pragma unroll
    for (int m = 0; m < 4; ++m)
#pragma unroll
        for (int n = 0; n < 4; ++n) { acc1[m][n] = (f32x4){0.f, 0.f, 0.f, 0.f}; acc2[m][n] = (f32x4){0.f, 0.f, 0.f, 0.f}; }
#pragma unroll
    for (int ks = 0; ks < 2; ++ks) {
        bf16x8 xf[4];
#pragma unroll
        for (int n = 0; n < 4; ++n) xf[n] = tr_frag(Xs, 528, 32 * ks, 64 * w + 16 * n, lane);
#pragma unroll
        for (int m = 0; m < 4; ++m) {
            if (ks * 32 > 16 * m + 15) continue;
            const int t = 16 * m + fr, s0 = 32 * ks + fq * 8;
            const float bt = bsh[w * 64 + t];
            const f32x4 c0 = *(const f32x4*)(CB + t * 68 + s0), c1 = *(const f32x4*)(CB + t * 68 + s0 + 4);
            float mv[8];
#pragma unroll
            for (int i = 0; i < 8; ++i) { const int s_ = s0 + i; const float cv = i < 4 ? c0[i & 3] : c1[i & 3];
                mv[i] = (s_ <= t) ? cv * expf(bt - bsh[w * 64 + s_]) * dtsh[w * 64 + s_] : 0.f; }
            union { u32x4 u; bf16x8 v; } af;
            af.u.x = pk2(mv[0], mv[1]); af.u.y = pk2(mv[2], mv[3]); af.u.z = pk2(mv[4], mv[5]); af.u.w = pk2(mv[6], mv[7]);
#pragma unroll
            for (int n = 0; n < 4; ++n) acc1[m][n] = mfma16(xf[n], af.v, acc1[m][n]);
        }
    }
    if (c > 0) {
        const bf16_t* STp = (const bf16_t*)(p.ws + WS_ST) + (size_t)((b * 16 + head) * 32 + c - 1) * 8192;
#pragma unroll
        for (int k0 = 0; k0 < 128; k0 += 32) {
            bf16x8 a[4];
#pragma unroll
            for (int m = 0; m < 4; ++m) a[m] = *(const bf16x8*)(Cm + (16 * m + fr) * 136 + k0 + fq * 8);
#pragma unroll
            for (int n = 0; n < 4; ++n) { const bf16x8 sf = *(const bf16x8*)(STp + (16 * n + fr) * 128 + k0 + fq * 8);
#pragma unroll
                for (int m = 0; m < 4; ++m) acc2[m][n] = mfma16(sf, a[m], acc2[m][n]); }
        }
    }
    const float dsk = p.D_skip[l * 16 + head];
#pragma unroll
    for (int m = 0; m < 4; ++m) {
        const int t = 16 * m + fr;
        const float eb = expf(bsh[w * 64 + t]);
        float sm = 0.f;
#pragma unroll
        for (int n = 0; n < 4; ++n) {
            const int pp4 = 16 * n + fq * 4;
            const uint2 xv = *(const uint2*)(Xs + t * 528 + 64 * w + pp4);
            const uint2 zv = *(const uint2*)(U + (size_t)t * INP + UZ + g * 512 + w * 64 + pp4);
            const float xs4[4] = {bflo(xv.x), bfhi(xv.x), bflo(xv.y), bfhi(xv.y)};
            const float z4[4] = {bflo(zv.x), bfhi(zv.x), bflo(zv.y), bfhi(zv.y)};
#pragma unroll
            for (int j = 0; j < 4; ++j) {
                const float y = acc1[m][n][j] + eb * acc2[m][n][j] + dsk * xs4[j];
                const float gt = y * z4[j] * sigmoidf_(z4[j]);
                acc1[m][n][j] = gt; sm += gt * gt;
            }
        }
        sm += __shfl_xor(sm, 16); sm += __shfl_xor(sm, 32);
        if (fq == 0) red[t * 8 + w] = sm;
    }
    __syncthreads();
    if (tid < 64) { float sm = 0.f;
#pragma unroll
        for (int i = 0; i < 8; ++i) sm += red[tid * 8 + i];
        stat[tid] = rsqrtf(sm * (1.0f / 512.0f) + 1e-6f); }
    __syncthreads();
    bf16_t* MX = (bf16_t*)(p.ws + WS_MIXIN);
#pragma unroll
    for (int m = 0; m < 4; ++m) {
        const int t = 16 * m + fr;
        const float rs = stat[t];
#pragma unroll
        for (int n = 0; n < 4; ++n) {
            const int ch = g * 512 + w * 64 + 16 * n + fq * 4;
            const f32x4 nw = *(const f32x4*)(p.s_norm_w + l * 1024 + ch);
            u32x2 wv; wv.x = pk2(acc1[m][n][0] * rs * nw[0], acc1[m][n][1] * rs * nw[1]); wv.y = pk2(acc1[m][n][2] * rs * nw[2], acc1[m][n][3] * rs * nw[3]);
            *(u32x2*)(MX + (size_t)(r0 + t) * D + 1024 + ch) = wv;
        }
    }
    __syncthreads();
}

DEV void smp_mlstm(const P& p, int l, int unit, unsigned char* lds) {
    const int b = unit >> 2, h = unit & 3;
    int tid_ = threadIdx.x; asm volatile("" : "+v"(tid_)); const int tid = tid_, lane = tid & 63, w = tid >> 6;
    const int r0 = NPR + b * 8;
    const bf16_t* U = (const bf16_t*)(p.ws + WS_U) + (size_t)r0 * INP;
    float* qn = (float*)lds; float* kn = qn + 2048; float* vn = kn + 2048; float* qT = vn + 2048; float* kwT = qT + 2048; float* sc = kwT + 2048; float* red = sc + 256;
    const size_t sidx = (size_t)(l * 128 + b) * 4 + h;
    const float* C0 = p.st_C + sidx * 65536; const float* n0 = p.st_n + sidx * 256;
    float* Cout = p.out + O_SC + sidx * 65536;
    if (tid == 0) {
        const float m0 = p.st_m[sidx];
        float bs = 0.f, cm = -INFINITY, mt = 0.f;
        for (int t = 0; t < 8; ++t) {
            const float ig = bf2f(U[(size_t)t * INP + UIG + h]) + p.b_i[l * 4 + h];
            const float lf = logsigf_(bf2f(U[(size_t)t * INP + UFG + h]) + p.b_f[l * 4 + h]);
            bs += lf; const float a = ig - bs; cm = fmaxf(cm, a); mt = bs + fmaxf(m0, cm);
            sc[32 + t] = mt; sc[t] = expf(bs + m0 - mt); sc[40 + t] = a; sc[48 + t] = bs;
        }
        for (int s = 0; s < 8; ++s) sc[16 + s] = expf(bs + sc[40 + s] - mt);
        sc[24] = expf(bs + m0 - mt);
        p.out[O_SM + sidx] = mt;
    }
    __syncthreads();
#pragma unroll
    for (int i = 0; i < 4; ++i) {
        const int idx = tid + 512 * i, t = idx >> 8, d = idx & 255;
        const float q = bf2f(U[(size_t)t * INP + UQ + h * 256 + d]), k = bf2f(U[(size_t)t * INP + UK + h * 256 + d]), v = bf2f(U[(size_t)t * INP + UV + h * 256 + d]);
        qn[t * 256 + d] = q; kn[t * 256 + d] = k; vn[t * 256 + d] = v; qT[d * 8 + t] = q; kwT[d * 8 + t] = k * sc[16 + t];
    }
    __syncthreads();
    {
        const int t = w;
        const f32x4 qv = *(const f32x4*)(qn + t * 256 + lane * 4);
        float dot[9];
#pragma unroll
        for (int s = 0; s < 8; ++s) { const f32x4 kv = *(const f32x4*)(kn + s * 256 + lane * 4); dot[s] = qv[0] * kv[0] + qv[1] * kv[1] + qv[2] * kv[2] + qv[3] * kv[3]; }
        { const f32x4 nv = *(const f32x4*)(n0 + lane * 4); dot[8] = qv[0] * nv[0] + qv[1] * nv[1] + qv[2] * nv[2] + qv[3] * nv[3]; }
#pragma unroll
        for (int s = 0; s < 9; ++s) dot[s] = wave_sum(dot[s]);
        float den = 0.f;
#pragma unroll
        for (int s = 0; s < 8; ++s) { const float sv = (s <= t) ? dot[s] * expf(sc[48 + t] - sc[32 + t] + sc[40 + s]) : 0.f; den += sv; if (lane == 0) sc[64 + t * 8 + s] = sv; }
        den += sc[t] * dot[8];
        if (lane == 0) sc[8 + t] = 1.0f / fmaxf(fabsf(den), expf(-sc[32 + t]));
    }
    if (tid < 256) {
        float a = sc[24] * n0[tid];
#pragma unroll
        for (int s = 0; s < 8; ++s) a += kwT[tid * 8 + s];
        p.out[O_SN + sidx * 256 + tid] = a;
    }
    const int e4 = lane * 4;
    f32x4 num[8], vv[8];
#pragma unroll
    for (int t = 0; t < 8; ++t) { num[t] = (f32x4){0.f, 0.f, 0.f, 0.f}; vv[t] = *(const f32x4*)(vn + t * 256 + e4); }
    const float decay = sc[24];
#pragma unroll 1
    for (int ib = 0; ib < 4; ++ib) {
        f32x4 cc[8];
#pragma unroll
        for (int j = 0; j < 8; ++j) cc[j] = __builtin_nontemporal_load((const f32x4*)(C0 + (size_t)(w + 8 * (ib * 8 + j)) * 256 + e4));
#pragma unroll
        for (int j = 0; j < 8; ++j) {
            const int d = w + 8 * (ib * 8 + j);
            const f32x4 q0 = *(const f32x4*)(qT + d * 8), q1 = *(const f32x4*)(qT + d * 8 + 4), k0 = *(const f32x4*)(kwT + d * 8), k1 = *(const f32x4*)(kwT + d * 8 + 4);
            f32x4 cn = cc[j] * decay;
#pragma unroll
            for (int t = 0; t < 4; ++t) { num[t] += cc[j] * q0[t]; num[4 + t] += cc[j] * q1[t]; cn += vv[t] * k0[t]; cn += vv[4 + t] * k1[t]; }
            __builtin_nontemporal_store(cn, (f32x4*)(Cout + (size_t)d * 256 + e4));
        }
    }
#pragma unroll
    for (int t = 0; t < 8; ++t) *(f32x4*)(red + (w * 8 + t) * 256 + e4) = num[t];
    __syncthreads();
    {
        const int t = w;
        f32x4 hv = (f32x4){0.f, 0.f, 0.f, 0.f};
#pragma unroll
        for (int ww = 0; ww < 8; ++ww) hv += *(const f32x4*)(red + (ww * 8 + t) * 256 + e4);
        hv = hv * sc[t];
#pragma unroll
        for (int s = 0; s < 8; ++s) hv += vv[s] * sc[64 + t * 8 + s];
        hv = hv * sc[8 + t];
        const float mu = wave_sum(hv[0] + hv[1] + hv[2] + hv[3]) * (1.0f / 256.0f);
        const f32x4 dv = hv - mu;
        const float var = wave_sum(dv[0] * dv[0] + dv[1] * dv[1] + dv[2] * dv[2] + dv[3] * dv[3]) * (1.0f / 256.0f);
        const float rs = rsqrtf(var + 1e-6f);
        const uint2 ov = *(const uint2*)(U + (size_t)t * INP + UO + h * 256 + e4);
        const f32x4 nw = *(const f32x4*)(p.m_norm_w + l * 1024 + h * 256 + e4);
        const float o0 = dv[0] * rs * nw[0] * sigmoidf_(bflo(ov.x)), o1 = dv[1] * rs * nw[1] * sigmoidf_(bfhi(ov.x));
        const float o2 = dv[2] * rs * nw[2] * sigmoidf_(bflo(ov.y)), o3 = dv[3] * rs * nw[3] * sigmoidf_(bfhi(ov.y));
        u32x2 wv; wv.x = pk2(o0, o1); wv.y = pk2(o2, o3);
        *(u32x2*)((bf16_t*)(p.ws + WS_MIXIN) + (size_t)(r0 + t) * D + h * 256 + e4) = wv;
    }
    __syncthreads();
}

DEV void smp_ssd(const P& p, int l, int unit, unsigned char* lds) {
    const int b = unit >> 1, g = unit & 1;
    int tid_ = threadIdx.x; asm volatile("" : "+v"(tid_)); const int tid = tid_, lane = tid & 63, w = tid >> 6, fr = lane & 15, fq = lane >> 4;
    const int r0 = NPR + b * 8;
    const bf16_t* U = (const bf16_t*)(p.ws + WS_U) + (size_t)r0 * INP;
    float* xs = (float*)lds;
    float* xwT = xs + 4096;
    float* Bmf = xwT + 4096;
    float* CBs = Bmf + 1024;
    float* bsh = CBs + 64;
    float* dtsh = bsh + 64;
    float* bLs = dtsh + 64;
    float* MW = bLs + 64;
    float* red = MW + 512;
    float* stat = red + 64;
    bf16_t* Cmb = (bf16_t*)(stat + 64);
    if (tid < 64) {
        const int hd = tid >> 3, t = tid & 7, head = g * 8 + hd;
        const float A = -expf(p.A_log[l * 16 + head]), dtb = p.dt_bias[l * 16 + head];
        float bs = 0.f, bL = 0.f, dtt = 0.f;
        for (int s = 0; s < 8; ++s) { const float dt = softplusf_(bf2f(U[(size_t)s * INP + UDT + head]) + dtb); bL += dt * A; if (s <= t) bs += dt * A; if (s == t) dtt = dt; }
        bsh[hd * 8 + t] = bs; dtsh[hd * 8 + t] = dtt; if (t == 0) bLs[hd] = bL;
    }
    for (int i = tid; i < 8 * 136 / 2; i += NTHR) ((unsigned*)(Cmb + 8 * 136))[i] = 0u;
    const float* cw = p.s_conv_w + (size_t)l * 4 * 1536; const float* cb = p.s_conv_b + (size_t)l * 1536;
    const float* cv0 = p.st_sconv + (size_t)(l * 128 + b) * 3 * 1536;
    for (int i = 0; i < 2; ++i) {
        const int it = tid + 512 * i;
        if (it < 768) {
            const int t = it / 96, gidx = it % 96;
            const int ch8 = gidx < 64 ? g * 512 + gidx * 8 : (gidx < 80 ? 1024 + g * 128 + (gidx - 64) * 8 : 1280 + g * 128 + (gidx - 80) * 8);
            float o[8];
            { const f32x4 b0 = *(const f32x4*)(cb + ch8), b1 = *(const f32x4*)(cb + ch8 + 4); o[0] = b0[0]; o[1] = b0[1]; o[2] = b0[2]; o[3] = b0[3]; o[4] = b1[0]; o[5] = b1[1]; o[6] = b1[2]; o[7] = b1[3]; }
#pragma unroll
            for (int j = 0; j < 4; ++j) {
                const int idx = t + j;
                float xf[8];
                if (idx < 3) { const f32x4 a0 = *(const f32x4*)(cv0 + idx * 1536 + ch8), a1 = *(const f32x4*)(cv0 + idx * 1536 + ch8 + 4);
                    xf[0] = a0[0]; xf[1] = a0[1]; xf[2] = a0[2]; xf[3] = a0[3]; xf[4] = a1[0]; xf[5] = a1[1]; xf[6] = a1[2]; xf[7] = a1[3]; }
                else { const uint4 x = *(const uint4*)(U + (size_t)(idx - 3) * INP + UXS + ch8); unpack8(x, xf); }
                const f32x4 w0 = *(const f32x4*)(cw + j * 1536 + ch8), w1 = *(const f32x4*)(cw + j * 1536 + ch8 + 4);
                o[0] += w0[0] * xf[0]; o[1] += w0[1] * xf[1]; o[2] += w0[2] * xf[2]; o[3] += w0[3] * xf[3];
                o[4] += w1[0] * xf[4]; o[5] += w1[1] * xf[5]; o[6] += w1[2] * xf[6]; o[7] += w1[3] * xf[7];
            }
#pragma unroll
            for (int k = 0; k < 8; ++k) o[k] = siluf_(o[k]);
            if (gidx < 64) {
#pragma unroll
                for (int k = 0; k < 8; ++k) xs[t * 512 + gidx * 8 + k] = o[k]; }
            else if (gidx < 80) {
#pragma unroll
                for (int k = 0; k < 8; ++k) Bmf[t * 128 + (gidx - 64) * 8 + k] = o[k]; }
            else { u32x4 wv; wv.x = pk2(o[0], o[1]); wv.y = pk2(o[2], o[3]); wv.z = pk2(o[4], o[5]); wv.w = pk2(o[6], o[7]); *(u32x4*)(Cmb + t * 136 + (gidx - 80) * 8) = wv; }
        }
    }
    __syncthreads();
#pragma unroll
    for (int i = 0; i < 8; ++i) {
        const int idx = tid + 512 * i, hp = idx >> 3, s = idx & 7, hd = hp >> 6;
        xwT[hp * 8 + s] = xs[s * 512 + hp] * expf(bLs[hd] - bsh[hd * 8 + s]) * dtsh[hd * 8 + s];
    }
    if (tid < 64) {
        const int t = tid >> 3, s = tid & 7; float a = 0.f;
        for (int n = 0; n < 128; ++n) a += bf2f(Cmb[t * 136 + n]) * Bmf[s * 128 + n];
        CBs[t * 8 + s] = a;
    }
    __syncthreads();
    { const int hd = tid >> 6, t = (tid >> 3) & 7, s = tid & 7;
      MW[tid] = (s <= t) ? CBs[t * 8 + s] * expf(bsh[hd * 8 + t] - bsh[hd * 8 + s]) * dtsh[hd * 8 + s] : 0.f; }
    __syncthreads();
    const int head = g * 8 + w;
    const size_t sidx = (size_t)(l * 128 + b) * 16 + head;
    const float* S0 = p.st_ssm + sidx * 8192; float* So = p.out + O_SS + sidx * 8192;
    const float dA = expf(bLs[w]);
    f32x4 acc[4];
#pragma unroll
    for (int nt = 0; nt < 4; ++nt) {
        acc[nt] = (f32x4){0.f, 0.f, 0.f, 0.f};
        const int pp = 16 * nt + fr;
        const f32x4 xw0 = *(const f32x4*)(xwT + (64 * w + pp) * 8), xw1 = *(const f32x4*)(xwT + (64 * w + pp) * 8 + 4);
        f32x4 sv[4][2];
#pragma unroll
        for (int ks = 0; ks < 4; ++ks) { sv[ks][0] = __builtin_nontemporal_load((const f32x4*)(S0 + pp * 128 + 32 * ks + fq * 8)); sv[ks][1] = __builtin_nontemporal_load((const f32x4*)(S0 + pp * 128 + 32 * ks + fq * 8 + 4)); }
#pragma unroll
        for (int ks = 0; ks < 4; ++ks) {
            const int n0 = 32 * ks + fq * 8;
            const f32x4 s0 = sv[ks][0], s1 = sv[ks][1];
            union { u32x4 u; bf16x8 v; } bfr;
            bfr.u.x = pk2(s0[0], s0[1]); bfr.u.y = pk2(s0[2], s0[3]); bfr.u.z = pk2(s1[0], s1[1]); bfr.u.w = pk2(s1[2], s1[3]);
            const bf16x8 af = *(const bf16x8*)(Cmb + fr * 136 + n0);
            acc[nt] = mfma16(af, bfr.v, acc[nt]);
            f32x4 o0 = s0 * dA, o1 = s1 * dA;
#pragma unroll
            for (int s = 0; s < 8; ++s) {
                const float xv = s < 4 ? xw0[s & 3] : xw1[s & 3];
                const f32x4 bm0 = *(const f32x4*)(Bmf + s * 128 + n0), bm1 = *(const f32x4*)(Bmf + s * 128 + n0 + 4);
                o0 += bm0 * xv; o1 += bm1 * xv;
            }
            __builtin_nontemporal_store(o0, (f32x4*)(So + pp * 128 + n0)); __builtin_nontemporal_store(o1, (f32x4*)(So + pp * 128 + n0 + 4));
        }
        asm volatile("" ::: "memory");
    }
    const float dsk = p.D_skip[l * 16 + head];
    float gts[4][4];
#pragma unroll
    for (int j = 0; j < 4; ++j) {
        const int t = (fq & 1) * 4 + j;
        const float eb = expf(bsh[w * 8 + t]);
        float ssq = 0.f;
#pragma unroll
        for (int nt = 0; nt < 4; ++nt) {
            const int hp = 64 * w + 16 * nt + fr;
            float y = eb * acc[nt][j] + dsk * xs[t * 512 + hp];
#pragma unroll
            for (int s = 0; s < 8; ++s) y += MW[(w * 8 + t) * 8 + s] * xs[s * 512 + hp];
            const float z = bf2f(U[(size_t)t * INP + UZ + g * 512 + hp]);
            const float gt = y * siluf_(z);
            gts[nt][j] = gt; ssq += gt * gt;
        }
        ssq += __shfl_xor(ssq, 1); ssq += __shfl_xor(ssq, 2); ssq += __shfl_xor(ssq, 4); ssq += __shfl_xor(ssq, 8);
        if (fr == 0 && fq < 2) red[t * 8 + w] = ssq;
    }
    __syncthreads();
    if (tid < 8) { float s = 0.f;
#pragma unroll
        for (int i = 0; i < 8; ++i) s += red[tid * 8 + i];
        stat[tid] = rsqrtf(s * (1.0f / 512.0f) + 1e-6f); }
    __syncthreads();
    if (fq < 2) {
        bf16_t* MX = (bf16_t*)(p.ws + WS_MIXIN);
#pragma unroll
        for (int j = 0; j < 4; ++j) {
            const int t = fq * 4 + j;
#pragma unroll
            for (int nt = 0; nt < 4; ++nt) {
                const int ch = g * 512 + 64 * w + 16 * nt + fr;
                MX[(size_t)(r0 + t) * D + 1024 + ch] = f2bf(gts[nt][j] * stat[t] * p.s_norm_w[l * 1024 + ch]);
            }
        }
    }
    __syncthreads();
}

DEV void phase_ln(const P& p, int l, int which) {
    int tid_ = threadIdx.x; asm volatile("" : "+v"(tid_));
    const int lane = tid_ & 63, w = tid_ >> 6;
    const float* gam = (which ? p.ln2_g : p.ln1_g) + l * D; const float* bet = (which ? p.ln2_b : p.ln1_b) + l * D;
    const bf16_t* mix = (const bf16_t*)(p.ws + WS_MIXF);
    bf16_t* xb = (bf16_t*)(p.ws + WS_XB);
    const bool first = (l == 0 && which == 0), lastp = (l == 1 && which == 1), split = (gridDim.x == 256);
    for (int r = blockIdx.x * 8 + w; r < NTOK; r += gridDim.x * 8) {
        f32x4 y[8]; float s = 0.f;
#pragma unroll
        for (int i = 0; i < 8; ++i) { const int cidx = i * 256 + lane * 4;
            f32x4 xv, mv;
            if (first) xv = *(const f32x4*)((r < NPR ? p.x_prompt + (size_t)r * D : p.x_sample + (size_t)(r - NPR) * D) + cidx);
            else { const uint2 t = *(const uint2*)(xb + (size_t)r * D + cidx); xv = (f32x4){bflo(t.x), bfhi(t.x), bflo(t.y), bfhi(t.y)}; }
            if (split && r >= NPR) { const float* pp = (const float*)(p.ws + WS_PART) + (size_t)(r - NPR) * D + cidx; mv = *(const f32x4*)pp;
#pragma unroll
                for (int k = 1; k < 8; ++k) mv += *(const f32x4*)(pp + (size_t)k * NSM * D); }
            else { const uint2 t = *(const uint2*)(mix + (size_t)r * D + cidx); mv = (f32x4){bflo(t.x), bfhi(t.x), bflo(t.y), bfhi(t.y)}; }
            y[i] = xv * ALPHA + mv; s += (y[i][0] + y[i][1]) + (y[i][2] + y[i][3]); }
        const float mu = wave_sum(s) * (1.0f / D);
        float q = 0.f;
#pragma unroll
        for (int i = 0; i < 8; ++i) { y[i] = y[i] - mu; q += (y[i][0] * y[i][0] + y[i][1] * y[i][1]) + (y[i][2] * y[i][2] + y[i][3] * y[i][3]); }
        const float rs = rsqrtf(wave_sum(q) * (1.0f / D) + 1e-5f);
#pragma unroll
        for (int i = 0; i < 8; ++i) { const int cidx = i * 256 + lane * 4;
            const f32x4 o = y[i] * rs * *(const f32x4*)(gam + cidx) + *(const f32x4*)(bet + cidx);
            if (lastp) *(f32x4*)(p.out + (size_t)r * D + cidx) = o;
            else { u32x2 wv; wv.x = pk2(o[0], o[1]); wv.y = pk2(o[2], o[3]); *(u32x2*)(xb + (size_t)r * D + cidx) = wv; } }
    }
}

DEV void phase_ffn_gate(const P& p, int l) {
    const bf16_t* up = (const bf16_t*)(p.ws + WS_UP); bf16_t* act = (bf16_t*)(p.ws + WS_ACT);
    const float* fw = p.f_conv_w + (size_t)l * 3 * DFF2; const float* fb = p.f_conv_b + (size_t)l * DFF2;
    const int total = (NTOK / 8) * (DFF / 8);
    int tid_ = threadIdx.x; asm volatile("" : "+v"(tid_));
    for (int it = blockIdx.x * NTHR + tid_; it < total; it += gridDim.x * NTHR) {
        const int rb = it / (DFF / 8), j8 = (it % (DFF / 8)) * 8, r0 = rb * 8;
        const bool smp = r0 >= NPR; const int t0 = smp ? 0 : (r0 & 2047); const int sb = (r0 - NPR) >> 3;
        float wg[3][8], wv[3][8], bg[8], bv[8];
#pragma unroll
        for (int k = 0; k < 3; ++k) {
            const f32x4 a0 = *(const f32x4*)(fw + k * DFF2 + j8), a1 = *(const f32x4*)(fw + k * DFF2 + j8 + 4), c0 = *(const f32x4*)(fw + k * DFF2 + DFF + j8), c1 = *(const f32x4*)(fw + k * DFF2 + DFF + j8 + 4);
#pragma unroll
            for (int i = 0; i < 4; ++i) { wg[k][i] = a0[i]; wg[k][4 + i] = a1[i]; wv[k][i] = c0[i]; wv[k][4 + i] = c1[i]; }
        }
        { const f32x4 a0 = *(const f32x4*)(fb + j8), a1 = *(const f32x4*)(fb + j8 + 4), c0 = *(const f32x4*)(fb + DFF + j8), c1 = *(const f32x4*)(fb + DFF + j8 + 4);
#pragma unroll
          for (int i = 0; i < 4; ++i) { bg[i] = a0[i]; bg[4 + i] = a1[i]; bv[i] = c0[i]; bv[4 + i] = c1[i]; } }
        float g0[8], g1[8], v0[8], v1[8];
        if (t0 > 0) {
            unpack8(*(const uint4*)(up + (size_t)(r0 - 2) * DFF2 + j8), g0); unpack8(*(const uint4*)(up + (size_t)(r0 - 2) * DFF2 + DFF + j8), v0);
            unpack8(*(const uint4*)(up + (size_t)(r0 - 1) * DFF2 + j8), g1); unpack8(*(const uint4*)(up + (size_t)(r0 - 1) * DFF2 + DFF + j8), v1);
        } else if (smp) {
            const float* bp = p.st_fconv + (size_t)(l * 128 + sb) * 2 * DFF2;
            const f32x4 a0 = *(const f32x4*)(bp + j8), a1 = *(const f32x4*)(bp + j8 + 4), c0 = *(const f32x4*)(bp + DFF + j8), c1 = *(const f32x4*)(bp + DFF + j8 + 4);
            const f32x4 d0 = *(const f32x4*)(bp + DFF2 + j8), d1 = *(const f32x4*)(bp + DFF2 + j8 + 4), e0 = *(const f32x4*)(bp + DFF2 + DFF + j8), e1 = *(const f32x4*)(bp + DFF2 + DFF + j8 + 4);
#pragma unroll
            for (int i = 0; i < 4; ++i) { g0[i] = a0[i]; g0[4 + i] = a1[i]; v0[i] = c0[i]; v0[4 + i] = c1[i]; g1[i] = d0[i]; g1[4 + i] = d1[i]; v1[i] = e0[i]; v1[4 + i] = e1[i]; }
        } else {
#pragma unroll
            for (int i = 0; i < 8; ++i) { g0[i] = 0.f; g1[i] = 0.f; v0[i] = 0.f; v1[i] = 0.f; }
        }
#pragma unroll
        for (int rr = 0; rr < 8; ++rr) {
            float g2[8], v2[8];
            unpack8(*(const uint4*)(up + (size_t)(r0 + rr) * DFF2 + j8), g2); unpack8(*(const uint4*)(up + (size_t)(r0 + rr) * DFF2 + DFF + j8), v2);
            float o[8];
#pragma unroll
            for (int i = 0; i < 8; ++i) {
                const float ag = bg[i] + wg[0][i] * g0[i] + wg[1][i] * g1[i] + wg[2][i] * g2[i];
                const float av = bv[i] + wv[0][i] * v0[i] + wv[1][i] * v1[i] + wv[2][i] * v2[i];
                o[i] = ag * __builtin_amdgcn_rcpf(1.0f + __expf(-ag)) * av;
                g0[i] = g1[i]; g1[i] = g2[i]; v0[i] = v1[i]; v1[i] = v2[i];
            }
            u32x4 wv4; wv4.x = pk2(o[0], o[1]); wv4.y = pk2(o[2], o[3]); wv4.z = pk2(o[4], o[5]); wv4.w = pk2(o[6], o[7]);
            *(u32x4*)(act + (size_t)(r0 + rr) * DFF + j8) = wv4;
        }
    }
    const int tot2 = 132 * 2 * (DFF2 / 8);
    for (int it = blockIdx.x * NTHR + tid_; it < tot2; it += gridDim.x * NTHR) {
        const int c8 = (it % (DFF2 / 8)) * 8, rr = it / (DFF2 / 8), j = rr & 1, sq = rr >> 1;
        float* o; size_t row;
        if (sq < 4) { o = p.out + O_PFC + ((size_t)(l * 4 + sq) * 2 + j) * DFF2 + c8; row = (size_t)sq * 2048 + 2046 + j; }
        else { const int b = sq - 4; o = p.out + O_SFC + ((size_t)(l * 128 + b) * 2 + j) * DFF2 + c8; row = (size_t)NPR + b * 8 + 6 + j; }
        float xf[8]; unpack8(*(const uint4*)(up + row * DFF2 + c8), xf);
        *(f32x4*)o = (f32x4){xf[0], xf[1], xf[2], xf[3]}; *(f32x4*)(o + 4) = (f32x4){xf[4], xf[5], xf[6], xf[7]};
    }
}


#define XB_TMO      128
#define XB_XCNT(j)  (256  + 64 * (j))
#define XB_XSUB(j)  (1280 + 64 * (j))
#define XB_XGEN(j)  (2304 + 64 * (j))
#define XB_TOP      3328
#define XB_TOPGEN   3392
#define XCD_BAR_WORDS 3456
#define XB_SPIN_CAP (1u << 20)
DEV unsigned xb_ld(unsigned* p)              { return __hip_atomic_load(p, __ATOMIC_RELAXED, __HIP_MEMORY_SCOPE_AGENT); }
DEV unsigned xb_add(unsigned* p, unsigned v) { return __hip_atomic_fetch_add(p, v, __ATOMIC_RELAXED, __HIP_MEMORY_SCOPE_AGENT); }
DEV unsigned xb_xcc_id() { return (unsigned)__builtin_amdgcn_s_getreg((3 << 11) | 20) & 0xFu; }
#define XB_SPIN(cond, bar) do { unsigned _sp = 0; while (cond) { __builtin_amdgcn_s_sleep(1); \
    if ((++_sp & 255u) == 0u) { if (xb_ld(&(bar)[XB_TMO])) break; if (_sp > XB_SPIN_CAP) { atomicAdd(&(bar)[XB_TMO], 1u); break; } } } } while (0)
struct XcdBarrier { unsigned* bar; unsigned x; volatile LAS unsigned* st; };
DEV XcdBarrier xcd_barrier_post(unsigned* bar, volatile LAS unsigned* st) {
    XcdBarrier b; b.bar = bar; b.x = xb_xcc_id(); b.st = st;
    if (threadIdx.x == 0) (void)xb_add(&bar[XB_XCNT(b.x)], 1u);
    return b;
}
DEV void xcd_barrier_complete(unsigned* bar, unsigned x, unsigned& nloc, unsigned& nx) {
    const unsigned G = gridDim.x * gridDim.y * gridDim.z;
    unsigned sum, cnt, mine, sp = 0u;
    for (;;) {
        sum = 0u; cnt = 0u; mine = 0u;
#pragma unroll
        for (unsigned j = 0; j < 16; ++j) { const unsigned c = xb_ld(&bar[XB_XCNT(j)]); sum += c; cnt += (c > 0u) ? 1u : 0u; mine = (j == x) ? c : mine; }
        if (sum == G) break;
        __builtin_amdgcn_s_sleep(1);
        if ((++sp & 255u) == 0u) { if (xb_ld(&bar[XB_TMO])) break; if (sp > XB_SPIN_CAP) { atomicAdd(&bar[XB_TMO], 1u); break; } }
    }
    nloc = mine > 0u ? mine : 1u; nx = cnt > 0u ? cnt : 1u;
}
DEV void xcd_barrier(const XcdBarrier& b) {
    asm volatile("s_waitcnt vmcnt(0)" ::: "memory");
    __syncthreads();
    if (threadIdx.x == 0) {
        unsigned* bar = b.bar;
        __builtin_amdgcn_s_waitcnt(0);
        unsigned nloc = b.st[0], nx = b.st[1];
        if (nloc == 0u) { xcd_barrier_complete(bar, b.x, nloc, nx); b.st[0] = nloc; b.st[1] = nx; }
        const unsigned old = xb_add(&bar[XB_XSUB(b.x)], 1u);
        const unsigned gen = old / nloc;
        if (old + 1u == (gen + 1u) * nloc) {
            __builtin_amdgcn_fence(__ATOMIC_RELEASE, "agent");
            asm volatile("s_waitcnt vmcnt(0)" ::: "memory");
            const unsigned og = xb_add(&bar[XB_TOP], 1u);
            const unsigned tg = og / nx;
            if (og + 1u == (tg + 1u) * nx) xb_add(&bar[XB_TOPGEN], 1u);
            else XB_SPIN(xb_ld(&bar[XB_TOPGEN]) == tg, bar);
            __builtin_amdgcn_fence(__ATOMIC_ACQUIRE, "agent");
            xb_add(&bar[XB_XGEN(b.x)], 1u);
            asm volatile("s_waitcnt vmcnt(0)" ::: "memory");
        } else {
            XB_SPIN(xb_ld(&bar[XB_XGEN(b.x)]) == gen, bar);
            __builtin_amdgcn_fence(__ATOMIC_ACQUIRE, "agent");
            asm volatile("s_waitcnt vmcnt(0)" ::: "memory");
        }
    }
    __syncthreads();
}

constexpr int NPHASE = 21;
DEV void run_phase(const P& p, int l, int q, unsigned char* lds) {
    int bid = blockIdx.x, G = gridDim.x; asm volatile("" : "+s"(bid), "+s"(G));
    if (q == 0) {
        pg8::Gemm g{(const bf16_t*)(p.ws + WS_XB), (const bf16_t*)(p.ws + WS_WIN) + (size_t)l * INP * D, NTOK, INP, D};
        pg8::StaticOrder S; S.init(NTOK, INP, D, G, bid);
        pg8::EpiBf16 E{(bf16_t*)(p.ws + WS_U), INP, nullptr};
        pg8::gemm_phase<pg8::EpiBf16, pg8::StaticOrder>((LAS unsigned char*)lds, g, S, E);
    } else if (q == 1) {
        const int par = bid & 1;
#pragma unroll 1
        for (int half = 0; half < 2; ++half) {
            if ((half ^ par) == 0) {
                for (int u = bid; u < 512; u += G) smp_mlstm(p, l, u, lds);
                for (int u = bid; u < 256; u += G) smp_ssd(p, l, u, lds);
            } else {
                for (int u = bid; u < 512; u += G) mlstm_local(p, l, u, lds);
                for (int u = bid; u < 256; u += G) ssd_local(p, l, u, lds);
            }
        }
    } else if (q == 2) {
        for (int u = bid; u < 256; u += G) mlstm_scan(p, l, u, lds);
        for (int u = bid; u < 128; u += G) ssd_scan(p, l, u, lds);
        for (int u = bid; u < 132; u += G) convstate_copy(p, l, u);
    } else if (q == 3) {
        for (int u = bid; u < 512; u += G) mlstm_out(p, l, u, lds);
        for (int u = bid; u < 256; u += G) ssd_out(p, l, u, lds);
    } else if (q == 4) {
        pg8::Gemm g{(const bf16_t*)(p.ws + WS_MIXIN), (const bf16_t*)(p.ws + WS_WOUT) + (size_t)l * D * D, NTOK, D, D};
        pg8::EpiBf16 E{(bf16_t*)(p.ws + WS_MIXF), D, (float*)(p.ws + WS_PART)};
        if (G == 256) { pg8::TailSplitOrder S; S.init(D, bid); pg8::gemm_phase<pg8::EpiBf16, pg8::TailSplitOrder>((LAS unsigned char*)lds, g, S, E); }
        else { pg8::StaticOrder S; S.init(NTOK, D, D, G, bid); pg8::gemm_phase<pg8::EpiBf16, pg8::StaticOrder>((LAS unsigned char*)lds, g, S, E); }
    } else if (q == 5) {
        phase_ln(p, l, 0);
    } else if (q == 6) {
        pg8::Gemm g{(const bf16_t*)(p.ws + WS_XB), (const bf16_t*)(p.ws + WS_WUP) + (size_t)l * DFF2 * D, NTOK, DFF2, D};
        pg8::StaticOrder S; S.init(NTOK, DFF2, D, G, bid);
        pg8::EpiBf16 E{(bf16_t*)(p.ws + WS_UP), DFF2, nullptr};
        pg8::gemm_phase<pg8::EpiBf16, pg8::StaticOrder>((LAS unsigned char*)lds, g, S, E);
    } else if (q == 7) {
        phase_ffn_gate(p, l);
    } else if (q == 8) {
        pg8::Gemm g{(const bf16_t*)(p.ws + WS_ACT), (const bf16_t*)(p.ws + WS_WDN) + (size_t)l * D * DFF, NTOK, D, DFF};
        pg8::EpiBf16 E{(bf16_t*)(p.ws + WS_MIXF), D, (float*)(p.ws + WS_PART)};
        if (G == 256) { pg8::TailSplitOrder S; S.init(DFF, bid); pg8::gemm_phase<pg8::EpiBf16, pg8::TailSplitOrder>((LAS unsigned char*)lds, g, S, E); }
        else { pg8::StaticOrder S; S.init(NTOK, D, DFF, G, bid); pg8::gemm_phase<pg8::EpiBf16, pg8::StaticOrder>((LAS unsigned char*)lds, g, S, E); }
    } else {
        phase_ln(p, l, 1);
    }
}
#if MK_MULTI
template <int T> __global__ void __launch_bounds__(NTHR, 2) k_unit(P p) {
    extern __shared__ __attribute__((aligned(16))) unsigned char lds[];
    const int l = p.ph_lo; int bid = blockIdx.x, G = gridDim.x;
    if (T == 11) for (int u = bid; u < 512; u += G) smp_mlstm(p, l, u, lds);
    if (T == 12) for (int u = bid; u < 256; u += G) smp_ssd(p, l, u, lds);
    if (T == 13) for (int u = bid; u < 512; u += G) mlstm_local(p, l, u, lds);
    if (T == 14) for (int u = bid; u < 256; u += G) ssd_local(p, l, u, lds);
    if (T == 31) for (int u = bid; u < 512; u += G) mlstm_out(p, l, u, lds);
    if (T == 32) for (int u = bid; u < 256; u += G) ssd_out(p, l, u, lds);
    if (T == 21) for (int u = bid; u < 256; u += G) mlstm_scan(p, l, u, lds);
    if (T == 22) for (int u = bid; u < 128; u += G) ssd_scan(p, l, u, lds);
}
template <int Q> __global__ void __launch_bounds__(NTHR, 2) k_phase(P p) {
    extern __shared__ __attribute__((aligned(16))) unsigned char lds[];
    if (Q < 0) phase_prologue(p, lds); else run_phase(p, p.ph_lo, Q, lds);
}
#else
__global__ void __launch_bounds__(NTHR, 2) mk_fwd(P p) {
    extern __shared__ __attribute__((aligned(16))) unsigned char lds[];
    cg::grid_group grid = cg::this_grid();
    if (p.ph_hi < 0) grid.sync();
    if (threadIdx.x < 4) ((unsigned*)(lds + LDS_BYTES - 16))[threadIdx.x] = 0u;
    __syncthreads();
    (void)xcd_barrier_post((unsigned*)(p.ws + WS_BAR), (volatile LAS unsigned*)(lds + LDS_BYTES - 16));
#define GSYNC() do { XcdBarrier b_; b_.bar = (unsigned*)(p.ws + WS_BAR); b_.x = xb_xcc_id(); b_.st = (volatile LAS unsigned*)(lds + LDS_BYTES - 16); xcd_barrier(b_); } while (0)
    phase_prologue(p, lds);
#pragma unroll 1
    for (int l = 0; l < 2; ++l) {
        GSYNC(); run_phase(p, l, 0, lds);
        GSYNC(); run_phase(p, l, 1, lds);
        GSYNC(); run_phase(p, l, 2, lds);
        GSYNC(); run_phase(p, l, 3, lds);
        GSYNC(); run_phase(p, l, 4, lds);
        GSYNC(); run_phase(p, l, 5, lds);
        GSYNC(); run_phase(p, l, 6, lds);
        GSYNC(); run_phase(p, l, 7, lds);
        GSYNC(); run_phase(p, l, 8, lds);
        GSYNC(); run_phase(p, l, 9, lds);
    }
    for (int i = 0; i < PROBE_SYNCS; ++i) GSYNC();
}
#endif

extern "C" void kernel_launch(void* const* d_in, const int* in_sizes, int n_in, void* d_out, int out_size, void* d_ws, size_t ws_size, hipStream_t stream) {
    static int grid = 0;
    if (grid == 0) {
        if (n_in != 27 || ws_size < WS_END) { fprintf(stderr, "kernel_launch: unexpected n_in %d or ws_size %zu (need %zu)\n", n_in, ws_size, (size_t)WS_END); grid = -1; return; }
        int dev = 0, cus = 0, per_cu = 0;
        hipGetDevice(&dev);
        hipDeviceGetAttribute(&cus, hipDeviceAttributeMultiprocessorCount, dev);
#if MK_MULTI
        const void* fns[11] = {(const void*)k_phase<-1>, (const void*)k_phase<0>, (const void*)k_phase<1>, (const void*)k_phase<2>, (const void*)k_phase<3>, (const void*)k_phase<4>, (const void*)k_phase<5>,
                               (const void*)k_phase<6>, (const void*)k_phase<7>, (const void*)k_phase<8>, (const void*)k_phase<9>};
        for (int i = 0; i < 11; ++i) if (hipFuncSetAttribute(fns[i], hipFuncAttributeMaxDynamicSharedMemorySize, LDS_BYTES) != hipSuccess) { fprintf(stderr, "kernel_launch: hipFuncSetAttribute failed\n"); grid = -1; return; }
#else
        if (hipFuncSetAttribute((const void*)mk_fwd, hipFuncAttributeMaxDynamicSharedMemorySize, LDS_BYTES) != hipSuccess) { fprintf(stderr, "kernel_launch: hipFuncSetAttribute failed\n"); grid = -1; return; }
        hipOccupancyMaxActiveBlocksPerMultiprocessor(&per_cu, (const void*)mk_fwd, NTHR, LDS_BYTES);
        (void)hipGetLastError();
#endif
        (void)per_cu;
        grid = cus * 1;
    }
    if (grid < 0) return;
    P p{};
    const float** pp = (const float**)&p;
    for (int i = 0; i < 27; ++i) pp[i] = (const float*)d_in[i];
    p.out = (float*)d_out; p.ws = (unsigned char*)d_ws;
#if MK_MULTI
    p.ph_lo = 0; p.ph_hi = 0;
    if (PROBE_REP == -1) hipLaunchKernelGGL(k_phase<-1>, dim3(grid), dim3(NTHR), LDS_BYTES, stream, p);
    hipLaunchKernelGGL(k_phase<-1>, dim3(grid), dim3(NTHR), LDS_BYTES, stream, p);
    for (int l = 0; l < 2; ++l) {
        p.ph_lo = l;
        for (int rep = 0; rep < 1 + ((PROBE_REP == 0) || (PROBE_REP == 100 && (0 == 0 || 0 == 4 || 0 == 6 || 0 == 8))); ++rep) hipLaunchKernelGGL(k_phase<0>, dim3(grid), dim3(NTHR), LDS_BYTES, stream, p);
        for (int rep = 0; rep < 1 + ((PROBE_REP == 1) || (PROBE_REP == 100 && (1 == 0 || 1 == 4 || 1 == 6 || 1 == 8))); ++rep) hipLaunchKernelGGL(k_phase<1>, dim3(grid), dim3(NTHR), LDS_BYTES, stream, p);
        for (int rep = 0; rep < 1 + ((PROBE_REP == 2) || (PROBE_REP == 100 && (2 == 0 || 2 == 4 || 2 == 6 || 2 == 8))); ++rep) hipLaunchKernelGGL(k_phase<2>, dim3(grid), dim3(NTHR), LDS_BYTES, stream, p);
        for (int rep = 0; rep < 1 + ((PROBE_REP == 3) || (PROBE_REP == 100 && (3 == 0 || 3 == 4 || 3 == 6 || 3 == 8))); ++rep) hipLaunchKernelGGL(k_phase<3>, dim3(grid), dim3(NTHR), LDS_BYTES, stream, p);
        if (PROBE_REP == 11 || PROBE_REP == 12 || PROBE_REP == 13 || PROBE_REP == 14 || PROBE_REP == 31 || PROBE_REP == 32 || PROBE_REP == 21 || PROBE_REP == 22) {
            hipFuncSetAttribute((const void*)k_unit<PROBE_REP>, hipFuncAttributeMaxDynamicSharedMemorySize, LDS_BYTES);
            hipLaunchKernelGGL(k_unit<PROBE_REP>, dim3(grid), dim3(NTHR), LDS_BYTES, stream, p);
        }
        for (int rep = 0; rep < 1 + ((PROBE_REP == 4) || (PROBE_REP == 100 && (4 == 0 || 4 == 4 || 4 == 6 || 4 == 8))); ++rep) hipLaunchKernelGGL(k_phase<4>, dim3(grid), dim3(NTHR), LDS_BYTES, stream, p);
        for (int rep = 0; rep < 1 + ((PROBE_REP == 5) || (PROBE_REP == 100 && (5 == 0 || 5 == 4 || 5 == 6 || 5 == 8))); ++rep) hipLaunchKernelGGL(k_phase<5>, dim3(grid), dim3(NTHR), LDS_BYTES, stream, p);
        for (int rep = 0; rep < 1 + ((PROBE_REP == 6) || (PROBE_REP == 100 && (6 == 0 || 6 == 4 || 6 == 6 || 6 == 8))); ++rep) hipLaunchKernelGGL(k_phase<6>, dim3(grid), dim3(NTHR), LDS_BYTES, stream, p);
        for (int rep = 0; rep < 1 + ((PROBE_REP == 7) || (PROBE_REP == 100 && (7 == 0 || 7 == 4 || 7 == 6 || 7 == 8))); ++rep) hipLaunchKernelGGL(k_phase<7>, dim3(grid), dim3(NTHR), LDS_BYTES, stream, p);
        for (int rep = 0; rep < 1 + ((PROBE_REP == 8) || (PROBE_REP == 100 && (8 == 0 || 8 == 4 || 8 == 6 || 8 == 8))); ++rep) hipLaunchKernelGGL(k_phase<8>, dim3(grid), dim3(NTHR), LDS_BYTES, stream, p);
        for (int rep = 0; rep < 1 + ((PROBE_REP == 9) || (PROBE_REP == 100 && (9 == 0 || 9 == 4 || 9 == 6 || 9 == 8))); ++rep) hipLaunchKernelGGL(k_phase<9>, dim3(grid), dim3(NTHR), LDS_BYTES, stream, p);
    }
#else
    p.ph_lo = 0; p.ph_hi = NPHASE;
    if (hipMemsetAsync((char*)d_ws + WS_BAR, 0, 16384, stream) != hipSuccess) { fprintf(stderr, "kernel_launch: memset failed\n"); return; }
    void* args[] = {&p};
    hipError_t e = hipLaunchCooperativeKernel((const void*)mk_fwd, dim3(grid), dim3(NTHR), args, LDS_BYTES, stream);
    if (e != hipSuccess) fprintf(stderr, "cooperative launch failed: %s (grid %d)\n", hipGetErrorString(e), grid);
#endif
}
```

```cpp
#include <hip/hip_runtime.h>
#include <hip/hip_cooperative_groups.h>
#include <cstdio>
namespace cg = cooperative_groups;

#ifndef MK_MULTI
#define MK_MULTI 0
#endif
#ifndef PROBE_REP
#define PROBE_REP -99
#endif
#ifndef PROBE_SYNCS
#define PROBE_SYNCS 0
#endif

#define DEV __device__ __forceinline__
#define LAS __attribute__((address_space(3)))
typedef unsigned short bf16_t;
typedef short bf16x8 __attribute__((ext_vector_type(8)));
typedef float f32x4 __attribute__((ext_vector_type(4)));
typedef float f32x2 __attribute__((ext_vector_type(2)));
typedef unsigned u32x4 __attribute__((ext_vector_type(4)));
typedef unsigned u32x2 __attribute__((ext_vector_type(2)));

constexpr int D = 2048, NPR = 8192, NSM = 1024, NTOK = 9216, INP = 6912, IN_DIM = 6680, DFF = 5504, DFF2 = 11008;
constexpr int UQ = 0, UK = 1024, UV = 2048, UO = 3072, UZ = 4096, UXS = 5120, UIG = 6656, UFG = 6660, UDT = 6664;
constexpr int NTHR = 512;
constexpr int LDS_BYTES = 136 * 1024;
constexpr float ALPHA = 1.41421356237309515f;

constexpr size_t O_YP = 0;
constexpr size_t O_YS = O_YP + (size_t)4 * 2048 * 2048;
constexpr size_t O_PC = O_YS + (size_t)128 * 8 * 2048;
constexpr size_t O_PN = O_PC + (size_t)2 * 4 * 4 * 256 * 256;
constexpr size_t O_PM = O_PN + (size_t)2 * 4 * 4 * 256;
constexpr size_t O_PS = O_PM + (size_t)2 * 4 * 4;
constexpr size_t O_PSC = O_PS + (size_t)2 * 4 * 16 * 64 * 128;
constexpr size_t O_PFC = O_PSC + (size_t)2 * 4 * 3 * 1536;
constexpr size_t O_SC = O_PFC + (size_t)2 * 4 * 2 * DFF2;
constexpr size_t O_SN = O_SC + (size_t)2 * 128 * 4 * 256 * 256;
constexpr size_t O_SM = O_SN + (size_t)2 * 128 * 4 * 256;
constexpr size_t O_SS = O_SM + (size_t)2 * 128 * 4;
constexpr size_t O_SSC = O_SS + (size_t)2 * 128 * 16 * 64 * 128;
constexpr size_t O_SFC = O_SSC + (size_t)2 * 128 * 3 * 1536;

constexpr size_t WS_WIN = 0;
constexpr size_t WS_WOUT = WS_WIN + (size_t)2 * INP * D * 2;
constexpr size_t WS_WUP = WS_WOUT + (size_t)2 * D * D * 2;
constexpr size_t WS_WDN = WS_WUP + (size_t)2 * DFF2 * D * 2;
constexpr size_t WS_XB = WS_WDN + (size_t)2 * D * DFF * 2;
constexpr size_t WS_XF = WS_XB + (size_t)NTOK * D * 2;
constexpr size_t WS_XBC = WS_XF;
constexpr size_t WS_U = WS_XF + (size_t)NTOK * D * 4;
constexpr size_t WS_MIXIN = WS_U + (size_t)NTOK * INP * 2;
constexpr size_t WS_MIXF = WS_MIXIN + (size_t)NTOK * D * 2;
constexpr size_t WS_UP = WS_MIXF + (size_t)NTOK * D * 4;
constexpr size_t WS_ACT = WS_UP + (size_t)NTOK * DFF2 * 2;
constexpr size_t WS_PART = WS_ACT + (size_t)NTOK * DFF * 2;
constexpr size_t WS_SMALL = WS_PART + (size_t)8 * NSM * D * 4;
constexpr size_t WS_DBUF = WS_UP;
constexpr size_t WS_SBUF = WS_UP + (size_t)512 * 65536 * 4;
constexpr size_t WS_CT = WS_ACT;
constexpr size_t WS_ST = WS_ACT + (size_t)512 * 65536 * 2;
static_assert(WS_SBUF + (size_t)2048 * 8192 * 4 <= WS_ACT, "alias");
static_assert(WS_ST + (size_t)2048 * 8192 * 2 <= WS_PART, "alias");
constexpr size_t WS_NLOC = WS_SMALL;
constexpr size_t WS_NST = WS_NLOC + (size_t)512 * 256 * 4;
constexpr size_t WS_GSTAT = WS_NST + (size_t)512 * 256 * 4;
constexpr size_t WS_MST = WS_GSTAT + 4096;
constexpr size_t WS_SBSUM = WS_MST + 4096;
constexpr size_t WS_BAR = WS_SBSUM + 8192;
constexpr size_t WS_END = WS_BAR + 16384;

struct P {
    const float* x_prompt; const float* x_sample; const float* st_C; const float* st_n; const float* st_m; const float* st_ssm; const float* st_sconv; const float* st_fconv;
    const float* w_in; const float* b_i; const float* b_f; const float* m_norm_w; const float* s_conv_w; const float* s_conv_b; const float* dt_bias; const float* A_log; const float* D_skip;
    const float* s_norm_w; const float* w_out; const float* ln1_g; const float* ln1_b; const float* w_up; const float* f_conv_w; const float* f_conv_b; const float* w_down; const float* ln2_g; const float* ln2_b;
    float* out; unsigned char* ws; int ph_lo, ph_hi;
};

DEV float bf2f(bf16_t v) { return __uint_as_float(((unsigned)v) << 16); }
DEV bf16_t f2bf(float f) { unsigned u = __float_as_uint(f); u += 0x7FFFu + ((u >> 16) & 1u); return (bf16_t)(u >> 16); }
DEV unsigned pk2(float lo, float hi) { return (unsigned)f2bf(lo) | ((unsigned)f2bf(hi) << 16); }
DEV float bflo(unsigned w) { return __uint_as_float(w << 16); }
DEV float bfhi(unsigned w) { return __uint_as_float(w & 0xffff0000u); }
DEV float sigmoidf_(float x) { return __builtin_amdgcn_rcpf(1.0f + __expf(-x)); }
DEV float siluf_(float x) { return x * sigmoidf_(x); }
DEV float softplusf_(float x) { return fmaxf(x, 0.f) + log1pf(expf(-fabsf(x))); }
DEV float logsigf_(float x) { return fminf(x, 0.f) - log1pf(expf(-fabsf(x))); }
DEV float wave_sum(float v) {
#pragma unroll
    for (int o = 32; o >= 1; o >>= 1) v += __shfl_xor(v, o);
    return v; }
DEV float wave_max(float v) {
#pragma unroll
    for (int o = 32; o >= 1; o >>= 1) v = fmaxf(v, __shfl_xor(v, o));
    return v; }
DEV float wave_incl_sum(float v, int lane) {
#pragma unroll
    for (int o = 1; o < 64; o <<= 1) { float t = __shfl_up(v, o); if (lane >= o) v += t; }
    return v; }
DEV float wave_incl_max(float v, int lane) {
#pragma unroll
    for (int o = 1; o < 64; o <<= 1) { float t = __shfl_up(v, o); if (lane >= o) v = fmaxf(v, t); }
    return v; }
DEV f32x4 mfma16(bf16x8 a, bf16x8 b, f32x4 c) { return __builtin_amdgcn_mfma_f32_16x16x32_bf16(a, b, c, 0, 0, 0); }
DEV void unpack8(uint4 x, float (&f)[8]) { f[0] = bflo(x.x); f[1] = bfhi(x.x); f[2] = bflo(x.y); f[3] = bfhi(x.y); f[4] = bflo(x.z); f[5] = bfhi(x.z); f[6] = bflo(x.w); f[7] = bfhi(x.w); }

typedef short s16x4 __attribute__((ext_vector_type(4)));
DEV bf16x8 tr_frag(const bf16_t* T, int pitch, int krow0, int col0, int lane) {
    const int g = lane >> 4, q = (lane & 15) >> 2, pl = lane & 3;
    const bf16_t* a0 = T + (krow0 + 8 * g + q) * pitch + col0 + 4 * pl;
    const s16x4 lo = __builtin_amdgcn_ds_read_tr16_b64_v4i16((LAS s16x4*)a0);
    const s16x4 hi = __builtin_amdgcn_ds_read_tr16_b64_v4i16((LAS s16x4*)(a0 + 4 * pitch));
    return (bf16x8){lo[0], lo[1], lo[2], lo[3], hi[0], hi[1], hi[2], hi[3]};
}

namespace pg8 {
constexpr int BM = 256, BK = 64, HALF = 128, HTB = HALF * BK * 2, STAGE_BYTES = 8 * HTB, NXCD = 8, WGM = 8;
DEV int lds_byte(int r, int c) { const int st = (r >> 4) * 2 + (c >> 5), rr = r & 15, cc = c & 31, ob = rr * 64 + cc * 2; return st * 1024 + (ob ^ (((ob >> 9) & 1) << 5)); }
DEV void stage_rc(int b, int& R, int& C) { const int st = b / 1024, sb = b % 1024, swz = sb ^ (((sb >> 9) & 1) << 5); R = (st >> 1) * 16 + swz / 64; C = (st & 1) * 32 + (swz % 64) / 2; }
DEV int perm32(int rho) { const int n = rho >> 4, i = rho & 15; return 8 * (i >> 2) + 4 * n + (i & 3); }
struct Unit { int pm, pn, k0, nt, ks; };
struct Gemm { const bf16_t* A; const bf16_t* Bt; int M, N, K; };
struct StaticOrder {
    int nM, nN, nwg, G, c, ntk;
    DEV void init(int M, int N, int K, int G_, int c_) { nM = M / BM; nN = N / BM; nwg = nM * nN; G = G_; c = c_; ntk = K / BK; }
    DEV bool next(int i, Unit& u) const {
        u.pm = 0; u.pn = 0; u.k0 = 0; u.nt = 4; u.ks = -1;
        const long L = (long)i * G + c; if (L >= nwg) return false;
        int wgid = (int)L; { const int q = nwg / NXCD, r = nwg % NXCD, xcd = wgid % NXCD, off = wgid / NXCD; wgid = (xcd < r ? xcd * (q + 1) : r * (q + 1) + (xcd - r) * q) + off; }
        const int nig = WGM * nN, gid = wgid / nig, fm = gid * WGM, gsz = (nM - fm) < WGM ? (nM - fm) : WGM;
        u.pm = fm + ((wgid % nig) % gsz); u.pn = (wgid % nig) / gsz; u.k0 = 0; u.nt = ntk; u.ks = -1; return true;
    }
};
struct TailSplitOrder {
    StaticOrder so; int c, ntk;
    DEV void init(int K, int c_) { so.init(NPR, D, K, 256, c_); c = c_; ntk = K / BK; }
    DEV bool next(int i, Unit& u) const {
        u.pm = 0; u.pn = 0; u.k0 = 0; u.nt = 4; u.ks = -1;
        if (i == 0) return so.next(0, u);
        if (i > 1) return false;
        const int tt = c >> 3, ks = c & 7; u.pm = 32 + (tt >> 3); u.pn = tt & 7; u.ks = ks;
        const int pairs = ntk >> 1, base = pairs >> 3, rem = pairs & 7;
        const int p0 = ks * base + (ks < rem ? ks : rem), np = base + (ks < rem ? 1 : 0);
        u.k0 = p0 * 128; u.nt = np * 2; return true;
    }
};
DEV unsigned cvt_pk_bf16(float lo, float hi) { unsigned r; asm volatile("v_cvt_pk_bf16_f32 %0, %1, %2" : "=v"(r) : "v"(lo), "v"(hi)); return r; }
struct EpiF32 {
    static constexpr bool PERM = false;
    float* C; int ldc; float* part;
    DEV void operator()(const f32x4 (&acc)[2][2][4][2], const Unit& u, int wr, int wc, int fr, int fq) const {
        const int row0 = u.pm * BM + wr * 64 + fr, col0 = u.pn * BM + wc * 32 + 4 * fq;
        float* Cb = u.ks < 0 ? C : part + (size_t)u.ks * NSM * D - (size_t)NPR * ldc;
#pragma unroll
        for (int ai = 0; ai < 2; ++ai)
#pragma unroll
            for (int m = 0; m < 4; ++m) { float* rowp = Cb + (size_t)(row0 + ai * HALF + m * 16) * ldc + col0;
#pragma unroll
                for (int bj = 0; bj < 2; ++bj)
#pragma unroll
                    for (int n = 0; n < 2; ++n) *(f32x4*)(rowp + bj * HALF + n * 16) = acc[ai][bj][m][n]; }
    }
};
struct EpiBf16 {
    static constexpr bool PERM = true;
    bf16_t* O; int ldc; float* part;
    DEV void operator()(const f32x4 (&acc)[2][2][4][2], const Unit& u, int wr, int wc, int fr, int fq) const {
        const int row0 = u.pm * BM + wr * 64 + fr; const int col0 = u.pn * BM + wc * 32 + 8 * fq;
        if (u.ks >= 0) {
            float* pb = part + (size_t)u.ks * NSM * ldc + (size_t)(row0 - NPR) * ldc + col0;
#pragma unroll
            for (int ai = 0; ai < 2; ++ai)
#pragma unroll
                for (int m = 0; m < 4; ++m)
#pragma unroll
                    for (int bj = 0; bj < 2; ++bj) { float* q = pb + (size_t)(ai * HALF + m * 16) * ldc + bj * HALF; *(f32x4*)q = acc[ai][bj][m][0]; *(f32x4*)(q + 4) = acc[ai][bj][m][1]; }
            return;
        }
#pragma unroll
        for (int ai = 0; ai < 2; ++ai)
#pragma unroll
            for (int m = 0; m < 4; ++m) { bf16_t* rowp = O + (size_t)(row0 + ai * HALF + m * 16) * ldc + col0;
#pragma unroll
                for (int bj = 0; bj < 2; ++bj) { const f32x4 v0 = acc[ai][bj][m][0], v1 = acc[ai][bj][m][1];
                    u32x4 w; w.x = cvt_pk_bf16(v0[0], v0[1]); w.y = cvt_pk_bf16(v0[2], v0[3]); w.z = cvt_pk_bf16(v1[0], v1[1]); w.w = cvt_pk_bf16(v1[2], v1[3]);
                    *(u32x4*)(rowp + bj * HALF) = w; } }
    }
};

template <class Epi, class Sched>
DEV void gemm_phase(LAS unsigned char* lds, const Gemm g, const Sched& S, const Epi& E) {
    int tid_ = threadIdx.x; asm volatile("" : "+v"(tid_)); const int tid = tid_, wid = __builtin_amdgcn_readfirstlane(tid >> 6), lane = tid & 63, wr = wid >> 2, wc = wid & 3, fr = lane & 15, fq = lane >> 4;
    const int K = g.K;
    unsigned voffA[2], voffB[2];
#pragma unroll
    for (int i = 0; i < 2; ++i) { int R, C; stage_rc(tid * 16 + i * 8192, R, C); const int Rb = Epi::PERM ? ((R & ~31) + perm32(R & 31)) : R;
        voffA[i] = (unsigned)(R * K + C) * 2u; voffB[i] = (unsigned)(Rb * K + C) * 2u; }
    const size_t kstep = (size_t)(BK * 2);
    const size_t hstep = (size_t)HALF * K * 2;
    const size_t tstep = 2 * hstep;
    const unsigned ldsw = (unsigned)wid * 1024u;
    const int aoff = lds_byte(wr * 64 + fr, fq * 8), boff = lds_byte(wc * 32 + fr, fq * 8);
#define PG8_SA(b, h) (((b) * 2 + (h)) * HTB)
#define PG8_SB(b, h) ((4 + (b) * 2 + (h)) * HTB)
#define PG8_STAGE(bufoff, gbase, voff) do { _Pragma("unroll") for (int _i = 0; _i < 2; ++_i) \
        __builtin_amdgcn_global_load_lds((const unsigned*)((const char*)(gbase) + (voff)[_i]), (LAS unsigned*)(lds + (bufoff) + ldsw + _i * 8192), 16, 0, 0); } while (0)
#define PG8_LDA(dst, b, h) do { _Pragma("unroll") for (int m = 0; m < 4; ++m) _Pragma("unroll") for (int k = 0; k < 2; ++k) dst[m][k] = *(const LAS bf16x8*)(lds + PG8_SA(b, h) + aoff + m * 2048 + k * 1024); } while (0)
#define PG8_LDB(dst, b, h) do { _Pragma("unroll") for (int n = 0; n < 2; ++n) _Pragma("unroll") for (int k = 0; k < 2; ++k) dst[n][k] = *(const LAS bf16x8*)(lds + PG8_SB(b, h) + boff + n * 2048 + k * 1024); } while (0)
#define PG8_MMA(ai, bj, At, Bt) do { __builtin_amdgcn_s_setprio(1); _Pragma("unroll") for (int m = 0; m < 4; ++m) _Pragma("unroll") for (int n = 0; n < 2; ++n) _Pragma("unroll") for (int k = 0; k < 2; ++k) \
        acc[ai][bj][m][n] = __builtin_amdgcn_mfma_f32_16x16x32_bf16(Bt[n][k], At[m][k], acc[ai][bj][m][n], 0, 0, 0); __builtin_amdgcn_s_setprio(0); } while (0)
#define PG8_WAIT_V(n) asm volatile("s_waitcnt vmcnt(" #n ")" ::: "memory")
#define PG8_WAIT_L(n) asm volatile("s_waitcnt lgkmcnt(" #n ")" ::: "memory")
#define PG8_BAR __builtin_amdgcn_s_barrier()
#define PG8_SCHED __builtin_amdgcn_sched_barrier(0)
    Unit cur, nxt; int ui = 0;
    if (!S.next(0, cur)) return;
    f32x4 acc[2][2][4][2];
#pragma unroll
    for (int a = 0; a < 2; ++a)
#pragma unroll
        for (int b = 0; b < 2; ++b)
#pragma unroll
            for (int m = 0; m < 4; ++m)
#pragma unroll
                for (int n = 0; n < 2; ++n) acc[a][b][m][n] = (f32x4){0.f, 0.f, 0.f, 0.f};
    bf16x8 At[4][2], B0[2][2], B1[2][2];
    const char* cA = (const char*)g.A + (size_t)cur.pm * tstep + (size_t)cur.k0 * 2; const char* cB = (const char*)g.Bt + (size_t)cur.pn * tstep + (size_t)cur.k0 * 2;
    PG8_STAGE(PG8_SB(0, 0), cB, voffB); PG8_STAGE(PG8_SA(0, 0), cA, voffA); PG8_STAGE(PG8_SB(0, 1), cB + hstep, voffB); PG8_STAGE(PG8_SA(0, 1), cA + hstep, voffA);
    if (wr == 1) PG8_BAR;
    PG8_WAIT_V(4); PG8_BAR;
    PG8_STAGE(PG8_SB(1, 0), cB + kstep, voffB); PG8_STAGE(PG8_SA(1, 0), cA + kstep, voffA); PG8_STAGE(PG8_SB(1, 1), cB + hstep + kstep, voffB);
    PG8_WAIT_V(6); PG8_BAR;
    for (;;) {
        const bool has_next = S.next(ui + 1, nxt);
        const char* nA = has_next ? (const char*)g.A + (size_t)nxt.pm * tstep + (size_t)nxt.k0 * 2 : cA; const char* nB = has_next ? (const char*)g.Bt + (size_t)nxt.pn * tstep + (size_t)nxt.k0 * 2 : cB;
        const int nt = cur.nt;
        for (int t = 0; t < nt; t += 2) {
            const bool last = (t == nt - 2);
            const char* a1 = cA + (size_t)(t + 1) * kstep;
            const char* a2 = last ? nA : cA + (size_t)(t + 2) * kstep; const char* b2 = last ? nB : cB + (size_t)(t + 2) * kstep;
            const char* a3 = a2 + kstep; const char* b3 = b2 + kstep;
            PG8_LDB(B0, 0, 0); PG8_SCHED; PG8_LDA(At, 0, 0); PG8_STAGE(PG8_SA(1, 1), a1 + hstep, voffA);
            PG8_WAIT_L(8); PG8_BAR; PG8_WAIT_L(0); PG8_MMA(0, 0, At, B0); PG8_BAR; PG8_SCHED;
            PG8_LDB(B1, 0, 1); PG8_STAGE(PG8_SB(0, 0), b2, voffB);
            PG8_BAR; PG8_WAIT_L(0); PG8_MMA(0, 1, At, B1); PG8_BAR;
            PG8_LDA(At, 0, 1); PG8_STAGE(PG8_SA(0, 0), a2, voffA);
            PG8_BAR; PG8_WAIT_L(0); PG8_MMA(1, 0, At, B0); PG8_BAR; PG8_SCHED;
            PG8_STAGE(PG8_SB(0, 1), b2 + hstep, voffB);
            PG8_WAIT_V(6); PG8_BAR; PG8_MMA(1, 1, At, B1); PG8_BAR;
            PG8_LDB(B0, 1, 0); PG8_SCHED; PG8_LDA(At, 1, 0); PG8_STAGE(PG8_SA(0, 1), a2 + hstep, voffA);
            PG8_WAIT_L(8); PG8_BAR; PG8_WAIT_L(0); PG8_MMA(0, 0, At, B0); PG8_BAR; PG8_SCHED;
            PG8_LDB(B1, 1, 1); PG8_STAGE(PG8_SB(1, 0), b3, voffB);
            PG8_BAR; PG8_WAIT_L(0); PG8_MMA(0, 1, At, B1); PG8_BAR;
            PG8_LDA(At, 1, 1); PG8_STAGE(PG8_SA(1, 0), a3, voffA);
            PG8_BAR; PG8_WAIT_L(0); PG8_MMA(1, 0, At, B0); PG8_BAR; PG8_SCHED;
            PG8_STAGE(PG8_SB(1, 1), b3 + hstep, voffB);
            PG8_WAIT_V(6); PG8_BAR; PG8_MMA(1, 1, At, B1); PG8_BAR;
        }
        E(acc, cur, wr, wc, fr, fq);
        if (!has_next) break;
#pragma unroll
        for (int a = 0; a < 2; ++a)
#pragma unroll
            for (int b = 0; b < 2; ++b)
#pragma unroll
                for (int m = 0; m < 4; ++m)
#pragma unroll
                    for (int n = 0; n < 2; ++n) acc[a][b][m][n] = (f32x4){0.f, 0.f, 0.f, 0.f};
        cur = nxt; cA = nA; cB = nB; ++ui;
    }
    PG8_WAIT_V(0);
    if (wr == 0) PG8_BAR;
    PG8_BAR;
#undef PG8_SA
#undef PG8_SB
#undef PG8_STAGE
#undef PG8_LDA
#undef PG8_LDB
#undef PG8_MMA
#undef PG8_WAIT_V
#undef PG8_WAIT_L
#undef PG8_BAR
#undef PG8_SCHED
}
}

DEV int win_srccol(int n) { return n < 4096 ? n : (n < 6656 ? n + 8 : (n < 6664 ? n - 2560 : (n < 6680 ? n : -1))); }
DEV void transpose_tile(const float* __restrict__ src, int srcN, bf16_t* __restrict__ dst, int K, int n0, int k0, int mode, float* tile) {
    int tid_ = threadIdx.x; asm volatile("" : "+v"(tid_)); const int tid = tid_;
    f32x4 v[4];
#pragma unroll
    for (int i = 0; i < 4; ++i) {
        const int kk = (tid >> 5) + 16 * i, nn4 = (tid & 31) * 4, n = n0 + nn4;
        const int sc = mode ? win_srccol(n) : n;
        v[i] = (f32x4){0.f, 0.f, 0.f, 0.f};
        if (sc >= 0) v[i] = __builtin_nontemporal_load((const f32x4*)(src + (size_t)(k0 + kk) * srcN + sc));
        if (mode && n >= 1024 && n < 2048) v[i] = v[i] * 0.0625f;
    }
#pragma unroll
    for (int i = 0; i < 4; ++i) {
        const int kk = (tid >> 5) + 16 * i, nn4 = (tid & 31) * 4;
        tile[kk * 129 + nn4 + 0] = v[i][0]; tile[kk * 129 + nn4 + 1] = v[i][1]; tile[kk * 129 + nn4 + 2] = v[i][2]; tile[kk * 129 + nn4 + 3] = v[i][3];
    }
    __syncthreads();
#pragma unroll
    for (int i = 0; i < 2; ++i) {
        const int ch = tid + 512 * i, nn = ch >> 3, kk8 = (ch & 7) * 8;
        u32x4 w;
        w.x = pk2(tile[(kk8 + 0) * 129 + nn], tile[(kk8 + 1) * 129 + nn]); w.y = pk2(tile[(kk8 + 2) * 129 + nn], tile[(kk8 + 3) * 129 + nn]);
        w.z = pk2(tile[(kk8 + 4) * 129 + nn], tile[(kk8 + 5) * 129 + nn]); w.w = pk2(tile[(kk8 + 6) * 129 + nn], tile[(kk8 + 7) * 129 + nn]);
        *(u32x4*)(dst + (size_t)(n0 + nn) * K + k0 + kk8) = w;
    }
    __syncthreads();
}
DEV void phase_prologue(const P& p, unsigned char* lds) {
    float* tile = (float*)lds;
    constexpr int T_WIN = (INP / 128) * (D / 64), T_WOUT = (D / 128) * (D / 64), T_WUP = (DFF2 / 128) * (D / 64), T_WDN = (D / 128) * (DFF / 64);
    constexpr int T_L = T_WIN + T_WOUT + T_WUP + T_WDN, T_X = NTOK * D / 4096;
    const int total = 2 * T_L + T_X;
    for (int u = blockIdx.x; u < total; u += gridDim.x) {
        if (u < 2 * T_L) {
            const int l = u / T_L; int r = u % T_L;
            if (r < T_WIN) { const int nt = r / (D / 64), kt = r % (D / 64);
                transpose_tile(p.w_in + (size_t)l * D * IN_DIM, IN_DIM, (bf16_t*)(p.ws + WS_WIN) + (size_t)l * INP * D, D, nt * 128, kt * 64, 1, tile); }
            else if ((r -= T_WIN) < T_WOUT) { const int nt = r / (D / 64), kt = r % (D / 64);
                transpose_tile(p.w_out + (size_t)l * D * D, D, (bf16_t*)(p.ws + WS_WOUT) + (size_t)l * D * D, D, nt * 128, kt * 64, 0, tile); }
            else if ((r -= T_WOUT) < T_WUP) { const int nt = r / (D / 64), kt = r % (D / 64);
                transpose_tile(p.w_up + (size_t)l * D * DFF2, DFF2, (bf16_t*)(p.ws + WS_WUP) + (size_t)l * DFF2 * D, D, nt * 128, kt * 64, 0, tile); }
            else { r -= T_WUP; const int nt = r / (DFF / 64), kt = r % (DFF / 64);
                transpose_tile(p.w_down + (size_t)l * DFF * D, D, (bf16_t*)(p.ws + WS_WDN) + (size_t)l * D * DFF, DFF, nt * 128, kt * 64, 0, tile); }
        } else {
            const size_t e = (size_t)(u - 2 * T_L) * 4096 + threadIdx.x * 8;
            const float* s = e < (size_t)NPR * D ? p.x_prompt + e : p.x_sample + (e - (size_t)NPR * D);
            const f32x4 a = *(const f32x4*)s, b = *(const f32x4*)(s + 4);
            u32x4 w; w.x = pk2(a[0], a[1]); w.y = pk2(a[2], a[3]); w.z = pk2(b[0], b[1]); w.w = pk2(b[2], b[3]);
            *(u32x4*)((bf16_t*)(p.ws + WS_XB) + e) = w;
        }
    }
}

DEV void mlstm_local(const P& p, int l, int unit, unsigned char* lds) {
    const int bh = unit >> 5, c = unit & 31, b = bh >> 2, h = bh & 3;
    int tid_ = threadIdx.x; asm volatile("" : "+v"(tid_)); const int tid = tid_, lane = tid & 63, w = tid >> 6, fr = lane & 15, fq = lane >> 4;
    const bf16_t* U = (const bf16_t*)(p.ws + WS_U) + (size_t)(b * 2048 + c * 64) * INP;
    float* wsh = (float*)lds;
    bf16_t* KW = (bf16_t*)(lds + 1024);
    bf16_t* V = KW + 64 * 272;
    float* gstat = (float*)(p.ws + WS_GSTAT);
    if (w == 0) {
        const float ig = bf2f(U[(size_t)lane * INP + UIG + h]) + p.b_i[l * 4 + h];
        const float lf = logsigf_(bf2f(U[(size_t)lane * INP + UFG + h]) + p.b_f[l * 4 + h]);
        const float bs = wave_incl_sum(lf, lane);
        const float a = ig - bs;
        const float amax = wave_max(a);
        const float bsum = __shfl(bs, 63);
        wsh[lane] = expf(a - amax);
        if (lane == 0) { gstat[(bh * 32 + c) * 2] = bsum; gstat[(bh * 32 + c) * 2 + 1] = bsum + amax; }
    }
    __syncthreads();
#pragma unroll
    for (int i = 0; i < 4; ++i) {
        const int it = tid + 512 * i, s_ = it >> 5, d8 = (it & 31) * 8;
        const uint4 kv = *(const uint4*)(U + (size_t)s_ * INP + UK + h * 256 + d8);
        const uint4 vv = *(const uint4*)(U + (size_t)s_ * INP + UV + h * 256 + d8);
        const float ws_ = wsh[s_];
        float kf[8]; unpack8(kv, kf);
        u32x4 kw; kw.x = pk2(kf[0] * ws_, kf[1] * ws_); kw.y = pk2(kf[2] * ws_, kf[3] * ws_); kw.z = pk2(kf[4] * ws_, kf[5] * ws_); kw.w = pk2(kf[6] * ws_, kf[7] * ws_);
        *(u32x4*)(KW + s_ * 272 + d8) = kw;
        *(uint4*)(V + s_ * 272 + d8) = vv;
    }
    __syncthreads();
    if (tid < 256) { float a = 0.f; for (int s_ = 0; s_ < 64; ++s_) a += bf2f(KW[s_ * 272 + tid]); ((float*)(p.ws + WS_NLOC))[(size_t)(bh * 32 + c) * 256 + tid] = a; }
    f32x4 acc[2][16];
#pragma unroll
    for (int m = 0; m < 2; ++m)
#pragma unroll
        for (int n = 0; n < 16; ++n) acc[m][n] = (f32x4){0.f, 0.f, 0.f, 0.f};
#pragma unroll
    for (int ks = 0; ks < 2; ++ks) {
        bf16x8 vf[2];
#pragma unroll
        for (int m = 0; m < 2; ++m) vf[m] = tr_frag(V, 272, 32 * ks, 32 * w + 16 * m, lane);
#pragma unroll
        for (int n = 0; n < 16; ++n) {
            const bf16x8 kf = tr_frag(KW, 272, 32 * ks, 16 * n, lane);
#pragma unroll
            for (int m = 0; m < 2; ++m) acc[m][n] = mfma16(kf, vf[m], acc[m][n]);
        }
    }
    bf16_t* Dp = (bf16_t*)(p.ws + WS_DBUF) + (size_t)(bh * 32 + c) * 65536;
#pragma unroll
    for (int m = 0; m < 2; ++m)
#pragma unroll
        for (int n = 0; n < 16; ++n) { u32x2 wv; wv.x = pk2(acc[m][n][0], acc[m][n][1]); wv.y = pk2(acc[m][n][2], acc[m][n][3]);
            *(u32x2*)(Dp + (32 * w + 16 * m + fr) * 256 + 16 * n + fq * 4) = wv; }
    __syncthreads();
}

DEV void mlstm_scan(const P& p, int l, int unit, unsigned char* lds) {
    int tid_ = threadIdx.x; asm volatile("" : "+v"(tid_)); const int bh = unit >> 4, slab = unit & 15, tid = tid_;
    float* fA = (float*)lds; float* fB = fA + 32;
    const float* gstat = (const float*)(p.ws + WS_GSTAT);
    if (tid == 0) {
        float m = 0.f;
        for (int c = 0; c < 32; ++c) {
            const float bsum = gstat[(bh * 32 + c) * 2], mloc = gstat[(bh * 32 + c) * 2 + 1];
            const float mn = fmaxf(bsum + m, mloc);
            fA[c] = expf(bsum + m - mn); fB[c] = expf(mloc - mn); m = mn;
            if (slab == 0) ((float*)(p.ws + WS_MST))[bh * 32 + c] = mn;
        }
        if (slab == 0) p.out[O_PM + l * 16 + bh] = m;
    }
    __syncthreads();
    const size_t e0 = (size_t)slab * 4096 + tid * 8;
    float run[8];
#pragma unroll
    for (int i = 0; i < 8; ++i) run[i] = 0.f;
    const bf16_t* Dp = (const bf16_t*)(p.ws + WS_DBUF) + (size_t)bh * 32 * 65536 + e0;
    bf16_t* Cp = (bf16_t*)(p.ws + WS_CT) + (size_t)bh * 32 * 65536 + e0;
#pragma unroll 1
    for (int cb = 0; cb < 32; cb += 8) {
        uint4 xx[8];
#pragma unroll
        for (int j = 0; j < 8; ++j) xx[j] = *(const uint4*)(Dp + (size_t)(cb + j) * 65536);
#pragma unroll
        for (int j = 0; j < 8; ++j) {
            const int c = cb + j;
            const float a = fA[c], bq = fB[c];
            float xf[8]; unpack8(xx[j], xf);
#pragma unroll
            for (int i = 0; i < 8; ++i) run[i] = a * run[i] + bq * xf[i];
            u32x4 wv; wv.x = pk2(run[0], run[1]); wv.y = pk2(run[2], run[3]); wv.z = pk2(run[4], run[5]); wv.w = pk2(run[6], run[7]);
            *(u32x4*)(Cp + (size_t)c * 65536) = wv;
        }
    }
    {
        float* o = p.out + O_PC + (size_t)(l * 16 + bh) * 65536;
        const int e = (int)(e0 >> 8), d0 = (int)(e0 & 255);
#pragma unroll
        for (int i = 0; i < 8; ++i) o[(d0 + i) * 256 + e] = run[i];
    }
    if (slab == 0 && tid < 256) {
        float r = 0.f;
        const float* nl = (const float*)(p.ws + WS_NLOC) + (size_t)bh * 32 * 256 + tid;
        float* ns = (float*)(p.ws + WS_NST) + (size_t)bh * 32 * 256 + tid;
        for (int c = 0; c < 32; ++c) { r = fA[c] * r + fB[c] * nl[c * 256]; ns[c * 256] = r; }
        p.out[O_PN + (size_t)(l * 16 + bh) * 256 + tid] = r;
    }
    __syncthreads();
}

DEV void ssd_scan(const P& p, int l, int unit, unsigned char* lds) {
    int tid_ = threadIdx.x; asm volatile("" : "+v"(tid_)); const int bhd = unit >> 2, slab = unit & 3, tid = tid_;
    float* dec = (float*)lds;
    if (tid < 32) dec[tid] = expf(((const float*)(p.ws + WS_SBSUM))[bhd * 32 + tid]);
    __syncthreads();
    const size_t e0 = (size_t)slab * 2048 + tid * 4;
    f32x4 run = (f32x4){0.f, 0.f, 0.f, 0.f};
    const float* Sp = (const float*)(p.ws + WS_SBUF) + (size_t)bhd * 32 * 8192 + e0;
    bf16_t* Tp = (bf16_t*)(p.ws + WS_ST) + (size_t)bhd * 32 * 8192 + e0;
#pragma unroll 1
    for (int cb = 0; cb < 32; cb += 8) {
        f32x4 xx[8];
#pragma unroll
        for (int j = 0; j < 8; ++j) xx[j] = __builtin_nontemporal_load((const f32x4*)(Sp + (size_t)(cb + j) * 8192));
#pragma unroll
        for (int j = 0; j < 8; ++j) {
            run = run * dec[cb + j] + xx[j];
            u32x2 wv; wv.x = pk2(run[0], run[1]); wv.y = pk2(run[2], run[3]);
            *(u32x2*)(Tp + (size_t)(cb + j) * 8192) = wv;
        }
    }
    *(f32x4*)(p.out + O_PS + (size_t)(l * 64 + bhd) * 8192 + e0) = run;
    __syncthreads();
}

DEV void convstate_copy(const P& p, int l, int unit) {
    const bf16_t* Ub = (const bf16_t*)(p.ws + WS_U);
    int tid_ = threadIdx.x; asm volatile("" : "+v"(tid_));
    for (int i = tid_; i < 3 * 1536; i += NTHR) {
        const int j = i / 1536, ch = i % 1536;
        if (unit < 4) p.out[O_PSC + ((size_t)(l * 4 + unit) * 3 + j) * 1536 + ch] = bf2f(Ub[(size_t)(unit * 2048 + 2045 + j) * INP + UXS + ch]);
        else { const int b = unit - 4; p.out[O_SSC + ((size_t)(l * 128 + b) * 3 + j) * 1536 + ch] = bf2f(Ub[(size_t)(NPR + b * 8 + 5 + j) * INP + UXS + ch]); }
    }
}

DEV void mlstm_out(const P& p, int l, int unit, unsigned char* lds) {
    const int bh = unit >> 5, c = unit & 31, b = bh >> 2, h = bh & 3;
    int tid_ = threadIdx.x; asm volatile("" : "+v"(tid_)); const int tid = tid_, lane = tid & 63, w = tid >> 6, fr = lane & 15, fq = lane >> 4;
    const int r0 = b * 2048 + c * 64;
    const bf16_t* U = (const bf16_t*)(p.ws + WS_U) + (size_t)r0 * INP;
    bf16_t* Qs = (bf16_t*)lds;
    bf16_t* Ks = Qs + 64 * 264;
    bf16_t* V = Ks + 64 * 264;
    bf16_t* Ss = V + 64 * 272;
    float* fl = (float*)(lds + 113664);
    float* bsh = fl; float* ash = fl + 64; float* mth = fl + 128; float* wint = fl + 192; float* rdn = fl + 256; float* qn = fl + 320; float* nprev = fl + 384; float* red = fl + 640;
    float* stat = fl + 1152;
    if (w == 0) {
        const float ig = bf2f(U[(size_t)lane * INP + UIG + h]) + p.b_i[l * 4 + h];
        const float lf = logsigf_(bf2f(U[(size_t)lane * INP + UFG + h]) + p.b_f[l * 4 + h]);
        const float bs = wave_incl_sum(lf, lane);
        const float a = ig - bs;
        const float cm = wave_incl_max(a, lane);
        const float mprev = c > 0 ? ((const float*)(p.ws + WS_MST))[bh * 32 + c - 1] : 0.f;
        const float mt = bs + fmaxf(mprev, cm);
        bsh[lane] = bs; ash[lane] = a; mth[lane] = mt; wint[lane] = expf(bs + mprev - mt);
    }
    if (tid >= 256) { const int d = tid - 256; nprev[d] = c > 0 ? ((const float*)(p.ws + WS_NST))[(size_t)(bh * 32 + c - 1) * 256 + d] : 0.f; }
#pragma unroll
    for (int i = 0; i < 4; ++i) {
        const int it = tid + 512 * i, s_ = it >> 5, d8 = (it & 31) * 8;
        *(uint4*)(Qs + s_ * 264 + d8) = *(const uint4*)(U + (size_t)s_ * INP + UQ + h * 256 + d8);
        *(uint4*)(Ks + s_ * 264 + d8) = *(const uint4*)(U + (size_t)s_ * INP + UK + h * 256 + d8);
        *(uint4*)(V + s_ * 272 + d8) = *(const uint4*)(U + (size_t)s_ * INP + UV + h * 256 + d8);
    }
    __syncthreads();
    {
        const int mt_ = w >> 1, nt0 = (w & 1) * 2;
        f32x4 sacc[2] = {(f32x4){0.f, 0.f, 0.f, 0.f}, (f32x4){0.f, 0.f, 0.f, 0.f}};
#pragma unroll
        for (int k0 = 0; k0 < 256; k0 += 32) {
            const bf16x8 a = *(const bf16x8*)(Qs + (16 * mt_ + fr) * 264 + k0 + fq * 8);
#pragma unroll
            for (int n = 0; n < 2; ++n) { const bf16x8 bb = *(const bf16x8*)(Ks + (16 * (nt0 + n) + fr) * 264 + k0 + fq * 8); sacc[n] = mfma16(a, bb, sacc[n]); }
        }
#pragma unroll
        for (int n = 0; n < 2; ++n)
#pragma unroll
            for (int j = 0; j < 4; ++j) {
                const int t = 16 * mt_ + fq * 4 + j, s_ = 16 * (nt0 + n) + fr;
                const float val = (s_ <= t) ? sacc[n][j] * expf(bsh[t] - mth[t] + ash[s_]) : 0.f;
                Ss[t * 72 + s_] = f2bf(val);
            }
        const int t = tid >> 3, part = tid & 7;
        float a = 0.f;
        for (int d = part * 32; d < part * 32 + 32; ++d) a += bf2f(Qs[t * 264 + d]) * nprev[d];
        a += __shfl_xor(a, 1); a += __shfl_xor(a, 2); a += __shfl_xor(a, 4);
        if (part == 0) qn[t] = a;
    }
    __syncthreads();
    if (tid < 64) {
        float di = 0.f;
        for (int s_ = 0; s_ < 64; ++s_) di += bf2f(Ss[tid * 72 + s_]);
        const float den = di + wint[tid] * qn[tid];
        rdn[tid] = 1.0f / fmaxf(fabsf(den), expf(-mth[tid]));
    }
    const int e0 = 32 * w;
    f32x4 acc1[4][2], acc2[4][2];
#pragma unroll
    for (int m = 0; m < 4; ++m)
#pragma unroll
        for (int n = 0; n < 2; ++n) { acc1[m][n] = (f32x4){0.f, 0.f, 0.f, 0.f}; acc2[m][n] = (f32x4){0.f, 0.f, 0.f, 0.f}; }
#pragma unroll
    for (int ks = 0; ks < 2; ++ks) {
        bf16x8 sf[4];
#pragma unroll
        for (int m = 0; m < 4; ++m) sf[m] = *(const bf16x8*)(Ss + (16 * m + fr) * 72 + 32 * ks + fq * 8);
#pragma unroll
        for (int n = 0; n < 2; ++n) { const bf16x8 vf = tr_frag(V, 272, 32 * ks, e0 + 16 * n, lane);
#pragma unroll
            for (int m = 0; m < 4; ++m) acc1[m][n] = mfma16(vf, sf[m], acc1[m][n]); }
    }
    if (c > 0) {
        const bf16_t* CTp = (const bf16_t*)(p.ws + WS_CT) + (size_t)(bh * 32 + c - 1) * 65536;
#pragma unroll 2
        for (int k0 = 0; k0 < 256; k0 += 32) {
            bf16x8 a[4];
#pragma unroll
            for (int m = 0; m < 4; ++m) a[m] = *(const bf16x8*)(Qs + (16 * m + fr) * 264 + k0 + fq * 8);
#pragma unroll
            for (int n = 0; n < 2; ++n) { const bf16x8 cf = *(const bf16x8*)(CTp + (size_t)(e0 + 16 * n + fr) * 256 + k0 + fq * 8);
#pragma unroll
                for (int m = 0; m < 4; ++m) acc2[m][n] = mfma16(cf, a[m], acc2[m][n]); }
        }
    }
    __syncthreads();
#pragma unroll
    for (int m = 0; m < 4; ++m) {
        const int t = 16 * m + fr;
        const float wi = wint[t], rd = rdn[t];
        float sm = 0.f;
#pragma unroll
        for (int n = 0; n < 2; ++n)
#pragma unroll
            for (int j = 0; j < 4; ++j) { const float hv = (acc1[m][n][j] + wi * acc2[m][n][j]) * rd; acc1[m][n][j] = hv; sm += hv; }
        sm += __shfl_xor(sm, 16); sm += __shfl_xor(sm, 32);
        if (fq == 0) red[t * 8 + w] = sm;
    }
    __syncthreads();
    if (tid < 64) { float sm = 0.f;
#pragma unroll
        for (int i = 0; i < 8; ++i) sm += red[tid * 8 + i];
        stat[tid] = sm * (1.0f / 256.0f); }
    __syncthreads();
#pragma unroll
    for (int m = 0; m < 4; ++m) {
        const int t = 16 * m + fr;
        const float mu = stat[t];
        float sm = 0.f;
#pragma unroll
        for (int n = 0; n < 2; ++n)
#pragma unroll
            for (int j = 0; j < 4; ++j) { const float dv = acc1[m][n][j] - mu; acc1[m][n][j] = dv; sm += dv * dv; }
        sm += __shfl_xor(sm, 16); sm += __shfl_xor(sm, 32);
        if (fq == 0) red[t * 8 + w] = sm;
    }
    __syncthreads();
    if (tid < 64) { float sm = 0.f;
#pragma unroll
        for (int i = 0; i < 8; ++i) sm += red[tid * 8 + i];
        stat[64 + tid] = rsqrtf(sm * (1.0f / 256.0f) + 1e-6f); }
    __syncthreads();
    bf16_t* MX = (bf16_t*)(p.ws + WS_MIXIN);
#pragma unroll
    for (int m = 0; m < 4; ++m) {
        const int t = 16 * m + fr;
        const float rs = stat[64 + t];
#pragma unroll
        for (int n = 0; n < 2; ++n) {
            const int e4 = e0 + 16 * n + fq * 4;
            const uint2 ov = *(const uint2*)(U + (size_t)t * INP + UO + h * 256 + e4);
            const f32x4 nw = *(const f32x4*)(p.m_norm_w + l * 1024 + h * 256 + e4);
            u32x2 wv;
            wv.x = pk2(acc1[m][n][0] * rs * nw[0] * sigmoidf_(bflo(ov.x)), acc1[m][n][1] * rs * nw[1] * sigmoidf_(bfhi(ov.x)));
            wv.y = pk2(acc1[m][n][2] * rs * nw[2] * sigmoidf_(bflo(ov.y)), acc1[m][n][3] * rs * nw[3] * sigmoidf_(bfhi(ov.y)));
            *(u32x2*)(MX + (size_t)(r0 + t) * D + h * 256 + e4) = wv;
        }
    }
    __syncthreads();
}

DEV void ssd_conv8(const bf16_t* Urow, int tpos, const float* cw, const float* cb, int ch8, float (&o)[8]) {
    const f32x4 b0 = *(const f32x4*)(cb + ch8), b1 = *(const f32x4*)(cb + ch8 + 4);
    o[0] = b0[0]; o[1] = b0[1]; o[2] = b0[2]; o[3] = b0[3]; o[4] = b1[0]; o[5] = b1[1]; o[6] = b1[2]; o[7] = b1[3];
#pragma unroll
    for (int j = 0; j < 4; ++j) {
        const int back = 3 - j;
        if (tpos - back >= 0) {
            const uint4 x = *(const uint4*)(Urow - (size_t)back * INP + UXS + ch8);
            float xf[8]; unpack8(x, xf);
            const f32x4 w0 = *(const f32x4*)(cw + j * 1536 + ch8), w1 = *(const f32x4*)(cw + j * 1536 + ch8 + 4);
            o[0] += w0[0] * xf[0]; o[1] += w0[1] * xf[1]; o[2] += w0[2] * xf[2]; o[3] += w0[3] * xf[3];
            o[4] += w1[0] * xf[4]; o[5] += w1[1] * xf[5]; o[6] += w1[2] * xf[6]; o[7] += w1[3] * xf[7];
        }
    }
#pragma unroll
    for (int i = 0; i < 8; ++i) o[i] = siluf_(o[i]);
}

DEV void ssd_local(const P& p, int l, int unit, unsigned char* lds) {
    const int b = unit >> 6, g = (unit >> 5) & 1, c = unit & 31;
    int tid_ = threadIdx.x; asm volatile("" : "+v"(tid_)); const int tid = tid_, lane = tid & 63, w = tid >> 6, fr = lane & 15, fq = lane >> 4;
    const int r0 = b * 2048 + c * 64;
    const bf16_t* U = (const bf16_t*)(p.ws + WS_U) + (size_t)r0 * INP;
    bf16_t* XW = (bf16_t*)lds;
    bf16_t* Bmn = XW + 64 * 528;
    float* wsh = (float*)(lds + 86016);
    {
        const int head = g * 8 + w;
        const float dt = softplusf_(bf2f(U[(size_t)lane * INP + UDT + head]) + p.dt_bias[l * 16 + head]);
        const float a = -expf(p.A_log[l * 16 + head]) * dt;
        const float bs = wave_incl_sum(a, lane);
        const float bL = __shfl(bs, 63);
        wsh[w * 64 + lane] = expf(bL - bs) * dt;
        if (lane == 0) ((float*)(p.ws + WS_SBSUM))[(b * 16 + head) * 32 + c] = bL;
    }
    __syncthreads();
    const float* cw = p.s_conv_w + (size_t)l * 4 * 1536; const float* cb = p.s_conv_b + (size_t)l * 1536;
    bf16_t* XBC = (bf16_t*)(p.ws + WS_XBC) + (size_t)r0 * 1536;
    for (int i = 0; i < 12; ++i) {
        const int it = tid + 512 * i, t = it / 96, gidx = it % 96;
        const int ch8 = gidx < 64 ? g * 512 + gidx * 8 : (gidx < 80 ? 1024 + g * 128 + (gidx - 64) * 8 : 1280 + g * 128 + (gidx - 80) * 8);
        float v[8];
        ssd_conv8(U + (size_t)t * INP, c * 64 + t, cw, cb, ch8, v);
        { u32x4 wr_; wr_.x = pk2(v[0], v[1]); wr_.y = pk2(v[2], v[3]); wr_.z = pk2(v[4], v[5]); wr_.w = pk2(v[6], v[7]); *(u32x4*)(XBC + (size_t)t * 1536 + ch8) = wr_; }
        if (gidx >= 80) continue;
        if (gidx < 64) { const float sc = wsh[(gidx >> 3) * 64 + t];
            u32x4 wv; wv.x = pk2(v[0] * sc, v[1] * sc); wv.y = pk2(v[2] * sc, v[3] * sc); wv.z = pk2(v[4] * sc, v[5] * sc); wv.w = pk2(v[6] * sc, v[7] * sc);
            *(u32x4*)(XW + t * 528 + gidx * 8) = wv; }
        else { u32x4 wv; wv.x = pk2(v[0], v[1]); wv.y = pk2(v[2], v[3]); wv.z = pk2(v[4], v[5]); wv.w = pk2(v[6], v[7]);
            *(u32x4*)(Bmn + t * 144 + (gidx - 64) * 8) = wv; }
    }
    __syncthreads();
    f32x4 acc[4][8];
#pragma unroll
    for (int m = 0; m < 4; ++m)
#pragma unroll
        for (int n = 0; n < 8; ++n) acc[m][n] = (f32x4){0.f, 0.f, 0.f, 0.f};
#pragma unroll
    for (int ks = 0; ks < 2; ++ks) {
        bf16x8 xf[4];
#pragma unroll
        for (int m = 0; m < 4; ++m) xf[m] = tr_frag(XW, 528, 32 * ks, 64 * w + 16 * m, lane);
#pragma unroll
        for (int n = 0; n < 8; ++n) { const bf16x8 bf_ = tr_frag(Bmn, 144, 32 * ks, 16 * n, lane);
#pragma unroll
            for (int m = 0; m < 4; ++m) acc[m][n] = mfma16(bf_, xf[m], acc[m][n]); }
    }
    float* Sp = (float*)(p.ws + WS_SBUF) + (size_t)((b * 16 + g * 8 + w) * 32 + c) * 8192;
#pragma unroll
    for (int m = 0; m < 4; ++m)
#pragma unroll
        for (int n = 0; n < 8; ++n) *(f32x4*)(Sp + (16 * m + fr) * 128 + 16 * n + fq * 4) = acc[m][n];
    __syncthreads();
}

DEV void ssd_out(const P& p, int l, int unit, unsigned char* lds) {
    const int b = unit >> 6, g = (unit >> 5) & 1, c = unit & 31;
    int tid_ = threadIdx.x; asm volatile("" : "+v"(tid_)); const int tid = tid_, lane = tid & 63, w = tid >> 6, fr = lane & 15, fq = lane >> 4;
    const int r0 = b * 2048 + c * 64;
    const bf16_t* U = (const bf16_t*)(p.ws + WS_U) + (size_t)r0 * INP;
    bf16_t* Xs = (bf16_t*)lds;
    bf16_t* Bm = Xs + 64 * 528;
    bf16_t* Cm = Bm + 64 * 136;
    float* CB = (float*)(lds + 102400);
    float* bsh = (float*)(lds + 119808);
    float* dtsh = bsh + 512;
    float* red = dtsh + 512;
    float* stat = red + 512;
    const int head = g * 8 + w;
    {
        const float dt = softplusf_(bf2f(U[(size_t)lane * INP + UDT + head]) + p.dt_bias[l * 16 + head]);
        const float a = -expf(p.A_log[l * 16 + head]) * dt;
        const float bs = wave_incl_sum(a, lane);
        bsh[w * 64 + lane] = bs; dtsh[w * 64 + lane] = dt;
    }
    const bf16_t* XBC = (const bf16_t*)(p.ws + WS_XBC) + (size_t)r0 * 1536;
#pragma unroll
    for (int i = 0; i < 12; ++i) {
        const int it = tid + 512 * i, t = it / 96, gidx = it % 96;
        const int ch8 = gidx < 64 ? g * 512 + gidx * 8 : (gidx < 80 ? 1024 + g * 128 + (gidx - 64) * 8 : 1280 + g * 128 + (gidx - 80) * 8);
        const u32x4 wv = *(const u32x4*)(XBC + (size_t)t * 1536 + ch8);
        if (gidx < 64) *(u32x4*)(Xs + t * 528 + gidx * 8) = wv;
        else if (gidx < 80) *(u32x4*)(Bm + t * 136 + (gidx - 64) * 8) = wv;
        else *(u32x4*)(Cm + t * 136 + (gidx - 80) * 8) = wv;
    }
    __syncthreads();
    {
        const int mt_ = w >> 1, nt0 = (w & 1) * 2;
        f32x4 cacc[2] = {(f32x4){0.f, 0.f, 0.f, 0.f}, (f32x4){0.f, 0.f, 0.f, 0.f}};
#pragma unroll
        for (int k0 = 0; k0 < 128; k0 += 32) {
            const bf16x8 a = *(const bf16x8*)(Cm + (16 * mt_ + fr) * 136 + k0 + fq * 8);
#pragma unroll
            for (int n = 0; n < 2; ++n) { const bf16x8 bb = *(const bf16x8*)(Bm + (16 * (nt0 + n) + fr) * 136 + k0 + fq * 8); cacc[n] = mfma16(a, bb, cacc[n]); }
        }
#pragma unroll
        for (int n = 0; n < 2; ++n)
#pragma unroll
            for (int j = 0; j < 4; ++j) CB[(16 * mt_ + fq * 4 + j) * 68 + 16 * (nt0 + n) + fr] = cacc[n][j];
    }
    __syncthreads();
    f32x4 acc1[4][4], acc2[4][4];
#pragma unroll
    for (int m = 0; m < 4; ++m)
#pragma unroll
        for (int n = 0; n < 4; ++n) { acc1[m][n] = (f32x4){0.f, 0.f, 0.f, 0.f}; acc2[m][n] = (f32x4){0.f, 0.f, 0.f, 0.f}; }
#pragma unroll
    for (int ks = 0; ks < 2; ++ks) {
        bf16x8 xf[4];
#pragma unroll
        for (int n = 0; n < 4; ++n) xf[n] = tr_frag(Xs, 528, 32 * ks, 64 * w + 16 * n, lane);
#pragma unroll
        for (int m = 0; m < 4; ++m) {
            if (ks * 32 > 16 * m + 15) continue;
            const int t = 16 * m + fr, s0 = 32 * ks + fq * 8;
            const float bt = bsh[w * 64 + t];
            const f32x4 c0 = *(const f32x4*)(CB + t * 68 + s0), c1 = *(const f32x4*)(CB + t * 68 + s0 + 4);
            float mv[8];
#pragma unroll
            for (int i = 0; i < 8; ++i) { const int s_ = s0 + i; const float cv = i < 4 ? c0[i & 3] : c1[i & 3];
                mv[i] = (s_ <= t) ? cv * expf(bt - bsh[w * 64 + s_]) * dtsh[w * 64 + s_] : 0.f; }
            union { u32x4 u; bf16x8 v; } af;
            af.u.x = pk2(mv[0], mv[1]); af.u.y = pk2(mv[2], mv[3]); af.u.z = pk2(mv[4], mv[5]); af.u.w = pk2(mv[6], mv[7]);
#pragma unroll
            for (int n = 0; n < 4; ++n) acc1[m][n] = mfma16(xf[n], af.v, acc1[m][n]);
        }
    }
    if (c > 0) {
        const bf16_t* STp = (const bf16_t*)(p.ws + WS_ST) + (size_t)((b * 16 + head) * 32 + c - 1) * 8192;
#pragma unroll
        for (int k0 = 0; k0 < 128; k0 += 32) {
            bf16x8 a[4];
#pragma unroll
            for (int m = 0; m < 4; ++m) a[m] = *(const bf16x8*)(Cm + (16 * m + fr) * 136 + k0 + fq * 8);
#pragma unroll
            for (int n = 0; n < 4; ++n) { const bf16x8 sf = *(const bf16x8*)(STp + (16 * n + fr) * 128 + k0 + fq * 8);
#pragma unroll
                for (int m = 0; m < 4; ++m) acc2[m][n] = mfma16(sf, a[m], acc2[m][n]); }
        }
    }
    const float dsk = p.D_skip[l * 16 + head];
#pragma unroll
    for (int m = 0; m < 4; ++m) {
        const int t = 16 * m + fr;
        const float eb = expf(bsh[w * 64 + t]);
        float sm = 0.f;
#pragma unroll
        for (int n = 0; n < 4; ++n) {
            const int pp4 = 16 * n + fq * 4;
            const uint2 xv = *(const uint2*)(Xs + t * 528 + 64 * w + pp4);
            const uint2 zv = *(const uint2*)(U + (size_t)t * INP + UZ + g * 512 + w * 64 + pp4);
            const float xs4[4] = {bflo(xv.x), bfhi(xv.x), bflo(xv.y), bfhi(xv.y)};
            const float z4[4] = {bflo(zv.x), bfhi(zv.x), bflo(zv.y), bfhi(zv.y)};
#pragma unroll
            for (int j = 0; j < 4; ++j) {
                const float y = acc1[m][n][j] + eb * acc2[m][n][j] + dsk * xs4[j];
                const float gt = y * z4[j] * sigmoidf_(z4[j]);
                acc1[m][n][j] = gt; sm += gt * gt;
            }
        }
        sm += __shfl_xor(sm, 16); sm += __shfl_xor(sm, 32);
        if (fq == 0) red[t * 8 + w] = sm;
    }
    __syncthreads();
    if (tid < 64) { float sm = 0.f;
#pragma unroll
        for (int i = 0; i < 8; ++i) sm += red[tid * 8 + i];
        stat[tid] = rsqrtf(sm * (1.0f / 512.0f) + 1e-6f); }
    __syncthreads();
    bf16_t* MX = (bf16_t*)(p.ws + WS_MIXIN);
#pragma unroll
    for (int m = 0; m < 4; ++m) {
        const int t = 16 * m + fr;
        const float rs = stat[t];
#pragma unroll
        for (int n = 0; n < 4; ++n) {
            const int ch = g * 512 + w * 64 + 16 * n + fq * 4;
            const f32x4 nw = *(const f32x4*)(p.s_norm_w + l * 1024 + ch);
            u32x2 wv; wv.x = pk2(acc1[m][n][0] * rs * nw[0], acc1[m][n][1] * rs * nw[1]); wv.y = pk2(acc1[m][n][2] * rs * nw[2], acc1[m][n][3] * rs * nw[3]);
            *(u32x2*)(MX + (size_t)(r0 + t) * D + 1024 + ch) = wv;
        }
    }
    __syncthreads();
}

DEV void smp_mlstm(const P& p, int l, int unit, unsigned char* lds) {
    const int b = unit >> 2, h = unit & 3;
    int tid_ = threadIdx.x; asm volatile("" : "+v"(tid_)); const int tid = tid_, lane = tid & 63, w = tid >> 6;
    const int r0 = NPR + b * 8;
    const bf16_t* U = (const bf16_t*)(p.ws + WS_U) + (size_t)r0 * INP;
    float* qn = (float*)lds; float* kn = qn + 2048; float* vn = kn + 2048; float* qT = vn + 2048; float* kwT = qT + 2048; float* sc = kwT + 2048; float* red = sc + 256;
    const size_t sidx = (size_t)(l * 128 + b) * 4 + h;
    const float* C0 = p.st_C + sidx * 65536; const float* n0 = p.st_n + sidx * 256;
    float* Cout = p.out + O_SC + sidx * 65536;
    if (tid == 0) {
        const float m0 = p.st_m[sidx];
        float bs = 0.f, cm = -INFINITY, mt = 0.f;
        for (int t = 0; t < 8; ++t) {
            const float ig = bf2f(U[(size_t)t * INP + UIG + h]) + p.b_i[l * 4 + h];
            const float lf = logsigf_(bf2f(U[(size_t)t * INP + UFG + h]) + p.b_f[l * 4 + h]);
            bs += lf; const float a = ig - bs; cm = fmaxf(cm, a); mt = bs + fmaxf(m0, cm);
            sc[32 + t] = mt; sc[t] = expf(bs + m0 - mt); sc[40 + t] = a; sc[48 + t] = bs;
        }
        for (int s = 0; s < 8; ++s) sc[16 + s] = expf(bs + sc[40 + s] - mt);
        sc[24] = expf(bs + m0 - mt);
        p.out[O_SM + sidx] = mt;
    }
    __syncthreads();
#pragma unroll
    for (int i = 0; i < 4; ++i) {
        const int idx = tid + 512 * i, t = idx >> 8, d = idx & 255;
        const float q = bf2f(U[(size_t)t * INP + UQ + h * 256 + d]), k = bf2f(U[(size_t)t * INP + UK + h * 256 + d]), v = bf2f(U[(size_t)t * INP + UV + h * 256 + d]);
        qn[t * 256 + d] = q; kn[t * 256 + d] = k; vn[t * 256 + d] = v; qT[d * 8 + t] = q; kwT[d * 8 + t] = k * sc[16 + t];
    }
    __syncthreads();
    {
        const int t = w;
        const f32x4 qv = *(const f32x4*)(qn + t * 256 + lane * 4);
        float dot[9];
#pragma unroll
        for (int s = 0; s < 8; ++s) { const f32x4 kv = *(const f32x4*)(kn + s * 256 + lane * 4); dot[s] = qv[0] * kv[0] + qv[1] * kv[1] + qv[2] * kv[2] + qv[3] * kv[3]; }
        { const f32x4 nv = *(const f32x4*)(n0 + lane * 4); dot[8] = qv[0] * nv[0] + qv[1] * nv[1] + qv[2] * nv[2] + qv[3] * nv[3]; }
#pragma unroll
        for (int s = 0; s < 9; ++s) dot[s] = wave_sum(dot[s]);
        float den = 0.f;
#pragma unroll
        for (int s = 0; s < 8; ++s) { const float sv = (s <= t) ? dot[s] * expf(sc[48 + t] - sc[32 + t] + sc[40 + s]) : 0.f; den += sv; if (lane == 0) sc[64 + t * 8 + s] = sv; }
        den += sc[t] * dot[8];
        if (lane == 0) sc[8 + t] = 1.0f / fmaxf(fabsf(den), expf(-sc[32 + t]));
    }
    if (tid < 256) {
        float a = sc[24] * n0[tid];
#pragma unroll
        for (int s = 0; s < 8; ++s) a += kwT[tid * 8 + s];
        p.out[O_SN + sidx * 256 + tid] = a;
    }
    const int e4 = lane * 4;
    f32x4 num[8], vv[8];
#pragma unroll
    for (int t = 0; t < 8; ++t) { num[t] = (f32x4){0.f, 0.f, 0.f, 0.f}; vv[t] = *(const f32x4*)(vn + t * 256 + e4); }
    const float decay = sc[24];
#pragma unroll 1
    for (int ib = 0; ib < 4; ++ib) {
        f32x4 cc[8];
#pragma unroll
        for (int j = 0; j < 8; ++j) cc[j] = __builtin_nontemporal_load((const f32x4*)(C0 + (size_t)(w + 8 * (ib * 8 + j)) * 256 + e4));
#pragma unroll
        for (int j = 0; j < 8; ++j) {
            const int d = w + 8 * (ib * 8 + j);
            const f32x4 q0 = *(const f32x4*)(qT + d * 8), q1 = *(const f32x4*)(qT + d * 8 + 4), k0 = *(const f32x4*)(kwT + d * 8), k1 = *(const f32x4*)(kwT + d * 8 + 4);
            f32x4 cn = cc[j] * decay;
#pragma unroll
            for (int t = 0; t < 4; ++t) { num[t] += cc[j] * q0[t]; num[4 + t] += cc[j] * q1[t]; cn += vv[t] * k0[t]; cn += vv[4 + t] * k1[t]; }
            __builtin_nontemporal_store(cn, (f32x4*)(Cout + (size_t)d * 256 + e4));
        }
    }
#pragma unroll
    for (int t = 0; t < 8; ++t) *(f32x4*)(red + (w * 8 + t) * 256 + e4) = num[t];
    __syncthreads();
    {
        const int t = w;
        f32x4 hv = (f32x4){0.f, 0.f, 0.f, 0.f};
#pragma unroll
        for (int ww = 0; ww < 8; ++ww) hv += *(const f32x4*)(red + (ww * 8 + t) * 256 + e4);
        hv = hv * sc[t];
#pragma unroll
        for (int s = 0; s < 8; ++s) hv += vv[s] * sc[64 + t * 8 + s];
        hv = hv * sc[8 + t];
        const float mu = wave_sum(hv[0] + hv[1] + hv[2] + hv[3]) * (1.0f / 256.0f);
        const f32x4 dv = hv - mu;
        const float var = wave_sum(dv[0] * dv[0] + dv[1] * dv[1] + dv[2] * dv[2] + dv[3] * dv[3]) * (1.0f / 256.0f);
        const float rs = rsqrtf(var + 1e-6f);
        const uint2 ov = *(const uint2*)(U + (size_t)t * INP + UO + h * 256 + e4);
        const f32x4 nw = *(const f32x4*)(p.m_norm_w + l * 1024 + h * 256 + e4);
        const float o0 = dv[0] * rs * nw[0] * sigmoidf_(bflo(ov.x)), o1 = dv[1] * rs * nw[1] * sigmoidf_(bfhi(ov.x));
        const float o2 = dv[2] * rs * nw[2] * sigmoidf_(bflo(ov.y)), o3 = dv[3] * rs * nw[3] * sigmoidf_(bfhi(ov.y));
        u32x2 wv; wv.x = pk2(o0, o1); wv.y = pk2(o2, o3);
        *(u32x2*)((bf16_t*)(p.ws + WS_MIXIN) + (size_t)(r0 + t) * D + h * 256 + e4) = wv;
    }
    __syncthreads();
}

DEV void smp_ssd(const P& p, int l, int unit, unsigned char* lds) {
    const int b = unit >> 1, g = unit & 1;
    int tid_ = threadIdx.x; asm volatile("" : "+v"(tid_)); const int tid = tid_, lane = tid & 63, w = tid >> 6, fr = lane & 15, fq = lane >> 4;
    const int r0 = NPR + b * 8;
    const bf16_t* U = (const bf16_t*)(p.ws + WS_U) + (size_t)r0 * INP;
    float* xs = (float*)lds;
    float* xwT = xs + 4096;
    float* Bmf = xwT + 4096;
    float* CBs = Bmf + 1024;
    float* bsh = CBs + 64;
    float* dtsh = bsh + 64;
    float* bLs = dtsh + 64;
    float* MW = bLs + 64;
    float* red = MW + 512;
    float* stat = red + 64;
    bf16_t* Cmb = (bf16_t*)(stat + 64);
    if (tid < 64) {
        const int hd = tid >> 3, t = tid & 7, head = g * 8 + hd;
        const float A = -expf(p.A_log[l * 16 + head]), dtb = p.dt_bias[l * 16 + head];
        float bs = 0.f, bL = 0.f, dtt = 0.f;
        for (int s = 0; s < 8; ++s) { const float dt = softplusf_(bf2f(U[(size_t)s * INP + UDT + head]) + dtb); bL += dt * A; if (s <= t) bs += dt * A; if (s == t) dtt = dt; }
        bsh[hd * 8 + t] = bs; dtsh[hd * 8 + t] = dtt; if (t == 0) bLs[hd] = bL;
    }
    for (int i = tid; i < 8 * 136 / 2; i += NTHR) ((unsigned*)(Cmb + 8 * 136))[i] = 0u;
    const float* cw = p.s_conv_w + (size_t)l * 4 * 1536; const float* cb = p.s_conv_b + (size_t)l * 1536;
    const float* cv0 = p.st_sconv + (size_t)(l * 128 + b) * 3 * 1536;
    for (int i = 0; i < 2; ++i) {
        const int it = tid + 512 * i;
        if (it < 768) {
            const int t = it / 96, gidx = it % 96;
            const int ch8 = gidx < 64 ? g * 512 + gidx * 8 : (gidx < 80 ? 1024 + g * 128 + (gidx - 64) * 8 : 1280 + g * 128 + (gidx - 80) * 8);
            float o[8];
            { const f32x4 b0 = *(const f32x4*)(cb + ch8), b1 = *(const f32x4*)(cb + ch8 + 4); o[0] = b0[0]; o[1] = b0[1]; o[2] = b0[2]; o[3] = b0[3]; o[4] = b1[0]; o[5] = b1[1]; o[6] = b1[2]; o[7] = b1[3]; }
#pragma unroll
            for (int j = 0; j < 4; ++j) {
                const int idx = t + j;
                float xf[8];
                if (idx < 3) { const f32x4 a0 = *(const f32x4*)(cv0 + idx * 1536 + ch8), a1 = *(const f32x4*)(cv0 + idx * 1536 + ch8 + 4);
                    xf[0] = a0[0]; xf[1] = a0[1]; xf[2] = a0[2]; xf[3] = a0[3]; xf[4] = a1[0]; xf[5] = a1[1]; xf[6] = a1[2]; xf[7] = a1[3]; }
                else { const uint4 x = *(const uint4*)(U + (size_t)(idx - 3) * INP + UXS + ch8); unpack8(x, xf); }
                const f32x4 w0 = *(const f32x4*)(cw + j * 1536 + ch8), w1 = *(const f32x4*)(cw + j * 1536 + ch8 + 4);
                o[0] += w0[0] * xf[0]; o[1] += w0[1] * xf[1]; o[2] += w0[2] * xf[2]; o[3] += w0[3] * xf[3];
                o[4] += w1[0] * xf[4]; o[5] += w1[1] * xf[5]; o[6] += w1[2] * xf[6]; o[7] += w1[3] * xf[7];
            }
#pragma unroll
            for (int k = 0; k < 8; ++k) o[k] = siluf_(o[k]);
            if (gidx < 64) {
#pragma unroll
                for (int k = 0; k < 8; ++k) xs[t * 512 + gidx * 8 + k] = o[k]; }
            else if (gidx < 80) {
#pragma unroll
                for (int k = 0; k < 8; ++k) Bmf[t * 128 + (gidx - 64) * 8 + k] = o[k]; }
            else { u32x4 wv; wv.x = pk2(o[0], o[1]); wv.y = pk2(o[2], o[3]); wv.z = pk2(o[4], o[5]); wv.w = pk2(o[6], o[7]); *(u32x4*)(Cmb + t * 136 + (gidx - 80) * 8) = wv; }
        }
    }
    __syncthreads();
#pragma unroll
    for (int i = 0; i < 8; ++i) {
        const int idx = tid + 512 * i, hp = idx >> 3, s = idx & 7, hd = hp >> 6;
        xwT[hp * 8 + s] = xs[s * 512 + hp] * expf(bLs[hd] - bsh[hd * 8 + s]) * dtsh[hd * 8 + s];
    }
    if (tid < 64) {
        const int t = tid >> 3, s = tid & 7; float a = 0.f;
        for (int n = 0; n < 128; ++n) a += bf2f(Cmb[t * 136 + n]) * Bmf[s * 128 + n];
        CBs[t * 8 + s] = a;
    }
    __syncthreads();
    { const int hd = tid >> 6, t = (tid >> 3) & 7, s = tid & 7;
      MW[tid] = (s <= t) ? CBs[t * 8 + s] * expf(bsh[hd * 8 + t] - bsh[hd * 8 + s]) * dtsh[hd * 8 + s] : 0.f; }
    __syncthreads();
    const int head = g * 8 + w;
    const size_t sidx = (size_t)(l * 128 + b) * 16 + head;
    const float* S0 = p.st_ssm + sidx * 8192; float* So = p.out + O_SS + sidx * 8192;
    const float dA = expf(bLs[w]);
    f32x4 acc[4];
#pragma unroll
    for (int nt = 0; nt < 4; ++nt) {
        acc[nt] = (f32x4){0.f, 0.f, 0.f, 0.f};
        const int pp = 16 * nt + fr;
        const f32x4 xw0 = *(const f32x4*)(xwT + (64 * w + pp) * 8), xw1 = *(const f32x4*)(xwT + (64 * w + pp) * 8 + 4);
        f32x4 sv[4][2];
#pragma unroll
        for (int ks = 0; ks < 4; ++ks) { sv[ks][0] = __builtin_nontemporal_load((const f32x4*)(S0 + pp * 128 + 32 * ks + fq * 8)); sv[ks][1] = __builtin_nontemporal_load((const f32x4*)(S0 + pp * 128 + 32 * ks + fq * 8 + 4)); }
#pragma unroll
        for (int ks = 0; ks < 4; ++ks) {
            const int n0 = 32 * ks + fq * 8;
            const f32x4 s0 = sv[ks][0], s1 = sv[ks][1];
            union { u32x4 u; bf16x8 v; } bfr;
            bfr.u.x = pk2(s0[0], s0[1]); bfr.u.y = pk2(s0[2], s0[3]); bfr.u.z = pk2(s1[0], s1[1]); bfr.u.w = pk2(s1[2], s1[3]);
            const bf16x8 af = *(const bf16x8*)(Cmb + fr * 136 + n0);
            acc[nt] = mfma16(af, bfr.v, acc[nt]);
            f32x4 o0 = s0 * dA, o1 = s1 * dA;
#pragma unroll
            for (int s = 0; s < 8; ++s) {
                const float xv = s < 4 ? xw0[s & 3] : xw1[s & 3];
                const f32x4 bm0 = *(const f32x4*)(Bmf + s * 128 + n0), bm1 = *(const f32x4*)(Bmf + s * 128 + n0 + 4);
                o0 += bm0 * xv; o1 += bm1 * xv;
            }
            __builtin_nontemporal_store(o0, (f32x4*)(So + pp * 128 + n0)); __builtin_nontemporal_store(o1, (f32x4*)(So + pp * 128 + n0 + 4));
        }
        asm volatile("" ::: "memory");
    }
    const float dsk = p.D_skip[l * 16 + head];
    float gts[4][4];
#pragma unroll
    for (int j = 0; j < 4; ++j) {
        const int t = (fq & 1) * 4 + j;
        const float eb = expf(bsh[w * 8 + t]);
        float ssq = 0.f;
#pragma unroll
        for (int nt = 0; nt < 4; ++nt) {
            const int hp = 64 * w + 16 * nt + fr;
            float y = eb * acc[nt][j] + dsk * xs[t * 512 + hp];
#pragma unroll
            for (int s = 0; s < 8; ++s) y += MW[(w * 8 + t) * 8 + s] * xs[s * 512 + hp];
            const float z = bf2f(U[(size_t)t * INP + UZ + g * 512 + hp]);
            const float gt = y * siluf_(z);
            gts[nt][j] = gt; ssq += gt * gt;
        }
        ssq += __shfl_xor(ssq, 1); ssq += __shfl_xor(ssq, 2); ssq += __shfl_xor(ssq, 4); ssq += __shfl_xor(ssq, 8);
        if (fr == 0 && fq < 2) red[t * 8 + w] = ssq;
    }
    __syncthreads();
    if (tid < 8) { float s = 0.f;
#pragma unroll
        for (int i = 0; i < 8; ++i) s += red[tid * 8 + i];
        stat[tid] = rsqrtf(s * (1.0f / 512.0f) + 1e-6f); }
    __syncthreads();
    if (fq < 2) {
        bf16_t* MX = (bf16_t*)(p.ws + WS_MIXIN);
#pragma unroll
        for (int j = 0; j < 4; ++j) {
            const int t = fq * 4 + j;
#pragma unroll
            for (int nt = 0; nt < 4; ++nt) {
                const int ch = g * 512 + 64 * w + 16 * nt + fr;
                MX[(size_t)(r0 + t) * D + 1024 + ch] = f2bf(gts[nt][j] * stat[t] * p.s_norm_w[l * 1024 + ch]);
            }
        }
    }
    __syncthreads();
}

DEV void phase_ln(const P& p, int l, int which) {
    int tid_ = threadIdx.x; asm volatile("" : "+v"(tid_));
    const int lane = tid_ & 63, w = tid_ >> 6;
    const float* gam = (which ? p.ln2_g : p.ln1_g) + l * D; const float* bet = (which ? p.ln2_b : p.ln1_b) + l * D;
    const bf16_t* mix = (const bf16_t*)(p.ws + WS_MIXF);
    bf16_t* xb = (bf16_t*)(p.ws + WS_XB);
    const bool first = (l == 0 && which == 0), lastp = (l == 1 && which == 1), split = (gridDim.x == 256);
    for (int r = blockIdx.x * 8 + w; r < NTOK; r += gridDim.x * 8) {
        f32x4 y[8]; float s = 0.f;
#pragma unroll
        for (int i = 0; i < 8; ++i) { const int cidx = i * 256 + lane * 4;
            f32x4 xv, mv;
            if (first) xv = *(const f32x4*)((r < NPR ? p.x_prompt + (size_t)r * D : p.x_sample + (size_t)(r - NPR) * D) + cidx);
            else { const uint2 t = *(const uint2*)(xb + (size_t)r * D + cidx); xv = (f32x4){bflo(t.x), bfhi(t.x), bflo(t.y), bfhi(t.y)}; }
            if (split && r >= NPR) { const float* pp = (const float*)(p.ws + WS_PART) + (size_t)(r - NPR) * D + cidx; mv = *(const f32x4*)pp;
#pragma unroll
                for (int k = 1; k < 8; ++k) mv += *(const f32x4*)(pp + (size_t)k * NSM * D); }
            else { const uint2 t = *(const uint2*)(mix + (size_t)r * D + cidx); mv = (f32x4){bflo(t.x), bfhi(t.x), bflo(t.y), bfhi(t.y)}; }
            y[i] = xv * ALPHA + mv; s += (y[i][0] + y[i][1]) + (y[i][2] + y[i][3]); }
        const float mu = wave_sum(s) * (1.0f / D);
        float q = 0.f;
#pragma unroll
        for (int i = 0; i < 8; ++i) { y[i] = y[i] - mu; q += (y[i][0] * y[i][0] + y[i][1] * y[i][1]) + (y[i][2] * y[i][2] + y[i][3] * y[i][3]); }
        const float rs = rsqrtf(wave_sum(q) * (1.0f / D) + 1e-5f);
#pragma unroll
        for (int i = 0; i < 8; ++i) { const int cidx = i * 256 + lane * 4;
            const f32x4 o = y[i] * rs * *(const f32x4*)(gam + cidx) + *(const f32x4*)(bet + cidx);
            if (lastp) *(f32x4*)(p.out + (size_t)r * D + cidx) = o;
            else { u32x2 wv; wv.x = pk2(o[0], o[1]); wv.y = pk2(o[2], o[3]); *(u32x2*)(xb + (size_t)r * D + cidx) = wv; } }
    }
}

DEV void phase_ffn_gate(const P& p, int l) {
    const bf16_t* up = (const bf16_t*)(p.ws + WS_UP); bf16_t* act = (bf16_t*)(p.ws + WS_ACT);
    const float* fw = p.f_conv_w + (size_t)l * 3 * DFF2; const float* fb = p.f_conv_b + (size_t)l * DFF2;
    const int total = (NTOK / 8) * (DFF / 8);
    int tid_ = threadIdx.x; asm volatile("" : "+v"(tid_));
    for (int it = blockIdx.x * NTHR + tid_; it < total; it += gridDim.x * NTHR) {
        const int rb = it / (DFF / 8), j8 = (it % (DFF / 8)) * 8, r0 = rb * 8;
        const bool smp = r0 >= NPR; const int t0 = smp ? 0 : (r0 & 2047); const int sb = (r0 - NPR) >> 3;
        float wg[3][8], wv[3][8], bg[8], bv[8];
#pragma unroll
        for (int k = 0; k < 3; ++k) {
            const f32x4 a0 = *(const f32x4*)(fw + k * DFF2 + j8), a1 = *(const f32x4*)(fw + k * DFF2 + j8 + 4), c0 = *(const f32x4*)(fw + k * DFF2 + DFF + j8), c1 = *(const f32x4*)(fw + k * DFF2 + DFF + j8 + 4);
#pragma unroll
            for (int i = 0; i < 4; ++i) { wg[k][i] = a0[i]; wg[k][4 + i] = a1[i]; wv[k][i] = c0[i]; wv[k][4 + i] = c1[i]; }
        }
        { const f32x4 a0 = *(const f32x4*)(fb + j8), a1 = *(const f32x4*)(fb + j8 + 4), c0 = *(const f32x4*)(fb + DFF + j8), c1 = *(const f32x4*)(fb + DFF + j8 + 4);
#pragma unroll
          for (int i = 0; i < 4; ++i) { bg[i] = a0[i]; bg[4 + i] = a1[i]; bv[i] = c0[i]; bv[4 + i] = c1[i]; } }
        float g0[8], g1[8], v0[8], v1[8];
        if (t0 > 0) {
            unpack8(*(const uint4*)(up + (size_t)(r0 - 2) * DFF2 + j8), g0); unpack8(*(const uint4*)(up + (size_t)(r0 - 2) * DFF2 + DFF + j8), v0);
            unpack8(*(const uint4*)(up + (size_t)(r0 - 1) * DFF2 + j8), g1); unpack8(*(const uint4*)(up + (size_t)(r0 - 1) * DFF2 + DFF + j8), v1);
        } else if (smp) {
            const float* bp = p.st_fconv + (size_t)(l * 128 + sb) * 2 * DFF2;
            const f32x4 a0 = *(const f32x4*)(bp + j8), a1 = *(const f32x4*)(bp + j8 + 4), c0 = *(const f32x4*)(bp + DFF + j8), c1 = *(const f32x4*)(bp + DFF + j8 + 4);
            const f32x4 d0 = *(const f32x4*)(bp + DFF2 + j8), d1 = *(const f32x4*)(bp + DFF2 + j8 + 4), e0 = *(const f32x4*)(bp + DFF2 + DFF + j8), e1 = *(const f32x4*)(bp + DFF2 + DFF + j8 + 4);
#pragma unroll
            for (int i = 0; i < 4; ++i) { g0[i] = a0[i]; g0[4 + i] = a1[i]; v0[i] = c0[i]; v0[4 + i] = c1[i]; g1[i] = d0[i]; g1[4 + i] = d1[i]; v1[i] = e0[i]; v1[4 + i] = e1[i]; }
        } else {
#pragma unroll
            for (int i = 0; i < 8; ++i) { g0[i] = 0.f; g1[i] = 0.f; v0[i] = 0.f; v1[i] = 0.f; }
        }
#pragma unroll
        for (int rr = 0; rr < 8; ++rr) {
            float g2[8], v2[8];
            unpack8(*(const uint4*)(up + (size_t)(r0 + rr) * DFF2 + j8), g2); unpack8(*(const uint4*)(up + (size_t)(r0 + rr) * DFF2 + DFF + j8), v2);
            float o[8];
#pragma unroll
            for (int i = 0; i < 8; ++i) {
                const float ag = bg[i] + wg[0][i] * g0[i] + wg[1][i] * g1[i] + wg[2][i] * g2[i];
                const float av = bv[i] + wv[0][i] * v0[i] + wv[1][i] * v1[i] + wv[2][i] * v2[i];
                o[i] = ag * __builtin_amdgcn_rcpf(1.0f + __expf(-ag)) * av;
                g0[i] = g1[i]; g1[i] = g2[i]; v0[i] = v1[i]; v1[i] = v2[i];
            }
            u32x4 wv4; wv4.x = pk2(o[0], o[1]); wv4.y = pk2(o[2], o[3]); wv4.z = pk2(o[4], o[5]); wv4.w = pk2(o[6], o[7]);
            *(u32x4*)(act + (size_t)(r0 + rr) * DFF + j8) = wv4;
        }
    }
    const int tot2 = 132 * 2 * (DFF2 / 8);
    for (int it = blockIdx.x * NTHR + tid_; it < tot2; it += gridDim.x * NTHR) {
        const int c8 = (it % (DFF2 / 8)) * 8, rr = it / (DFF2 / 8), j = rr & 1, sq = rr >> 1;
        float* o; size_t row;
        if (sq < 4) { o = p.out + O_PFC + ((size_t)(l * 4 + sq) * 2 + j) * DFF2 + c8; row = (size_t)sq * 2048 + 2046 + j; }
        else { const int b = sq - 4; o = p.out + O_SFC + ((size_t)(l * 128 + b) * 2 + j) * DFF2 + c8; row = (size_t)NPR + b * 8 + 6 + j; }
        float xf[8]; unpack8(*(const uint4*)(up + row * DFF2 + c8), xf);
        *(f32x4*)o = (f32x4){xf[0], xf[1], xf[2], xf[3]}; *(f32x4*)(o + 4) = (f32x4){xf[4], xf[5], xf[6], xf[7]};
    }
}


#define XB_TMO      128
#define XB_XCNT(j)  (256  + 64 * (j))
#define XB_XSUB(j)  (1280 + 64 * (j))
#define XB_XGEN(j)  (2304 + 64 * (j))
#define XB_TOP      3328
#define XB_TOPGEN   3392
#define XCD_BAR_WORDS 3456
#define XB_SPIN_CAP (1u << 20)
DEV unsigned xb_ld(unsigned* p)              { return __hip_atomic_load(p, __ATOMIC_RELAXED, __HIP_MEMORY_SCOPE_AGENT); }
DEV unsigned xb_add(unsigned* p, unsigned v) { return __hip_atomic_fetch_add(p, v, __ATOMIC_RELAXED, __HIP_MEMORY_SCOPE_AGENT); }
DEV unsigned xb_xcc_id() { return (unsigned)__builtin_amdgcn_s_getreg((3 << 11) | 20) & 0xFu; }
#define XB_SPIN(cond, bar) do { unsigned _sp = 0; while (cond) { __builtin_amdgcn_s_sleep(1); \
    if ((++_sp & 255u) == 0u) { if (xb_ld(&(bar)[XB_TMO])) break; if (_sp > XB_SPIN_CAP) { atomicAdd(&(bar)[XB_TMO], 1u); break; } } } } while (0)
struct XcdBarrier { unsigned* bar; unsigned x; volatile LAS unsigned* st; };
DEV XcdBarrier xcd_barrier_post(unsigned* bar, volatile LAS unsigned* st) {
    XcdBarrier b; b.bar = bar; b.x = xb_xcc_id(); b.st = st;
    if (threadIdx.x == 0) (void)xb_add(&bar[XB_XCNT(b.x)], 1u);
    return b;
}
DEV void xcd_barrier_complete(unsigned* bar, unsigned x, unsigned& nloc, unsigned& nx) {
    const unsigned G = gridDim.x * gridDim.y * gridDim.z;
    unsigned sum, cnt, mine, sp = 0u;
    for (;;) {
        sum = 0u; cnt = 0u; mine = 0u;
#pragma unroll
        for (unsigned j = 0; j < 16; ++j) { const unsigned c = xb_ld(&bar[XB_XCNT(j)]); sum += c; cnt += (c > 0u) ? 1u : 0u; mine = (j == x) ? c : mine; }
        if (sum == G) break;
        __builtin_amdgcn_s_sleep(1);
        if ((++sp & 255u) == 0u) { if (xb_ld(&bar[XB_TMO])) break; if (sp > XB_SPIN_CAP) { atomicAdd(&bar[XB_TMO], 1u); break; } }
    }
    nloc = mine > 0u ? mine : 1u; nx = cnt > 0u ? cnt : 1u;
}
DEV void xcd_barrier(const XcdBarrier& b) {
    asm volatile("s_waitcnt vmcnt(0)" ::: "memory");
    __syncthreads();
    if (threadIdx.x == 0) {
        unsigned* bar = b.bar;
        __builtin_amdgcn_s_waitcnt(0);
        unsigned nloc = b.st[0], nx = b.st[1];
        if (nloc == 0u) { xcd_barrier_complete(bar, b.x, nloc, nx); b.st[0] = nloc; b.st[1] = nx; }
        const unsigned old = xb_add(&bar[XB_XSUB(b.x)], 1u);
        const unsigned gen = old / nloc;
        if (old + 1u == (gen + 1u) * nloc) {
            __builtin_amdgcn_fence(__ATOMIC_RELEASE, "agent");
            asm volatile("s_waitcnt vmcnt(0)" ::: "memory");
            const unsigned og = xb_add(&bar[XB_TOP], 1u);
            const unsigned tg = og / nx;
            if (og + 1u == (tg + 1u) * nx) xb_add(&bar[XB_TOPGEN], 1u);
            else XB_SPIN(xb_ld(&bar[XB_TOPGEN]) == tg, bar);
            __builtin_amdgcn_fence(__ATOMIC_ACQUIRE, "agent");
            xb_add(&bar[XB_XGEN(b.x)], 1u);
            asm volatile("s_waitcnt vmcnt(0)" ::: "memory");
        } else {
            XB_SPIN(xb_ld(&bar[XB_XGEN(b.x)]) == gen, bar);
            __builtin_amdgcn_fence(__ATOMIC_ACQUIRE, "agent");
            asm volatile("s_waitcnt vmcnt(0)" ::: "memory");
        }
    }
    __syncthreads();
}

constexpr int NPHASE = 21;
DEV void run_phase(const P& p, int l, int q, unsigned char* lds) {
    int bid = blockIdx.x, G = gridDim.x; asm volatile("" : "+s"(bid), "+s"(G));
    if (q == 0) {
        pg8::Gemm g{(const bf16_t*)(p.ws + WS_XB), (const bf16_t*)(p.ws + WS_WIN) + (size_t)l * INP * D, NTOK, INP, D};
        pg8::StaticOrder S; S.init(NTOK, INP, D, G, bid);
        pg8::EpiBf16 E{(bf16_t*)(p.ws + WS_U), INP, nullptr};
        pg8::gemm_phase<pg8::EpiBf16, pg8::StaticOrder>((LAS unsigned char*)lds, g, S, E);
    } else if (q == 1) {
        const int par = bid & 1;
#pragma unroll 1
        for (int half = 0; half < 2; ++half) {
            if ((half ^ par) == 0) {
                for (int u = bid; u < 512; u += G) smp_mlstm(p, l, u, lds);
                for (int u = bid; u < 256; u += G) smp_ssd(p, l, u, lds);
            } else {
                for (int u = bid; u < 512; u += G) mlstm_local(p, l, u, lds);
                for (int u = bid; u < 256; u += G) ssd_local(p, l, u, lds);
            }
        }
    } else if (q == 2) {
        for (int u = bid; u < 256; u += G) mlstm_scan(p, l, u, lds);
        for (int u = bid; u < 256; u += G) ssd_scan(p, l, u, lds);
        for (int u = bid; u < 132; u += G) convstate_copy(p, l, u);
    } else if (q == 3) {
        for (int u = bid; u < 512; u += G) mlstm_out(p, l, u, lds);
        for (int u = bid; u < 256; u += G) ssd_out(p, l, u, lds);
    } else if (q == 4) {
        pg8::Gemm g{(const bf16_t*)(p.ws + WS_MIXIN), (const bf16_t*)(p.ws + WS_WOUT) + (size_t)l * D * D, NTOK, D, D};
        pg8::EpiBf16 E{(bf16_t*)(p.ws + WS_MIXF), D, (float*)(p.ws + WS_PART)};
        if (G == 256) { pg8::TailSplitOrder S; S.init(D, bid); pg8::gemm_phase<pg8::EpiBf16, pg8::TailSplitOrder>((LAS unsigned char*)lds, g, S, E); }
        else { pg8::StaticOrder S; S.init(NTOK, D, D, G, bid); pg8::gemm_phase<pg8::EpiBf16, pg8::StaticOrder>((LAS unsigned char*)lds, g, S, E); }
    } else if (q == 5) {
        phase_ln(p, l, 0);
    } else if (q == 6) {
        pg8::Gemm g{(const bf16_t*)(p.ws + WS_XB), (const bf16_t*)(p.ws + WS_WUP) + (size_t)l * DFF2 * D, NTOK, DFF2, D};
        pg8::StaticOrder S; S.init(NTOK, DFF2, D, G, bid);
        pg8::EpiBf16 E{(bf16_t*)(p.ws + WS_UP), DFF2, nullptr};
        pg8::gemm_phase<pg8::EpiBf16, pg8::StaticOrder>((LAS unsigned char*)lds, g, S, E);
    } else if (q == 7) {
        phase_ffn_gate(p, l);
    } else if (q == 8) {
        pg8::Gemm g{(const bf16_t*)(p.ws + WS_ACT), (const bf16_t*)(p.ws + WS_WDN) + (size_t)l * D * DFF, NTOK, D, DFF};
        pg8::EpiBf16 E{(bf16_t*)(p.ws + WS_MIXF), D, (float*)(p.ws + WS_PART)};
        if (G == 256) { pg8::TailSplitOrder S; S.init(DFF, bid); pg8::gemm_phase<pg8::EpiBf16, pg8::TailSplitOrder>((LAS unsigned char*)lds, g, S, E); }
        else { pg8::StaticOrder S; S.init(NTOK, D, DFF, G, bid); pg8::gemm_phase<pg8::EpiBf16, pg8::StaticOrder>((LAS unsigned char*)lds, g, S, E); }
    } else {
        phase_ln(p, l, 1);
    }
}
#if MK_MULTI
template <int T> __global__ void __launch_bounds__(NTHR, 2) k_unit(P p) {
    extern __shared__ __attribute__((aligned(16))) unsigned char lds[];
    const int l = p.ph_lo; int bid = blockIdx.x, G = gridDim.x;
    if (T == 11) for (int u = bid; u < 512; u += G) smp_mlstm(p, l, u, lds);
    if (T == 12) for (int u = bid; u < 256; u += G) smp_ssd(p, l, u, lds);
    if (T == 13) for (int u = bid; u < 512; u += G) mlstm_local(p, l, u, lds);
    if (T == 14) for (int u = bid; u < 256; u += G) ssd_local(p, l, u, lds);
    if (T == 31) for (int u = bid; u < 512; u += G) mlstm_out(p, l, u, lds);
    if (T == 32) for (int u = bid; u < 256; u += G) ssd_out(p, l, u, lds);
    if (T == 21) for (int u = bid; u < 256; u += G) mlstm_scan(p, l, u, lds);
    if (T == 22) for (int u = bid; u < 256; u += G) ssd_scan(p, l, u, lds);
}
template <int Q> __global__ void __launch_bounds__(NTHR, 2) k_phase(P p) {
    extern __shared__ __attribute__((aligned(16))) unsigned char lds[];
    if (Q < 0) phase_prologue(p, lds); else run_phase(p, p.ph_lo, Q, lds);
}
#else
__global__ void __launch_bounds__(NTHR, 2) mk_fwd(P p) {
    extern __shared__ __attribute__((aligned(16))) unsigned char lds[];
    cg::grid_group grid = cg::this_grid();
    if (p.ph_hi < 0) grid.sync();
    if (threadIdx.x < 4) ((unsigned*)(lds + LDS_BYTES - 16))[threadIdx.x] = 0u;
    __syncthreads();
    (void)xcd_barrier_post((unsigned*)(p.ws + WS_BAR), (volatile LAS unsigned*)(lds + LDS_BYTES - 16));
#define GSYNC() do { XcdBarrier b_; b_.bar = (unsigned*)(p.ws + WS_BAR); b_.x = xb_xcc_id(); b_.st = (volatile LAS unsigned*)(lds + LDS_BYTES - 16); xcd_barrier(b_); } while (0)
    phase_prologue(p, lds);
#pragma unroll 1
    for (int l = 0; l < 2; ++l) {
        GSYNC(); run_phase(p, l, 0, lds);
        GSYNC(); run_phase(p, l, 1, lds);
        GSYNC(); run_phase(p, l, 2, lds);
        GSYNC(); run_phase(p, l, 3, lds);
        GSYNC(); run_phase(p, l, 4, lds);
        GSYNC(); run_phase(p, l, 5, lds);
        GSYNC(); run_phase(p, l, 6, lds);
        GSYNC(); run_phase(p, l, 7, lds);
        GSYNC(); run_phase(p, l, 8, lds);
        GSYNC(); run_phase(p, l, 9, lds);
    }
    for (int i = 0; i < PROBE_SYNCS; ++i) GSYNC();
}
#endif

extern "C" void kernel_launch(void* const* d_in, const int* in_sizes, int n_in, void* d_out, int out_size, void* d_ws, size_t ws_size, hipStream_t stream) {
    static int grid = 0;
    if (grid == 0) {
        if (n_in != 27 || ws_size < WS_END) { fprintf(stderr, "kernel_launch: unexpected n_in %d or ws_size %zu (need %zu)\n", n_in, ws_size, (size_t)WS_END); grid = -1; return; }
        int dev = 0, cus = 0, per_cu = 0;
        hipGetDevice(&dev);
        hipDeviceGetAttribute(&cus, hipDeviceAttributeMultiprocessorCount, dev);
#if MK_MULTI
        const void* fns[11] = {(const void*)k_phase<-1>, (const void*)k_phase<0>, (const void*)k_phase<1>, (const void*)k_phase<2>, (const void*)k_phase<3>, (const void*)k_phase<4>, (const void*)k_phase<5>,
                               (const void*)k_phase<6>, (const void*)k_phase<7>, (const void*)k_phase<8>, (const void*)k_phase<9>};
        for (int i = 0; i < 11; ++i) if (hipFuncSetAttribute(fns[i], hipFuncAttributeMaxDynamicSharedMemorySize, LDS_BYTES) != hipSuccess) { fprintf(stderr, "kernel_launch: hipFuncSetAttribute failed\n"); grid = -1; return; }
#else
        if (hipFuncSetAttribute((const void*)mk_fwd, hipFuncAttributeMaxDynamicSharedMemorySize, LDS_BYTES) != hipSuccess) { fprintf(stderr, "kernel_launch: hipFuncSetAttribute failed\n"); grid = -1; return; }
        hipOccupancyMaxActiveBlocksPerMultiprocessor(&per_cu, (const void*)mk_fwd, NTHR, LDS_BYTES);
        (void)hipGetLastError();
#endif
        (void)per_cu;
        grid = cus * 1;
    }
    if (grid < 0) return;
    P p{};
    const float** pp = (const float**)&p;
    for (int i = 0; i < 27; ++i) pp[i] = (const float*)d_in[i];
    p.out = (float*)d_out; p.ws = (unsigned char*)d_ws;
#if MK_MULTI
    p.ph_lo = 0; p.ph_hi = 0;
    if (PROBE_REP == -1) hipLaunchKernelGGL(k_phase<-1>, dim3(grid), dim3(NTHR), LDS_BYTES, stream, p);
    hipLaunchKernelGGL(k_phase<-1>, dim3(grid), dim3(NTHR), LDS_BYTES, stream, p);
    for (int l = 0; l < 2; ++l) {
        p.ph_lo = l;
        for (int rep = 0; rep < 1 + ((PROBE_REP == 0) || (PROBE_REP == 100 && (0 == 0 || 0 == 4 || 0 == 6 || 0 == 8))); ++rep) hipLaunchKernelGGL(k_phase<0>, dim3(grid), dim3(NTHR), LDS_BYTES, stream, p);
        for (int rep = 0; rep < 1 + ((PROBE_REP == 1) || (PROBE_REP == 100 && (1 == 0 || 1 == 4 || 1 == 6 || 1 == 8))); ++rep) hipLaunchKernelGGL(k_phase<1>, dim3(grid), dim3(NTHR), LDS_BYTES, stream, p);
        for (int rep = 0; rep < 1 + ((PROBE_REP == 2) || (PROBE_REP == 100 && (2 == 0 || 2 == 4 || 2 == 6 || 2 == 8))); ++rep) hipLaunchKernelGGL(k_phase<2>, dim3(grid), dim3(NTHR), LDS_BYTES, stream, p);
        for (int rep = 0; rep < 1 + ((PROBE_REP == 3) || (PROBE_REP == 100 && (3 == 0 || 3 == 4 || 3 == 6 || 3 == 8))); ++rep) hipLaunchKernelGGL(k_phase<3>, dim3(grid), dim3(NTHR), LDS_BYTES, stream, p);
        if (PROBE_REP == 11 || PROBE_REP == 12 || PROBE_REP == 13 || PROBE_REP == 14 || PROBE_REP == 31 || PROBE_REP == 32 || PROBE_REP == 21 || PROBE_REP == 22) {
            hipFuncSetAttribute((const void*)k_unit<PROBE_REP>, hipFuncAttributeMaxDynamicSharedMemorySize, LDS_BYTES);
            hipLaunchKernelGGL(k_unit<PROBE_REP>, dim3(grid), dim3(NTHR), LDS_BYTES, stream, p);
        }
        for (int rep = 0; rep < 1 + ((PROBE_REP == 4) || (PROBE_REP == 100 && (4 == 0 || 4 == 4 || 4 == 6 || 4 == 8))); ++rep) hipLaunchKernelGGL(k_phase<4>, dim3(grid), dim3(NTHR), LDS_BYTES, stream, p);
        for (int rep = 0; rep < 1 + ((PROBE_REP == 5) || (PROBE_REP == 100 && (5 == 0 || 5 == 4 || 5 == 6 || 5 == 8))); ++rep) hipLaunchKernelGGL(k_phase<5>, dim3(grid), dim3(NTHR), LDS_BYTES, stream, p);
        for (int rep = 0; rep < 1 + ((PROBE_REP == 6) || (PROBE_REP == 100 && (6 == 0 || 6 == 4 || 6 == 6 || 6 == 8))); ++rep) hipLaunchKernelGGL(k_phase<6>, dim3(grid), dim3(NTHR), LDS_BYTES, stream, p);
        for (int rep = 0; rep < 1 + ((PROBE_REP == 7) || (PROBE_REP == 100 && (7 == 0 || 7 == 4 || 7 == 6 || 7 == 8))); ++rep) hipLaunchKernelGGL(k_phase<7>, dim3(grid), dim3(NTHR), LDS_BYTES, stream, p);
        for (int rep = 0; rep < 1 + ((PROBE_REP == 8) || (PROBE_REP == 100 && (8 == 0 || 8 == 4 || 8 == 6 || 8 == 8))); ++rep) hipLaunchKernelGGL(k_phase<8>, dim3(grid), dim3(NTHR), LDS_BYTES, stream, p);
        for (int rep = 0; rep < 1 + ((PROBE_REP == 9) || (PROBE_REP == 100 && (9 == 0 || 9 == 4 || 9 == 6 || 9 == 8))); ++rep) hipLaunchKernelGGL(k_phase<9>, dim3(grid), dim3(NTHR), LDS_BYTES, stream, p);
    }
#else
    p.ph_lo = 0; p.ph_hi = NPHASE;
    if (hipMemsetAsync((char*)d_ws + WS_BAR, 0, 16384, stream) != hipSuccess) { fprintf(stderr, "kernel_launch: memset failed\n"); return; }
    void* args[] = {&p};
    hipError_t e = hipLaunchCooperativeKernel((const void*)mk_fwd, dim3(grid), dim3(NTHR), args, LDS_BYTES, stream);
    if (e != hipSuccess) fprintf(stderr, "cooperative launch failed: %s (grid %d)\n", hipGetErrorString(e), grid);
#endif
}
```

```cpp
#include <hip/hip_runtime.h>
#include <hip/hip_cooperative_groups.h>
#include <cstdio>
namespace cg = cooperative_groups;

#ifndef MK_MULTI
#define MK_MULTI 0
#endif
#ifndef PROBE_REP
#define PROBE_REP -99
#endif
#ifndef PROBE_SYNCS
#define PROBE_SYNCS 0
#endif

#define DEV __device__ __forceinline__
#define LAS __attribute__((address_space(3)))
typedef unsigned short bf16_t;
typedef short bf16x8 __attribute__((ext_vector_type(8)));
typedef float f32x4 __attribute__((ext_vector_type(4)));
typedef float f32x2 __attribute__((ext_vector_type(2)));
typedef unsigned u32x4 __attribute__((ext_vector_type(4)));
typedef unsigned u32x2 __attribute__((ext_vector_type(2)));

constexpr int D = 2048, NPR = 8192, NSM = 1024, NTOK = 9216, INP = 6912, IN_DIM = 6680, DFF = 5504, DFF2 = 11008;
constexpr int UQ = 0, UK = 1024, UV = 2048, UO = 3072, UZ = 4096, UXS = 5120, UIG = 6656, UFG = 6660, UDT = 6664;
constexpr int NTHR = 512;
constexpr int LDS_BYTES = 136 * 1024;
constexpr float ALPHA = 1.41421356237309515f;

constexpr size_t O_YP = 0;
constexpr size_t O_YS = O_YP + (size_t)4 * 2048 * 2048;
constexpr size_t O_PC = O_YS + (size_t)128 * 8 * 2048;
constexpr size_t O_PN = O_PC + (size_t)2 * 4 * 4 * 256 * 256;
constexpr size_t O_PM = O_PN + (size_t)2 * 4 * 4 * 256;
constexpr size_t O_PS = O_PM + (size_t)2 * 4 * 4;
constexpr size_t O_PSC = O_PS + (size_t)2 * 4 * 16 * 64 * 128;
constexpr size_t O_PFC = O_PSC + (size_t)2 * 4 * 3 * 1536;
constexpr size_t O_SC = O_PFC + (size_t)2 * 4 * 2 * DFF2;
constexpr size_t O_SN = O_SC + (size_t)2 * 128 * 4 * 256 * 256;
constexpr size_t O_SM = O_SN + (size_t)2 * 128 * 4 * 256;
constexpr size_t O_SS = O_SM + (size_t)2 * 128 * 4;
constexpr size_t O_SSC = O_SS + (size_t)2 * 128 * 16 * 64 * 128;
constexpr size_t O_SFC = O_SSC + (size_t)2 * 128 * 3 * 1536;

constexpr size_t WS_WIN = 0;
constexpr size_t WS_WOUT = WS_WIN + (size_t)2 * INP * D * 2;
constexpr size_t WS_WUP = WS_WOUT + (size_t)2 * D * D * 2;
constexpr size_t WS_WDN = WS_WUP + (size_t)2 * DFF2 * D * 2;
constexpr size_t WS_XB = WS_WDN + (size_t)2 * D * DFF * 2;
constexpr size_t WS_XF = WS_XB + (size_t)NTOK * D * 2;
constexpr size_t WS_XBC = WS_XF;
constexpr size_t WS_U = WS_XF + (size_t)NTOK * D * 4;
constexpr size_t WS_MIXIN = WS_U + (size_t)NTOK * INP * 2;
constexpr size_t WS_MIXF = WS_MIXIN + (size_t)NTOK * D * 2;
constexpr size_t WS_UP = WS_MIXF + (size_t)NTOK * D * 4;
constexpr size_t WS_ACT = WS_UP + (size_t)NTOK * DFF2 * 2;
constexpr size_t WS_PART = WS_ACT + (size_t)NTOK * DFF * 2;
constexpr size_t WS_SMALL = WS_PART + (size_t)8 * NSM * D * 4;
constexpr size_t WS_DBUF = WS_UP;
constexpr size_t WS_SBUF = WS_UP + (size_t)512 * 65536 * 4;
constexpr size_t WS_CT = WS_ACT;
constexpr size_t WS_ST = WS_ACT + (size_t)512 * 65536 * 2;
static_assert(WS_SBUF + (size_t)2048 * 8192 * 4 <= WS_ACT, "alias");
static_assert(WS_ST + (size_t)2048 * 8192 * 2 <= WS_PART, "alias");
constexpr size_t WS_NLOC = WS_SMALL;
constexpr size_t WS_NST = WS_NLOC + (size_t)512 * 256 * 4;
constexpr size_t WS_GSTAT = WS_NST + (size_t)512 * 256 * 4;
constexpr size_t WS_MST = WS_GSTAT + 4096;
constexpr size_t WS_SBSUM = WS_MST + 4096;
constexpr size_t WS_BAR = WS_SBSUM + 8192;
constexpr size_t WS_END = WS_BAR + 16384;

struct P {
    const float* x_prompt; const float* x_sample; const float* st_C; const float* st_n; const float* st_m; const float* st_ssm; const float* st_sconv; const float* st_fconv;
    const float* w_in; const float* b_i; const float* b_f; const float* m_norm_w; const float* s_conv_w; const float* s_conv_b; const float* dt_bias; const float* A_log; const float* D_skip;
    const float* s_norm_w; const float* w_out; const float* ln1_g; const float* ln1_b; const float* w_up; const float* f_conv_w; const float* f_conv_b; const float* w_down; const float* ln2_g; const float* ln2_b;
    float* out; unsigned char* ws; int ph_lo, ph_hi;
};

DEV float bf2f(bf16_t v) { return __uint_as_float(((unsigned)v) << 16); }
DEV bf16_t f2bf(float f) { unsigned u = __float_as_uint(f); u += 0x7FFFu + ((u >> 16) & 1u); return (bf16_t)(u >> 16); }
DEV unsigned pk2(float lo, float hi) { return (unsigned)f2bf(lo) | ((unsigned)f2bf(hi) << 16); }
DEV float bflo(unsigned w) { return __uint_as_float(w << 16); }
DEV float bfhi(unsigned w) { return __uint_as_float(w & 0xffff0000u); }
DEV float sigmoidf_(float x) { return __builtin_amdgcn_rcpf(1.0f + __expf(-x)); }
DEV float siluf_(float x) { return x * sigmoidf_(x); }
DEV float softplusf_(float x) { return fmaxf(x, 0.f) + log1pf(expf(-fabsf(x))); }
DEV float logsigf_(float x) { return fminf(x, 0.f) - log1pf(expf(-fabsf(x))); }
DEV float wave_sum(float v) {
#pragma unroll
    for (int o = 32; o >= 1; o >>= 1) v += __shfl_xor(v, o);
    return v; }
DEV float wave_max(float v) {
#pragma unroll
    for (int o = 32; o >= 1; o >>= 1) v = fmaxf(v, __shfl_xor(v, o));
    return v; }
DEV float wave_incl_sum(float v, int lane) {
#pragma unroll
    for (int o = 1; o < 64; o <<= 1) { float t = __shfl_up(v, o); if (lane >= o) v += t; }
    return v; }
DEV float wave_incl_max(float v, int lane) {
#pragma unroll
    for (int o = 1; o < 64; o <<= 1) { float t = __shfl_up(v, o); if (lane >= o) v = fmaxf(v, t); }
    return v; }
DEV f32x4 mfma16(bf16x8 a, bf16x8 b, f32x4 c) { return __builtin_amdgcn_mfma_f32_16x16x32_bf16(a, b, c, 0, 0, 0); }
DEV void unpack8(uint4 x, float (&f)[8]) { f[0] = bflo(x.x); f[1] = bfhi(x.x); f[2] = bflo(x.y); f[3] = bfhi(x.y); f[4] = bflo(x.z); f[5] = bfhi(x.z); f[6] = bflo(x.w); f[7] = bfhi(x.w); }

typedef short s16x4 __attribute__((ext_vector_type(4)));
DEV bf16x8 tr_frag(const bf16_t* T, int pitch, int krow0, int col0, int lane) {
    const int g = lane >> 4, q = (lane & 15) >> 2, pl = lane & 3;
    const bf16_t* a0 = T + (krow0 + 8 * g + q) * pitch + col0 + 4 * pl;
    const s16x4 lo = __builtin_amdgcn_ds_read_tr16_b64_v4i16((LAS s16x4*)a0);
    const s16x4 hi = __builtin_amdgcn_ds_read_tr16_b64_v4i16((LAS s16x4*)(a0 + 4 * pitch));
    return (bf16x8){lo[0], lo[1], lo[2], lo[3], hi[0], hi[1], hi[2], hi[3]};
}

namespace pg8 {
constexpr int BM = 256, BK = 64, HALF = 128, HTB = HALF * BK * 2, STAGE_BYTES = 8 * HTB, NXCD = 8, WGM = 8;
DEV int lds_byte(int r, int c) { const int st = (r >> 4) * 2 + (c >> 5), rr = r & 15, cc = c & 31, ob = rr * 64 + cc * 2; return st * 1024 + (ob ^ (((ob >> 9) & 1) << 5)); }
DEV void stage_rc(int b, int& R, int& C) { const int st = b / 1024, sb = b % 1024, swz = sb ^ (((sb >> 9) & 1) << 5); R = (st >> 1) * 16 + swz / 64; C = (st & 1) * 32 + (swz % 64) / 2; }
DEV int perm32(int rho) { const int n = rho >> 4, i = rho & 15; return 8 * (i >> 2) + 4 * n + (i & 3); }
struct Unit { int pm, pn, k0, nt, ks; };
struct Gemm { const bf16_t* A; const bf16_t* Bt; int M, N, K; };
struct StaticOrder {
    int nM, nN, nwg, G, c, ntk;
    DEV void init(int M, int N, int K, int G_, int c_) { nM = M / BM; nN = N / BM; nwg = nM * nN; G = G_; c = c_; ntk = K / BK; }
    DEV bool next(int i, Unit& u) const {
        u.pm = 0; u.pn = 0; u.k0 = 0; u.nt = 4; u.ks = -1;
        const long L = (long)i * G + c; if (L >= nwg) return false;
        int wgid = (int)L; { const int q = nwg / NXCD, r = nwg % NXCD, xcd = wgid % NXCD, off = wgid / NXCD; wgid = (xcd < r ? xcd * (q + 1) : r * (q + 1) + (xcd - r) * q) + off; }
        const int nig = WGM * nN, gid = wgid / nig, fm = gid * WGM, gsz = (nM - fm) < WGM ? (nM - fm) : WGM;
        u.pm = fm + ((wgid % nig) % gsz); u.pn = (wgid % nig) / gsz; u.k0 = 0; u.nt = ntk; u.ks = -1; return true;
    }
};
struct TailSplitOrder {
    StaticOrder so; int c, ntk;
    DEV void init(int K, int c_) { so.init(NPR, D, K, 256, c_); c = c_; ntk = K / BK; }
    DEV bool next(int i, Unit& u) const {
        u.pm = 0; u.pn = 0; u.k0 = 0; u.nt = 4; u.ks = -1;
        if (i == 0) return so.next(0, u);
        if (i > 1) return false;
        const int tt = c >> 3, ks = c & 7; u.pm = 32 + (tt >> 3); u.pn = tt & 7; u.ks = ks;
        const int pairs = ntk >> 1, base = pairs >> 3, rem = pairs & 7;
        const int p0 = ks * base + (ks < rem ? ks : rem), np = base + (ks < rem ? 1 : 0);
        u.k0 = p0 * 128; u.nt = np * 2; return true;
    }
};
DEV unsigned cvt_pk_bf16(float lo, float hi) { unsigned r; asm volatile("v_cvt_pk_bf16_f32 %0, %1, %2" : "=v"(r) : "v"(lo), "v"(hi)); return r; }
struct EpiF32 {
    static constexpr bool PERM = false;
    float* C; int ldc; float* part;
    DEV void operator()(const f32x4 (&acc)[2][2][4][2], const Unit& u, int wr, int wc, int fr, int fq) const {
        const int row0 = u.pm * BM + wr * 64 + fr, col0 = u.pn * BM + wc * 32 + 4 * fq;
        float* Cb = u.ks < 0 ? C : part + (size_t)u.ks * NSM * D - (size_t)NPR * ldc;
#pragma unroll
        for (int ai = 0; ai < 2; ++ai)
#pragma unroll
            for (int m = 0; m < 4; ++m) { float* rowp = Cb + (size_t)(row0 + ai * HALF + m * 16) * ldc + col0;
#pragma unroll
                for (int bj = 0; bj < 2; ++bj)
#pragma unroll
                    for (int n = 0; n < 2; ++n) *(f32x4*)(rowp + bj * HALF + n * 16) = acc[ai][bj][m][n]; }
    }
};
struct EpiBf16 {
    static constexpr bool PERM = true;
    bf16_t* O; int ldc; float* part;
    DEV void operator()(const f32x4 (&acc)[2][2][4][2], const Unit& u, int wr, int wc, int fr, int fq) const {
        const int row0 = u.pm * BM + wr * 64 + fr; const int col0 = u.pn * BM + wc * 32 + 8 * fq;
        if (u.ks >= 0) {
            float* pb = part + (size_t)u.ks * NSM * ldc + (size_t)(row0 - NPR) * ldc + col0;
#pragma unroll
            for (int ai = 0; ai < 2; ++ai)
#pragma unroll
                for (int m = 0; m < 4; ++m)
#pragma unroll
                    for (int bj = 0; bj < 2; ++bj) { float* q = pb + (size_t)(ai * HALF + m * 16) * ldc + bj * HALF; *(f32x4*)q = acc[ai][bj][m][0]; *(f32x4*)(q + 4) = acc[ai][bj][m][1]; }
            return;
        }
#pragma unroll
        for (int ai = 0; ai < 2; ++ai)
#pragma unroll
            for (int m = 0; m < 4; ++m) { bf16_t* rowp = O + (size_t)(row0 + ai * HALF + m * 16) * ldc + col0;
#pragma unroll
                for (int bj = 0; bj < 2; ++bj) { const f32x4 v0 = acc[ai][bj][m][0], v1 = acc[ai][bj][m][1];
                    u32x4 w; w.x = cvt_pk_bf16(v0[0], v0[1]); w.y = cvt_pk_bf16(v0[2], v0[3]); w.z = cvt_pk_bf16(v1[0], v1[1]); w.w = cvt_pk_bf16(v1[2], v1[3]);
                    *(u32x4*)(rowp + bj * HALF) = w; } }
    }
};

template <class Epi, class Sched>
DEV void gemm_phase(LAS unsigned char* lds, const Gemm g, const Sched& S, const Epi& E) {
    int tid_ = threadIdx.x; asm volatile("" : "+v"(tid_)); const int tid = tid_, wid = __builtin_amdgcn_readfirstlane(tid >> 6), lane = tid & 63, wr = wid >> 2, wc = wid & 3, fr = lane & 15, fq = lane >> 4;
    const int K = g.K;
    unsigned voffA[2], voffB[2];
#pragma unroll
    for (int i = 0; i < 2; ++i) { int R, C; stage_rc(tid * 16 + i * 8192, R, C); const int Rb = Epi::PERM ? ((R & ~31) + perm32(R & 31)) : R;
        voffA[i] = (unsigned)(R * K + C) * 2u; voffB[i] = (unsigned)(Rb * K + C) * 2u; }
    const size_t kstep = (size_t)(BK * 2);
    const size_t hstep = (size_t)HALF * K * 2;
    const size_t tstep = 2 * hstep;
    const unsigned ldsw = (unsigned)wid * 1024u;
    const int aoff = lds_byte(wr * 64 + fr, fq * 8), boff = lds_byte(wc * 32 + fr, fq * 8);
#define PG8_SA(b, h) (((b) * 2 + (h)) * HTB)
#define PG8_SB(b, h) ((4 + (b) * 2 + (h)) * HTB)
#define PG8_STAGE(bufoff, gbase, voff) do { _Pragma("unroll") for (int _i = 0; _i < 2; ++_i) \
        __builtin_amdgcn_global_load_lds((const unsigned*)((const char*)(gbase) + (voff)[_i]), (LAS unsigned*)(lds + (bufoff) + ldsw + _i * 8192), 16, 0, 0); } while (0)
#define PG8_LDA(dst, b, h) do { _Pragma("unroll") for (int m = 0; m < 4; ++m) _Pragma("unroll") for (int k = 0; k < 2; ++k) dst[m][k] = *(const LAS bf16x8*)(lds + PG8_SA(b, h) + aoff + m * 2048 + k * 1024); } while (0)
#define PG8_LDB(dst, b, h) do { _Pragma("unroll") for (int n = 0; n < 2; ++n) _Pragma("unroll") for (int k = 0; k < 2; ++k) dst[n][k] = *(const LAS bf16x8*)(lds + PG8_SB(b, h) + boff + n * 2048 + k * 1024); } while (0)
#define PG8_MMA(ai, bj, At, Bt) do { __builtin_amdgcn_s_setprio(1); _Pragma("unroll") for (int m = 0; m < 4; ++m) _Pragma("unroll") for (int n = 0; n < 2; ++n) _Pragma("unroll") for (int k = 0; k < 2; ++k) \
        acc[ai][bj][m][n] = __builtin_amdgcn_mfma_f32_16x16x32_bf16(Bt[n][k], At[m][k], acc[ai][bj][m][n], 0, 0, 0); __builtin_amdgcn_s_setprio(0); } while (0)
#define PG8_WAIT_V(n) asm volatile("s_waitcnt vmcnt(" #n ")" ::: "memory")
#define PG8_WAIT_L(n) asm volatile("s_waitcnt lgkmcnt(" #n ")" ::: "memory")
#define PG8_BAR __builtin_amdgcn_s_barrier()
#define PG8_SCHED __builtin_amdgcn_sched_barrier(0)
    Unit cur, nxt; int ui = 0;
    if (!S.next(0, cur)) return;
    f32x4 acc[2][2][4][2];
#pragma unroll
    for (int a = 0; a < 2; ++a)
#pragma unroll
        for (int b = 0; b < 2; ++b)
#pragma unroll
            for (int m = 0; m < 4; ++m)
#pragma unroll
                for (int n = 0; n < 2; ++n) acc[a][b][m][n] = (f32x4){0.f, 0.f, 0.f, 0.f};
    bf16x8 At[4][2], B0[2][2], B1[2][2];
    const char* cA = (const char*)g.A + (size_t)cur.pm * tstep + (size_t)cur.k0 * 2; const char* cB = (const char*)g.Bt + (size_t)cur.pn * tstep + (size_t)cur.k0 * 2;
    PG8_STAGE(PG8_SB(0, 0), cB, voffB); PG8_STAGE(PG8_SA(0, 0), cA, voffA); PG8_STAGE(PG8_SB(0, 1), cB + hstep, voffB); PG8_STAGE(PG8_SA(0, 1), cA + hstep, voffA);
    if (wr == 1) PG8_BAR;
    PG8_WAIT_V(4); PG8_BAR;
    PG8_STAGE(PG8_SB(1, 0), cB + kstep, voffB); PG8_STAGE(PG8_SA(1, 0), cA + kstep, voffA); PG8_STAGE(PG8_SB(1, 1), cB + hstep + kstep, voffB);
    PG8_WAIT_V(6); PG8_BAR;
    for (;;) {
        const bool has_next = S.next(ui + 1, nxt);
        const char* nA = has_next ? (const char*)g.A + (size_t)nxt.pm * tstep + (size_t)nxt.k0 * 2 : cA; const char* nB = has_next ? (const char*)g.Bt + (size_t)nxt.pn * tstep + (size_t)nxt.k0 * 2 : cB;
        const int nt = cur.nt;
        for (int t = 0; t < nt; t += 2) {
            const bool last = (t == nt - 2);
            const char* a1 = cA + (size_t)(t + 1) * kstep;
            const char* a2 = last ? nA : cA + (size_t)(t + 2) * kstep; const char* b2 = last ? nB : cB + (size_t)(t + 2) * kstep;
            const char* a3 = a2 + kstep; const char* b3 = b2 + kstep;
            PG8_LDB(B0, 0, 0); PG8_SCHED; PG8_LDA(At, 0, 0); PG8_STAGE(PG8_SA(1, 1), a1 + hstep, voffA);
            PG8_WAIT_L(8); PG8_BAR; PG8_WAIT_L(0); PG8_MMA(0, 0, At, B0); PG8_BAR; PG8_SCHED;
            PG8_LDB(B1, 0, 1); PG8_STAGE(PG8_SB(0, 0), b2, voffB);
            PG8_BAR; PG8_WAIT_L(0); PG8_MMA(0, 1, At, B1); PG8_BAR;
            PG8_LDA(At, 0, 1); PG8_STAGE(PG8_SA(0, 0), a2, voffA);
            PG8_BAR; PG8_WAIT_L(0); PG8_MMA(1, 0, At, B0); PG8_BAR; PG8_SCHED;
            PG8_STAGE(PG8_SB(0, 1), b2 + hstep, voffB);
            PG8_WAIT_V(6); PG8_BAR; PG8_MMA(1, 1, At, B1); PG8_BAR;
            PG8_LDB(B0, 1, 0); PG8_SCHED; PG8_LDA(At, 1, 0); PG8_STAGE(PG8_SA(0, 1), a2 + hstep, voffA);
            PG8_WAIT_L(8); PG8_BAR; PG8_WAIT_L(0); PG8_MMA(0, 0, At, B0); PG8_BAR; PG8_SCHED;
            PG8_LDB(B1, 1, 1); PG8_STAGE(PG8_SB(1, 0), b3, voffB);
            PG8_BAR; PG8_WAIT_L(0); PG8_MMA(0, 1, At, B1); PG8_BAR;
            PG8_LDA(At, 1, 1); PG8_STAGE(PG8_SA(1, 0), a3, voffA);
            PG8_BAR; PG8_WAIT_L(0); PG8_MMA(1, 0, At, B0); PG8_BAR; PG8_SCHED;
            PG8_STAGE(PG8_SB(1, 1), b3 + hstep, voffB);
            PG8_WAIT_V(6); PG8_BAR; PG8_MMA(1, 1, At, B1); PG8_BAR;
        }
        E(acc, cur, wr, wc, fr, fq);
        if (!has_next) break;
#pragma unroll
        for (int a = 0; a < 2; ++a)
#pragma unroll
            for (int b = 0; b < 2; ++b)
#pragma unroll
                for (int m = 0; m < 4; ++m)
#pragma unroll
                    for (int n = 0; n < 2; ++n) acc[a][b][m][n] = (f32x4){0.f, 0.f, 0.f, 0.f};
        cur = nxt; cA = nA; cB = nB; ++ui;
    }
    PG8_WAIT_V(0);
    if (wr == 0) PG8_BAR;
    PG8_BAR;
#undef PG8_SA
#undef PG8_SB
#undef PG8_STAGE
#undef PG8_LDA
#undef PG8_LDB
#undef PG8_MMA
#undef PG8_WAIT_V
#undef PG8_WAIT_L
#undef PG8_BAR
#undef PG8_SCHED
}
}

DEV int win_srccol(int n) { return n < 4096 ? n : (n < 6656 ? n + 8 : (n < 6664 ? n - 2560 : (n < 6680 ? n : -1))); }
DEV void transpose_tile(const float* __restrict__ src, int srcN, bf16_t* __restrict__ dst, int K, int n0, int k0, int mode, float* tile) {
    int tid_ = threadIdx.x; asm volatile("" : "+v"(tid_)); const int tid = tid_;
    f32x4 v[4];
#pragma unroll
    for (int i = 0; i < 4; ++i) {
        const int kk = (tid >> 5) + 16 * i, nn4 = (tid & 31) * 4, n = n0 + nn4;
        const int sc = mode ? win_srccol(n) : n;
        v[i] = (f32x4){0.f, 0.f, 0.f, 0.f};
        if (sc >= 0) v[i] = __builtin_nontemporal_load((const f32x4*)(src + (size_t)(k0 + kk) * srcN + sc));
        if (mode && n >= 1024 && n < 2048) v[i] = v[i] * 0.0625f;
    }
#pragma unroll
    for (int i = 0; i < 4; ++i) {
        const int kk = (tid >> 5) + 16 * i, nn4 = (tid & 31) * 4;
        tile[kk * 129 + nn4 + 0] = v[i][0]; tile[kk * 129 + nn4 + 1] = v[i][1]; tile[kk * 129 + nn4 + 2] = v[i][2]; tile[kk * 129 + nn4 + 3] = v[i][3];
    }
    __syncthreads();
#pragma unroll
    for (int i = 0; i < 2; ++i) {
        const int ch = tid + 512 * i, nn = ch >> 3, kk8 = (ch & 7) * 8;
        u32x4 w;
        w.x = pk2(tile[(kk8 + 0) * 129 + nn], tile[(kk8 + 1) * 129 + nn]); w.y = pk2(tile[(kk8 + 2) * 129 + nn], tile[(kk8 + 3) * 129 + nn]);
        w.z = pk2(tile[(kk8 + 4) * 129 + nn], tile[(kk8 + 5) * 129 + nn]); w.w = pk2(tile[(kk8 + 6) * 129 + nn], tile[(kk8 + 7) * 129 + nn]);
        *(u32x4*)(dst + (size_t)(n0 + nn) * K + k0 + kk8) = w;
    }
    __syncthreads();
}
DEV void phase_prologue(const P& p, unsigned char* lds, int l_lo, int l_hi, bool with_x, int b0, int nb) {
    float* tile = (float*)lds;
    constexpr int T_WIN = (INP / 128) * (D / 64), T_WOUT = (D / 128) * (D / 64), T_WUP = (DFF2 / 128) * (D / 64), T_WDN = (D / 128) * (DFF / 64);
    constexpr int T_L = T_WIN + T_WOUT + T_WUP + T_WDN, T_X = NTOK * D / 4096;
    const int nw = (l_hi - l_lo) * T_L, total = nw + (with_x ? T_X : 0);
    for (int u = b0; u < total; u += nb) {
        if (u < nw) {
            const int l = l_lo + u / T_L; int r = u % T_L;
            if (r < T_WIN) { const int nt = r / (D / 64), kt = r % (D / 64);
                transpose_tile(p.w_in + (size_t)l * D * IN_DIM, IN_DIM, (bf16_t*)(p.ws + WS_WIN) + (size_t)l * INP * D, D, nt * 128, kt * 64, 1, tile); }
            else if ((r -= T_WIN) < T_WOUT) { const int nt = r / (D / 64), kt = r % (D / 64);
                transpose_tile(p.w_out + (size_t)l * D * D, D, (bf16_t*)(p.ws + WS_WOUT) + (size_t)l * D * D, D, nt * 128, kt * 64, 0, tile); }
            else if ((r -= T_WOUT) < T_WUP) { const int nt = r / (D / 64), kt = r % (D / 64);
                transpose_tile(p.w_up + (size_t)l * D * DFF2, DFF2, (bf16_t*)(p.ws + WS_WUP) + (size_t)l * DFF2 * D, D, nt * 128, kt * 64, 0, tile); }
            else { r -= T_WUP; const int nt = r / (DFF / 64), kt = r % (DFF / 64);
                transpose_tile(p.w_down + (size_t)l * DFF * D, D, (bf16_t*)(p.ws + WS_WDN) + (size_t)l * D * DFF, DFF, nt * 128, kt * 64, 0, tile); }
        } else {
            const size_t e = (size_t)(u - nw) * 4096 + threadIdx.x * 8;
            const float* s = e < (size_t)NPR * D ? p.x_prompt + e : p.x_sample + (e - (size_t)NPR * D);
            const f32x4 a = *(const f32x4*)s, b = *(const f32x4*)(s + 4);
            u32x4 w; w.x = pk2(a[0], a[1]); w.y = pk2(a[2], a[3]); w.z = pk2(b[0], b[1]); w.w = pk2(b[2], b[3]);
            *(u32x4*)((bf16_t*)(p.ws + WS_XB) + e) = w;
        }
    }
}

DEV void mlstm_local(const P& p, int l, int unit, unsigned char* lds) {
    const int bh = unit >> 5, c = unit & 31, b = bh >> 2, h = bh & 3;
    int tid_ = threadIdx.x; asm volatile("" : "+v"(tid_)); const int tid = tid_, lane = tid & 63, w = tid >> 6, fr = lane & 15, fq = lane >> 4;
    const bf16_t* U = (const bf16_t*)(p.ws + WS_U) + (size_t)(b * 2048 + c * 64) * INP;
    float* wsh = (float*)lds;
    bf16_t* KW = (bf16_t*)(lds + 1024);
    bf16_t* V = KW + 64 * 272;
    float* gstat = (float*)(p.ws + WS_GSTAT);
    if (w == 0) {
        const float ig = bf2f(U[(size_t)lane * INP + UIG + h]) + p.b_i[l * 4 + h];
        const float lf = logsigf_(bf2f(U[(size_t)lane * INP + UFG + h]) + p.b_f[l * 4 + h]);
        const float bs = wave_incl_sum(lf, lane);
        const float a = ig - bs;
        const float amax = wave_max(a);
        const float bsum = __shfl(bs, 63);
        wsh[lane] = expf(a - amax);
        if (lane == 0) { gstat[(bh * 32 + c) * 2] = bsum; gstat[(bh * 32 + c) * 2 + 1] = bsum + amax; }
    }
    __syncthreads();
#pragma unroll
    for (int i = 0; i < 4; ++i) {
        const int it = tid + 512 * i, s_ = it >> 5, d8 = (it & 31) * 8;
        const uint4 kv = *(const uint4*)(U + (size_t)s_ * INP + UK + h * 256 + d8);
        const uint4 vv = *(const uint4*)(U + (size_t)s_ * INP + UV + h * 256 + d8);
        const float ws_ = wsh[s_];
        float kf[8]; unpack8(kv, kf);
        u32x4 kw; kw.x = pk2(kf[0] * ws_, kf[1] * ws_); kw.y = pk2(kf[2] * ws_, kf[3] * ws_); kw.z = pk2(kf[4] * ws_, kf[5] * ws_); kw.w = pk2(kf[6] * ws_, kf[7] * ws_);
        *(u32x4*)(KW + s_ * 272 + d8) = kw;
        *(uint4*)(V + s_ * 272 + d8) = vv;
    }
    __syncthreads();
    if (tid < 256) { float a = 0.f; for (int s_ = 0; s_ < 64; ++s_) a += bf2f(KW[s_ * 272 + tid]); ((float*)(p.ws + WS_NLOC))[(size_t)(bh * 32 + c) * 256 + tid] = a; }
    f32x4 acc[2][16];
#pragma unroll
    for (int m = 0; m < 2; ++m)
#pragma unroll
        for (int n = 0; n < 16; ++n) acc[m][n] = (f32x4){0.f, 0.f, 0.f, 0.f};
#pragma unroll
    for (int ks = 0; ks < 2; ++ks) {
        bf16x8 vf[2];
#pragma unroll
        for (int m = 0; m < 2; ++m) vf[m] = tr_frag(V, 272, 32 * ks, 32 * w + 16 * m, lane);
#pragma unroll
        for (int n = 0; n < 16; ++n) {
            const bf16x8 kf = tr_frag(KW, 272, 32 * ks, 16 * n, lane);
#pragma unroll
            for (int m = 0; m < 2; ++m) acc[m][n] = mfma16(kf, vf[m], acc[m][n]);
        }
    }
    bf16_t* Dp = (bf16_t*)(p.ws + WS_DBUF) + (size_t)(bh * 32 + c) * 65536;
#pragma unroll
    for (int m = 0; m < 2; ++m)
#pragma unroll
        for (int n = 0; n < 16; ++n) { u32x2 wv; wv.x = pk2(acc[m][n][0], acc[m][n][1]); wv.y = pk2(acc[m][n][2], acc[m][n][3]);
            *(u32x2*)(Dp + (32 * w + 16 * m + fr) * 256 + 16 * n + fq * 4) = wv; }
    __syncthreads();
}

DEV void mlstm_scan(const P& p, int l, int unit, unsigned char* lds) {
    int tid_ = threadIdx.x; asm volatile("" : "+v"(tid_)); const int bh = unit >> 4, slab = unit & 15, tid = tid_;
    float* fA = (float*)lds; float* fB = fA + 32;
    const float* gstat = (const float*)(p.ws + WS_GSTAT);
    if (tid == 0) {
        float m = 0.f;
        for (int c = 0; c < 32; ++c) {
            const float bsum = gstat[(bh * 32 + c) * 2], mloc = gstat[(bh * 32 + c) * 2 + 1];
            const float mn = fmaxf(bsum + m, mloc);
            fA[c] = expf(bsum + m - mn); fB[c] = expf(mloc - mn); m = mn;
            if (slab == 0) ((float*)(p.ws + WS_MST))[bh * 32 + c] = mn;
        }
        if (slab == 0) p.out[O_PM + l * 16 + bh] = m;
    }
    __syncthreads();
    const size_t e0 = (size_t)slab * 4096 + tid * 8;
    float run[8];
#pragma unroll
    for (int i = 0; i < 8; ++i) run[i] = 0.f;
    const bf16_t* Dp = (const bf16_t*)(p.ws + WS_DBUF) + (size_t)bh * 32 * 65536 + e0;
    bf16_t* Cp = (bf16_t*)(p.ws + WS_CT) + (size_t)bh * 32 * 65536 + e0;
#pragma unroll 1
    for (int cb = 0; cb < 32; cb += 8) {
        uint4 xx[8];
#pragma unroll
        for (int j = 0; j < 8; ++j) xx[j] = *(const uint4*)(Dp + (size_t)(cb + j) * 65536);
#pragma unroll
        for (int j = 0; j < 8; ++j) {
            const int c = cb + j;
            const float a = fA[c], bq = fB[c];
            float xf[8]; unpack8(xx[j], xf);
#pragma unroll
            for (int i = 0; i < 8; ++i) run[i] = a * run[i] + bq * xf[i];
            u32x4 wv; wv.x = pk2(run[0], run[1]); wv.y = pk2(run[2], run[3]); wv.z = pk2(run[4], run[5]); wv.w = pk2(run[6], run[7]);
            *(u32x4*)(Cp + (size_t)c * 65536) = wv;
        }
    }
    {
        float* o = p.out + O_PC + (size_t)(l * 16 + bh) * 65536;
        const int e = (int)(e0 >> 8), d0 = (int)(e0 & 255);
#pragma unroll
        for (int i = 0; i < 8; ++i) o[(d0 + i) * 256 + e] = run[i];
    }
    if (slab == 0 && tid < 256) {
        float r = 0.f;
        const float* nl = (const float*)(p.ws + WS_NLOC) + (size_t)bh * 32 * 256 + tid;
        float* ns = (float*)(p.ws + WS_NST) + (size_t)bh * 32 * 256 + tid;
        for (int c = 0; c < 32; ++c) { r = fA[c] * r + fB[c] * nl[c * 256]; ns[c * 256] = r; }
        p.out[O_PN + (size_t)(l * 16 + bh) * 256 + tid] = r;
    }
    __syncthreads();
}

DEV void ssd_scan(const P& p, int l, int unit, unsigned char* lds) {
    int tid_ = threadIdx.x; asm volatile("" : "+v"(tid_)); const int bhd = unit >> 2, slab = unit & 3, tid = tid_;
    float* dec = (float*)lds;
    if (tid < 32) dec[tid] = expf(((const float*)(p.ws + WS_SBSUM))[bhd * 32 + tid]);
    __syncthreads();
    const size_t e0 = (size_t)slab * 2048 + tid * 4;
    f32x4 run = (f32x4){0.f, 0.f, 0.f, 0.f};
    const bf16_t* Sp = (const bf16_t*)(p.ws + WS_SBUF) + (size_t)bhd * 32 * 8192 + e0;
    bf16_t* Tp = (bf16_t*)(p.ws + WS_ST) + (size_t)bhd * 32 * 8192 + e0;
#pragma unroll 1
    for (int cb = 0; cb < 32; cb += 8) {
        uint2 xx[8];
#pragma unroll
        for (int j = 0; j < 8; ++j) xx[j] = *(const uint2*)(Sp + (size_t)(cb + j) * 8192);
#pragma unroll
        for (int j = 0; j < 8; ++j) {
            run = run * dec[cb + j] + (f32x4){bflo(xx[j].x), bfhi(xx[j].x), bflo(xx[j].y), bfhi(xx[j].y)};
            u32x2 wv; wv.x = pk2(run[0], run[1]); wv.y = pk2(run[2], run[3]);
            *(u32x2*)(Tp + (size_t)(cb + j) * 8192) = wv;
        }
    }
    *(f32x4*)(p.out + O_PS + (size_t)(l * 64 + bhd) * 8192 + e0) = run;
    __syncthreads();
}

DEV void convstate_copy(const P& p, int l, int unit) {
    const bf16_t* Ub = (const bf16_t*)(p.ws + WS_U);
    int tid_ = threadIdx.x; asm volatile("" : "+v"(tid_));
    for (int i = tid_; i < 3 * 1536; i += NTHR) {
        const int j = i / 1536, ch = i % 1536;
        if (unit < 4) p.out[O_PSC + ((size_t)(l * 4 + unit) * 3 + j) * 1536 + ch] = bf2f(Ub[(size_t)(unit * 2048 + 2045 + j) * INP + UXS + ch]);
        else { const int b = unit - 4; p.out[O_SSC + ((size_t)(l * 128 + b) * 3 + j) * 1536 + ch] = bf2f(Ub[(size_t)(NPR + b * 8 + 5 + j) * INP + UXS + ch]); }
    }
}

DEV void mlstm_out(const P& p, int l, int unit, unsigned char* lds) {
    const int bh = unit >> 5, c = unit & 31, b = bh >> 2, h = bh & 3;
    int tid_ = threadIdx.x; asm volatile("" : "+v"(tid_)); const int tid = tid_, lane = tid & 63, w = tid >> 6, fr = lane & 15, fq = lane >> 4;
    const int r0 = b * 2048 + c * 64;
    const bf16_t* U = (const bf16_t*)(p.ws + WS_U) + (size_t)r0 * INP;
    bf16_t* Qs = (bf16_t*)lds;
    bf16_t* Ks = Qs + 64 * 264;
    bf16_t* V = Ks + 64 * 264;
    bf16_t* Ss = V + 64 * 272;
    float* fl = (float*)(lds + 113664);
    float* bsh = fl; float* ash = fl + 64; float* mth = fl + 128; float* wint = fl + 192; float* rdn = fl + 256; float* qn = fl + 320; float* nprev = fl + 384; float* red = fl + 640;
    float* stat = fl + 1152;
    if (w == 0) {
        const float ig = bf2f(U[(size_t)lane * INP + UIG + h]) + p.b_i[l * 4 + h];
        const float lf = logsigf_(bf2f(U[(size_t)lane * INP + UFG + h]) + p.b_f[l * 4 + h]);
        const float bs = wave_incl_sum(lf, lane);
        const float a = ig - bs;
        const float cm = wave_incl_max(a, lane);
        const float mprev = c > 0 ? ((const float*)(p.ws + WS_MST))[bh * 32 + c - 1] : 0.f;
        const float mt = bs + fmaxf(mprev, cm);
        bsh[lane] = bs; ash[lane] = a; mth[lane] = mt; wint[lane] = expf(bs + mprev - mt);
    }
    if (tid >= 256) { const int d = tid - 256; nprev[d] = c > 0 ? ((const float*)(p.ws + WS_NST))[(size_t)(bh * 32 + c - 1) * 256 + d] : 0.f; }
#pragma unroll
    for (int i = 0; i < 4; ++i) {
        const int it = tid + 512 * i, s_ = it >> 5, d8 = (it & 31) * 8;
        *(uint4*)(Qs + s_ * 264 + d8) = *(const uint4*)(U + (size_t)s_ * INP + UQ + h * 256 + d8);
        *(uint4*)(Ks + s_ * 264 + d8) = *(const uint4*)(U + (size_t)s_ * INP + UK + h * 256 + d8);
        *(uint4*)(V + s_ * 272 + d8) = *(const uint4*)(U + (size_t)s_ * INP + UV + h * 256 + d8);
    }
    __syncthreads();
    {
        const int mt_ = w >> 1, nt0 = (w & 1) * 2;
        f32x4 sacc[2] = {(f32x4){0.f, 0.f, 0.f, 0.f}, (f32x4){0.f, 0.f, 0.f, 0.f}};
#pragma unroll
        for (int k0 = 0; k0 < 256; k0 += 32) {
            const bf16x8 a = *(const bf16x8*)(Qs + (16 * mt_ + fr) * 264 + k0 + fq * 8);
#pragma unroll
            for (int n = 0; n < 2; ++n) { const bf16x8 bb = *(const bf16x8*)(Ks + (16 * (nt0 + n) + fr) * 264 + k0 + fq * 8); sacc[n] = mfma16(a, bb, sacc[n]); }
        }
#pragma unroll
        for (int n = 0; n < 2; ++n)
#pragma unroll
            for (int j = 0; j < 4; ++j) {
                const int t = 16 * mt_ + fq * 4 + j, s_ = 16 * (nt0 + n) + fr;
                const float val = (s_ <= t) ? sacc[n][j] * expf(bsh[t] - mth[t] + ash[s_]) : 0.f;
                Ss[t * 72 + s_] = f2bf(val);
            }
        const int t = tid >> 3, part = tid & 7;
        float a = 0.f;
        for (int d = part * 32; d < part * 32 + 32; ++d) a += bf2f(Qs[t * 264 + d]) * nprev[d];
        a += __shfl_xor(a, 1); a += __shfl_xor(a, 2); a += __shfl_xor(a, 4);
        if (part == 0) qn[t] = a;
    }
    __syncthreads();
    if (tid < 64) {
        float di = 0.f;
        for (int s_ = 0; s_ < 64; ++s_) di += bf2f(Ss[tid * 72 + s_]);
        const float den = di + wint[tid] * qn[tid];
        rdn[tid] = 1.0f / fmaxf(fabsf(den), expf(-mth[tid]));
    }
    const int e0 = 32 * w;
    f32x4 acc1[4][2], acc2[4][2];
#pragma unroll
    for (int m = 0; m < 4; ++m)
#pragma unroll
        for (int n = 0; n < 2; ++n) { acc1[m][n] = (f32x4){0.f, 0.f, 0.f, 0.f}; acc2[m][n] = (f32x4){0.f, 0.f, 0.f, 0.f}; }
#pragma unroll
    for (int ks = 0; ks < 2; ++ks) {
        bf16x8 sf[4];
#pragma unroll
        for (int m = 0; m < 4; ++m) sf[m] = *(const bf16x8*)(Ss + (16 * m + fr) * 72 + 32 * ks + fq * 8);
#pragma unroll
        for (int n = 0; n < 2; ++n) { const bf16x8 vf = tr_frag(V, 272, 32 * ks, e0 + 16 * n, lane);
#pragma unroll
            for (int m = 0; m < 4; ++m) acc1[m][n] = mfma16(vf, sf[m], acc1[m][n]); }
    }
    if (c > 0) {
        const bf16_t* CTp = (const bf16_t*)(p.ws + WS_CT) + (size_t)(bh * 32 + c - 1) * 65536;
#pragma unroll 2
        for (int k0 = 0; k0 < 256; k0 += 32) {
            bf16x8 a[4];
#pragma unroll
            for (int m = 0; m < 4; ++m) a[m] = *(const bf16x8*)(Qs + (16 * m + fr) * 264 + k0 + fq * 8);
#pragma unroll
            for (int n = 0; n < 2; ++n) { const bf16x8 cf = *(const bf16x8*)(CTp + (size_t)(e0 + 16 * n + fr) * 256 + k0 + fq * 8);
#pragma unroll
                for (int m = 0; m < 4; ++m) acc2[m][n] = mfma16(cf, a[m], acc2[m][n]); }
        }
    }
    __syncthreads();
#pragma unroll
    for (int m = 0; m < 4; ++m) {
        const int t = 16 * m + fr;
        const float wi = wint[t], rd = rdn[t];
        float sm = 0.f;
#pragma unroll
        for (int n = 0; n < 2; ++n)
#pragma unroll
            for (int j = 0; j < 4; ++j) { const float hv = (acc1[m][n][j] + wi * acc2[m][n][j]) * rd; acc1[m][n][j] = hv; sm += hv; }
        sm += __shfl_xor(sm, 16); sm += __shfl_xor(sm, 32);
        if (fq == 0) red[t * 8 + w] = sm;
    }
    __syncthreads();
    if (tid < 64) { float sm = 0.f;
#pragma unroll
        for (int i = 0; i < 8; ++i) sm += red[tid * 8 + i];
        stat[tid] = sm * (1.0f / 256.0f); }
    __syncthreads();
#pragma unroll
    for (int m = 0; m < 4; ++m) {
        const int t = 16 * m + fr;
        const float mu = stat[t];
        float sm = 0.f;
#pragma unroll
        for (int n = 0; n < 2; ++n)
#pragma unroll
            for (int j = 0; j < 4; ++j) { const float dv = acc1[m][n][j] - mu; acc1[m][n][j] = dv; sm += dv * dv; }
        sm += __shfl_xor(sm, 16); sm += __shfl_xor(sm, 32);
        if (fq == 0) red[t * 8 + w] = sm;
    }
    __syncthreads();
    if (tid < 64) { float sm = 0.f;
#pragma unroll
        for (int i = 0; i < 8; ++i) sm += red[tid * 8 + i];
        stat[64 + tid] = rsqrtf(sm * (1.0f / 256.0f) + 1e-6f); }
    __syncthreads();
    bf16_t* MX = (bf16_t*)(p.ws + WS_MIXIN);
#pragma unroll
    for (int m = 0; m < 4; ++m) {
        const int t = 16 * m + fr;
        const float rs = stat[64 + t];
#pragma unroll
        for (int n = 0; n < 2; ++n) {
            const int e4 = e0 + 16 * n + fq * 4;
            const uint2 ov = *(const uint2*)(U + (size_t)t * INP + UO + h * 256 + e4);
            const f32x4 nw = *(const f32x4*)(p.m_norm_w + l * 1024 + h * 256 + e4);
            u32x2 wv;
            wv.x = pk2(acc1[m][n][0] * rs * nw[0] * sigmoidf_(bflo(ov.x)), acc1[m][n][1] * rs * nw[1] * sigmoidf_(bfhi(ov.x)));
            wv.y = pk2(acc1[m][n][2] * rs * nw[2] * sigmoidf_(bflo(ov.y)), acc1[m][n][3] * rs * nw[3] * sigmoidf_(bfhi(ov.y)));
            *(u32x2*)(MX + (size_t)(r0 + t) * D + h * 256 + e4) = wv;
        }
    }
    __syncthreads();
}

DEV void ssd_conv8(const bf16_t* Urow, int tpos, const float* cw, const float* cb, int ch8, float (&o)[8]) {
    const f32x4 b0 = *(const f32x4*)(cb + ch8), b1 = *(const f32x4*)(cb + ch8 + 4);
    o[0] = b0[0]; o[1] = b0[1]; o[2] = b0[2]; o[3] = b0[3]; o[4] = b1[0]; o[5] = b1[1]; o[6] = b1[2]; o[7] = b1[3];
#pragma unroll
    for (int j = 0; j < 4; ++j) {
        const int back = 3 - j;
        if (tpos - back >= 0) {
            const uint4 x = *(const uint4*)(Urow - (size_t)back * INP + UXS + ch8);
            float xf[8]; unpack8(x, xf);
            const f32x4 w0 = *(const f32x4*)(cw + j * 1536 + ch8), w1 = *(const f32x4*)(cw + j * 1536 + ch8 + 4);
            o[0] += w0[0] * xf[0]; o[1] += w0[1] * xf[1]; o[2] += w0[2] * xf[2]; o[3] += w0[3] * xf[3];
            o[4] += w1[0] * xf[4]; o[5] += w1[1] * xf[5]; o[6] += w1[2] * xf[6]; o[7] += w1[3] * xf[7];
        }
    }
#pragma unroll
    for (int i = 0; i < 8; ++i) o[i] = siluf_(o[i]);
}

DEV void ssd_local(const P& p, int l, int unit, unsigned char* lds) {
    const int b = unit >> 6, g = (unit >> 5) & 1, c = unit & 31;
    int tid_ = threadIdx.x; asm volatile("" : "+v"(tid_)); const int tid = tid_, lane = tid & 63, w = tid >> 6, fr = lane & 15, fq = lane >> 4;
    const int r0 = b * 2048 + c * 64;
    const bf16_t* U = (const bf16_t*)(p.ws + WS_U) + (size_t)r0 * INP;
    bf16_t* XW = (bf16_t*)lds;
    bf16_t* Bmn = XW + 64 * 528;
    float* wsh = (float*)(lds + 86016);
    {
        const int head = g * 8 + w;
        const float dt = softplusf_(bf2f(U[(size_t)lane * INP + UDT + head]) + p.dt_bias[l * 16 + head]);
        const float a = -expf(p.A_log[l * 16 + head]) * dt;
        const float bs = wave_incl_sum(a, lane);
        const float bL = __shfl(bs, 63);
        wsh[w * 64 + lane] = expf(bL - bs) * dt;
        if (lane == 0) ((float*)(p.ws + WS_SBSUM))[(b * 16 + head) * 32 + c] = bL;
    }
    __syncthreads();
    const float* cw = p.s_conv_w + (size_t)l * 4 * 1536; const float* cb = p.s_conv_b + (size_t)l * 1536;
    bf16_t* XBC = (bf16_t*)(p.ws + WS_XBC) + (size_t)r0 * 1536;
    for (int i = 0; i < 12; ++i) {
        const int it = tid + 512 * i, t = it / 96, gidx = it % 96;
        const int ch8 = gidx < 64 ? g * 512 + gidx * 8 : (gidx < 80 ? 1024 + g * 128 + (gidx - 64) * 8 : 1280 + g * 128 + (gidx - 80) * 8);
        float v[8];
        ssd_conv8(U + (size_t)t * INP, c * 64 + t, cw, cb, ch8, v);
        { u32x4 wr_; wr_.x = pk2(v[0], v[1]); wr_.y = pk2(v[2], v[3]); wr_.z = pk2(v[4], v[5]); wr_.w = pk2(v[6], v[7]); *(u32x4*)(XBC + (size_t)t * 1536 + ch8) = wr_; }
        if (gidx >= 80) continue;
        if (gidx < 64) { const float sc = wsh[(gidx >> 3) * 64 + t];
            u32x4 wv; wv.x = pk2(v[0] * sc, v[1] * sc); wv.y = pk2(v[2] * sc, v[3] * sc); wv.z = pk2(v[4] * sc, v[5] * sc); wv.w = pk2(v[6] * sc, v[7] * sc);
            *(u32x4*)(XW + t * 528 + gidx * 8) = wv; }
        else { u32x4 wv; wv.x = pk2(v[0], v[1]); wv.y = pk2(v[2], v[3]); wv.z = pk2(v[4], v[5]); wv.w = pk2(v[6], v[7]);
            *(u32x4*)(Bmn + t * 144 + (gidx - 64) * 8) = wv; }
    }
    __syncthreads();
    f32x4 acc[4][8];
#pragma unroll
    for (int m = 0; m < 4; ++m)
#pragma unroll
        for (int n = 0; n < 8; ++n) acc[m][n] = (f32x4){0.f, 0.f, 0.f, 0.f};
#pragma unroll
    for (int ks = 0; ks < 2; ++ks) {
        bf16x8 xf[4];
#pragma unroll
        for (int m = 0; m < 4; ++m) xf[m] = tr_frag(XW, 528, 32 * ks, 64 * w + 16 * m, lane);
#pragma unroll
        for (int n = 0; n < 8; ++n) { const bf16x8 bf_ = tr_frag(Bmn, 144, 32 * ks, 16 * n, lane);
#pragma unroll
            for (int m = 0; m < 4; ++m) acc[m][n] = mfma16(bf_, xf[m], acc[m][n]); }
    }
    bf16_t* Sp = (bf16_t*)(p.ws + WS_SBUF) + (size_t)((b * 16 + g * 8 + w) * 32 + c) * 8192;
#pragma unroll
    for (int m = 0; m < 4; ++m)
#pragma unroll
        for (int n = 0; n < 8; ++n) { u32x2 wv; wv.x = pk2(acc[m][n][0], acc[m][n][1]); wv.y = pk2(acc[m][n][2], acc[m][n][3]); *(u32x2*)(Sp + (16 * m + fr) * 128 + 16 * n + fq * 4) = wv; }
    __syncthreads();
}

DEV void ssd_out(const P& p, int l, int unit, unsigned char* lds) {
    const int b = unit >> 6, g = (unit >> 5) & 1, c = unit & 31;
    int tid_ = threadIdx.x; asm volatile("" : "+v"(tid_)); const int tid = tid_, lane = tid & 63, w = tid >> 6, fr = lane & 15, fq = lane >> 4;
    const int r0 = b * 2048 + c * 64;
    const bf16_t* U = (const bf16_t*)(p.ws + WS_U) + (size_t)r0 * INP;
    bf16_t* Xs = (bf16_t*)lds;
    bf16_t* Bm = Xs + 64 * 528;
    bf16_t* Cm = Bm + 64 * 136;
    float* CB = (float*)(lds + 102400);
    float* bsh = (float*)(lds + 119808);
    float* dtsh = bsh + 512;
    float* red = dtsh + 512;
    float* stat = red + 512;
    const int head = g * 8 + w;
    {
        const float dt = softplusf_(bf2f(U[(size_t)lane * INP + UDT + head]) + p.dt_bias[l * 16 + head]);
        const float a = -expf(p.A_log[l * 16 + head]) * dt;
        const float bs = wave_incl_sum(a, lane);
        bsh[w * 64 + lane] = bs; dtsh[w * 64 + lane] = dt;
    }
    const bf16_t* XBC = (const bf16_t*)(p.ws + WS_XBC) + (size_t)r0 * 1536;
#pragma unroll
    for (int i = 0; i < 12; ++i) {
        const int it = tid + 512 * i, t = it / 96, gidx = it % 96;
        const int ch8 = gidx < 64 ? g * 512 + gidx * 8 : (gidx < 80 ? 1024 + g * 128 + (gidx - 64) * 8 : 1280 + g * 128 + (gidx - 80) * 8);
        const u32x4 wv = *(const u32x4*)(XBC + (size_t)t * 1536 + ch8);
        if (gidx < 64) *(u32x4*)(Xs + t * 528 + gidx * 8) = wv;
        else if (gidx < 80) *(u32x4*)(Bm + t * 136 + (gidx - 64) * 8) = wv;
        else *(u32x4*)(Cm + t * 136 + (gidx - 80) * 8) = wv;
    }
    __syncthreads();
    {
        const int mt_ = w >> 1, nt0 = (w & 1) * 2;
        f32x4 cacc[2] = {(f32x4){0.f, 0.f, 0.f, 0.f}, (f32x4){0.f, 0.f, 0.f, 0.f}};
#pragma unroll
        for (int k0 = 0; k0 < 128; k0 += 32) {
            const bf16x8 a = *(const bf16x8*)(Cm + (16 * mt_ + fr) * 136 + k0 + fq * 8);
#pragma unroll
            for (int n = 0; n < 2; ++n) { const bf16x8 bb = *(const bf16x8*)(Bm + (16 * (nt0 + n) + fr) * 136 + k0 + fq * 8); cacc[n] = mfma16(a, bb, cacc[n]); }
        }
#pragma unroll
        for (int n = 0; n < 2; ++n)
#pragma unroll
            for (int j = 0; j < 4; ++j) CB[(16 * mt_ + fq * 4 + j) * 68 + 16 * (nt0 + n) + fr] = cacc[n][j];
    }
    __syncthreads();
    f32x4 acc1[4][4], acc2[4][4];
#pragma unroll
    for (int m = 0; m < 4; ++m)
#pragma unroll
        for (int n = 0; n < 4; ++n) { acc1[m][n] = (f32x4){0.f, 0.f, 0.f, 0.f}; acc2[m][n] = (f32x4){0.f, 0.f, 0.f, 0.f}; }
#pragma unroll
    for (int ks = 0; ks < 2; ++ks) {
        bf16x8 xf[4];
#pragma unroll
        for (int n = 0; n < 4; ++n) xf[n] = tr_frag(Xs, 528, 32 * ks, 64 * w + 16 * n, lane);
#pragma unroll
        for (int m = 0; m < 4; ++m) {
            if (ks * 32 > 16 * m + 15) continue;
            const int t = 16 * m + fr, s0 = 32 * ks + fq * 8;
            const float bt = bsh[w * 64 + t];
            const f32x4 c0 = *(const f32x4*)(CB + t * 68 + s0), c1 = *(const f32x4*)(CB + t * 68 + s0 + 4);
            float mv[8];
#pragma unroll
            for (int i = 0; i < 8; ++i) { const int s_ = s0 + i; const float cv = i < 4 ? c0[i & 3] : c1[i & 3];
                mv[i] = (s_ <= t) ? cv * expf(bt - bsh[w * 64 + s_]) * dtsh[w * 64 + s_] : 0.f; }
            union { u32x4 u; bf16x8 v; } af;
            af.u.x = pk2(mv[0], mv[1]); af.u.y = pk2(mv[2], mv[3]); af.u.z = pk2(mv[4], mv[5]); af.u.w = pk2(mv[6], mv[7]);
#pragma unroll
            for (int n = 0; n < 4; ++n) acc1[m][n] = mfma16(xf[n], af.v, acc1[m][n]);
        }
    }
    if (c > 0) {
        const bf16_t* STp = (const bf16_t*)(p.ws + WS_ST) + (size_t)((b * 16 + head) * 32 + c - 1) * 8192;
#pragma unroll
        for (int k0 = 0; k0 < 128; k0 += 32) {
            bf16x8 a[4];
#pragma unroll
            for (int m = 0; m < 4; ++m) a[m] = *(const bf16x8*)(Cm + (16 * m + fr) * 136 + k0 + fq * 8);
#pragma unroll
            for (int n = 0; n < 4; ++n) { const bf16x8 sf = *(const bf16x8*)(STp + (16 * n + fr) * 128 + k0 + fq * 8);
#pragma unroll
                for (int m = 0; m < 4; ++m) acc2[m][n] = mfma16(sf, a[m], acc2[m][n]); }
        }
    }
    const float dsk = p.D_skip[l * 16 + head];
#pragma unroll
    for (int m = 0; m < 4; ++m) {
        const int t = 16 * m + fr;
        const float eb = expf(bsh[w * 64 + t]);
        float sm = 0.f;
#pragma unroll
        for (int n = 0; n < 4; ++n) {
            const int pp4 = 16 * n + fq * 4;
            const uint2 xv = *(const uint2*)(Xs + t * 528 + 64 * w + pp4);
            const uint2 zv = *(const uint2*)(U + (size_t)t * INP + UZ + g * 512 + w * 64 + pp4);
            const float xs4[4] = {bflo(xv.x), bfhi(xv.x), bflo(xv.y), bfhi(xv.y)};
            const float z4[4] = {bflo(zv.x), bfhi(zv.x), bflo(zv.y), bfhi(zv.y)};
#pragma unroll
            for (int j = 0; j < 4; ++j) {
                const float y = acc1[m][n][j] + eb * acc2[m][n][j] + dsk * xs4[j];
                const float gt = y * z4[j] * sigmoidf_(z4[j]);
                acc1[m][n][j] = gt; sm += gt * gt;
            }
        }
        sm += __shfl_xor(sm, 16); sm += __shfl_xor(sm, 32);
        if (fq == 0) red[t * 8 + w] = sm;
    }
    __syncthreads();
    if (tid < 64) { float sm = 0.f;
#pragma unroll
        for (int i = 0; i < 8; ++i) sm += red[tid * 8 + i];
        stat[tid] = rsqrtf(sm * (1.0f / 512.0f) + 1e-6f); }
    __syncthreads();
    bf16_t* MX = (bf16_t*)(p.ws + WS_MIXIN);
#pragma unroll
    for (int m = 0; m < 4; ++m) {
        const int t = 16 * m + fr;
        const float rs = stat[t];
#pragma unroll
        for (int n = 0; n < 4; ++n) {
            const int ch = g * 512 + w * 64 + 16 * n + fq * 4;
            const f32x4 nw = *(const f32x4*)(p.s_norm_w + l * 1024 + ch);
            u32x2 wv; wv.x = pk2(acc1[m][n][0] * rs * nw[0], acc1[m][n][1] * rs * nw[1]); wv.y = pk2(acc1[m][n][2] * rs * nw[2], acc1[m][n][3] * rs * nw[3]);
            *(u32x2*)(MX + (size_t)(r0 + t) * D + 1024 + ch) = wv;
        }
    }
    __syncthreads();
}

DEV void smp_mlstm(const P& p, int l, int unit, unsigned char* lds) {
    const int b = unit >> 2, h = unit & 3;
    int tid_ = threadIdx.x; asm volatile("" : "+v"(tid_)); const int tid = tid_, lane = tid & 63, w = tid >> 6;
    const int r0 = NPR + b * 8;
    const bf16_t* U = (const bf16_t*)(p.ws + WS_U) + (size_t)r0 * INP;
    float* qn = (float*)lds; float* kn = qn + 2048; float* vn = kn + 2048; float* qT = vn + 2048; float* kwT = qT + 2048; float* sc = kwT + 2048; float* red = sc + 256;
    const size_t sidx = (size_t)(l * 128 + b) * 4 + h;
    const float* C0 = p.st_C + sidx * 65536; const float* n0 = p.st_n + sidx * 256;
    float* Cout = p.out + O_SC + sidx * 65536;
    if (tid == 0) {
        const float m0 = p.st_m[sidx];
        float bs = 0.f, cm = -INFINITY, mt = 0.f;
        for (int t = 0; t < 8; ++t) {
            const float ig = bf2f(U[(size_t)t * INP + UIG + h]) + p.b_i[l * 4 + h];
            const float lf = logsigf_(bf2f(U[(size_t)t * INP + UFG + h]) + p.b_f[l * 4 + h]);
            bs += lf; const float a = ig - bs; cm = fmaxf(cm, a); mt = bs + fmaxf(m0, cm);
            sc[32 + t] = mt; sc[t] = expf(bs + m0 - mt); sc[40 + t] = a; sc[48 + t] = bs;
        }
        for (int s = 0; s < 8; ++s) sc[16 + s] = expf(bs + sc[40 + s] - mt);
        sc[24] = expf(bs + m0 - mt);
        p.out[O_SM + sidx] = mt;
    }
    __syncthreads();
#pragma unroll
    for (int i = 0; i < 4; ++i) {
        const int idx = tid + 512 * i, t = idx >> 8, d = idx & 255;
        const float q = bf2f(U[(size_t)t * INP + UQ + h * 256 + d]), k = bf2f(U[(size_t)t * INP + UK + h * 256 + d]), v = bf2f(U[(size_t)t * INP + UV + h * 256 + d]);
        qn[t * 256 + d] = q; kn[t * 256 + d] = k; vn[t * 256 + d] = v; qT[d * 8 + t] = q; kwT[d * 8 + t] = k * sc[16 + t];
    }
    __syncthreads();
    {
        const int t = w;
        const f32x4 qv = *(const f32x4*)(qn + t * 256 + lane * 4);
        float dot[9];
#pragma unroll
        for (int s = 0; s < 8; ++s) { const f32x4 kv = *(const f32x4*)(kn + s * 256 + lane * 4); dot[s] = qv[0] * kv[0] + qv[1] * kv[1] + qv[2] * kv[2] + qv[3] * kv[3]; }
        { const f32x4 nv = *(const f32x4*)(n0 + lane * 4); dot[8] = qv[0] * nv[0] + qv[1] * nv[1] + qv[2] * nv[2] + qv[3] * nv[3]; }
#pragma unroll
        for (int s = 0; s < 9; ++s) dot[s] = wave_sum(dot[s]);
        float den = 0.f;
#pragma unroll
        for (int s = 0; s < 8; ++s) { const float sv = (s <= t) ? dot[s] * expf(sc[48 + t] - sc[32 + t] + sc[40 + s]) : 0.f; den += sv; if (lane == 0) sc[64 + t * 8 + s] = sv; }
        den += sc[t] * dot[8];
        if (lane == 0) sc[8 + t] = 1.0f / fmaxf(fabsf(den), expf(-sc[32 + t]));
    }
    if (tid < 256) {
        float a = sc[24] * n0[tid];
#pragma unroll
        for (int s = 0; s < 8; ++s) a += kwT[tid * 8 + s];
        p.out[O_SN + sidx * 256 + tid] = a;
    }
    const int e4 = lane * 4;
    f32x4 num[8], vv[8];
#pragma unroll
    for (int t = 0; t < 8; ++t) { num[t] = (f32x4){0.f, 0.f, 0.f, 0.f}; vv[t] = *(const f32x4*)(vn + t * 256 + e4); }
    const float decay = sc[24];
    {
        f32x4 cn_[8];
#pragma unroll
        for (int j = 0; j < 8; ++j) cn_[j] = __builtin_nontemporal_load((const f32x4*)(C0 + (size_t)(w + 8 * j) * 256 + e4));
#pragma unroll 1
        for (int ib = 0; ib < 4; ++ib) {
            f32x4 cc[8];
#pragma unroll
            for (int j = 0; j < 8; ++j) cc[j] = cn_[j];
            if (ib < 3) {
#pragma unroll
                for (int j = 0; j < 8; ++j) cn_[j] = __builtin_nontemporal_load((const f32x4*)(C0 + (size_t)(w + 8 * ((ib + 1) * 8 + j)) * 256 + e4));
            }
#pragma unroll
            for (int j = 0; j < 8; ++j) {
                const int d = w + 8 * (ib * 8 + j);
                const f32x4 q0 = *(const f32x4*)(qT + d * 8), q1 = *(const f32x4*)(qT + d * 8 + 4), k0 = *(const f32x4*)(kwT + d * 8), k1 = *(const f32x4*)(kwT + d * 8 + 4);
                f32x4 cn = cc[j] * decay;
#pragma unroll
                for (int t = 0; t < 4; ++t) { num[t] += cc[j] * q0[t]; num[4 + t] += cc[j] * q1[t]; cn += vv[t] * k0[t]; cn += vv[4 + t] * k1[t]; }
                __builtin_nontemporal_store(cn, (f32x4*)(Cout + (size_t)d * 256 + e4));
            }
        }
    }
#pragma unroll
    for (int t = 0; t < 8; ++t) *(f32x4*)(red + (w * 8 + t) * 256 + e4) = num[t];
    __syncthreads();
    {
        const int t = w;
        f32x4 hv = (f32x4){0.f, 0.f, 0.f, 0.f};
#pragma unroll
        for (int ww = 0; ww < 8; ++ww) hv += *(const f32x4*)(red + (ww * 8 + t) * 256 + e4);
        hv = hv * sc[t];
#pragma unroll
        for (int s = 0; s < 8; ++s) hv += vv[s] * sc[64 + t * 8 + s];
        hv = hv * sc[8 + t];
        const float mu = wave_sum(hv[0] + hv[1] + hv[2] + hv[3]) * (1.0f / 256.0f);
        const f32x4 dv = hv - mu;
        const float var = wave_sum(dv[0] * dv[0] + dv[1] * dv[1] + dv[2] * dv[2] + dv[3] * dv[3]) * (1.0f / 256.0f);
        const float rs = rsqrtf(var + 1e-6f);
        const uint2 ov = *(const uint2*)(U + (size_t)t * INP + UO + h * 256 + e4);
        const f32x4 nw = *(const f32x4*)(p.m_norm_w + l * 1024 + h * 256 + e4);
        const float o0 = dv[0] * rs * nw[0] * sigmoidf_(bflo(ov.x)), o1 = dv[1] * rs * nw[1] * sigmoidf_(bfhi(ov.x));
        const float o2 = dv[2] * rs * nw[2] * sigmoidf_(bflo(ov.y)), o3 = dv[3] * rs * nw[3] * sigmoidf_(bfhi(ov.y));
        u32x2 wv; wv.x = pk2(o0, o1); wv.y = pk2(o2, o3);
        *(u32x2*)((bf16_t*)(p.ws + WS_MIXIN) + (size_t)(r0 + t) * D + h * 256 + e4) = wv;
    }
    __syncthreads();
}

DEV void smp_ssd(const P& p, int l, int unit, unsigned char* lds) {
    const int b = unit >> 1, g = unit & 1;
    int tid_ = threadIdx.x; asm volatile("" : "+v"(tid_)); const int tid = tid_, lane = tid & 63, w = tid >> 6, fr = lane & 15, fq = lane >> 4;
    const int r0 = NPR + b * 8;
    const bf16_t* U = (const bf16_t*)(p.ws + WS_U) + (size_t)r0 * INP;
    float* xs = (float*)lds;
    float* xwT = xs + 4096;
    float* Bmf = xwT + 4096;
    float* CBs = Bmf + 1024;
    float* bsh = CBs + 64;
    float* dtsh = bsh + 64;
    float* bLs = dtsh + 64;
    float* MW = bLs + 64;
    float* red = MW + 512;
    float* stat = red + 64;
    bf16_t* Cmb = (bf16_t*)(stat + 64);
    if (tid < 64) {
        const int hd = tid >> 3, t = tid & 7, head = g * 8 + hd;
        const float A = -expf(p.A_log[l * 16 + head]), dtb = p.dt_bias[l * 16 + head];
        float bs = 0.f, bL = 0.f, dtt = 0.f;
        for (int s = 0; s < 8; ++s) { const float dt = softplusf_(bf2f(U[(size_t)s * INP + UDT + head]) + dtb); bL += dt * A; if (s <= t) bs += dt * A; if (s == t) dtt = dt; }
        bsh[hd * 8 + t] = bs; dtsh[hd * 8 + t] = dtt; if (t == 0) bLs[hd] = bL;
    }
    for (int i = tid; i < 8 * 136 / 2; i += NTHR) ((unsigned*)(Cmb + 8 * 136))[i] = 0u;
    const float* cw = p.s_conv_w + (size_t)l * 4 * 1536; const float* cb = p.s_conv_b + (size_t)l * 1536;
    const float* cv0 = p.st_sconv + (size_t)(l * 128 + b) * 3 * 1536;
    for (int i = 0; i < 2; ++i) {
        const int it = tid + 512 * i;
        if (it < 768) {
            const int t = it / 96, gidx = it % 96;
            const int ch8 = gidx < 64 ? g * 512 + gidx * 8 : (gidx < 80 ? 1024 + g * 128 + (gidx - 64) * 8 : 1280 + g * 128 + (gidx - 80) * 8);
            float o[8];
            { const f32x4 b0 = *(const f32x4*)(cb + ch8), b1 = *(const f32x4*)(cb + ch8 + 4); o[0] = b0[0]; o[1] = b0[1]; o[2] = b0[2]; o[3] = b0[3]; o[4] = b1[0]; o[5] = b1[1]; o[6] = b1[2]; o[7] = b1[3]; }
#pragma unroll
            for (int j = 0; j < 4; ++j) {
                const int idx = t + j;
                float xf[8];
                if (idx < 3) { const f32x4 a0 = *(const f32x4*)(cv0 + idx * 1536 + ch8), a1 = *(const f32x4*)(cv0 + idx * 1536 + ch8 + 4);
                    xf[0] = a0[0]; xf[1] = a0[1]; xf[2] = a0[2]; xf[3] = a0[3]; xf[4] = a1[0]; xf[5] = a1[1]; xf[6] = a1[2]; xf[7] = a1[3]; }
                else { const uint4 x = *(const uint4*)(U + (size_t)(idx - 3) * INP + UXS + ch8); unpack8(x, xf); }
                const f32x4 w0 = *(const f32x4*)(cw + j * 1536 + ch8), w1 = *(const f32x4*)(cw + j * 1536 + ch8 + 4);
                o[0] += w0[0] * xf[0]; o[1] += w0[1] * xf[1]; o[2] += w0[2] * xf[2]; o[3] += w0[3] * xf[3];
                o[4] += w1[0] * xf[4]; o[5] += w1[1] * xf[5]; o[6] += w1[2] * xf[6]; o[7] += w1[3] * xf[7];
            }
#pragma unroll
            for (int k = 0; k < 8; ++k) o[k] = siluf_(o[k]);
            if (gidx < 64) {
#pragma unroll
                for (int k = 0; k < 8; ++k) xs[t * 512 + gidx * 8 + k] = o[k]; }
            else if (gidx < 80) {
#pragma unroll
                for (int k = 0; k < 8; ++k) Bmf[t * 128 + (gidx - 64) * 8 + k] = o[k]; }
            else { u32x4 wv; wv.x = pk2(o[0], o[1]); wv.y = pk2(o[2], o[3]); wv.z = pk2(o[4], o[5]); wv.w = pk2(o[6], o[7]); *(u32x4*)(Cmb + t * 136 + (gidx - 80) * 8) = wv; }
        }
    }
    __syncthreads();
#pragma unroll
    for (int i = 0; i < 8; ++i) {
        const int idx = tid + 512 * i, hp = idx >> 3, s = idx & 7, hd = hp >> 6;
        xwT[hp * 8 + s] = xs[s * 512 + hp] * expf(bLs[hd] - bsh[hd * 8 + s]) * dtsh[hd * 8 + s];
    }
    if (tid < 64) {
        const int t = tid >> 3, s = tid & 7; float a = 0.f;
        for (int n = 0; n < 128; ++n) a += bf2f(Cmb[t * 136 + n]) * Bmf[s * 128 + n];
        CBs[t * 8 + s] = a;
    }
    __syncthreads();
    { const int hd = tid >> 6, t = (tid >> 3) & 7, s = tid & 7;
      MW[tid] = (s <= t) ? CBs[t * 8 + s] * expf(bsh[hd * 8 + t] - bsh[hd * 8 + s]) * dtsh[hd * 8 + s] : 0.f; }
    __syncthreads();
    const int head = g * 8 + w;
    const size_t sidx = (size_t)(l * 128 + b) * 16 + head;
    const float* S0 = p.st_ssm + sidx * 8192; float* So = p.out + O_SS + sidx * 8192;
    const float dA = expf(bLs[w]);
    f32x4 acc[4];
    f32x4 svn[4][2];
#pragma unroll
    for (int ks = 0; ks < 4; ++ks) { svn[ks][0] = __builtin_nontemporal_load((const f32x4*)(S0 + fr * 128 + 32 * ks + fq * 8)); svn[ks][1] = __builtin_nontemporal_load((const f32x4*)(S0 + fr * 128 + 32 * ks + fq * 8 + 4)); }
#pragma unroll
    for (int nt = 0; nt < 4; ++nt) {
        acc[nt] = (f32x4){0.f, 0.f, 0.f, 0.f};
        const int pp = 16 * nt + fr;
        const f32x4 xw0 = *(const f32x4*)(xwT + (64 * w + pp) * 8), xw1 = *(const f32x4*)(xwT + (64 * w + pp) * 8 + 4);
        f32x4 sv[4][2];
#pragma unroll
        for (int ks = 0; ks < 4; ++ks) { sv[ks][0] = svn[ks][0]; sv[ks][1] = svn[ks][1]; }
        if (nt < 3) {
#pragma unroll
            for (int ks = 0; ks < 4; ++ks) { svn[ks][0] = __builtin_nontemporal_load((const f32x4*)(S0 + (pp + 16) * 128 + 32 * ks + fq * 8)); svn[ks][1] = __builtin_nontemporal_load((const f32x4*)(S0 + (pp + 16) * 128 + 32 * ks + fq * 8 + 4)); }
        }
#pragma unroll
        for (int ks = 0; ks < 4; ++ks) {
            const int n0 = 32 * ks + fq * 8;
            const f32x4 s0 = sv[ks][0], s1 = sv[ks][1];
            union { u32x4 u; bf16x8 v; } bfr;
            bfr.u.x = pk2(s0[0], s0[1]); bfr.u.y = pk2(s0[2], s0[3]); bfr.u.z = pk2(s1[0], s1[1]); bfr.u.w = pk2(s1[2], s1[3]);
            const bf16x8 af = *(const bf16x8*)(Cmb + fr * 136 + n0);
            acc[nt] = mfma16(af, bfr.v, acc[nt]);
            f32x4 o0 = s0 * dA, o1 = s1 * dA;
#pragma unroll
            for (int s = 0; s < 8; ++s) {
                const float xv = s < 4 ? xw0[s & 3] : xw1[s & 3];
                const f32x4 bm0 = *(const f32x4*)(Bmf + s * 128 + n0), bm1 = *(const f32x4*)(Bmf + s * 128 + n0 + 4);
                o0 += bm0 * xv; o1 += bm1 * xv;
            }
            __builtin_nontemporal_store(o0, (f32x4*)(So + pp * 128 + n0)); __builtin_nontemporal_store(o1, (f32x4*)(So + pp * 128 + n0 + 4));
        }
        asm volatile("" ::: "memory");
    }
    const float dsk = p.D_skip[l * 16 + head];
    float gts[4][4];
#pragma unroll
    for (int j = 0; j < 4; ++j) {
        const int t = (fq & 1) * 4 + j;
        const float eb = expf(bsh[w * 8 + t]);
        float ssq = 0.f;
#pragma unroll
        for (int nt = 0; nt < 4; ++nt) {
            const int hp = 64 * w + 16 * nt + fr;
            float y = eb * acc[nt][j] + dsk * xs[t * 512 + hp];
#pragma unroll
            for (int s = 0; s < 8; ++s) y += MW[(w * 8 + t) * 8 + s] * xs[s * 512 + hp];
            const float z = bf2f(U[(size_t)t * INP + UZ + g * 512 + hp]);
            const float gt = y * siluf_(z);
            gts[nt][j] = gt; ssq += gt * gt;
        }
        ssq += __shfl_xor(ssq, 1); ssq += __shfl_xor(ssq, 2); ssq += __shfl_xor(ssq, 4); ssq += __shfl_xor(ssq, 8);
        if (fr == 0 && fq < 2) red[t * 8 + w] = ssq;
    }
    __syncthreads();
    if (tid < 8) { float s = 0.f;
#pragma unroll
        for (int i = 0; i < 8; ++i) s += red[tid * 8 + i];
        stat[tid] = rsqrtf(s * (1.0f / 512.0f) + 1e-6f); }
    __syncthreads();
    if (fq < 2) {
        bf16_t* MX = (bf16_t*)(p.ws + WS_MIXIN);
#pragma unroll
        for (int j = 0; j < 4; ++j) {
            const int t = fq * 4 + j;
#pragma unroll
            for (int nt = 0; nt < 4; ++nt) {
                const int ch = g * 512 + 64 * w + 16 * nt + fr;
                MX[(size_t)(r0 + t) * D + 1024 + ch] = f2bf(gts[nt][j] * stat[t] * p.s_norm_w[l * 1024 + ch]);
            }
        }
    }
    __syncthreads();
}

DEV void phase_ln(const P& p, int l, int which) {
    int tid_ = threadIdx.x; asm volatile("" : "+v"(tid_));
    const int lane = tid_ & 63, w = tid_ >> 6;
    const float* gam = (which ? p.ln2_g : p.ln1_g) + l * D; const float* bet = (which ? p.ln2_b : p.ln1_b) + l * D;
    const bf16_t* mix = (const bf16_t*)(p.ws + WS_MIXF);
    bf16_t* xb = (bf16_t*)(p.ws + WS_XB);
    const bool first = (l == 0 && which == 0), lastp = (l == 1 && which == 1), split = (gridDim.x == 256);
    for (int r = blockIdx.x * 8 + w; r < NTOK; r += gridDim.x * 8) {
        f32x4 y[8]; float s = 0.f;
#pragma unroll
        for (int i = 0; i < 8; ++i) { const int cidx = i * 256 + lane * 4;
            f32x4 xv, mv;
            if (first) xv = *(const f32x4*)((r < NPR ? p.x_prompt + (size_t)r * D : p.x_sample + (size_t)(r - NPR) * D) + cidx);
            else { const uint2 t = *(const uint2*)(xb + (size_t)r * D + cidx); xv = (f32x4){bflo(t.x), bfhi(t.x), bflo(t.y), bfhi(t.y)}; }
            if (split && r >= NPR) { const float* pp = (const float*)(p.ws + WS_PART) + (size_t)(r - NPR) * D + cidx; mv = *(const f32x4*)pp;
#pragma unroll
                for (int k = 1; k < 8; ++k) mv += *(const f32x4*)(pp + (size_t)k * NSM * D); }
            else { const uint2 t = *(const uint2*)(mix + (size_t)r * D + cidx); mv = (f32x4){bflo(t.x), bfhi(t.x), bflo(t.y), bfhi(t.y)}; }
            y[i] = xv * ALPHA + mv; s += (y[i][0] + y[i][1]) + (y[i][2] + y[i][3]); }
        const float mu = wave_sum(s) * (1.0f / D);
        float q = 0.f;
#pragma unroll
        for (int i = 0; i < 8; ++i) { y[i] = y[i] - mu; q += (y[i][0] * y[i][0] + y[i][1] * y[i][1]) + (y[i][2] * y[i][2] + y[i][3] * y[i][3]); }
        const float rs = rsqrtf(wave_sum(q) * (1.0f / D) + 1e-5f);
#pragma unroll
        for (int i = 0; i < 8; ++i) { const int cidx = i * 256 + lane * 4;
            const f32x4 o = y[i] * rs * *(const f32x4*)(gam + cidx) + *(const f32x4*)(bet + cidx);
            if (lastp) *(f32x4*)(p.out + (size_t)r * D + cidx) = o;
            else { u32x2 wv; wv.x = pk2(o[0], o[1]); wv.y = pk2(o[2], o[3]); *(u32x2*)(xb + (size_t)r * D + cidx) = wv; } }
    }
}

DEV void phase_ffn_gate(const P& p, int l) {
    const bf16_t* up = (const bf16_t*)(p.ws + WS_UP); bf16_t* act = (bf16_t*)(p.ws + WS_ACT);
    const float* fw = p.f_conv_w + (size_t)l * 3 * DFF2; const float* fb = p.f_conv_b + (size_t)l * DFF2;
    const int total = (NTOK / 8) * (DFF / 8);
    int tid_ = threadIdx.x; asm volatile("" : "+v"(tid_));
    for (int it = blockIdx.x * NTHR + tid_; it < total; it += gridDim.x * NTHR) {
        const int rb = it / (DFF / 8), j8 = (it % (DFF / 8)) * 8, r0 = rb * 8;
        const bool smp = r0 >= NPR; const int t0 = smp ? 0 : (r0 & 2047); const int sb = (r0 - NPR) >> 3;
        float wg[3][8], wv[3][8], bg[8], bv[8];
#pragma unroll
        for (int k = 0; k < 3; ++k) {
            const f32x4 a0 = *(const f32x4*)(fw + k * DFF2 + j8), a1 = *(const f32x4*)(fw + k * DFF2 + j8 + 4), c0 = *(const f32x4*)(fw + k * DFF2 + DFF + j8), c1 = *(const f32x4*)(fw + k * DFF2 + DFF + j8 + 4);
#pragma unroll
            for (int i = 0; i < 4; ++i) { wg[k][i] = a0[i]; wg[k][4 + i] = a1[i]; wv[k][i] = c0[i]; wv[k][4 + i] = c1[i]; }
        }
        { const f32x4 a0 = *(const f32x4*)(fb + j8), a1 = *(const f32x4*)(fb + j8 + 4), c0 = *(const f32x4*)(fb + DFF + j8), c1 = *(const f32x4*)(fb + DFF + j8 + 4);
#pragma unroll
          for (int i = 0; i < 4; ++i) { bg[i] = a0[i]; bg[4 + i] = a1[i]; bv[i] = c0[i]; bv[4 + i] = c1[i]; } }
        float g0[8], g1[8], v0[8], v1[8];
        if (t0 > 0) {
            unpack8(*(const uint4*)(up + (size_t)(r0 - 2) * DFF2 + j8), g0); unpack8(*(const uint4*)(up + (size_t)(r0 - 2) * DFF2 + DFF + j8), v0);
            unpack8(*(const uint4*)(up + (size_t)(r0 - 1) * DFF2 + j8), g1); unpack8(*(const uint4*)(up + (size_t)(r0 - 1) * DFF2 + DFF + j8), v1);
        } else if (smp) {
            const float* bp = p.st_fconv + (size_t)(l * 128 + sb) * 2 * DFF2;
            const f32x4 a0 = *(const f32x4*)(bp + j8), a1 = *(const f32x4*)(bp + j8 + 4), c0 = *(const f32x4*)(bp + DFF + j8), c1 = *(const f32x4*)(bp + DFF + j8 + 4);
            const f32x4 d0 = *(const f32x4*)(bp + DFF2 + j8), d1 = *(const f32x4*)(bp + DFF2 + j8 + 4), e0 = *(const f32x4*)(bp + DFF2 + DFF + j8), e1 = *(const f32x4*)(bp + DFF2 + DFF + j8 + 4);
#pragma unroll
            for (int i = 0; i < 4; ++i) { g0[i] = a0[i]; g0[4 + i] = a1[i]; v0[i] = c0[i]; v0[4 + i] = c1[i]; g1[i] = d0[i]; g1[4 + i] = d1[i]; v1[i] = e0[i]; v1[4 + i] = e1[i]; }
        } else {
#pragma unroll
            for (int i = 0; i < 8; ++i) { g0[i] = 0.f; g1[i] = 0.f; v0[i] = 0.f; v1[i] = 0.f; }
        }
#pragma unroll
        for (int rr = 0; rr < 8; ++rr) {
            float g2[8], v2[8];
            unpack8(*(const uint4*)(up + (size_t)(r0 + rr) * DFF2 + j8), g2); unpack8(*(const uint4*)(up + (size_t)(r0 + rr) * DFF2 + DFF + j8), v2);
            float o[8];
#pragma unroll
            for (int i = 0; i < 8; ++i) {
                const float ag = bg[i] + wg[0][i] * g0[i] + wg[1][i] * g1[i] + wg[2][i] * g2[i];
                const float av = bv[i] + wv[0][i] * v0[i] + wv[1][i] * v1[i] + wv[2][i] * v2[i];
                o[i] = ag * __builtin_amdgcn_rcpf(1.0f + __expf(-ag)) * av;
                g0[i] = g1[i]; g1[i] = g2[i]; v0[i] = v1[i]; v1[i] = v2[i];
            }
            u32x4 wv4; wv4.x = pk2(o[0], o[1]); wv4.y = pk2(o[2], o[3]); wv4.z = pk2(o[4], o[5]); wv4.w = pk2(o[6], o[7]);
            *(u32x4*)(act + (size_t)(r0 + rr) * DFF + j8) = wv4;
        }
    }
    const int tot2 = 132 * 2 * (DFF2 / 8);
    for (int it = blockIdx.x * NTHR + tid_; it < tot2; it += gridDim.x * NTHR) {
        const int c8 = (it % (DFF2 / 8)) * 8, rr = it / (DFF2 / 8), j = rr & 1, sq = rr >> 1;
        float* o; size_t row;
        if (sq < 4) { o = p.out + O_PFC + ((size_t)(l * 4 + sq) * 2 + j) * DFF2 + c8; row = (size_t)sq * 2048 + 2046 + j; }
        else { const int b = sq - 4; o = p.out + O_SFC + ((size_t)(l * 128 + b) * 2 + j) * DFF2 + c8; row = (size_t)NPR + b * 8 + 6 + j; }
        float xf[8]; unpack8(*(const uint4*)(up + row * DFF2 + c8), xf);
        *(f32x4*)o = (f32x4){xf[0], xf[1], xf[2], xf[3]}; *(f32x4*)(o + 4) = (f32x4){xf[4], xf[5], xf[6], xf[7]};
    }
}


#define XB_TMO      128
#define XB_XCNT(j)  (256  + 64 * (j))
#define XB_XSUB(j)  (1280 + 64 * (j))
#define XB_XGEN(j)  (2304 + 64 * (j))
#define XB_TOP      3328
#define XB_TOPGEN   3392
#define XCD_BAR_WORDS 3456
#define XB_SPIN_CAP (1u << 20)
DEV unsigned xb_ld(unsigned* p)              { return __hip_atomic_load(p, __ATOMIC_RELAXED, __HIP_MEMORY_SCOPE_AGENT); }
DEV unsigned xb_add(unsigned* p, unsigned v) { return __hip_atomic_fetch_add(p, v, __ATOMIC_RELAXED, __HIP_MEMORY_SCOPE_AGENT); }
DEV unsigned xb_xcc_id() { return (unsigned)__builtin_amdgcn_s_getreg((3 << 11) | 20) & 0xFu; }
#define XB_SPIN(cond, bar) do { unsigned _sp = 0; while (cond) { __builtin_amdgcn_s_sleep(1); \
    if ((++_sp & 255u) == 0u) { if (xb_ld(&(bar)[XB_TMO])) break; if (_sp > XB_SPIN_CAP) { atomicAdd(&(bar)[XB_TMO], 1u); break; } } } } while (0)
struct XcdBarrier { unsigned* bar; unsigned x; volatile LAS unsigned* st; };
DEV XcdBarrier xcd_barrier_post(unsigned* bar, volatile LAS unsigned* st) {
    XcdBarrier b; b.bar = bar; b.x = xb_xcc_id(); b.st = st;
    if (threadIdx.x == 0) (void)xb_add(&bar[XB_XCNT(b.x)], 1u);
    return b;
}
DEV void xcd_barrier_complete(unsigned* bar, unsigned x, unsigned& nloc, unsigned& nx) {
    const unsigned G = gridDim.x * gridDim.y * gridDim.z;
    unsigned sum, cnt, mine, sp = 0u;
    for (;;) {
        sum = 0u; cnt = 0u; mine = 0u;
#pragma unroll
        for (unsigned j = 0; j < 16; ++j) { const unsigned c = xb_ld(&bar[XB_XCNT(j)]); sum += c; cnt += (c > 0u) ? 1u : 0u; mine = (j == x) ? c : mine; }
        if (sum == G) break;
        __builtin_amdgcn_s_sleep(1);
        if ((++sp & 255u) == 0u) { if (xb_ld(&bar[XB_TMO])) break; if (sp > XB_SPIN_CAP) { atomicAdd(&bar[XB_TMO], 1u); break; } }
    }
    nloc = mine > 0u ? mine : 1u; nx = cnt > 0u ? cnt : 1u;
}
DEV void xcd_barrier(const XcdBarrier& b) {
    asm volatile("s_waitcnt vmcnt(0)" ::: "memory");
    __syncthreads();
    if (threadIdx.x == 0) {
        unsigned* bar = b.bar;
        __builtin_amdgcn_s_waitcnt(0);
        unsigned nloc = b.st[0], nx = b.st[1];
        if (nloc == 0u) { xcd_barrier_complete(bar, b.x, nloc, nx); b.st[0] = nloc; b.st[1] = nx; }
        const unsigned old = xb_add(&bar[XB_XSUB(b.x)], 1u);
        const unsigned gen = old / nloc;
        if (old + 1u == (gen + 1u) * nloc) {
            __builtin_amdgcn_fence(__ATOMIC_RELEASE, "agent");
            asm volatile("s_waitcnt vmcnt(0)" ::: "memory");
            const unsigned og = xb_add(&bar[XB_TOP], 1u);
            const unsigned tg = og / nx;
            if (og + 1u == (tg + 1u) * nx) xb_add(&bar[XB_TOPGEN], 1u);
            else XB_SPIN(xb_ld(&bar[XB_TOPGEN]) == tg, bar);
            __builtin_amdgcn_fence(__ATOMIC_ACQUIRE, "agent");
            xb_add(&bar[XB_XGEN(b.x)], 1u);
            asm volatile("s_waitcnt vmcnt(0)" ::: "memory");
        } else {
            XB_SPIN(xb_ld(&bar[XB_XGEN(b.x)]) == gen, bar);
            __builtin_amdgcn_fence(__ATOMIC_ACQUIRE, "agent");
            asm volatile("s_waitcnt vmcnt(0)" ::: "memory");
        }
    }
    __syncthreads();
}

constexpr int NPHASE = 21;
DEV void run_phase(const P& p, int l, int q, unsigned char* lds) {
    int bid = blockIdx.x, G = gridDim.x; asm volatile("" : "+s"(bid), "+s"(G));
    if (q == 0) {
        pg8::Gemm g{(const bf16_t*)(p.ws + WS_XB), (const bf16_t*)(p.ws + WS_WIN) + (size_t)l * INP * D, NTOK, INP, D};
        pg8::StaticOrder S; S.init(NTOK, INP, D, G, bid);
        pg8::EpiBf16 E{(bf16_t*)(p.ws + WS_U), INP, nullptr};
        pg8::gemm_phase<pg8::EpiBf16, pg8::StaticOrder>((LAS unsigned char*)lds, g, S, E);
    } else if (q == 1) {
        const int par = bid & 1;
#pragma unroll 1
        for (int half = 0; half < 2; ++half) {
            if ((half ^ par) == 0) {
                for (int u = bid; u < 512; u += G) smp_mlstm(p, l, u, lds);
                for (int u = bid; u < 256; u += G) smp_ssd(p, l, u, lds);
            } else {
                for (int u = bid; u < 512; u += G) mlstm_local(p, l, u, lds);
                for (int u = bid; u < 256; u += G) ssd_local(p, l, u, lds);
            }
        }
    } else if (q == 2) {
        for (int u = bid; u < 256; u += G) mlstm_scan(p, l, u, lds);
        for (int u = bid; u < 256; u += G) ssd_scan(p, l, u, lds);
        for (int u = bid; u < 132; u += G) convstate_copy(p, l, u);
    } else if (q == 3) {
        for (int u = bid; u < 512; u += G) mlstm_out(p, l, u, lds);
        for (int u = bid; u < 256; u += G) ssd_out(p, l, u, lds);
    } else if (q == 4) {
        pg8::Gemm g{(const bf16_t*)(p.ws + WS_MIXIN), (const bf16_t*)(p.ws + WS_WOUT) + (size_t)l * D * D, NTOK, D, D};
        pg8::EpiBf16 E{(bf16_t*)(p.ws + WS_MIXF), D, (float*)(p.ws + WS_PART)};
        if (G == 256) { pg8::TailSplitOrder S; S.init(D, bid); pg8::gemm_phase<pg8::EpiBf16, pg8::TailSplitOrder>((LAS unsigned char*)lds, g, S, E); }
        else { pg8::StaticOrder S; S.init(NTOK, D, D, G, bid); pg8::gemm_phase<pg8::EpiBf16, pg8::StaticOrder>((LAS unsigned char*)lds, g, S, E); }
    } else if (q == 5) {
        phase_ln(p, l, 0);
    } else if (q == 6) {
        pg8::Gemm g{(const bf16_t*)(p.ws + WS_XB), (const bf16_t*)(p.ws + WS_WUP) + (size_t)l * DFF2 * D, NTOK, DFF2, D};
        pg8::StaticOrder S; S.init(NTOK, DFF2, D, G, bid);
        pg8::EpiBf16 E{(bf16_t*)(p.ws + WS_UP), DFF2, nullptr};
        pg8::gemm_phase<pg8::EpiBf16, pg8::StaticOrder>((LAS unsigned char*)lds, g, S, E);
        if (l == 0 && G == 256 && bid >= 12) phase_prologue(p, lds, 1, 2, false, bid - 12, 244);
    } else if (q == 7) {
        phase_ffn_gate(p, l);
    } else if (q == 8) {
        pg8::Gemm g{(const bf16_t*)(p.ws + WS_ACT), (const bf16_t*)(p.ws + WS_WDN) + (size_t)l * D * DFF, NTOK, D, DFF};
        pg8::EpiBf16 E{(bf16_t*)(p.ws + WS_MIXF), D, (float*)(p.ws + WS_PART)};
        if (G == 256) { pg8::TailSplitOrder S; S.init(DFF, bid); pg8::gemm_phase<pg8::EpiBf16, pg8::TailSplitOrder>((LAS unsigned char*)lds, g, S, E); }
        else { pg8::StaticOrder S; S.init(NTOK, D, DFF, G, bid); pg8::gemm_phase<pg8::EpiBf16, pg8::StaticOrder>((LAS unsigned char*)lds, g, S, E); }
    } else {
        phase_ln(p, l, 1);
    }
}
#if MK_MULTI
template <int T> __global__ void __launch_bounds__(NTHR, 2) k_unit(P p) {
    extern __shared__ __attribute__((aligned(16))) unsigned char lds[];
    const int l = p.ph_lo; int bid = blockIdx.x, G = gridDim.x;
    if (T == 11) for (int u = bid; u < 512; u += G) smp_mlstm(p, l, u, lds);
    if (T == 12) for (int u = bid; u < 256; u += G) smp_ssd(p, l, u, lds);
    if (T == 13) for (int u = bid; u < 512; u += G) mlstm_local(p, l, u, lds);
    if (T == 14) for (int u = bid; u < 256; u += G) ssd_local(p, l, u, lds);
    if (T == 31) for (int u = bid; u < 512; u += G) mlstm_out(p, l, u, lds);
    if (T == 32) for (int u = bid; u < 256; u += G) ssd_out(p, l, u, lds);
    if (T == 21) for (int u = bid; u < 256; u += G) mlstm_scan(p, l, u, lds);
    if (T == 22) for (int u = bid; u < 256; u += G) ssd_scan(p, l, u, lds);
}
template <int Q> __global__ void __launch_bounds__(NTHR, 2) k_phase(P p) {
    extern __shared__ __attribute__((aligned(16))) unsigned char lds[];
    if (Q < 0) phase_prologue(p, lds, 0, gridDim.x == 256 ? 1 : 2, true, blockIdx.x, gridDim.x); else run_phase(p, p.ph_lo, Q, lds);
}
#else
__global__ void __launch_bounds__(NTHR, 2) mk_fwd(P p) {
    extern __shared__ __attribute__((aligned(16))) unsigned char lds[];
    cg::grid_group grid = cg::this_grid();
    if (p.ph_hi < 0) grid.sync();
    if (threadIdx.x < 4) ((unsigned*)(lds + LDS_BYTES - 16))[threadIdx.x] = 0u;
    __syncthreads();
    (void)xcd_barrier_post((unsigned*)(p.ws + WS_BAR), (volatile LAS unsigned*)(lds + LDS_BYTES - 16));
#define GSYNC() do { XcdBarrier b_; b_.bar = (unsigned*)(p.ws + WS_BAR); b_.x = xb_xcc_id(); b_.st = (volatile LAS unsigned*)(lds + LDS_BYTES - 16); xcd_barrier(b_); } while (0)
    phase_prologue(p, lds, 0, gridDim.x == 256 ? 1 : 2, true, blockIdx.x, gridDim.x);
#pragma unroll 1
    for (int l = 0; l < 2; ++l) {
        GSYNC(); run_phase(p, l, 0, lds);
        GSYNC(); run_phase(p, l, 1, lds);
        GSYNC(); run_phase(p, l, 2, lds);
        GSYNC(); run_phase(p, l, 3, lds);
        GSYNC(); run_phase(p, l, 4, lds);
        GSYNC(); run_phase(p, l, 5, lds);
        GSYNC(); run_phase(p, l, 6, lds);
        GSYNC(); run_phase(p, l, 7, lds);
        GSYNC(); run_phase(p, l, 8, lds);
        GSYNC(); run_phase(p, l, 9, lds);
    }
    for (int i = 0; i < PROBE_SYNCS; ++i) GSYNC();
}
#endif

extern "C" void kernel_launch(void* const* d_in, const int* in_sizes, int n_in, void* d_out, int out_size, void* d_ws, size_t ws_size, hipStream_t stream) {
    static int grid = 0;
    if (grid == 0) {
        if (n_in != 27 || ws_size < WS_END) { fprintf(stderr, "kernel_launch: unexpected n_in %d or ws_size %zu (need %zu)\n", n_in, ws_size, (size_t)WS_END); grid = -1; return; }
        int dev = 0, cus = 0, per_cu = 0;
        hipGetDevice(&dev);
        hipDeviceGetAttribute(&cus, hipDeviceAttributeMultiprocessorCount, dev);
#if MK_MULTI
        const void* fns[11] = {(const void*)k_phase<-1>, (const void*)k_phase<0>, (const void*)k_phase<1>, (const void*)k_phase<2>, (const void*)k_phase<3>, (const void*)k_phase<4>, (const void*)k_phase<5>,
                               (const void*)k_phase<6>, (const void*)k_phase<7>, (const void*)k_phase<8>, (const void*)k_phase<9>};
        for (int i = 0; i < 11; ++i) if (hipFuncSetAttribute(fns[i], hipFuncAttributeMaxDynamicSharedMemorySize, LDS_BYTES) != hipSuccess) { fprintf(stderr, "kernel_launch: hipFuncSetAttribute failed\n"); grid = -1; return; }
#else
        if (hipFuncSetAttribute((const void*)mk_fwd, hipFuncAttributeMaxDynamicSharedMemorySize, LDS_BYTES) != hipSuccess) { fprintf(stderr, "kernel_launch: hipFuncSetAttribute failed\n"); grid = -1; return; }
        hipOccupancyMaxActiveBlocksPerMultiprocessor(&per_cu, (const void*)mk_fwd, NTHR, LDS_BYTES);
        (void)hipGetLastError();
#endif
        (void)per_cu;
        grid = cus * 1;
    }
    if (grid < 0) return;
    P p{};
    const float** pp = (const float**)&p;
    for (int i = 0; i < 27; ++i) pp[i] = (const float*)d_in[i];
    p.out = (float*)d_out; p.ws = (unsigned char*)d_ws;
#if MK_MULTI
    p.ph_lo = 0; p.ph_hi = 0;
    if (PROBE_REP == -1) hipLaunchKernelGGL(k_phase<-1>, dim3(grid), dim3(NTHR), LDS_BYTES, stream, p);
    hipLaunchKernelGGL(k_phase<-1>, dim3(grid), dim3(NTHR), LDS_BYTES, stream, p);
    for (int l = 0; l < 2; ++l) {
        p.ph_lo = l;
        for (int rep = 0; rep < 1 + ((PROBE_REP == 0) || (PROBE_REP == 100 && (0 == 0 || 0 == 4 || 0 == 6 || 0 == 8))); ++rep) hipLaunchKernelGGL(k_phase<0>, dim3(grid), dim3(NTHR), LDS_BYTES, stream, p);
        for (int rep = 0; rep < 1 + ((PROBE_REP == 1) || (PROBE_REP == 100 && (1 == 0 || 1 == 4 || 1 == 6 || 1 == 8))); ++rep) hipLaunchKernelGGL(k_phase<1>, dim3(grid), dim3(NTHR), LDS_BYTES, stream, p);
        for (int rep = 0; rep < 1 + ((PROBE_REP == 2) || (PROBE_REP == 100 && (2 == 0 || 2 == 4 || 2 == 6 || 2 == 8))); ++rep) hipLaunchKernelGGL(k_phase<2>, dim3(grid), dim3(NTHR), LDS_BYTES, stream, p);
        for (int rep = 0; rep < 1 + ((PROBE_REP == 3) || (PROBE_REP == 100 && (3 == 0 || 3 == 4 || 3 == 6 || 3 == 8))); ++rep) hipLaunchKernelGGL(k_phase<3>, dim3(grid), dim3(NTHR), LDS_BYTES, stream, p);
        if (PROBE_REP == 11 || PROBE_REP == 12 || PROBE_REP == 13 || PROBE_REP == 14 || PROBE_REP == 31 || PROBE_REP == 32 || PROBE_REP == 21 || PROBE_REP == 22) {
            hipFuncSetAttribute((const void*)k_unit<PROBE_REP>, hipFuncAttributeMaxDynamicSharedMemorySize, LDS_BYTES);
            hipLaunchKernelGGL(k_unit<PROBE_REP>, dim3(grid), dim3(NTHR), LDS_BYTES, stream, p);
        }
        for (int rep = 0; rep < 1 + ((PROBE_REP == 4) || (PROBE_REP == 100 && (4 == 0 || 4 == 4 || 4 == 6 || 4 == 8))); ++rep) hipLaunchKernelGGL(k_phase<4>, dim3(grid), dim3(NTHR), LDS_BYTES, stream, p);
        for (int rep = 0; rep < 1 + ((PROBE_REP == 5) || (PROBE_REP == 100 && (5 == 0 || 5 == 4 || 5 == 6 || 5 == 8))); ++rep) hipLaunchKernelGGL(k_phase<5>, dim3(grid), dim3(NTHR), LDS_BYTES, stream, p);
        for (int rep = 0; rep < 1 + ((PROBE_REP == 6) || (PROBE_REP == 100 && (6 == 0 || 6 == 4 || 6 == 6 || 6 == 8))); ++rep) hipLaunchKernelGGL(k_phase<6>, dim3(grid), dim3(NTHR), LDS_BYTES, stream, p);
        for (int rep = 0; rep < 1 + ((PROBE_REP == 7) || (PROBE_REP == 100 && (7 == 0 || 7 == 4 || 7 == 6 || 7 == 8))); ++rep) hipLaunchKernelGGL(k_phase<7>, dim3(grid), dim3(NTHR), LDS_BYTES, stream, p);
        for (int rep = 0; rep < 1 + ((PROBE_REP == 8) || (PROBE_REP == 100 && (8 == 0 || 8 == 4 || 8 == 6 || 8 == 8))); ++rep) hipLaunchKernelGGL(k_phase<8>, dim3(grid), dim3(NTHR), LDS_BYTES, stream, p);
        for (int rep = 0; rep < 1 + ((PROBE_REP == 9) || (PROBE_REP == 100 && (9 == 0 || 9 == 4 || 9 == 6 || 9 == 8))); ++rep) hipLaunchKernelGGL(k_phase<9>, dim3(grid), dim3(NTHR), LDS_BYTES, stream, p);
    }
#else
    p.ph_lo = 0; p.ph_hi = NPHASE;
    if (hipMemsetAsync((char*)d_ws + WS_BAR, 0, 16384, stream) != hipSuccess) { fprintf(stderr, "kernel_launch: memset failed\n"); return; }
    void* args[] = {&p};
    hipError_t e = hipLaunchCooperativeKernel((const void*)mk_fwd, dim3(grid), dim3(NTHR), args, LDS_BYTES, stream);
    if (e != hipSuccess) fprintf(stderr, "cooperative launch failed: %s (grid %d)\n", hipGetErrorString(e), grid);
#endif
}
```

```cpp
#include <hip/hip_runtime.h>
#include <hip/hip_cooperative_groups.h>
#include <cstdio>
namespace cg = cooperative_groups;

#ifndef MK_MULTI
#define MK_MULTI 0
#endif
#ifndef PROBE_REP
#define PROBE_REP -99
#endif
#ifndef PROBE_SYNCS
#define PROBE_SYNCS 0
#endif

#define DEV __device__ __forceinline__
#define LAS __attribute__((address_space(3)))
typedef unsigned short bf16_t;
typedef short bf16x8 __attribute__((ext_vector_type(8)));
typedef float f32x4 __attribute__((ext_vector_type(4)));
typedef float f32x2 __attribute__((ext_vector_type(2)));
typedef unsigned u32x4 __attribute__((ext_vector_type(4)));
typedef unsigned u32x2 __attribute__((ext_vector_type(2)));

constexpr int D = 2048, NPR = 8192, NSM = 1024, NTOK = 9216, INP = 6912, IN_DIM = 6680, DFF = 5504, DFF2 = 11008;
constexpr int UQ = 0, UK = 1024, UV = 2048, UO = 3072, UZ = 4096, UXS = 5120, UIG = 6656, UFG = 6660, UDT = 6664;
constexpr int NTHR = 512;
constexpr int LDS_BYTES = 136 * 1024;
constexpr float ALPHA = 1.41421356237309515f;

constexpr size_t O_YP = 0;
constexpr size_t O_YS = O_YP + (size_t)4 * 2048 * 2048;
constexpr size_t O_PC = O_YS + (size_t)128 * 8 * 2048;
constexpr size_t O_PN = O_PC + (size_t)2 * 4 * 4 * 256 * 256;
constexpr size_t O_PM = O_PN + (size_t)2 * 4 * 4 * 256;
constexpr size_t O_PS = O_PM + (size_t)2 * 4 * 4;
constexpr size_t O_PSC = O_PS + (size_t)2 * 4 * 16 * 64 * 128;
constexpr size_t O_PFC = O_PSC + (size_t)2 * 4 * 3 * 1536;
constexpr size_t O_SC = O_PFC + (size_t)2 * 4 * 2 * DFF2;
constexpr size_t O_SN = O_SC + (size_t)2 * 128 * 4 * 256 * 256;
constexpr size_t O_SM = O_SN + (size_t)2 * 128 * 4 * 256;
constexpr size_t O_SS = O_SM + (size_t)2 * 128 * 4;
constexpr size_t O_SSC = O_SS + (size_t)2 * 128 * 16 * 64 * 128;
constexpr size_t O_SFC = O_SSC + (size_t)2 * 128 * 3 * 1536;

constexpr size_t WS_WIN = 0;
constexpr size_t WS_WOUT = WS_WIN + (size_t)2 * INP * D * 2;
constexpr size_t WS_WUP = WS_WOUT + (size_t)2 * D * D * 2;
constexpr size_t WS_WDN = WS_WUP + (size_t)2 * DFF2 * D * 2;
constexpr size_t WS_XB = WS_WDN + (size_t)2 * D * DFF * 2;
constexpr size_t WS_XF = WS_XB + (size_t)NTOK * D * 2;
constexpr size_t WS_XBC = WS_XF;
constexpr size_t WS_U = WS_XF + (size_t)NTOK * D * 4;
constexpr size_t WS_MIXIN = WS_U + (size_t)NTOK * INP * 2;
constexpr size_t WS_MIXF = WS_MIXIN + (size_t)NTOK * D * 2;
constexpr size_t WS_UP = WS_MIXF + (size_t)NTOK * D * 4;
constexpr size_t WS_ACT = WS_UP + (size_t)NTOK * DFF2 * 2;
constexpr size_t WS_PART = WS_ACT + (size_t)NTOK * DFF * 2;
constexpr size_t WS_SMALL = WS_PART + (size_t)8 * NSM * D * 4;
constexpr size_t WS_DBUF = WS_UP;
constexpr size_t WS_SBUF = WS_UP + (size_t)512 * 65536 * 4;
constexpr size_t WS_CT = WS_ACT;
constexpr size_t WS_ST = WS_ACT + (size_t)512 * 65536 * 2;
static_assert(WS_SBUF + (size_t)2048 * 8192 * 4 <= WS_ACT, "alias");
static_assert(WS_ST + (size_t)2048 * 8192 * 2 <= WS_PART, "alias");
constexpr size_t WS_NLOC = WS_SMALL;
constexpr size_t WS_NST = WS_NLOC + (size_t)512 * 256 * 4;
constexpr size_t WS_GSTAT = WS_NST + (size_t)512 * 256 * 4;
constexpr size_t WS_MST = WS_GSTAT + 4096;
constexpr size_t WS_SBSUM = WS_MST + 4096;
constexpr size_t WS_BAR = WS_SBSUM + 8192;
constexpr size_t WS_END = WS_BAR + 16384;

struct P {
    const float* x_prompt; const float* x_sample; const float* st_C; const float* st_n; const float* st_m; const float* st_ssm; const float* st_sconv; const float* st_fconv;
    const float* w_in; const float* b_i; const float* b_f; const float* m_norm_w; const float* s_conv_w; const float* s_conv_b; const float* dt_bias; const float* A_log; const float* D_skip;
    const float* s_norm_w; const float* w_out; const float* ln1_g; const float* ln1_b; const float* w_up; const float* f_conv_w; const float* f_conv_b; const float* w_down; const float* ln2_g; const float* ln2_b;
    float* out; unsigned char* ws; int ph_lo, ph_hi;
};

DEV float bf2f(bf16_t v) { return __uint_as_float(((unsigned)v) << 16); }
DEV bf16_t f2bf(float f) { unsigned u = __float_as_uint(f); u += 0x7FFFu + ((u >> 16) & 1u); return (bf16_t)(u >> 16); }
DEV unsigned pk2(float lo, float hi) { return (unsigned)f2bf(lo) | ((unsigned)f2bf(hi) << 16); }
DEV float bflo(unsigned w) { return __uint_as_float(w << 16); }
DEV float bfhi(unsigned w) { return __uint_as_float(w & 0xffff0000u); }
DEV float sigmoidf_(float x) { return __builtin_amdgcn_rcpf(1.0f + __expf(-x)); }
DEV float siluf_(float x) { return x * sigmoidf_(x); }
DEV float softplusf_(float x) { return fmaxf(x, 0.f) + log1pf(expf(-fabsf(x))); }
DEV float logsigf_(float x) { return fminf(x, 0.f) - log1pf(expf(-fabsf(x))); }
DEV float wave_sum(float v) {
#pragma unroll
    for (int o = 32; o >= 1; o >>= 1) v += __shfl_xor(v, o);
    return v; }
DEV float wave_max(float v) {
#pragma unroll
    for (int o = 32; o >= 1; o >>= 1) v = fmaxf(v, __shfl_xor(v, o));
    return v; }
DEV float wave_incl_sum(float v, int lane) {
#pragma unroll
    for (int o = 1; o < 64; o <<= 1) { float t = __shfl_up(v, o); if (lane >= o) v += t; }
    return v; }
DEV float wave_incl_max(float v, int lane) {
#pragma unroll
    for (int o = 1; o < 64; o <<= 1) { float t = __shfl_up(v, o); if (lane >= o) v = fmaxf(v, t); }
    return v; }
DEV f32x4 mfma16(bf16x8 a, bf16x8 b, f32x4 c) { return __builtin_amdgcn_mfma_f32_16x16x32_bf16(a, b, c, 0, 0, 0); }
DEV void unpack8(uint4 x, float (&f)[8]) { f[0] = bflo(x.x); f[1] = bfhi(x.x); f[2] = bflo(x.y); f[3] = bfhi(x.y); f[4] = bflo(x.z); f[5] = bfhi(x.z); f[6] = bflo(x.w); f[7] = bfhi(x.w); }

typedef short s16x4 __attribute__((ext_vector_type(4)));
DEV bf16x8 tr_frag(const bf16_t* T, int pitch, int krow0, int col0, int lane) {
    const int g = lane >> 4, q = (lane & 15) >> 2, pl = lane & 3;
    const bf16_t* a0 = T + (krow0 + 8 * g + q) * pitch + col0 + 4 * pl;
    const s16x4 lo = __builtin_amdgcn_ds_read_tr16_b64_v4i16((LAS s16x4*)a0);
    const s16x4 hi = __builtin_amdgcn_ds_read_tr16_b64_v4i16((LAS s16x4*)(a0 + 4 * pitch));
    return (bf16x8){lo[0], lo[1], lo[2], lo[3], hi[0], hi[1], hi[2], hi[3]};
}

namespace pg8 {
constexpr int BM = 256, BK = 64, HALF = 128, HTB = HALF * BK * 2, STAGE_BYTES = 8 * HTB, NXCD = 8, WGM = 8;
DEV int lds_byte(int r, int c) { const int st = (r >> 4) * 2 + (c >> 5), rr = r & 15, cc = c & 31, ob = rr * 64 + cc * 2; return st * 1024 + (ob ^ (((ob >> 9) & 1) << 5)); }
DEV void stage_rc(int b, int& R, int& C) { const int st = b / 1024, sb = b % 1024, swz = sb ^ (((sb >> 9) & 1) << 5); R = (st >> 1) * 16 + swz / 64; C = (st & 1) * 32 + (swz % 64) / 2; }
DEV int perm32(int rho) { const int n = rho >> 4, i = rho & 15; return 8 * (i >> 2) + 4 * n + (i & 3); }
struct Unit { int pm, pn, k0, nt, ks; };
struct Gemm { const bf16_t* A; const bf16_t* Bt; int M, N, K; };
struct StaticOrder {
    int nM, nN, nwg, G, c, ntk;
    DEV void init(int M, int N, int K, int G_, int c_) { nM = M / BM; nN = N / BM; nwg = nM * nN; G = G_; c = c_; ntk = K / BK; }
    DEV bool next(int i, Unit& u) const {
        u.pm = 0; u.pn = 0; u.k0 = 0; u.nt = 4; u.ks = -1;
        const long L = (long)i * G + c; if (L >= nwg) return false;
        int wgid = (int)L; { const int q = nwg / NXCD, r = nwg % NXCD, xcd = wgid % NXCD, off = wgid / NXCD; wgid = (xcd < r ? xcd * (q + 1) : r * (q + 1) + (xcd - r) * q) + off; }
        const int nig = WGM * nN, gid = wgid / nig, fm = gid * WGM, gsz = (nM - fm) < WGM ? (nM - fm) : WGM;
        u.pm = fm + ((wgid % nig) % gsz); u.pn = (wgid % nig) / gsz; u.k0 = 0; u.nt = ntk; u.ks = -1; return true;
    }
};
struct TailSplitOrder {
    StaticOrder so; int c, ntk;
    DEV void init(int K, int c_) { so.init(NPR, D, K, 256, c_); c = c_; ntk = K / BK; }
    DEV bool next(int i, Unit& u) const {
        u.pm = 0; u.pn = 0; u.k0 = 0; u.nt = 4; u.ks = -1;
        if (i == 0) return so.next(0, u);
        if (i > 1) return false;
        const int tt = c >> 3, ks = c & 7; u.pm = 32 + (tt >> 3); u.pn = tt & 7; u.ks = ks;
        const int pairs = ntk >> 1, base = pairs >> 3, rem = pairs & 7;
        const int p0 = ks * base + (ks < rem ? ks : rem), np = base + (ks < rem ? 1 : 0);
        u.k0 = p0 * 128; u.nt = np * 2; return true;
    }
};
DEV unsigned cvt_pk_bf16(float lo, float hi) { unsigned r; asm volatile("v_cvt_pk_bf16_f32 %0, %1, %2" : "=v"(r) : "v"(lo), "v"(hi)); return r; }
struct EpiF32 {
    static constexpr bool PERM = false;
    float* C; int ldc; float* part;
    DEV void operator()(const f32x4 (&acc)[2][2][4][2], const Unit& u, int wr, int wc, int fr, int fq) const {
        const int row0 = u.pm * BM + wr * 64 + fr, col0 = u.pn * BM + wc * 32 + 4 * fq;
        float* Cb = u.ks < 0 ? C : part + (size_t)u.ks * NSM * D - (size_t)NPR * ldc;
#pragma unroll
        for (int ai = 0; ai < 2; ++ai)
#pragma unroll
            for (int m = 0; m < 4; ++m) { float* rowp = Cb + (size_t)(row0 + ai * HALF + m * 16) * ldc + col0;
#pragma unroll
                for (int bj = 0; bj < 2; ++bj)
#pragma unroll
                    for (int n = 0; n < 2; ++n) *(f32x4*)(rowp + bj * HALF + n * 16) = acc[ai][bj][m][n]; }
    }
};
struct EpiBf16 {
    static constexpr bool PERM = true;
    bf16_t* O; int ldc; float* part;
    DEV void operator()(const f32x4 (&acc)[2][2][4][2], const Unit& u, int wr, int wc, int fr, int fq) const {
        const int row0 = u.pm * BM + wr * 64 + fr; const int col0 = u.pn * BM + wc * 32 + 8 * fq;
        if (u.ks >= 0) {
            bf16_t* pb = (bf16_t*)part + (size_t)u.ks * NSM * ldc + (size_t)(row0 - NPR) * ldc + col0;
#pragma unroll
            for (int ai = 0; ai < 2; ++ai)
#pragma unroll
                for (int m = 0; m < 4; ++m)
#pragma unroll
                    for (int bj = 0; bj < 2; ++bj) { const f32x4 v0 = acc[ai][bj][m][0], v1 = acc[ai][bj][m][1];
                        u32x4 w; w.x = cvt_pk_bf16(v0[0], v0[1]); w.y = cvt_pk_bf16(v0[2], v0[3]); w.z = cvt_pk_bf16(v1[0], v1[1]); w.w = cvt_pk_bf16(v1[2], v1[3]);
                        *(u32x4*)(pb + (size_t)(ai * HALF + m * 16) * ldc + bj * HALF) = w; }
            return;
        }
#pragma unroll
        for (int ai = 0; ai < 2; ++ai)
#pragma unroll
            for (int m = 0; m < 4; ++m) { bf16_t* rowp = O + (size_t)(row0 + ai * HALF + m * 16) * ldc + col0;
#pragma unroll
                for (int bj = 0; bj < 2; ++bj) { const f32x4 v0 = acc[ai][bj][m][0], v1 = acc[ai][bj][m][1];
                    u32x4 w; w.x = cvt_pk_bf16(v0[0], v0[1]); w.y = cvt_pk_bf16(v0[2], v0[3]); w.z = cvt_pk_bf16(v1[0], v1[1]); w.w = cvt_pk_bf16(v1[2], v1[3]);
                    *(u32x4*)(rowp + bj * HALF) = w; } }
    }
};

template <class Epi, class Sched>
DEV void gemm_phase(LAS unsigned char* lds, const Gemm g, const Sched& S, const Epi& E) {
    int tid_ = threadIdx.x; asm volatile("" : "+v"(tid_)); const int tid = tid_, wid = __builtin_amdgcn_readfirstlane(tid >> 6), lane = tid & 63, wr = wid >> 2, wc = wid & 3, fr = lane & 15, fq = lane >> 4;
    const int K = g.K;
    unsigned voffA[2], voffB[2];
#pragma unroll
    for (int i = 0; i < 2; ++i) { int R, C; stage_rc(tid * 16 + i * 8192, R, C); const int Rb = Epi::PERM ? ((R & ~31) + perm32(R & 31)) : R;
        voffA[i] = (unsigned)(R * K + C) * 2u; voffB[i] = (unsigned)(Rb * K + C) * 2u; }
    const size_t kstep = (size_t)(BK * 2);
    const size_t hstep = (size_t)HALF * K * 2;
    const size_t tstep = 2 * hstep;
    const unsigned ldsw = (unsigned)wid * 1024u;
    const int aoff = lds_byte(wr * 64 + fr, fq * 8), boff = lds_byte(wc * 32 + fr, fq * 8);
#define PG8_SA(b, h) (((b) * 2 + (h)) * HTB)
#define PG8_SB(b, h) ((4 + (b) * 2 + (h)) * HTB)
#define PG8_STAGE(bufoff, gbase, voff) do { _Pragma("unroll") for (int _i = 0; _i < 2; ++_i) \
        __builtin_amdgcn_global_load_lds((const unsigned*)((const char*)(gbase) + (voff)[_i]), (LAS unsigned*)(lds + (bufoff) + ldsw + _i * 8192), 16, 0, 0); } while (0)
#define PG8_LDA(dst, b, h) do { _Pragma("unroll") for (int m = 0; m < 4; ++m) _Pragma("unroll") for (int k = 0; k < 2; ++k) dst[m][k] = *(const LAS bf16x8*)(lds + PG8_SA(b, h) + aoff + m * 2048 + k * 1024); } while (0)
#define PG8_LDB(dst, b, h) do { _Pragma("unroll") for (int n = 0; n < 2; ++n) _Pragma("unroll") for (int k = 0; k < 2; ++k) dst[n][k] = *(const LAS bf16x8*)(lds + PG8_SB(b, h) + boff + n * 2048 + k * 1024); } while (0)
#define PG8_MMA(ai, bj, At, Bt) do { __builtin_amdgcn_s_setprio(1); _Pragma("unroll") for (int m = 0; m < 4; ++m) _Pragma("unroll") for (int n = 0; n < 2; ++n) _Pragma("unroll") for (int k = 0; k < 2; ++k) \
        acc[ai][bj][m][n] = __builtin_amdgcn_mfma_f32_16x16x32_bf16(Bt[n][k], At[m][k], acc[ai][bj][m][n], 0, 0, 0); __builtin_amdgcn_s_setprio(0); } while (0)
#define PG8_WAIT_V(n) asm volatile("s_waitcnt vmcnt(" #n ")" ::: "memory")
#define PG8_WAIT_L(n) asm volatile("s_waitcnt lgkmcnt(" #n ")" ::: "memory")
#define PG8_BAR __builtin_amdgcn_s_barrier()
#define PG8_SCHED __builtin_amdgcn_sched_barrier(0)
    Unit cur, nxt; int ui = 0;
    if (!S.next(0, cur)) return;
    f32x4 acc[2][2][4][2];
#pragma unroll
    for (int a = 0; a < 2; ++a)
#pragma unroll
        for (int b = 0; b < 2; ++b)
#pragma unroll
            for (int m = 0; m < 4; ++m)
#pragma unroll
                for (int n = 0; n < 2; ++n) acc[a][b][m][n] = (f32x4){0.f, 0.f, 0.f, 0.f};
    bf16x8 At[4][2], B0[2][2], B1[2][2];
    const char* cA = (const char*)g.A + (size_t)cur.pm * tstep + (size_t)cur.k0 * 2; const char* cB = (const char*)g.Bt + (size_t)cur.pn * tstep + (size_t)cur.k0 * 2;
    PG8_STAGE(PG8_SB(0, 0), cB, voffB); PG8_STAGE(PG8_SA(0, 0), cA, voffA); PG8_STAGE(PG8_SB(0, 1), cB + hstep, voffB); PG8_STAGE(PG8_SA(0, 1), cA + hstep, voffA);
    if (wr == 1) PG8_BAR;
    PG8_WAIT_V(4); PG8_BAR;
    PG8_STAGE(PG8_SB(1, 0), cB + kstep, voffB); PG8_STAGE(PG8_SA(1, 0), cA + kstep, voffA); PG8_STAGE(PG8_SB(1, 1), cB + hstep + kstep, voffB);
    PG8_WAIT_V(6); PG8_BAR;
    for (;;) {
        const bool has_next = S.next(ui + 1, nxt);
        const char* nA = has_next ? (const char*)g.A + (size_t)nxt.pm * tstep + (size_t)nxt.k0 * 2 : cA; const char* nB = has_next ? (const char*)g.Bt + (size_t)nxt.pn * tstep + (size_t)nxt.k0 * 2 : cB;
        const int nt = cur.nt;
        for (int t = 0; t < nt; t += 2) {
            const bool last = (t == nt - 2);
            const char* a1 = cA + (size_t)(t + 1) * kstep;
            const char* a2 = last ? nA : cA + (size_t)(t + 2) * kstep; const char* b2 = last ? nB : cB + (size_t)(t + 2) * kstep;
            const char* a3 = a2 + kstep; const char* b3 = b2 + kstep;
            PG8_LDB(B0, 0, 0); PG8_SCHED; PG8_LDA(At, 0, 0); PG8_STAGE(PG8_SA(1, 1), a1 + hstep, voffA);
            PG8_WAIT_L(8); PG8_BAR; PG8_WAIT_L(0); PG8_MMA(0, 0, At, B0); PG8_BAR; PG8_SCHED;
            PG8_LDB(B1, 0, 1); PG8_STAGE(PG8_SB(0, 0), b2, voffB);
            PG8_BAR; PG8_WAIT_L(0); PG8_MMA(0, 1, At, B1); PG8_BAR;
            PG8_LDA(At, 0, 1); PG8_STAGE(PG8_SA(0, 0), a2, voffA);
            PG8_BAR; PG8_WAIT_L(0); PG8_MMA(1, 0, At, B0); PG8_BAR; PG8_SCHED;
            PG8_STAGE(PG8_SB(0, 1), b2 + hstep, voffB);
            PG8_WAIT_V(6); PG8_BAR; PG8_MMA(1, 1, At, B1); PG8_BAR;
            PG8_LDB(B0, 1, 0); PG8_SCHED; PG8_LDA(At, 1, 0); PG8_STAGE(PG8_SA(0, 1), a2 + hstep, voffA);
            PG8_WAIT_L(8); PG8_BAR; PG8_WAIT_L(0); PG8_MMA(0, 0, At, B0); PG8_BAR; PG8_SCHED;
            PG8_LDB(B1, 1, 1); PG8_STAGE(PG8_SB(1, 0), b3, voffB);
            PG8_BAR; PG8_WAIT_L(0); PG8_MMA(0, 1, At, B1); PG8_BAR;
            PG8_LDA(At, 1, 1); PG8_STAGE(PG8_SA(1, 0), a3, voffA);
            PG8_BAR; PG8_WAIT_L(0); PG8_MMA(1, 0, At, B0); PG8_BAR; PG8_SCHED;
            PG8_STAGE(PG8_SB(1, 1), b3 + hstep, voffB);
            PG8_WAIT_V(6); PG8_BAR; PG8_MMA(1, 1, At, B1); PG8_BAR;
        }
        E(acc, cur, wr, wc, fr, fq);
        if (!has_next) break;
#pragma unroll
        for (int a = 0; a < 2; ++a)
#pragma unroll
            for (int b = 0; b < 2; ++b)
#pragma unroll
                for (int m = 0; m < 4; ++m)
#pragma unroll
                    for (int n = 0; n < 2; ++n) acc[a][b][m][n] = (f32x4){0.f, 0.f, 0.f, 0.f};
        cur = nxt; cA = nA; cB = nB; ++ui;
    }
    PG8_WAIT_V(0);
    if (wr == 0) PG8_BAR;
    PG8_BAR;
#undef PG8_SA
#undef PG8_SB
#undef PG8_STAGE
#undef PG8_LDA
#undef PG8_LDB
#undef PG8_MMA
#undef PG8_WAIT_V
#undef PG8_WAIT_L
#undef PG8_BAR
#undef PG8_SCHED
}
}

DEV int win_srccol(int n) { return n < 4096 ? n : (n < 6656 ? n + 8 : (n < 6664 ? n - 2560 : (n < 6680 ? n : -1))); }
DEV void transpose_tile(const float* __restrict__ src, int srcN, bf16_t* __restrict__ dst, int K, int n0, int k0, int mode, float* tile) {
    int tid_ = threadIdx.x; asm volatile("" : "+v"(tid_)); const int tid = tid_;
    f32x4 v[4];
#pragma unroll
    for (int i = 0; i < 4; ++i) {
        const int kk = (tid >> 5) + 16 * i, nn4 = (tid & 31) * 4, n = n0 + nn4;
        const int sc = mode ? win_srccol(n) : n;
        v[i] = (f32x4){0.f, 0.f, 0.f, 0.f};
        if (sc >= 0) v[i] = __builtin_nontemporal_load((const f32x4*)(src + (size_t)(k0 + kk) * srcN + sc));
        if (mode && n >= 1024 && n < 2048) v[i] = v[i] * 0.0625f;
    }
#pragma unroll
    for (int i = 0; i < 4; ++i) {
        const int kk = (tid >> 5) + 16 * i, nn4 = (tid & 31) * 4;
        tile[kk * 129 + nn4 + 0] = v[i][0]; tile[kk * 129 + nn4 + 1] = v[i][1]; tile[kk * 129 + nn4 + 2] = v[i][2]; tile[kk * 129 + nn4 + 3] = v[i][3];
    }
    __syncthreads();
#pragma unroll
    for (int i = 0; i < 2; ++i) {
        const int ch = tid + 512 * i, nn = ch >> 3, kk8 = (ch & 7) * 8;
        u32x4 w;
        w.x = pk2(tile[(kk8 + 0) * 129 + nn], tile[(kk8 + 1) * 129 + nn]); w.y = pk2(tile[(kk8 + 2) * 129 + nn], tile[(kk8 + 3) * 129 + nn]);
        w.z = pk2(tile[(kk8 + 4) * 129 + nn], tile[(kk8 + 5) * 129 + nn]); w.w = pk2(tile[(kk8 + 6) * 129 + nn], tile[(kk8 + 7) * 129 + nn]);
        *(u32x4*)(dst + (size_t)(n0 + nn) * K + k0 + kk8) = w;
    }
    __syncthreads();
}
DEV void phase_prologue(const P& p, unsigned char* lds, int l_lo, int l_hi, bool with_x, int b0, int nb) {
    float* tile = (float*)lds;
    constexpr int T_WIN = (INP / 128) * (D / 64), T_WOUT = (D / 128) * (D / 64), T_WUP = (DFF2 / 128) * (D / 64), T_WDN = (D / 128) * (DFF / 64);
    constexpr int T_L = T_WIN + T_WOUT + T_WUP + T_WDN, T_X = NTOK * D / 4096;
    const int nw = (l_hi - l_lo) * T_L, total = nw + (with_x ? T_X : 0);
    for (int u = b0; u < total; u += nb) {
        if (u < nw) {
            const int l = l_lo + u / T_L; int r = u % T_L;
            if (r < T_WIN) { const int nt = r / (D / 64), kt = r % (D / 64);
                transpose_tile(p.w_in + (size_t)l * D * IN_DIM, IN_DIM, (bf16_t*)(p.ws + WS_WIN) + (size_t)l * INP * D, D, nt * 128, kt * 64, 1, tile); }
            else if ((r -= T_WIN) < T_WOUT) { const int nt = r / (D / 64), kt = r % (D / 64);
                transpose_tile(p.w_out + (size_t)l * D * D, D, (bf16_t*)(p.ws + WS_WOUT) + (size_t)l * D * D, D, nt * 128, kt * 64, 0, tile); }
            else if ((r -= T_WOUT) < T_WUP) { const int nt = r / (D / 64), kt = r % (D / 64);
                transpose_tile(p.w_up + (size_t)l * D * DFF2, DFF2, (bf16_t*)(p.ws + WS_WUP) + (size_t)l * DFF2 * D, D, nt * 128, kt * 64, 0, tile); }
            else { r -= T_WUP; const int nt = r / (DFF / 64), kt = r % (DFF / 64);
                transpose_tile(p.w_down + (size_t)l * DFF * D, D, (bf16_t*)(p.ws + WS_WDN) + (size_t)l * D * DFF, DFF, nt * 128, kt * 64, 0, tile); }
        } else {
            const size_t e = (size_t)(u - nw) * 4096 + threadIdx.x * 8;
            const float* s = e < (size_t)NPR * D ? p.x_prompt + e : p.x_sample + (e - (size_t)NPR * D);
            const f32x4 a = *(const f32x4*)s, b = *(const f32x4*)(s + 4);
            u32x4 w; w.x = pk2(a[0], a[1]); w.y = pk2(a[2], a[3]); w.z = pk2(b[0], b[1]); w.w = pk2(b[2], b[3]);
            *(u32x4*)((bf16_t*)(p.ws + WS_XB) + e) = w;
        }
    }
}

DEV void mlstm_local(const P& p, int l, int unit, unsigned char* lds) {
    const int bh = unit >> 5, c = unit & 31, b = bh >> 2, h = bh & 3;
    int tid_ = threadIdx.x; asm volatile("" : "+v"(tid_)); const int tid = tid_, lane = tid & 63, w = tid >> 6, fr = lane & 15, fq = lane >> 4;
    const bf16_t* U = (const bf16_t*)(p.ws + WS_U) + (size_t)(b * 2048 + c * 64) * INP;
    float* wsh = (float*)lds;
    bf16_t* KW = (bf16_t*)(lds + 1024);
    bf16_t* V = KW + 64 * 272;
    float* gstat = (float*)(p.ws + WS_GSTAT);
    if (w == 0) {
        const float ig = bf2f(U[(size_t)lane * INP + UIG + h]) + p.b_i[l * 4 + h];
        const float lf = logsigf_(bf2f(U[(size_t)lane * INP + UFG + h]) + p.b_f[l * 4 + h]);
        const float bs = wave_incl_sum(lf, lane);
        const float a = ig - bs;
        const float amax = wave_max(a);
        const float bsum = __shfl(bs, 63);
        wsh[lane] = expf(a - amax);
        if (lane == 0) { gstat[(bh * 32 + c) * 2] = bsum; gstat[(bh * 32 + c) * 2 + 1] = bsum + amax; }
    }
    __syncthreads();
#pragma unroll
    for (int i = 0; i < 4; ++i) {
        const int it = tid + 512 * i, s_ = it >> 5, d8 = (it & 31) * 8;
        const uint4 kv = *(const uint4*)(U + (size_t)s_ * INP + UK + h * 256 + d8);
        const uint4 vv = *(const uint4*)(U + (size_t)s_ * INP + UV + h * 256 + d8);
        const float ws_ = wsh[s_];
        float kf[8]; unpack8(kv, kf);
        u32x4 kw; kw.x = pk2(kf[0] * ws_, kf[1] * ws_); kw.y = pk2(kf[2] * ws_, kf[3] * ws_); kw.z = pk2(kf[4] * ws_, kf[5] * ws_); kw.w = pk2(kf[6] * ws_, kf[7] * ws_);
        *(u32x4*)(KW + s_ * 272 + d8) = kw;
        *(uint4*)(V + s_ * 272 + d8) = vv;
    }
    __syncthreads();
    if (tid < 256) { float a = 0.f; for (int s_ = 0; s_ < 64; ++s_) a += bf2f(KW[s_ * 272 + tid]); ((float*)(p.ws + WS_NLOC))[(size_t)(bh * 32 + c) * 256 + tid] = a; }
    f32x4 acc[2][16];
#pragma unroll
    for (int m = 0; m < 2; ++m)
#pragma unroll
        for (int n = 0; n < 16; ++n) acc[m][n] = (f32x4){0.f, 0.f, 0.f, 0.f};
#pragma unroll
    for (int ks = 0; ks < 2; ++ks) {
        bf16x8 vf[2];
#pragma unroll
        for (int m = 0; m < 2; ++m) vf[m] = tr_frag(V, 272, 32 * ks, 32 * w + 16 * m, lane);
#pragma unroll
        for (int n = 0; n < 16; ++n) {
            const bf16x8 kf = tr_frag(KW, 272, 32 * ks, 16 * n, lane);
#pragma unroll
            for (int m = 0; m < 2; ++m) acc[m][n] = mfma16(kf, vf[m], acc[m][n]);
        }
    }
    bf16_t* Dp = (bf16_t*)(p.ws + WS_DBUF) + (size_t)(bh * 32 + c) * 65536;
#pragma unroll
    for (int m = 0; m < 2; ++m)
#pragma unroll
        for (int n = 0; n < 16; ++n) { u32x2 wv; wv.x = pk2(acc[m][n][0], acc[m][n][1]); wv.y = pk2(acc[m][n][2], acc[m][n][3]);
            *(u32x2*)(Dp + (32 * w + 16 * m + fr) * 256 + 16 * n + fq * 4) = wv; }
    __syncthreads();
}

DEV void mlstm_scan(const P& p, int l, int unit, unsigned char* lds) {
    int tid_ = threadIdx.x; asm volatile("" : "+v"(tid_)); const int bh = unit >> 4, slab = unit & 15, tid = tid_;
    float* fA = (float*)lds; float* fB = fA + 32;
    const float* gstat = (const float*)(p.ws + WS_GSTAT);
    if (tid == 0) {
        float m = 0.f;
        for (int c = 0; c < 32; ++c) {
            const float bsum = gstat[(bh * 32 + c) * 2], mloc = gstat[(bh * 32 + c) * 2 + 1];
            const float mn = fmaxf(bsum + m, mloc);
            fA[c] = expf(bsum + m - mn); fB[c] = expf(mloc - mn); m = mn;
            if (slab == 0) ((float*)(p.ws + WS_MST))[bh * 32 + c] = mn;
        }
        if (slab == 0) p.out[O_PM + l * 16 + bh] = m;
    }
    __syncthreads();
    const size_t e0 = (size_t)slab * 4096 + tid * 8;
    float run[8];
#pragma unroll
    for (int i = 0; i < 8; ++i) run[i] = 0.f;
    const bf16_t* Dp = (const bf16_t*)(p.ws + WS_DBUF) + (size_t)bh * 32 * 65536 + e0;
    bf16_t* Cp = (bf16_t*)(p.ws + WS_CT) + (size_t)bh * 32 * 65536 + e0;
#pragma unroll 1
    for (int cb = 0; cb < 32; cb += 8) {
        uint4 xx[8];
#pragma unroll
        for (int j = 0; j < 8; ++j) xx[j] = *(const uint4*)(Dp + (size_t)(cb + j) * 65536);
#pragma unroll
        for (int j = 0; j < 8; ++j) {
            const int c = cb + j;
            const float a = fA[c], bq = fB[c];
            float xf[8]; unpack8(xx[j], xf);
#pragma unroll
            for (int i = 0; i < 8; ++i) run[i] = a * run[i] + bq * xf[i];
            u32x4 wv; wv.x = pk2(run[0], run[1]); wv.y = pk2(run[2], run[3]); wv.z = pk2(run[4], run[5]); wv.w = pk2(run[6], run[7]);
            *(u32x4*)(Cp + (size_t)c * 65536) = wv;
        }
    }
    {
        float* o = p.out + O_PC + (size_t)(l * 16 + bh) * 65536;
        const int e = (int)(e0 >> 8), d0 = (int)(e0 & 255);
#pragma unroll
        for (int i = 0; i < 8; ++i) o[(d0 + i) * 256 + e] = run[i];
    }
    if (slab == 0 && tid < 256) {
        float r = 0.f;
        const float* nl = (const float*)(p.ws + WS_NLOC) + (size_t)bh * 32 * 256 + tid;
        float* ns = (float*)(p.ws + WS_NST) + (size_t)bh * 32 * 256 + tid;
        for (int c = 0; c < 32; ++c) { r = fA[c] * r + fB[c] * nl[c * 256]; ns[c * 256] = r; }
        p.out[O_PN + (size_t)(l * 16 + bh) * 256 + tid] = r;
    }
    __syncthreads();
}

DEV void ssd_scan(const P& p, int l, int unit, unsigned char* lds) {
    int tid_ = threadIdx.x; asm volatile("" : "+v"(tid_)); const int bhd = unit >> 2, slab = unit & 3, tid = tid_;
    float* dec = (float*)lds;
    if (tid < 32) dec[tid] = expf(((const float*)(p.ws + WS_SBSUM))[bhd * 32 + tid]);
    __syncthreads();
    const size_t e0 = (size_t)slab * 2048 + tid * 4;
    f32x4 run = (f32x4){0.f, 0.f, 0.f, 0.f};
    const bf16_t* Sp = (const bf16_t*)(p.ws + WS_SBUF) + (size_t)bhd * 32 * 8192 + e0;
    bf16_t* Tp = (bf16_t*)(p.ws + WS_ST) + (size_t)bhd * 32 * 8192 + e0;
#pragma unroll 1
    for (int cb = 0; cb < 32; cb += 8) {
        uint2 xx[8];
#pragma unroll
        for (int j = 0; j < 8; ++j) xx[j] = *(const uint2*)(Sp + (size_t)(cb + j) * 8192);
#pragma unroll
        for (int j = 0; j < 8; ++j) {
            run = run * dec[cb + j] + (f32x4){bflo(xx[j].x), bfhi(xx[j].x), bflo(xx[j].y), bfhi(xx[j].y)};
            u32x2 wv; wv.x = pk2(run[0], run[1]); wv.y = pk2(run[2], run[3]);
            *(u32x2*)(Tp + (size_t)(cb + j) * 8192) = wv;
        }
    }
    *(f32x4*)(p.out + O_PS + (size_t)(l * 64 + bhd) * 8192 + e0) = run;
    __syncthreads();
}

DEV void convstate_copy(const P& p, int l, int unit) {
    const bf16_t* Ub = (const bf16_t*)(p.ws + WS_U);
    int tid_ = threadIdx.x; asm volatile("" : "+v"(tid_));
    for (int i = tid_; i < 3 * 1536; i += NTHR) {
        const int j = i / 1536, ch = i % 1536;
        if (unit < 4) p.out[O_PSC + ((size_t)(l * 4 + unit) * 3 + j) * 1536 + ch] = bf2f(Ub[(size_t)(unit * 2048 + 2045 + j) * INP + UXS + ch]);
        else { const int b = unit - 4; p.out[O_SSC + ((size_t)(l * 128 + b) * 3 + j) * 1536 + ch] = bf2f(Ub[(size_t)(NPR + b * 8 + 5 + j) * INP + UXS + ch]); }
    }
}

DEV void mlstm_out(const P& p, int l, int unit, unsigned char* lds) {
    const int bh = unit >> 5, c = unit & 31, b = bh >> 2, h = bh & 3;
    int tid_ = threadIdx.x; asm volatile("" : "+v"(tid_)); const int tid = tid_, lane = tid & 63, w = tid >> 6, fr = lane & 15, fq = lane >> 4;
    const int r0 = b * 2048 + c * 64;
    const bf16_t* U = (const bf16_t*)(p.ws + WS_U) + (size_t)r0 * INP;
    bf16_t* Qs = (bf16_t*)lds;
    bf16_t* Ks = Qs + 64 * 264;
    bf16_t* V = Ks + 64 * 264;
    bf16_t* Ss = V + 64 * 272;
    float* fl = (float*)(lds + 113664);
    float* bsh = fl; float* ash = fl + 64; float* mth = fl + 128; float* wint = fl + 192; float* rdn = fl + 256; float* qn = fl + 320; float* nprev = fl + 384; float* red = fl + 640;
    float* stat = fl + 1152;
    if (w == 0) {
        const float ig = bf2f(U[(size_t)lane * INP + UIG + h]) + p.b_i[l * 4 + h];
        const float lf = logsigf_(bf2f(U[(size_t)lane * INP + UFG + h]) + p.b_f[l * 4 + h]);
        const float bs = wave_incl_sum(lf, lane);
        const float a = ig - bs;
        const float cm = wave_incl_max(a, lane);
        const float mprev = c > 0 ? ((const float*)(p.ws + WS_MST))[bh * 32 + c - 1] : 0.f;
        const float mt = bs + fmaxf(mprev, cm);
        bsh[lane] = bs; ash[lane] = a; mth[lane] = mt; wint[lane] = expf(bs + mprev - mt);
    }
    if (tid >= 256) { const int d = tid - 256; nprev[d] = c > 0 ? ((const float*)(p.ws + WS_NST))[(size_t)(bh * 32 + c - 1) * 256 + d] : 0.f; }
#pragma unroll
    for (int i = 0; i < 4; ++i) {
        const int it = tid + 512 * i, s_ = it >> 5, d8 = (it & 31) * 8;
        *(uint4*)(Qs + s_ * 264 + d8) = *(const uint4*)(U + (size_t)s_ * INP + UQ + h * 256 + d8);
        *(uint4*)(Ks + s_ * 264 + d8) = *(const uint4*)(U + (size_t)s_ * INP + UK + h * 256 + d8);
        *(uint4*)(V + s_ * 272 + d8) = *(const uint4*)(U + (size_t)s_ * INP + UV + h * 256 + d8);
    }
    __syncthreads();
    {
        const int mt_ = w >> 1, nt0 = (w & 1) * 2;
        f32x4 sacc[2] = {(f32x4){0.f, 0.f, 0.f, 0.f}, (f32x4){0.f, 0.f, 0.f, 0.f}};
#pragma unroll
        for (int k0 = 0; k0 < 256; k0 += 32) {
            const bf16x8 a = *(const bf16x8*)(Qs + (16 * mt_ + fr) * 264 + k0 + fq * 8);
#pragma unroll
            for (int n = 0; n < 2; ++n) { const bf16x8 bb = *(const bf16x8*)(Ks + (16 * (nt0 + n) + fr) * 264 + k0 + fq * 8); sacc[n] = mfma16(a, bb, sacc[n]); }
        }
#pragma unroll
        for (int n = 0; n < 2; ++n)
#pragma unroll
            for (int j = 0; j < 4; ++j) {
                const int t = 16 * mt_ + fq * 4 + j, s_ = 16 * (nt0 + n) + fr;
                const float val = (s_ <= t) ? sacc[n][j] * expf(bsh[t] - mth[t] + ash[s_]) : 0.f;
                Ss[t * 72 + s_] = f2bf(val);
            }
        const int t = tid >> 3, part = tid & 7;
        float a = 0.f;
        for (int d = part * 32; d < part * 32 + 32; ++d) a += bf2f(Qs[t * 264 + d]) * nprev[d];
        a += __shfl_xor(a, 1); a += __shfl_xor(a, 2); a += __shfl_xor(a, 4);
        if (part == 0) qn[t] = a;
    }
    __syncthreads();
    if (tid < 64) {
        float di = 0.f;
        for (int s_ = 0; s_ < 64; ++s_) di += bf2f(Ss[tid * 72 + s_]);
        const float den = di + wint[tid] * qn[tid];
        rdn[tid] = 1.0f / fmaxf(fabsf(den), expf(-mth[tid]));
    }
    const int e0 = 32 * w;
    f32x4 acc1[4][2], acc2[4][2];
#pragma unroll
    for (int m = 0; m < 4; ++m)
#pragma unroll
        for (int n = 0; n < 2; ++n) { acc1[m][n] = (f32x4){0.f, 0.f, 0.f, 0.f}; acc2[m][n] = (f32x4){0.f, 0.f, 0.f, 0.f}; }
#pragma unroll
    for (int ks = 0; ks < 2; ++ks) {
        bf16x8 sf[4];
#pragma unroll
        for (int m = 0; m < 4; ++m) sf[m] = *(const bf16x8*)(Ss + (16 * m + fr) * 72 + 32 * ks + fq * 8);
#pragma unroll
        for (int n = 0; n < 2; ++n) { const bf16x8 vf = tr_frag(V, 272, 32 * ks, e0 + 16 * n, lane);
#pragma unroll
            for (int m = 0; m < 4; ++m) acc1[m][n] = mfma16(vf, sf[m], acc1[m][n]); }
    }
    if (c > 0) {
        const bf16_t* CTp = (const bf16_t*)(p.ws + WS_CT) + (size_t)(bh * 32 + c - 1) * 65536;
#pragma unroll 2
        for (int k0 = 0; k0 < 256; k0 += 32) {
            bf16x8 a[4];
#pragma unroll
            for (int m = 0; m < 4; ++m) a[m] = *(const bf16x8*)(Qs + (16 * m + fr) * 264 + k0 + fq * 8);
#pragma unroll
            for (int n = 0; n < 2; ++n) { const bf16x8 cf = *(const bf16x8*)(CTp + (size_t)(e0 + 16 * n + fr) * 256 + k0 + fq * 8);
#pragma unroll
                for (int m = 0; m < 4; ++m) acc2[m][n] = mfma16(cf, a[m], acc2[m][n]); }
        }
    }
    __syncthreads();
#pragma unroll
    for (int m = 0; m < 4; ++m) {
        const int t = 16 * m + fr;
        const float wi = wint[t], rd = rdn[t];
        float sm = 0.f;
#pragma unroll
        for (int n = 0; n < 2; ++n)
#pragma unroll
            for (int j = 0; j < 4; ++j) { const float hv = (acc1[m][n][j] + wi * acc2[m][n][j]) * rd; acc1[m][n][j] = hv; sm += hv; }
        sm += __shfl_xor(sm, 16); sm += __shfl_xor(sm, 32);
        if (fq == 0) red[t * 8 + w] = sm;
    }
    __syncthreads();
    if (tid < 64) { float sm = 0.f;
#pragma unroll
        for (int i = 0; i < 8; ++i) sm += red[tid * 8 + i];
        stat[tid] = sm * (1.0f / 256.0f); }
    __syncthreads();
#pragma unroll
    for (int m = 0; m < 4; ++m) {
        const int t = 16 * m + fr;
        const float mu = stat[t];
        float sm = 0.f;
#pragma unroll
        for (int n = 0; n < 2; ++n)
#pragma unroll
            for (int j = 0; j < 4; ++j) { const float dv = acc1[m][n][j] - mu; acc1[m][n][j] = dv; sm += dv * dv; }
        sm += __shfl_xor(sm, 16); sm += __shfl_xor(sm, 32);
        if (fq == 0) red[t * 8 + w] = sm;
    }
    __syncthreads();
    if (tid < 64) { float sm = 0.f;
#pragma unroll
        for (int i = 0; i < 8; ++i) sm += red[tid * 8 + i];
        stat[64 + tid] = rsqrtf(sm * (1.0f / 256.0f) + 1e-6f); }
    __syncthreads();
    bf16_t* MX = (bf16_t*)(p.ws + WS_MIXIN);
#pragma unroll
    for (int m = 0; m < 4; ++m) {
        const int t = 16 * m + fr;
        const float rs = stat[64 + t];
#pragma unroll
        for (int n = 0; n < 2; ++n) {
            const int e4 = e0 + 16 * n + fq * 4;
            const uint2 ov = *(const uint2*)(U + (size_t)t * INP + UO + h * 256 + e4);
            const f32x4 nw = *(const f32x4*)(p.m_norm_w + l * 1024 + h * 256 + e4);
            u32x2 wv;
            wv.x = pk2(acc1[m][n][0] * rs * nw[0] * sigmoidf_(bflo(ov.x)), acc1[m][n][1] * rs * nw[1] * sigmoidf_(bfhi(ov.x)));
            wv.y = pk2(acc1[m][n][2] * rs * nw[2] * sigmoidf_(bflo(ov.y)), acc1[m][n][3] * rs * nw[3] * sigmoidf_(bfhi(ov.y)));
            *(u32x2*)(MX + (size_t)(r0 + t) * D + h * 256 + e4) = wv;
        }
    }
    __syncthreads();
}

DEV void ssd_conv8(const bf16_t* Urow, int tpos, const float* cw, const float* cb, int ch8, float (&o)[8]) {
    const f32x4 b0 = *(const f32x4*)(cb + ch8), b1 = *(const f32x4*)(cb + ch8 + 4);
    o[0] = b0[0]; o[1] = b0[1]; o[2] = b0[2]; o[3] = b0[3]; o[4] = b1[0]; o[5] = b1[1]; o[6] = b1[2]; o[7] = b1[3];
#pragma unroll
    for (int j = 0; j < 4; ++j) {
        const int back = 3 - j;
        if (tpos - back >= 0) {
            const uint4 x = *(const uint4*)(Urow - (size_t)back * INP + UXS + ch8);
            float xf[8]; unpack8(x, xf);
            const f32x4 w0 = *(const f32x4*)(cw + j * 1536 + ch8), w1 = *(const f32x4*)(cw + j * 1536 + ch8 + 4);
            o[0] += w0[0] * xf[0]; o[1] += w0[1] * xf[1]; o[2] += w0[2] * xf[2]; o[3] += w0[3] * xf[3];
            o[4] += w1[0] * xf[4]; o[5] += w1[1] * xf[5]; o[6] += w1[2] * xf[6]; o[7] += w1[3] * xf[7];
        }
    }
#pragma unroll
    for (int i = 0; i < 8; ++i) o[i] = siluf_(o[i]);
}

DEV void ssd_local(const P& p, int l, int unit, unsigned char* lds) {
    const int b = unit >> 6, g = (unit >> 5) & 1, c = unit & 31;
    int tid_ = threadIdx.x; asm volatile("" : "+v"(tid_)); const int tid = tid_, lane = tid & 63, w = tid >> 6, fr = lane & 15, fq = lane >> 4;
    const int r0 = b * 2048 + c * 64;
    const bf16_t* U = (const bf16_t*)(p.ws + WS_U) + (size_t)r0 * INP;
    bf16_t* XW = (bf16_t*)lds;
    bf16_t* Bmn = XW + 64 * 528;
    float* wsh = (float*)(lds + 86016);
    {
        const int head = g * 8 + w;
        const float dt = softplusf_(bf2f(U[(size_t)lane * INP + UDT + head]) + p.dt_bias[l * 16 + head]);
        const float a = -expf(p.A_log[l * 16 + head]) * dt;
        const float bs = wave_incl_sum(a, lane);
        const float bL = __shfl(bs, 63);
        wsh[w * 64 + lane] = expf(bL - bs) * dt;
        if (lane == 0) ((float*)(p.ws + WS_SBSUM))[(b * 16 + head) * 32 + c] = bL;
    }
    __syncthreads();
    const float* cw = p.s_conv_w + (size_t)l * 4 * 1536; const float* cb = p.s_conv_b + (size_t)l * 1536;
    bf16_t* XBC = (bf16_t*)(p.ws + WS_XBC) + (size_t)r0 * 1536;
    for (int i = 0; i < 12; ++i) {
        const int it = tid + 512 * i, t = it / 96, gidx = it % 96;
        const int ch8 = gidx < 64 ? g * 512 + gidx * 8 : (gidx < 80 ? 1024 + g * 128 + (gidx - 64) * 8 : 1280 + g * 128 + (gidx - 80) * 8);
        float v[8];
        ssd_conv8(U + (size_t)t * INP, c * 64 + t, cw, cb, ch8, v);
        { u32x4 wr_; wr_.x = pk2(v[0], v[1]); wr_.y = pk2(v[2], v[3]); wr_.z = pk2(v[4], v[5]); wr_.w = pk2(v[6], v[7]); *(u32x4*)(XBC + (size_t)t * 1536 + ch8) = wr_; }
        if (gidx >= 80) continue;
        if (gidx < 64) { const float sc = wsh[(gidx >> 3) * 64 + t];
            u32x4 wv; wv.x = pk2(v[0] * sc, v[1] * sc); wv.y = pk2(v[2] * sc, v[3] * sc); wv.z = pk2(v[4] * sc, v[5] * sc); wv.w = pk2(v[6] * sc, v[7] * sc);
            *(u32x4*)(XW + t * 528 + gidx * 8) = wv; }
        else { u32x4 wv; wv.x = pk2(v[0], v[1]); wv.y = pk2(v[2], v[3]); wv.z = pk2(v[4], v[5]); wv.w = pk2(v[6], v[7]);
            *(u32x4*)(Bmn + t * 144 + (gidx - 64) * 8) = wv; }
    }
    __syncthreads();
    f32x4 acc[4][8];
#pragma unroll
    for (int m = 0; m < 4; ++m)
#pragma unroll
        for (int n = 0; n < 8; ++n) acc[m][n] = (f32x4){0.f, 0.f, 0.f, 0.f};
#pragma unroll
    for (int ks = 0; ks < 2; ++ks) {
        bf16x8 xf[4];
#pragma unroll
        for (int m = 0; m < 4; ++m) xf[m] = tr_frag(XW, 528, 32 * ks, 64 * w + 16 * m, lane);
#pragma unroll
        for (int n = 0; n < 8; ++n) { const bf16x8 bf_ = tr_frag(Bmn, 144, 32 * ks, 16 * n, lane);
#pragma unroll
            for (int m = 0; m < 4; ++m) acc[m][n] = mfma16(bf_, xf[m], acc[m][n]); }
    }
    bf16_t* Sp = (bf16_t*)(p.ws + WS_SBUF) + (size_t)((b * 16 + g * 8 + w) * 32 + c) * 8192;
#pragma unroll
    for (int m = 0; m < 4; ++m)
#pragma unroll
        for (int n = 0; n < 8; ++n) { u32x2 wv; wv.x = pk2(acc[m][n][0], acc[m][n][1]); wv.y = pk2(acc[m][n][2], acc[m][n][3]); *(u32x2*)(Sp + (16 * m + fr) * 128 + 16 * n + fq * 4) = wv; }
    __syncthreads();
}

DEV void ssd_out(const P& p, int l, int unit, unsigned char* lds) {
    const int b = unit >> 6, g = (unit >> 5) & 1, c = unit & 31;
    int tid_ = threadIdx.x; asm volatile("" : "+v"(tid_)); const int tid = tid_, lane = tid & 63, w = tid >> 6, fr = lane & 15, fq = lane >> 4;
    const int r0 = b * 2048 + c * 64;
    const bf16_t* U = (const bf16_t*)(p.ws + WS_U) + (size_t)r0 * INP;
    bf16_t* Xs = (bf16_t*)lds;
    bf16_t* Bm = Xs + 64 * 528;
    bf16_t* Cm = Bm + 64 * 136;
    float* CB = (float*)(lds + 102400);
    float* bsh = (float*)(lds + 119808);
    float* dtsh = bsh + 512;
    float* red = dtsh + 512;
    float* stat = red + 512;
    const int head = g * 8 + w;
    {
        const float dt = softplusf_(bf2f(U[(size_t)lane * INP + UDT + head]) + p.dt_bias[l * 16 + head]);
        const float a = -expf(p.A_log[l * 16 + head]) * dt;
        const float bs = wave_incl_sum(a, lane);
        bsh[w * 64 + lane] = bs; dtsh[w * 64 + lane] = dt;
    }
    const bf16_t* XBC = (const bf16_t*)(p.ws + WS_XBC) + (size_t)r0 * 1536;
#pragma unroll
    for (int i = 0; i < 12; ++i) {
        const int it = tid + 512 * i, t = it / 96, gidx = it % 96;
        const int ch8 = gidx < 64 ? g * 512 + gidx * 8 : (gidx < 80 ? 1024 + g * 128 + (gidx - 64) * 8 : 1280 + g * 128 + (gidx - 80) * 8);
        const u32x4 wv = *(const u32x4*)(XBC + (size_t)t * 1536 + ch8);
        if (gidx < 64) *(u32x4*)(Xs + t * 528 + gidx * 8) = wv;
        else if (gidx < 80) *(u32x4*)(Bm + t * 136 + (gidx - 64) * 8) = wv;
        else *(u32x4*)(Cm + t * 136 + (gidx - 80) * 8) = wv;
    }
    __syncthreads();
    {
        const int mt_ = w >> 1, nt0 = (w & 1) * 2;
        f32x4 cacc[2] = {(f32x4){0.f, 0.f, 0.f, 0.f}, (f32x4){0.f, 0.f, 0.f, 0.f}};
#pragma unroll
        for (int k0 = 0; k0 < 128; k0 += 32) {
            const bf16x8 a = *(const bf16x8*)(Cm + (16 * mt_ + fr) * 136 + k0 + fq * 8);
#pragma unroll
            for (int n = 0; n < 2; ++n) { const bf16x8 bb = *(const bf16x8*)(Bm + (16 * (nt0 + n) + fr) * 136 + k0 + fq * 8); cacc[n] = mfma16(a, bb, cacc[n]); }
        }
#pragma unroll
        for (int n = 0; n < 2; ++n)
#pragma unroll
            for (int j = 0; j < 4; ++j) CB[(16 * mt_ + fq * 4 + j) * 68 + 16 * (nt0 + n) + fr] = cacc[n][j];
    }
    __syncthreads();
    f32x4 acc1[4][4], acc2[4][4];
#pragma unroll
    for (int m = 0; m < 4; ++m)
#pragma unroll
        for (int n = 0; n < 4; ++n) { acc1[m][n] = (f32x4){0.f, 0.f, 0.f, 0.f}; acc2[m][n] = (f32x4){0.f, 0.f, 0.f, 0.f}; }
#pragma unroll
    for (int ks = 0; ks < 2; ++ks) {
        bf16x8 xf[4];
#pragma unroll
        for (int n = 0; n < 4; ++n) xf[n] = tr_frag(Xs, 528, 32 * ks, 64 * w + 16 * n, lane);
#pragma unroll
        for (int m = 0; m < 4; ++m) {
            if (ks * 32 > 16 * m + 15) continue;
            const int t = 16 * m + fr, s0 = 32 * ks + fq * 8;
            const float bt = bsh[w * 64 + t];
            const f32x4 c0 = *(const f32x4*)(CB + t * 68 + s0), c1 = *(const f32x4*)(CB + t * 68 + s0 + 4);
            float mv[8];
#pragma unroll
            for (int i = 0; i < 8; ++i) { const int s_ = s0 + i; const float cv = i < 4 ? c0[i & 3] : c1[i & 3];
                mv[i] = (s_ <= t) ? cv * expf(bt - bsh[w * 64 + s_]) * dtsh[w * 64 + s_] : 0.f; }
            union { u32x4 u; bf16x8 v; } af;
            af.u.x = pk2(mv[0], mv[1]); af.u.y = pk2(mv[2], mv[3]); af.u.z = pk2(mv[4], mv[5]); af.u.w = pk2(mv[6], mv[7]);
#pragma unroll
            for (int n = 0; n < 4; ++n) acc1[m][n] = mfma16(xf[n], af.v, acc1[m][n]);
        }
    }
    if (c > 0) {
        const bf16_t* STp = (const bf16_t*)(p.ws + WS_ST) + (size_t)((b * 16 + head) * 32 + c - 1) * 8192;
#pragma unroll
        for (int k0 = 0; k0 < 128; k0 += 32) {
            bf16x8 a[4];
#pragma unroll
            for (int m = 0; m < 4; ++m) a[m] = *(const bf16x8*)(Cm + (16 * m + fr) * 136 + k0 + fq * 8);
#pragma unroll
            for (int n = 0; n < 4; ++n) { const bf16x8 sf = *(const bf16x8*)(STp + (16 * n + fr) * 128 + k0 + fq * 8);
#pragma unroll
                for (int m = 0; m < 4; ++m) acc2[m][n] = mfma16(sf, a[m], acc2[m][n]); }
        }
    }
    const float dsk = p.D_skip[l * 16 + head];
#pragma unroll
    for (int m = 0; m < 4; ++m) {
        const int t = 16 * m + fr;
        const float eb = expf(bsh[w * 64 + t]);
        float sm = 0.f;
#pragma unroll
        for (int n = 0; n < 4; ++n) {
            const int pp4 = 16 * n + fq * 4;
            const uint2 xv = *(const uint2*)(Xs + t * 528 + 64 * w + pp4);
            const uint2 zv = *(const uint2*)(U + (size_t)t * INP + UZ + g * 512 + w * 64 + pp4);
            const float xs4[4] = {bflo(xv.x), bfhi(xv.x), bflo(xv.y), bfhi(xv.y)};
            const float z4[4] = {bflo(zv.x), bfhi(zv.x), bflo(zv.y), bfhi(zv.y)};
#pragma unroll
            for (int j = 0; j < 4; ++j) {
                const float y = acc1[m][n][j] + eb * acc2[m][n][j] + dsk * xs4[j];
                const float gt = y * z4[j] * sigmoidf_(z4[j]);
                acc1[m][n][j] = gt; sm += gt * gt;
            }
        }
        sm += __shfl_xor(sm, 16); sm += __shfl_xor(sm, 32);
        if (fq == 0) red[t * 8 + w] = sm;
    }
    __syncthreads();
    if (tid < 64) { float sm = 0.f;
#pragma unroll
        for (int i = 0; i < 8; ++i) sm += red[tid * 8 + i];
        stat[tid] = rsqrtf(sm * (1.0f / 512.0f) + 1e-6f); }
    __syncthreads();
    bf16_t* MX = (bf16_t*)(p.ws + WS_MIXIN);
#pragma unroll
    for (int m = 0; m < 4; ++m) {
        const int t = 16 * m + fr;
        const float rs = stat[t];
#pragma unroll
        for (int n = 0; n < 4; ++n) {
            const int ch = g * 512 + w * 64 + 16 * n + fq * 4;
            const f32x4 nw = *(const f32x4*)(p.s_norm_w + l * 1024 + ch);
            u32x2 wv; wv.x = pk2(acc1[m][n][0] * rs * nw[0], acc1[m][n][1] * rs * nw[1]); wv.y = pk2(acc1[m][n][2] * rs * nw[2], acc1[m][n][3] * rs * nw[3]);
            *(u32x2*)(MX + (size_t)(r0 + t) * D + 1024 + ch) = wv;
        }
    }
    __syncthreads();
}

DEV void smp_mlstm(const P& p, int l, int unit, unsigned char* lds) {
    const int b = unit >> 2, h = unit & 3;
    int tid_ = threadIdx.x; asm volatile("" : "+v"(tid_)); const int tid = tid_, lane = tid & 63, w = tid >> 6;
    const int r0 = NPR + b * 8;
    const bf16_t* U = (const bf16_t*)(p.ws + WS_U) + (size_t)r0 * INP;
    float* qn = (float*)lds; float* kn = qn + 2048; float* vn = kn + 2048; float* qT = vn + 2048; float* kwT = qT + 2048; float* sc = kwT + 2048; float* red = sc + 256;
    const size_t sidx = (size_t)(l * 128 + b) * 4 + h;
    const float* C0 = p.st_C + sidx * 65536; const float* n0 = p.st_n + sidx * 256;
    float* Cout = p.out + O_SC + sidx * 65536;
    if (tid == 0) {
        const float m0 = p.st_m[sidx];
        float bs = 0.f, cm = -INFINITY, mt = 0.f;
        for (int t = 0; t < 8; ++t) {
            const float ig = bf2f(U[(size_t)t * INP + UIG + h]) + p.b_i[l * 4 + h];
            const float lf = logsigf_(bf2f(U[(size_t)t * INP + UFG + h]) + p.b_f[l * 4 + h]);
            bs += lf; const float a = ig - bs; cm = fmaxf(cm, a); mt = bs + fmaxf(m0, cm);
            sc[32 + t] = mt; sc[t] = expf(bs + m0 - mt); sc[40 + t] = a; sc[48 + t] = bs;
        }
        for (int s = 0; s < 8; ++s) sc[16 + s] = expf(bs + sc[40 + s] - mt);
        sc[24] = expf(bs + m0 - mt);
        p.out[O_SM + sidx] = mt;
    }
    __syncthreads();
#pragma unroll
    for (int i = 0; i < 4; ++i) {
        const int idx = tid + 512 * i, t = idx >> 8, d = idx & 255;
        const float q = bf2f(U[(size_t)t * INP + UQ + h * 256 + d]), k = bf2f(U[(size_t)t * INP + UK + h * 256 + d]), v = bf2f(U[(size_t)t * INP + UV + h * 256 + d]);
        qn[t * 256 + d] = q; kn[t * 256 + d] = k; vn[t * 256 + d] = v; qT[d * 8 + t] = q; kwT[d * 8 + t] = k * sc[16 + t];
    }
    __syncthreads();
    {
        const int t = w;
        const f32x4 qv = *(const f32x4*)(qn + t * 256 + lane * 4);
        float dot[9];
#pragma unroll
        for (int s = 0; s < 8; ++s) { const f32x4 kv = *(const f32x4*)(kn + s * 256 + lane * 4); dot[s] = qv[0] * kv[0] + qv[1] * kv[1] + qv[2] * kv[2] + qv[3] * kv[3]; }
        { const f32x4 nv = *(const f32x4*)(n0 + lane * 4); dot[8] = qv[0] * nv[0] + qv[1] * nv[1] + qv[2] * nv[2] + qv[3] * nv[3]; }
#pragma unroll
        for (int s = 0; s < 9; ++s) dot[s] = wave_sum(dot[s]);
        float den = 0.f;
#pragma unroll
        for (int s = 0; s < 8; ++s) { const float sv = (s <= t) ? dot[s] * expf(sc[48 + t] - sc[32 + t] + sc[40 + s]) : 0.f; den += sv; if (lane == 0) sc[64 + t * 8 + s] = sv; }
        den += sc[t] * dot[8];
        if (lane == 0) sc[8 + t] = 1.0f / fmaxf(fabsf(den), expf(-sc[32 + t]));
    }
    if (tid < 256) {
        float a = sc[24] * n0[tid];
#pragma unroll
        for (int s = 0; s < 8; ++s) a += kwT[tid * 8 + s];
        p.out[O_SN + sidx * 256 + tid] = a;
    }
    const int e4 = lane * 4;
    f32x4 num[8], vv[8];
#pragma unroll
    for (int t = 0; t < 8; ++t) { num[t] = (f32x4){0.f, 0.f, 0.f, 0.f}; vv[t] = *(const f32x4*)(vn + t * 256 + e4); }
    const float decay = sc[24];
    {
        f32x4 cn_[8];
#pragma unroll
        for (int j = 0; j < 8; ++j) cn_[j] = __builtin_nontemporal_load((const f32x4*)(C0 + (size_t)(w + 8 * j) * 256 + e4));
#pragma unroll 1
        for (int ib = 0; ib < 4; ++ib) {
            f32x4 cc[8];
#pragma unroll
            for (int j = 0; j < 8; ++j) cc[j] = cn_[j];
            if (ib < 3) {
#pragma unroll
                for (int j = 0; j < 8; ++j) cn_[j] = __builtin_nontemporal_load((const f32x4*)(C0 + (size_t)(w + 8 * ((ib + 1) * 8 + j)) * 256 + e4));
            }
#pragma unroll
            for (int j = 0; j < 8; ++j) {
                const int d = w + 8 * (ib * 8 + j);
                const f32x4 q0 = *(const f32x4*)(qT + d * 8), q1 = *(const f32x4*)(qT + d * 8 + 4), k0 = *(const f32x4*)(kwT + d * 8), k1 = *(const f32x4*)(kwT + d * 8 + 4);
                f32x4 cn = cc[j] * decay;
#pragma unroll
                for (int t = 0; t < 4; ++t) { num[t] += cc[j] * q0[t]; num[4 + t] += cc[j] * q1[t]; cn += vv[t] * k0[t]; cn += vv[4 + t] * k1[t]; }
                __builtin_nontemporal_store(cn, (f32x4*)(Cout + (size_t)d * 256 + e4));
            }
        }
    }
#pragma unroll
    for (int t = 0; t < 8; ++t) *(f32x4*)(red + (w * 8 + t) * 256 + e4) = num[t];
    __syncthreads();
    {
        const int t = w;
        f32x4 hv = (f32x4){0.f, 0.f, 0.f, 0.f};
#pragma unroll
        for (int ww = 0; ww < 8; ++ww) hv += *(const f32x4*)(red + (ww * 8 + t) * 256 + e4);
        hv = hv * sc[t];
#pragma unroll
        for (int s = 0; s < 8; ++s) hv += vv[s] * sc[64 + t * 8 + s];
        hv = hv * sc[8 + t];
        const float mu = wave_sum(hv[0] + hv[1] + hv[2] + hv[3]) * (1.0f / 256.0f);
        const f32x4 dv = hv - mu;
        const float var = wave_sum(dv[0] * dv[0] + dv[1] * dv[1] + dv[2] * dv[2] + dv[3] * dv[3]) * (1.0f / 256.0f);
        const float rs = rsqrtf(var + 1e-6f);
        const uint2 ov = *(const uint2*)(U + (size_t)t * INP + UO + h * 256 + e4);
        const f32x4 nw = *(const f32x4*)(p.m_norm_w + l * 1024 + h * 256 + e4);
        const float o0 = dv[0] * rs * nw[0] * sigmoidf_(bflo(ov.x)), o1 = dv[1] * rs * nw[1] * sigmoidf_(bfhi(ov.x));
        const float o2 = dv[2] * rs * nw[2] * sigmoidf_(bflo(ov.y)), o3 = dv[3] * rs * nw[3] * sigmoidf_(bfhi(ov.y));
        u32x2 wv; wv.x = pk2(o0, o1); wv.y = pk2(o2, o3);
        *(u32x2*)((bf16_t*)(p.ws + WS_MIXIN) + (size_t)(r0 + t) * D + h * 256 + e4) = wv;
    }
    __syncthreads();
}

DEV void smp_ssd(const P& p, int l, int unit, unsigned char* lds) {
    const int b = unit >> 1, g = unit & 1;
    int tid_ = threadIdx.x; asm volatile("" : "+v"(tid_)); const int tid = tid_, lane = tid & 63, w = tid >> 6, fr = lane & 15, fq = lane >> 4;
    const int r0 = NPR + b * 8;
    const bf16_t* U = (const bf16_t*)(p.ws + WS_U) + (size_t)r0 * INP;
    float* xs = (float*)lds;
    float* xwT = xs + 4096;
    float* Bmf = xwT + 4096;
    float* CBs = Bmf + 1024;
    float* bsh = CBs + 64;
    float* dtsh = bsh + 64;
    float* bLs = dtsh + 64;
    float* MW = bLs + 64;
    float* red = MW + 512;
    float* stat = red + 64;
    bf16_t* Cmb = (bf16_t*)(stat + 64);
    if (tid < 64) {
        const int hd = tid >> 3, t = tid & 7, head = g * 8 + hd;
        const float A = -expf(p.A_log[l * 16 + head]), dtb = p.dt_bias[l * 16 + head];
        float bs = 0.f, bL = 0.f, dtt = 0.f;
        for (int s = 0; s < 8; ++s) { const float dt = softplusf_(bf2f(U[(size_t)s * INP + UDT + head]) + dtb); bL += dt * A; if (s <= t) bs += dt * A; if (s == t) dtt = dt; }
        bsh[hd * 8 + t] = bs; dtsh[hd * 8 + t] = dtt; if (t == 0) bLs[hd] = bL;
    }
    for (int i = tid; i < 8 * 136 / 2; i += NTHR) ((unsigned*)(Cmb + 8 * 136))[i] = 0u;
    const float* cw = p.s_conv_w + (size_t)l * 4 * 1536; const float* cb = p.s_conv_b + (size_t)l * 1536;
    const float* cv0 = p.st_sconv + (size_t)(l * 128 + b) * 3 * 1536;
    for (int i = 0; i < 2; ++i) {
        const int it = tid + 512 * i;
        if (it < 768) {
            const int t = it / 96, gidx = it % 96;
            const int ch8 = gidx < 64 ? g * 512 + gidx * 8 : (gidx < 80 ? 1024 + g * 128 + (gidx - 64) * 8 : 1280 + g * 128 + (gidx - 80) * 8);
            float o[8];
            { const f32x4 b0 = *(const f32x4*)(cb + ch8), b1 = *(const f32x4*)(cb + ch8 + 4); o[0] = b0[0]; o[1] = b0[1]; o[2] = b0[2]; o[3] = b0[3]; o[4] = b1[0]; o[5] = b1[1]; o[6] = b1[2]; o[7] = b1[3]; }
#pragma unroll
            for (int j = 0; j < 4; ++j) {
                const int idx = t + j;
                float xf[8];
                if (idx < 3) { const f32x4 a0 = *(const f32x4*)(cv0 + idx * 1536 + ch8), a1 = *(const f32x4*)(cv0 + idx * 1536 + ch8 + 4);
                    xf[0] = a0[0]; xf[1] = a0[1]; xf[2] = a0[2]; xf[3] = a0[3]; xf[4] = a1[0]; xf[5] = a1[1]; xf[6] = a1[2]; xf[7] = a1[3]; }
                else { const uint4 x = *(const uint4*)(U + (size_t)(idx - 3) * INP + UXS + ch8); unpack8(x, xf); }
                const f32x4 w0 = *(const f32x4*)(cw + j * 1536 + ch8), w1 = *(const f32x4*)(cw + j * 1536 + ch8 + 4);
                o[0] += w0[0] * xf[0]; o[1] += w0[1] * xf[1]; o[2] += w0[2] * xf[2]; o[3] += w0[3] * xf[3];
                o[4] += w1[0] * xf[4]; o[5] += w1[1] * xf[5]; o[6] += w1[2] * xf[6]; o[7] += w1[3] * xf[7];
            }
#pragma unroll
            for (int k = 0; k < 8; ++k) o[k] = siluf_(o[k]);
            if (gidx < 64) {
#pragma unroll
                for (int k = 0; k < 8; ++k) xs[t * 512 + gidx * 8 + k] = o[k]; }
            else if (gidx < 80) {
#pragma unroll
                for (int k = 0; k < 8; ++k) Bmf[t * 128 + (gidx - 64) * 8 + k] = o[k]; }
            else { u32x4 wv; wv.x = pk2(o[0], o[1]); wv.y = pk2(o[2], o[3]); wv.z = pk2(o[4], o[5]); wv.w = pk2(o[6], o[7]); *(u32x4*)(Cmb + t * 136 + (gidx - 80) * 8) = wv; }
        }
    }
    __syncthreads();
#pragma unroll
    for (int i = 0; i < 8; ++i) {
        const int idx = tid + 512 * i, hp = idx >> 3, s = idx & 7, hd = hp >> 6;
        xwT[hp * 8 + s] = xs[s * 512 + hp] * expf(bLs[hd] - bsh[hd * 8 + s]) * dtsh[hd * 8 + s];
    }
    if (tid < 64) {
        const int t = tid >> 3, s = tid & 7; float a = 0.f;
        for (int n = 0; n < 128; ++n) a += bf2f(Cmb[t * 136 + n]) * Bmf[s * 128 + n];
        CBs[t * 8 + s] = a;
    }
    __syncthreads();
    { const int hd = tid >> 6, t = (tid >> 3) & 7, s = tid & 7;
      MW[tid] = (s <= t) ? CBs[t * 8 + s] * expf(bsh[hd * 8 + t] - bsh[hd * 8 + s]) * dtsh[hd * 8 + s] : 0.f; }
    __syncthreads();
    const int head = g * 8 + w;
    const size_t sidx = (size_t)(l * 128 + b) * 16 + head;
    const float* S0 = p.st_ssm + sidx * 8192; float* So = p.out + O_SS + sidx * 8192;
    const float dA = expf(bLs[w]);
    f32x4 acc[4];
    f32x4 svn[4][2];
#pragma unroll
    for (int ks = 0; ks < 4; ++ks) { svn[ks][0] = __builtin_nontemporal_load((const f32x4*)(S0 + fr * 128 + 32 * ks + fq * 8)); svn[ks][1] = __builtin_nontemporal_load((const f32x4*)(S0 + fr * 128 + 32 * ks + fq * 8 + 4)); }
#pragma unroll
    for (int nt = 0; nt < 4; ++nt) {
        acc[nt] = (f32x4){0.f, 0.f, 0.f, 0.f};
        const int pp = 16 * nt + fr;
        const f32x4 xw0 = *(const f32x4*)(xwT + (64 * w + pp) * 8), xw1 = *(const f32x4*)(xwT + (64 * w + pp) * 8 + 4);
        f32x4 sv[4][2];
#pragma unroll
        for (int ks = 0; ks < 4; ++ks) { sv[ks][0] = svn[ks][0]; sv[ks][1] = svn[ks][1]; }
        if (nt < 3) {
#pragma unroll
            for (int ks = 0; ks < 4; ++ks) { svn[ks][0] = __builtin_nontemporal_load((const f32x4*)(S0 + (pp + 16) * 128 + 32 * ks + fq * 8)); svn[ks][1] = __builtin_nontemporal_load((const f32x4*)(S0 + (pp + 16) * 128 + 32 * ks + fq * 8 + 4)); }
        }
#pragma unroll
        for (int ks = 0; ks < 4; ++ks) {
            const int n0 = 32 * ks + fq * 8;
            const f32x4 s0 = sv[ks][0], s1 = sv[ks][1];
            union { u32x4 u; bf16x8 v; } bfr;
            bfr.u.x = pk2(s0[0], s0[1]); bfr.u.y = pk2(s0[2], s0[3]); bfr.u.z = pk2(s1[0], s1[1]); bfr.u.w = pk2(s1[2], s1[3]);
            const bf16x8 af = *(const bf16x8*)(Cmb + fr * 136 + n0);
            acc[nt] = mfma16(af, bfr.v, acc[nt]);
            f32x4 o0 = s0 * dA, o1 = s1 * dA;
#pragma unroll
            for (int s = 0; s < 8; ++s) {
                const float xv = s < 4 ? xw0[s & 3] : xw1[s & 3];
                const f32x4 bm0 = *(const f32x4*)(Bmf + s * 128 + n0), bm1 = *(const f32x4*)(Bmf + s * 128 + n0 + 4);
                o0 += bm0 * xv; o1 += bm1 * xv;
            }
            __builtin_nontemporal_store(o0, (f32x4*)(So + pp * 128 + n0)); __builtin_nontemporal_store(o1, (f32x4*)(So + pp * 128 + n0 + 4));
        }
        asm volatile("" ::: "memory");
    }
    const float dsk = p.D_skip[l * 16 + head];
    float gts[4][4];
#pragma unroll
    for (int j = 0; j < 4; ++j) {
        const int t = (fq & 1) * 4 + j;
        const float eb = expf(bsh[w * 8 + t]);
        float ssq = 0.f;
#pragma unroll
        for (int nt = 0; nt < 4; ++nt) {
            const int hp = 64 * w + 16 * nt + fr;
            float y = eb * acc[nt][j] + dsk * xs[t * 512 + hp];
#pragma unroll
            for (int s = 0; s < 8; ++s) y += MW[(w * 8 + t) * 8 + s] * xs[s * 512 + hp];
            const float z = bf2f(U[(size_t)t * INP + UZ + g * 512 + hp]);
            const float gt = y * siluf_(z);
            gts[nt][j] = gt; ssq += gt * gt;
        }
        ssq += __shfl_xor(ssq, 1); ssq += __shfl_xor(ssq, 2); ssq += __shfl_xor(ssq, 4); ssq += __shfl_xor(ssq, 8);
        if (fr == 0 && fq < 2) red[t * 8 + w] = ssq;
    }
    __syncthreads();
    if (tid < 8) { float s = 0.f;
#pragma unroll
        for (int i = 0; i < 8; ++i) s += red[tid * 8 + i];
        stat[tid] = rsqrtf(s * (1.0f / 512.0f) + 1e-6f); }
    __syncthreads();
    if (fq < 2) {
        bf16_t* MX = (bf16_t*)(p.ws + WS_MIXIN);
#pragma unroll
        for (int j = 0; j < 4; ++j) {
            const int t = fq * 4 + j;
#pragma unroll
            for (int nt = 0; nt < 4; ++nt) {
                const int ch = g * 512 + 64 * w + 16 * nt + fr;
                MX[(size_t)(r0 + t) * D + 1024 + ch] = f2bf(gts[nt][j] * stat[t] * p.s_norm_w[l * 1024 + ch]);
            }
        }
    }
    __syncthreads();
}

DEV void phase_ln(const P& p, int l, int which) {
    int tid_ = threadIdx.x; asm volatile("" : "+v"(tid_));
    const int lane = tid_ & 63, w = tid_ >> 6;
    const float* gam = (which ? p.ln2_g : p.ln1_g) + l * D; const float* bet = (which ? p.ln2_b : p.ln1_b) + l * D;
    const bf16_t* mix = (const bf16_t*)(p.ws + WS_MIXF);
    bf16_t* xb = (bf16_t*)(p.ws + WS_XB);
    const bool first = (l == 0 && which == 0), lastp = (l == 1 && which == 1), split = (gridDim.x == 256);
    for (int r = blockIdx.x * 8 + w; r < NTOK; r += gridDim.x * 8) {
        f32x4 y[8]; float s = 0.f;
#pragma unroll
        for (int i = 0; i < 8; ++i) { const int cidx = i * 256 + lane * 4;
            f32x4 xv, mv;
            if (first) xv = *(const f32x4*)((r < NPR ? p.x_prompt + (size_t)r * D : p.x_sample + (size_t)(r - NPR) * D) + cidx);
            else { const uint2 t = *(const uint2*)(xb + (size_t)r * D + cidx); xv = (f32x4){bflo(t.x), bfhi(t.x), bflo(t.y), bfhi(t.y)}; }
            if (split && r >= NPR) { const bf16_t* pp = (const bf16_t*)(p.ws + WS_PART) + (size_t)(r - NPR) * D + cidx; mv = (f32x4){0.f, 0.f, 0.f, 0.f};
#pragma unroll
                for (int k = 0; k < 8; ++k) { const uint2 t = *(const uint2*)(pp + (size_t)k * NSM * D); mv += (f32x4){bflo(t.x), bfhi(t.x), bflo(t.y), bfhi(t.y)}; } }
            else { const uint2 t = *(const uint2*)(mix + (size_t)r * D + cidx); mv = (f32x4){bflo(t.x), bfhi(t.x), bflo(t.y), bfhi(t.y)}; }
            y[i] = xv * ALPHA + mv; s += (y[i][0] + y[i][1]) + (y[i][2] + y[i][3]); }
        const float mu = wave_sum(s) * (1.0f / D);
        float q = 0.f;
#pragma unroll
        for (int i = 0; i < 8; ++i) { y[i] = y[i] - mu; q += (y[i][0] * y[i][0] + y[i][1] * y[i][1]) + (y[i][2] * y[i][2] + y[i][3] * y[i][3]); }
        const float rs = rsqrtf(wave_sum(q) * (1.0f / D) + 1e-5f);
#pragma unroll
        for (int i = 0; i < 8; ++i) { const int cidx = i * 256 + lane * 4;
            const f32x4 o = y[i] * rs * *(const f32x4*)(gam + cidx) + *(const f32x4*)(bet + cidx);
            if (lastp) *(f32x4*)(p.out + (size_t)r * D + cidx) = o;
            else { u32x2 wv; wv.x = pk2(o[0], o[1]); wv.y = pk2(o[2], o[3]); *(u32x2*)(xb + (size_t)r * D + cidx) = wv; } }
    }
}

DEV void phase_ffn_gate(const P& p, int l) {
    const bf16_t* up = (const bf16_t*)(p.ws + WS_UP); bf16_t* act = (bf16_t*)(p.ws + WS_ACT);
    const float* fw = p.f_conv_w + (size_t)l * 3 * DFF2; const float* fb = p.f_conv_b + (size_t)l * DFF2;
    const int total = (NTOK / 8) * (DFF / 8);
    int tid_ = threadIdx.x; asm volatile("" : "+v"(tid_));
    for (int it = blockIdx.x * NTHR + tid_; it < total; it += gridDim.x * NTHR) {
        const int rb = it / (DFF / 8), j8 = (it % (DFF / 8)) * 8, r0 = rb * 8;
        const bool smp = r0 >= NPR; const int t0 = smp ? 0 : (r0 & 2047); const int sb = (r0 - NPR) >> 3;
        float wg[3][8], wv[3][8], bg[8], bv[8];
#pragma unroll
        for (int k = 0; k < 3; ++k) {
            const f32x4 a0 = *(const f32x4*)(fw + k * DFF2 + j8), a1 = *(const f32x4*)(fw + k * DFF2 + j8 + 4), c0 = *(const f32x4*)(fw + k * DFF2 + DFF + j8), c1 = *(const f32x4*)(fw + k * DFF2 + DFF + j8 + 4);
#pragma unroll
            for (int i = 0; i < 4; ++i) { wg[k][i] = a0[i]; wg[k][4 + i] = a1[i]; wv[k][i] = c0[i]; wv[k][4 + i] = c1[i]; }
        }
        { const f32x4 a0 = *(const f32x4*)(fb + j8), a1 = *(const f32x4*)(fb + j8 + 4), c0 = *(const f32x4*)(fb + DFF + j8), c1 = *(const f32x4*)(fb + DFF + j8 + 4);
#pragma unroll
          for (int i = 0; i < 4; ++i) { bg[i] = a0[i]; bg[4 + i] = a1[i]; bv[i] = c0[i]; bv[4 + i] = c1[i]; } }
        float g0[8], g1[8], v0[8], v1[8];
        if (t0 > 0) {
            unpack8(*(const uint4*)(up + (size_t)(r0 - 2) * DFF2 + j8), g0); unpack8(*(const uint4*)(up + (size_t)(r0 - 2) * DFF2 + DFF + j8), v0);
            unpack8(*(const uint4*)(up + (size_t)(r0 - 1) * DFF2 + j8), g1); unpack8(*(const uint4*)(up + (size_t)(r0 - 1) * DFF2 + DFF + j8), v1);
        } else if (smp) {
            const float* bp = p.st_fconv + (size_t)(l * 128 + sb) * 2 * DFF2;
            const f32x4 a0 = *(const f32x4*)(bp + j8), a1 = *(const f32x4*)(bp + j8 + 4), c0 = *(const f32x4*)(bp + DFF + j8), c1 = *(const f32x4*)(bp + DFF + j8 + 4);
            const f32x4 d0 = *(const f32x4*)(bp + DFF2 + j8), d1 = *(const f32x4*)(bp + DFF2 + j8 + 4), e0 = *(const f32x4*)(bp + DFF2 + DFF + j8), e1 = *(const f32x4*)(bp + DFF2 + DFF + j8 + 4);
#pragma unroll
            for (int i = 0; i < 4; ++i) { g0[i] = a0[i]; g0[4 + i] = a1[i]; v0[i] = c0[i]; v0[4 + i] = c1[i]; g1[i] = d0[i]; g1[4 + i] = d1[i]; v1[i] = e0[i]; v1[4 + i] = e1[i]; }
        } else {
#pragma unroll
            for (int i = 0; i < 8; ++i) { g0[i] = 0.f; g1[i] = 0.f; v0[i] = 0.f; v1[i] = 0.f; }
        }
#pragma unroll
        for (int rr = 0; rr < 8; ++rr) {
            float g2[8], v2[8];
            unpack8(*(const uint4*)(up + (size_t)(r0 + rr) * DFF2 + j8), g2); unpack8(*(const uint4*)(up + (size_t)(r0 + rr) * DFF2 + DFF + j8), v2);
            float o[8];
#pragma unroll
            for (int i = 0; i < 8; ++i) {
                const float ag = bg[i] + wg[0][i] * g0[i] + wg[1][i] * g1[i] + wg[2][i] * g2[i];
                const float av = bv[i] + wv[0][i] * v0[i] + wv[1][i] * v1[i] + wv[2][i] * v2[i];
                o[i] = ag * __builtin_amdgcn_rcpf(1.0f + __expf(-ag)) * av;
                g0[i] = g1[i]; g1[i] = g2[i]; v0[i] = v1[i]; v1[i] = v2[i];
            }
            u32x4 wv4; wv4.x = pk2(o[0], o[1]); wv4.y = pk2(o[2], o[3]); wv4.z = pk2(o[4], o[5]); wv4.w = pk2(o[6], o[7]);
            *(u32x4*)(act + (size_t)(r0 + rr) * DFF + j8) = wv4;
        }
    }
    const int tot2 = 132 * 2 * (DFF2 / 8);
    for (int it = blockIdx.x * NTHR + tid_; it < tot2; it += gridDim.x * NTHR) {
        const int c8 = (it % (DFF2 / 8)) * 8, rr = it / (DFF2 / 8), j = rr & 1, sq = rr >> 1;
        float* o; size_t row;
        if (sq < 4) { o = p.out + O_PFC + ((size_t)(l * 4 + sq) * 2 + j) * DFF2 + c8; row = (size_t)sq * 2048 + 2046 + j; }
        else { const int b = sq - 4; o = p.out + O_SFC + ((size_t)(l * 128 + b) * 2 + j) * DFF2 + c8; row = (size_t)NPR + b * 8 + 6 + j; }
        float xf[8]; unpack8(*(const uint4*)(up + row * DFF2 + c8), xf);
        *(f32x4*)o = (f32x4){xf[0], xf[1], xf[2], xf[3]}; *(f32x4*)(o + 4) = (f32x4){xf[4], xf[5], xf[6], xf[7]};
    }
}


#define XB_TMO      128
#define XB_XCNT(j)  (256  + 64 * (j))
#define XB_XSUB(j)  (1280 + 64 * (j))
#define XB_XGEN(j)  (2304 + 64 * (j))
#define XB_TOP      3328
#define XB_TOPGEN   3392
#define XCD_BAR_WORDS 3456
#define XB_SPIN_CAP (1u << 20)
DEV unsigned xb_ld(unsigned* p)              { return __hip_atomic_load(p, __ATOMIC_RELAXED, __HIP_MEMORY_SCOPE_AGENT); }
DEV unsigned xb_add(unsigned* p, unsigned v) { return __hip_atomic_fetch_add(p, v, __ATOMIC_RELAXED, __HIP_MEMORY_SCOPE_AGENT); }
DEV unsigned xb_xcc_id() { return (unsigned)__builtin_amdgcn_s_getreg((3 << 11) | 20) & 0xFu; }
#define XB_SPIN(cond, bar) do { unsigned _sp = 0; while (cond) { __builtin_amdgcn_s_sleep(1); \
    if ((++_sp & 255u) == 0u) { if (xb_ld(&(bar)[XB_TMO])) break; if (_sp > XB_SPIN_CAP) { atomicAdd(&(bar)[XB_TMO], 1u); break; } } } } while (0)
struct XcdBarrier { unsigned* bar; unsigned x; volatile LAS unsigned* st; };
DEV XcdBarrier xcd_barrier_post(unsigned* bar, volatile LAS unsigned* st) {
    XcdBarrier b; b.bar = bar; b.x = xb_xcc_id(); b.st = st;
    if (threadIdx.x == 0) (void)xb_add(&bar[XB_XCNT(b.x)], 1u);
    return b;
}
DEV void xcd_barrier_complete(unsigned* bar, unsigned x, unsigned& nloc, unsigned& nx) {
    const unsigned G = gridDim.x * gridDim.y * gridDim.z;
    unsigned sum, cnt, mine, sp = 0u;
    for (;;) {
        sum = 0u; cnt = 0u; mine = 0u;
#pragma unroll
        for (unsigned j = 0; j < 16; ++j) { const unsigned c = xb_ld(&bar[XB_XCNT(j)]); sum += c; cnt += (c > 0u) ? 1u : 0u; mine = (j == x) ? c : mine; }
        if (sum == G) break;
        __builtin_amdgcn_s_sleep(1);
        if ((++sp & 255u) == 0u) { if (xb_ld(&bar[XB_TMO])) break; if (sp > XB_SPIN_CAP) { atomicAdd(&bar[XB_TMO], 1u); break; } }
    }
    nloc = mine > 0u ? mine : 1u; nx = cnt > 0u ? cnt : 1u;
}
DEV void xcd_barrier(const XcdBarrier& b) {
    asm volatile("s_waitcnt vmcnt(0)" ::: "memory");
    __syncthreads();
    if (threadIdx.x == 0) {
        unsigned* bar = b.bar;
        __builtin_amdgcn_s_waitcnt(0);
        unsigned nloc = b.st[0], nx = b.st[1];
        if (nloc == 0u) { xcd_barrier_complete(bar, b.x, nloc, nx); b.st[0] = nloc; b.st[1] = nx; }
        const unsigned old = xb_add(&bar[XB_XSUB(b.x)], 1u);
        const unsigned gen = old / nloc;
        if (old + 1u == (gen + 1u) * nloc) {
            __builtin_amdgcn_fence(__ATOMIC_RELEASE, "agent");
            asm volatile("s_waitcnt vmcnt(0)" ::: "memory");
            const unsigned og = xb_add(&bar[XB_TOP], 1u);
            const unsigned tg = og / nx;
            if (og + 1u == (tg + 1u) * nx) xb_add(&bar[XB_TOPGEN], 1u);
            else XB_SPIN(xb_ld(&bar[XB_TOPGEN]) == tg, bar);
            __builtin_amdgcn_fence(__ATOMIC_ACQUIRE, "agent");
            xb_add(&bar[XB_XGEN(b.x)], 1u);
            asm volatile("s_waitcnt vmcnt(0)" ::: "memory");
        } else {
            XB_SPIN(xb_ld(&bar[XB_XGEN(b.x)]) == gen, bar);
            __builtin_amdgcn_fence(__ATOMIC_ACQUIRE, "agent");
            asm volatile("s_waitcnt vmcnt(0)" ::: "memory");
        }
    }
    __syncthreads();
}

constexpr int NPHASE = 21;
DEV void run_phase(const P& p, int l, int q, unsigned char* lds) {
    int bid = blockIdx.x, G = gridDim.x; asm volatile("" : "+s"(bid), "+s"(G));
    if (q == 0) {
        pg8::Gemm g{(const bf16_t*)(p.ws + WS_XB), (const bf16_t*)(p.ws + WS_WIN) + (size_t)l * INP * D, NTOK, INP, D};
        pg8::StaticOrder S; S.init(NTOK, INP, D, G, bid);
        pg8::EpiBf16 E{(bf16_t*)(p.ws + WS_U), INP, nullptr};
        pg8::gemm_phase<pg8::EpiBf16, pg8::StaticOrder>((LAS unsigned char*)lds, g, S, E);
    } else if (q == 1) {
        const int par = bid & 1;
#pragma unroll 1
        for (int half = 0; half < 2; ++half) {
            if ((half ^ par) == 0) {
                for (int u = bid; u < 512; u += G) smp_mlstm(p, l, u, lds);
                for (int u = bid; u < 256; u += G) smp_ssd(p, l, u, lds);
            } else {
                for (int u = bid; u < 512; u += G) mlstm_local(p, l, u, lds);
                for (int u = bid; u < 256; u += G) ssd_local(p, l, u, lds);
            }
        }
    } else if (q == 2) {
        for (int u = bid; u < 256; u += G) mlstm_scan(p, l, u, lds);
        for (int u = bid; u < 256; u += G) ssd_scan(p, l, u, lds);
        for (int u = bid; u < 132; u += G) convstate_copy(p, l, u);
    } else if (q == 3) {
        for (int u = bid; u < 512; u += G) mlstm_out(p, l, u, lds);
        for (int u = bid; u < 256; u += G) ssd_out(p, l, u, lds);
    } else if (q == 4) {
        pg8::Gemm g{(const bf16_t*)(p.ws + WS_MIXIN), (const bf16_t*)(p.ws + WS_WOUT) + (size_t)l * D * D, NTOK, D, D};
        pg8::EpiBf16 E{(bf16_t*)(p.ws + WS_MIXF), D, (float*)(p.ws + WS_PART)};
        if (G == 256) { pg8::TailSplitOrder S; S.init(D, bid); pg8::gemm_phase<pg8::EpiBf16, pg8::TailSplitOrder>((LAS unsigned char*)lds, g, S, E); }
        else { pg8::StaticOrder S; S.init(NTOK, D, D, G, bid); pg8::gemm_phase<pg8::EpiBf16, pg8::StaticOrder>((LAS unsigned char*)lds, g, S, E); }
    } else if (q == 5) {
        phase_ln(p, l, 0);
    } else if (q == 6) {
        pg8::Gemm g{(const bf16_t*)(p.ws + WS_XB), (const bf16_t*)(p.ws + WS_WUP) + (size_t)l * DFF2 * D, NTOK, DFF2, D};
        pg8::StaticOrder S; S.init(NTOK, DFF2, D, G, bid);
        pg8::EpiBf16 E{(bf16_t*)(p.ws + WS_UP), DFF2, nullptr};
        pg8::gemm_phase<pg8::EpiBf16, pg8::StaticOrder>((LAS unsigned char*)lds, g, S, E);
        if (l == 0 && G == 256 && bid >= 12) phase_prologue(p, lds, 1, 2, false, bid - 12, 244);
    } else if (q == 7) {
        phase_ffn_gate(p, l);
    } else if (q == 8) {
        pg8::Gemm g{(const bf16_t*)(p.ws + WS_ACT), (const bf16_t*)(p.ws + WS_WDN) + (size_t)l * D * DFF, NTOK, D, DFF};
        pg8::EpiBf16 E{(bf16_t*)(p.ws + WS_MIXF), D, (float*)(p.ws + WS_PART)};
        if (G == 256) { pg8::TailSplitOrder S; S.init(DFF, bid); pg8::gemm_phase<pg8::EpiBf16, pg8::TailSplitOrder>((LAS unsigned char*)lds, g, S, E); }
        else { pg8::StaticOrder S; S.init(NTOK, D, DFF, G, bid); pg8::gemm_phase<pg8::EpiBf16, pg8::StaticOrder>((LAS unsigned char*)lds, g, S, E); }
    } else {
        phase_ln(p, l, 1);
    }
}
#if MK_MULTI
template <int T> __global__ void __launch_bounds__(NTHR, 2) k_unit(P p) {
    extern __shared__ __attribute__((aligned(16))) unsigned char lds[];
    const int l = p.ph_lo; int bid = blockIdx.x, G = gridDim.x;
    if (T == 11) for (int u = bid; u < 512; u += G) smp_mlstm(p, l, u, lds);
    if (T == 12) for (int u = bid; u < 256; u += G) smp_ssd(p, l, u, lds);
    if (T == 13) for (int u = bid; u < 512; u += G) mlstm_local(p, l, u, lds);
    if (T == 14) for (int u = bid; u < 256; u += G) ssd_local(p, l, u, lds);
    if (T == 31) for (int u = bid; u < 512; u += G) mlstm_out(p, l, u, lds);
    if (T == 32) for (int u = bid; u < 256; u += G) ssd_out(p, l, u, lds);
    if (T == 21) for (int u = bid; u < 256; u += G) mlstm_scan(p, l, u, lds);
    if (T == 22) for (int u = bid; u < 256; u += G) ssd_scan(p, l, u, lds);
}
template <int Q> __global__ void __launch_bounds__(NTHR, 2) k_phase(P p) {
    extern __shared__ __attribute__((aligned(16))) unsigned char lds[];
    if (Q < 0) phase_prologue(p, lds, 0, gridDim.x == 256 ? 1 : 2, true, blockIdx.x, gridDim.x); else run_phase(p, p.ph_lo, Q, lds);
}
#else
__global__ void __launch_bounds__(NTHR, 2) mk_fwd(P p) {
    extern __shared__ __attribute__((aligned(16))) unsigned char lds[];
    cg::grid_group grid = cg::this_grid();
    if (p.ph_hi < 0) grid.sync();
    if (threadIdx.x < 4) ((unsigned*)(lds + LDS_BYTES - 16))[threadIdx.x] = 0u;
    __syncthreads();
    (void)xcd_barrier_post((unsigned*)(p.ws + WS_BAR), (volatile LAS unsigned*)(lds + LDS_BYTES - 16));
#define GSYNC() do { XcdBarrier b_; b_.bar = (unsigned*)(p.ws + WS_BAR); b_.x = xb_xcc_id(); b_.st = (volatile LAS unsigned*)(lds + LDS_BYTES - 16); xcd_barrier(b_); } while (0)
    phase_prologue(p, lds, 0, gridDim.x == 256 ? 1 : 2, true, blockIdx.x, gridDim.x);
#pragma unroll 1
    for (int l = 0; l < 2; ++l) {
        GSYNC(); run_phase(p, l, 0, lds);
        GSYNC(); run_phase(p, l, 1, lds);
        GSYNC(); run_phase(p, l, 2, lds);
        GSYNC(); run_phase(p, l, 3, lds);
        GSYNC(); run_phase(p, l, 4, lds);
        GSYNC(); run_phase(p, l, 5, lds);
        GSYNC(); run_phase(p, l, 6, lds);
        GSYNC(); run_phase(p, l, 7, lds);
        GSYNC(); run_phase(p, l, 8, lds);
        GSYNC(); run_phase(p, l, 9, lds);
    }
    for (int i = 0; i < PROBE_SYNCS; ++i) GSYNC();
}
#endif

extern "C" void kernel_launch(void* const* d_in, const int* in_sizes, int n_in, void* d_out, int out_size, void* d_ws, size_t ws_size, hipStream_t stream) {
    static int grid = 0;
    if (grid == 0) {
        if (n_in != 27 || ws_size < WS_END) { fprintf(stderr, "kernel_launch: unexpected n_in %d or ws_size %zu (need %zu)\n", n_in, ws_size, (size_t)WS_END); grid = -1; return; }
        int dev = 0, cus = 0, per_cu = 0;
        hipGetDevice(&dev);
        hipDeviceGetAttribute(&cus, hipDeviceAttributeMultiprocessorCount, dev);
#if MK_MULTI
        const void* fns[11] = {(const void*)k_phase<-1>, (const void*)k_phase<0>, (const void*)k_phase<1>, (const void*)k_phase<2>, (const void*)k_phase<3>, (const void*)k_phase<4>, (const void*)k_phase<5>,
                               (const void*)k_phase<6>, (const void*)k_phase<7>, (const void*)k_phase<8>, (const void*)k_phase<9>};
        for (int i = 0; i < 11; ++i) if (hipFuncSetAttribute(fns[i], hipFuncAttributeMaxDynamicSharedMemorySize, LDS_BYTES) != hipSuccess) { fprintf(stderr, "kernel_launch: hipFuncSetAttribute failed\n"); grid = -1; return; }
#else
        if (hipFuncSetAttribute((const void*)mk_fwd, hipFuncAttributeMaxDynamicSharedMemorySize, LDS_BYTES) != hipSuccess) { fprintf(stderr, "kernel_launch: hipFuncSetAttribute failed\n"); grid = -1; return; }
        hipOccupancyMaxActiveBlocksPerMultiprocessor(&per_cu, (const void*)mk_fwd, NTHR, LDS_BYTES);
        (void)hipGetLastError();
#endif
        (void)per_cu;
        grid = cus * 1;
    }
    if (grid < 0) return;
    P p{};
    const float** pp = (const float**)&p;
    for (int i = 0; i < 27; ++i) pp[i] = (const float*)d_in[i];
    p.out = (float*)d_out; p.ws = (unsigned char*)d_ws;
#if MK_MULTI
    p.ph_lo = 0; p.ph_hi = 0;
    if (PROBE_REP == -1) hipLaunchKernelGGL(k_phase<-1>, dim3(grid), dim3(NTHR), LDS_BYTES, stream, p);
    hipLaunchKernelGGL(k_phase<-1>, dim3(grid), dim3(NTHR), LDS_BYTES, stream, p);
    for (int l = 0; l < 2; ++l) {
        p.ph_lo = l;
        for (int rep = 0; rep < 1 + ((PROBE_REP == 0) || (PROBE_REP == 100 && (0 == 0 || 0 == 4 || 0 == 6 || 0 == 8))); ++rep) hipLaunchKernelGGL(k_phase<0>, dim3(grid), dim3(NTHR), LDS_BYTES, stream, p);
        for (int rep = 0; rep < 1 + ((PROBE_REP == 1) || (PROBE_REP == 100 && (1 == 0 || 1 == 4 || 1 == 6 || 1 == 8))); ++rep) hipLaunchKernelGGL(k_phase<1>, dim3(grid), dim3(NTHR), LDS_BYTES, stream, p);
        for (int rep = 0; rep < 1 + ((PROBE_REP == 2) || (PROBE_REP == 100 && (2 == 0 || 2 == 4 || 2 == 6 || 2 == 8))); ++rep) hipLaunchKernelGGL(k_phase<2>, dim3(grid), dim3(NTHR), LDS_BYTES, stream, p);
        for (int rep = 0; rep < 1 + ((PROBE_REP == 3) || (PROBE_REP == 100 && (3 == 0 || 3 == 4 || 3 == 6 || 3 == 8))); ++rep) hipLaunchKernelGGL(k_phase<3>, dim3(grid), dim3(NTHR), LDS_BYTES, stream, p);
        if (PROBE_REP == 11 || PROBE_REP == 12 || PROBE_REP == 13 || PROBE_REP == 14 || PROBE_REP == 31 || PROBE_REP == 32 || PROBE_REP == 21 || PROBE_REP == 22) {
            hipFuncSetAttribute((const void*)k_unit<PROBE_REP>, hipFuncAttributeMaxDynamicSharedMemorySize, LDS_BYTES);
            hipLaunchKernelGGL(k_unit<PROBE_REP>, dim3(grid), dim3(NTHR), LDS_BYTES, stream, p);
        }
        for (int rep = 0; rep < 1 + ((PROBE_REP == 4) || (PROBE_REP == 100 && (4 == 0 || 4 == 4 || 4 == 6 || 4 == 8))); ++rep) hipLaunchKernelGGL(k_phase<4>, dim3(grid), dim3(NTHR), LDS_BYTES, stream, p);
        for (int rep = 0; rep < 1 + ((PROBE_REP == 5) || (PROBE_REP == 100 && (5 == 0 || 5 == 4 || 5 == 6 || 5 == 8))); ++rep) hipLaunchKernelGGL(k_phase<5>, dim3(grid), dim3(NTHR), LDS_BYTES, stream, p);
        for (int rep = 0; rep < 1 + ((PROBE_REP == 6) || (PROBE_REP == 100 && (6 == 0 || 6 == 4 || 6 == 6 || 6 == 8))); ++rep) hipLaunchKernelGGL(k_phase<6>, dim3(grid), dim3(NTHR), LDS_BYTES, stream, p);
        for (int rep = 0; rep < 1 + ((PROBE_REP == 7) || (PROBE_REP == 100 && (7 == 0 || 7 == 4 || 7 == 6 || 7 == 8))); ++rep) hipLaunchKernelGGL(k_phase<7>, dim3(grid), dim3(NTHR), LDS_BYTES, stream, p);
        for (int rep = 0; rep < 1 + ((PROBE_REP == 8) || (PROBE_REP == 100 && (8 == 0 || 8 == 4 || 8 == 6 || 8 == 8))); ++rep) hipLaunchKernelGGL(k_phase<8>, dim3(grid), dim3(NTHR), LDS_BYTES, stream, p);
        for (int rep = 0; rep < 1 + ((PROBE_REP == 9) || (PROBE_REP == 100 && (9 == 0 || 9 == 4 || 9 == 6 || 9 == 8))); ++rep) hipLaunchKernelGGL(k_phase<9>, dim3(grid), dim3(NTHR), LDS_BYTES, stream, p);
    }
#else
    p.ph_lo = 0; p.ph_hi = NPHASE;
    if (hipMemsetAsync((char*)d_ws + WS_BAR, 0, 16384, stream) != hipSuccess) { fprintf(stderr, "kernel_launch: memset failed\n"); return; }
    void* args[] = {&p};
    hipError_t e = hipLaunchCooperativeKernel((const void*)mk_fwd, dim3(grid), dim3(NTHR), args, LDS_BYTES, stream);
    if (e != hipSuccess) fprintf(stderr, "cooperative launch failed: %s (grid %d)\n", hipGetErrorString(e), grid);
#endif
}
```

```cpp
#include <hip/hip_runtime.h>
#include <hip/hip_cooperative_groups.h>
#include <cstdio>
namespace cg = cooperative_groups;

#ifndef MK_MULTI
#define MK_MULTI 0
#endif
#ifndef PROBE_REP
#define PROBE_REP -99
#endif
#ifndef PROBE_SYNCS
#define PROBE_SYNCS 0
#endif

#define DEV __device__ __forceinline__
#define LAS __attribute__((address_space(3)))
typedef unsigned short bf16_t;
typedef short bf16x8 __attribute__((ext_vector_type(8)));
typedef float f32x4 __attribute__((ext_vector_type(4)));
typedef float f32x2 __attribute__((ext_vector_type(2)));
typedef unsigned u32x4 __attribute__((ext_vector_type(4)));
typedef unsigned u32x2 __attribute__((ext_vector_type(2)));

constexpr int D = 2048, NPR = 8192, NSM = 1024, NTOK = 9216, INP = 6912, IN_DIM = 6680, DFF = 5504, DFF2 = 11008;
constexpr int UQ = 0, UK = 1024, UV = 2048, UO = 3072, UZ = 4096, UXS = 5120, UIG = 6656, UFG = 6660, UDT = 6664;
constexpr int NTHR = 512;
constexpr int LDS_BYTES = 136 * 1024;
constexpr float ALPHA = 1.41421356237309515f;

constexpr size_t O_YP = 0;
constexpr size_t O_YS = O_YP + (size_t)4 * 2048 * 2048;
constexpr size_t O_PC = O_YS + (size_t)128 * 8 * 2048;
constexpr size_t O_PN = O_PC + (size_t)2 * 4 * 4 * 256 * 256;
constexpr size_t O_PM = O_PN + (size_t)2 * 4 * 4 * 256;
constexpr size_t O_PS = O_PM + (size_t)2 * 4 * 4;
constexpr size_t O_PSC = O_PS + (size_t)2 * 4 * 16 * 64 * 128;
constexpr size_t O_PFC = O_PSC + (size_t)2 * 4 * 3 * 1536;
constexpr size_t O_SC = O_PFC + (size_t)2 * 4 * 2 * DFF2;
constexpr size_t O_SN = O_SC + (size_t)2 * 128 * 4 * 256 * 256;
constexpr size_t O_SM = O_SN + (size_t)2 * 128 * 4 * 256;
constexpr size_t O_SS = O_SM + (size_t)2 * 128 * 4;
constexpr size_t O_SSC = O_SS + (size_t)2 * 128 * 16 * 64 * 128;
constexpr size_t O_SFC = O_SSC + (size_t)2 * 128 * 3 * 1536;

constexpr size_t WS_WIN = 0;
constexpr size_t WS_WOUT = WS_WIN + (size_t)2 * INP * D * 2;
constexpr size_t WS_WUP = WS_WOUT + (size_t)2 * D * D * 2;
constexpr size_t WS_WDN = WS_WUP + (size_t)2 * DFF2 * D * 2;
constexpr size_t WS_XB = WS_WDN + (size_t)2 * D * DFF * 2;
constexpr size_t WS_XF = WS_XB + (size_t)NTOK * D * 2;
constexpr size_t WS_XBC = WS_XF;
constexpr size_t WS_U = WS_XF + (size_t)NTOK * D * 4;
constexpr size_t WS_MIXIN = WS_U + (size_t)NTOK * INP * 2;
constexpr size_t WS_MIXF = WS_MIXIN + (size_t)NTOK * D * 2;
constexpr size_t WS_UP = WS_MIXF + (size_t)NTOK * D * 4;
constexpr size_t WS_ACT = WS_UP + (size_t)NTOK * DFF2 * 2;
constexpr size_t WS_PART = WS_ACT + (size_t)NTOK * DFF * 2;
constexpr size_t WS_SMALL = WS_PART + (size_t)8 * NSM * D * 4;
constexpr size_t WS_DBUF = WS_UP;
constexpr size_t WS_SBUF = WS_UP + (size_t)512 * 65536 * 4;
constexpr size_t WS_CT = WS_ACT;
constexpr size_t WS_ST = WS_ACT + (size_t)512 * 65536 * 2;
static_assert(WS_SBUF + (size_t)2048 * 8192 * 4 <= WS_ACT, "alias");
static_assert(WS_ST + (size_t)2048 * 8192 * 2 <= WS_PART, "alias");
constexpr size_t WS_NLOC = WS_SMALL;
constexpr size_t WS_NST = WS_NLOC + (size_t)512 * 256 * 4;
constexpr size_t WS_GSTAT = WS_NST + (size_t)512 * 256 * 4;
constexpr size_t WS_MST = WS_GSTAT + 4096;
constexpr size_t WS_SBSUM = WS_MST + 4096;
constexpr size_t WS_BAR = WS_SBSUM + 8192;
constexpr size_t WS_END = WS_BAR + 16384;

struct P {
    const float* x_prompt; const float* x_sample; const float* st_C; const float* st_n; const float* st_m; const float* st_ssm; const float* st_sconv; const float* st_fconv;
    const float* w_in; const float* b_i; const float* b_f; const float* m_norm_w; const float* s_conv_w; const float* s_conv_b; const float* dt_bias; const float* A_log; const float* D_skip;
    const float* s_norm_w; const float* w_out; const float* ln1_g; const float* ln1_b; const float* w_up; const float* f_conv_w; const float* f_conv_b; const float* w_down; const float* ln2_g; const float* ln2_b;
    float* out; unsigned char* ws; int ph_lo, ph_hi;
};

DEV float bf2f(bf16_t v) { return __uint_as_float(((unsigned)v) << 16); }
DEV bf16_t f2bf(float f) { unsigned u = __float_as_uint(f); u += 0x7FFFu + ((u >> 16) & 1u); return (bf16_t)(u >> 16); }
DEV unsigned pk2(float lo, float hi) { return (unsigned)f2bf(lo) | ((unsigned)f2bf(hi) << 16); }
DEV float bflo(unsigned w) { return __uint_as_float(w << 16); }
DEV float bfhi(unsigned w) { return __uint_as_float(w & 0xffff0000u); }
DEV float sigmoidf_(float x) { return __builtin_amdgcn_rcpf(1.0f + __expf(-x)); }
DEV float siluf_(float x) { return x * sigmoidf_(x); }
DEV float softplusf_(float x) { return fmaxf(x, 0.f) + log1pf(expf(-fabsf(x))); }
DEV float logsigf_(float x) { return fminf(x, 0.f) - log1pf(expf(-fabsf(x))); }
DEV float wave_sum(float v) {
#pragma unroll
    for (int o = 32; o >= 1; o >>= 1) v += __shfl_xor(v, o);
    return v; }
DEV float wave_max(float v) {
#pragma unroll
    for (int o = 32; o >= 1; o >>= 1) v = fmaxf(v, __shfl_xor(v, o));
    return v; }
DEV float wave_incl_sum(float v, int lane) {
#pragma unroll
    for (int o = 1; o < 64; o <<= 1) { float t = __shfl_up(v, o); if (lane >= o) v += t; }
    return v; }
DEV float wave_incl_max(float v, int lane) {
#pragma unroll
    for (int o = 1; o < 64; o <<= 1) { float t = __shfl_up(v, o); if (lane >= o) v = fmaxf(v, t); }
    return v; }
DEV f32x4 mfma16(bf16x8 a, bf16x8 b, f32x4 c) { return __builtin_amdgcn_mfma_f32_16x16x32_bf16(a, b, c, 0, 0, 0); }
DEV void unpack8(uint4 x, float (&f)[8]) { f[0] = bflo(x.x); f[1] = bfhi(x.x); f[2] = bflo(x.y); f[3] = bfhi(x.y); f[4] = bflo(x.z); f[5] = bfhi(x.z); f[6] = bflo(x.w); f[7] = bfhi(x.w); }

typedef short s16x4 __attribute__((ext_vector_type(4)));
DEV bf16x8 tr_frag(const bf16_t* T, int pitch, int krow0, int col0, int lane) {
    const int g = lane >> 4, q = (lane & 15) >> 2, pl = lane & 3;
    const bf16_t* a0 = T + (krow0 + 8 * g + q) * pitch + col0 + 4 * pl;
    const s16x4 lo = __builtin_amdgcn_ds_read_tr16_b64_v4i16((LAS s16x4*)a0);
    const s16x4 hi = __builtin_amdgcn_ds_read_tr16_b64_v4i16((LAS s16x4*)(a0 + 4 * pitch));
    return (bf16x8){lo[0], lo[1], lo[2], lo[3], hi[0], hi[1], hi[2], hi[3]};
}

namespace pg8 {
constexpr int BM = 256, BK = 64, HALF = 128, HTB = HALF * BK * 2, STAGE_BYTES = 8 * HTB, NXCD = 8, WGM = 8;
DEV int lds_byte(int r, int c) { const int st = (r >> 4) * 2 + (c >> 5), rr = r & 15, cc = c & 31, ob = rr * 64 + cc * 2; return st * 1024 + (ob ^ (((ob >> 9) & 1) << 5)); }
DEV void stage_rc(int b, int& R, int& C) { const int st = b / 1024, sb = b % 1024, swz = sb ^ (((sb >> 9) & 1) << 5); R = (st >> 1) * 16 + swz / 64; C = (st & 1) * 32 + (swz % 64) / 2; }
DEV int perm32(int rho) { const int n = rho >> 4, i = rho & 15; return 8 * (i >> 2) + 4 * n + (i & 3); }
struct Unit { int pm, pn, k0, nt, ks; };
struct Gemm { const bf16_t* A; const bf16_t* Bt; int M, N, K; };
struct StaticOrder {
    int nM, nN, nwg, G, c, ntk;
    DEV void init(int M, int N, int K, int G_, int c_) { nM = M / BM; nN = N / BM; nwg = nM * nN; G = G_; c = c_; ntk = K / BK; }
    DEV bool next(int i, Unit& u) const {
        u.pm = 0; u.pn = 0; u.k0 = 0; u.nt = 4; u.ks = -1;
        const long L = (long)i * G + c; if (L >= nwg) return false;
        int wgid = (int)L; { const int q = nwg / NXCD, r = nwg % NXCD, xcd = wgid % NXCD, off = wgid / NXCD; wgid = (xcd < r ? xcd * (q + 1) : r * (q + 1) + (xcd - r) * q) + off; }
        const int nig = WGM * nN, gid = wgid / nig, fm = gid * WGM, gsz = (nM - fm) < WGM ? (nM - fm) : WGM;
        u.pm = fm + ((wgid % nig) % gsz); u.pn = (wgid % nig) / gsz; u.k0 = 0; u.nt = ntk; u.ks = -1; return true;
    }
};
struct TailSplitOrder {
    StaticOrder so; int c, ntk;
    DEV void init(int K, int c_) { so.init(NPR, D, K, 256, c_); c = c_; ntk = K / BK; }
    DEV bool next(int i, Unit& u) const {
        u.pm = 0; u.pn = 0; u.k0 = 0; u.nt = 4; u.ks = -1;
        if (i == 0) return so.next(0, u);
        if (i > 1) return false;
        const int tt = c >> 3, ks = c & 7; u.pm = 32 + (tt >> 3); u.pn = tt & 7; u.ks = ks;
        const int pairs = ntk >> 1, base = pairs >> 3, rem = pairs & 7;
        const int p0 = ks * base + (ks < rem ? ks : rem), np = base + (ks < rem ? 1 : 0);
        u.k0 = p0 * 128; u.nt = np * 2; return true;
    }
};
DEV unsigned cvt_pk_bf16(float lo, float hi) { unsigned r; asm volatile("v_cvt_pk_bf16_f32 %0, %1, %2" : "=v"(r) : "v"(lo), "v"(hi)); return r; }
struct EpiF32 {
    static constexpr bool PERM = false;
    float* C; int ldc; float* part;
    DEV void operator()(const f32x4 (&acc)[2][2][4][2], const Unit& u, int wr, int wc, int fr, int fq) const {
        const int row0 = u.pm * BM + wr * 64 + fr, col0 = u.pn * BM + wc * 32 + 4 * fq;
        float* Cb = u.ks < 0 ? C : part + (size_t)u.ks * NSM * D - (size_t)NPR * ldc;
#pragma unroll
        for (int ai = 0; ai < 2; ++ai)
#pragma unroll
            for (int m = 0; m < 4; ++m) { float* rowp = Cb + (size_t)(row0 + ai * HALF + m * 16) * ldc + col0;
#pragma unroll
                for (int bj = 0; bj < 2; ++bj)
#pragma unroll
                    for (int n = 0; n < 2; ++n) *(f32x4*)(rowp + bj * HALF + n * 16) = acc[ai][bj][m][n]; }
    }
};
struct EpiBf16 {
    static constexpr bool PERM = true;
    bf16_t* O; int ldc; float* part;
    DEV void operator()(const f32x4 (&acc)[2][2][4][2], const Unit& u, int wr, int wc, int fr, int fq) const {
        const int row0 = u.pm * BM + wr * 64 + fr; const int col0 = u.pn * BM + wc * 32 + 8 * fq;
        if (u.ks >= 0) {
            bf16_t* pb = (bf16_t*)part + (size_t)u.ks * NSM * ldc + (size_t)(row0 - NPR) * ldc + col0;
#pragma unroll
            for (int ai = 0; ai < 2; ++ai)
#pragma unroll
                for (int m = 0; m < 4; ++m)
#pragma unroll
                    for (int bj = 0; bj < 2; ++bj) { const f32x4 v0 = acc[ai][bj][m][0], v1 = acc[ai][bj][m][1];
                        u32x4 w; w.x = cvt_pk_bf16(v0[0], v0[1]); w.y = cvt_pk_bf16(v0[2], v0[3]); w.z = cvt_pk_bf16(v1[0], v1[1]); w.w = cvt_pk_bf16(v1[2], v1[3]);
                        *(u32x4*)(pb + (size_t)(ai * HALF + m * 16) * ldc + bj * HALF) = w; }
            return;
        }
#pragma unroll
        for (int ai = 0; ai < 2; ++ai)
#pragma unroll
            for (int m = 0; m < 4; ++m) { bf16_t* rowp = O + (size_t)(row0 + ai * HALF + m * 16) * ldc + col0;
#pragma unroll
                for (int bj = 0; bj < 2; ++bj) { const f32x4 v0 = acc[ai][bj][m][0], v1 = acc[ai][bj][m][1];
                    u32x4 w; w.x = cvt_pk_bf16(v0[0], v0[1]); w.y = cvt_pk_bf16(v0[2], v0[3]); w.z = cvt_pk_bf16(v1[0], v1[1]); w.w = cvt_pk_bf16(v1[2], v1[3]);
                    *(u32x4*)(rowp + bj * HALF) = w; } }
    }
};

template <class Epi, class Sched>
DEV void gemm_phase(LAS unsigned char* lds, const Gemm g, const Sched& S, const Epi& E) {
    int tid_ = threadIdx.x; asm volatile("" : "+v"(tid_)); const int tid = tid_, wid = __builtin_amdgcn_readfirstlane(tid >> 6), lane = tid & 63, wr = wid >> 2, wc = wid & 3, fr = lane & 15, fq = lane >> 4;
    const int K = g.K;
    unsigned voffA[2], voffB[2];
#pragma unroll
    for (int i = 0; i < 2; ++i) { int R, C; stage_rc(tid * 16 + i * 8192, R, C); const int Rb = Epi::PERM ? ((R & ~31) + perm32(R & 31)) : R;
        voffA[i] = (unsigned)(R * K + C) * 2u; voffB[i] = (unsigned)(Rb * K + C) * 2u; }
    const size_t kstep = (size_t)(BK * 2);
    const size_t hstep = (size_t)HALF * K * 2;
    const size_t tstep = 2 * hstep;
    const unsigned ldsw = (unsigned)wid * 1024u;
    const int aoff = lds_byte(wr * 64 + fr, fq * 8), boff = lds_byte(wc * 32 + fr, fq * 8);
#define PG8_SA(b, h) (((b) * 2 + (h)) * HTB)
#define PG8_SB(b, h) ((4 + (b) * 2 + (h)) * HTB)
#define PG8_STAGE(bufoff, gbase, voff) do { _Pragma("unroll") for (int _i = 0; _i < 2; ++_i) \
        __builtin_amdgcn_global_load_lds((const unsigned*)((const char*)(gbase) + (voff)[_i]), (LAS unsigned*)(lds + (bufoff) + ldsw + _i * 8192), 16, 0, 0); } while (0)
#define PG8_LDA(dst, b, h) do { _Pragma("unroll") for (int m = 0; m < 4; ++m) _Pragma("unroll") for (int k = 0; k < 2; ++k) dst[m][k] = *(const LAS bf16x8*)(lds + PG8_SA(b, h) + aoff + m * 2048 + k * 1024); } while (0)
#define PG8_LDB(dst, b, h) do { _Pragma("unroll") for (int n = 0; n < 2; ++n) _Pragma("unroll") for (int k = 0; k < 2; ++k) dst[n][k] = *(const LAS bf16x8*)(lds + PG8_SB(b, h) + boff + n * 2048 + k * 1024); } while (0)
#define PG8_MMA(ai, bj, At, Bt) do { __builtin_amdgcn_s_setprio(1); _Pragma("unroll") for (int m = 0; m < 4; ++m) _Pragma("unroll") for (int n = 0; n < 2; ++n) _Pragma("unroll") for (int k = 0; k < 2; ++k) \
        acc[ai][bj][m][n] = __builtin_amdgcn_mfma_f32_16x16x32_bf16(Bt[n][k], At[m][k], acc[ai][bj][m][n], 0, 0, 0); __builtin_amdgcn_s_setprio(0); } while (0)
#define PG8_WAIT_V(n) asm volatile("s_waitcnt vmcnt(" #n ")" ::: "memory")
#define PG8_WAIT_L(n) asm volatile("s_waitcnt lgkmcnt(" #n ")" ::: "memory")
#define PG8_BAR __builtin_amdgcn_s_barrier()
#define PG8_SCHED __builtin_amdgcn_sched_barrier(0)
    Unit cur, nxt; int ui = 0;
    if (!S.next(0, cur)) return;
    f32x4 acc[2][2][4][2];
#pragma unroll
    for (int a = 0; a < 2; ++a)
#pragma unroll
        for (int b = 0; b < 2; ++b)
#pragma unroll
            for (int m = 0; m < 4; ++m)
#pragma unroll
                for (int n = 0; n < 2; ++n) acc[a][b][m][n] = (f32x4){0.f, 0.f, 0.f, 0.f};
    bf16x8 At[4][2], B0[2][2], B1[2][2];
    const char* cA = (const char*)g.A + (size_t)cur.pm * tstep + (size_t)cur.k0 * 2; const char* cB = (const char*)g.Bt + (size_t)cur.pn * tstep + (size_t)cur.k0 * 2;
    PG8_STAGE(PG8_SB(0, 0), cB, voffB); PG8_STAGE(PG8_SA(0, 0), cA, voffA); PG8_STAGE(PG8_SB(0, 1), cB + hstep, voffB); PG8_STAGE(PG8_SA(0, 1), cA + hstep, voffA);
    if (wr == 1) PG8_BAR;
    PG8_WAIT_V(4); PG8_BAR;
    PG8_STAGE(PG8_SB(1, 0), cB + kstep, voffB); PG8_STAGE(PG8_SA(1, 0), cA + kstep, voffA); PG8_STAGE(PG8_SB(1, 1), cB + hstep + kstep, voffB);
    PG8_WAIT_V(6); PG8_BAR;
    for (;;) {
        const bool has_next = S.next(ui + 1, nxt);
        const char* nA = has_next ? (const char*)g.A + (size_t)nxt.pm * tstep + (size_t)nxt.k0 * 2 : cA; const char* nB = has_next ? (const char*)g.Bt + (size_t)nxt.pn * tstep + (size_t)nxt.k0 * 2 : cB;
        const int nt = cur.nt;
        for (int t = 0; t < nt; t += 2) {
            const bool last = (t == nt - 2);
            const char* a1 = cA + (size_t)(t + 1) * kstep;
            const char* a2 = last ? nA : cA + (size_t)(t + 2) * kstep; const char* b2 = last ? nB : cB + (size_t)(t + 2) * kstep;
            const char* a3 = a2 + kstep; const char* b3 = b2 + kstep;
            PG8_LDB(B0, 0, 0); PG8_SCHED; PG8_LDA(At, 0, 0); PG8_STAGE(PG8_SA(1, 1), a1 + hstep, voffA);
            PG8_WAIT_L(8); PG8_BAR; PG8_WAIT_L(0); PG8_MMA(0, 0, At, B0); PG8_BAR; PG8_SCHED;
            PG8_LDB(B1, 0, 1); PG8_STAGE(PG8_SB(0, 0), b2, voffB);
            PG8_BAR; PG8_WAIT_L(0); PG8_MMA(0, 1, At, B1); PG8_BAR;
            PG8_LDA(At, 0, 1); PG8_STAGE(PG8_SA(0, 0), a2, voffA);
            PG8_BAR; PG8_WAIT_L(0); PG8_MMA(1, 0, At, B0); PG8_BAR; PG8_SCHED;
            PG8_STAGE(PG8_SB(0, 1), b2 + hstep, voffB);
            PG8_WAIT_V(6); PG8_BAR; PG8_MMA(1, 1, At, B1); PG8_BAR;
            PG8_LDB(B0, 1, 0); PG8_SCHED; PG8_LDA(At, 1, 0); PG8_STAGE(PG8_SA(0, 1), a2 + hstep, voffA);
            PG8_WAIT_L(8); PG8_BAR; PG8_WAIT_L(0); PG8_MMA(0, 0, At, B0); PG8_BAR; PG8_SCHED;
            PG8_LDB(B1, 1, 1); PG8_STAGE(PG8_SB(1, 0), b3, voffB);
            PG8_BAR; PG8_WAIT_L(0); PG8_MMA(0, 1, At, B1); PG8_BAR;
            PG8_LDA(At, 1, 1); PG8_STAGE(PG8_SA(1, 0), a3, voffA);
            PG8_BAR; PG8_WAIT_L(0); PG8_MMA(1, 0, At, B0); PG8_BAR; PG8_SCHED;
            PG8_STAGE(PG8_SB(1, 1), b3 + hstep, voffB);
            PG8_WAIT_V(6); PG8_BAR; PG8_MMA(1, 1, At, B1); PG8_BAR;
        }
        E(acc, cur, wr, wc, fr, fq);
        if (!has_next) break;
#pragma unroll
        for (int a = 0; a < 2; ++a)
#pragma unroll
            for (int b = 0; b < 2; ++b)
#pragma unroll
                for (int m = 0; m < 4; ++m)
#pragma unroll
                    for (int n = 0; n < 2; ++n) acc[a][b][m][n] = (f32x4){0.f, 0.f, 0.f, 0.f};
        cur = nxt; cA = nA; cB = nB; ++ui;
    }
    PG8_WAIT_V(0);
    if (wr == 0) PG8_BAR;
    PG8_BAR;
#undef PG8_SA
#undef PG8_SB
#undef PG8_STAGE
#undef PG8_LDA
#undef PG8_LDB
#undef PG8_MMA
#undef PG8_WAIT_V
#undef PG8_WAIT_L
#undef PG8_BAR
#undef PG8_SCHED
}
}

DEV int win_srccol(int n) { return n < 4096 ? n : (n < 6656 ? n + 8 : (n < 6664 ? n - 2560 : (n < 6680 ? n : -1))); }
DEV void transpose_tile(const float* __restrict__ src, int srcN, bf16_t* __restrict__ dst, int K, int n0, int k0, int mode, float* tile) {
    int tid_ = threadIdx.x; asm volatile("" : "+v"(tid_)); const int tid = tid_;
    f32x4 v[4];
#pragma unroll
    for (int i = 0; i < 4; ++i) {
        const int kk = (tid >> 5) + 16 * i, nn4 = (tid & 31) * 4, n = n0 + nn4;
        const int sc = mode ? win_srccol(n) : n;
        v[i] = (f32x4){0.f, 0.f, 0.f, 0.f};
        if (sc >= 0) v[i] = __builtin_nontemporal_load((const f32x4*)(src + (size_t)(k0 + kk) * srcN + sc));
        if (mode && n >= 1024 && n < 2048) v[i] = v[i] * 0.0625f;
    }
#pragma unroll
    for (int i = 0; i < 4; ++i) {
        const int kk = (tid >> 5) + 16 * i, nn4 = (tid & 31) * 4;
        tile[kk * 129 + nn4 + 0] = v[i][0]; tile[kk * 129 + nn4 + 1] = v[i][1]; tile[kk * 129 + nn4 + 2] = v[i][2]; tile[kk * 129 + nn4 + 3] = v[i][3];
    }
    __syncthreads();
#pragma unroll
    for (int i = 0; i < 2; ++i) {
        const int ch = tid + 512 * i, nn = ch >> 3, kk8 = (ch & 7) * 8;
        u32x4 w;
        w.x = pk2(tile[(kk8 + 0) * 129 + nn], tile[(kk8 + 1) * 129 + nn]); w.y = pk2(tile[(kk8 + 2) * 129 + nn], tile[(kk8 + 3) * 129 + nn]);
        w.z = pk2(tile[(kk8 + 4) * 129 + nn], tile[(kk8 + 5) * 129 + nn]); w.w = pk2(tile[(kk8 + 6) * 129 + nn], tile[(kk8 + 7) * 129 + nn]);
        *(u32x4*)(dst + (size_t)(n0 + nn) * K + k0 + kk8) = w;
    }
    __syncthreads();
}
DEV void phase_prologue(const P& p, unsigned char* lds, int l_lo, int l_hi, bool with_x, int b0, int nb) {
    float* tile = (float*)lds;
    constexpr int T_WIN = (INP / 128) * (D / 64), T_WOUT = (D / 128) * (D / 64), T_WUP = (DFF2 / 128) * (D / 64), T_WDN = (D / 128) * (DFF / 64);
    constexpr int T_L = T_WIN + T_WOUT + T_WUP + T_WDN, T_X = NTOK * D / 4096;
    const int nw = (l_hi - l_lo) * T_L, total = nw + (with_x ? T_X : 0);
    for (int u = b0; u < total; u += nb) {
        if (u < nw) {
            const int l = l_lo + u / T_L; int r = u % T_L;
            if (r < T_WIN) { const int nt = r / (D / 64), kt = r % (D / 64);
                transpose_tile(p.w_in + (size_t)l * D * IN_DIM, IN_DIM, (bf16_t*)(p.ws + WS_WIN) + (size_t)l * INP * D, D, nt * 128, kt * 64, 1, tile); }
            else if ((r -= T_WIN) < T_WOUT) { const int nt = r / (D / 64), kt = r % (D / 64);
                transpose_tile(p.w_out + (size_t)l * D * D, D, (bf16_t*)(p.ws + WS_WOUT) + (size_t)l * D * D, D, nt * 128, kt * 64, 0, tile); }
            else if ((r -= T_WOUT) < T_WUP) { const int nt = r / (D / 64), kt = r % (D / 64);
                transpose_tile(p.w_up + (size_t)l * D * DFF2, DFF2, (bf16_t*)(p.ws + WS_WUP) + (size_t)l * DFF2 * D, D, nt * 128, kt * 64, 0, tile); }
            else { r -= T_WUP; const int nt = r / (DFF / 64), kt = r % (DFF / 64);
                transpose_tile(p.w_down + (size_t)l * DFF * D, D, (bf16_t*)(p.ws + WS_WDN) + (size_t)l * D * DFF, DFF, nt * 128, kt * 64, 0, tile); }
        } else {
            const size_t e = (size_t)(u - nw) * 4096 + threadIdx.x * 8;
            const float* s = e < (size_t)NPR * D ? p.x_prompt + e : p.x_sample + (e - (size_t)NPR * D);
            const f32x4 a = *(const f32x4*)s, b = *(const f32x4*)(s + 4);
            u32x4 w; w.x = pk2(a[0], a[1]); w.y = pk2(a[2], a[3]); w.z = pk2(b[0], b[1]); w.w = pk2(b[2], b[3]);
            *(u32x4*)((bf16_t*)(p.ws + WS_XB) + e) = w;
        }
    }
}

DEV void mlstm_local(const P& p, int l, int unit, unsigned char* lds) {
    const int bh = unit >> 5, c = unit & 31, b = bh >> 2, h = bh & 3;
    int tid_ = threadIdx.x; asm volatile("" : "+v"(tid_)); const int tid = tid_, lane = tid & 63, w = tid >> 6, fr = lane & 15, fq = lane >> 4;
    const bf16_t* U = (const bf16_t*)(p.ws + WS_U) + (size_t)(b * 2048 + c * 64) * INP;
    float* wsh = (float*)lds;
    bf16_t* KW = (bf16_t*)(lds + 1024);
    bf16_t* V = KW + 64 * 272;
    float* gstat = (float*)(p.ws + WS_GSTAT);
    if (w == 0) {
        const float ig = bf2f(U[(size_t)lane * INP + UIG + h]) + p.b_i[l * 4 + h];
        const float lf = logsigf_(bf2f(U[(size_t)lane * INP + UFG + h]) + p.b_f[l * 4 + h]);
        const float bs = wave_incl_sum(lf, lane);
        const float a = ig - bs;
        const float amax = wave_max(a);
        const float bsum = __shfl(bs, 63);
        wsh[lane] = expf(a - amax);
        if (lane == 0) { gstat[(bh * 32 + c) * 2] = bsum; gstat[(bh * 32 + c) * 2 + 1] = bsum + amax; }
    }
    __syncthreads();
#pragma unroll
    for (int i = 0; i < 4; ++i) {
        const int it = tid + 512 * i, s_ = it >> 5, d8 = (it & 31) * 8;
        const uint4 kv = *(const uint4*)(U + (size_t)s_ * INP + UK + h * 256 + d8);
        const uint4 vv = *(const uint4*)(U + (size_t)s_ * INP + UV + h * 256 + d8);
        const float ws_ = wsh[s_];
        float kf[8]; unpack8(kv, kf);
        u32x4 kw; kw.x = pk2(kf[0] * ws_, kf[1] * ws_); kw.y = pk2(kf[2] * ws_, kf[3] * ws_); kw.z = pk2(kf[4] * ws_, kf[5] * ws_); kw.w = pk2(kf[6] * ws_, kf[7] * ws_);
        *(u32x4*)(KW + s_ * 272 + d8) = kw;
        *(uint4*)(V + s_ * 272 + d8) = vv;
    }
    __syncthreads();
    if (tid < 256) { float a = 0.f; for (int s_ = 0; s_ < 64; ++s_) a += bf2f(KW[s_ * 272 + tid]); ((float*)(p.ws + WS_NLOC))[(size_t)(bh * 32 + c) * 256 + tid] = a; }
    f32x4 acc[2][16];
#pragma unroll
    for (int m = 0; m < 2; ++m)
#pragma unroll
        for (int n = 0; n < 16; ++n) acc[m][n] = (f32x4){0.f, 0.f, 0.f, 0.f};
#pragma unroll
    for (int ks = 0; ks < 2; ++ks) {
        bf16x8 vf[2];
#pragma unroll
        for (int m = 0; m < 2; ++m) vf[m] = tr_frag(V, 272, 32 * ks, 32 * w + 16 * m, lane);
#pragma unroll
        for (int n = 0; n < 16; ++n) {
            const bf16x8 kf = tr_frag(KW, 272, 32 * ks, 16 * n, lane);
#pragma unroll
            for (int m = 0; m < 2; ++m) acc[m][n] = mfma16(kf, vf[m], acc[m][n]);
        }
    }
    bf16_t* Dp = (bf16_t*)(p.ws + WS_DBUF) + (size_t)(bh * 32 + c) * 65536;
#pragma unroll
    for (int m = 0; m < 2; ++m)
#pragma unroll
        for (int n = 0; n < 16; ++n) { u32x2 wv; wv.x = pk2(acc[m][n][0], acc[m][n][1]); wv.y = pk2(acc[m][n][2], acc[m][n][3]);
            *(u32x2*)(Dp + (32 * w + 16 * m + fr) * 256 + 16 * n + fq * 4) = wv; }
    __syncthreads();
}

DEV void mlstm_scan(const P& p, int l, int unit, unsigned char* lds) {
    int tid_ = threadIdx.x; asm volatile("" : "+v"(tid_)); const int bh = unit >> 4, slab = unit & 15, tid = tid_;
    float* fA = (float*)lds; float* fB = fA + 32;
    const float* gstat = (const float*)(p.ws + WS_GSTAT);
    if (tid == 0) {
        float m = 0.f;
        for (int c = 0; c < 32; ++c) {
            const float bsum = gstat[(bh * 32 + c) * 2], mloc = gstat[(bh * 32 + c) * 2 + 1];
            const float mn = fmaxf(bsum + m, mloc);
            fA[c] = expf(bsum + m - mn); fB[c] = expf(mloc - mn); m = mn;
            if (slab == 0) ((float*)(p.ws + WS_MST))[bh * 32 + c] = mn;
        }
        if (slab == 0) p.out[O_PM + l * 16 + bh] = m;
    }
    __syncthreads();
    const size_t e0 = (size_t)slab * 4096 + tid * 8;
    float run[8];
#pragma unroll
    for (int i = 0; i < 8; ++i) run[i] = 0.f;
    const bf16_t* Dp = (const bf16_t*)(p.ws + WS_DBUF) + (size_t)bh * 32 * 65536 + e0;
    bf16_t* Cp = (bf16_t*)(p.ws + WS_CT) + (size_t)bh * 32 * 65536 + e0;
#pragma unroll 1
    for (int cb = 0; cb < 32; cb += 8) {
        uint4 xx[8];
#pragma unroll
        for (int j = 0; j < 8; ++j) xx[j] = *(const uint4*)(Dp + (size_t)(cb + j) * 65536);
#pragma unroll
        for (int j = 0; j < 8; ++j) {
            const int c = cb + j;
            const float a = fA[c], bq = fB[c];
            float xf[8]; unpack8(xx[j], xf);
#pragma unroll
            for (int i = 0; i < 8; ++i) run[i] = a * run[i] + bq * xf[i];
            u32x4 wv; wv.x = pk2(run[0], run[1]); wv.y = pk2(run[2], run[3]); wv.z = pk2(run[4], run[5]); wv.w = pk2(run[6], run[7]);
            *(u32x4*)(Cp + (size_t)c * 65536) = wv;
        }
    }
    {
        float* o = p.out + O_PC + (size_t)(l * 16 + bh) * 65536;
        const int e = (int)(e0 >> 8), d0 = (int)(e0 & 255);
#pragma unroll
        for (int i = 0; i < 8; ++i) o[(d0 + i) * 256 + e] = run[i];
    }
    if (slab == 0 && tid < 256) {
        float r = 0.f;
        const float* nl = (const float*)(p.ws + WS_NLOC) + (size_t)bh * 32 * 256 + tid;
        float* ns = (float*)(p.ws + WS_NST) + (size_t)bh * 32 * 256 + tid;
        for (int c = 0; c < 32; ++c) { r = fA[c] * r + fB[c] * nl[c * 256]; ns[c * 256] = r; }
        p.out[O_PN + (size_t)(l * 16 + bh) * 256 + tid] = r;
    }
    __syncthreads();
}

DEV void ssd_scan(const P& p, int l, int unit, unsigned char* lds) {
    int tid_ = threadIdx.x; asm volatile("" : "+v"(tid_)); const int bhd = unit >> 2, slab = unit & 3, tid = tid_;
    float* dec = (float*)lds;
    if (tid < 32) dec[tid] = expf(((const float*)(p.ws + WS_SBSUM))[bhd * 32 + tid]);
    __syncthreads();
    const size_t e0 = (size_t)slab * 2048 + tid * 4;
    f32x4 run = (f32x4){0.f, 0.f, 0.f, 0.f};
    const bf16_t* Sp = (const bf16_t*)(p.ws + WS_SBUF) + (size_t)bhd * 32 * 8192 + e0;
    bf16_t* Tp = (bf16_t*)(p.ws + WS_ST) + (size_t)bhd * 32 * 8192 + e0;
#pragma unroll 1
    for (int cb = 0; cb < 32; cb += 8) {
        uint2 xx[8];
#pragma unroll
        for (int j = 0; j < 8; ++j) xx[j] = *(const uint2*)(Sp + (size_t)(cb + j) * 8192);
#pragma unroll
        for (int j = 0; j < 8; ++j) {
            run = run * dec[cb + j] + (f32x4){bflo(xx[j].x), bfhi(xx[j].x), bflo(xx[j].y), bfhi(xx[j].y)};
            u32x2 wv; wv.x = pk2(run[0], run[1]); wv.y = pk2(run[2], run[3]);
            *(u32x2*)(Tp + (size_t)(cb + j) * 8192) = wv;
        }
    }
    *(f32x4*)(p.out + O_PS + (size_t)(l * 64 + bhd) * 8192 + e0) = run;
    __syncthreads();
}

DEV void convstate_copy(const P& p, int l, int unit) {
    const bf16_t* Ub = (const bf16_t*)(p.ws + WS_U);
    int tid_ = threadIdx.x; asm volatile("" : "+v"(tid_));
    for (int i = tid_; i < 3 * 1536; i += NTHR) {
        const int j = i / 1536, ch = i % 1536;
        if (unit < 4) p.out[O_PSC + ((size_t)(l * 4 + unit) * 3 + j) * 1536 + ch] = bf2f(Ub[(size_t)(unit * 2048 + 2045 + j) * INP + UXS + ch]);
        else { const int b = unit - 4; p.out[O_SSC + ((size_t)(l * 128 + b) * 3 + j) * 1536 + ch] = bf2f(Ub[(size_t)(NPR + b * 8 + 5 + j) * INP + UXS + ch]); }
    }
}

DEV void mlstm_out(const P& p, int l, int unit, unsigned char* lds) {
    const int bh = unit >> 5, c = unit & 31, b = bh >> 2, h = bh & 3;
    int tid_ = threadIdx.x; asm volatile("" : "+v"(tid_)); const int tid = tid_, lane = tid & 63, w = tid >> 6, fr = lane & 15, fq = lane >> 4;
    const int r0 = b * 2048 + c * 64;
    const bf16_t* U = (const bf16_t*)(p.ws + WS_U) + (size_t)r0 * INP;
    bf16_t* Qs = (bf16_t*)lds;
    bf16_t* Ks = Qs + 64 * 264;
    bf16_t* V = Ks + 64 * 264;
    bf16_t* Ss = V + 64 * 272;
    float* fl = (float*)(lds + 113664);
    float* bsh = fl; float* ash = fl + 64; float* mth = fl + 128; float* wint = fl + 192; float* rdn = fl + 256; float* qn = fl + 320; float* nprev = fl + 384; float* red = fl + 640;
    float* stat = fl + 1152;
    if (w == 0) {
        const float ig = bf2f(U[(size_t)lane * INP + UIG + h]) + p.b_i[l * 4 + h];
        const float lf = logsigf_(bf2f(U[(size_t)lane * INP + UFG + h]) + p.b_f[l * 4 + h]);
        const float bs = wave_incl_sum(lf, lane);
        const float a = ig - bs;
        const float cm = wave_incl_max(a, lane);
        const float mprev = c > 0 ? ((const float*)(p.ws + WS_MST))[bh * 32 + c - 1] : 0.f;
        const float mt = bs + fmaxf(mprev, cm);
        bsh[lane] = bs; ash[lane] = a; mth[lane] = mt; wint[lane] = expf(bs + mprev - mt);
    }
    if (tid >= 256) { const int d = tid - 256; nprev[d] = c > 0 ? ((const float*)(p.ws + WS_NST))[(size_t)(bh * 32 + c - 1) * 256 + d] : 0.f; }
#pragma unroll
    for (int i = 0; i < 4; ++i) {
        const int it = tid + 512 * i, s_ = it >> 5, d8 = (it & 31) * 8;
        *(uint4*)(Qs + s_ * 264 + d8) = *(const uint4*)(U + (size_t)s_ * INP + UQ + h * 256 + d8);
        *(uint4*)(Ks + s_ * 264 + d8) = *(const uint4*)(U + (size_t)s_ * INP + UK + h * 256 + d8);
        *(uint4*)(V + s_ * 272 + d8) = *(const uint4*)(U + (size_t)s_ * INP + UV + h * 256 + d8);
    }
    __syncthreads();
    {
        const int mt_ = w >> 1, nt0 = (w & 1) * 2;
        f32x4 sacc[2] = {(f32x4){0.f, 0.f, 0.f, 0.f}, (f32x4){0.f, 0.f, 0.f, 0.f}};
#pragma unroll
        for (int k0 = 0; k0 < 256; k0 += 32) {
            const bf16x8 a = *(const bf16x8*)(Qs + (16 * mt_ + fr) * 264 + k0 + fq * 8);
#pragma unroll
            for (int n = 0; n < 2; ++n) { const bf16x8 bb = *(const bf16x8*)(Ks + (16 * (nt0 + n) + fr) * 264 + k0 + fq * 8); sacc[n] = mfma16(a, bb, sacc[n]); }
        }
#pragma unroll
        for (int n = 0; n < 2; ++n)
#pragma unroll
            for (int j = 0; j < 4; ++j) {
                const int t = 16 * mt_ + fq * 4 + j, s_ = 16 * (nt0 + n) + fr;
                const float val = (s_ <= t) ? sacc[n][j] * expf(bsh[t] - mth[t] + ash[s_]) : 0.f;
                Ss[t * 72 + s_] = f2bf(val);
            }
        const int t = tid >> 3, part = tid & 7;
        float a = 0.f;
        for (int d = part * 32; d < part * 32 + 32; ++d) a += bf2f(Qs[t * 264 + d]) * nprev[d];
        a += __shfl_xor(a, 1); a += __shfl_xor(a, 2); a += __shfl_xor(a, 4);
        if (part == 0) qn[t] = a;
    }
    __syncthreads();
    if (tid < 64) {
        float di = 0.f;
        for (int s_ = 0; s_ < 64; ++s_) di += bf2f(Ss[tid * 72 + s_]);
        const float den = di + wint[tid] * qn[tid];
        rdn[tid] = 1.0f / fmaxf(fabsf(den), expf(-mth[tid]));
    }
    const int e0 = 32 * w;
    f32x4 acc1[4][2], acc2[4][2];
#pragma unroll
    for (int m = 0; m < 4; ++m)
#pragma unroll
        for (int n = 0; n < 2; ++n) { acc1[m][n] = (f32x4){0.f, 0.f, 0.f, 0.f}; acc2[m][n] = (f32x4){0.f, 0.f, 0.f, 0.f}; }
#pragma unroll
    for (int ks = 0; ks < 2; ++ks) {
        bf16x8 sf[4];
#pragma unroll
        for (int m = 0; m < 4; ++m) sf[m] = *(const bf16x8*)(Ss + (16 * m + fr) * 72 + 32 * ks + fq * 8);
#pragma unroll
        for (int n = 0; n < 2; ++n) { const bf16x8 vf = tr_frag(V, 272, 32 * ks, e0 + 16 * n, lane);
#pragma unroll
            for (int m = 0; m < 4; ++m) acc1[m][n] = mfma16(vf, sf[m], acc1[m][n]); }
    }
    if (c > 0) {
        const bf16_t* CTp = (const bf16_t*)(p.ws + WS_CT) + (size_t)(bh * 32 + c - 1) * 65536;
#pragma unroll 2
        for (int k0 = 0; k0 < 256; k0 += 32) {
            bf16x8 a[4];
#pragma unroll
            for (int m = 0; m < 4; ++m) a[m] = *(const bf16x8*)(Qs + (16 * m + fr) * 264 + k0 + fq * 8);
#pragma unroll
            for (int n = 0; n < 2; ++n) { const bf16x8 cf = *(const bf16x8*)(CTp + (size_t)(e0 + 16 * n + fr) * 256 + k0 + fq * 8);
#pragma unroll
                for (int m = 0; m < 4; ++m) acc2[m][n] = mfma16(cf, a[m], acc2[m][n]); }
        }
    }
    __syncthreads();
#pragma unroll
    for (int m = 0; m < 4; ++m) {
        const int t = 16 * m + fr;
        const float wi = wint[t], rd = rdn[t];
        float sm = 0.f;
#pragma unroll
        for (int n = 0; n < 2; ++n)
#pragma unroll
            for (int j = 0; j < 4; ++j) { const float hv = (acc1[m][n][j] + wi * acc2[m][n][j]) * rd; acc1[m][n][j] = hv; sm += hv; }
        sm += __shfl_xor(sm, 16); sm += __shfl_xor(sm, 32);
        if (fq == 0) red[t * 8 + w] = sm;
    }
    __syncthreads();
    if (tid < 64) { float sm = 0.f;
#pragma unroll
        for (int i = 0; i < 8; ++i) sm += red[tid * 8 + i];
        stat[tid] = sm * (1.0f / 256.0f); }
    __syncthreads();
#pragma unroll
    for (int m = 0; m < 4; ++m) {
        const int t = 16 * m + fr;
        const float mu = stat[t];
        float sm = 0.f;
#pragma unroll
        for (int n = 0; n < 2; ++n)
#pragma unroll
            for (int j = 0; j < 4; ++j) { const float dv = acc1[m][n][j] - mu; acc1[m][n][j] = dv; sm += dv * dv; }
        sm += __shfl_xor(sm, 16); sm += __shfl_xor(sm, 32);
        if (fq == 0) red[t * 8 + w] = sm;
    }
    __syncthreads();
    if (tid < 64) { float sm = 0.f;
#pragma unroll
        for (int i = 0; i < 8; ++i) sm += red[tid * 8 + i];
        stat[64 + tid] = rsqrtf(sm * (1.0f / 256.0f) + 1e-6f); }
    __syncthreads();
    bf16_t* MX = (bf16_t*)(p.ws + WS_MIXIN);
#pragma unroll
    for (int m = 0; m < 4; ++m) {
        const int t = 16 * m + fr;
        const float rs = stat[64 + t];
#pragma unroll
        for (int n = 0; n < 2; ++n) {
            const int e4 = e0 + 16 * n + fq * 4;
            const uint2 ov = *(const uint2*)(U + (size_t)t * INP + UO + h * 256 + e4);
            const f32x4 nw = *(const f32x4*)(p.m_norm_w + l * 1024 + h * 256 + e4);
            u32x2 wv;
            wv.x = pk2(acc1[m][n][0] * rs * nw[0] * sigmoidf_(bflo(ov.x)), acc1[m][n][1] * rs * nw[1] * sigmoidf_(bfhi(ov.x)));
            wv.y = pk2(acc1[m][n][2] * rs * nw[2] * sigmoidf_(bflo(ov.y)), acc1[m][n][3] * rs * nw[3] * sigmoidf_(bfhi(ov.y)));
            *(u32x2*)(MX + (size_t)(r0 + t) * D + h * 256 + e4) = wv;
        }
    }
    __syncthreads();
}

DEV void ssd_conv8(const bf16_t* Urow, int tpos, const float* cw, const float* cb, int ch8, float (&o)[8]) {
    const f32x4 b0 = *(const f32x4*)(cb + ch8), b1 = *(const f32x4*)(cb + ch8 + 4);
    o[0] = b0[0]; o[1] = b0[1]; o[2] = b0[2]; o[3] = b0[3]; o[4] = b1[0]; o[5] = b1[1]; o[6] = b1[2]; o[7] = b1[3];
#pragma unroll
    for (int j = 0; j < 4; ++j) {
        const int back = 3 - j;
        if (tpos - back >= 0) {
            const uint4 x = *(const uint4*)(Urow - (size_t)back * INP + UXS + ch8);
            float xf[8]; unpack8(x, xf);
            const f32x4 w0 = *(const f32x4*)(cw + j * 1536 + ch8), w1 = *(const f32x4*)(cw + j * 1536 + ch8 + 4);
            o[0] += w0[0] * xf[0]; o[1] += w0[1] * xf[1]; o[2] += w0[2] * xf[2]; o[3] += w0[3] * xf[3];
            o[4] += w1[0] * xf[4]; o[5] += w1[1] * xf[5]; o[6] += w1[2] * xf[6]; o[7] += w1[3] * xf[7];
        }
    }
#pragma unroll
    for (int i = 0; i < 8; ++i) o[i] = siluf_(o[i]);
}

DEV void ssd_local(const P& p, int l, int unit, unsigned char* lds) {
    const int b = unit >> 6, g = (unit >> 5) & 1, c = unit & 31;
    int tid_ = threadIdx.x; asm volatile("" : "+v"(tid_)); const int tid = tid_, lane = tid & 63, w = tid >> 6, fr = lane & 15, fq = lane >> 4;
    const int r0 = b * 2048 + c * 64;
    const bf16_t* U = (const bf16_t*)(p.ws + WS_U) + (size_t)r0 * INP;
    bf16_t* XW = (bf16_t*)lds;
    bf16_t* Bmn = XW + 64 * 528;
    float* wsh = (float*)(lds + 86016);
    {
        const int head = g * 8 + w;
        const float dt = softplusf_(bf2f(U[(size_t)lane * INP + UDT + head]) + p.dt_bias[l * 16 + head]);
        const float a = -expf(p.A_log[l * 16 + head]) * dt;
        const float bs = wave_incl_sum(a, lane);
        const float bL = __shfl(bs, 63);
        wsh[w * 64 + lane] = expf(bL - bs) * dt;
        if (lane == 0) ((float*)(p.ws + WS_SBSUM))[(b * 16 + head) * 32 + c] = bL;
    }
    __syncthreads();
    const float* cw = p.s_conv_w + (size_t)l * 4 * 1536; const float* cb = p.s_conv_b + (size_t)l * 1536;
    bf16_t* XBC = (bf16_t*)(p.ws + WS_XBC) + (size_t)r0 * 1536;
    for (int i = 0; i < 12; ++i) {
        const int it = tid + 512 * i, t = it / 96, gidx = it % 96;
        const int ch8 = gidx < 64 ? g * 512 + gidx * 8 : (gidx < 80 ? 1024 + g * 128 + (gidx - 64) * 8 : 1280 + g * 128 + (gidx - 80) * 8);
        float v[8];
        ssd_conv8(U + (size_t)t * INP, c * 64 + t, cw, cb, ch8, v);
        { u32x4 wr_; wr_.x = pk2(v[0], v[1]); wr_.y = pk2(v[2], v[3]); wr_.z = pk2(v[4], v[5]); wr_.w = pk2(v[6], v[7]); *(u32x4*)(XBC + (size_t)t * 1536 + ch8) = wr_; }
        if (gidx >= 80) continue;
        if (gidx < 64) { const float sc = wsh[(gidx >> 3) * 64 + t];
            u32x4 wv; wv.x = pk2(v[0] * sc, v[1] * sc); wv.y = pk2(v[2] * sc, v[3] * sc); wv.z = pk2(v[4] * sc, v[5] * sc); wv.w = pk2(v[6] * sc, v[7] * sc);
            *(u32x4*)(XW + t * 528 + gidx * 8) = wv; }
        else { u32x4 wv; wv.x = pk2(v[0], v[1]); wv.y = pk2(v[2], v[3]); wv.z = pk2(v[4], v[5]); wv.w = pk2(v[6], v[7]);
            *(u32x4*)(Bmn + t * 144 + (gidx - 64) * 8) = wv; }
    }
    __syncthreads();
    f32x4 acc[4][8];
#pragma unroll
    for (int m = 0; m < 4; ++m)
#pragma unroll
        for (int n = 0; n < 8; ++n) acc[m][n] = (f32x4){0.f, 0.f, 0.f, 0.f};
#pragma unroll
    for (int ks = 0; ks < 2; ++ks) {
        bf16x8 xf[4];
#pragma unroll
        for (int m = 0; m < 4; ++m) xf[m] = tr_frag(XW, 528, 32 * ks, 64 * w + 16 * m, lane);
#pragma unroll
        for (int n = 0; n < 8; ++n) { const bf16x8 bf_ = tr_frag(Bmn, 144, 32 * ks, 16 * n, lane);
#pragma unroll
            for (int m = 0; m < 4; ++m) acc[m][n] = mfma16(bf_, xf[m], acc[m][n]); }
    }
    bf16_t* Sp = (bf16_t*)(p.ws + WS_SBUF) + (size_t)((b * 16 + g * 8 + w) * 32 + c) * 8192;
#pragma unroll
    for (int m = 0; m < 4; ++m)
#pragma unroll
        for (int n = 0; n < 8; ++n) { u32x2 wv; wv.x = pk2(acc[m][n][0], acc[m][n][1]); wv.y = pk2(acc[m][n][2], acc[m][n][3]); *(u32x2*)(Sp + (16 * m + fr) * 128 + 16 * n + fq * 4) = wv; }
    __syncthreads();
}

DEV void ssd_out(const P& p, int l, int unit, unsigned char* lds) {
    const int b = unit >> 6, g = (unit >> 5) & 1, c = unit & 31;
    int tid_ = threadIdx.x; asm volatile("" : "+v"(tid_)); const int tid = tid_, lane = tid & 63, w = tid >> 6, fr = lane & 15, fq = lane >> 4;
    const int r0 = b * 2048 + c * 64;
    const bf16_t* U = (const bf16_t*)(p.ws + WS_U) + (size_t)r0 * INP;
    bf16_t* Xs = (bf16_t*)lds;
    bf16_t* Bm = Xs + 64 * 528;
    bf16_t* Cm = Bm + 64 * 136;
    float* CB = (float*)(lds + 102400);
    float* bsh = (float*)(lds + 119808);
    float* dtsh = bsh + 512;
    float* red = dtsh + 512;
    float* stat = red + 512;
    const int head = g * 8 + w;
    {
        const float dt = softplusf_(bf2f(U[(size_t)lane * INP + UDT + head]) + p.dt_bias[l * 16 + head]);
        const float a = -expf(p.A_log[l * 16 + head]) * dt;
        const float bs = wave_incl_sum(a, lane);
        bsh[w * 64 + lane] = bs; dtsh[w * 64 + lane] = dt;
    }
    const bf16_t* XBC = (const bf16_t*)(p.ws + WS_XBC) + (size_t)r0 * 1536;
#pragma unroll
    for (int i = 0; i < 12; ++i) {
        const int it = tid + 512 * i, t = it / 96, gidx = it % 96;
        const int ch8 = gidx < 64 ? g * 512 + gidx * 8 : (gidx < 80 ? 1024 + g * 128 + (gidx - 64) * 8 : 1280 + g * 128 + (gidx - 80) * 8);
        const u32x4 wv = *(const u32x4*)(XBC + (size_t)t * 1536 + ch8);
        if (gidx < 64) *(u32x4*)(Xs + t * 528 + gidx * 8) = wv;
        else if (gidx < 80) *(u32x4*)(Bm + t * 136 + (gidx - 64) * 8) = wv;
        else *(u32x4*)(Cm + t * 136 + (gidx - 80) * 8) = wv;
    }
    __syncthreads();
    {
        const int mt_ = w >> 1, nt0 = (w & 1) * 2;
        f32x4 cacc[2] = {(f32x4){0.f, 0.f, 0.f, 0.f}, (f32x4){0.f, 0.f, 0.f, 0.f}};
#pragma unroll
        for (int k0 = 0; k0 < 128; k0 += 32) {
            const bf16x8 a = *(const bf16x8*)(Cm + (16 * mt_ + fr) * 136 + k0 + fq * 8);
#pragma unroll
            for (int n = 0; n < 2; ++n) { const bf16x8 bb = *(const bf16x8*)(Bm + (16 * (nt0 + n) + fr) * 136 + k0 + fq * 8); cacc[n] = mfma16(a, bb, cacc[n]); }
        }
#pragma unroll
        for (int n = 0; n < 2; ++n)
#pragma unroll
            for (int j = 0; j < 4; ++j) CB[(16 * mt_ + fq * 4 + j) * 68 + 16 * (nt0 + n) + fr] = cacc[n][j];
    }
    __syncthreads();
    f32x4 acc1[4][4], acc2[4][4];
#pragma unroll
    for (int m = 0; m < 4; ++m)
#pragma unroll
        for (int n = 0; n < 4; ++n) { acc1[m][n] = (f32x4){0.f, 0.f, 0.f, 0.f}; acc2[m][n] = (f32x4){0.f, 0.f, 0.f, 0.f}; }
#pragma unroll
    for (int ks = 0; ks < 2; ++ks) {
        bf16x8 xf[4];
#pragma unroll
        for (int n = 0; n < 4; ++n) xf[n] = tr_frag(Xs, 528, 32 * ks, 64 * w + 16 * n, lane);
#pragma unroll
        for (int m = 0; m < 4; ++m) {
            if (ks * 32 > 16 * m + 15) continue;
            const int t = 16 * m + fr, s0 = 32 * ks + fq * 8;
            const float bt = bsh[w * 64 + t];
            const f32x4 c0 = *(const f32x4*)(CB + t * 68 + s0), c1 = *(const f32x4*)(CB + t * 68 + s0 + 4);
            float mv[8];
#pragma unroll
            for (int i = 0; i < 8; ++i) { const int s_ = s0 + i; const float cv = i < 4 ? c0[i & 3] : c1[i & 3];
                mv[i] = (s_ <= t) ? cv * expf(bt - bsh[w * 64 + s_]) * dtsh[w * 64 + s_] : 0.f; }
            union { u32x4 u; bf16x8 v; } af;
            af.u.x = pk2(mv[0], mv[1]); af.u.y = pk2(mv[2], mv[3]); af.u.z = pk2(mv[4], mv[5]); af.u.w = pk2(mv[6], mv[7]);
#pragma unroll
            for (int n = 0; n < 4; ++n) acc1[m][n] = mfma16(xf[n], af.v, acc1[m][n]);
        }
    }
    if (c > 0) {
        const bf16_t* STp = (const bf16_t*)(p.ws + WS_ST) + (size_t)((b * 16 + head) * 32 + c - 1) * 8192;
#pragma unroll
        for (int k0 = 0; k0 < 128; k0 += 32) {
            bf16x8 a[4];
#pragma unroll
            for (int m = 0; m < 4; ++m) a[m] = *(const bf16x8*)(Cm + (16 * m + fr) * 136 + k0 + fq * 8);
#pragma unroll
            for (int n = 0; n < 4; ++n) { const bf16x8 sf = *(const bf16x8*)(STp + (16 * n + fr) * 128 + k0 + fq * 8);
#pragma unroll
                for (int m = 0; m < 4; ++m) acc2[m][n] = mfma16(sf, a[m], acc2[m][n]); }
        }
    }
    const float dsk = p.D_skip[l * 16 + head];
#pragma unroll
    for (int m = 0; m < 4; ++m) {
        const int t = 16 * m + fr;
        const float eb = expf(bsh[w * 64 + t]);
        float sm = 0.f;
#pragma unroll
        for (int n = 0; n < 4; ++n) {
            const int pp4 = 16 * n + fq * 4;
            const uint2 xv = *(const uint2*)(Xs + t * 528 + 64 * w + pp4);
            const uint2 zv = *(const uint2*)(U + (size_t)t * INP + UZ + g * 512 + w * 64 + pp4);
            const float xs4[4] = {bflo(xv.x), bfhi(xv.x), bflo(xv.y), bfhi(xv.y)};
            const float z4[4] = {bflo(zv.x), bfhi(zv.x), bflo(zv.y), bfhi(zv.y)};
#pragma unroll
            for (int j = 0; j < 4; ++j) {
                const float y = acc1[m][n][j] + eb * acc2[m][n][j] + dsk * xs4[j];
                const float gt = y * z4[j] * sigmoidf_(z4[j]);
                acc1[m][n][j] = gt; sm += gt * gt;
            }
        }
        sm += __shfl_xor(sm, 16); sm += __shfl_xor(sm, 32);
        if (fq == 0) red[t * 8 + w] = sm;
    }
    __syncthreads();
    if (tid < 64) { float sm = 0.f;
#pragma unroll
        for (int i = 0; i < 8; ++i) sm += red[tid * 8 + i];
        stat[tid] = rsqrtf(sm * (1.0f / 512.0f) + 1e-6f); }
    __syncthreads();
    bf16_t* MX = (bf16_t*)(p.ws + WS_MIXIN);
#pragma unroll
    for (int m = 0; m < 4; ++m) {
        const int t = 16 * m + fr;
        const float rs = stat[t];
#pragma unroll
        for (int n = 0; n < 4; ++n) {
            const int ch = g * 512 + w * 64 + 16 * n + fq * 4;
            const f32x4 nw = *(const f32x4*)(p.s_norm_w + l * 1024 + ch);
            u32x2 wv; wv.x = pk2(acc1[m][n][0] * rs * nw[0], acc1[m][n][1] * rs * nw[1]); wv.y = pk2(acc1[m][n][2] * rs * nw[2], acc1[m][n][3] * rs * nw[3]);
            *(u32x2*)(MX + (size_t)(r0 + t) * D + 1024 + ch) = wv;
        }
    }
    __syncthreads();
}

DEV void smp_mlstm(const P& p, int l, int unit, unsigned char* lds) {
    const int b = unit >> 2, h = unit & 3;
    int tid_ = threadIdx.x; asm volatile("" : "+v"(tid_)); const int tid = tid_, lane = tid & 63, w = tid >> 6;
    const int r0 = NPR + b * 8;
    const bf16_t* U = (const bf16_t*)(p.ws + WS_U) + (size_t)r0 * INP;
    float* qn = (float*)lds; float* kn = qn + 2048; float* vn = kn + 2048; float* qT = vn + 2048; float* kwT = qT + 2048; float* sc = kwT + 2048; float* red = sc + 256;
    const size_t sidx = (size_t)(l * 128 + b) * 4 + h;
    const float* C0 = p.st_C + sidx * 65536; const float* n0 = p.st_n + sidx * 256;
    float* Cout = p.out + O_SC + sidx * 65536;
    if (tid == 0) {
        const float m0 = p.st_m[sidx];
        float bs = 0.f, cm = -INFINITY, mt = 0.f;
        for (int t = 0; t < 8; ++t) {
            const float ig = bf2f(U[(size_t)t * INP + UIG + h]) + p.b_i[l * 4 + h];
            const float lf = logsigf_(bf2f(U[(size_t)t * INP + UFG + h]) + p.b_f[l * 4 + h]);
            bs += lf; const float a = ig - bs; cm = fmaxf(cm, a); mt = bs + fmaxf(m0, cm);
            sc[32 + t] = mt; sc[t] = expf(bs + m0 - mt); sc[40 + t] = a; sc[48 + t] = bs;
        }
        for (int s = 0; s < 8; ++s) sc[16 + s] = expf(bs + sc[40 + s] - mt);
        sc[24] = expf(bs + m0 - mt);
        p.out[O_SM + sidx] = mt;
    }
    __syncthreads();
#pragma unroll
    for (int i = 0; i < 4; ++i) {
        const int idx = tid + 512 * i, t = idx >> 8, d = idx & 255;
        const float q = bf2f(U[(size_t)t * INP + UQ + h * 256 + d]), k = bf2f(U[(size_t)t * INP + UK + h * 256 + d]), v = bf2f(U[(size_t)t * INP + UV + h * 256 + d]);
        qn[t * 256 + d] = q; kn[t * 256 + d] = k; vn[t * 256 + d] = v; qT[d * 8 + t] = q; kwT[d * 8 + t] = k * sc[16 + t];
    }
    __syncthreads();
    {
        const int t = w;
        const f32x4 qv = *(const f32x4*)(qn + t * 256 + lane * 4);
        float dot[9];
#pragma unroll
        for (int s = 0; s < 8; ++s) { const f32x4 kv = *(const f32x4*)(kn + s * 256 + lane * 4); dot[s] = qv[0] * kv[0] + qv[1] * kv[1] + qv[2] * kv[2] + qv[3] * kv[3]; }
        { const f32x4 nv = *(const f32x4*)(n0 + lane * 4); dot[8] = qv[0] * nv[0] + qv[1] * nv[1] + qv[2] * nv[2] + qv[3] * nv[3]; }
#pragma unroll
        for (int s = 0; s < 9; ++s) dot[s] = wave_sum(dot[s]);
        float den = 0.f;
#pragma unroll
        for (int s = 0; s < 8; ++s) { const float sv = (s <= t) ? dot[s] * expf(sc[48 + t] - sc[32 + t] + sc[40 + s]) : 0.f; den += sv; if (lane == 0) sc[64 + t * 8 + s] = sv; }
        den += sc[t] * dot[8];
        if (lane == 0) sc[8 + t] = 1.0f / fmaxf(fabsf(den), expf(-sc[32 + t]));
    }
    if (tid < 256) {
        float a = sc[24] * n0[tid];
#pragma unroll
        for (int s = 0; s < 8; ++s) a += kwT[tid * 8 + s];
        p.out[O_SN + sidx * 256 + tid] = a;
    }
    const int e4 = lane * 4;
    f32x4 num[8], vv[8];
#pragma unroll
    for (int t = 0; t < 8; ++t) { num[t] = (f32x4){0.f, 0.f, 0.f, 0.f}; vv[t] = *(const f32x4*)(vn + t * 256 + e4); }
    const float decay = sc[24];
    {
        f32x4 cn_[8];
#pragma unroll
        for (int j = 0; j < 8; ++j) cn_[j] = __builtin_nontemporal_load((const f32x4*)(C0 + (size_t)(w + 8 * j) * 256 + e4));
#pragma unroll 1
        for (int ib = 0; ib < 4; ++ib) {
            f32x4 cc[8];
#pragma unroll
            for (int j = 0; j < 8; ++j) cc[j] = cn_[j];
            if (ib < 3) {
#pragma unroll
                for (int j = 0; j < 8; ++j) cn_[j] = __builtin_nontemporal_load((const f32x4*)(C0 + (size_t)(w + 8 * ((ib + 1) * 8 + j)) * 256 + e4));
            }
#pragma unroll
            for (int j = 0; j < 8; ++j) {
                const int d = w + 8 * (ib * 8 + j);
                const f32x4 q0 = *(const f32x4*)(qT + d * 8), q1 = *(const f32x4*)(qT + d * 8 + 4), k0 = *(const f32x4*)(kwT + d * 8), k1 = *(const f32x4*)(kwT + d * 8 + 4);
                f32x4 cn = cc[j] * decay;
#pragma unroll
                for (int t = 0; t < 4; ++t) { num[t] += cc[j] * q0[t]; num[4 + t] += cc[j] * q1[t]; cn += vv[t] * k0[t]; cn += vv[4 + t] * k1[t]; }
                __builtin_nontemporal_store(cn, (f32x4*)(Cout + (size_t)d * 256 + e4));
            }
        }
    }
#pragma unroll
    for (int t = 0; t < 8; ++t) *(f32x4*)(red + (w * 8 + t) * 256 + e4) = num[t];
    __syncthreads();
    {
        const int t = w;
        f32x4 hv = (f32x4){0.f, 0.f, 0.f, 0.f};
#pragma unroll
        for (int ww = 0; ww < 8; ++ww) hv += *(const f32x4*)(red + (ww * 8 + t) * 256 + e4);
        hv = hv * sc[t];
#pragma unroll
        for (int s = 0; s < 8; ++s) hv += vv[s] * sc[64 + t * 8 + s];
        hv = hv * sc[8 + t];
        const float mu = wave_sum(hv[0] + hv[1] + hv[2] + hv[3]) * (1.0f / 256.0f);
        const f32x4 dv = hv - mu;
        const float var = wave_sum(dv[0] * dv[0] + dv[1] * dv[1] + dv[2] * dv[2] + dv[3] * dv[3]) * (1.0f / 256.0f);
        const float rs = rsqrtf(var + 1e-6f);
        const uint2 ov = *(const uint2*)(U + (size_t)t * INP + UO + h * 256 + e4);
        const f32x4 nw = *(const f32x4*)(p.m_norm_w + l * 1024 + h * 256 + e4);
        const float o0 = dv[0] * rs * nw[0] * sigmoidf_(bflo(ov.x)), o1 = dv[1] * rs * nw[1] * sigmoidf_(bfhi(ov.x));
        const float o2 = dv[2] * rs * nw[2] * sigmoidf_(bflo(ov.y)), o3 = dv[3] * rs * nw[3] * sigmoidf_(bfhi(ov.y));
        u32x2 wv; wv.x = pk2(o0, o1); wv.y = pk2(o2, o3);
        *(u32x2*)((bf16_t*)(p.ws + WS_MIXIN) + (size_t)(r0 + t) * D + h * 256 + e4) = wv;
    }
    __syncthreads();
}

DEV void smp_ssd(const P& p, int l, int unit, unsigned char* lds) {
    const int b = unit >> 1, g = unit & 1;
    int tid_ = threadIdx.x; asm volatile("" : "+v"(tid_)); const int tid = tid_, lane = tid & 63, w = tid >> 6, fr = lane & 15, fq = lane >> 4;
    const int r0 = NPR + b * 8;
    const bf16_t* U = (const bf16_t*)(p.ws + WS_U) + (size_t)r0 * INP;
    float* xs = (float*)lds;
    float* xwT = xs + 4096;
    float* Bmf = xwT + 4096;
    float* CBs = Bmf + 1024;
    float* bsh = CBs + 64;
    float* dtsh = bsh + 64;
    float* bLs = dtsh + 64;
    float* MW = bLs + 64;
    float* red = MW + 512;
    float* stat = red + 64;
    bf16_t* Cmb = (bf16_t*)(stat + 64);
    if (tid < 64) {
        const int hd = tid >> 3, t = tid & 7, head = g * 8 + hd;
        const float A = -expf(p.A_log[l * 16 + head]), dtb = p.dt_bias[l * 16 + head];
        float bs = 0.f, bL = 0.f, dtt = 0.f;
        for (int s = 0; s < 8; ++s) { const float dt = softplusf_(bf2f(U[(size_t)s * INP + UDT + head]) + dtb); bL += dt * A; if (s <= t) bs += dt * A; if (s == t) dtt = dt; }
        bsh[hd * 8 + t] = bs; dtsh[hd * 8 + t] = dtt; if (t == 0) bLs[hd] = bL;
    }
    for (int i = tid; i < 8 * 136 / 2; i += NTHR) ((unsigned*)(Cmb + 8 * 136))[i] = 0u;
    const float* cw = p.s_conv_w + (size_t)l * 4 * 1536; const float* cb = p.s_conv_b + (size_t)l * 1536;
    const float* cv0 = p.st_sconv + (size_t)(l * 128 + b) * 3 * 1536;
    for (int i = 0; i < 2; ++i) {
        const int it = tid + 512 * i;
        if (it < 768) {
            const int t = it / 96, gidx = it % 96;
            const int ch8 = gidx < 64 ? g * 512 + gidx * 8 : (gidx < 80 ? 1024 + g * 128 + (gidx - 64) * 8 : 1280 + g * 128 + (gidx - 80) * 8);
            float o[8];
            { const f32x4 b0 = *(const f32x4*)(cb + ch8), b1 = *(const f32x4*)(cb + ch8 + 4); o[0] = b0[0]; o[1] = b0[1]; o[2] = b0[2]; o[3] = b0[3]; o[4] = b1[0]; o[5] = b1[1]; o[6] = b1[2]; o[7] = b1[3]; }
#pragma unroll
            for (int j = 0; j < 4; ++j) {
                const int idx = t + j;
                float xf[8];
                if (idx < 3) { const f32x4 a0 = *(const f32x4*)(cv0 + idx * 1536 + ch8), a1 = *(const f32x4*)(cv0 + idx * 1536 + ch8 + 4);
                    xf[0] = a0[0]; xf[1] = a0[1]; xf[2] = a0[2]; xf[3] = a0[3]; xf[4] = a1[0]; xf[5] = a1[1]; xf[6] = a1[2]; xf[7] = a1[3]; }
                else { const uint4 x = *(const uint4*)(U + (size_t)(idx - 3) * INP + UXS + ch8); unpack8(x, xf); }
                const f32x4 w0 = *(const f32x4*)(cw + j * 1536 + ch8), w1 = *(const f32x4*)(cw + j * 1536 + ch8 + 4);
                o[0] += w0[0] * xf[0]; o[1] += w0[1] * xf[1]; o[2] += w0[2] * xf[2]; o[3] += w0[3] * xf[3];
                o[4] += w1[0] * xf[4]; o[5] += w1[1] * xf[5]; o[6] += w1[2] * xf[6]; o[7] += w1[3] * xf[7];
            }
#pragma unroll
            for (int k = 0; k < 8; ++k) o[k] = siluf_(o[k]);
            if (gidx < 64) {
#pragma unroll
                for (int k = 0; k < 8; ++k) xs[t * 512 + gidx * 8 + k] = o[k]; }
            else if (gidx < 80) {
#pragma unroll
                for (int k = 0; k < 8; ++k) Bmf[t * 128 + (gidx - 64) * 8 + k] = o[k]; }
            else { u32x4 wv; wv.x = pk2(o[0], o[1]); wv.y = pk2(o[2], o[3]); wv.z = pk2(o[4], o[5]); wv.w = pk2(o[6], o[7]); *(u32x4*)(Cmb + t * 136 + (gidx - 80) * 8) = wv; }
        }
    }
    __syncthreads();
#pragma unroll
    for (int i = 0; i < 8; ++i) {
        const int idx = tid + 512 * i, hp = idx >> 3, s = idx & 7, hd = hp >> 6;
        xwT[hp * 8 + s] = xs[s * 512 + hp] * expf(bLs[hd] - bsh[hd * 8 + s]) * dtsh[hd * 8 + s];
    }
    if (tid < 64) {
        const int t = tid >> 3, s = tid & 7; float a = 0.f;
        for (int n = 0; n < 128; ++n) a += bf2f(Cmb[t * 136 + n]) * Bmf[s * 128 + n];
        CBs[t * 8 + s] = a;
    }
    __syncthreads();
    { const int hd = tid >> 6, t = (tid >> 3) & 7, s = tid & 7;
      MW[tid] = (s <= t) ? CBs[t * 8 + s] * expf(bsh[hd * 8 + t] - bsh[hd * 8 + s]) * dtsh[hd * 8 + s] : 0.f; }
    __syncthreads();
    const int head = g * 8 + w;
    const size_t sidx = (size_t)(l * 128 + b) * 16 + head;
    const float* S0 = p.st_ssm + sidx * 8192; float* So = p.out + O_SS + sidx * 8192;
    const float dA = expf(bLs[w]);
    f32x4 acc[4];
    f32x4 svn[4][2];
#pragma unroll
    for (int ks = 0; ks < 4; ++ks) { svn[ks][0] = __builtin_nontemporal_load((const f32x4*)(S0 + fr * 128 + 32 * ks + fq * 8)); svn[ks][1] = __builtin_nontemporal_load((const f32x4*)(S0 + fr * 128 + 32 * ks + fq * 8 + 4)); }
#pragma unroll
    for (int nt = 0; nt < 4; ++nt) {
        acc[nt] = (f32x4){0.f, 0.f, 0.f, 0.f};
        const int pp = 16 * nt + fr;
        const f32x4 xw0 = *(const f32x4*)(xwT + (64 * w + pp) * 8), xw1 = *(const f32x4*)(xwT + (64 * w + pp) * 8 + 4);
        f32x4 sv[4][2];
#pragma unroll
        for (int ks = 0; ks < 4; ++ks) { sv[ks][0] = svn[ks][0]; sv[ks][1] = svn[ks][1]; }
        if (nt < 3) {
#pragma unroll
            for (int ks = 0; ks < 4; ++ks) { svn[ks][0] = __builtin_nontemporal_load((const f32x4*)(S0 + (pp + 16) * 128 + 32 * ks + fq * 8)); svn[ks][1] = __builtin_nontemporal_load((const f32x4*)(S0 + (pp + 16) * 128 + 32 * ks + fq * 8 + 4)); }
        }
#pragma unroll
        for (int ks = 0; ks < 4; ++ks) {
            const int n0 = 32 * ks + fq * 8;
            const f32x4 s0 = sv[ks][0], s1 = sv[ks][1];
            union { u32x4 u; bf16x8 v; } bfr;
            bfr.u.x = pk2(s0[0], s0[1]); bfr.u.y = pk2(s0[2], s0[3]); bfr.u.z = pk2(s1[0], s1[1]); bfr.u.w = pk2(s1[2], s1[3]);
            const bf16x8 af = *(const bf16x8*)(Cmb + fr * 136 + n0);
            acc[nt] = mfma16(af, bfr.v, acc[nt]);
            f32x4 o0 = s0 * dA, o1 = s1 * dA;
#pragma unroll
            for (int s = 0; s < 8; ++s) {
                const float xv = s < 4 ? xw0[s & 3] : xw1[s & 3];
                const f32x4 bm0 = *(const f32x4*)(Bmf + s * 128 + n0), bm1 = *(const f32x4*)(Bmf + s * 128 + n0 + 4);
                o0 += bm0 * xv; o1 += bm1 * xv;
            }
            __builtin_nontemporal_store(o0, (f32x4*)(So + pp * 128 + n0)); __builtin_nontemporal_store(o1, (f32x4*)(So + pp * 128 + n0 + 4));
        }
        asm volatile("" ::: "memory");
    }
    const float dsk = p.D_skip[l * 16 + head];
    float gts[4][4];
#pragma unroll
    for (int j = 0; j < 4; ++j) {
        const int t = (fq & 1) * 4 + j;
        const float eb = expf(bsh[w * 8 + t]);
        float ssq = 0.f;
#pragma unroll
        for (int nt = 0; nt < 4; ++nt) {
            const int hp = 64 * w + 16 * nt + fr;
            float y = eb * acc[nt][j] + dsk * xs[t * 512 + hp];
#pragma unroll
            for (int s = 0; s < 8; ++s) y += MW[(w * 8 + t) * 8 + s] * xs[s * 512 + hp];
            const float z = bf2f(U[(size_t)t * INP + UZ + g * 512 + hp]);
            const float gt = y * siluf_(z);
            gts[nt][j] = gt; ssq += gt * gt;
        }
        ssq += __shfl_xor(ssq, 1); ssq += __shfl_xor(ssq, 2); ssq += __shfl_xor(ssq, 4); ssq += __shfl_xor(ssq, 8);
        if (fr == 0 && fq < 2) red[t * 8 + w] = ssq;
    }
    __syncthreads();
    if (tid < 8) { float s = 0.f;
#pragma unroll
        for (int i = 0; i < 8; ++i) s += red[tid * 8 + i];
        stat[tid] = rsqrtf(s * (1.0f / 512.0f) + 1e-6f); }
    __syncthreads();
    if (fq < 2) {
        bf16_t* MX = (bf16_t*)(p.ws + WS_MIXIN);
#pragma unroll
        for (int j = 0; j < 4; ++j) {
            const int t = fq * 4 + j;
#pragma unroll
            for (int nt = 0; nt < 4; ++nt) {
                const int ch = g * 512 + 64 * w + 16 * nt + fr;
                MX[(size_t)(r0 + t) * D + 1024 + ch] = f2bf(gts[nt][j] * stat[t] * p.s_norm_w[l * 1024 + ch]);
            }
        }
    }
    __syncthreads();
}

DEV void phase_ln(const P& p, int l, int which) {
    int tid_ = threadIdx.x; asm volatile("" : "+v"(tid_));
    const int lane = tid_ & 63, w = tid_ >> 6;
    const float* gam = (which ? p.ln2_g : p.ln1_g) + l * D; const float* bet = (which ? p.ln2_b : p.ln1_b) + l * D;
    const bf16_t* mix = (const bf16_t*)(p.ws + WS_MIXF);
    bf16_t* xb = (bf16_t*)(p.ws + WS_XB);
    const bool lastp = (l == 1 && which == 1), split = (gridDim.x == 256);
    for (int r = blockIdx.x * 8 + w; r < NTOK; r += gridDim.x * 8) {
        f32x4 y[8]; float s = 0.f;
#pragma unroll
        for (int i = 0; i < 8; ++i) { const int cidx = i * 256 + lane * 4;
            f32x4 xv, mv;
            { const uint2 t = *(const uint2*)(xb + (size_t)r * D + cidx); xv = (f32x4){bflo(t.x), bfhi(t.x), bflo(t.y), bfhi(t.y)}; }
            if (split && r >= NPR) { const bf16_t* pp = (const bf16_t*)(p.ws + WS_PART) + (size_t)(r - NPR) * D + cidx; mv = (f32x4){0.f, 0.f, 0.f, 0.f};
#pragma unroll
                for (int k = 0; k < 8; ++k) { const uint2 t = *(const uint2*)(pp + (size_t)k * NSM * D); mv += (f32x4){bflo(t.x), bfhi(t.x), bflo(t.y), bfhi(t.y)}; } }
            else { const uint2 t = *(const uint2*)(mix + (size_t)r * D + cidx); mv = (f32x4){bflo(t.x), bfhi(t.x), bflo(t.y), bfhi(t.y)}; }
            y[i] = xv * ALPHA + mv; s += (y[i][0] + y[i][1]) + (y[i][2] + y[i][3]); }
        const float mu = wave_sum(s) * (1.0f / D);
        float q = 0.f;
#pragma unroll
        for (int i = 0; i < 8; ++i) { y[i] = y[i] - mu; q += (y[i][0] * y[i][0] + y[i][1] * y[i][1]) + (y[i][2] * y[i][2] + y[i][3] * y[i][3]); }
        const float rs = rsqrtf(wave_sum(q) * (1.0f / D) + 1e-5f);
#pragma unroll
        for (int i = 0; i < 8; ++i) { const int cidx = i * 256 + lane * 4;
            const f32x4 o = y[i] * rs * *(const f32x4*)(gam + cidx) + *(const f32x4*)(bet + cidx);
            if (lastp) *(f32x4*)(p.out + (size_t)r * D + cidx) = o;
            else { u32x2 wv; wv.x = pk2(o[0], o[1]); wv.y = pk2(o[2], o[3]); *(u32x2*)(xb + (size_t)r * D + cidx) = wv; } }
    }
}

DEV void phase_ffn_gate(const P& p, int l) {
    const bf16_t* up = (const bf16_t*)(p.ws + WS_UP); bf16_t* act = (bf16_t*)(p.ws + WS_ACT);
    const float* fw = p.f_conv_w + (size_t)l * 3 * DFF2; const float* fb = p.f_conv_b + (size_t)l * DFF2;
    const int total = (NTOK / 8) * (DFF / 8);
    int tid_ = threadIdx.x; asm volatile("" : "+v"(tid_));
    for (int it = blockIdx.x * NTHR + tid_; it < total; it += gridDim.x * NTHR) {
        const int rb = it / (DFF / 8), j8 = (it % (DFF / 8)) * 8, r0 = rb * 8;
        const bool smp = r0 >= NPR; const int t0 = smp ? 0 : (r0 & 2047); const int sb = (r0 - NPR) >> 3;
        float wg[3][8], wv[3][8], bg[8], bv[8];
#pragma unroll
        for (int k = 0; k < 3; ++k) {
            const f32x4 a0 = *(const f32x4*)(fw + k * DFF2 + j8), a1 = *(const f32x4*)(fw + k * DFF2 + j8 + 4), c0 = *(const f32x4*)(fw + k * DFF2 + DFF + j8), c1 = *(const f32x4*)(fw + k * DFF2 + DFF + j8 + 4);
#pragma unroll
            for (int i = 0; i < 4; ++i) { wg[k][i] = a0[i]; wg[k][4 + i] = a1[i]; wv[k][i] = c0[i]; wv[k][4 + i] = c1[i]; }
        }
        { const f32x4 a0 = *(const f32x4*)(fb + j8), a1 = *(const f32x4*)(fb + j8 + 4), c0 = *(const f32x4*)(fb + DFF + j8), c1 = *(const f32x4*)(fb + DFF + j8 + 4);
#pragma unroll
          for (int i = 0; i < 4; ++i) { bg[i] = a0[i]; bg[4 + i] = a1[i]; bv[i] = c0[i]; bv[4 + i] = c1[i]; } }
        float g0[8], g1[8], v0[8], v1[8];
        if (t0 > 0) {
            unpack8(*(const uint4*)(up + (size_t)(r0 - 2) * DFF2 + j8), g0); unpack8(*(const uint4*)(up + (size_t)(r0 - 2) * DFF2 + DFF + j8), v0);
            unpack8(*(const uint4*)(up + (size_t)(r0 - 1) * DFF2 + j8), g1); unpack8(*(const uint4*)(up + (size_t)(r0 - 1) * DFF2 + DFF + j8), v1);
        } else if (smp) {
            const float* bp = p.st_fconv + (size_t)(l * 128 + sb) * 2 * DFF2;
            const f32x4 a0 = *(const f32x4*)(bp + j8), a1 = *(const f32x4*)(bp + j8 + 4), c0 = *(const f32x4*)(bp + DFF + j8), c1 = *(const f32x4*)(bp + DFF + j8 + 4);
            const f32x4 d0 = *(const f32x4*)(bp + DFF2 + j8), d1 = *(const f32x4*)(bp + DFF2 + j8 + 4), e0 = *(const f32x4*)(bp + DFF2 + DFF + j8), e1 = *(const f32x4*)(bp + DFF2 + DFF + j8 + 4);
#pragma unroll
            for (int i = 0; i < 4; ++i) { g0[i] = a0[i]; g0[4 + i] = a1[i]; v0[i] = c0[i]; v0[4 + i] = c1[i]; g1[i] = d0[i]; g1[4 + i] = d1[i]; v1[i] = e0[i]; v1[4 + i] = e1[i]; }
        } else {
#pragma unroll
            for (int i = 0; i < 8; ++i) { g0[i] = 0.f; g1[i] = 0.f; v0[i] = 0.f; v1[i] = 0.f; }
        }
#pragma unroll
        for (int rr = 0; rr < 8; ++rr) {
            float g2[8], v2[8];
            unpack8(*(const uint4*)(up + (size_t)(r0 + rr) * DFF2 + j8), g2); unpack8(*(const uint4*)(up + (size_t)(r0 + rr) * DFF2 + DFF + j8), v2);
            float o[8];
#pragma unroll
            for (int i = 0; i < 8; ++i) {
                const float ag = bg[i] + wg[0][i] * g0[i] + wg[1][i] * g1[i] + wg[2][i] * g2[i];
                const float av = bv[i] + wv[0][i] * v0[i] + wv[1][i] * v1[i] + wv[2][i] * v2[i];
                o[i] = ag * __builtin_amdgcn_rcpf(1.0f + __expf(-ag)) * av;
                g0[i] = g1[i]; g1[i] = g2[i]; v0[i] = v1[i]; v1[i] = v2[i];
            }
            u32x4 wv4; wv4.x = pk2(o[0], o[1]); wv4.y = pk2(o[2], o[3]); wv4.z = pk2(o[4], o[5]); wv4.w = pk2(o[6], o[7]);
            *(u32x4*)(act + (size_t)(r0 + rr) * DFF + j8) = wv4;
        }
    }
    const int tot2 = 132 * 2 * (DFF2 / 8);
    for (int it = blockIdx.x * NTHR + tid_; it < tot2; it += gridDim.x * NTHR) {
        const int c8 = (it % (DFF2 / 8)) * 8, rr = it / (DFF2 / 8), j = rr & 1, sq = rr >> 1;
        float* o; size_t row;
        if (sq < 4) { o = p.out + O_PFC + ((size_t)(l * 4 + sq) * 2 + j) * DFF2 + c8; row = (size_t)sq * 2048 + 2046 + j; }
        else { const int b = sq - 4; o = p.out + O_SFC + ((size_t)(l * 128 + b) * 2 + j) * DFF2 + c8; row = (size_t)NPR + b * 8 + 6 + j; }
        float xf[8]; unpack8(*(const uint4*)(up + row * DFF2 + c8), xf);
        *(f32x4*)o = (f32x4){xf[0], xf[1], xf[2], xf[3]}; *(f32x4*)(o + 4) = (f32x4){xf[4], xf[5], xf[6], xf[7]};
    }
}


#define XB_TMO      128
#define XB_XCNT(j)  (256  + 64 * (j))
#define XB_XSUB(j)  (1280 + 64 * (j))
#define XB_XGEN(j)  (2304 + 64 * (j))
#define XB_TOP      3328
#define XB_TOPGEN   3392
#define XCD_BAR_WORDS 3456
#define XB_SPIN_CAP (1u << 20)
DEV unsigned xb_ld(unsigned* p)              { return __hip_atomic_load(p, __ATOMIC_RELAXED, __HIP_MEMORY_SCOPE_AGENT); }
DEV unsigned xb_add(unsigned* p, unsigned v) { return __hip_atomic_fetch_add(p, v, __ATOMIC_RELAXED, __HIP_MEMORY_SCOPE_AGENT); }
DEV unsigned xb_xcc_id() { return (unsigned)__builtin_amdgcn_s_getreg((3 << 11) | 20) & 0xFu; }
#define XB_SPIN(cond, bar) do { unsigned _sp = 0; while (cond) { __builtin_amdgcn_s_sleep(1); \
    if ((++_sp & 255u) == 0u) { if (xb_ld(&(bar)[XB_TMO])) break; if (_sp > XB_SPIN_CAP) { atomicAdd(&(bar)[XB_TMO], 1u); break; } } } } while (0)
struct XcdBarrier { unsigned* bar; unsigned x; volatile LAS unsigned* st; };
DEV XcdBarrier xcd_barrier_post(unsigned* bar, volatile LAS unsigned* st) {
    XcdBarrier b; b.bar = bar; b.x = xb_xcc_id(); b.st = st;
    if (threadIdx.x == 0) (void)xb_add(&bar[XB_XCNT(b.x)], 1u);
    return b;
}
DEV void xcd_barrier_complete(unsigned* bar, unsigned x, unsigned& nloc, unsigned& nx) {
    const unsigned G = gridDim.x * gridDim.y * gridDim.z;
    unsigned sum, cnt, mine, sp = 0u;
    for (;;) {
        sum = 0u; cnt = 0u; mine = 0u;
#pragma unroll
        for (unsigned j = 0; j < 16; ++j) { const unsigned c = xb_ld(&bar[XB_XCNT(j)]); sum += c; cnt += (c > 0u) ? 1u : 0u; mine = (j == x) ? c : mine; }
        if (sum == G) break;
        __builtin_amdgcn_s_sleep(1);
        if ((++sp & 255u) == 0u) { if (xb_ld(&bar[XB_TMO])) break; if (sp > XB_SPIN_CAP) { atomicAdd(&bar[XB_TMO], 1u); break; } }
    }
    nloc = mine > 0u ? mine : 1u; nx = cnt > 0u ? cnt : 1u;
}
DEV void xcd_barrier(const XcdBarrier& b) {
    asm volatile("s_waitcnt vmcnt(0)" ::: "memory");
    __syncthreads();
    if (threadIdx.x == 0) {
        unsigned* bar = b.bar;
        __builtin_amdgcn_s_waitcnt(0);
        unsigned nloc = b.st[0], nx = b.st[1];
        if (nloc == 0u) { xcd_barrier_complete(bar, b.x, nloc, nx); b.st[0] = nloc; b.st[1] = nx; }
        const unsigned old = xb_add(&bar[XB_XSUB(b.x)], 1u);
        const unsigned gen = old / nloc;
        if (old + 1u == (gen + 1u) * nloc) {
            __builtin_amdgcn_fence(__ATOMIC_RELEASE, "agent");
            asm volatile("s_waitcnt vmcnt(0)" ::: "memory");
            const unsigned og = xb_add(&bar[XB_TOP], 1u);
            const unsigned tg = og / nx;
            if (og + 1u == (tg + 1u) * nx) xb_add(&bar[XB_TOPGEN], 1u);
            else XB_SPIN(xb_ld(&bar[XB_TOPGEN]) == tg, bar);
            __builtin_amdgcn_fence(__ATOMIC_ACQUIRE, "agent");
            xb_add(&bar[XB_XGEN(b.x)], 1u);
            asm volatile("s_waitcnt vmcnt(0)" ::: "memory");
        } else {
            XB_SPIN(xb_ld(&bar[XB_XGEN(b.x)]) == gen, bar);
            __builtin_amdgcn_fence(__ATOMIC_ACQUIRE, "agent");
            asm volatile("s_waitcnt vmcnt(0)" ::: "memory");
        }
    }
    __syncthreads();
}

constexpr int NPHASE = 21;
DEV void run_phase(const P& p, int l, int q, unsigned char* lds) {
    int bid = blockIdx.x, G = gridDim.x; asm volatile("" : "+s"(bid), "+s"(G));
    if (q == 0) {
        pg8::Gemm g{(const bf16_t*)(p.ws + WS_XB), (const bf16_t*)(p.ws + WS_WIN) + (size_t)l * INP * D, NTOK, INP, D};
        pg8::StaticOrder S; S.init(NTOK, INP, D, G, bid);
        pg8::EpiBf16 E{(bf16_t*)(p.ws + WS_U), INP, nullptr};
        pg8::gemm_phase<pg8::EpiBf16, pg8::StaticOrder>((LAS unsigned char*)lds, g, S, E);
    } else if (q == 1) {
        const int par = bid & 1;
#pragma unroll 1
        for (int half = 0; half < 2; ++half) {
            if ((half ^ par) == 0) {
                for (int u = bid; u < 512; u += G) smp_mlstm(p, l, u, lds);
                for (int u = bid; u < 256; u += G) smp_ssd(p, l, u, lds);
            } else {
                for (int u = bid; u < 512; u += G) mlstm_local(p, l, u, lds);
                for (int u = bid; u < 256; u += G) ssd_local(p, l, u, lds);
            }
        }
    } else if (q == 2) {
        for (int u = bid; u < 256; u += G) mlstm_scan(p, l, u, lds);
        for (int u = bid; u < 256; u += G) ssd_scan(p, l, u, lds);
        for (int u = bid; u < 132; u += G) convstate_copy(p, l, u);
    } else if (q == 3) {
        for (int u = bid; u < 512; u += G) mlstm_out(p, l, u, lds);
        for (int u = bid; u < 256; u += G) ssd_out(p, l, u, lds);
    } else if (q == 4) {
        pg8::Gemm g{(const bf16_t*)(p.ws + WS_MIXIN), (const bf16_t*)(p.ws + WS_WOUT) + (size_t)l * D * D, NTOK, D, D};
        pg8::EpiBf16 E{(bf16_t*)(p.ws + WS_MIXF), D, (float*)(p.ws + WS_PART)};
        if (G == 256) { pg8::TailSplitOrder S; S.init(D, bid); pg8::gemm_phase<pg8::EpiBf16, pg8::TailSplitOrder>((LAS unsigned char*)lds, g, S, E); }
        else { pg8::StaticOrder S; S.init(NTOK, D, D, G, bid); pg8::gemm_phase<pg8::EpiBf16, pg8::StaticOrder>((LAS unsigned char*)lds, g, S, E); }
    } else if (q == 5) {
        phase_ln(p, l, 0);
    } else if (q == 6) {
        pg8::Gemm g{(const bf16_t*)(p.ws + WS_XB), (const bf16_t*)(p.ws + WS_WUP) + (size_t)l * DFF2 * D, NTOK, DFF2, D};
        pg8::StaticOrder S; S.init(NTOK, DFF2, D, G, bid);
        pg8::EpiBf16 E{(bf16_t*)(p.ws + WS_UP), DFF2, nullptr};
        pg8::gemm_phase<pg8::EpiBf16, pg8::StaticOrder>((LAS unsigned char*)lds, g, S, E);
        if (l == 0 && G == 256 && bid >= 12) phase_prologue(p, lds, 1, 2, false, bid - 12, 244);
    } else if (q == 7) {
        phase_ffn_gate(p, l);
    } else if (q == 8) {
        pg8::Gemm g{(const bf16_t*)(p.ws + WS_ACT), (const bf16_t*)(p.ws + WS_WDN) + (size_t)l * D * DFF, NTOK, D, DFF};
        pg8::EpiBf16 E{(bf16_t*)(p.ws + WS_MIXF), D, (float*)(p.ws + WS_PART)};
        if (G == 256) { pg8::TailSplitOrder S; S.init(DFF, bid); pg8::gemm_phase<pg8::EpiBf16, pg8::TailSplitOrder>((LAS unsigned char*)lds, g, S, E); }
        else { pg8::StaticOrder S; S.init(NTOK, D, DFF, G, bid); pg8::gemm_phase<pg8::EpiBf16, pg8::StaticOrder>((LAS unsigned char*)lds, g, S, E); }
    } else {
        phase_ln(p, l, 1);
    }
}
#if MK_MULTI
template <int T> __global__ void __launch_bounds__(NTHR, 2) k_unit(P p) {
    extern __shared__ __attribute__((aligned(16))) unsigned char lds[];
    const int l = p.ph_lo; int bid = blockIdx.x, G = gridDim.x;
    if (T == 11) for (int u = bid; u < 512; u += G) smp_mlstm(p, l, u, lds);
    if (T == 12) for (int u = bid; u < 256; u += G) smp_ssd(p, l, u, lds);
    if (T == 13) for (int u = bid; u < 512; u += G) mlstm_local(p, l, u, lds);
    if (T == 14) for (int u = bid; u < 256; u += G) ssd_local(p, l, u, lds);
    if (T == 31) for (int u = bid; u < 512; u += G) mlstm_out(p, l, u, lds);
    if (T == 32) for (int u = bid; u < 256; u += G) ssd_out(p, l, u, lds);
    if (T == 21) for (int u = bid; u < 256; u += G) mlstm_scan(p, l, u, lds);
    if (T == 22) for (int u = bid; u < 256; u += G) ssd_scan(p, l, u, lds);
}
template <int Q> __global__ void __launch_bounds__(NTHR, 2) k_phase(P p) {
    extern __shared__ __attribute__((aligned(16))) unsigned char lds[];
    if (Q < 0) phase_prologue(p, lds, 0, gridDim.x == 256 ? 1 : 2, true, blockIdx.x, gridDim.x); else run_phase(p, p.ph_lo, Q, lds);
}
#else
__global__ void __launch_bounds__(NTHR, 2) mk_fwd(P p) {
    extern __shared__ __attribute__((aligned(16))) unsigned char lds[];
    cg::grid_group grid = cg::this_grid();
    if (p.ph_hi < 0) grid.sync();
    if (threadIdx.x < 4) ((unsigned*)(lds + LDS_BYTES - 16))[threadIdx.x] = 0u;
    __syncthreads();
    (void)xcd_barrier_post((unsigned*)(p.ws + WS_BAR), (volatile LAS unsigned*)(lds + LDS_BYTES - 16));
#define GSYNC() do { XcdBarrier b_; b_.bar = (unsigned*)(p.ws + WS_BAR); b_.x = xb_xcc_id(); b_.st = (volatile LAS unsigned*)(lds + LDS_BYTES - 16); xcd_barrier(b_); } while (0)
    phase_prologue(p, lds, 0, gridDim.x == 256 ? 1 : 2, true, blockIdx.x, gridDim.x);
#pragma unroll 1
    for (int l = 0; l < 2; ++l) {
        GSYNC(); run_phase(p, l, 0, lds);
        GSYNC(); run_phase(p, l, 1, lds);
        GSYNC(); run_phase(p, l, 2, lds);
        GSYNC(); run_phase(p, l, 3, lds);
        GSYNC(); run_phase(p, l, 4, lds);
        GSYNC(); run_phase(p, l, 5, lds);
        GSYNC(); run_phase(p, l, 6, lds);
        GSYNC(); run_phase(p, l, 7, lds);
        GSYNC(); run_phase(p, l, 8, lds);
        GSYNC(); run_phase(p, l, 9, lds);
    }
    for (int i = 0; i < PROBE_SYNCS; ++i) GSYNC();
}
#endif

extern "C" void kernel_launch(void* const* d_in, const int* in_sizes, int n_in, void* d_out, int out_size, void* d_ws, size_t ws_size, hipStream_t stream) {
    static int grid = 0;
    if (grid == 0) {
        if (n_in != 27 || ws_size < WS_END) { fprintf(stderr, "kernel_launch: unexpected n_in %d or ws_size %zu (need %zu)\n", n_in, ws_size, (size_t)WS_END); grid = -1; return; }
        int dev = 0, cus = 0, per_cu = 0;
        hipGetDevice(&dev);
        hipDeviceGetAttribute(&cus, hipDeviceAttributeMultiprocessorCount, dev);
#if MK_MULTI
        const void* fns[11] = {(const void*)k_phase<-1>, (const void*)k_phase<0>, (const void*)k_phase<1>, (const void*)k_phase<2>, (const void*)k_phase<3>, (const void*)k_phase<4>, (const void*)k_phase<5>,
                               (const void*)k_phase<6>, (const void*)k_phase<7>, (const void*)k_phase<8>, (const void*)k_phase<9>};
        for (int i = 0; i < 11; ++i) if (hipFuncSetAttribute(fns[i], hipFuncAttributeMaxDynamicSharedMemorySize, LDS_BYTES) != hipSuccess) { fprintf(stderr, "kernel_launch: hipFuncSetAttribute failed\n"); grid = -1; return; }
#else
        if (hipFuncSetAttribute((const void*)mk_fwd, hipFuncAttributeMaxDynamicSharedMemorySize, LDS_BYTES) != hipSuccess) { fprintf(stderr, "kernel_launch: hipFuncSetAttribute failed\n"); grid = -1; return; }
        hipOccupancyMaxActiveBlocksPerMultiprocessor(&per_cu, (const void*)mk_fwd, NTHR, LDS_BYTES);
        (void)hipGetLastError();
#endif
        (void)per_cu;
        grid = cus * 1;
    }
    if (grid < 0) return;
    P p{};
    const float** pp = (const float**)&p;
    for (int i = 0; i < 27; ++i) pp[i] = (const float*)d_in[i];
    p.out = (float*)d_out; p.ws = (unsigned char*)d_ws;
#if MK_MULTI
    p.ph_lo = 0; p.ph_hi = 0;
    if (PROBE_REP == -1) hipLaunchKernelGGL(k_phase<-1>, dim3(grid), dim3(NTHR), LDS_BYTES, stream, p);
    hipLaunchKernelGGL(k_phase<-1>, dim3(grid), dim3(NTHR), LDS_BYTES, stream, p);
    for (int l = 0; l < 2; ++l) {
        p.ph_lo = l;
        for (int rep = 0; rep < 1 + ((PROBE_REP == 0) || (PROBE_REP == 100 && (0 == 0 || 0 == 4 || 0 == 6 || 0 == 8))); ++rep) hipLaunchKernelGGL(k_phase<0>, dim3(grid), dim3(NTHR), LDS_BYTES, stream, p);
        for (int rep = 0; rep < 1 + ((PROBE_REP == 1) || (PROBE_REP == 100 && (1 == 0 || 1 == 4 || 1 == 6 || 1 == 8))); ++rep) hipLaunchKernelGGL(k_phase<1>, dim3(grid), dim3(NTHR), LDS_BYTES, stream, p);
        for (int rep = 0; rep < 1 + ((PROBE_REP == 2) || (PROBE_REP == 100 && (2 == 0 || 2 == 4 || 2 == 6 || 2 == 8))); ++rep) hipLaunchKernelGGL(k_phase<2>, dim3(grid), dim3(NTHR), LDS_BYTES, stream, p);
        for (int rep = 0; rep < 1 + ((PROBE_REP == 3) || (PROBE_REP == 100 && (3 == 0 || 3 == 4 || 3 == 6 || 3 == 8))); ++rep) hipLaunchKernelGGL(k_phase<3>, dim3(grid), dim3(NTHR), LDS_BYTES, stream, p);
        if (PROBE_REP == 11 || PROBE_REP == 12 || PROBE_REP == 13 || PROBE_REP == 14 || PROBE_REP == 31 || PROBE_REP == 32 || PROBE_REP == 21 || PROBE_REP == 22) {
            hipFuncSetAttribute((const void*)k_unit<PROBE_REP>, hipFuncAttributeMaxDynamicSharedMemorySize, LDS_BYTES);
            hipLaunchKernelGGL(k_unit<PROBE_REP>, dim3(grid), dim3(NTHR), LDS_BYTES, stream, p);
        }
        for (int rep = 0; rep < 1 + ((PROBE_REP == 4) || (PROBE_REP == 100 && (4 == 0 || 4 == 4 || 4 == 6 || 4 == 8))); ++rep) hipLaunchKernelGGL(k_phase<4>, dim3(grid), dim3(NTHR), LDS_BYTES, stream, p);
        for (int rep = 0; rep < 1 + ((PROBE_REP == 5) || (PROBE_REP == 100 && (5 == 0 || 5 == 4 || 5 == 6 || 5 == 8))); ++rep) hipLaunchKernelGGL(k_phase<5>, dim3(grid), dim3(NTHR), LDS_BYTES, stream, p);
        for (int rep = 0; rep < 1 + ((PROBE_REP == 6) || (PROBE_REP == 100 && (6 == 0 || 6 == 4 || 6 == 6 || 6 == 8))); ++rep) hipLaunchKernelGGL(k_phase<6>, dim3(grid), dim3(NTHR), LDS_BYTES, stream, p);
        for (int rep = 0; rep < 1 + ((PROBE_REP == 7) || (PROBE_REP == 100 && (7 == 0 || 7 == 4 || 7 == 6 || 7 == 8))); ++rep) hipLaunchKernelGGL(k_phase<7>, dim3(grid), dim3(NTHR), LDS_BYTES, stream, p);
        for (int rep = 0; rep < 1 + ((PROBE_REP == 8) || (PROBE_REP == 100 && (8 == 0 || 8 == 4 || 8 == 6 || 8 == 8))); ++rep) hipLaunchKernelGGL(k_phase<8>, dim3(grid), dim3(NTHR), LDS_BYTES, stream, p);
        for (int rep = 0; rep < 1 + ((PROBE_REP == 9) || (PROBE_REP == 100 && (9 == 0 || 9 == 4 || 9 == 6 || 9 == 8))); ++rep) hipLaunchKernelGGL(k_phase<9>, dim3(grid), dim3(NTHR), LDS_BYTES, stream, p);
    }
#else
    p.ph_lo = 0; p.ph_hi = NPHASE;
    if (hipMemsetAsync((char*)d_ws + WS_BAR, 0, 16384, stream) != hipSuccess) { fprintf(stderr, "kernel_launch: memset failed\n"); return; }
    void* args[] = {&p};
    hipError_t e = hipLaunchCooperativeKernel((const void*)mk_fwd, dim3(grid), dim3(NTHR), args, LDS_BYTES, stream);
    if (e != hipSuccess) fprintf(stderr, "cooperative launch failed: %s (grid %d)\n", hipGetErrorString(e), grid);
#endif
}
```

```cpp
#include <hip/hip_runtime.h>
#include <hip/hip_cooperative_groups.h>
#include <cstdio>
namespace cg = cooperative_groups;

#ifndef MK_MULTI
#define MK_MULTI 0
#endif
#ifndef PROBE_REP
#define PROBE_REP -99
#endif
#ifndef PROBE_SYNCS
#define PROBE_SYNCS 0
#endif

#define DEV __device__ __forceinline__
#define LAS __attribute__((address_space(3)))
typedef unsigned short bf16_t;
typedef short bf16x8 __attribute__((ext_vector_type(8)));
typedef float f32x4 __attribute__((ext_vector_type(4)));
typedef float f32x2 __attribute__((ext_vector_type(2)));
typedef unsigned u32x4 __attribute__((ext_vector_type(4)));
typedef unsigned u32x2 __attribute__((ext_vector_type(2)));

constexpr int D = 2048, NPR = 8192, NSM = 1024, NTOK = 9216, INP = 6912, IN_DIM = 6680, DFF = 5504, DFF2 = 11008;
constexpr int UQ = 0, UK = 1024, UV = 2048, UO = 3072, UZ = 4096, UXS = 5120, UIG = 6656, UFG = 6660, UDT = 6664;
constexpr int NTHR = 512;
constexpr int LDS_BYTES = 136 * 1024;
constexpr float ALPHA = 1.41421356237309515f;

constexpr size_t O_YP = 0;
constexpr size_t O_YS = O_YP + (size_t)4 * 2048 * 2048;
constexpr size_t O_PC = O_YS + (size_t)128 * 8 * 2048;
constexpr size_t O_PN = O_PC + (size_t)2 * 4 * 4 * 256 * 256;
constexpr size_t O_PM = O_PN + (size_t)2 * 4 * 4 * 256;
constexpr size_t O_PS = O_PM + (size_t)2 * 4 * 4;
constexpr size_t O_PSC = O_PS + (size_t)2 * 4 * 16 * 64 * 128;
constexpr size_t O_PFC = O_PSC + (size_t)2 * 4 * 3 * 1536;
constexpr size_t O_SC = O_PFC + (size_t)2 * 4 * 2 * DFF2;
constexpr size_t O_SN = O_SC + (size_t)2 * 128 * 4 * 256 * 256;
constexpr size_t O_SM = O_SN + (size_t)2 * 128 * 4 * 256;
constexpr size_t O_SS = O_SM + (size_t)2 * 128 * 4;
constexpr size_t O_SSC = O_SS + (size_t)2 * 128 * 16 * 64 * 128;
constexpr size_t O_SFC = O_SSC + (size_t)2 * 128 * 3 * 1536;

constexpr size_t WS_WIN = 0;
constexpr size_t WS_WOUT = WS_WIN + (size_t)2 * INP * D * 2;
constexpr size_t WS_WUP = WS_WOUT + (size_t)2 * D * D * 2;
constexpr size_t WS_WDN = WS_WUP + (size_t)2 * DFF2 * D * 2;
constexpr size_t WS_XB = WS_WDN + (size_t)2 * D * DFF * 2;
constexpr size_t WS_XF = WS_XB + (size_t)NTOK * D * 2;
constexpr size_t WS_XBC = WS_XF;
constexpr size_t WS_U = WS_XF + (size_t)NTOK * D * 4;
constexpr size_t WS_MIXIN = WS_U + (size_t)NTOK * INP * 2;
constexpr size_t WS_MIXF = WS_MIXIN + (size_t)NTOK * D * 2;
constexpr size_t WS_UP = WS_MIXF + (size_t)NTOK * D * 4;
constexpr size_t WS_ACT = WS_UP + (size_t)NTOK * DFF2 * 2;
constexpr size_t WS_PART = WS_ACT + (size_t)NTOK * DFF * 2;
constexpr size_t WS_SMALL = WS_PART + (size_t)8 * NSM * D * 4;
constexpr size_t WS_DBUF = WS_UP;
constexpr size_t WS_SBUF = WS_UP + (size_t)512 * 65536 * 4;
constexpr size_t WS_CT = WS_ACT;
constexpr size_t WS_ST = WS_ACT + (size_t)512 * 65536 * 2;
static_assert(WS_SBUF + (size_t)2048 * 8192 * 4 <= WS_ACT, "alias");
static_assert(WS_ST + (size_t)2048 * 8192 * 2 <= WS_PART, "alias");
constexpr size_t WS_NLOC = WS_SMALL;
constexpr size_t WS_NST = WS_NLOC + (size_t)512 * 256 * 4;
constexpr size_t WS_GSTAT = WS_NST + (size_t)512 * 256 * 4;
constexpr size_t WS_MST = WS_GSTAT + 4096;
constexpr size_t WS_SBSUM = WS_MST + 4096;
constexpr size_t WS_BAR = WS_SBSUM + 8192;
constexpr size_t WS_END = WS_BAR + 16384;

struct P {
    const float* x_prompt; const float* x_sample; const float* st_C; const float* st_n; const float* st_m; const float* st_ssm; const float* st_sconv; const float* st_fconv;
    const float* w_in; const float* b_i; const float* b_f; const float* m_norm_w; const float* s_conv_w; const float* s_conv_b; const float* dt_bias; const float* A_log; const float* D_skip;
    const float* s_norm_w; const float* w_out; const float* ln1_g; const float* ln1_b; const float* w_up; const float* f_conv_w; const float* f_conv_b; const float* w_down; const float* ln2_g; const float* ln2_b;
    float* out; unsigned char* ws; int ph_lo, ph_hi;
};

DEV float bf2f(bf16_t v) { return __uint_as_float(((unsigned)v) << 16); }
DEV bf16_t f2bf(float f) { unsigned u = __float_as_uint(f); u += 0x7FFFu + ((u >> 16) & 1u); return (bf16_t)(u >> 16); }
DEV unsigned pk2(float lo, float hi) { return (unsigned)f2bf(lo) | ((unsigned)f2bf(hi) << 16); }
DEV float bflo(unsigned w) { return __uint_as_float(w << 16); }
DEV float bfhi(unsigned w) { return __uint_as_float(w & 0xffff0000u); }
DEV float sigmoidf_(float x) { return __builtin_amdgcn_rcpf(1.0f + __expf(-x)); }
DEV float siluf_(float x) { return x * sigmoidf_(x); }
DEV float softplusf_(float x) { return fmaxf(x, 0.f) + log1pf(expf(-fabsf(x))); }
DEV float logsigf_(float x) { return fminf(x, 0.f) - log1pf(expf(-fabsf(x))); }
DEV float wave_sum(float v) {
#pragma unroll
    for (int o = 32; o >= 1; o >>= 1) v += __shfl_xor(v, o);
    return v; }
DEV float wave_max(float v) {
#pragma unroll
    for (int o = 32; o >= 1; o >>= 1) v = fmaxf(v, __shfl_xor(v, o));
    return v; }
DEV float wave_incl_sum(float v, int lane) {
#pragma unroll
    for (int o = 1; o < 64; o <<= 1) { float t = __shfl_up(v, o); if (lane >= o) v += t; }
    return v; }
DEV float wave_incl_max(float v, int lane) {
#pragma unroll
    for (int o = 1; o < 64; o <<= 1) { float t = __shfl_up(v, o); if (lane >= o) v = fmaxf(v, t); }
    return v; }
DEV f32x4 mfma16(bf16x8 a, bf16x8 b, f32x4 c) { return __builtin_amdgcn_mfma_f32_16x16x32_bf16(a, b, c, 0, 0, 0); }
DEV void unpack8(uint4 x, float (&f)[8]) { f[0] = bflo(x.x); f[1] = bfhi(x.x); f[2] = bflo(x.y); f[3] = bfhi(x.y); f[4] = bflo(x.z); f[5] = bfhi(x.z); f[6] = bflo(x.w); f[7] = bfhi(x.w); }

typedef short s16x4 __attribute__((ext_vector_type(4)));
DEV bf16x8 tr_frag(const bf16_t* T, int pitch, int krow0, int col0, int lane) {
    const int g = lane >> 4, q = (lane & 15) >> 2, pl = lane & 3;
    const bf16_t* a0 = T + (krow0 + 8 * g + q) * pitch + col0 + 4 * pl;
    const s16x4 lo = __builtin_amdgcn_ds_read_tr16_b64_v4i16((LAS s16x4*)a0);
    const s16x4 hi = __builtin_amdgcn_ds_read_tr16_b64_v4i16((LAS s16x4*)(a0 + 4 * pitch));
    return (bf16x8){lo[0], lo[1], lo[2], lo[3], hi[0], hi[1], hi[2], hi[3]};
}

namespace pg8 {
constexpr int BM = 256, BK = 64, HALF = 128, HTB = HALF * BK * 2, STAGE_BYTES = 8 * HTB, NXCD = 8, WGM = 8;
DEV int lds_byte(int r, int c) { const int st = (r >> 4) * 2 + (c >> 5), rr = r & 15, cc = c & 31, ob = rr * 64 + cc * 2; return st * 1024 + (ob ^ (((ob >> 9) & 1) << 5)); }
DEV void stage_rc(int b, int& R, int& C) { const int st = b / 1024, sb = b % 1024, swz = sb ^ (((sb >> 9) & 1) << 5); R = (st >> 1) * 16 + swz / 64; C = (st & 1) * 32 + (swz % 64) / 2; }
DEV int perm32(int rho) { const int n = rho >> 4, i = rho & 15; return 8 * (i >> 2) + 4 * n + (i & 3); }
struct Unit { int pm, pn, k0, nt, ks; };
struct Gemm { const bf16_t* A; const bf16_t* Bt; int M, N, K; };
struct StaticOrder {
    int nM, nN, nwg, G, c, ntk, ioff, imax;
    DEV void init(int M, int N, int K, int G_, int c_, int ioff_ = 0, int imax_ = 1 << 20) { nM = M / BM; nN = N / BM; nwg = nM * nN; G = G_; c = c_; ntk = K / BK; ioff = ioff_; imax = imax_; }
    DEV bool next(int i, Unit& u) const {
        u.pm = 0; u.pn = 0; u.k0 = 0; u.nt = 4; u.ks = -1;
        if (i + ioff >= imax) return false;
        const long L = (long)(i + ioff) * G + c; if (L >= nwg) return false;
        int wgid = (int)L; { const int q = nwg / NXCD, r = nwg % NXCD, xcd = wgid % NXCD, off = wgid / NXCD; wgid = (xcd < r ? xcd * (q + 1) : r * (q + 1) + (xcd - r) * q) + off; }
        const int nig = WGM * nN, gid = wgid / nig, fm = gid * WGM, gsz = (nM - fm) < WGM ? (nM - fm) : WGM;
        u.pm = fm + ((wgid % nig) % gsz); u.pn = (wgid % nig) / gsz; u.k0 = 0; u.nt = ntk; u.ks = -1; return true;
    }
};
struct TailSplitOrder {
    StaticOrder so; int c, ntk;
    DEV void init(int K, int c_) { so.init(NPR, D, K, 256, c_); c = c_; ntk = K / BK; }
    DEV bool next(int i, Unit& u) const {
        u.pm = 0; u.pn = 0; u.k0 = 0; u.nt = 4; u.ks = -1;
        if (i == 0) return so.next(0, u);
        if (i > 1) return false;
        const int tt = c >> 3, ks = c & 7; u.pm = 32 + (tt >> 3); u.pn = tt & 7; u.ks = ks;
        const int pairs = ntk >> 1, base = pairs >> 3, rem = pairs & 7;
        const int p0 = ks * base + (ks < rem ? ks : rem), np = base + (ks < rem ? 1 : 0);
        u.k0 = p0 * 128; u.nt = np * 2; return true;
    }
};
struct UpOrder {
    int c, ioff, imax;
    DEV void init(int c_, int ioff_, int imax_) { c = c_; ioff = ioff_; imax = imax_; }
    DEV bool next(int i, Unit& u) const {
        u.pm = 0; u.pn = 0; u.k0 = 0; u.nt = D / BK; u.ks = -1;
        const int r = i + ioff;
        if (r >= imax || r > 6 || (r == 6 && c >= 12)) return false;
        const int wgid = r < 6 ? ((r * 256 + c) % NXCD) * 192 + (r * 256 + c) / NXCD : 1536 + c;
        const int nN = DFF2 / BM, nig = WGM * nN, gid = wgid / nig, fm = gid * WGM, gsz = (36 - fm) < WGM ? (36 - fm) : WGM;
        u.pm = fm + ((wgid % nig) % gsz); u.pn = (wgid % nig) / gsz; return true;
    }
};
DEV unsigned cvt_pk_bf16(float lo, float hi) { unsigned r; asm volatile("v_cvt_pk_bf16_f32 %0, %1, %2" : "=v"(r) : "v"(lo), "v"(hi)); return r; }
struct EpiF32 {
    static constexpr bool PERM = false;
    float* C; int ldc; float* part;
    DEV void operator()(const f32x4 (&acc)[2][2][4][2], const Unit& u, int wr, int wc, int fr, int fq) const {
        const int row0 = u.pm * BM + wr * 64 + fr, col0 = u.pn * BM + wc * 32 + 4 * fq;
        float* Cb = u.ks < 0 ? C : part + (size_t)u.ks * NSM * D - (size_t)NPR * ldc;
#pragma unroll
        for (int ai = 0; ai < 2; ++ai)
#pragma unroll
            for (int m = 0; m < 4; ++m) { float* rowp = Cb + (size_t)(row0 + ai * HALF + m * 16) * ldc + col0;
#pragma unroll
                for (int bj = 0; bj < 2; ++bj)
#pragma unroll
                    for (int n = 0; n < 2; ++n) *(f32x4*)(rowp + bj * HALF + n * 16) = acc[ai][bj][m][n]; }
    }
};
struct EpiBf16 {
    static constexpr bool PERM = true;
    bf16_t* O; int ldc; float* part;
    DEV void operator()(const f32x4 (&acc)[2][2][4][2], const Unit& u, int wr, int wc, int fr, int fq) const {
        const int row0 = u.pm * BM + wr * 64 + fr; const int col0 = u.pn * BM + wc * 32 + 8 * fq;
        if (u.ks >= 0) {
            bf16_t* pb = (bf16_t*)part + (size_t)u.ks * NSM * ldc + (size_t)(row0 - NPR) * ldc + col0;
#pragma unroll
            for (int ai = 0; ai < 2; ++ai)
#pragma unroll
                for (int m = 0; m < 4; ++m)
#pragma unroll
                    for (int bj = 0; bj < 2; ++bj) { const f32x4 v0 = acc[ai][bj][m][0], v1 = acc[ai][bj][m][1];
                        u32x4 w; w.x = cvt_pk_bf16(v0[0], v0[1]); w.y = cvt_pk_bf16(v0[2], v0[3]); w.z = cvt_pk_bf16(v1[0], v1[1]); w.w = cvt_pk_bf16(v1[2], v1[3]);
                        *(u32x4*)(pb + (size_t)(ai * HALF + m * 16) * ldc + bj * HALF) = w; }
            return;
        }
#pragma unroll
        for (int ai = 0; ai < 2; ++ai)
#pragma unroll
            for (int m = 0; m < 4; ++m) { bf16_t* rowp = O + (size_t)(row0 + ai * HALF + m * 16) * ldc + col0;
#pragma unroll
                for (int bj = 0; bj < 2; ++bj) { const f32x4 v0 = acc[ai][bj][m][0], v1 = acc[ai][bj][m][1];
                    u32x4 w; w.x = cvt_pk_bf16(v0[0], v0[1]); w.y = cvt_pk_bf16(v0[2], v0[3]); w.z = cvt_pk_bf16(v1[0], v1[1]); w.w = cvt_pk_bf16(v1[2], v1[3]);
                    *(u32x4*)(rowp + bj * HALF) = w; } }
    }
};

template <class Epi, class Sched>
DEV void gemm_phase(LAS unsigned char* lds, const Gemm g, const Sched& S, const Epi& E) {
    int tid_ = threadIdx.x; asm volatile("" : "+v"(tid_)); const int tid = tid_, wid = __builtin_amdgcn_readfirstlane(tid >> 6), lane = tid & 63, wr = wid >> 2, wc = wid & 3, fr = lane & 15, fq = lane >> 4;
    const int K = g.K;
    unsigned voffA[2], voffB[2];
#pragma unroll
    for (int i = 0; i < 2; ++i) { int R, C; stage_rc(tid * 16 + i * 8192, R, C); const int Rb = Epi::PERM ? ((R & ~31) + perm32(R & 31)) : R;
        voffA[i] = (unsigned)(R * K + C) * 2u; voffB[i] = (unsigned)(Rb * K + C) * 2u; }
    const size_t kstep = (size_t)(BK * 2);
    const size_t hstep = (size_t)HALF * K * 2;
    const size_t tstep = 2 * hstep;
    const unsigned ldsw = (unsigned)wid * 1024u;
    const int aoff = lds_byte(wr * 64 + fr, fq * 8), boff = lds_byte(wc * 32 + fr, fq * 8);
#define PG8_SA(b, h) (((b) * 2 + (h)) * HTB)
#define PG8_SB(b, h) ((4 + (b) * 2 + (h)) * HTB)
#define PG8_STAGE(bufoff, gbase, voff) do { _Pragma("unroll") for (int _i = 0; _i < 2; ++_i) \
        __builtin_amdgcn_global_load_lds((const unsigned*)((const char*)(gbase) + (voff)[_i]), (LAS unsigned*)(lds + (bufoff) + ldsw + _i * 8192), 16, 0, 0); } while (0)
#define PG8_LDA(dst, b, h) do { _Pragma("unroll") for (int m = 0; m < 4; ++m) _Pragma("unroll") for (int k = 0; k < 2; ++k) dst[m][k] = *(const LAS bf16x8*)(lds + PG8_SA(b, h) + aoff + m * 2048 + k * 1024); } while (0)
#define PG8_LDB(dst, b, h) do { _Pragma("unroll") for (int n = 0; n < 2; ++n) _Pragma("unroll") for (int k = 0; k < 2; ++k) dst[n][k] = *(const LAS bf16x8*)(lds + PG8_SB(b, h) + boff + n * 2048 + k * 1024); } while (0)
#define PG8_MMA(ai, bj, At, Bt) do { __builtin_amdgcn_s_setprio(1); _Pragma("unroll") for (int m = 0; m < 4; ++m) _Pragma("unroll") for (int n = 0; n < 2; ++n) _Pragma("unroll") for (int k = 0; k < 2; ++k) \
        acc[ai][bj][m][n] = __builtin_amdgcn_mfma_f32_16x16x32_bf16(Bt[n][k], At[m][k], acc[ai][bj][m][n], 0, 0, 0); __builtin_amdgcn_s_setprio(0); } while (0)
#define PG8_WAIT_V(n) asm volatile("s_waitcnt vmcnt(" #n ")" ::: "memory")
#define PG8_WAIT_L(n) asm volatile("s_waitcnt lgkmcnt(" #n ")" ::: "memory")
#define PG8_BAR __builtin_amdgcn_s_barrier()
#define PG8_SCHED __builtin_amdgcn_sched_barrier(0)
    Unit cur, nxt; int ui = 0;
    if (!S.next(0, cur)) return;
    f32x4 acc[2][2][4][2];
#pragma unroll
    for (int a = 0; a < 2; ++a)
#pragma unroll
        for (int b = 0; b < 2; ++b)
#pragma unroll
            for (int m = 0; m < 4; ++m)
#pragma unroll
                for (int n = 0; n < 2; ++n) acc[a][b][m][n] = (f32x4){0.f, 0.f, 0.f, 0.f};
    bf16x8 At[4][2], B0[2][2], B1[2][2];
    const char* cA = (const char*)g.A + (size_t)cur.pm * tstep + (size_t)cur.k0 * 2; const char* cB = (const char*)g.Bt + (size_t)cur.pn * tstep + (size_t)cur.k0 * 2;
    PG8_STAGE(PG8_SB(0, 0), cB, voffB); PG8_STAGE(PG8_SA(0, 0), cA, voffA); PG8_STAGE(PG8_SB(0, 1), cB + hstep, voffB); PG8_STAGE(PG8_SA(0, 1), cA + hstep, voffA);
    if (wr == 1) PG8_BAR;
    PG8_WAIT_V(4); PG8_BAR;
    PG8_STAGE(PG8_SB(1, 0), cB + kstep, voffB); PG8_STAGE(PG8_SA(1, 0), cA + kstep, voffA); PG8_STAGE(PG8_SB(1, 1), cB + hstep + kstep, voffB);
    PG8_WAIT_V(6); PG8_BAR;
    for (;;) {
        const bool has_next = S.next(ui + 1, nxt);
        const char* nA = has_next ? (const char*)g.A + (size_t)nxt.pm * tstep + (size_t)nxt.k0 * 2 : cA; const char* nB = has_next ? (const char*)g.Bt + (size_t)nxt.pn * tstep + (size_t)nxt.k0 * 2 : cB;
        const int nt = cur.nt;
        for (int t = 0; t < nt; t += 2) {
            const bool last = (t == nt - 2);
            const char* a1 = cA + (size_t)(t + 1) * kstep;
            const char* a2 = last ? nA : cA + (size_t)(t + 2) * kstep; const char* b2 = last ? nB : cB + (size_t)(t + 2) * kstep;
            const char* a3 = a2 + kstep; const char* b3 = b2 + kstep;
            PG8_LDB(B0, 0, 0); PG8_SCHED; PG8_LDA(At, 0, 0); PG8_STAGE(PG8_SA(1, 1), a1 + hstep, voffA);
            PG8_WAIT_L(8); PG8_BAR; PG8_WAIT_L(0); PG8_MMA(0, 0, At, B0); PG8_BAR; PG8_SCHED;
            PG8_LDB(B1, 0, 1); PG8_STAGE(PG8_SB(0, 0), b2, voffB);
            PG8_BAR; PG8_WAIT_L(0); PG8_MMA(0, 1, At, B1); PG8_BAR;
            PG8_LDA(At, 0, 1); PG8_STAGE(PG8_SA(0, 0), a2, voffA);
            PG8_BAR; PG8_WAIT_L(0); PG8_MMA(1, 0, At, B0); PG8_BAR; PG8_SCHED;
            PG8_STAGE(PG8_SB(0, 1), b2 + hstep, voffB);
            PG8_WAIT_V(6); PG8_BAR; PG8_MMA(1, 1, At, B1); PG8_BAR;
            PG8_LDB(B0, 1, 0); PG8_SCHED; PG8_LDA(At, 1, 0); PG8_STAGE(PG8_SA(0, 1), a2 + hstep, voffA);
            PG8_WAIT_L(8); PG8_BAR; PG8_WAIT_L(0); PG8_MMA(0, 0, At, B0); PG8_BAR; PG8_SCHED;
            PG8_LDB(B1, 1, 1); PG8_STAGE(PG8_SB(1, 0), b3, voffB);
            PG8_BAR; PG8_WAIT_L(0); PG8_MMA(0, 1, At, B1); PG8_BAR;
            PG8_LDA(At, 1, 1); PG8_STAGE(PG8_SA(1, 0), a3, voffA);
            PG8_BAR; PG8_WAIT_L(0); PG8_MMA(1, 0, At, B0); PG8_BAR; PG8_SCHED;
            PG8_STAGE(PG8_SB(1, 1), b3 + hstep, voffB);
            PG8_WAIT_V(6); PG8_BAR; PG8_MMA(1, 1, At, B1); PG8_BAR;
        }
        E(acc, cur, wr, wc, fr, fq);
        if (!has_next) break;
#pragma unroll
        for (int a = 0; a < 2; ++a)
#pragma unroll
            for (int b = 0; b < 2; ++b)
#pragma unroll
                for (int m = 0; m < 4; ++m)
#pragma unroll
                    for (int n = 0; n < 2; ++n) acc[a][b][m][n] = (f32x4){0.f, 0.f, 0.f, 0.f};
        cur = nxt; cA = nA; cB = nB; ++ui;
    }
    PG8_WAIT_V(0);
    if (wr == 0) PG8_BAR;
    PG8_BAR;
#undef PG8_SA
#undef PG8_SB
#undef PG8_STAGE
#undef PG8_LDA
#undef PG8_LDB
#undef PG8_MMA
#undef PG8_WAIT_V
#undef PG8_WAIT_L
#undef PG8_BAR
#undef PG8_SCHED
}
}

DEV int win_srccol(int n) { return n < 4096 ? n : (n < 6656 ? n + 8 : (n < 6664 ? n - 2560 : (n < 6680 ? n : -1))); }
DEV void transpose_tile(const float* __restrict__ src, int srcN, bf16_t* __restrict__ dst, int K, int n0, int k0, int mode, float* tile) {
    int tid_ = threadIdx.x; asm volatile("" : "+v"(tid_)); const int tid = tid_;
    f32x4 v[4];
#pragma unroll
    for (int i = 0; i < 4; ++i) {
        const int kk = (tid >> 5) + 16 * i, nn4 = (tid & 31) * 4, n = n0 + nn4;
        const int sc = mode ? win_srccol(n) : n;
        v[i] = (f32x4){0.f, 0.f, 0.f, 0.f};
        if (sc >= 0) v[i] = __builtin_nontemporal_load((const f32x4*)(src + (size_t)(k0 + kk) * srcN + sc));
        if (mode && n >= 1024 && n < 2048) v[i] = v[i] * 0.0625f;
    }
#pragma unroll
    for (int i = 0; i < 4; ++i) {
        const int kk = (tid >> 5) + 16 * i, nn4 = (tid & 31) * 4;
        tile[kk * 129 + nn4 + 0] = v[i][0]; tile[kk * 129 + nn4 + 1] = v[i][1]; tile[kk * 129 + nn4 + 2] = v[i][2]; tile[kk * 129 + nn4 + 3] = v[i][3];
    }
    __syncthreads();
#pragma unroll
    for (int i = 0; i < 2; ++i) {
        const int ch = tid + 512 * i, nn = ch >> 3, kk8 = (ch & 7) * 8;
        u32x4 w;
        w.x = pk2(tile[(kk8 + 0) * 129 + nn], tile[(kk8 + 1) * 129 + nn]); w.y = pk2(tile[(kk8 + 2) * 129 + nn], tile[(kk8 + 3) * 129 + nn]);
        w.z = pk2(tile[(kk8 + 4) * 129 + nn], tile[(kk8 + 5) * 129 + nn]); w.w = pk2(tile[(kk8 + 6) * 129 + nn], tile[(kk8 + 7) * 129 + nn]);
        *(u32x4*)(dst + (size_t)(n0 + nn) * K + k0 + kk8) = w;
    }
    __syncthreads();
}
DEV void phase_prologue(const P& p, unsigned char* lds, int l_lo, int l_hi, bool with_x, int b0, int nb) {
    float* tile = (float*)lds;
    constexpr int T_WIN = (INP / 128) * (D / 64), T_WOUT = (D / 128) * (D / 64), T_WUP = (DFF2 / 128) * (D / 64), T_WDN = (D / 128) * (DFF / 64);
    constexpr int T_L = T_WIN + T_WOUT + T_WUP + T_WDN, T_X = NTOK * D / 4096;
    const int nw = (l_hi - l_lo) * T_L, total = nw + (with_x ? T_X : 0);
    for (int u = b0; u < total; u += nb) {
        if (u < nw) {
            const int l = l_lo + u / T_L; int r = u % T_L;
            if (r < T_WIN) { const int nt = r / (D / 64), kt = r % (D / 64);
                transpose_tile(p.w_in + (size_t)l * D * IN_DIM, IN_DIM, (bf16_t*)(p.ws + WS_WIN) + (size_t)l * INP * D, D, nt * 128, kt * 64, 1, tile); }
            else if ((r -= T_WIN) < T_WOUT) { const int nt = r / (D / 64), kt = r % (D / 64);
                transpose_tile(p.w_out + (size_t)l * D * D, D, (bf16_t*)(p.ws + WS_WOUT) + (size_t)l * D * D, D, nt * 128, kt * 64, 0, tile); }
            else if ((r -= T_WOUT) < T_WUP) { const int nt = r / (D / 64), kt = r % (D / 64);
                transpose_tile(p.w_up + (size_t)l * D * DFF2, DFF2, (bf16_t*)(p.ws + WS_WUP) + (size_t)l * DFF2 * D, D, nt * 128, kt * 64, 0, tile); }
            else { r -= T_WUP; const int nt = r / (DFF / 64), kt = r % (DFF / 64);
                transpose_tile(p.w_down + (size_t)l * DFF * D, D, (bf16_t*)(p.ws + WS_WDN) + (size_t)l * D * DFF, DFF, nt * 128, kt * 64, 0, tile); }
        } else {
            const size_t e = (size_t)(u - nw) * 4096 + threadIdx.x * 8;
            const float* s = e < (size_t)NPR * D ? p.x_prompt + e : p.x_sample + (e - (size_t)NPR * D);
            const f32x4 a = *(const f32x4*)s, b = *(const f32x4*)(s + 4);
            u32x4 w; w.x = pk2(a[0], a[1]); w.y = pk2(a[2], a[3]); w.z = pk2(b[0], b[1]); w.w = pk2(b[2], b[3]);
            *(u32x4*)((bf16_t*)(p.ws + WS_XB) + e) = w;
        }
    }
}

DEV void mlstm_local(const P& p, int l, int unit, unsigned char* lds) {
    const int bh = unit >> 5, c = unit & 31, b = bh >> 2, h = bh & 3;
    int tid_ = threadIdx.x; asm volatile("" : "+v"(tid_)); const int tid = tid_, lane = tid & 63, w = tid >> 6, fr = lane & 15, fq = lane >> 4;
    const bf16_t* U = (const bf16_t*)(p.ws + WS_U) + (size_t)(b * 2048 + c * 64) * INP;
    float* wsh = (float*)lds;
    bf16_t* KW = (bf16_t*)(lds + 1024);
    bf16_t* V = KW + 64 * 272;
    float* gstat = (float*)(p.ws + WS_GSTAT);
    if (w == 0) {
        const float ig = bf2f(U[(size_t)lane * INP + UIG + h]) + p.b_i[l * 4 + h];
        const float lf = logsigf_(bf2f(U[(size_t)lane * INP + UFG + h]) + p.b_f[l * 4 + h]);
        const float bs = wave_incl_sum(lf, lane);
        const float a = ig - bs;
        const float amax = wave_max(a);
        const float bsum = __shfl(bs, 63);
        wsh[lane] = expf(a - amax);
        if (lane == 0) { gstat[(bh * 32 + c) * 2] = bsum; gstat[(bh * 32 + c) * 2 + 1] = bsum + amax; }
    }
    __syncthreads();
#pragma unroll
    for (int i = 0; i < 4; ++i) {
        const int it = tid + 512 * i, s_ = it >> 5, d8 = (it & 31) * 8;
        const uint4 kv = *(const uint4*)(U + (size_t)s_ * INP + UK + h * 256 + d8);
        const uint4 vv = *(const uint4*)(U + (size_t)s_ * INP + UV + h * 256 + d8);
        const float ws_ = wsh[s_];
        float kf[8]; unpack8(kv, kf);
        u32x4 kw; kw.x = pk2(kf[0] * ws_, kf[1] * ws_); kw.y = pk2(kf[2] * ws_, kf[3] * ws_); kw.z = pk2(kf[4] * ws_, kf[5] * ws_); kw.w = pk2(kf[6] * ws_, kf[7] * ws_);
        *(u32x4*)(KW + s_ * 272 + d8) = kw;
        *(uint4*)(V + s_ * 272 + d8) = vv;
    }
    __syncthreads();
    if (tid < 256) { float a = 0.f; for (int s_ = 0; s_ < 64; ++s_) a += bf2f(KW[s_ * 272 + tid]); ((float*)(p.ws + WS_NLOC))[(size_t)(bh * 32 + c) * 256 + tid] = a; }
    f32x4 acc[2][16];
#pragma unroll
    for (int m = 0; m < 2; ++m)
#pragma unroll
        for (int n = 0; n < 16; ++n) acc[m][n] = (f32x4){0.f, 0.f, 0.f, 0.f};
#pragma unroll
    for (int ks = 0; ks < 2; ++ks) {
        bf16x8 vf[2];
#pragma unroll
        for (int m = 0; m < 2; ++m) vf[m] = tr_frag(V, 272, 32 * ks, 32 * w + 16 * m, lane);
#pragma unroll
        for (int n = 0; n < 16; ++n) {
            const bf16x8 kf = tr_frag(KW, 272, 32 * ks, 16 * n, lane);
#pragma unroll
            for (int m = 0; m < 2; ++m) acc[m][n] = mfma16(kf, vf[m], acc[m][n]);
        }
    }
    bf16_t* Dp = (bf16_t*)(p.ws + WS_DBUF) + (size_t)(bh * 32 + c) * 65536;
#pragma unroll
    for (int m = 0; m < 2; ++m)
#pragma unroll
        for (int n = 0; n < 16; ++n) { u32x2 wv; wv.x = pk2(acc[m][n][0], acc[m][n][1]); wv.y = pk2(acc[m][n][2], acc[m][n][3]);
            *(u32x2*)(Dp + (32 * w + 16 * m + fr) * 256 + 16 * n + fq * 4) = wv; }
    __syncthreads();
}

DEV void mlstm_scan(const P& p, int l, int unit, unsigned char* lds) {
    int tid_ = threadIdx.x; asm volatile("" : "+v"(tid_)); const int bh = unit >> 4, slab = unit & 15, tid = tid_;
    float* fA = (float*)lds; float* fB = fA + 32;
    const float* gstat = (const float*)(p.ws + WS_GSTAT);
    if (tid == 0) {
        float m = 0.f;
        for (int c = 0; c < 32; ++c) {
            const float bsum = gstat[(bh * 32 + c) * 2], mloc = gstat[(bh * 32 + c) * 2 + 1];
            const float mn = fmaxf(bsum + m, mloc);
            fA[c] = expf(bsum + m - mn); fB[c] = expf(mloc - mn); m = mn;
            if (slab == 0) ((float*)(p.ws + WS_MST))[bh * 32 + c] = mn;
        }
        if (slab == 0) p.out[O_PM + l * 16 + bh] = m;
    }
    __syncthreads();
    const size_t e0 = (size_t)slab * 4096 + tid * 8;
    float run[8];
#pragma unroll
    for (int i = 0; i < 8; ++i) run[i] = 0.f;
    const bf16_t* Dp = (const bf16_t*)(p.ws + WS_DBUF) + (size_t)bh * 32 * 65536 + e0;
    bf16_t* Cp = (bf16_t*)(p.ws + WS_CT) + (size_t)bh * 32 * 65536 + e0;
#pragma unroll 1
    for (int cb = 0; cb < 32; cb += 8) {
        uint4 xx[8];
#pragma unroll
        for (int j = 0; j < 8; ++j) xx[j] = *(const uint4*)(Dp + (size_t)(cb + j) * 65536);
#pragma unroll
        for (int j = 0; j < 8; ++j) {
            const int c = cb + j;
            const float a = fA[c], bq = fB[c];
            float xf[8]; unpack8(xx[j], xf);
#pragma unroll
            for (int i = 0; i < 8; ++i) run[i] = a * run[i] + bq * xf[i];
            u32x4 wv; wv.x = pk2(run[0], run[1]); wv.y = pk2(run[2], run[3]); wv.z = pk2(run[4], run[5]); wv.w = pk2(run[6], run[7]);
            *(u32x4*)(Cp + (size_t)c * 65536) = wv;
        }
    }
    {
        float* o = p.out + O_PC + (size_t)(l * 16 + bh) * 65536;
        const int e = (int)(e0 >> 8), d0 = (int)(e0 & 255);
#pragma unroll
        for (int i = 0; i < 8; ++i) o[(d0 + i) * 256 + e] = run[i];
    }
    if (slab == 0 && tid < 256) {
        float r = 0.f;
        const float* nl = (const float*)(p.ws + WS_NLOC) + (size_t)bh * 32 * 256 + tid;
        float* ns = (float*)(p.ws + WS_NST) + (size_t)bh * 32 * 256 + tid;
        for (int c = 0; c < 32; ++c) { r = fA[c] * r + fB[c] * nl[c * 256]; ns[c * 256] = r; }
        p.out[O_PN + (size_t)(l * 16 + bh) * 256 + tid] = r;
    }
    __syncthreads();
}

DEV void ssd_scan(const P& p, int l, int unit, unsigned char* lds) {
    int tid_ = threadIdx.x; asm volatile("" : "+v"(tid_)); const int bhd = unit >> 2, slab = unit & 3, tid = tid_;
    float* dec = (float*)lds;
    if (tid < 32) dec[tid] = expf(((const float*)(p.ws + WS_SBSUM))[bhd * 32 + tid]);
    __syncthreads();
    const size_t e0 = (size_t)slab * 2048 + tid * 4;
    f32x4 run = (f32x4){0.f, 0.f, 0.f, 0.f};
    const bf16_t* Sp = (const bf16_t*)(p.ws + WS_SBUF) + (size_t)bhd * 32 * 8192 + e0;
    bf16_t* Tp = (bf16_t*)(p.ws + WS_ST) + (size_t)bhd * 32 * 8192 + e0;
#pragma unroll 1
    for (int cb = 0; cb < 32; cb += 8) {
        uint2 xx[8];
#pragma unroll
        for (int j = 0; j < 8; ++j) xx[j] = *(const uint2*)(Sp + (size_t)(cb + j) * 8192);
#pragma unroll
        for (int j = 0; j < 8; ++j) {
            run = run * dec[cb + j] + (f32x4){bflo(xx[j].x), bfhi(xx[j].x), bflo(xx[j].y), bfhi(xx[j].y)};
            u32x2 wv; wv.x = pk2(run[0], run[1]); wv.y = pk2(run[2], run[3]);
            *(u32x2*)(Tp + (size_t)(cb + j) * 8192) = wv;
        }
    }
    *(f32x4*)(p.out + O_PS + (size_t)(l * 64 + bhd) * 8192 + e0) = run;
    __syncthreads();
}

DEV void convstate_copy(const P& p, int l, int unit) {
    const bf16_t* Ub = (const bf16_t*)(p.ws + WS_U);
    int tid_ = threadIdx.x; asm volatile("" : "+v"(tid_));
    for (int i = tid_; i < 3 * 1536; i += NTHR) {
        const int j = i / 1536, ch = i % 1536;
        if (unit < 4) p.out[O_PSC + ((size_t)(l * 4 + unit) * 3 + j) * 1536 + ch] = bf2f(Ub[(size_t)(unit * 2048 + 2045 + j) * INP + UXS + ch]);
        else { const int b = unit - 4; p.out[O_SSC + ((size_t)(l * 128 + b) * 3 + j) * 1536 + ch] = bf2f(Ub[(size_t)(NPR + b * 8 + 5 + j) * INP + UXS + ch]); }
    }
}

DEV void mlstm_out(const P& p, int l, int unit, unsigned char* lds) {
    const int bh = unit >> 5, c = unit & 31, b = bh >> 2, h = bh & 3;
    int tid_ = threadIdx.x; asm volatile("" : "+v"(tid_)); const int tid = tid_, lane = tid & 63, w = tid >> 6, fr = lane & 15, fq = lane >> 4;
    const int r0 = b * 2048 + c * 64;
    const bf16_t* U = (const bf16_t*)(p.ws + WS_U) + (size_t)r0 * INP;
    bf16_t* Qs = (bf16_t*)lds;
    bf16_t* Ks = Qs + 64 * 264;
    bf16_t* V = Ks + 64 * 264;
    bf16_t* Ss = V + 64 * 272;
    float* fl = (float*)(lds + 113664);
    float* bsh = fl; float* ash = fl + 64; float* mth = fl + 128; float* wint = fl + 192; float* rdn = fl + 256; float* qn = fl + 320; float* nprev = fl + 384; float* red = fl + 640;
    float* stat = fl + 1152;
    if (w == 0) {
        const float ig = bf2f(U[(size_t)lane * INP + UIG + h]) + p.b_i[l * 4 + h];
        const float lf = logsigf_(bf2f(U[(size_t)lane * INP + UFG + h]) + p.b_f[l * 4 + h]);
        const float bs = wave_incl_sum(lf, lane);
        const float a = ig - bs;
        const float cm = wave_incl_max(a, lane);
        const float mprev = c > 0 ? ((const float*)(p.ws + WS_MST))[bh * 32 + c - 1] : 0.f;
        const float mt = bs + fmaxf(mprev, cm);
        bsh[lane] = bs; ash[lane] = a; mth[lane] = mt; wint[lane] = expf(bs + mprev - mt);
    }
    if (tid >= 256) { const int d = tid - 256; nprev[d] = c > 0 ? ((const float*)(p.ws + WS_NST))[(size_t)(bh * 32 + c - 1) * 256 + d] : 0.f; }
#pragma unroll
    for (int i = 0; i < 4; ++i) {
        const int it = tid + 512 * i, s_ = it >> 5, d8 = (it & 31) * 8;
        *(uint4*)(Qs + s_ * 264 + d8) = *(const uint4*)(U + (size_t)s_ * INP + UQ + h * 256 + d8);
        *(uint4*)(Ks + s_ * 264 + d8) = *(const uint4*)(U + (size_t)s_ * INP + UK + h * 256 + d8);
        *(uint4*)(V + s_ * 272 + d8) = *(const uint4*)(U + (size_t)s_ * INP + UV + h * 256 + d8);
    }
    __syncthreads();
    {
        const int mt_ = w >> 1, nt0 = (w & 1) * 2;
        f32x4 sacc[2] = {(f32x4){0.f, 0.f, 0.f, 0.f}, (f32x4){0.f, 0.f, 0.f, 0.f}};
#pragma unroll
        for (int k0 = 0; k0 < 256; k0 += 32) {
            const bf16x8 a = *(const bf16x8*)(Qs + (16 * mt_ + fr) * 264 + k0 + fq * 8);
#pragma unroll
            for (int n = 0; n < 2; ++n) { const bf16x8 bb = *(const bf16x8*)(Ks + (16 * (nt0 + n) + fr) * 264 + k0 + fq * 8); sacc[n] = mfma16(a, bb, sacc[n]); }
        }
#pragma unroll
        for (int n = 0; n < 2; ++n)
#pragma unroll
            for (int j = 0; j < 4; ++j) {
                const int t = 16 * mt_ + fq * 4 + j, s_ = 16 * (nt0 + n) + fr;
                const float val = (s_ <= t) ? sacc[n][j] * expf(bsh[t] - mth[t] + ash[s_]) : 0.f;
                Ss[t * 72 + s_] = f2bf(val);
            }
        const int t = tid >> 3, part = tid & 7;
        float a = 0.f;
        for (int d = part * 32; d < part * 32 + 32; ++d) a += bf2f(Qs[t * 264 + d]) * nprev[d];
        a += __shfl_xor(a, 1); a += __shfl_xor(a, 2); a += __shfl_xor(a, 4);
        if (part == 0) qn[t] = a;
    }
    __syncthreads();
    if (tid < 64) {
        float di = 0.f;
        for (int s_ = 0; s_ < 64; ++s_) di += bf2f(Ss[tid * 72 + s_]);
        const float den = di + wint[tid] * qn[tid];
        rdn[tid] = 1.0f / fmaxf(fabsf(den), expf(-mth[tid]));
    }
    const int e0 = 32 * w;
    f32x4 acc1[4][2], acc2[4][2];
#pragma unroll
    for (int m = 0; m < 4; ++m)
#pragma unroll
        for (int n = 0; n < 2; ++n) { acc1[m][n] = (f32x4){0.f, 0.f, 0.f, 0.f}; acc2[m][n] = (f32x4){0.f, 0.f, 0.f, 0.f}; }
#pragma unroll
    for (int ks = 0; ks < 2; ++ks) {
        bf16x8 sf[4];
#pragma unroll
        for (int m = 0; m < 4; ++m) sf[m] = *(const bf16x8*)(Ss + (16 * m + fr) * 72 + 32 * ks + fq * 8);
#pragma unroll
        for (int n = 0; n < 2; ++n) { const bf16x8 vf = tr_frag(V, 272, 32 * ks, e0 + 16 * n, lane);
#pragma unroll
            for (int m = 0; m < 4; ++m) acc1[m][n] = mfma16(vf, sf[m], acc1[m][n]); }
    }
    if (c > 0) {
        const bf16_t* CTp = (const bf16_t*)(p.ws + WS_CT) + (size_t)(bh * 32 + c - 1) * 65536;
#pragma unroll 2
        for (int k0 = 0; k0 < 256; k0 += 32) {
            bf16x8 a[4];
#pragma unroll
            for (int m = 0; m < 4; ++m) a[m] = *(const bf16x8*)(Qs + (16 * m + fr) * 264 + k0 + fq * 8);
#pragma unroll
            for (int n = 0; n < 2; ++n) { const bf16x8 cf = *(const bf16x8*)(CTp + (size_t)(e0 + 16 * n + fr) * 256 + k0 + fq * 8);
#pragma unroll
                for (int m = 0; m < 4; ++m) acc2[m][n] = mfma16(cf, a[m], acc2[m][n]); }
        }
    }
    __syncthreads();
#pragma unroll
    for (int m = 0; m < 4; ++m) {
        const int t = 16 * m + fr;
        const float wi = wint[t], rd = rdn[t];
        float sm = 0.f;
#pragma unroll
        for (int n = 0; n < 2; ++n)
#pragma unroll
            for (int j = 0; j < 4; ++j) { const float hv = (acc1[m][n][j] + wi * acc2[m][n][j]) * rd; acc1[m][n][j] = hv; sm += hv; }
        sm += __shfl_xor(sm, 16); sm += __shfl_xor(sm, 32);
        if (fq == 0) red[t * 8 + w] = sm;
    }
    __syncthreads();
    if (tid < 64) { float sm = 0.f;
#pragma unroll
        for (int i = 0; i < 8; ++i) sm += red[tid * 8 + i];
        stat[tid] = sm * (1.0f / 256.0f); }
    __syncthreads();
#pragma unroll
    for (int m = 0; m < 4; ++m) {
        const int t = 16 * m + fr;
        const float mu = stat[t];
        float sm = 0.f;
#pragma unroll
        for (int n = 0; n < 2; ++n)
#pragma unroll
            for (int j = 0; j < 4; ++j) { const float dv = acc1[m][n][j] - mu; acc1[m][n][j] = dv; sm += dv * dv; }
        sm += __shfl_xor(sm, 16); sm += __shfl_xor(sm, 32);
        if (fq == 0) red[t * 8 + w] = sm;
    }
    __syncthreads();
    if (tid < 64) { float sm = 0.f;
#pragma unroll
        for (int i = 0; i < 8; ++i) sm += red[tid * 8 + i];
        stat[64 + tid] = rsqrtf(sm * (1.0f / 256.0f) + 1e-6f); }
    __syncthreads();
    bf16_t* MX = (bf16_t*)(p.ws + WS_MIXIN);
#pragma unroll
    for (int m = 0; m < 4; ++m) {
        const int t = 16 * m + fr;
        const float rs = stat[64 + t];
#pragma unroll
        for (int n = 0; n < 2; ++n) {
            const int e4 = e0 + 16 * n + fq * 4;
            const uint2 ov = *(const uint2*)(U + (size_t)t * INP + UO + h * 256 + e4);
            const f32x4 nw = *(const f32x4*)(p.m_norm_w + l * 1024 + h * 256 + e4);
            u32x2 wv;
            wv.x = pk2(acc1[m][n][0] * rs * nw[0] * sigmoidf_(bflo(ov.x)), acc1[m][n][1] * rs * nw[1] * sigmoidf_(bfhi(ov.x)));
            wv.y = pk2(acc1[m][n][2] * rs * nw[2] * sigmoidf_(bflo(ov.y)), acc1[m][n][3] * rs * nw[3] * sigmoidf_(bfhi(ov.y)));
            *(u32x2*)(MX + (size_t)(r0 + t) * D + h * 256 + e4) = wv;
        }
    }
    __syncthreads();
}

DEV void ssd_conv8(const bf16_t* Urow, int tpos, const float* cw, const float* cb, int ch8, float (&o)[8]) {
    const f32x4 b0 = *(const f32x4*)(cb + ch8), b1 = *(const f32x4*)(cb + ch8 + 4);
    o[0] = b0[0]; o[1] = b0[1]; o[2] = b0[2]; o[3] = b0[3]; o[4] = b1[0]; o[5] = b1[1]; o[6] = b1[2]; o[7] = b1[3];
#pragma unroll
    for (int j = 0; j < 4; ++j) {
        const int back = 3 - j;
        if (tpos - back >= 0) {
            const uint4 x = *(const uint4*)(Urow - (size_t)back * INP + UXS + ch8);
            float xf[8]; unpack8(x, xf);
            const f32x4 w0 = *(const f32x4*)(cw + j * 1536 + ch8), w1 = *(const f32x4*)(cw + j * 1536 + ch8 + 4);
            o[0] += w0[0] * xf[0]; o[1] += w0[1] * xf[1]; o[2] += w0[2] * xf[2]; o[3] += w0[3] * xf[3];
            o[4] += w1[0] * xf[4]; o[5] += w1[1] * xf[5]; o[6] += w1[2] * xf[6]; o[7] += w1[3] * xf[7];
        }
    }
#pragma unroll
    for (int i = 0; i < 8; ++i) o[i] = siluf_(o[i]);
}

DEV void ssd_local(const P& p, int l, int unit, unsigned char* lds) {
    const int b = unit >> 6, g = (unit >> 5) & 1, c = unit & 31;
    int tid_ = threadIdx.x; asm volatile("" : "+v"(tid_)); const int tid = tid_, lane = tid & 63, w = tid >> 6, fr = lane & 15, fq = lane >> 4;
    const int r0 = b * 2048 + c * 64;
    const bf16_t* U = (const bf16_t*)(p.ws + WS_U) + (size_t)r0 * INP;
    bf16_t* XW = (bf16_t*)lds;
    bf16_t* Bmn = XW + 64 * 528;
    float* wsh = (float*)(lds + 86016);
    {
        const int head = g * 8 + w;
        const float dt = softplusf_(bf2f(U[(size_t)lane * INP + UDT + head]) + p.dt_bias[l * 16 + head]);
        const float a = -expf(p.A_log[l * 16 + head]) * dt;
        const float bs = wave_incl_sum(a, lane);
        const float bL = __shfl(bs, 63);
        wsh[w * 64 + lane] = expf(bL - bs) * dt;
        if (lane == 0) ((float*)(p.ws + WS_SBSUM))[(b * 16 + head) * 32 + c] = bL;
    }
    __syncthreads();
    const float* cw = p.s_conv_w + (size_t)l * 4 * 1536; const float* cb = p.s_conv_b + (size_t)l * 1536;
    bf16_t* XBC = (bf16_t*)(p.ws + WS_XBC) + (size_t)r0 * 1536;
    for (int i = 0; i < 12; ++i) {
        const int it = tid + 512 * i, t = it / 96, gidx = it % 96;
        const int ch8 = gidx < 64 ? g * 512 + gidx * 8 : (gidx < 80 ? 1024 + g * 128 + (gidx - 64) * 8 : 1280 + g * 128 + (gidx - 80) * 8);
        float v[8];
        ssd_conv8(U + (size_t)t * INP, c * 64 + t, cw, cb, ch8, v);
        { u32x4 wr_; wr_.x = pk2(v[0], v[1]); wr_.y = pk2(v[2], v[3]); wr_.z = pk2(v[4], v[5]); wr_.w = pk2(v[6], v[7]); *(u32x4*)(XBC + (size_t)t * 1536 + ch8) = wr_; }
        if (gidx >= 80) continue;
        if (gidx < 64) { const float sc = wsh[(gidx >> 3) * 64 + t];
            u32x4 wv; wv.x = pk2(v[0] * sc, v[1] * sc); wv.y = pk2(v[2] * sc, v[3] * sc); wv.z = pk2(v[4] * sc, v[5] * sc); wv.w = pk2(v[6] * sc, v[7] * sc);
            *(u32x4*)(XW + t * 528 + gidx * 8) = wv; }
        else { u32x4 wv; wv.x = pk2(v[0], v[1]); wv.y = pk2(v[2], v[3]); wv.z = pk2(v[4], v[5]); wv.w = pk2(v[6], v[7]);
            *(u32x4*)(Bmn + t * 144 + (gidx - 64) * 8) = wv; }
    }
    __syncthreads();
    f32x4 acc[4][8];
#pragma unroll
    for (int m = 0; m < 4; ++m)
#pragma unroll
        for (int n = 0; n < 8; ++n) acc[m][n] = (f32x4){0.f, 0.f, 0.f, 0.f};
#pragma unroll
    for (int ks = 0; ks < 2; ++ks) {
        bf16x8 xf[4];
#pragma unroll
        for (int m = 0; m < 4; ++m) xf[m] = tr_frag(XW, 528, 32 * ks, 64 * w + 16 * m, lane);
#pragma unroll
        for (int n = 0; n < 8; ++n) { const bf16x8 bf_ = tr_frag(Bmn, 144, 32 * ks, 16 * n, lane);
#pragma unroll
            for (int m = 0; m < 4; ++m) acc[m][n] = mfma16(bf_, xf[m], acc[m][n]); }
    }
    bf16_t* Sp = (bf16_t*)(p.ws + WS_SBUF) + (size_t)((b * 16 + g * 8 + w) * 32 + c) * 8192;
#pragma unroll
    for (int m = 0; m < 4; ++m)
#pragma unroll
        for (int n = 0; n < 8; ++n) { u32x2 wv; wv.x = pk2(acc[m][n][0], acc[m][n][1]); wv.y = pk2(acc[m][n][2], acc[m][n][3]); *(u32x2*)(Sp + (16 * m + fr) * 128 + 16 * n + fq * 4) = wv; }
    __syncthreads();
}

DEV void ssd_out(const P& p, int l, int unit, unsigned char* lds) {
    const int b = unit >> 6, g = (unit >> 5) & 1, c = unit & 31;
    int tid_ = threadIdx.x; asm volatile("" : "+v"(tid_)); const int tid = tid_, lane = tid & 63, w = tid >> 6, fr = lane & 15, fq = lane >> 4;
    const int r0 = b * 2048 + c * 64;
    const bf16_t* U = (const bf16_t*)(p.ws + WS_U) + (size_t)r0 * INP;
    bf16_t* Xs = (bf16_t*)lds;
    bf16_t* Bm = Xs + 64 * 528;
    bf16_t* Cm = Bm + 64 * 136;
    float* CB = (float*)(lds + 102400);
    float* bsh = (float*)(lds + 119808);
    float* dtsh = bsh + 512;
    float* red = dtsh + 512;
    float* stat = red + 512;
    const int head = g * 8 + w;
    {
        const float dt = softplusf_(bf2f(U[(size_t)lane * INP + UDT + head]) + p.dt_bias[l * 16 + head]);
        const float a = -expf(p.A_log[l * 16 + head]) * dt;
        const float bs = wave_incl_sum(a, lane);
        bsh[w * 64 + lane] = bs; dtsh[w * 64 + lane] = dt;
    }
    const bf16_t* XBC = (const bf16_t*)(p.ws + WS_XBC) + (size_t)r0 * 1536;
#pragma unroll
    for (int i = 0; i < 12; ++i) {
        const int it = tid + 512 * i, t = it / 96, gidx = it % 96;
        const int ch8 = gidx < 64 ? g * 512 + gidx * 8 : (gidx < 80 ? 1024 + g * 128 + (gidx - 64) * 8 : 1280 + g * 128 + (gidx - 80) * 8);
        const u32x4 wv = *(const u32x4*)(XBC + (size_t)t * 1536 + ch8);
        if (gidx < 64) *(u32x4*)(Xs + t * 528 + gidx * 8) = wv;
        else if (gidx < 80) *(u32x4*)(Bm + t * 136 + (gidx - 64) * 8) = wv;
        else *(u32x4*)(Cm + t * 136 + (gidx - 80) * 8) = wv;
    }
    __syncthreads();
    {
        const int mt_ = w >> 1, nt0 = (w & 1) * 2;
        f32x4 cacc[2] = {(f32x4){0.f, 0.f, 0.f, 0.f}, (f32x4){0.f, 0.f, 0.f, 0.f}};
#pragma unroll
        for (int k0 = 0; k0 < 128; k0 += 32) {
            const bf16x8 a = *(const bf16x8*)(Cm + (16 * mt_ + fr) * 136 + k0 + fq * 8);
#pragma unroll
            for (int n = 0; n < 2; ++n) { const bf16x8 bb = *(const bf16x8*)(Bm + (16 * (nt0 + n) + fr) * 136 + k0 + fq * 8); cacc[n] = mfma16(a, bb, cacc[n]); }
        }
#pragma unroll
        for (int n = 0; n < 2; ++n)
#pragma unroll
            for (int j = 0; j < 4; ++j) CB[(16 * mt_ + fq * 4 + j) * 68 + 16 * (nt0 + n) + fr] = cacc[n][j];
    }
    __syncthreads();
    f32x4 acc1[4][4], acc2[4][4];
#pragma unroll
    for (int m = 0; m < 4; ++m)
#pragma unroll
        for (int n = 0; n < 4; ++n) { acc1[m][n] = (f32x4){0.f, 0.f, 0.f, 0.f}; acc2[m][n] = (f32x4){0.f, 0.f, 0.f, 0.f}; }
#pragma unroll
    for (int ks = 0; ks < 2; ++ks) {
        bf16x8 xf[4];
#pragma unroll
        for (int n = 0; n < 4; ++n) xf[n] = tr_frag(Xs, 528, 32 * ks, 64 * w + 16 * n, lane);
#pragma unroll
        for (int m = 0; m < 4; ++m) {
            if (ks * 32 > 16 * m + 15) continue;
            const int t = 16 * m + fr, s0 = 32 * ks + fq * 8;
            const float bt = bsh[w * 64 + t];
            const f32x4 c0 = *(const f32x4*)(CB + t * 68 + s0), c1 = *(const f32x4*)(CB + t * 68 + s0 + 4);
            float mv[8];
#pragma unroll
            for (int i = 0; i < 8; ++i) { const int s_ = s0 + i; const float cv = i < 4 ? c0[i & 3] : c1[i & 3];
                mv[i] = (s_ <= t) ? cv * expf(bt - bsh[w * 64 + s_]) * dtsh[w * 64 + s_] : 0.f; }
            union { u32x4 u; bf16x8 v; } af;
            af.u.x = pk2(mv[0], mv[1]); af.u.y = pk2(mv[2], mv[3]); af.u.z = pk2(mv[4], mv[5]); af.u.w = pk2(mv[6], mv[7]);
#pragma unroll
            for (int n = 0; n < 4; ++n) acc1[m][n] = mfma16(xf[n], af.v, acc1[m][n]);
        }
    }
    if (c > 0) {
        const bf16_t* STp = (const bf16_t*)(p.ws + WS_ST) + (size_t)((b * 16 + head) * 32 + c - 1) * 8192;
#pragma unroll
        for (int k0 = 0; k0 < 128; k0 += 32) {
            bf16x8 a[4];
#pragma unroll
            for (int m = 0; m < 4; ++m) a[m] = *(const bf16x8*)(Cm + (16 * m + fr) * 136 + k0 + fq * 8);
#pragma unroll
            for (int n = 0; n < 4; ++n) { const bf16x8 sf = *(const bf16x8*)(STp + (16 * n + fr) * 128 + k0 + fq * 8);
#pragma unroll
                for (int m = 0; m < 4; ++m) acc2[m][n] = mfma16(sf, a[m], acc2[m][n]); }
        }
    }
    const float dsk = p.D_skip[l * 16 + head];
#pragma unroll
    for (int m = 0; m < 4; ++m) {
        const int t = 16 * m + fr;
        const float eb = expf(bsh[w * 64 + t]);
        float sm = 0.f;
#pragma unroll
        for (int n = 0; n < 4; ++n) {
            const int pp4 = 16 * n + fq * 4;
            const uint2 xv = *(const uint2*)(Xs + t * 528 + 64 * w + pp4);
            const uint2 zv = *(const uint2*)(U + (size_t)t * INP + UZ + g * 512 + w * 64 + pp4);
            const float xs4[4] = {bflo(xv.x), bfhi(xv.x), bflo(xv.y), bfhi(xv.y)};
            const float z4[4] = {bflo(zv.x), bfhi(zv.x), bflo(zv.y), bfhi(zv.y)};
#pragma unroll
            for (int j = 0; j < 4; ++j) {
                const float y = acc1[m][n][j] + eb * acc2[m][n][j] + dsk * xs4[j];
                const float gt = y * z4[j] * sigmoidf_(z4[j]);
                acc1[m][n][j] = gt; sm += gt * gt;
            }
        }
        sm += __shfl_xor(sm, 16); sm += __shfl_xor(sm, 32);
        if (fq == 0) red[t * 8 + w] = sm;
    }
    __syncthreads();
    if (tid < 64) { float sm = 0.f;
#pragma unroll
        for (int i = 0; i < 8; ++i) sm += red[tid * 8 + i];
        stat[tid] = rsqrtf(sm * (1.0f / 512.0f) + 1e-6f); }
    __syncthreads();
    bf16_t* MX = (bf16_t*)(p.ws + WS_MIXIN);
#pragma unroll
    for (int m = 0; m < 4; ++m) {
        const int t = 16 * m + fr;
        const float rs = stat[t];
#pragma unroll
        for (int n = 0; n < 4; ++n) {
            const int ch = g * 512 + w * 64 + 16 * n + fq * 4;
            const f32x4 nw = *(const f32x4*)(p.s_norm_w + l * 1024 + ch);
            u32x2 wv; wv.x = pk2(acc1[m][n][0] * rs * nw[0], acc1[m][n][1] * rs * nw[1]); wv.y = pk2(acc1[m][n][2] * rs * nw[2], acc1[m][n][3] * rs * nw[3]);
            *(u32x2*)(MX + (size_t)(r0 + t) * D + 1024 + ch) = wv;
        }
    }
    __syncthreads();
}

DEV void smp_mlstm(const P& p, int l, int unit, unsigned char* lds) {
    const int b = unit >> 2, h = unit & 3;
    int tid_ = threadIdx.x; asm volatile("" : "+v"(tid_)); const int tid = tid_, lane = tid & 63, w = tid >> 6;
    const int r0 = NPR + b * 8;
    const bf16_t* U = (const bf16_t*)(p.ws + WS_U) + (size_t)r0 * INP;
    float* qn = (float*)lds; float* kn = qn + 2048; float* vn = kn + 2048; float* qT = vn + 2048; float* kwT = qT + 2048; float* sc = kwT + 2048; float* red = sc + 256;
    const size_t sidx = (size_t)(l * 128 + b) * 4 + h;
    const float* C0 = p.st_C + sidx * 65536; const float* n0 = p.st_n + sidx * 256;
    float* Cout = p.out + O_SC + sidx * 65536;
    if (tid == 0) {
        const float m0 = p.st_m[sidx];
        float bs = 0.f, cm = -INFINITY, mt = 0.f;
        for (int t = 0; t < 8; ++t) {
            const float ig = bf2f(U[(size_t)t * INP + UIG + h]) + p.b_i[l * 4 + h];
            const float lf = logsigf_(bf2f(U[(size_t)t * INP + UFG + h]) + p.b_f[l * 4 + h]);
            bs += lf; const float a = ig - bs; cm = fmaxf(cm, a); mt = bs + fmaxf(m0, cm);
            sc[32 + t] = mt; sc[t] = expf(bs + m0 - mt); sc[40 + t] = a; sc[48 + t] = bs;
        }
        for (int s = 0; s < 8; ++s) sc[16 + s] = expf(bs + sc[40 + s] - mt);
        sc[24] = expf(bs + m0 - mt);
        p.out[O_SM + sidx] = mt;
    }
    __syncthreads();
#pragma unroll
    for (int i = 0; i < 4; ++i) {
        const int idx = tid + 512 * i, t = idx >> 8, d = idx & 255;
        const float q = bf2f(U[(size_t)t * INP + UQ + h * 256 + d]), k = bf2f(U[(size_t)t * INP + UK + h * 256 + d]), v = bf2f(U[(size_t)t * INP + UV + h * 256 + d]);
        qn[t * 256 + d] = q; kn[t * 256 + d] = k; vn[t * 256 + d] = v; qT[d * 8 + t] = q; kwT[d * 8 + t] = k * sc[16 + t];
    }
    __syncthreads();
    {
        const int t = w;
        const f32x4 qv = *(const f32x4*)(qn + t * 256 + lane * 4);
        float dot[9];
#pragma unroll
        for (int s = 0; s < 8; ++s) { const f32x4 kv = *(const f32x4*)(kn + s * 256 + lane * 4); dot[s] = qv[0] * kv[0] + qv[1] * kv[1] + qv[2] * kv[2] + qv[3] * kv[3]; }
        { const f32x4 nv = *(const f32x4*)(n0 + lane * 4); dot[8] = qv[0] * nv[0] + qv[1] * nv[1] + qv[2] * nv[2] + qv[3] * nv[3]; }
#pragma unroll
        for (int s = 0; s < 9; ++s) dot[s] = wave_sum(dot[s]);
        float den = 0.f;
#pragma unroll
        for (int s = 0; s < 8; ++s) { const float sv = (s <= t) ? dot[s] * expf(sc[48 + t] - sc[32 + t] + sc[40 + s]) : 0.f; den += sv; if (lane == 0) sc[64 + t * 8 + s] = sv; }
        den += sc[t] * dot[8];
        if (lane == 0) sc[8 + t] = 1.0f / fmaxf(fabsf(den), expf(-sc[32 + t]));
    }
    if (tid < 256) {
        float a = sc[24] * n0[tid];
#pragma unroll
        for (int s = 0; s < 8; ++s) a += kwT[tid * 8 + s];
        p.out[O_SN + sidx * 256 + tid] = a;
    }
    const int e4 = lane * 4;
    f32x4 num[8], vv[8];
#pragma unroll
    for (int t = 0; t < 8; ++t) { num[t] = (f32x4){0.f, 0.f, 0.f, 0.f}; vv[t] = *(const f32x4*)(vn + t * 256 + e4); }
    const float decay = sc[24];
    {
        f32x4 cn_[8];
#pragma unroll
        for (int j = 0; j < 8; ++j) cn_[j] = __builtin_nontemporal_load((const f32x4*)(C0 + (size_t)(w + 8 * j) * 256 + e4));
#pragma unroll 1
        for (int ib = 0; ib < 4; ++ib) {
            f32x4 cc[8];
#pragma unroll
            for (int j = 0; j < 8; ++j) cc[j] = cn_[j];
            if (ib < 3) {
#pragma unroll
                for (int j = 0; j < 8; ++j) cn_[j] = __builtin_nontemporal_load((const f32x4*)(C0 + (size_t)(w + 8 * ((ib + 1) * 8 + j)) * 256 + e4));
            }
#pragma unroll
            for (int j = 0; j < 8; ++j) {
                const int d = w + 8 * (ib * 8 + j);
                const f32x4 q0 = *(const f32x4*)(qT + d * 8), q1 = *(const f32x4*)(qT + d * 8 + 4), k0 = *(const f32x4*)(kwT + d * 8), k1 = *(const f32x4*)(kwT + d * 8 + 4);
                f32x4 cn = cc[j] * decay;
#pragma unroll
                for (int t = 0; t < 4; ++t) { num[t] += cc[j] * q0[t]; num[4 + t] += cc[j] * q1[t]; cn += vv[t] * k0[t]; cn += vv[4 + t] * k1[t]; }
                __builtin_nontemporal_store(cn, (f32x4*)(Cout + (size_t)d * 256 + e4));
            }
        }
    }
#pragma unroll
    for (int t = 0; t < 8; ++t) *(f32x4*)(red + (w * 8 + t) * 256 + e4) = num[t];
    __syncthreads();
    {
        const int t = w;
        f32x4 hv = (f32x4){0.f, 0.f, 0.f, 0.f};
#pragma unroll
        for (int ww = 0; ww < 8; ++ww) hv += *(const f32x4*)(red + (ww * 8 + t) * 256 + e4);
        hv = hv * sc[t];
#pragma unroll
        for (int s = 0; s < 8; ++s) hv += vv[s] * sc[64 + t * 8 + s];
        hv = hv * sc[8 + t];
        const float mu = wave_sum(hv[0] + hv[1] + hv[2] + hv[3]) * (1.0f / 256.0f);
        const f32x4 dv = hv - mu;
        const float var = wave_sum(dv[0] * dv[0] + dv[1] * dv[1] + dv[2] * dv[2] + dv[3] * dv[3]) * (1.0f / 256.0f);
        const float rs = rsqrtf(var + 1e-6f);
        const uint2 ov = *(const uint2*)(U + (size_t)t * INP + UO + h * 256 + e4);
        const f32x4 nw = *(const f32x4*)(p.m_norm_w + l * 1024 + h * 256 + e4);
        const float o0 = dv[0] * rs * nw[0] * sigmoidf_(bflo(ov.x)), o1 = dv[1] * rs * nw[1] * sigmoidf_(bfhi(ov.x));
        const float o2 = dv[2] * rs * nw[2] * sigmoidf_(bflo(ov.y)), o3 = dv[3] * rs * nw[3] * sigmoidf_(bfhi(ov.y));
        u32x2 wv; wv.x = pk2(o0, o1); wv.y = pk2(o2, o3);
        *(u32x2*)((bf16_t*)(p.ws + WS_MIXIN) + (size_t)(r0 + t) * D + h * 256 + e4) = wv;
    }
    __syncthreads();
}

DEV void smp_ssd(const P& p, int l, int unit, unsigned char* lds) {
    const int b = unit >> 1, g = unit & 1;
    int tid_ = threadIdx.x; asm volatile("" : "+v"(tid_)); const int tid = tid_, lane = tid & 63, w = tid >> 6, fr = lane & 15, fq = lane >> 4;
    const int r0 = NPR + b * 8;
    const bf16_t* U = (const bf16_t*)(p.ws + WS_U) + (size_t)r0 * INP;
    float* xs = (float*)lds;
    float* xwT = xs + 4096;
    float* Bmf = xwT + 4096;
    float* CBs = Bmf + 1024;
    float* bsh = CBs + 64;
    float* dtsh = bsh + 64;
    float* bLs = dtsh + 64;
    float* MW = bLs + 64;
    float* red = MW + 512;
    float* stat = red + 64;
    bf16_t* Cmb = (bf16_t*)(stat + 64);
    if (tid < 64) {
        const int hd = tid >> 3, t = tid & 7, head = g * 8 + hd;
        const float A = -expf(p.A_log[l * 16 + head]), dtb = p.dt_bias[l * 16 + head];
        float bs = 0.f, bL = 0.f, dtt = 0.f;
        for (int s = 0; s < 8; ++s) { const float dt = softplusf_(bf2f(U[(size_t)s * INP + UDT + head]) + dtb); bL += dt * A; if (s <= t) bs += dt * A; if (s == t) dtt = dt; }
        bsh[hd * 8 + t] = bs; dtsh[hd * 8 + t] = dtt; if (t == 0) bLs[hd] = bL;
    }
    for (int i = tid; i < 8 * 136 / 2; i += NTHR) ((unsigned*)(Cmb + 8 * 136))[i] = 0u;
    const float* cw = p.s_conv_w + (size_t)l * 4 * 1536; const float* cb = p.s_conv_b + (size_t)l * 1536;
    const float* cv0 = p.st_sconv + (size_t)(l * 128 + b) * 3 * 1536;
    for (int i = 0; i < 2; ++i) {
        const int it = tid + 512 * i;
        if (it < 768) {
            const int t = it / 96, gidx = it % 96;
            const int ch8 = gidx < 64 ? g * 512 + gidx * 8 : (gidx < 80 ? 1024 + g * 128 + (gidx - 64) * 8 : 1280 + g * 128 + (gidx - 80) * 8);
            float o[8];
            { const f32x4 b0 = *(const f32x4*)(cb + ch8), b1 = *(const f32x4*)(cb + ch8 + 4); o[0] = b0[0]; o[1] = b0[1]; o[2] = b0[2]; o[3] = b0[3]; o[4] = b1[0]; o[5] = b1[1]; o[6] = b1[2]; o[7] = b1[3]; }
#pragma unroll
            for (int j = 0; j < 4; ++j) {
                const int idx = t + j;
                float xf[8];
                if (idx < 3) { const f32x4 a0 = *(const f32x4*)(cv0 + idx * 1536 + ch8), a1 = *(const f32x4*)(cv0 + idx * 1536 + ch8 + 4);
                    xf[0] = a0[0]; xf[1] = a0[1]; xf[2] = a0[2]; xf[3] = a0[3]; xf[4] = a1[0]; xf[5] = a1[1]; xf[6] = a1[2]; xf[7] = a1[3]; }
                else { const uint4 x = *(const uint4*)(U + (size_t)(idx - 3) * INP + UXS + ch8); unpack8(x, xf); }
                const f32x4 w0 = *(const f32x4*)(cw + j * 1536 + ch8), w1 = *(const f32x4*)(cw + j * 1536 + ch8 + 4);
                o[0] += w0[0] * xf[0]; o[1] += w0[1] * xf[1]; o[2] += w0[2] * xf[2]; o[3] += w0[3] * xf[3];
                o[4] += w1[0] * xf[4]; o[5] += w1[1] * xf[5]; o[6] += w1[2] * xf[6]; o[7] += w1[3] * xf[7];
            }
#pragma unroll
            for (int k = 0; k < 8; ++k) o[k] = siluf_(o[k]);
            if (gidx < 64) {
#pragma unroll
                for (int k = 0; k < 8; ++k) xs[t * 512 + gidx * 8 + k] = o[k]; }
            else if (gidx < 80) {
#pragma unroll
                for (int k = 0; k < 8; ++k) Bmf[t * 128 + (gidx - 64) * 8 + k] = o[k]; }
            else { u32x4 wv; wv.x = pk2(o[0], o[1]); wv.y = pk2(o[2], o[3]); wv.z = pk2(o[4], o[5]); wv.w = pk2(o[6], o[7]); *(u32x4*)(Cmb + t * 136 + (gidx - 80) * 8) = wv; }
        }
    }
    __syncthreads();
#pragma unroll
    for (int i = 0; i < 8; ++i) {
        const int idx = tid + 512 * i, hp = idx >> 3, s = idx & 7, hd = hp >> 6;
        xwT[hp * 8 + s] = xs[s * 512 + hp] * expf(bLs[hd] - bsh[hd * 8 + s]) * dtsh[hd * 8 + s];
    }
    if (tid < 64) {
        const int t = tid >> 3, s = tid & 7; float a = 0.f;
        for (int n = 0; n < 128; ++n) a += bf2f(Cmb[t * 136 + n]) * Bmf[s * 128 + n];
        CBs[t * 8 + s] = a;
    }
    __syncthreads();
    { const int hd = tid >> 6, t = (tid >> 3) & 7, s = tid & 7;
      MW[tid] = (s <= t) ? CBs[t * 8 + s] * expf(bsh[hd * 8 + t] - bsh[hd * 8 + s]) * dtsh[hd * 8 + s] : 0.f; }
    __syncthreads();
    const int head = g * 8 + w;
    const size_t sidx = (size_t)(l * 128 + b) * 16 + head;
    const float* S0 = p.st_ssm + sidx * 8192; float* So = p.out + O_SS + sidx * 8192;
    const float dA = expf(bLs[w]);
    f32x4 acc[4];
    f32x4 svn[4][2];
#pragma unroll
    for (int ks = 0; ks < 4; ++ks) { svn[ks][0] = __builtin_nontemporal_load((const f32x4*)(S0 + fr * 128 + 32 * ks + fq * 8)); svn[ks][1] = __builtin_nontemporal_load((const f32x4*)(S0 + fr * 128 + 32 * ks + fq * 8 + 4)); }
#pragma unroll
    for (int nt = 0; nt < 4; ++nt) {
        acc[nt] = (f32x4){0.f, 0.f, 0.f, 0.f};
        const int pp = 16 * nt + fr;
        const f32x4 xw0 = *(const f32x4*)(xwT + (64 * w + pp) * 8), xw1 = *(const f32x4*)(xwT + (64 * w + pp) * 8 + 4);
        f32x4 sv[4][2];
#pragma unroll
        for (int ks = 0; ks < 4; ++ks) { sv[ks][0] = svn[ks][0]; sv[ks][1] = svn[ks][1]; }
        if (nt < 3) {
#pragma unroll
            for (int ks = 0; ks < 4; ++ks) { svn[ks][0] = __builtin_nontemporal_load((const f32x4*)(S0 + (pp + 16) * 128 + 32 * ks + fq * 8)); svn[ks][1] = __builtin_nontemporal_load((const f32x4*)(S0 + (pp + 16) * 128 + 32 * ks + fq * 8 + 4)); }
        }
#pragma unroll
        for (int ks = 0; ks < 4; ++ks) {
            const int n0 = 32 * ks + fq * 8;
            const f32x4 s0 = sv[ks][0], s1 = sv[ks][1];
            union { u32x4 u; bf16x8 v; } bfr;
            bfr.u.x = pk2(s0[0], s0[1]); bfr.u.y = pk2(s0[2], s0[3]); bfr.u.z = pk2(s1[0], s1[1]); bfr.u.w = pk2(s1[2], s1[3]);
            const bf16x8 af = *(const bf16x8*)(Cmb + fr * 136 + n0);
            acc[nt] = mfma16(af, bfr.v, acc[nt]);
            f32x4 o0 = s0 * dA, o1 = s1 * dA;
#pragma unroll
            for (int s = 0; s < 8; ++s) {
                const float xv = s < 4 ? xw0[s & 3] : xw1[s & 3];
                const f32x4 bm0 = *(const f32x4*)(Bmf + s * 128 + n0), bm1 = *(const f32x4*)(Bmf + s * 128 + n0 + 4);
                o0 += bm0 * xv; o1 += bm1 * xv;
            }
            __builtin_nontemporal_store(o0, (f32x4*)(So + pp * 128 + n0)); __builtin_nontemporal_store(o1, (f32x4*)(So + pp * 128 + n0 + 4));
        }
        asm volatile("" ::: "memory");
    }
    const float dsk = p.D_skip[l * 16 + head];
    float gts[4][4];
#pragma unroll
    for (int j = 0; j < 4; ++j) {
        const int t = (fq & 1) * 4 + j;
        const float eb = expf(bsh[w * 8 + t]);
        float ssq = 0.f;
#pragma unroll
        for (int nt = 0; nt < 4; ++nt) {
            const int hp = 64 * w + 16 * nt + fr;
            float y = eb * acc[nt][j] + dsk * xs[t * 512 + hp];
#pragma unroll
            for (int s = 0; s < 8; ++s) y += MW[(w * 8 + t) * 8 + s] * xs[s * 512 + hp];
            const float z = bf2f(U[(size_t)t * INP + UZ + g * 512 + hp]);
            const float gt = y * siluf_(z);
            gts[nt][j] = gt; ssq += gt * gt;
        }
        ssq += __shfl_xor(ssq, 1); ssq += __shfl_xor(ssq, 2); ssq += __shfl_xor(ssq, 4); ssq += __shfl_xor(ssq, 8);
        if (fr == 0 && fq < 2) red[t * 8 + w] = ssq;
    }
    __syncthreads();
    if (tid < 8) { float s = 0.f;
#pragma unroll
        for (int i = 0; i < 8; ++i) s += red[tid * 8 + i];
        stat[tid] = rsqrtf(s * (1.0f / 512.0f) + 1e-6f); }
    __syncthreads();
    if (fq < 2) {
        bf16_t* MX = (bf16_t*)(p.ws + WS_MIXIN);
#pragma unroll
        for (int j = 0; j < 4; ++j) {
            const int t = fq * 4 + j;
#pragma unroll
            for (int nt = 0; nt < 4; ++nt) {
                const int ch = g * 512 + 64 * w + 16 * nt + fr;
                MX[(size_t)(r0 + t) * D + 1024 + ch] = f2bf(gts[nt][j] * stat[t] * p.s_norm_w[l * 1024 + ch]);
            }
        }
    }
    __syncthreads();
}

DEV void phase_ln(const P& p, int l, int which) {
    int tid_ = threadIdx.x; asm volatile("" : "+v"(tid_));
    const int lane = tid_ & 63, w = tid_ >> 6;
    const float* gam = (which ? p.ln2_g : p.ln1_g) + l * D; const float* bet = (which ? p.ln2_b : p.ln1_b) + l * D;
    const bf16_t* mix = (const bf16_t*)(p.ws + WS_MIXF);
    bf16_t* xb = (bf16_t*)(p.ws + WS_XB);
    const bool lastp = (l == 1 && which == 1), split = (gridDim.x == 256);
    for (int r = blockIdx.x * 8 + w; r < NTOK; r += gridDim.x * 8) {
        f32x4 y[8]; float s = 0.f;
#pragma unroll
        for (int i = 0; i < 8; ++i) { const int cidx = i * 256 + lane * 4;
            f32x4 xv, mv;
            { const uint2 t = *(const uint2*)(xb + (size_t)r * D + cidx); xv = (f32x4){bflo(t.x), bfhi(t.x), bflo(t.y), bfhi(t.y)}; }
            if (split && r >= NPR) { const bf16_t* pp = (const bf16_t*)(p.ws + WS_PART) + (size_t)(r - NPR) * D + cidx; mv = (f32x4){0.f, 0.f, 0.f, 0.f};
#pragma unroll
                for (int k = 0; k < 8; ++k) { const uint2 t = *(const uint2*)(pp + (size_t)k * NSM * D); mv += (f32x4){bflo(t.x), bfhi(t.x), bflo(t.y), bfhi(t.y)}; } }
            else { const uint2 t = *(const uint2*)(mix + (size_t)r * D + cidx); mv = (f32x4){bflo(t.x), bfhi(t.x), bflo(t.y), bfhi(t.y)}; }
            y[i] = xv * ALPHA + mv; s += (y[i][0] + y[i][1]) + (y[i][2] + y[i][3]); }
        const float mu = wave_sum(s) * (1.0f / D);
        float q = 0.f;
#pragma unroll
        for (int i = 0; i < 8; ++i) { y[i] = y[i] - mu; q += (y[i][0] * y[i][0] + y[i][1] * y[i][1]) + (y[i][2] * y[i][2] + y[i][3] * y[i][3]); }
        const float rs = rsqrtf(wave_sum(q) * (1.0f / D) + 1e-5f);
#pragma unroll
        for (int i = 0; i < 8; ++i) { const int cidx = i * 256 + lane * 4;
            const f32x4 o = y[i] * rs * *(const f32x4*)(gam + cidx) + *(const f32x4*)(bet + cidx);
            if (lastp) *(f32x4*)(p.out + (size_t)r * D + cidx) = o;
            else { u32x2 wv; wv.x = pk2(o[0], o[1]); wv.y = pk2(o[2], o[3]); *(u32x2*)(xb + (size_t)r * D + cidx) = wv; } }
    }
}

DEV void phase_ffn_gate(const P& p, int l, int part, int b0, int nb) {
    const bf16_t* up = (const bf16_t*)(p.ws + WS_UP); bf16_t* act = (bf16_t*)(p.ws + WS_ACT);
    const float* fw = p.f_conv_w + (size_t)l * 3 * DFF2; const float* fb = p.f_conv_b + (size_t)l * DFF2;
    const int lo = part == 2 ? (NPR / 8) * (DFF / 8) : 0, total = part == 1 ? (NPR / 8) * (DFF / 8) : (NTOK / 8) * (DFF / 8);
    int tid_ = threadIdx.x; asm volatile("" : "+v"(tid_));
    for (int it = lo + b0 * NTHR + tid_; it < total; it += nb * NTHR) {
        const int rb = it / (DFF / 8), j8 = (it % (DFF / 8)) * 8, r0 = rb * 8;
        const bool smp = r0 >= NPR; const int t0 = smp ? 0 : (r0 & 2047); const int sb = (r0 - NPR) >> 3;
        float wg[3][8], wv[3][8], bg[8], bv[8];
#pragma unroll
        for (int k = 0; k < 3; ++k) {
            const f32x4 a0 = *(const f32x4*)(fw + k * DFF2 + j8), a1 = *(const f32x4*)(fw + k * DFF2 + j8 + 4), c0 = *(const f32x4*)(fw + k * DFF2 + DFF + j8), c1 = *(const f32x4*)(fw + k * DFF2 + DFF + j8 + 4);
#pragma unroll
            for (int i = 0; i < 4; ++i) { wg[k][i] = a0[i]; wg[k][4 + i] = a1[i]; wv[k][i] = c0[i]; wv[k][4 + i] = c1[i]; }
        }
        { const f32x4 a0 = *(const f32x4*)(fb + j8), a1 = *(const f32x4*)(fb + j8 + 4), c0 = *(const f32x4*)(fb + DFF + j8), c1 = *(const f32x4*)(fb + DFF + j8 + 4);
#pragma unroll
          for (int i = 0; i < 4; ++i) { bg[i] = a0[i]; bg[4 + i] = a1[i]; bv[i] = c0[i]; bv[4 + i] = c1[i]; } }
        float g0[8], g1[8], v0[8], v1[8];
        if (t0 > 0) {
            unpack8(*(const uint4*)(up + (size_t)(r0 - 2) * DFF2 + j8), g0); unpack8(*(const uint4*)(up + (size_t)(r0 - 2) * DFF2 + DFF + j8), v0);
            unpack8(*(const uint4*)(up + (size_t)(r0 - 1) * DFF2 + j8), g1); unpack8(*(const uint4*)(up + (size_t)(r0 - 1) * DFF2 + DFF + j8), v1);
        } else if (smp) {
            const float* bp = p.st_fconv + (size_t)(l * 128 + sb) * 2 * DFF2;
            const f32x4 a0 = *(const f32x4*)(bp + j8), a1 = *(const f32x4*)(bp + j8 + 4), c0 = *(const f32x4*)(bp + DFF + j8), c1 = *(const f32x4*)(bp + DFF + j8 + 4);
            const f32x4 d0 = *(const f32x4*)(bp + DFF2 + j8), d1 = *(const f32x4*)(bp + DFF2 + j8 + 4), e0 = *(const f32x4*)(bp + DFF2 + DFF + j8), e1 = *(const f32x4*)(bp + DFF2 + DFF + j8 + 4);
#pragma unroll
            for (int i = 0; i < 4; ++i) { g0[i] = a0[i]; g0[4 + i] = a1[i]; v0[i] = c0[i]; v0[4 + i] = c1[i]; g1[i] = d0[i]; g1[4 + i] = d1[i]; v1[i] = e0[i]; v1[4 + i] = e1[i]; }
        } else {
#pragma unroll
            for (int i = 0; i < 8; ++i) { g0[i] = 0.f; g1[i] = 0.f; v0[i] = 0.f; v1[i] = 0.f; }
        }
#pragma unroll
        for (int rr = 0; rr < 8; ++rr) {
            float g2[8], v2[8];
            unpack8(*(const uint4*)(up + (size_t)(r0 + rr) * DFF2 + j8), g2); unpack8(*(const uint4*)(up + (size_t)(r0 + rr) * DFF2 + DFF + j8), v2);
            float o[8];
#pragma unroll
            for (int i = 0; i < 8; ++i) {
                const float ag = bg[i] + wg[0][i] * g0[i] + wg[1][i] * g1[i] + wg[2][i] * g2[i];
                const float av = bv[i] + wv[0][i] * v0[i] + wv[1][i] * v1[i] + wv[2][i] * v2[i];
                o[i] = ag * __builtin_amdgcn_rcpf(1.0f + __expf(-ag)) * av;
                g0[i] = g1[i]; g1[i] = g2[i]; v0[i] = v1[i]; v1[i] = v2[i];
            }
            u32x4 wv4; wv4.x = pk2(o[0], o[1]); wv4.y = pk2(o[2], o[3]); wv4.z = pk2(o[4], o[5]); wv4.w = pk2(o[6], o[7]);
            *(u32x4*)(act + (size_t)(r0 + rr) * DFF + j8) = wv4;
        }
    }
    const int tot2 = part == 1 ? 0 : 132 * 2 * (DFF2 / 8);
    for (int it = b0 * NTHR + tid_; it < tot2; it += nb * NTHR) {
        const int c8 = (it % (DFF2 / 8)) * 8, rr = it / (DFF2 / 8), j = rr & 1, sq = rr >> 1;
        float* o; size_t row;
        if (sq < 4) { o = p.out + O_PFC + ((size_t)(l * 4 + sq) * 2 + j) * DFF2 + c8; row = (size_t)sq * 2048 + 2046 + j; }
        else { const int b = sq - 4; o = p.out + O_SFC + ((size_t)(l * 128 + b) * 2 + j) * DFF2 + c8; row = (size_t)NPR + b * 8 + 6 + j; }
        float xf[8]; unpack8(*(const uint4*)(up + row * DFF2 + c8), xf);
        *(f32x4*)o = (f32x4){xf[0], xf[1], xf[2], xf[3]}; *(f32x4*)(o + 4) = (f32x4){xf[4], xf[5], xf[6], xf[7]};
    }
}


#define XB_TMO      128
#define XB_XCNT(j)  (256  + 64 * (j))
#define XB_XSUB(j)  (1280 + 64 * (j))
#define XB_XGEN(j)  (2304 + 64 * (j))
#define XB_TOP      3328
#define XB_TOPGEN   3392
#define XCD_BAR_WORDS 3456
#define XB_SPIN_CAP (1u << 20)
DEV unsigned xb_ld(unsigned* p)              { return __hip_atomic_load(p, __ATOMIC_RELAXED, __HIP_MEMORY_SCOPE_AGENT); }
DEV unsigned xb_add(unsigned* p, unsigned v) { return __hip_atomic_fetch_add(p, v, __ATOMIC_RELAXED, __HIP_MEMORY_SCOPE_AGENT); }
DEV unsigned xb_xcc_id() { return (unsigned)__builtin_amdgcn_s_getreg((3 << 11) | 20) & 0xFu; }
#define XB_SPIN(cond, bar) do { unsigned _sp = 0; while (cond) { __builtin_amdgcn_s_sleep(1); \
    if ((++_sp & 255u) == 0u) { if (xb_ld(&(bar)[XB_TMO])) break; if (_sp > XB_SPIN_CAP) { atomicAdd(&(bar)[XB_TMO], 1u); break; } } } } while (0)
struct XcdBarrier { unsigned* bar; unsigned x; volatile LAS unsigned* st; };
DEV XcdBarrier xcd_barrier_post(unsigned* bar, volatile LAS unsigned* st) {
    XcdBarrier b; b.bar = bar; b.x = xb_xcc_id(); b.st = st;
    if (threadIdx.x == 0) (void)xb_add(&bar[XB_XCNT(b.x)], 1u);
    return b;
}
DEV void xcd_barrier_complete(unsigned* bar, unsigned x, unsigned& nloc, unsigned& nx) {
    const unsigned G = gridDim.x * gridDim.y * gridDim.z;
    unsigned sum, cnt, mine, sp = 0u;
    for (;;) {
        sum = 0u; cnt = 0u; mine = 0u;
#pragma unroll
        for (unsigned j = 0; j < 16; ++j) { const unsigned c = xb_ld(&bar[XB_XCNT(j)]); sum += c; cnt += (c > 0u) ? 1u : 0u; mine = (j == x) ? c : mine; }
        if (sum == G) break;
        __builtin_amdgcn_s_sleep(1);
        if ((++sp & 255u) == 0u) { if (xb_ld(&bar[XB_TMO])) break; if (sp > XB_SPIN_CAP) { atomicAdd(&bar[XB_TMO], 1u); break; } }
    }
    nloc = mine > 0u ? mine : 1u; nx = cnt > 0u ? cnt : 1u;
}
DEV void xcd_barrier(const XcdBarrier& b) {
    asm volatile("s_waitcnt vmcnt(0)" ::: "memory");
    __syncthreads();
    if (threadIdx.x == 0) {
        unsigned* bar = b.bar;
        __builtin_amdgcn_s_waitcnt(0);
        unsigned nloc = b.st[0], nx = b.st[1];
        if (nloc == 0u) { xcd_barrier_complete(bar, b.x, nloc, nx); b.st[0] = nloc; b.st[1] = nx; }
        const unsigned old = xb_add(&bar[XB_XSUB(b.x)], 1u);
        const unsigned gen = old / nloc;
        if (old + 1u == (gen + 1u) * nloc) {
            __builtin_amdgcn_fence(__ATOMIC_RELEASE, "agent");
            asm volatile("s_waitcnt vmcnt(0)" ::: "memory");
            const unsigned og = xb_add(&bar[XB_TOP], 1u);
            const unsigned tg = og / nx;
            if (og + 1u == (tg + 1u) * nx) xb_add(&bar[XB_TOPGEN], 1u);
            else XB_SPIN(xb_ld(&bar[XB_TOPGEN]) == tg, bar);
            __builtin_amdgcn_fence(__ATOMIC_ACQUIRE, "agent");
            xb_add(&bar[XB_XGEN(b.x)], 1u);
            asm volatile("s_waitcnt vmcnt(0)" ::: "memory");
        } else {
            XB_SPIN(xb_ld(&bar[XB_XGEN(b.x)]) == gen, bar);
            __builtin_amdgcn_fence(__ATOMIC_ACQUIRE, "agent");
            asm volatile("s_waitcnt vmcnt(0)" ::: "memory");
        }
    }
    __syncthreads();
}

constexpr int NPHASE = 21;
DEV void run_phase(const P& p, int l, int q, unsigned char* lds) {
    int bid = blockIdx.x, G = gridDim.x; asm volatile("" : "+s"(bid), "+s"(G));
    if (q == 0) {
        pg8::Gemm g{(const bf16_t*)(p.ws + WS_XB), (const bf16_t*)(p.ws + WS_WIN) + (size_t)l * INP * D, NTOK, INP, D};
        pg8::StaticOrder S; S.init(NTOK, INP, D, G, bid);
        pg8::EpiBf16 E{(bf16_t*)(p.ws + WS_U), INP, nullptr};
        pg8::gemm_phase<pg8::EpiBf16, pg8::StaticOrder>((LAS unsigned char*)lds, g, S, E);
    } else if (q == 1) {
        const int par = bid & 1;
#pragma unroll 1
        for (int half = 0; half < 2; ++half) {
            if ((half ^ par) == 0) {
                for (int u = bid; u < 512; u += G) smp_mlstm(p, l, u, lds);
                for (int u = bid; u < 256; u += G) smp_ssd(p, l, u, lds);
            } else {
                for (int u = bid; u < 512; u += G) mlstm_local(p, l, u, lds);
                for (int u = bid; u < 256; u += G) ssd_local(p, l, u, lds);
            }
        }
    } else if (q == 2) {
        for (int u = bid; u < 256; u += G) mlstm_scan(p, l, u, lds);
        for (int u = bid; u < 256; u += G) ssd_scan(p, l, u, lds);
        for (int u = bid; u < 132; u += G) convstate_copy(p, l, u);
    } else if (q == 3) {
        for (int u = bid; u < 512; u += G) mlstm_out(p, l, u, lds);
        for (int u = bid; u < 256; u += G) ssd_out(p, l, u, lds);
    } else if (q == 4) {
        pg8::Gemm g{(const bf16_t*)(p.ws + WS_MIXIN), (const bf16_t*)(p.ws + WS_WOUT) + (size_t)l * D * D, NTOK, D, D};
        pg8::EpiBf16 E{(bf16_t*)(p.ws + WS_MIXF), D, (float*)(p.ws + WS_PART)};
        if (G == 256) { pg8::TailSplitOrder S; S.init(D, bid); pg8::gemm_phase<pg8::EpiBf16, pg8::TailSplitOrder>((LAS unsigned char*)lds, g, S, E); }
        else { pg8::StaticOrder S; S.init(NTOK, D, D, G, bid); pg8::gemm_phase<pg8::EpiBf16, pg8::StaticOrder>((LAS unsigned char*)lds, g, S, E); }
    } else if (q == 5) {
        phase_ln(p, l, 0);
    } else if (q == 6) {
        pg8::Gemm g{(const bf16_t*)(p.ws + WS_XB), (const bf16_t*)(p.ws + WS_WUP) + (size_t)l * DFF2 * D, NTOK, DFF2, D};
        pg8::StaticOrder S; S.init(NTOK, DFF2, D, G, bid);
        pg8::EpiBf16 E{(bf16_t*)(p.ws + WS_UP), DFF2, nullptr};
        pg8::gemm_phase<pg8::EpiBf16, pg8::StaticOrder>((LAS unsigned char*)lds, g, S, E);
        if (l == 0 && G == 256 && bid >= 12) phase_prologue(p, lds, 1, 2, false, bid - 12, 244);
    } else if (q == 16 || q == 26) {
        pg8::Gemm g{(const bf16_t*)(p.ws + WS_XB), (const bf16_t*)(p.ws + WS_WUP) + (size_t)l * DFF2 * D, NTOK, DFF2, D};
        pg8::EpiBf16 E{(bf16_t*)(p.ws + WS_UP), DFF2, nullptr};
        if (q == 16 || bid < 12) { pg8::UpOrder S; S.init(bid, q == 16 ? 0 : 6, q == 16 ? 6 : 7); pg8::gemm_phase<pg8::EpiBf16, pg8::UpOrder>((LAS unsigned char*)lds, g, S, E); }
        else phase_ffn_gate(p, l, 1, bid - 12, 244);
    } else if (q == 17) {
        phase_ffn_gate(p, l, 2, bid, G);
    } else if (q == 7) {
        phase_ffn_gate(p, l, 0, bid, G);
    } else if (q == 8) {
        pg8::Gemm g{(const bf16_t*)(p.ws + WS_ACT), (const bf16_t*)(p.ws + WS_WDN) + (size_t)l * D * DFF, NTOK, D, DFF};
        pg8::EpiBf16 E{(bf16_t*)(p.ws + WS_MIXF), D, (float*)(p.ws + WS_PART)};
        if (G == 256) { pg8::TailSplitOrder S; S.init(DFF, bid); pg8::gemm_phase<pg8::EpiBf16, pg8::TailSplitOrder>((LAS unsigned char*)lds, g, S, E); }
        else { pg8::StaticOrder S; S.init(NTOK, D, DFF, G, bid); pg8::gemm_phase<pg8::EpiBf16, pg8::StaticOrder>((LAS unsigned char*)lds, g, S, E); }
    } else {
        phase_ln(p, l, 1);
    }
}
#if MK_MULTI
template <int T> __global__ void __launch_bounds__(NTHR, 2) k_unit(P p) {
    extern __shared__ __attribute__((aligned(16))) unsigned char lds[];
    const int l = p.ph_lo; int bid = blockIdx.x, G = gridDim.x;
    if (T == 11) for (int u = bid; u < 512; u += G) smp_mlstm(p, l, u, lds);
    if (T == 12) for (int u = bid; u < 256; u += G) smp_ssd(p, l, u, lds);
    if (T == 13) for (int u = bid; u < 512; u += G) mlstm_local(p, l, u, lds);
    if (T == 14) for (int u = bid; u < 256; u += G) ssd_local(p, l, u, lds);
    if (T == 31) for (int u = bid; u < 512; u += G) mlstm_out(p, l, u, lds);
    if (T == 32) for (int u = bid; u < 256; u += G) ssd_out(p, l, u, lds);
    if (T == 21) for (int u = bid; u < 256; u += G) mlstm_scan(p, l, u, lds);
    if (T == 22) for (int u = bid; u < 256; u += G) ssd_scan(p, l, u, lds);
}
template <int Q> __global__ void __launch_bounds__(NTHR, 2) k_phase(P p) {
    extern __shared__ __attribute__((aligned(16))) unsigned char lds[];
    if (Q < 0) phase_prologue(p, lds, 0, gridDim.x == 256 ? 1 : 2, true, blockIdx.x, gridDim.x); else run_phase(p, p.ph_lo, Q, lds);
}
#else
__global__ void __launch_bounds__(NTHR, 2) mk_fwd(P p) {
    extern __shared__ __attribute__((aligned(16))) unsigned char lds[];
    cg::grid_group grid = cg::this_grid();
    if (p.ph_hi < 0) grid.sync();
    if (threadIdx.x < 4) ((unsigned*)(lds + LDS_BYTES - 16))[threadIdx.x] = 0u;
    __syncthreads();
    (void)xcd_barrier_post((unsigned*)(p.ws + WS_BAR), (volatile LAS unsigned*)(lds + LDS_BYTES - 16));
#define GSYNC() do { XcdBarrier b_; b_.bar = (unsigned*)(p.ws + WS_BAR); b_.x = xb_xcc_id(); b_.st = (volatile LAS unsigned*)(lds + LDS_BYTES - 16); xcd_barrier(b_); } while (0)
    phase_prologue(p, lds, 0, gridDim.x == 256 ? 1 : 2, true, blockIdx.x, gridDim.x);
#pragma unroll 1
    for (int l = 0; l < 2; ++l) {
        GSYNC(); run_phase(p, l, 0, lds);
        GSYNC(); run_phase(p, l, 1, lds);
        GSYNC(); run_phase(p, l, 2, lds);
        GSYNC(); run_phase(p, l, 3, lds);
        GSYNC(); run_phase(p, l, 4, lds);
        GSYNC(); run_phase(p, l, 5, lds);
        if (l == 1 && gridDim.x == 256) {
            GSYNC(); run_phase(p, l, 16, lds);
            GSYNC(); run_phase(p, l, 26, lds);
            GSYNC(); run_phase(p, l, 17, lds);
        } else {
            GSYNC(); run_phase(p, l, 6, lds);
            GSYNC(); run_phase(p, l, 7, lds);
        }
        GSYNC(); run_phase(p, l, 8, lds);
        GSYNC(); run_phase(p, l, 9, lds);
    }
    for (int i = 0; i < PROBE_SYNCS; ++i) GSYNC();
}
#endif

extern "C" void kernel_launch(void* const* d_in, const int* in_sizes, int n_in, void* d_out, int out_size, void* d_ws, size_t ws_size, hipStream_t stream) {
    static int grid = 0;
    if (grid == 0) {
        if (n_in != 27 || ws_size < WS_END) { fprintf(stderr, "kernel_launch: unexpected n_in %d or ws_size %zu (need %zu)\n", n_in, ws_size, (size_t)WS_END); grid = -1; return; }
        int dev = 0, cus = 0, per_cu = 0;
        hipGetDevice(&dev);
        hipDeviceGetAttribute(&cus, hipDeviceAttributeMultiprocessorCount, dev);
#if MK_MULTI
        const void* fns[11] = {(const void*)k_phase<-1>, (const void*)k_phase<0>, (const void*)k_phase<1>, (const void*)k_phase<2>, (const void*)k_phase<3>, (const void*)k_phase<4>, (const void*)k_phase<5>,
                               (const void*)k_phase<6>, (const void*)k_phase<7>, (const void*)k_phase<8>, (const void*)k_phase<9>};
        for (int i = 0; i < 11; ++i) if (hipFuncSetAttribute(fns[i], hipFuncAttributeMaxDynamicSharedMemorySize, LDS_BYTES) != hipSuccess) { fprintf(stderr, "kernel_launch: hipFuncSetAttribute failed\n"); grid = -1; return; }
#else
        if (hipFuncSetAttribute((const void*)mk_fwd, hipFuncAttributeMaxDynamicSharedMemorySize, LDS_BYTES) != hipSuccess) { fprintf(stderr, "kernel_launch: hipFuncSetAttribute failed\n"); grid = -1; return; }
        hipOccupancyMaxActiveBlocksPerMultiprocessor(&per_cu, (const void*)mk_fwd, NTHR, LDS_BYTES);
        (void)hipGetLastError();
#endif
        (void)per_cu;
        grid = cus * 1;
    }
    if (grid < 0) return;
    P p{};
    const float** pp = (const float**)&p;
    for (int i = 0; i < 27; ++i) pp[i] = (const float*)d_in[i];
    p.out = (float*)d_out; p.ws = (unsigned char*)d_ws;
#if MK_MULTI
    p.ph_lo = 0; p.ph_hi = 0;
    if (PROBE_REP == -1) hipLaunchKernelGGL(k_phase<-1>, dim3(grid), dim3(NTHR), LDS_BYTES, stream, p);
    hipLaunchKernelGGL(k_phase<-1>, dim3(grid), dim3(NTHR), LDS_BYTES, stream, p);
    for (int l = 0; l < 2; ++l) {
        p.ph_lo = l;
        for (int rep = 0; rep < 1 + ((PROBE_REP == 0) || (PROBE_REP == 100 && (0 == 0 || 0 == 4 || 0 == 6 || 0 == 8))); ++rep) hipLaunchKernelGGL(k_phase<0>, dim3(grid), dim3(NTHR), LDS_BYTES, stream, p);
        for (int rep = 0; rep < 1 + ((PROBE_REP == 1) || (PROBE_REP == 100 && (1 == 0 || 1 == 4 || 1 == 6 || 1 == 8))); ++rep) hipLaunchKernelGGL(k_phase<1>, dim3(grid), dim3(NTHR), LDS_BYTES, stream, p);
        for (int rep = 0; rep < 1 + ((PROBE_REP == 2) || (PROBE_REP == 100 && (2 == 0 || 2 == 4 || 2 == 6 || 2 == 8))); ++rep) hipLaunchKernelGGL(k_phase<2>, dim3(grid), dim3(NTHR), LDS_BYTES, stream, p);
        for (int rep = 0; rep < 1 + ((PROBE_REP == 3) || (PROBE_REP == 100 && (3 == 0 || 3 == 4 || 3 == 6 || 3 == 8))); ++rep) hipLaunchKernelGGL(k_phase<3>, dim3(grid), dim3(NTHR), LDS_BYTES, stream, p);
        if (PROBE_REP == 11 || PROBE_REP == 12 || PROBE_REP == 13 || PROBE_REP == 14 || PROBE_REP == 31 || PROBE_REP == 32 || PROBE_REP == 21 || PROBE_REP == 22) {
            hipFuncSetAttribute((const void*)k_unit<PROBE_REP>, hipFuncAttributeMaxDynamicSharedMemorySize, LDS_BYTES);
            hipLaunchKernelGGL(k_unit<PROBE_REP>, dim3(grid), dim3(NTHR), LDS_BYTES, stream, p);
        }
        for (int rep = 0; rep < 1 + ((PROBE_REP == 4) || (PROBE_REP == 100 && (4 == 0 || 4 == 4 || 4 == 6 || 4 == 8))); ++rep) hipLaunchKernelGGL(k_phase<4>, dim3(grid), dim3(NTHR), LDS_BYTES, stream, p);
        for (int rep = 0; rep < 1 + ((PROBE_REP == 5) || (PROBE_REP == 100 && (5 == 0 || 5 == 4 || 5 == 6 || 5 == 8))); ++rep) hipLaunchKernelGGL(k_phase<5>, dim3(grid), dim3(NTHR), LDS_BYTES, stream, p);
        for (int rep = 0; rep < 1 + ((PROBE_REP == 6) || (PROBE_REP == 100 && (6 == 0 || 6 == 4 || 6 == 6 || 6 == 8))); ++rep) hipLaunchKernelGGL(k_phase<6>, dim3(grid), dim3(NTHR), LDS_BYTES, stream, p);
        for (int rep = 0; rep < 1 + ((PROBE_REP == 7) || (PROBE_REP == 100 && (7 == 0 || 7 == 4 || 7 == 6 || 7 == 8))); ++rep) hipLaunchKernelGGL(k_phase<7>, dim3(grid), dim3(NTHR), LDS_BYTES, stream, p);
        for (int rep = 0; rep < 1 + ((PROBE_REP == 8) || (PROBE_REP == 100 && (8 == 0 || 8 == 4 || 8 == 6 || 8 == 8))); ++rep) hipLaunchKernelGGL(k_phase<8>, dim3(grid), dim3(NTHR), LDS_BYTES, stream, p);
        for (int rep = 0; rep < 1 + ((PROBE_REP == 9) || (PROBE_REP == 100 && (9 == 0 || 9 == 4 || 9 == 6 || 9 == 8))); ++rep) hipLaunchKernelGGL(k_phase<9>, dim3(grid), dim3(NTHR), LDS_BYTES, stream, p);
    }
#else
    p.ph_lo = 0; p.ph_hi = NPHASE;
    if (hipMemsetAsync((char*)d_ws + WS_BAR, 0, 16384, stream) != hipSuccess) { fprintf(stderr, "kernel_launch: memset failed\n"); return; }
    void* args[] = {&p};
    hipError_t e = hipLaunchCooperativeKernel((const void*)mk_fwd, dim3(grid), dim3(NTHR), args, LDS_BYTES, stream);
    if (e != hipSuccess) fprintf(stderr, "cooperative launch failed: %s (grid %d)\n", hipGetErrorString(e), grid);
#endif
}
```

```cpp
#include <hip/hip_runtime.h>
#include <hip/hip_cooperative_groups.h>
#include <cstdio>
namespace cg = cooperative_groups;

#ifndef MK_MULTI
#define MK_MULTI 0
#endif
#ifndef PROBE_REP
#define PROBE_REP -99
#endif
#ifndef PROBE_SYNCS
#define PROBE_SYNCS 0
#endif

#define DEV __device__ __forceinline__
#define LAS __attribute__((address_space(3)))
typedef unsigned short bf16_t;
typedef short bf16x8 __attribute__((ext_vector_type(8)));
typedef float f32x4 __attribute__((ext_vector_type(4)));
typedef float f32x2 __attribute__((ext_vector_type(2)));
typedef unsigned u32x4 __attribute__((ext_vector_type(4)));
typedef unsigned u32x2 __attribute__((ext_vector_type(2)));

constexpr int D = 2048, NPR = 8192, NSM = 1024, NTOK = 9216, INP = 6912, IN_DIM = 6680, DFF = 5504, DFF2 = 11008;
constexpr int UQ = 0, UK = 1024, UV = 2048, UO = 3072, UZ = 4096, UXS = 5120, UIG = 6656, UFG = 6660, UDT = 6664;
constexpr int NTHR = 512;
constexpr int LDS_BYTES = 136 * 1024;
constexpr float ALPHA = 1.41421356237309515f;

constexpr size_t O_YP = 0;
constexpr size_t O_YS = O_YP + (size_t)4 * 2048 * 2048;
constexpr size_t O_PC = O_YS + (size_t)128 * 8 * 2048;
constexpr size_t O_PN = O_PC + (size_t)2 * 4 * 4 * 256 * 256;
constexpr size_t O_PM = O_PN + (size_t)2 * 4 * 4 * 256;
constexpr size_t O_PS = O_PM + (size_t)2 * 4 * 4;
constexpr size_t O_PSC = O_PS + (size_t)2 * 4 * 16 * 64 * 128;
constexpr size_t O_PFC = O_PSC + (size_t)2 * 4 * 3 * 1536;
constexpr size_t O_SC = O_PFC + (size_t)2 * 4 * 2 * DFF2;
constexpr size_t O_SN = O_SC + (size_t)2 * 128 * 4 * 256 * 256;
constexpr size_t O_SM = O_SN + (size_t)2 * 128 * 4 * 256;
constexpr size_t O_SS = O_SM + (size_t)2 * 128 * 4;
constexpr size_t O_SSC = O_SS + (size_t)2 * 128 * 16 * 64 * 128;
constexpr size_t O_SFC = O_SSC + (size_t)2 * 128 * 3 * 1536;

constexpr size_t WS_WIN = 0;
constexpr size_t WS_WOUT = WS_WIN + (size_t)2 * INP * D * 2;
constexpr size_t WS_WUP = WS_WOUT + (size_t)2 * D * D * 2;
constexpr size_t WS_WDN = WS_WUP + (size_t)2 * DFF2 * D * 2;
constexpr size_t WS_XB = WS_WDN + (size_t)2 * D * DFF * 2;
constexpr size_t WS_XF = WS_XB + (size_t)NTOK * D * 2;
constexpr size_t WS_XBC = WS_XF;
constexpr size_t WS_U = WS_XF + (size_t)NTOK * D * 4;
constexpr size_t WS_MIXIN = WS_U + (size_t)NTOK * INP * 2;
constexpr size_t WS_MIXF = WS_MIXIN + (size_t)NTOK * D * 2;
constexpr size_t WS_UP = WS_MIXF + (size_t)NTOK * D * 4;
constexpr size_t WS_ACT = WS_UP + (size_t)NTOK * DFF2 * 2;
constexpr size_t WS_PART = WS_ACT + (size_t)NTOK * DFF * 2;
constexpr size_t WS_SMALL = WS_PART + (size_t)8 * NSM * D * 4;
constexpr size_t WS_DBUF = WS_UP;
constexpr size_t WS_SBUF = WS_UP + (size_t)512 * 65536 * 4;
constexpr size_t WS_CT = WS_ACT;
constexpr size_t WS_ST = WS_ACT + (size_t)512 * 65536 * 2;
static_assert(WS_SBUF + (size_t)2048 * 8192 * 4 <= WS_ACT, "alias");
static_assert(WS_ST + (size_t)2048 * 8192 * 2 <= WS_PART, "alias");
constexpr size_t WS_NLOC = WS_SMALL;
constexpr size_t WS_NST = WS_NLOC + (size_t)512 * 256 * 4;
constexpr size_t WS_GSTAT = WS_NST + (size_t)512 * 256 * 4;
constexpr size_t WS_MST = WS_GSTAT + 4096;
constexpr size_t WS_SBSUM = WS_MST + 4096;
constexpr size_t WS_BAR = WS_SBSUM + 8192;
constexpr size_t WS_END = WS_BAR + 16384;

struct P {
    const float* x_prompt; const float* x_sample; const float* st_C; const float* st_n; const float* st_m; const float* st_ssm; const float* st_sconv; const float* st_fconv;
    const float* w_in; const float* b_i; const float* b_f; const float* m_norm_w; const float* s_conv_w; const float* s_conv_b; const float* dt_bias; const float* A_log; const float* D_skip;
    const float* s_norm_w; const float* w_out; const float* ln1_g; const float* ln1_b; const float* w_up; const float* f_conv_w; const float* f_conv_b; const float* w_down; const float* ln2_g; const float* ln2_b;
    float* out; unsigned char* ws; int ph_lo, ph_hi;
};

DEV float bf2f(bf16_t v) { return __uint_as_float(((unsigned)v) << 16); }
DEV bf16_t f2bf(float f) { unsigned u = __float_as_uint(f); u += 0x7FFFu + ((u >> 16) & 1u); return (bf16_t)(u >> 16); }
DEV unsigned pk2(float lo, float hi) { return (unsigned)f2bf(lo) | ((unsigned)f2bf(hi) << 16); }
DEV float bflo(unsigned w) { return __uint_as_float(w << 16); }
DEV float bfhi(unsigned w) { return __uint_as_float(w & 0xffff0000u); }
DEV float sigmoidf_(float x) { return __builtin_amdgcn_rcpf(1.0f + __expf(-x)); }
DEV float siluf_(float x) { return x * sigmoidf_(x); }
DEV float softplusf_(float x) { return fmaxf(x, 0.f) + log1pf(expf(-fabsf(x))); }
DEV float logsigf_(float x) { return fminf(x, 0.f) - log1pf(expf(-fabsf(x))); }
DEV float wave_sum(float v) {
#pragma unroll
    for (int o = 32; o >= 1; o >>= 1) v += __shfl_xor(v, o);
    return v; }
DEV float wave_max(float v) {
#pragma unroll
    for (int o = 32; o >= 1; o >>= 1) v = fmaxf(v, __shfl_xor(v, o));
    return v; }
DEV float wave_incl_sum(float v, int lane) {
#pragma unroll
    for (int o = 1; o < 64; o <<= 1) { float t = __shfl_up(v, o); if (lane >= o) v += t; }
    return v; }
DEV float wave_incl_max(float v, int lane) {
#pragma unroll
    for (int o = 1; o < 64; o <<= 1) { float t = __shfl_up(v, o); if (lane >= o) v = fmaxf(v, t); }
    return v; }
DEV f32x4 mfma16(bf16x8 a, bf16x8 b, f32x4 c) { return __builtin_amdgcn_mfma_f32_16x16x32_bf16(a, b, c, 0, 0, 0); }
DEV void unpack8(uint4 x, float (&f)[8]) { f[0] = bflo(x.x); f[1] = bfhi(x.x); f[2] = bflo(x.y); f[3] = bfhi(x.y); f[4] = bflo(x.z); f[5] = bfhi(x.z); f[6] = bflo(x.w); f[7] = bfhi(x.w); }

typedef short s16x4 __attribute__((ext_vector_type(4)));
DEV bf16x8 tr_frag(const bf16_t* T, int pitch, int krow0, int col0, int lane) {
    const int g = lane >> 4, q = (lane & 15) >> 2, pl = lane & 3;
    const bf16_t* a0 = T + (krow0 + 8 * g + q) * pitch + col0 + 4 * pl;
    const s16x4 lo = __builtin_amdgcn_ds_read_tr16_b64_v4i16((LAS s16x4*)a0);
    const s16x4 hi = __builtin_amdgcn_ds_read_tr16_b64_v4i16((LAS s16x4*)(a0 + 4 * pitch));
    return (bf16x8){lo[0], lo[1], lo[2], lo[3], hi[0], hi[1], hi[2], hi[3]};
}

namespace pg8 {
constexpr int BM = 256, BK = 64, HALF = 128, HTB = HALF * BK * 2, STAGE_BYTES = 8 * HTB, NXCD = 8, WGM = 8;
DEV int lds_byte(int r, int c) { const int st = (r >> 4) * 2 + (c >> 5), rr = r & 15, cc = c & 31, ob = rr * 64 + cc * 2; return st * 1024 + (ob ^ (((ob >> 9) & 1) << 5)); }
DEV void stage_rc(int b, int& R, int& C) { const int st = b / 1024, sb = b % 1024, swz = sb ^ (((sb >> 9) & 1) << 5); R = (st >> 1) * 16 + swz / 64; C = (st & 1) * 32 + (swz % 64) / 2; }
DEV int perm32(int rho) { const int n = rho >> 4, i = rho & 15; return 8 * (i >> 2) + 4 * n + (i & 3); }
struct Unit { int pm, pn, k0, nt, ks; };
struct Gemm { const bf16_t* A; const bf16_t* Bt; int M, N, K; };
struct StaticOrder {
    int nM, nN, nwg, G, c, ntk, ioff, imax;
    DEV void init(int M, int N, int K, int G_, int c_, int ioff_ = 0, int imax_ = 1 << 20) { nM = M / BM; nN = N / BM; nwg = nM * nN; G = G_; c = c_; ntk = K / BK; ioff = ioff_; imax = imax_; }
    DEV bool next(int i, Unit& u) const {
        u.pm = 0; u.pn = 0; u.k0 = 0; u.nt = 4; u.ks = -1;
        if (i + ioff >= imax) return false;
        const long L = (long)(i + ioff) * G + c; if (L >= nwg) return false;
        int wgid = (int)L; { const int q = nwg / NXCD, r = nwg % NXCD, xcd = wgid % NXCD, off = wgid / NXCD; wgid = (xcd < r ? xcd * (q + 1) : r * (q + 1) + (xcd - r) * q) + off; }
        const int nig = WGM * nN, gid = wgid / nig, fm = gid * WGM, gsz = (nM - fm) < WGM ? (nM - fm) : WGM;
        u.pm = fm + ((wgid % nig) % gsz); u.pn = (wgid % nig) / gsz; u.k0 = 0; u.nt = ntk; u.ks = -1; return true;
    }
};
struct TailSplitOrder {
    StaticOrder so; int c, ntk;
    DEV void init(int K, int c_) { so.init(NPR, D, K, 256, c_); c = c_; ntk = K / BK; }
    DEV bool next(int i, Unit& u) const {
        u.pm = 0; u.pn = 0; u.k0 = 0; u.nt = 4; u.ks = -1;
        if (i == 0) return so.next(0, u);
        if (i > 1) return false;
        const int tt = c >> 3, ks = c & 7; u.pm = 32 + (tt >> 3); u.pn = tt & 7; u.ks = ks;
        const int pairs = ntk >> 1, base = pairs >> 3, rem = pairs & 7;
        const int p0 = ks * base + (ks < rem ? ks : rem), np = base + (ks < rem ? 1 : 0);
        u.k0 = p0 * 128; u.nt = np * 2; return true;
    }
};
struct UpOrder {
    int c, ioff, imax;
    DEV void init(int c_, int ioff_, int imax_) { c = c_; ioff = ioff_; imax = imax_; }
    DEV bool next(int i, Unit& u) const {
        u.pm = 0; u.pn = 0; u.k0 = 0; u.nt = D / BK; u.ks = -1;
        const int r = i + ioff;
        if (r >= imax || r > 6 || (r == 6 && c >= 12)) return false;
        const int wgid = r < 6 ? ((r * 256 + c) % NXCD) * 192 + (r * 256 + c) / NXCD : 1536 + c;
        const int nN = DFF2 / BM, nig = WGM * nN, gid = wgid / nig, fm = gid * WGM, gsz = (36 - fm) < WGM ? (36 - fm) : WGM;
        u.pm = fm + ((wgid % nig) % gsz); u.pn = (wgid % nig) / gsz; return true;
    }
};
DEV unsigned cvt_pk_bf16(float lo, float hi) { unsigned r; asm volatile("v_cvt_pk_bf16_f32 %0, %1, %2" : "=v"(r) : "v"(lo), "v"(hi)); return r; }
struct EpiF32 {
    static constexpr bool PERM = false;
    float* C; int ldc; float* part;
    DEV void operator()(const f32x4 (&acc)[2][2][4][2], const Unit& u, int wr, int wc, int fr, int fq) const {
        const int row0 = u.pm * BM + wr * 64 + fr, col0 = u.pn * BM + wc * 32 + 4 * fq;
        float* Cb = u.ks < 0 ? C : part + (size_t)u.ks * NSM * D - (size_t)NPR * ldc;
#pragma unroll
        for (int ai = 0; ai < 2; ++ai)
#pragma unroll
            for (int m = 0; m < 4; ++m) { float* rowp = Cb + (size_t)(row0 + ai * HALF + m * 16) * ldc + col0;
#pragma unroll
                for (int bj = 0; bj < 2; ++bj)
#pragma unroll
                    for (int n = 0; n < 2; ++n) *(f32x4*)(rowp + bj * HALF + n * 16) = acc[ai][bj][m][n]; }
    }
};
struct EpiBf16 {
    static constexpr bool PERM = true;
    bf16_t* O; int ldc; float* part;
    DEV void operator()(const f32x4 (&acc)[2][2][4][2], const Unit& u, int wr, int wc, int fr, int fq) const {
        const int row0 = u.pm * BM + wr * 64 + fr; const int col0 = u.pn * BM + wc * 32 + 8 * fq;
        if (u.ks >= 0) {
            bf16_t* pb = (bf16_t*)part + (size_t)u.ks * NSM * ldc + (size_t)(row0 - NPR) * ldc + col0;
#pragma unroll
            for (int ai = 0; ai < 2; ++ai)
#pragma unroll
                for (int m = 0; m < 4; ++m)
#pragma unroll
                    for (int bj = 0; bj < 2; ++bj) { const f32x4 v0 = acc[ai][bj][m][0], v1 = acc[ai][bj][m][1];
                        u32x4 w; w.x = cvt_pk_bf16(v0[0], v0[1]); w.y = cvt_pk_bf16(v0[2], v0[3]); w.z = cvt_pk_bf16(v1[0], v1[1]); w.w = cvt_pk_bf16(v1[2], v1[3]);
                        *(u32x4*)(pb + (size_t)(ai * HALF + m * 16) * ldc + bj * HALF) = w; }
            return;
        }
#pragma unroll
        for (int ai = 0; ai < 2; ++ai)
#pragma unroll
            for (int m = 0; m < 4; ++m) { bf16_t* rowp = O + (size_t)(row0 + ai * HALF + m * 16) * ldc + col0;
#pragma unroll
                for (int bj = 0; bj < 2; ++bj) { const f32x4 v0 = acc[ai][bj][m][0], v1 = acc[ai][bj][m][1];
                    u32x4 w; w.x = cvt_pk_bf16(v0[0], v0[1]); w.y = cvt_pk_bf16(v0[2], v0[3]); w.z = cvt_pk_bf16(v1[0], v1[1]); w.w = cvt_pk_bf16(v1[2], v1[3]);
                    *(u32x4*)(rowp + bj * HALF) = w; } }
    }
};

template <class Epi, class Sched>
DEV void gemm_phase(LAS unsigned char* lds, const Gemm g, const Sched& S, const Epi& E) {
    int tid_ = threadIdx.x; asm volatile("" : "+v"(tid_)); const int tid = tid_, wid = __builtin_amdgcn_readfirstlane(tid >> 6), lane = tid & 63, wr = wid >> 2, wc = wid & 3, fr = lane & 15, fq = lane >> 4;
    const int K = g.K;
    unsigned voffA[2], voffB[2];
#pragma unroll
    for (int i = 0; i < 2; ++i) { int R, C; stage_rc(tid * 16 + i * 8192, R, C); const int Rb = Epi::PERM ? ((R & ~31) + perm32(R & 31)) : R;
        voffA[i] = (unsigned)(R * K + C) * 2u; voffB[i] = (unsigned)(Rb * K + C) * 2u; }
    const size_t kstep = (size_t)(BK * 2);
    const size_t hstep = (size_t)HALF * K * 2;
    const size_t tstep = 2 * hstep;
    const unsigned ldsw = (unsigned)wid * 1024u;
    const int aoff = lds_byte(wr * 64 + fr, fq * 8), boff = lds_byte(wc * 32 + fr, fq * 8);
#define PG8_SA(b, h) (((b) * 2 + (h)) * HTB)
#define PG8_SB(b, h) ((4 + (b) * 2 + (h)) * HTB)
#define PG8_STAGE(bufoff, gbase, voff) do { _Pragma("unroll") for (int _i = 0; _i < 2; ++_i) \
        __builtin_amdgcn_global_load_lds((const unsigned*)((const char*)(gbase) + (voff)[_i]), (LAS unsigned*)(lds + (bufoff) + ldsw + _i * 8192), 16, 0, 0); } while (0)
#define PG8_LDA(dst, b, h) do { _Pragma("unroll") for (int m = 0; m < 4; ++m) _Pragma("unroll") for (int k = 0; k < 2; ++k) dst[m][k] = *(const LAS bf16x8*)(lds + PG8_SA(b, h) + aoff + m * 2048 + k * 1024); } while (0)
#define PG8_LDB(dst, b, h) do { _Pragma("unroll") for (int n = 0; n < 2; ++n) _Pragma("unroll") for (int k = 0; k < 2; ++k) dst[n][k] = *(const LAS bf16x8*)(lds + PG8_SB(b, h) + boff + n * 2048 + k * 1024); } while (0)
#define PG8_MMA(ai, bj, At, Bt) do { __builtin_amdgcn_s_setprio(1); _Pragma("unroll") for (int m = 0; m < 4; ++m) _Pragma("unroll") for (int n = 0; n < 2; ++n) _Pragma("unroll") for (int k = 0; k < 2; ++k) \
        acc[ai][bj][m][n] = __builtin_amdgcn_mfma_f32_16x16x32_bf16(Bt[n][k], At[m][k], acc[ai][bj][m][n], 0, 0, 0); __builtin_amdgcn_s_setprio(0); } while (0)
#define PG8_WAIT_V(n) asm volatile("s_waitcnt vmcnt(" #n ")" ::: "memory")
#define PG8_WAIT_L(n) asm volatile("s_waitcnt lgkmcnt(" #n ")" ::: "memory")
#define PG8_BAR __builtin_amdgcn_s_barrier()
#define PG8_SCHED __builtin_amdgcn_sched_barrier(0)
    Unit cur, nxt; int ui = 0;
    if (!S.next(0, cur)) return;
    f32x4 acc[2][2][4][2];
#pragma unroll
    for (int a = 0; a < 2; ++a)
#pragma unroll
        for (int b = 0; b < 2; ++b)
#pragma unroll
            for (int m = 0; m < 4; ++m)
#pragma unroll
                for (int n = 0; n < 2; ++n) acc[a][b][m][n] = (f32x4){0.f, 0.f, 0.f, 0.f};
    bf16x8 At[4][2], B0[2][2], B1[2][2];
    const char* cA = (const char*)g.A + (size_t)cur.pm * tstep + (size_t)cur.k0 * 2; const char* cB = (const char*)g.Bt + (size_t)cur.pn * tstep + (size_t)cur.k0 * 2;
    PG8_STAGE(PG8_SB(0, 0), cB, voffB); PG8_STAGE(PG8_SA(0, 0), cA, voffA); PG8_STAGE(PG8_SB(0, 1), cB + hstep, voffB); PG8_STAGE(PG8_SA(0, 1), cA + hstep, voffA);
    if (wr == 1) PG8_BAR;
    PG8_WAIT_V(4); PG8_BAR;
    PG8_STAGE(PG8_SB(1, 0), cB + kstep, voffB); PG8_STAGE(PG8_SA(1, 0), cA + kstep, voffA); PG8_STAGE(PG8_SB(1, 1), cB + hstep + kstep, voffB);
    PG8_WAIT_V(6); PG8_BAR;
    for (;;) {
        const bool has_next = S.next(ui + 1, nxt);
        const char* nA = has_next ? (const char*)g.A + (size_t)nxt.pm * tstep + (size_t)nxt.k0 * 2 : cA; const char* nB = has_next ? (const char*)g.Bt + (size_t)nxt.pn * tstep + (size_t)nxt.k0 * 2 : cB;
        const int nt = cur.nt;
        for (int t = 0; t < nt; t += 2) {
            const bool last = (t == nt - 2);
            const char* a1 = cA + (size_t)(t + 1) * kstep;
            const char* a2 = last ? nA : cA + (size_t)(t + 2) * kstep; const char* b2 = last ? nB : cB + (size_t)(t + 2) * kstep;
            const char* a3 = a2 + kstep; const char* b3 = b2 + kstep;
            PG8_LDB(B0, 0, 0); PG8_SCHED; PG8_LDA(At, 0, 0); PG8_STAGE(PG8_SA(1, 1), a1 + hstep, voffA);
            PG8_WAIT_L(8); PG8_BAR; PG8_WAIT_L(0); PG8_MMA(0, 0, At, B0); PG8_BAR; PG8_SCHED;
            PG8_LDB(B1, 0, 1); PG8_STAGE(PG8_SB(0, 0), b2, voffB);
            PG8_BAR; PG8_WAIT_L(0); PG8_MMA(0, 1, At, B1); PG8_BAR;
            PG8_LDA(At, 0, 1); PG8_STAGE(PG8_SA(0, 0), a2, voffA);
            PG8_BAR; PG8_WAIT_L(0); PG8_MMA(1, 0, At, B0); PG8_BAR; PG8_SCHED;
            PG8_STAGE(PG8_SB(0, 1), b2 + hstep, voffB);
            PG8_WAIT_V(6); PG8_BAR; PG8_MMA(1, 1, At, B1); PG8_BAR;
            PG8_LDB(B0, 1, 0); PG8_SCHED; PG8_LDA(At, 1, 0); PG8_STAGE(PG8_SA(0, 1), a2 + hstep, voffA);
            PG8_WAIT_L(8); PG8_BAR; PG8_WAIT_L(0); PG8_MMA(0, 0, At, B0); PG8_BAR; PG8_SCHED;
            PG8_LDB(B1, 1, 1); PG8_STAGE(PG8_SB(1, 0), b3, voffB);
            PG8_BAR; PG8_WAIT_L(0); PG8_MMA(0, 1, At, B1); PG8_BAR;
            PG8_LDA(At, 1, 1); PG8_STAGE(PG8_SA(1, 0), a3, voffA);
            PG8_BAR; PG8_WAIT_L(0); PG8_MMA(1, 0, At, B0); PG8_BAR; PG8_SCHED;
            PG8_STAGE(PG8_SB(1, 1), b3 + hstep, voffB);
            PG8_WAIT_V(6); PG8_BAR; PG8_MMA(1, 1, At, B1); PG8_BAR;
        }
        E(acc, cur, wr, wc, fr, fq);
        if (!has_next) break;
#pragma unroll
        for (int a = 0; a < 2; ++a)
#pragma unroll
            for (int b = 0; b < 2; ++b)
#pragma unroll
                for (int m = 0; m < 4; ++m)
#pragma unroll
                    for (int n = 0; n < 2; ++n) acc[a][b][m][n] = (f32x4){0.f, 0.f, 0.f, 0.f};
        cur = nxt; cA = nA; cB = nB; ++ui;
    }
    PG8_WAIT_V(0);
    if (wr == 0) PG8_BAR;
    PG8_BAR;
#undef PG8_SA
#undef PG8_SB
#undef PG8_STAGE
#undef PG8_LDA
#undef PG8_LDB
#undef PG8_MMA
#undef PG8_WAIT_V
#undef PG8_WAIT_L
#undef PG8_BAR
#undef PG8_SCHED
}
}

DEV int win_srccol(int n) { return n < 4096 ? n : (n < 6656 ? n + 8 : (n < 6664 ? n - 2560 : (n < 6680 ? n : -1))); }
DEV void transpose_tile(const float* __restrict__ src, int srcN, bf16_t* __restrict__ dst, int K, int n0, int k0, int mode, float* tile) {
    int tid_ = threadIdx.x; asm volatile("" : "+v"(tid_)); const int tid = tid_;
    f32x4 v[4];
#pragma unroll
    for (int i = 0; i < 4; ++i) {
        const int kk = (tid >> 5) + 16 * i, nn4 = (tid & 31) * 4, n = n0 + nn4;
        const int sc = mode ? win_srccol(n) : n;
        v[i] = (f32x4){0.f, 0.f, 0.f, 0.f};
        if (sc >= 0) v[i] = __builtin_nontemporal_load((const f32x4*)(src + (size_t)(k0 + kk) * srcN + sc));
        if (mode && n >= 1024 && n < 2048) v[i] = v[i] * 0.0625f;
    }
#pragma unroll
    for (int i = 0; i < 4; ++i) {
        const int kk = (tid >> 5) + 16 * i, nn4 = (tid & 31) * 4;
        tile[kk * 129 + nn4 + 0] = v[i][0]; tile[kk * 129 + nn4 + 1] = v[i][1]; tile[kk * 129 + nn4 + 2] = v[i][2]; tile[kk * 129 + nn4 + 3] = v[i][3];
    }
    __syncthreads();
#pragma unroll
    for (int i = 0; i < 2; ++i) {
        const int ch = tid + 512 * i, nn = ch >> 3, kk8 = (ch & 7) * 8;
        u32x4 w;
        w.x = pk2(tile[(kk8 + 0) * 129 + nn], tile[(kk8 + 1) * 129 + nn]); w.y = pk2(tile[(kk8 + 2) * 129 + nn], tile[(kk8 + 3) * 129 + nn]);
        w.z = pk2(tile[(kk8 + 4) * 129 + nn], tile[(kk8 + 5) * 129 + nn]); w.w = pk2(tile[(kk8 + 6) * 129 + nn], tile[(kk8 + 7) * 129 + nn]);
        *(u32x4*)(dst + (size_t)(n0 + nn) * K + k0 + kk8) = w;
    }
    __syncthreads();
}
constexpr int T_WIN = (INP / 128) * (D / 64), T_WOUT = (D / 128) * (D / 64), T_WUP = (DFF2 / 128) * (D / 64), T_WDN = (D / 128) * (DFF / 64);
constexpr int T_L = T_WIN + T_WOUT + T_WUP + T_WDN, T_X = NTOK * D / 4096;
DEV void phase_prologue(const P& p, unsigned char* lds, int l_lo, int l_hi, bool with_x, int b0, int nb, int rlo = 0, int rhi = T_L) {
    float* tile = (float*)lds;
    const int cnt = rhi - rlo;
    const int nw = (l_hi - l_lo) * cnt, total = nw + (with_x ? T_X : 0);
    for (int u = b0; u < total; u += nb) {
        if (u < nw) {
            const int l = l_lo + u / cnt; int r = rlo + u % cnt;
            if (r < T_WIN) { const int nt = r / (D / 64), kt = r % (D / 64);
                transpose_tile(p.w_in + (size_t)l * D * IN_DIM, IN_DIM, (bf16_t*)(p.ws + WS_WIN) + (size_t)l * INP * D, D, nt * 128, kt * 64, 1, tile); }
            else if ((r -= T_WIN) < T_WOUT) { const int nt = r / (D / 64), kt = r % (D / 64);
                transpose_tile(p.w_out + (size_t)l * D * D, D, (bf16_t*)(p.ws + WS_WOUT) + (size_t)l * D * D, D, nt * 128, kt * 64, 0, tile); }
            else if ((r -= T_WOUT) < T_WUP) { const int nt = r / (D / 64), kt = r % (D / 64);
                transpose_tile(p.w_up + (size_t)l * D * DFF2, DFF2, (bf16_t*)(p.ws + WS_WUP) + (size_t)l * DFF2 * D, D, nt * 128, kt * 64, 0, tile); }
            else { r -= T_WUP; const int nt = r / (DFF / 64), kt = r % (DFF / 64);
                transpose_tile(p.w_down + (size_t)l * DFF * D, D, (bf16_t*)(p.ws + WS_WDN) + (size_t)l * D * DFF, DFF, nt * 128, kt * 64, 0, tile); }
        } else {
            const size_t e = (size_t)(u - nw) * 4096 + threadIdx.x * 8;
            const float* s = e < (size_t)NPR * D ? p.x_prompt + e : p.x_sample + (e - (size_t)NPR * D);
            const f32x4 a = *(const f32x4*)s, b = *(const f32x4*)(s + 4);
            u32x4 w; w.x = pk2(a[0], a[1]); w.y = pk2(a[2], a[3]); w.z = pk2(b[0], b[1]); w.w = pk2(b[2], b[3]);
            *(u32x4*)((bf16_t*)(p.ws + WS_XB) + e) = w;
        }
    }
}

DEV void mlstm_local(const P& p, int l, int unit, unsigned char* lds) {
    const int bh = unit >> 5, c = unit & 31, b = bh >> 2, h = bh & 3;
    int tid_ = threadIdx.x; asm volatile("" : "+v"(tid_)); const int tid = tid_, lane = tid & 63, w = tid >> 6, fr = lane & 15, fq = lane >> 4;
    const bf16_t* U = (const bf16_t*)(p.ws + WS_U) + (size_t)(b * 2048 + c * 64) * INP;
    float* wsh = (float*)lds;
    bf16_t* KW = (bf16_t*)(lds + 1024);
    bf16_t* V = KW + 64 * 272;
    float* gstat = (float*)(p.ws + WS_GSTAT);
    if (w == 0) {
        const float ig = bf2f(U[(size_t)lane * INP + UIG + h]) + p.b_i[l * 4 + h];
        const float lf = logsigf_(bf2f(U[(size_t)lane * INP + UFG + h]) + p.b_f[l * 4 + h]);
        const float bs = wave_incl_sum(lf, lane);
        const float a = ig - bs;
        const float amax = wave_max(a);
        const float bsum = __shfl(bs, 63);
        wsh[lane] = expf(a - amax);
        if (lane == 0) { gstat[(bh * 32 + c) * 2] = bsum; gstat[(bh * 32 + c) * 2 + 1] = bsum + amax; }
    }
    __syncthreads();
#pragma unroll
    for (int i = 0; i < 4; ++i) {
        const int it = tid + 512 * i, s_ = it >> 5, d8 = (it & 31) * 8;
        const uint4 kv = *(const uint4*)(U + (size_t)s_ * INP + UK + h * 256 + d8);
        const uint4 vv = *(const uint4*)(U + (size_t)s_ * INP + UV + h * 256 + d8);
        const float ws_ = wsh[s_];
        float kf[8]; unpack8(kv, kf);
        u32x4 kw; kw.x = pk2(kf[0] * ws_, kf[1] * ws_); kw.y = pk2(kf[2] * ws_, kf[3] * ws_); kw.z = pk2(kf[4] * ws_, kf[5] * ws_); kw.w = pk2(kf[6] * ws_, kf[7] * ws_);
        *(u32x4*)(KW + s_ * 272 + d8) = kw;
        *(uint4*)(V + s_ * 272 + d8) = vv;
    }
    __syncthreads();
    if (tid < 256) { float a = 0.f; for (int s_ = 0; s_ < 64; ++s_) a += bf2f(KW[s_ * 272 + tid]); ((float*)(p.ws + WS_NLOC))[(size_t)(bh * 32 + c) * 256 + tid] = a; }
    f32x4 acc[2][16];
#pragma unroll
    for (int m = 0; m < 2; ++m)
#pragma unroll
        for (int n = 0; n < 16; ++n) acc[m][n] = (f32x4){0.f, 0.f, 0.f, 0.f};
#pragma unroll
    for (int ks = 0; ks < 2; ++ks) {
        bf16x8 vf[2];
#pragma unroll
        for (int m = 0; m < 2; ++m) vf[m] = tr_frag(V, 272, 32 * ks, 32 * w + 16 * m, lane);
#pragma unroll
        for (int n = 0; n < 16; ++n) {
            const bf16x8 kf = tr_frag(KW, 272, 32 * ks, 16 * n, lane);
#pragma unroll
            for (int m = 0; m < 2; ++m) acc[m][n] = mfma16(kf, vf[m], acc[m][n]);
        }
    }
    bf16_t* Dp = (bf16_t*)(p.ws + WS_DBUF) + (size_t)(bh * 32 + c) * 65536;
#pragma unroll
    for (int m = 0; m < 2; ++m)
#pragma unroll
        for (int n = 0; n < 16; ++n) { u32x2 wv; wv.x = pk2(acc[m][n][0], acc[m][n][1]); wv.y = pk2(acc[m][n][2], acc[m][n][3]);
            *(u32x2*)(Dp + (32 * w + 16 * m + fr) * 256 + 16 * n + fq * 4) = wv; }
    __syncthreads();
}

DEV void mlstm_scan(const P& p, int l, int unit, unsigned char* lds) {
    int tid_ = threadIdx.x; asm volatile("" : "+v"(tid_)); const int bh = unit >> 4, slab = unit & 15, tid = tid_;
    float* fA = (float*)lds; float* fB = fA + 32;
    const float* gstat = (const float*)(p.ws + WS_GSTAT);
    if (tid == 0) {
        float m = 0.f;
        for (int c = 0; c < 32; ++c) {
            const float bsum = gstat[(bh * 32 + c) * 2], mloc = gstat[(bh * 32 + c) * 2 + 1];
            const float mn = fmaxf(bsum + m, mloc);
            fA[c] = expf(bsum + m - mn); fB[c] = expf(mloc - mn); m = mn;
            if (slab == 0) ((float*)(p.ws + WS_MST))[bh * 32 + c] = mn;
        }
        if (slab == 0) p.out[O_PM + l * 16 + bh] = m;
    }
    __syncthreads();
    const size_t e0 = (size_t)slab * 4096 + tid * 8;
    float run[8];
#pragma unroll
    for (int i = 0; i < 8; ++i) run[i] = 0.f;
    const bf16_t* Dp = (const bf16_t*)(p.ws + WS_DBUF) + (size_t)bh * 32 * 65536 + e0;
    bf16_t* Cp = (bf16_t*)(p.ws + WS_CT) + (size_t)bh * 32 * 65536 + e0;
#pragma unroll 1
    for (int cb = 0; cb < 32; cb += 8) {
        uint4 xx[8];
#pragma unroll
        for (int j = 0; j < 8; ++j) xx[j] = *(const uint4*)(Dp + (size_t)(cb + j) * 65536);
#pragma unroll
        for (int j = 0; j < 8; ++j) {
            const int c = cb + j;
            const float a = fA[c], bq = fB[c];
            float xf[8]; unpack8(xx[j], xf);
#pragma unroll
            for (int i = 0; i < 8; ++i) run[i] = a * run[i] + bq * xf[i];
            u32x4 wv; wv.x = pk2(run[0], run[1]); wv.y = pk2(run[2], run[3]); wv.z = pk2(run[4], run[5]); wv.w = pk2(run[6], run[7]);
            *(u32x4*)(Cp + (size_t)c * 65536) = wv;
        }
    }
    {
        float* o = p.out + O_PC + (size_t)(l * 16 + bh) * 65536;
        const int e = (int)(e0 >> 8), d0 = (int)(e0 & 255);
#pragma unroll
        for (int i = 0; i < 8; ++i) o[(d0 + i) * 256 + e] = run[i];
    }
    if (slab == 0 && tid < 256) {
        float r = 0.f;
        const float* nl = (const float*)(p.ws + WS_NLOC) + (size_t)bh * 32 * 256 + tid;
        float* ns = (float*)(p.ws + WS_NST) + (size_t)bh * 32 * 256 + tid;
        for (int c = 0; c < 32; ++c) { r = fA[c] * r + fB[c] * nl[c * 256]; ns[c * 256] = r; }
        p.out[O_PN + (size_t)(l * 16 + bh) * 256 + tid] = r;
    }
    __syncthreads();
}

DEV void ssd_scan(const P& p, int l, int unit, unsigned char* lds) {
    int tid_ = threadIdx.x; asm volatile("" : "+v"(tid_)); const int bhd = unit >> 2, slab = unit & 3, tid = tid_;
    float* dec = (float*)lds;
    if (tid < 32) dec[tid] = expf(((const float*)(p.ws + WS_SBSUM))[bhd * 32 + tid]);
    __syncthreads();
    const size_t e0 = (size_t)slab * 2048 + tid * 4;
    f32x4 run = (f32x4){0.f, 0.f, 0.f, 0.f};
    const bf16_t* Sp = (const bf16_t*)(p.ws + WS_SBUF) + (size_t)bhd * 32 * 8192 + e0;
    bf16_t* Tp = (bf16_t*)(p.ws + WS_ST) + (size_t)bhd * 32 * 8192 + e0;
#pragma unroll 1
    for (int cb = 0; cb < 32; cb += 8) {
        uint2 xx[8];
#pragma unroll
        for (int j = 0; j < 8; ++j) xx[j] = *(const uint2*)(Sp + (size_t)(cb + j) * 8192);
#pragma unroll
        for (int j = 0; j < 8; ++j) {
            run = run * dec[cb + j] + (f32x4){bflo(xx[j].x), bfhi(xx[j].x), bflo(xx[j].y), bfhi(xx[j].y)};
            u32x2 wv; wv.x = pk2(run[0], run[1]); wv.y = pk2(run[2], run[3]);
            *(u32x2*)(Tp + (size_t)(cb + j) * 8192) = wv;
        }
    }
    *(f32x4*)(p.out + O_PS + (size_t)(l * 64 + bhd) * 8192 + e0) = run;
    __syncthreads();
}

DEV void convstate_copy(const P& p, int l, int unit) {
    const bf16_t* Ub = (const bf16_t*)(p.ws + WS_U);
    int tid_ = threadIdx.x; asm volatile("" : "+v"(tid_));
    for (int i = tid_; i < 3 * 1536; i += NTHR) {
        const int j = i / 1536, ch = i % 1536;
        if (unit < 4) p.out[O_PSC + ((size_t)(l * 4 + unit) * 3 + j) * 1536 + ch] = bf2f(Ub[(size_t)(unit * 2048 + 2045 + j) * INP + UXS + ch]);
        else { const int b = unit - 4; p.out[O_SSC + ((size_t)(l * 128 + b) * 3 + j) * 1536 + ch] = bf2f(Ub[(size_t)(NPR + b * 8 + 5 + j) * INP + UXS + ch]); }
    }
}

DEV void mlstm_out(const P& p, int l, int unit, unsigned char* lds) {
    const int bh = unit >> 5, c = unit & 31, b = bh >> 2, h = bh & 3;
    int tid_ = threadIdx.x; asm volatile("" : "+v"(tid_)); const int tid = tid_, lane = tid & 63, w = tid >> 6, fr = lane & 15, fq = lane >> 4;
    const int r0 = b * 2048 + c * 64;
    const bf16_t* U = (const bf16_t*)(p.ws + WS_U) + (size_t)r0 * INP;
    bf16_t* Qs = (bf16_t*)lds;
    bf16_t* Ks = Qs + 64 * 264;
    bf16_t* V = Ks + 64 * 264;
    bf16_t* Ss = V + 64 * 272;
    float* fl = (float*)(lds + 113664);
    float* bsh = fl; float* ash = fl + 64; float* mth = fl + 128; float* wint = fl + 192; float* rdn = fl + 256; float* qn = fl + 320; float* nprev = fl + 384; float* red = fl + 640;
    float* stat = fl + 1152;
    if (w == 0) {
        const float ig = bf2f(U[(size_t)lane * INP + UIG + h]) + p.b_i[l * 4 + h];
        const float lf = logsigf_(bf2f(U[(size_t)lane * INP + UFG + h]) + p.b_f[l * 4 + h]);
        const float bs = wave_incl_sum(lf, lane);
        const float a = ig - bs;
        const float cm = wave_incl_max(a, lane);
        const float mprev = c > 0 ? ((const float*)(p.ws + WS_MST))[bh * 32 + c - 1] : 0.f;
        const float mt = bs + fmaxf(mprev, cm);
        bsh[lane] = bs; ash[lane] = a; mth[lane] = mt; wint[lane] = expf(bs + mprev - mt);
    }
    if (tid >= 256) { const int d = tid - 256; nprev[d] = c > 0 ? ((const float*)(p.ws + WS_NST))[(size_t)(bh * 32 + c - 1) * 256 + d] : 0.f; }
#pragma unroll
    for (int i = 0; i < 4; ++i) {
        const int it = tid + 512 * i, s_ = it >> 5, d8 = (it & 31) * 8;
        *(uint4*)(Qs + s_ * 264 + d8) = *(const uint4*)(U + (size_t)s_ * INP + UQ + h * 256 + d8);
        *(uint4*)(Ks + s_ * 264 + d8) = *(const uint4*)(U + (size_t)s_ * INP + UK + h * 256 + d8);
        *(uint4*)(V + s_ * 272 + d8) = *(const uint4*)(U + (size_t)s_ * INP + UV + h * 256 + d8);
    }
    __syncthreads();
    {
        const int mt_ = w >> 1, nt0 = (w & 1) * 2;
        f32x4 sacc[2] = {(f32x4){0.f, 0.f, 0.f, 0.f}, (f32x4){0.f, 0.f, 0.f, 0.f}};
#pragma unroll
        for (int k0 = 0; k0 < 256; k0 += 32) {
            const bf16x8 a = *(const bf16x8*)(Qs + (16 * mt_ + fr) * 264 + k0 + fq * 8);
#pragma unroll
            for (int n = 0; n < 2; ++n) { const bf16x8 bb = *(const bf16x8*)(Ks + (16 * (nt0 + n) + fr) * 264 + k0 + fq * 8); sacc[n] = mfma16(a, bb, sacc[n]); }
        }
#pragma unroll
        for (int n = 0; n < 2; ++n)
#pragma unroll
            for (int j = 0; j < 4; ++j) {
                const int t = 16 * mt_ + fq * 4 + j, s_ = 16 * (nt0 + n) + fr;
                const float val = (s_ <= t) ? sacc[n][j] * expf(bsh[t] - mth[t] + ash[s_]) : 0.f;
                Ss[t * 72 + s_] = f2bf(val);
            }
        const int t = tid >> 3, part = tid & 7;
        float a = 0.f;
        for (int d = part * 32; d < part * 32 + 32; ++d) a += bf2f(Qs[t * 264 + d]) * nprev[d];
        a += __shfl_xor(a, 1); a += __shfl_xor(a, 2); a += __shfl_xor(a, 4);
        if (part == 0) qn[t] = a;
    }
    __syncthreads();
    if (tid < 64) {
        float di = 0.f;
        for (int s_ = 0; s_ < 64; ++s_) di += bf2f(Ss[tid * 72 + s_]);
        const float den = di + wint[tid] * qn[tid];
        rdn[tid] = 1.0f / fmaxf(fabsf(den), expf(-mth[tid]));
    }
    const int e0 = 32 * w;
    f32x4 acc1[4][2], acc2[4][2];
#pragma unroll
    for (int m = 0; m < 4; ++m)
#pragma unroll
        for (int n = 0; n < 2; ++n) { acc1[m][n] = (f32x4){0.f, 0.f, 0.f, 0.f}; acc2[m][n] = (f32x4){0.f, 0.f, 0.f, 0.f}; }
#pragma unroll
    for (int ks = 0; ks < 2; ++ks) {
        bf16x8 sf[4];
#pragma unroll
        for (int m = 0; m < 4; ++m) sf[m] = *(const bf16x8*)(Ss + (16 * m + fr) * 72 + 32 * ks + fq * 8);
#pragma unroll
        for (int n = 0; n < 2; ++n) { const bf16x8 vf = tr_frag(V, 272, 32 * ks, e0 + 16 * n, lane);
#pragma unroll
            for (int m = 0; m < 4; ++m) acc1[m][n] = mfma16(vf, sf[m], acc1[m][n]); }
    }
    if (c > 0) {
        const bf16_t* CTp = (const bf16_t*)(p.ws + WS_CT) + (size_t)(bh * 32 + c - 1) * 65536;
#pragma unroll 2
        for (int k0 = 0; k0 < 256; k0 += 32) {
            bf16x8 a[4];
#pragma unroll
            for (int m = 0; m < 4; ++m) a[m] = *(const bf16x8*)(Qs + (16 * m + fr) * 264 + k0 + fq * 8);
#pragma unroll
            for (int n = 0; n < 2; ++n) { const bf16x8 cf = *(const bf16x8*)(CTp + (size_t)(e0 + 16 * n + fr) * 256 + k0 + fq * 8);
#pragma unroll
                for (int m = 0; m < 4; ++m) acc2[m][n] = mfma16(cf, a[m], acc2[m][n]); }
        }
    }
    __syncthreads();
#pragma unroll
    for (int m = 0; m < 4; ++m) {
        const int t = 16 * m + fr;
        const float wi = wint[t], rd = rdn[t];
        float sm = 0.f;
#pragma unroll
        for (int n = 0; n < 2; ++n)
#pragma unroll
            for (int j = 0; j < 4; ++j) { const float hv = (acc1[m][n][j] + wi * acc2[m][n][j]) * rd; acc1[m][n][j] = hv; sm += hv; }
        sm += __shfl_xor(sm, 16); sm += __shfl_xor(sm, 32);
        if (fq == 0) red[t * 8 + w] = sm;
    }
    __syncthreads();
    if (tid < 64) { float sm = 0.f;
#pragma unroll
        for (int i = 0; i < 8; ++i) sm += red[tid * 8 + i];
        stat[tid] = sm * (1.0f / 256.0f); }
    __syncthreads();
#pragma unroll
    for (int m = 0; m < 4; ++m) {
        const int t = 16 * m + fr;
        const float mu = stat[t];
        float sm = 0.f;
#pragma unroll
        for (int n = 0; n < 2; ++n)
#pragma unroll
            for (int j = 0; j < 4; ++j) { const float dv = acc1[m][n][j] - mu; acc1[m][n][j] = dv; sm += dv * dv; }
        sm += __shfl_xor(sm, 16); sm += __shfl_xor(sm, 32);
        if (fq == 0) red[t * 8 + w] = sm;
    }
    __syncthreads();
    if (tid < 64) { float sm = 0.f;
#pragma unroll
        for (int i = 0; i < 8; ++i) sm += red[tid * 8 + i];
        stat[64 + tid] = rsqrtf(sm * (1.0f / 256.0f) + 1e-6f); }
    __syncthreads();
    bf16_t* MX = (bf16_t*)(p.ws + WS_MIXIN);
#pragma unroll
    for (int m = 0; m < 4; ++m) {
        const int t = 16 * m + fr;
        const float rs = stat[64 + t];
#pragma unroll
        for (int n = 0; n < 2; ++n) {
            const int e4 = e0 + 16 * n + fq * 4;
            const uint2 ov = *(const uint2*)(U + (size_t)t * INP + UO + h * 256 + e4);
            const f32x4 nw = *(const f32x4*)(p.m_norm_w + l * 1024 + h * 256 + e4);
            u32x2 wv;
            wv.x = pk2(acc1[m][n][0] * rs * nw[0] * sigmoidf_(bflo(ov.x)), acc1[m][n][1] * rs * nw[1] * sigmoidf_(bfhi(ov.x)));
            wv.y = pk2(acc1[m][n][2] * rs * nw[2] * sigmoidf_(bflo(ov.y)), acc1[m][n][3] * rs * nw[3] * sigmoidf_(bfhi(ov.y)));
            *(u32x2*)(MX + (size_t)(r0 + t) * D + h * 256 + e4) = wv;
        }
    }
    __syncthreads();
}

DEV void ssd_conv8(const bf16_t* Urow, int tpos, const float* cw, const float* cb, int ch8, float (&o)[8]) {
    const f32x4 b0 = *(const f32x4*)(cb + ch8), b1 = *(const f32x4*)(cb + ch8 + 4);
    o[0] = b0[0]; o[1] = b0[1]; o[2] = b0[2]; o[3] = b0[3]; o[4] = b1[0]; o[5] = b1[1]; o[6] = b1[2]; o[7] = b1[3];
#pragma unroll
    for (int j = 0; j < 4; ++j) {
        const int back = 3 - j;
        if (tpos - back >= 0) {
            const uint4 x = *(const uint4*)(Urow - (size_t)back * INP + UXS + ch8);
            float xf[8]; unpack8(x, xf);
            const f32x4 w0 = *(const f32x4*)(cw + j * 1536 + ch8), w1 = *(const f32x4*)(cw + j * 1536 + ch8 + 4);
            o[0] += w0[0] * xf[0]; o[1] += w0[1] * xf[1]; o[2] += w0[2] * xf[2]; o[3] += w0[3] * xf[3];
            o[4] += w1[0] * xf[4]; o[5] += w1[1] * xf[5]; o[6] += w1[2] * xf[6]; o[7] += w1[3] * xf[7];
        }
    }
#pragma unroll
    for (int i = 0; i < 8; ++i) o[i] = siluf_(o[i]);
}

DEV void ssd_local(const P& p, int l, int unit, unsigned char* lds) {
    const int b = unit >> 6, g = (unit >> 5) & 1, c = unit & 31;
    int tid_ = threadIdx.x; asm volatile("" : "+v"(tid_)); const int tid = tid_, lane = tid & 63, w = tid >> 6, fr = lane & 15, fq = lane >> 4;
    const int r0 = b * 2048 + c * 64;
    const bf16_t* U = (const bf16_t*)(p.ws + WS_U) + (size_t)r0 * INP;
    bf16_t* XW = (bf16_t*)lds;
    bf16_t* Bmn = XW + 64 * 528;
    float* wsh = (float*)(lds + 86016);
    {
        const int head = g * 8 + w;
        const float dt = softplusf_(bf2f(U[(size_t)lane * INP + UDT + head]) + p.dt_bias[l * 16 + head]);
        const float a = -expf(p.A_log[l * 16 + head]) * dt;
        const float bs = wave_incl_sum(a, lane);
        const float bL = __shfl(bs, 63);
        wsh[w * 64 + lane] = expf(bL - bs) * dt;
        if (lane == 0) ((float*)(p.ws + WS_SBSUM))[(b * 16 + head) * 32 + c] = bL;
    }
    __syncthreads();
    const float* cw = p.s_conv_w + (size_t)l * 4 * 1536; const float* cb = p.s_conv_b + (size_t)l * 1536;
    bf16_t* XBC = (bf16_t*)(p.ws + WS_XBC) + (size_t)r0 * 1536;
    for (int i = 0; i < 12; ++i) {
        const int it = tid + 512 * i, t = it / 96, gidx = it % 96;
        const int ch8 = gidx < 64 ? g * 512 + gidx * 8 : (gidx < 80 ? 1024 + g * 128 + (gidx - 64) * 8 : 1280 + g * 128 + (gidx - 80) * 8);
        float v[8];
        ssd_conv8(U + (size_t)t * INP, c * 64 + t, cw, cb, ch8, v);
        { u32x4 wr_; wr_.x = pk2(v[0], v[1]); wr_.y = pk2(v[2], v[3]); wr_.z = pk2(v[4], v[5]); wr_.w = pk2(v[6], v[7]); *(u32x4*)(XBC + (size_t)t * 1536 + ch8) = wr_; }
        if (gidx >= 80) continue;
        if (gidx < 64) { const float sc = wsh[(gidx >> 3) * 64 + t];
            u32x4 wv; wv.x = pk2(v[0] * sc, v[1] * sc); wv.y = pk2(v[2] * sc, v[3] * sc); wv.z = pk2(v[4] * sc, v[5] * sc); wv.w = pk2(v[6] * sc, v[7] * sc);
            *(u32x4*)(XW + t * 528 + gidx * 8) = wv; }
        else { u32x4 wv; wv.x = pk2(v[0], v[1]); wv.y = pk2(v[2], v[3]); wv.z = pk2(v[4], v[5]); wv.w = pk2(v[6], v[7]);
            *(u32x4*)(Bmn + t * 144 + (gidx - 64) * 8) = wv; }
    }
    __syncthreads();
    f32x4 acc[4][8];
#pragma unroll
    for (int m = 0; m < 4; ++m)
#pragma unroll
        for (int n = 0; n < 8; ++n) acc[m][n] = (f32x4){0.f, 0.f, 0.f, 0.f};
#pragma unroll
    for (int ks = 0; ks < 2; ++ks) {
        bf16x8 xf[4];
#pragma unroll
        for (int m = 0; m < 4; ++m) xf[m] = tr_frag(XW, 528, 32 * ks, 64 * w + 16 * m, lane);
#pragma unroll
        for (int n = 0; n < 8; ++n) { const bf16x8 bf_ = tr_frag(Bmn, 144, 32 * ks, 16 * n, lane);
#pragma unroll
            for (int m = 0; m < 4; ++m) acc[m][n] = mfma16(bf_, xf[m], acc[m][n]); }
    }
    bf16_t* Sp = (bf16_t*)(p.ws + WS_SBUF) + (size_t)((b * 16 + g * 8 + w) * 32 + c) * 8192;
#pragma unroll
    for (int m = 0; m < 4; ++m)
#pragma unroll
        for (int n = 0; n < 8; ++n) { u32x2 wv; wv.x = pk2(acc[m][n][0], acc[m][n][1]); wv.y = pk2(acc[m][n][2], acc[m][n][3]); *(u32x2*)(Sp + (16 * m + fr) * 128 + 16 * n + fq * 4) = wv; }
    __syncthreads();
}

DEV void ssd_out(const P& p, int l, int unit, unsigned char* lds) {
    const int b = unit >> 6, g = (unit >> 5) & 1, c = unit & 31;
    int tid_ = threadIdx.x; asm volatile("" : "+v"(tid_)); const int tid = tid_, lane = tid & 63, w = tid >> 6, fr = lane & 15, fq = lane >> 4;
    const int r0 = b * 2048 + c * 64;
    const bf16_t* U = (const bf16_t*)(p.ws + WS_U) + (size_t)r0 * INP;
    bf16_t* Xs = (bf16_t*)lds;
    bf16_t* Bm = Xs + 64 * 528;
    bf16_t* Cm = Bm + 64 * 136;
    float* CB = (float*)(lds + 102400);
    float* bsh = (float*)(lds + 119808);
    float* dtsh = bsh + 512;
    float* red = dtsh + 512;
    float* stat = red + 512;
    const int head = g * 8 + w;
    {
        const float dt = softplusf_(bf2f(U[(size_t)lane * INP + UDT + head]) + p.dt_bias[l * 16 + head]);
        const float a = -expf(p.A_log[l * 16 + head]) * dt;
        const float bs = wave_incl_sum(a, lane);
        bsh[w * 64 + lane] = bs; dtsh[w * 64 + lane] = dt;
    }
    const bf16_t* XBC = (const bf16_t*)(p.ws + WS_XBC) + (size_t)r0 * 1536;
#pragma unroll
    for (int i = 0; i < 12; ++i) {
        const int it = tid + 512 * i, t = it / 96, gidx = it % 96;
        const int ch8 = gidx < 64 ? g * 512 + gidx * 8 : (gidx < 80 ? 1024 + g * 128 + (gidx - 64) * 8 : 1280 + g * 128 + (gidx - 80) * 8);
        const u32x4 wv = *(const u32x4*)(XBC + (size_t)t * 1536 + ch8);
        if (gidx < 64) *(u32x4*)(Xs + t * 528 + gidx * 8) = wv;
        else if (gidx < 80) *(u32x4*)(Bm + t * 136 + (gidx - 64) * 8) = wv;
        else *(u32x4*)(Cm + t * 136 + (gidx - 80) * 8) = wv;
    }
    __syncthreads();
    {
        const int mt_ = w >> 1, nt0 = (w & 1) * 2;
        f32x4 cacc[2] = {(f32x4){0.f, 0.f, 0.f, 0.f}, (f32x4){0.f, 0.f, 0.f, 0.f}};
#pragma unroll
        for (int k0 = 0; k0 < 128; k0 += 32) {
            const bf16x8 a = *(const bf16x8*)(Cm + (16 * mt_ + fr) * 136 + k0 + fq * 8);
#pragma unroll
            for (int n = 0; n < 2; ++n) { const bf16x8 bb = *(const bf16x8*)(Bm + (16 * (nt0 + n) + fr) * 136 + k0 + fq * 8); cacc[n] = mfma16(a, bb, cacc[n]); }
        }
#pragma unroll
        for (int n = 0; n < 2; ++n)
#pragma unroll
            for (int j = 0; j < 4; ++j) CB[(16 * mt_ + fq * 4 + j) * 68 + 16 * (nt0 + n) + fr] = cacc[n][j];
    }
    __syncthreads();
    f32x4 acc1[4][4], acc2[4][4];
#pragma unroll
    for (int m = 0; m < 4; ++m)
#pragma unroll
        for (int n = 0; n < 4; ++n) { acc1[m][n] = (f32x4){0.f, 0.f, 0.f, 0.f}; acc2[m][n] = (f32x4){0.f, 0.f, 0.f, 0.f}; }
#pragma unroll
    for (int ks = 0; ks < 2; ++ks) {
        bf16x8 xf[4];
#pragma unroll
        for (int n = 0; n < 4; ++n) xf[n] = tr_frag(Xs, 528, 32 * ks, 64 * w + 16 * n, lane);
#pragma unroll
        for (int m = 0; m < 4; ++m) {
            if (ks * 32 > 16 * m + 15) continue;
            const int t = 16 * m + fr, s0 = 32 * ks + fq * 8;
            const float bt = bsh[w * 64 + t];
            const f32x4 c0 = *(const f32x4*)(CB + t * 68 + s0), c1 = *(const f32x4*)(CB + t * 68 + s0 + 4);
            float mv[8];
#pragma unroll
            for (int i = 0; i < 8; ++i) { const int s_ = s0 + i; const float cv = i < 4 ? c0[i & 3] : c1[i & 3];
                mv[i] = (s_ <= t) ? cv * expf(bt - bsh[w * 64 + s_]) * dtsh[w * 64 + s_] : 0.f; }
            union { u32x4 u; bf16x8 v; } af;
            af.u.x = pk2(mv[0], mv[1]); af.u.y = pk2(mv[2], mv[3]); af.u.z = pk2(mv[4], mv[5]); af.u.w = pk2(mv[6], mv[7]);
#pragma unroll
            for (int n = 0; n < 4; ++n) acc1[m][n] = mfma16(xf[n], af.v, acc1[m][n]);
        }
    }
    if (c > 0) {
        const bf16_t* STp = (const bf16_t*)(p.ws + WS_ST) + (size_t)((b * 16 + head) * 32 + c - 1) * 8192;
#pragma unroll
        for (int k0 = 0; k0 < 128; k0 += 32) {
            bf16x8 a[4];
#pragma unroll
            for (int m = 0; m < 4; ++m) a[m] = *(const bf16x8*)(Cm + (16 * m + fr) * 136 + k0 + fq * 8);
#pragma unroll
            for (int n = 0; n < 4; ++n) { const bf16x8 sf = *(const bf16x8*)(STp + (16 * n + fr) * 128 + k0 + fq * 8);
#pragma unroll
                for (int m = 0; m < 4; ++m) acc2[m][n] = mfma16(sf, a[m], acc2[m][n]); }
        }
    }
    const float dsk = p.D_skip[l * 16 + head];
#pragma unroll
    for (int m = 0; m < 4; ++m) {
        const int t = 16 * m + fr;
        const float eb = expf(bsh[w * 64 + t]);
        float sm = 0.f;
#pragma unroll
        for (int n = 0; n < 4; ++n) {
            const int pp4 = 16 * n + fq * 4;
            const uint2 xv = *(const uint2*)(Xs + t * 528 + 64 * w + pp4);
            const uint2 zv = *(const uint2*)(U + (size_t)t * INP + UZ + g * 512 + w * 64 + pp4);
            const float xs4[4] = {bflo(xv.x), bfhi(xv.x), bflo(xv.y), bfhi(xv.y)};
            const float z4[4] = {bflo(zv.x), bfhi(zv.x), bflo(zv.y), bfhi(zv.y)};
#pragma unroll
            for (int j = 0; j < 4; ++j) {
                const float y = acc1[m][n][j] + eb * acc2[m][n][j] + dsk * xs4[j];
                const float gt = y * z4[j] * sigmoidf_(z4[j]);
                acc1[m][n][j] = gt; sm += gt * gt;
            }
        }
        sm += __shfl_xor(sm, 16); sm += __shfl_xor(sm, 32);
        if (fq == 0) red[t * 8 + w] = sm;
    }
    __syncthreads();
    if (tid < 64) { float sm = 0.f;
#pragma unroll
        for (int i = 0; i < 8; ++i) sm += red[tid * 8 + i];
        stat[tid] = rsqrtf(sm * (1.0f / 512.0f) + 1e-6f); }
    __syncthreads();
    bf16_t* MX = (bf16_t*)(p.ws + WS_MIXIN);
#pragma unroll
    for (int m = 0; m < 4; ++m) {
        const int t = 16 * m + fr;
        const float rs = stat[t];
#pragma unroll
        for (int n = 0; n < 4; ++n) {
            const int ch = g * 512 + w * 64 + 16 * n + fq * 4;
            const f32x4 nw = *(const f32x4*)(p.s_norm_w + l * 1024 + ch);
            u32x2 wv; wv.x = pk2(acc1[m][n][0] * rs * nw[0], acc1[m][n][1] * rs * nw[1]); wv.y = pk2(acc1[m][n][2] * rs * nw[2], acc1[m][n][3] * rs * nw[3]);
            *(u32x2*)(MX + (size_t)(r0 + t) * D + 1024 + ch) = wv;
        }
    }
    __syncthreads();
}

DEV void smp_mlstm(const P& p, int l, int unit, unsigned char* lds) {
    const int b = unit >> 2, h = unit & 3;
    int tid_ = threadIdx.x; asm volatile("" : "+v"(tid_)); const int tid = tid_, lane = tid & 63, w = tid >> 6;
    const int r0 = NPR + b * 8;
    const bf16_t* U = (const bf16_t*)(p.ws + WS_U) + (size_t)r0 * INP;
    float* qn = (float*)lds; float* kn = qn + 2048; float* vn = kn + 2048; float* qT = vn + 2048; float* kwT = qT + 2048; float* sc = kwT + 2048; float* red = sc + 256;
    const size_t sidx = (size_t)(l * 128 + b) * 4 + h;
    const float* C0 = p.st_C + sidx * 65536; const float* n0 = p.st_n + sidx * 256;
    float* Cout = p.out + O_SC + sidx * 65536;
    if (tid == 0) {
        const float m0 = p.st_m[sidx];
        float bs = 0.f, cm = -INFINITY, mt = 0.f;
        for (int t = 0; t < 8; ++t) {
            const float ig = bf2f(U[(size_t)t * INP + UIG + h]) + p.b_i[l * 4 + h];
            const float lf = logsigf_(bf2f(U[(size_t)t * INP + UFG + h]) + p.b_f[l * 4 + h]);
            bs += lf; const float a = ig - bs; cm = fmaxf(cm, a); mt = bs + fmaxf(m0, cm);
            sc[32 + t] = mt; sc[t] = expf(bs + m0 - mt); sc[40 + t] = a; sc[48 + t] = bs;
        }
        for (int s = 0; s < 8; ++s) sc[16 + s] = expf(bs + sc[40 + s] - mt);
        sc[24] = expf(bs + m0 - mt);
        p.out[O_SM + sidx] = mt;
    }
    __syncthreads();
#pragma unroll
    for (int i = 0; i < 4; ++i) {
        const int idx = tid + 512 * i, t = idx >> 8, d = idx & 255;
        const float q = bf2f(U[(size_t)t * INP + UQ + h * 256 + d]), k = bf2f(U[(size_t)t * INP + UK + h * 256 + d]), v = bf2f(U[(size_t)t * INP + UV + h * 256 + d]);
        qn[t * 256 + d] = q; kn[t * 256 + d] = k; vn[t * 256 + d] = v; qT[d * 8 + t] = q; kwT[d * 8 + t] = k * sc[16 + t];
    }
    __syncthreads();
    {
        const int t = w;
        const f32x4 qv = *(const f32x4*)(qn + t * 256 + lane * 4);
        float dot[9];
#pragma unroll
        for (int s = 0; s < 8; ++s) { const f32x4 kv = *(const f32x4*)(kn + s * 256 + lane * 4); dot[s] = qv[0] * kv[0] + qv[1] * kv[1] + qv[2] * kv[2] + qv[3] * kv[3]; }
        { const f32x4 nv = *(const f32x4*)(n0 + lane * 4); dot[8] = qv[0] * nv[0] + qv[1] * nv[1] + qv[2] * nv[2] + qv[3] * nv[3]; }
#pragma unroll
        for (int s = 0; s < 9; ++s) dot[s] = wave_sum(dot[s]);
        float den = 0.f;
#pragma unroll
        for (int s = 0; s < 8; ++s) { const float sv = (s <= t) ? dot[s] * expf(sc[48 + t] - sc[32 + t] + sc[40 + s]) : 0.f; den += sv; if (lane == 0) sc[64 + t * 8 + s] = sv; }
        den += sc[t] * dot[8];
        if (lane == 0) sc[8 + t] = 1.0f / fmaxf(fabsf(den), expf(-sc[32 + t]));
    }
    if (tid < 256) {
        float a = sc[24] * n0[tid];
#pragma unroll
        for (int s = 0; s < 8; ++s) a += kwT[tid * 8 + s];
        p.out[O_SN + sidx * 256 + tid] = a;
    }
    const int e4 = lane * 4;
    f32x4 num[8], vv[8];
#pragma unroll
    for (int t = 0; t < 8; ++t) { num[t] = (f32x4){0.f, 0.f, 0.f, 0.f}; vv[t] = *(const f32x4*)(vn + t * 256 + e4); }
    const float decay = sc[24];
    {
        f32x4 cn_[8];
#pragma unroll
        for (int j = 0; j < 8; ++j) cn_[j] = __builtin_nontemporal_load((const f32x4*)(C0 + (size_t)(w + 8 * j) * 256 + e4));
#pragma unroll 1
        for (int ib = 0; ib < 4; ++ib) {
            f32x4 cc[8];
#pragma unroll
            for (int j = 0; j < 8; ++j) cc[j] = cn_[j];
            if (ib < 3) {
#pragma unroll
                for (int j = 0; j < 8; ++j) cn_[j] = __builtin_nontemporal_load((const f32x4*)(C0 + (size_t)(w + 8 * ((ib + 1) * 8 + j)) * 256 + e4));
            }
#pragma unroll
            for (int j = 0; j < 8; ++j) {
                const int d = w + 8 * (ib * 8 + j);
                const f32x4 q0 = *(const f32x4*)(qT + d * 8), q1 = *(const f32x4*)(qT + d * 8 + 4), k0 = *(const f32x4*)(kwT + d * 8), k1 = *(const f32x4*)(kwT + d * 8 + 4);
                f32x4 cn = cc[j] * decay;
#pragma unroll
                for (int t = 0; t < 4; ++t) { num[t] += cc[j] * q0[t]; num[4 + t] += cc[j] * q1[t]; cn += vv[t] * k0[t]; cn += vv[4 + t] * k1[t]; }
                __builtin_nontemporal_store(cn, (f32x4*)(Cout + (size_t)d * 256 + e4));
            }
        }
    }
#pragma unroll
    for (int t = 0; t < 8; ++t) *(f32x4*)(red + (w * 8 + t) * 256 + e4) = num[t];
    __syncthreads();
    {
        const int t = w;
        f32x4 hv = (f32x4){0.f, 0.f, 0.f, 0.f};
#pragma unroll
        for (int ww = 0; ww < 8; ++ww) hv += *(const f32x4*)(red + (ww * 8 + t) * 256 + e4);
        hv = hv * sc[t];
#pragma unroll
        for (int s = 0; s < 8; ++s) hv += vv[s] * sc[64 + t * 8 + s];
        hv = hv * sc[8 + t];
        const float mu = wave_sum(hv[0] + hv[1] + hv[2] + hv[3]) * (1.0f / 256.0f);
        const f32x4 dv = hv - mu;
        const float var = wave_sum(dv[0] * dv[0] + dv[1] * dv[1] + dv[2] * dv[2] + dv[3] * dv[3]) * (1.0f / 256.0f);
        const float rs = rsqrtf(var + 1e-6f);
        const uint2 ov = *(const uint2*)(U + (size_t)t * INP + UO + h * 256 + e4);
        const f32x4 nw = *(const f32x4*)(p.m_norm_w + l * 1024 + h * 256 + e4);
        const float o0 = dv[0] * rs * nw[0] * sigmoidf_(bflo(ov.x)), o1 = dv[1] * rs * nw[1] * sigmoidf_(bfhi(ov.x));
        const float o2 = dv[2] * rs * nw[2] * sigmoidf_(bflo(ov.y)), o3 = dv[3] * rs * nw[3] * sigmoidf_(bfhi(ov.y));
        u32x2 wv; wv.x = pk2(o0, o1); wv.y = pk2(o2, o3);
        *(u32x2*)((bf16_t*)(p.ws + WS_MIXIN) + (size_t)(r0 + t) * D + h * 256 + e4) = wv;
    }
    __syncthreads();
}

DEV void smp_ssd(const P& p, int l, int unit, unsigned char* lds) {
    const int b = unit >> 1, g = unit & 1;
    int tid_ = threadIdx.x; asm volatile("" : "+v"(tid_)); const int tid = tid_, lane = tid & 63, w = tid >> 6, fr = lane & 15, fq = lane >> 4;
    const int r0 = NPR + b * 8;
    const bf16_t* U = (const bf16_t*)(p.ws + WS_U) + (size_t)r0 * INP;
    float* xs = (float*)lds;
    float* xwT = xs + 4096;
    float* Bmf = xwT + 4096;
    float* CBs = Bmf + 1024;
    float* bsh = CBs + 64;
    float* dtsh = bsh + 64;
    float* bLs = dtsh + 64;
    float* MW = bLs + 64;
    float* red = MW + 512;
    float* stat = red + 64;
    bf16_t* Cmb = (bf16_t*)(stat + 64);
    if (tid < 64) {
        const int hd = tid >> 3, t = tid & 7, head = g * 8 + hd;
        const float A = -expf(p.A_log[l * 16 + head]), dtb = p.dt_bias[l * 16 + head];
        float bs = 0.f, bL = 0.f, dtt = 0.f;
        for (int s = 0; s < 8; ++s) { const float dt = softplusf_(bf2f(U[(size_t)s * INP + UDT + head]) + dtb); bL += dt * A; if (s <= t) bs += dt * A; if (s == t) dtt = dt; }
        bsh[hd * 8 + t] = bs; dtsh[hd * 8 + t] = dtt; if (t == 0) bLs[hd] = bL;
    }
    for (int i = tid; i < 8 * 136 / 2; i += NTHR) ((unsigned*)(Cmb + 8 * 136))[i] = 0u;
    const float* cw = p.s_conv_w + (size_t)l * 4 * 1536; const float* cb = p.s_conv_b + (size_t)l * 1536;
    const float* cv0 = p.st_sconv + (size_t)(l * 128 + b) * 3 * 1536;
    for (int i = 0; i < 2; ++i) {
        const int it = tid + 512 * i;
        if (it < 768) {
            const int t = it / 96, gidx = it % 96;
            const int ch8 = gidx < 64 ? g * 512 + gidx * 8 : (gidx < 80 ? 1024 + g * 128 + (gidx - 64) * 8 : 1280 + g * 128 + (gidx - 80) * 8);
            float o[8];
            { const f32x4 b0 = *(const f32x4*)(cb + ch8), b1 = *(const f32x4*)(cb + ch8 + 4); o[0] = b0[0]; o[1] = b0[1]; o[2] = b0[2]; o[3] = b0[3]; o[4] = b1[0]; o[5] = b1[1]; o[6] = b1[2]; o[7] = b1[3]; }
#pragma unroll
            for (int j = 0; j < 4; ++j) {
                const int idx = t + j;
                float xf[8];
                if (idx < 3) { const f32x4 a0 = *(const f32x4*)(cv0 + idx * 1536 + ch8), a1 = *(const f32x4*)(cv0 + idx * 1536 + ch8 + 4);
                    xf[0] = a0[0]; xf[1] = a0[1]; xf[2] = a0[2]; xf[3] = a0[3]; xf[4] = a1[0]; xf[5] = a1[1]; xf[6] = a1[2]; xf[7] = a1[3]; }
                else { const uint4 x = *(const uint4*)(U + (size_t)(idx - 3) * INP + UXS + ch8); unpack8(x, xf); }
                const f32x4 w0 = *(const f32x4*)(cw + j * 1536 + ch8), w1 = *(const f32x4*)(cw + j * 1536 + ch8 + 4);
                o[0] += w0[0] * xf[0]; o[1] += w0[1] * xf[1]; o[2] += w0[2] * xf[2]; o[3] += w0[3] * xf[3];
                o[4] += w1[0] * xf[4]; o[5] += w1[1] * xf[5]; o[6] += w1[2] * xf[6]; o[7] += w1[3] * xf[7];
            }
#pragma unroll
            for (int k = 0; k < 8; ++k) o[k] = siluf_(o[k]);
            if (gidx < 64) {
#pragma unroll
                for (int k = 0; k < 8; ++k) xs[t * 512 + gidx * 8 + k] = o[k]; }
            else if (gidx < 80) {
#pragma unroll
                for (int k = 0; k < 8; ++k) Bmf[t * 128 + (gidx - 64) * 8 + k] = o[k]; }
            else { u32x4 wv; wv.x = pk2(o[0], o[1]); wv.y = pk2(o[2], o[3]); wv.z = pk2(o[4], o[5]); wv.w = pk2(o[6], o[7]); *(u32x4*)(Cmb + t * 136 + (gidx - 80) * 8) = wv; }
        }
    }
    __syncthreads();
#pragma unroll
    for (int i = 0; i < 8; ++i) {
        const int idx = tid + 512 * i, hp = idx >> 3, s = idx & 7, hd = hp >> 6;
        xwT[hp * 8 + s] = xs[s * 512 + hp] * expf(bLs[hd] - bsh[hd * 8 + s]) * dtsh[hd * 8 + s];
    }
    if (tid < 64) {
        const int t = tid >> 3, s = tid & 7; float a = 0.f;
        for (int n = 0; n < 128; ++n) a += bf2f(Cmb[t * 136 + n]) * Bmf[s * 128 + n];
        CBs[t * 8 + s] = a;
    }
    __syncthreads();
    { const int hd = tid >> 6, t = (tid >> 3) & 7, s = tid & 7;
      MW[tid] = (s <= t) ? CBs[t * 8 + s] * expf(bsh[hd * 8 + t] - bsh[hd * 8 + s]) * dtsh[hd * 8 + s] : 0.f; }
    __syncthreads();
    const int head = g * 8 + w;
    const size_t sidx = (size_t)(l * 128 + b) * 16 + head;
    const float* S0 = p.st_ssm + sidx * 8192; float* So = p.out + O_SS + sidx * 8192;
    const float dA = expf(bLs[w]);
    f32x4 acc[4];
    f32x4 svn[4][2];
#pragma unroll
    for (int ks = 0; ks < 4; ++ks) { svn[ks][0] = __builtin_nontemporal_load((const f32x4*)(S0 + fr * 128 + 32 * ks + fq * 8)); svn[ks][1] = __builtin_nontemporal_load((const f32x4*)(S0 + fr * 128 + 32 * ks + fq * 8 + 4)); }
#pragma unroll
    for (int nt = 0; nt < 4; ++nt) {
        acc[nt] = (f32x4){0.f, 0.f, 0.f, 0.f};
        const int pp = 16 * nt + fr;
        const f32x4 xw0 = *(const f32x4*)(xwT + (64 * w + pp) * 8), xw1 = *(const f32x4*)(xwT + (64 * w + pp) * 8 + 4);
        f32x4 sv[4][2];
#pragma unroll
        for (int ks = 0; ks < 4; ++ks) { sv[ks][0] = svn[ks][0]; sv[ks][1] = svn[ks][1]; }
        if (nt < 3) {
#pragma unroll
            for (int ks = 0; ks < 4; ++ks) { svn[ks][0] = __builtin_nontemporal_load((const f32x4*)(S0 + (pp + 16) * 128 + 32 * ks + fq * 8)); svn[ks][1] = __builtin_nontemporal_load((const f32x4*)(S0 + (pp + 16) * 128 + 32 * ks + fq * 8 + 4)); }
        }
#pragma unroll
        for (int ks = 0; ks < 4; ++ks) {
            const int n0 = 32 * ks + fq * 8;
            const f32x4 s0 = sv[ks][0], s1 = sv[ks][1];
            union { u32x4 u; bf16x8 v; } bfr;
            bfr.u.x = pk2(s0[0], s0[1]); bfr.u.y = pk2(s0[2], s0[3]); bfr.u.z = pk2(s1[0], s1[1]); bfr.u.w = pk2(s1[2], s1[3]);
            const bf16x8 af = *(const bf16x8*)(Cmb + fr * 136 + n0);
            acc[nt] = mfma16(af, bfr.v, acc[nt]);
            f32x4 o0 = s0 * dA, o1 = s1 * dA;
#pragma unroll
            for (int s = 0; s < 8; ++s) {
                const float xv = s < 4 ? xw0[s & 3] : xw1[s & 3];
                const f32x4 bm0 = *(const f32x4*)(Bmf + s * 128 + n0), bm1 = *(const f32x4*)(Bmf + s * 128 + n0 + 4);
                o0 += bm0 * xv; o1 += bm1 * xv;
            }
            __builtin_nontemporal_store(o0, (f32x4*)(So + pp * 128 + n0)); __builtin_nontemporal_store(o1, (f32x4*)(So + pp * 128 + n0 + 4));
        }
        asm volatile("" ::: "memory");
    }
    const float dsk = p.D_skip[l * 16 + head];
    float gts[4][4];
#pragma unroll
    for (int j = 0; j < 4; ++j) {
        const int t = (fq & 1) * 4 + j;
        const float eb = expf(bsh[w * 8 + t]);
        float ssq = 0.f;
#pragma unroll
        for (int nt = 0; nt < 4; ++nt) {
            const int hp = 64 * w + 16 * nt + fr;
            float y = eb * acc[nt][j] + dsk * xs[t * 512 + hp];
#pragma unroll
            for (int s = 0; s < 8; ++s) y += MW[(w * 8 + t) * 8 + s] * xs[s * 512 + hp];
            const float z = bf2f(U[(size_t)t * INP + UZ + g * 512 + hp]);
            const float gt = y * siluf_(z);
            gts[nt][j] = gt; ssq += gt * gt;
        }
        ssq += __shfl_xor(ssq, 1); ssq += __shfl_xor(ssq, 2); ssq += __shfl_xor(ssq, 4); ssq += __shfl_xor(ssq, 8);
        if (fr == 0 && fq < 2) red[t * 8 + w] = ssq;
    }
    __syncthreads();
    if (tid < 8) { float s = 0.f;
#pragma unroll
        for (int i = 0; i < 8; ++i) s += red[tid * 8 + i];
        stat[tid] = rsqrtf(s * (1.0f / 512.0f) + 1e-6f); }
    __syncthreads();
    if (fq < 2) {
        bf16_t* MX = (bf16_t*)(p.ws + WS_MIXIN);
#pragma unroll
        for (int j = 0; j < 4; ++j) {
            const int t = fq * 4 + j;
#pragma unroll
            for (int nt = 0; nt < 4; ++nt) {
                const int ch = g * 512 + 64 * w + 16 * nt + fr;
                MX[(size_t)(r0 + t) * D + 1024 + ch] = f2bf(gts[nt][j] * stat[t] * p.s_norm_w[l * 1024 + ch]);
            }
        }
    }
    __syncthreads();
}

DEV void phase_ln(const P& p, int l, int which) {
    int tid_ = threadIdx.x; asm volatile("" : "+v"(tid_));
    const int lane = tid_ & 63, w = tid_ >> 6;
    const float* gam = (which ? p.ln2_g : p.ln1_g) + l * D; const float* bet = (which ? p.ln2_b : p.ln1_b) + l * D;
    const bf16_t* mix = (const bf16_t*)(p.ws + WS_MIXF);
    bf16_t* xb = (bf16_t*)(p.ws + WS_XB);
    const bool lastp = (l == 1 && which == 1), split = (gridDim.x == 256);
    for (int r = blockIdx.x * 8 + w; r < NTOK; r += gridDim.x * 8) {
        f32x4 y[8]; float s = 0.f;
#pragma unroll
        for (int i = 0; i < 8; ++i) { const int cidx = i * 256 + lane * 4;
            f32x4 xv, mv;
            { const uint2 t = *(const uint2*)(xb + (size_t)r * D + cidx); xv = (f32x4){bflo(t.x), bfhi(t.x), bflo(t.y), bfhi(t.y)}; }
            if (split && r >= NPR) { const bf16_t* pp = (const bf16_t*)(p.ws + WS_PART) + (size_t)(r - NPR) * D + cidx; mv = (f32x4){0.f, 0.f, 0.f, 0.f};
#pragma unroll
                for (int k = 0; k < 8; ++k) { const uint2 t = *(const uint2*)(pp + (size_t)k * NSM * D); mv += (f32x4){bflo(t.x), bfhi(t.x), bflo(t.y), bfhi(t.y)}; } }
            else { const uint2 t = *(const uint2*)(mix + (size_t)r * D + cidx); mv = (f32x4){bflo(t.x), bfhi(t.x), bflo(t.y), bfhi(t.y)}; }
            y[i] = xv * ALPHA + mv; s += (y[i][0] + y[i][1]) + (y[i][2] + y[i][3]); }
        const float mu = wave_sum(s) * (1.0f / D);
        float q = 0.f;
#pragma unroll
        for (int i = 0; i < 8; ++i) { y[i] = y[i] - mu; q += (y[i][0] * y[i][0] + y[i][1] * y[i][1]) + (y[i][2] * y[i][2] + y[i][3] * y[i][3]); }
        const float rs = rsqrtf(wave_sum(q) * (1.0f / D) + 1e-5f);
#pragma unroll
        for (int i = 0; i < 8; ++i) { const int cidx = i * 256 + lane * 4;
            const f32x4 o = y[i] * rs * *(const f32x4*)(gam + cidx) + *(const f32x4*)(bet + cidx);
            if (lastp) *(f32x4*)(p.out + (size_t)r * D + cidx) = o;
            else { u32x2 wv; wv.x = pk2(o[0], o[1]); wv.y = pk2(o[2], o[3]); *(u32x2*)(xb + (size_t)r * D + cidx) = wv; } }
    }
}

DEV void phase_ffn_gate(const P& p, int l, int part, int b0, int nb) {
    const bf16_t* up = (const bf16_t*)(p.ws + WS_UP); bf16_t* act = (bf16_t*)(p.ws + WS_ACT);
    const float* fw = p.f_conv_w + (size_t)l * 3 * DFF2; const float* fb = p.f_conv_b + (size_t)l * DFF2;
    const int lo = part == 2 ? (NPR / 8) * (DFF / 8) : 0, total = part == 1 ? (NPR / 8) * (DFF / 8) : (NTOK / 8) * (DFF / 8);
    int tid_ = threadIdx.x; asm volatile("" : "+v"(tid_));
    for (int it = lo + b0 * NTHR + tid_; it < total; it += nb * NTHR) {
        const int rb = it / (DFF / 8), j8 = (it % (DFF / 8)) * 8, r0 = rb * 8;
        const bool smp = r0 >= NPR; const int t0 = smp ? 0 : (r0 & 2047); const int sb = (r0 - NPR) >> 3;
        float wg[3][8], wv[3][8], bg[8], bv[8];
#pragma unroll
        for (int k = 0; k < 3; ++k) {
            const f32x4 a0 = *(const f32x4*)(fw + k * DFF2 + j8), a1 = *(const f32x4*)(fw + k * DFF2 + j8 + 4), c0 = *(const f32x4*)(fw + k * DFF2 + DFF + j8), c1 = *(const f32x4*)(fw + k * DFF2 + DFF + j8 + 4);
#pragma unroll
            for (int i = 0; i < 4; ++i) { wg[k][i] = a0[i]; wg[k][4 + i] = a1[i]; wv[k][i] = c0[i]; wv[k][4 + i] = c1[i]; }
        }
        { const f32x4 a0 = *(const f32x4*)(fb + j8), a1 = *(const f32x4*)(fb + j8 + 4), c0 = *(const f32x4*)(fb + DFF + j8), c1 = *(const f32x4*)(fb + DFF + j8 + 4);
#pragma unroll
          for (int i = 0; i < 4; ++i) { bg[i] = a0[i]; bg[4 + i] = a1[i]; bv[i] = c0[i]; bv[4 + i] = c1[i]; } }
        float g0[8], g1[8], v0[8], v1[8];
        if (t0 > 0) {
            unpack8(*(const uint4*)(up + (size_t)(r0 - 2) * DFF2 + j8), g0); unpack8(*(const uint4*)(up + (size_t)(r0 - 2) * DFF2 + DFF + j8), v0);
            unpack8(*(const uint4*)(up + (size_t)(r0 - 1) * DFF2 + j8), g1); unpack8(*(const uint4*)(up + (size_t)(r0 - 1) * DFF2 + DFF + j8), v1);
        } else if (smp) {
            const float* bp = p.st_fconv + (size_t)(l * 128 + sb) * 2 * DFF2;
            const f32x4 a0 = *(const f32x4*)(bp + j8), a1 = *(const f32x4*)(bp + j8 + 4), c0 = *(const f32x4*)(bp + DFF + j8), c1 = *(const f32x4*)(bp + DFF + j8 + 4);
            const f32x4 d0 = *(const f32x4*)(bp + DFF2 + j8), d1 = *(const f32x4*)(bp + DFF2 + j8 + 4), e0 = *(const f32x4*)(bp + DFF2 + DFF + j8), e1 = *(const f32x4*)(bp + DFF2 + DFF + j8 + 4);
#pragma unroll
            for (int i = 0; i < 4; ++i) { g0[i] = a0[i]; g0[4 + i] = a1[i]; v0[i] = c0[i]; v0[4 + i] = c1[i]; g1[i] = d0[i]; g1[4 + i] = d1[i]; v1[i] = e0[i]; v1[4 + i] = e1[i]; }
        } else {
#pragma unroll
            for (int i = 0; i < 8; ++i) { g0[i] = 0.f; g1[i] = 0.f; v0[i] = 0.f; v1[i] = 0.f; }
        }
#pragma unroll
        for (int rr = 0; rr < 8; ++rr) {
            float g2[8], v2[8];
            unpack8(*(const uint4*)(up + (size_t)(r0 + rr) * DFF2 + j8), g2); unpack8(*(const uint4*)(up + (size_t)(r0 + rr) * DFF2 + DFF + j8), v2);
            float o[8];
#pragma unroll
            for (int i = 0; i < 8; ++i) {
                const float ag = bg[i] + wg[0][i] * g0[i] + wg[1][i] * g1[i] + wg[2][i] * g2[i];
                const float av = bv[i] + wv[0][i] * v0[i] + wv[1][i] * v1[i] + wv[2][i] * v2[i];
                o[i] = ag * __builtin_amdgcn_rcpf(1.0f + __expf(-ag)) * av;
                g0[i] = g1[i]; g1[i] = g2[i]; v0[i] = v1[i]; v1[i] = v2[i];
            }
            u32x4 wv4; wv4.x = pk2(o[0], o[1]); wv4.y = pk2(o[2], o[3]); wv4.z = pk2(o[4], o[5]); wv4.w = pk2(o[6], o[7]);
            *(u32x4*)(act + (size_t)(r0 + rr) * DFF + j8) = wv4;
        }
    }
    const int tot2 = part == 1 ? 0 : 132 * 2 * (DFF2 / 8);
    for (int it = b0 * NTHR + tid_; it < tot2; it += nb * NTHR) {
        const int c8 = (it % (DFF2 / 8)) * 8, rr = it / (DFF2 / 8), j = rr & 1, sq = rr >> 1;
        float* o; size_t row;
        if (sq < 4) { o = p.out + O_PFC + ((size_t)(l * 4 + sq) * 2 + j) * DFF2 + c8; row = (size_t)sq * 2048 + 2046 + j; }
        else { const int b = sq - 4; o = p.out + O_SFC + ((size_t)(l * 128 + b) * 2 + j) * DFF2 + c8; row = (size_t)NPR + b * 8 + 6 + j; }
        float xf[8]; unpack8(*(const uint4*)(up + row * DFF2 + c8), xf);
        *(f32x4*)o = (f32x4){xf[0], xf[1], xf[2], xf[3]}; *(f32x4*)(o + 4) = (f32x4){xf[4], xf[5], xf[6], xf[7]};
    }
}


#define XB_TMO      128
#define XB_XCNT(j)  (256  + 64 * (j))
#define XB_XSUB(j)  (1280 + 64 * (j))
#define XB_XGEN(j)  (2304 + 64 * (j))
#define XB_TOP      3328
#define XB_TOPGEN   3392
#define XCD_BAR_WORDS 3456
#define XB_SPIN_CAP (1u << 20)
DEV unsigned xb_ld(unsigned* p)              { return __hip_atomic_load(p, __ATOMIC_RELAXED, __HIP_MEMORY_SCOPE_AGENT); }
DEV unsigned xb_add(unsigned* p, unsigned v) { return __hip_atomic_fetch_add(p, v, __ATOMIC_RELAXED, __HIP_MEMORY_SCOPE_AGENT); }
DEV unsigned xb_xcc_id() { return (unsigned)__builtin_amdgcn_s_getreg((3 << 11) | 20) & 0xFu; }
#define XB_SPIN(cond, bar) do { unsigned _sp = 0; while (cond) { __builtin_amdgcn_s_sleep(1); \
    if ((++_sp & 255u) == 0u) { if (xb_ld(&(bar)[XB_TMO])) break; if (_sp > XB_SPIN_CAP) { atomicAdd(&(bar)[XB_TMO], 1u); break; } } } } while (0)
struct XcdBarrier { unsigned* bar; unsigned x; volatile LAS unsigned* st; };
DEV XcdBarrier xcd_barrier_post(unsigned* bar, volatile LAS unsigned* st) {
    XcdBarrier b; b.bar = bar; b.x = xb_xcc_id(); b.st = st;
    if (threadIdx.x == 0) (void)xb_add(&bar[XB_XCNT(b.x)], 1u);
    return b;
}
DEV void xcd_barrier_complete(unsigned* bar, unsigned x, unsigned& nloc, unsigned& nx) {
    const unsigned G = gridDim.x * gridDim.y * gridDim.z;
    unsigned sum, cnt, mine, sp = 0u;
    for (;;) {
        sum = 0u; cnt = 0u; mine = 0u;
#pragma unroll
        for (unsigned j = 0; j < 16; ++j) { const unsigned c = xb_ld(&bar[XB_XCNT(j)]); sum += c; cnt += (c > 0u) ? 1u : 0u; mine = (j == x) ? c : mine; }
        if (sum == G) break;
        __builtin_amdgcn_s_sleep(1);
        if ((++sp & 255u) == 0u) { if (xb_ld(&bar[XB_TMO])) break; if (sp > XB_SPIN_CAP) { atomicAdd(&bar[XB_TMO], 1u); break; } }
    }
    nloc = mine > 0u ? mine : 1u; nx = cnt > 0u ? cnt : 1u;
}
DEV void xcd_barrier(const XcdBarrier& b) {
    asm volatile("s_waitcnt vmcnt(0)" ::: "memory");
    __syncthreads();
    if (threadIdx.x == 0) {
        unsigned* bar = b.bar;
        __builtin_amdgcn_s_waitcnt(0);
        unsigned nloc = b.st[0], nx = b.st[1];
        if (nloc == 0u) { xcd_barrier_complete(bar, b.x, nloc, nx); b.st[0] = nloc; b.st[1] = nx; }
        const unsigned old = xb_add(&bar[XB_XSUB(b.x)], 1u);
        const unsigned gen = old / nloc;
        if (old + 1u == (gen + 1u) * nloc) {
            __builtin_amdgcn_fence(__ATOMIC_RELEASE, "agent");
            asm volatile("s_waitcnt vmcnt(0)" ::: "memory");
            const unsigned og = xb_add(&bar[XB_TOP], 1u);
            const unsigned tg = og / nx;
            if (og + 1u == (tg + 1u) * nx) xb_add(&bar[XB_TOPGEN], 1u);
            else XB_SPIN(xb_ld(&bar[XB_TOPGEN]) == tg, bar);
            __builtin_amdgcn_fence(__ATOMIC_ACQUIRE, "agent");
            xb_add(&bar[XB_XGEN(b.x)], 1u);
            asm volatile("s_waitcnt vmcnt(0)" ::: "memory");
        } else {
            XB_SPIN(xb_ld(&bar[XB_XGEN(b.x)]) == gen, bar);
            __builtin_amdgcn_fence(__ATOMIC_ACQUIRE, "agent");
            asm volatile("s_waitcnt vmcnt(0)" ::: "memory");
        }
    }
    __syncthreads();
}

constexpr int NPHASE = 21;
DEV void run_phase(const P& p, int l, int q, unsigned char* lds) {
    int bid = blockIdx.x, G = gridDim.x; asm volatile("" : "+s"(bid), "+s"(G));
    if (q == 0) {
        pg8::Gemm g{(const bf16_t*)(p.ws + WS_XB), (const bf16_t*)(p.ws + WS_WIN) + (size_t)l * INP * D, NTOK, INP, D};
        pg8::StaticOrder S; S.init(NTOK, INP, D, G, bid);
        pg8::EpiBf16 E{(bf16_t*)(p.ws + WS_U), INP, nullptr};
        pg8::gemm_phase<pg8::EpiBf16, pg8::StaticOrder>((LAS unsigned char*)lds, g, S, E);
    } else if (q == 1) {
        const int par = bid & 1;
#pragma unroll 1
        for (int half = 0; half < 2; ++half) {
            if ((half ^ par) == 0) {
                for (int u = bid; u < 512; u += G) smp_mlstm(p, l, u, lds);
                for (int u = bid; u < 256; u += G) smp_ssd(p, l, u, lds);
            } else {
                for (int u = bid; u < 512; u += G) mlstm_local(p, l, u, lds);
                for (int u = bid; u < 256; u += G) ssd_local(p, l, u, lds);
            }
        }
    } else if (q == 2) {
        for (int u = bid; u < 256; u += G) mlstm_scan(p, l, u, lds);
        for (int u = bid; u < 256; u += G) ssd_scan(p, l, u, lds);
        for (int u = bid; u < 132; u += G) convstate_copy(p, l, u);
    } else if (q == 3) {
        const bool cvt = (l == 0 && G == 256); const int par3 = bid & 1;
        if (cvt && par3) phase_prologue(p, lds, 0, 1, false, bid, 256, T_WIN, T_L);
        for (int u = bid; u < 512; u += G) mlstm_out(p, l, u, lds);
        for (int u = bid; u < 256; u += G) ssd_out(p, l, u, lds);
        if (cvt && !par3) phase_prologue(p, lds, 0, 1, false, bid, 256, T_WIN, T_L);
    } else if (q == 4) {
        pg8::Gemm g{(const bf16_t*)(p.ws + WS_MIXIN), (const bf16_t*)(p.ws + WS_WOUT) + (size_t)l * D * D, NTOK, D, D};
        pg8::EpiBf16 E{(bf16_t*)(p.ws + WS_MIXF), D, (float*)(p.ws + WS_PART)};
        if (G == 256) { pg8::TailSplitOrder S; S.init(D, bid); pg8::gemm_phase<pg8::EpiBf16, pg8::TailSplitOrder>((LAS unsigned char*)lds, g, S, E); }
        else { pg8::StaticOrder S; S.init(NTOK, D, D, G, bid); pg8::gemm_phase<pg8::EpiBf16, pg8::StaticOrder>((LAS unsigned char*)lds, g, S, E); }
    } else if (q == 5) {
        phase_ln(p, l, 0);
    } else if (q == 6) {
        pg8::Gemm g{(const bf16_t*)(p.ws + WS_XB), (const bf16_t*)(p.ws + WS_WUP) + (size_t)l * DFF2 * D, NTOK, DFF2, D};
        pg8::StaticOrder S; S.init(NTOK, DFF2, D, G, bid);
        pg8::EpiBf16 E{(bf16_t*)(p.ws + WS_UP), DFF2, nullptr};
        pg8::gemm_phase<pg8::EpiBf16, pg8::StaticOrder>((LAS unsigned char*)lds, g, S, E);
        if (l == 0 && G == 256 && bid >= 12) phase_prologue(p, lds, 1, 2, false, bid - 12, 244);
    } else if (q == 16 || q == 26) {
        pg8::Gemm g{(const bf16_t*)(p.ws + WS_XB), (const bf16_t*)(p.ws + WS_WUP) + (size_t)l * DFF2 * D, NTOK, DFF2, D};
        pg8::EpiBf16 E{(bf16_t*)(p.ws + WS_UP), DFF2, nullptr};
        if (q == 16 || bid < 12) { pg8::UpOrder S; S.init(bid, q == 16 ? 0 : 6, q == 16 ? 6 : 7); pg8::gemm_phase<pg8::EpiBf16, pg8::UpOrder>((LAS unsigned char*)lds, g, S, E); }
        else phase_ffn_gate(p, l, 1, bid - 12, 244);
    } else if (q == 17) {
        phase_ffn_gate(p, l, 2, bid, G);
    } else if (q == 7) {
        phase_ffn_gate(p, l, 0, bid, G);
    } else if (q == 8) {
        pg8::Gemm g{(const bf16_t*)(p.ws + WS_ACT), (const bf16_t*)(p.ws + WS_WDN) + (size_t)l * D * DFF, NTOK, D, DFF};
        pg8::EpiBf16 E{(bf16_t*)(p.ws + WS_MIXF), D, (float*)(p.ws + WS_PART)};
        if (G == 256) { pg8::TailSplitOrder S; S.init(DFF, bid); pg8::gemm_phase<pg8::EpiBf16, pg8::TailSplitOrder>((LAS unsigned char*)lds, g, S, E); }
        else { pg8::StaticOrder S; S.init(NTOK, D, DFF, G, bid); pg8::gemm_phase<pg8::EpiBf16, pg8::StaticOrder>((LAS unsigned char*)lds, g, S, E); }
    } else {
        phase_ln(p, l, 1);
    }
}
#if MK_MULTI
template <int T> __global__ void __launch_bounds__(NTHR, 2) k_unit(P p) {
    extern __shared__ __attribute__((aligned(16))) unsigned char lds[];
    const int l = p.ph_lo; int bid = blockIdx.x, G = gridDim.x;
    if (T == 11) for (int u = bid; u < 512; u += G) smp_mlstm(p, l, u, lds);
    if (T == 12) for (int u = bid; u < 256; u += G) smp_ssd(p, l, u, lds);
    if (T == 13) for (int u = bid; u < 512; u += G) mlstm_local(p, l, u, lds);
    if (T == 14) for (int u = bid; u < 256; u += G) ssd_local(p, l, u, lds);
    if (T == 31) for (int u = bid; u < 512; u += G) mlstm_out(p, l, u, lds);
    if (T == 32) for (int u = bid; u < 256; u += G) ssd_out(p, l, u, lds);
    if (T == 21) for (int u = bid; u < 256; u += G) mlstm_scan(p, l, u, lds);
    if (T == 22) for (int u = bid; u < 256; u += G) ssd_scan(p, l, u, lds);
}
template <int Q> __global__ void __launch_bounds__(NTHR, 2) k_phase(P p) {
    extern __shared__ __attribute__((aligned(16))) unsigned char lds[];
    if (Q < 0) { if (gridDim.x == 256) phase_prologue(p, lds, 0, 1, true, blockIdx.x, 256, 0, T_WIN); else phase_prologue(p, lds, 0, 2, true, blockIdx.x, gridDim.x); } else run_phase(p, p.ph_lo, Q, lds);
}
#else
__global__ void __launch_bounds__(NTHR, 2) mk_fwd(P p) {
    extern __shared__ __attribute__((aligned(16))) unsigned char lds[];
    cg::grid_group grid = cg::this_grid();
    if (p.ph_hi < 0) grid.sync();
    if (threadIdx.x < 4) ((unsigned*)(lds + LDS_BYTES - 16))[threadIdx.x] = 0u;
    __syncthreads();
    (void)xcd_barrier_post((unsigned*)(p.ws + WS_BAR), (volatile LAS unsigned*)(lds + LDS_BYTES - 16));
#define GSYNC() do { XcdBarrier b_; b_.bar = (unsigned*)(p.ws + WS_BAR); b_.x = xb_xcc_id(); b_.st = (volatile LAS unsigned*)(lds + LDS_BYTES - 16); xcd_barrier(b_); } while (0)
    if (gridDim.x == 256) phase_prologue(p, lds, 0, 1, true, blockIdx.x, 256, 0, T_WIN); else phase_prologue(p, lds, 0, 2, true, blockIdx.x, gridDim.x);
#pragma unroll 1
    for (int l = 0; l < 2; ++l) {
        GSYNC(); run_phase(p, l, 0, lds);
        GSYNC(); run_phase(p, l, 1, lds);
        GSYNC(); run_phase(p, l, 2, lds);
        GSYNC(); run_phase(p, l, 3, lds);
        GSYNC(); run_phase(p, l, 4, lds);
        GSYNC(); run_phase(p, l, 5, lds);
        if (l == 1 && gridDim.x == 256) {
            GSYNC(); run_phase(p, l, 16, lds);
            GSYNC(); run_phase(p, l, 26, lds);
            GSYNC(); run_phase(p, l, 17, lds);
        } else {
            GSYNC(); run_phase(p, l, 6, lds);
            GSYNC(); run_phase(p, l, 7, lds);
        }
        GSYNC(); run_phase(p, l, 8, lds);
        GSYNC(); run_phase(p, l, 9, lds);
    }
    for (int i = 0; i < PROBE_SYNCS; ++i) GSYNC();
}
#endif

extern "C" void kernel_launch(void* const* d_in, const int* in_sizes, int n_in, void* d_out, int out_size, void* d_ws, size_t ws_size, hipStream_t stream) {
    static int grid = 0;
    if (grid == 0) {
        if (n_in != 27 || ws_size < WS_END) { fprintf(stderr, "kernel_launch: unexpected n_in %d or ws_size %zu (need %zu)\n", n_in, ws_size, (size_t)WS_END); grid = -1; return; }
        int dev = 0, cus = 0, per_cu = 0;
        hipGetDevice(&dev);
        hipDeviceGetAttribute(&cus, hipDeviceAttributeMultiprocessorCount, dev);
#if MK_MULTI
        const void* fns[11] = {(const void*)k_phase<-1>, (const void*)k_phase<0>, (const void*)k_phase<1>, (const void*)k_phase<2>, (const void*)k_phase<3>, (const void*)k_phase<4>, (const void*)k_phase<5>,
                               (const void*)k_phase<6>, (const void*)k_phase<7>, (const void*)k_phase<8>, (const void*)k_phase<9>};
        for (int i = 0; i < 11; ++i) if (hipFuncSetAttribute(fns[i], hipFuncAttributeMaxDynamicSharedMemorySize, LDS_BYTES) != hipSuccess) { fprintf(stderr, "kernel_launch: hipFuncSetAttribute failed\n"); grid = -1; return; }
#else
        if (hipFuncSetAttribute((const void*)mk_fwd, hipFuncAttributeMaxDynamicSharedMemorySize, LDS_BYTES) != hipSuccess) { fprintf(stderr, "kernel_launch: hipFuncSetAttribute failed\n"); grid = -1; return; }
        hipOccupancyMaxActiveBlocksPerMultiprocessor(&per_cu, (const void*)mk_fwd, NTHR, LDS_BYTES);
        (void)hipGetLastError();
#endif
        (void)per_cu;
        grid = cus * 1;
    }
    if (grid < 0) return;
    P p{};
    const float** pp = (const float**)&p;
    for (int i = 0; i < 27; ++i) pp[i] = (const float*)d_in[i];
    p.out = (float*)d_out; p.ws = (unsigned char*)d_ws;
#if MK_MULTI
    p.ph_lo = 0; p.ph_hi = 0;
    if (PROBE_REP == -1) hipLaunchKernelGGL(k_phase<-1>, dim3(grid), dim3(NTHR), LDS_BYTES, stream, p);
    hipLaunchKernelGGL(k_phase<-1>, dim3(grid), dim3(NTHR), LDS_BYTES, stream, p);
    for (int l = 0; l < 2; ++l) {
        p.ph_lo = l;
        for (int rep = 0; rep < 1 + ((PROBE_REP == 0) || (PROBE_REP == 100 && (0 == 0 || 0 == 4 || 0 == 6 || 0 == 8))); ++rep) hipLaunchKernelGGL(k_phase<0>, dim3(grid), dim3(NTHR), LDS_BYTES, stream, p);
        for (int rep = 0; rep < 1 + ((PROBE_REP == 1) || (PROBE_REP == 100 && (1 == 0 || 1 == 4 || 1 == 6 || 1 == 8))); ++rep) hipLaunchKernelGGL(k_phase<1>, dim3(grid), dim3(NTHR), LDS_BYTES, stream, p);
        for (int rep = 0; rep < 1 + ((PROBE_REP == 2) || (PROBE_REP == 100 && (2 == 0 || 2 == 4 || 2 == 6 || 2 == 8))); ++rep) hipLaunchKernelGGL(k_phase<2>, dim3(grid), dim3(NTHR), LDS_BYTES, stream, p);
        for (int rep = 0; rep < 1 + ((PROBE_REP == 3) || (PROBE_REP == 100 && (3 == 0 || 3 == 4 || 3 == 6 || 3 == 8))); ++rep) hipLaunchKernelGGL(k_phase<3>, dim3(grid), dim3(NTHR), LDS_BYTES, stream, p);
        if (PROBE_REP == 11 || PROBE_REP == 12 || PROBE_REP == 13 || PROBE_REP == 14 || PROBE_REP == 31 || PROBE_REP == 32 || PROBE_REP == 21 || PROBE_REP == 22) {
            hipFuncSetAttribute((const void*)k_unit<PROBE_REP>, hipFuncAttributeMaxDynamicSharedMemorySize, LDS_BYTES);
            hipLaunchKernelGGL(k_unit<PROBE_REP>, dim3(grid), dim3(NTHR), LDS_BYTES, stream, p);
        }
        for (int rep = 0; rep < 1 + ((PROBE_REP == 4) || (PROBE_REP == 100 && (4 == 0 || 4 == 4 || 4 == 6 || 4 == 8))); ++rep) hipLaunchKernelGGL(k_phase<4>, dim3(grid), dim3(NTHR), LDS_BYTES, stream, p);
        for (int rep = 0; rep < 1 + ((PROBE_REP == 5) || (PROBE_REP == 100 && (5 == 0 || 5 == 4 || 5 == 6 || 5 == 8))); ++rep) hipLaunchKernelGGL(k_phase<5>, dim3(grid), dim3(NTHR), LDS_BYTES, stream, p);
        for (int rep = 0; rep < 1 + ((PROBE_REP == 6) || (PROBE_REP == 100 && (6 == 0 || 6 == 4 || 6 == 6 || 6 == 8))); ++rep) hipLaunchKernelGGL(k_phase<6>, dim3(grid), dim3(NTHR), LDS_BYTES, stream, p);
        for (int rep = 0; rep < 1 + ((PROBE_REP == 7) || (PROBE_REP == 100 && (7 == 0 || 7 == 4 || 7 == 6 || 7 == 8))); ++rep) hipLaunchKernelGGL(k_phase<7>, dim3(grid), dim3(NTHR), LDS_BYTES, stream, p);
        for (int rep = 0; rep < 1 + ((PROBE_REP == 8) || (PROBE_REP == 100 && (8 == 0 || 8 == 4 || 8 == 6 || 8 == 8))); ++rep) hipLaunchKernelGGL(k_phase<8>, dim3(grid), dim3(NTHR), LDS_BYTES, stream, p);
        for (int rep = 0; rep < 1 + ((PROBE_REP == 9) || (PROBE_REP == 100 && (9 == 0 || 9 == 4 || 9 == 6 || 9 == 8))); ++rep) hipLaunchKernelGGL(k_phase<9>, dim3(grid), dim3(NTHR), LDS_BYTES, stream, p);
    }
#else
    p.ph_lo = 0; p.ph_hi = NPHASE;
    if (hipMemsetAsync((char*)d_ws + WS_BAR, 0, 16384, stream) != hipSuccess) { fprintf(stderr, "kernel_launch: memset failed\n"); return; }
    void* args[] = {&p};
    hipError_t e = hipLaunchCooperativeKernel((const void*)mk_fwd, dim3(grid), dim3(NTHR), args, LDS_BYTES, stream);
    if (e != hipSuccess) fprintf(stderr, "cooperative launch failed: %s (grid %d)\n", hipGetErrorString(e), grid);
#endif
}
```

```cpp
#include <hip/hip_runtime.h>
#include <hip/hip_cooperative_groups.h>
#include <cstdio>
namespace cg = cooperative_groups;

#ifndef MK_MULTI
#define MK_MULTI 0
#endif
#ifndef PROBE_REP
#define PROBE_REP -99
#endif
#ifndef PROBE_SYNCS
#define PROBE_SYNCS 0
#endif

#define DEV __device__ __forceinline__
#define LAS __attribute__((address_space(3)))
typedef unsigned short bf16_t;
typedef short bf16x8 __attribute__((ext_vector_type(8)));
typedef float f32x4 __attribute__((ext_vector_type(4)));
typedef float f32x2 __attribute__((ext_vector_type(2)));
typedef unsigned u32x4 __attribute__((ext_vector_type(4)));
typedef unsigned u32x2 __attribute__((ext_vector_type(2)));

constexpr int D = 2048, NPR = 8192, NSM = 1024, NTOK = 9216, INP = 6912, IN_DIM = 6680, DFF = 5504, DFF2 = 11008;
constexpr int UQ = 0, UK = 1024, UV = 2048, UO = 3072, UZ = 4096, UXS = 5120, UIG = 6656, UFG = 6660, UDT = 6664;
constexpr int NTHR = 512;
constexpr int LDS_BYTES = 136 * 1024;
constexpr float ALPHA = 1.41421356237309515f;

constexpr size_t O_YP = 0;
constexpr size_t O_YS = O_YP + (size_t)4 * 2048 * 2048;
constexpr size_t O_PC = O_YS + (size_t)128 * 8 * 2048;
constexpr size_t O_PN = O_PC + (size_t)2 * 4 * 4 * 256 * 256;
constexpr size_t O_PM = O_PN + (size_t)2 * 4 * 4 * 256;
constexpr size_t O_PS = O_PM + (size_t)2 * 4 * 4;
constexpr size_t O_PSC = O_PS + (size_t)2 * 4 * 16 * 64 * 128;
constexpr size_t O_PFC = O_PSC + (size_t)2 * 4 * 3 * 1536;
constexpr size_t O_SC = O_PFC + (size_t)2 * 4 * 2 * DFF2;
constexpr size_t O_SN = O_SC + (size_t)2 * 128 * 4 * 256 * 256;
constexpr size_t O_SM = O_SN + (size_t)2 * 128 * 4 * 256;
constexpr size_t O_SS = O_SM + (size_t)2 * 128 * 4;
constexpr size_t O_SSC = O_SS + (size_t)2 * 128 * 16 * 64 * 128;
constexpr size_t O_SFC = O_SSC + (size_t)2 * 128 * 3 * 1536;

constexpr size_t WS_WIN = 0;
constexpr size_t WS_WOUT = WS_WIN + (size_t)2 * INP * D * 2;
constexpr size_t WS_WUP = WS_WOUT + (size_t)2 * D * D * 2;
constexpr size_t WS_WDN = WS_WUP + (size_t)2 * DFF2 * D * 2;
constexpr size_t WS_XB = WS_WDN + (size_t)2 * D * DFF * 2;
constexpr size_t WS_XF = WS_XB + (size_t)NTOK * D * 2;
constexpr size_t WS_XBC = WS_XF;
constexpr size_t WS_U = WS_XF + (size_t)NTOK * D * 4;
constexpr size_t WS_MIXIN = WS_U + (size_t)NTOK * INP * 2;
constexpr size_t WS_MIXF = WS_MIXIN + (size_t)NTOK * D * 2;
constexpr size_t WS_UP = WS_MIXF + (size_t)NTOK * D * 4;
constexpr size_t WS_ACT = WS_UP + (size_t)NTOK * DFF2 * 2;
constexpr size_t WS_PART = WS_ACT + (size_t)NTOK * DFF * 2;
constexpr size_t WS_SMALL = WS_PART + (size_t)8 * NSM * D * 4;
constexpr size_t WS_DBUF = WS_UP;
constexpr size_t WS_SBUF = WS_UP + (size_t)512 * 65536 * 4;
constexpr size_t WS_CT = WS_ACT;
constexpr size_t WS_ST = WS_ACT + (size_t)512 * 65536 * 2;
static_assert(WS_SBUF + (size_t)2048 * 8192 * 4 <= WS_ACT, "alias");
static_assert(WS_ST + (size_t)2048 * 8192 * 2 <= WS_PART, "alias");
constexpr size_t WS_NLOC = WS_SMALL;
constexpr size_t WS_NST = WS_NLOC + (size_t)512 * 256 * 4;
constexpr size_t WS_GSTAT = WS_NST + (size_t)512 * 256 * 4;
constexpr size_t WS_MST = WS_GSTAT + 4096;
constexpr size_t WS_SBSUM = WS_MST + 4096;
constexpr size_t WS_BAR = WS_SBSUM + 8192;
constexpr size_t WS_END = WS_BAR + 16384;

struct P {
    const float* x_prompt; const float* x_sample; const float* st_C; const float* st_n; const float* st_m; const float* st_ssm; const float* st_sconv; const float* st_fconv;
    const float* w_in; const float* b_i; const float* b_f; const float* m_norm_w; const float* s_conv_w; const float* s_conv_b; const float* dt_bias; const float* A_log; const float* D_skip;
    const float* s_norm_w; const float* w_out; const float* ln1_g; const float* ln1_b; const float* w_up; const float* f_conv_w; const float* f_conv_b; const float* w_down; const float* ln2_g; const float* ln2_b;
    float* out; unsigned char* ws; int ph_lo, ph_hi;
};

DEV float bf2f(bf16_t v) { return __uint_as_float(((unsigned)v) << 16); }
DEV bf16_t f2bf(float f) { unsigned u = __float_as_uint(f); u += 0x7FFFu + ((u >> 16) & 1u); return (bf16_t)(u >> 16); }
DEV unsigned pk2(float lo, float hi) { return (unsigned)f2bf(lo) | ((unsigned)f2bf(hi) << 16); }
DEV float bflo(unsigned w) { return __uint_as_float(w << 16); }
DEV float bfhi(unsigned w) { return __uint_as_float(w & 0xffff0000u); }
DEV float sigmoidf_(float x) { return __builtin_amdgcn_rcpf(1.0f + __expf(-x)); }
DEV float siluf_(float x) { return x * sigmoidf_(x); }
DEV float softplusf_(float x) { return fmaxf(x, 0.f) + __logf(1.0f + __expf(-fabsf(x))); }
DEV float logsigf_(float x) { return fminf(x, 0.f) - __logf(1.0f + __expf(-fabsf(x))); }
DEV float wave_sum(float v) {
#pragma unroll
    for (int o = 32; o >= 1; o >>= 1) v += __shfl_xor(v, o);
    return v; }
DEV float wave_max(float v) {
#pragma unroll
    for (int o = 32; o >= 1; o >>= 1) v = fmaxf(v, __shfl_xor(v, o));
    return v; }
DEV float wave_incl_sum(float v, int lane) {
#pragma unroll
    for (int o = 1; o < 64; o <<= 1) { float t = __shfl_up(v, o); if (lane >= o) v += t; }
    return v; }
DEV float wave_incl_max(float v, int lane) {
#pragma unroll
    for (int o = 1; o < 64; o <<= 1) { float t = __shfl_up(v, o); if (lane >= o) v = fmaxf(v, t); }
    return v; }
DEV f32x4 mfma16(bf16x8 a, bf16x8 b, f32x4 c) { return __builtin_amdgcn_mfma_f32_16x16x32_bf16(a, b, c, 0, 0, 0); }
DEV void unpack8(uint4 x, float (&f)[8]) { f[0] = bflo(x.x); f[1] = bfhi(x.x); f[2] = bflo(x.y); f[3] = bfhi(x.y); f[4] = bflo(x.z); f[5] = bfhi(x.z); f[6] = bflo(x.w); f[7] = bfhi(x.w); }

typedef short s16x4 __attribute__((ext_vector_type(4)));
DEV bf16x8 tr_frag(const bf16_t* T, int pitch, int krow0, int col0, int lane) {
    const int g = lane >> 4, q = (lane & 15) >> 2, pl = lane & 3;
    const bf16_t* a0 = T + (krow0 + 8 * g + q) * pitch + col0 + 4 * pl;
    const s16x4 lo = __builtin_amdgcn_ds_read_tr16_b64_v4i16((LAS s16x4*)a0);
    const s16x4 hi = __builtin_amdgcn_ds_read_tr16_b64_v4i16((LAS s16x4*)(a0 + 4 * pitch));
    return (bf16x8){lo[0], lo[1], lo[2], lo[3], hi[0], hi[1], hi[2], hi[3]};
}

namespace pg8 {
constexpr int BM = 256, BK = 64, HALF = 128, HTB = HALF * BK * 2, STAGE_BYTES = 8 * HTB, NXCD = 8, WGM = 8;
DEV int lds_byte(int r, int c) { const int st = (r >> 4) * 2 + (c >> 5), rr = r & 15, cc = c & 31, ob = rr * 64 + cc * 2; return st * 1024 + (ob ^ (((ob >> 9) & 1) << 5)); }
DEV void stage_rc(int b, int& R, int& C) { const int st = b / 1024, sb = b % 1024, swz = sb ^ (((sb >> 9) & 1) << 5); R = (st >> 1) * 16 + swz / 64; C = (st & 1) * 32 + (swz % 64) / 2; }
DEV int perm32(int rho) { const int n = rho >> 4, i = rho & 15; return 8 * (i >> 2) + 4 * n + (i & 3); }
struct Unit { int pm, pn, k0, nt, ks; };
struct Gemm { const bf16_t* A; const bf16_t* Bt; int M, N, K; };
struct StaticOrder {
    int nM, nN, nwg, G, c, ntk, ioff, imax;
    DEV void init(int M, int N, int K, int G_, int c_, int ioff_ = 0, int imax_ = 1 << 20) { nM = M / BM; nN = N / BM; nwg = nM * nN; G = G_; c = c_; ntk = K / BK; ioff = ioff_; imax = imax_; }
    DEV bool next(int i, Unit& u) const {
        u.pm = 0; u.pn = 0; u.k0 = 0; u.nt = 4; u.ks = -1;
        if (i + ioff >= imax) return false;
        const long L = (long)(i + ioff) * G + c; if (L >= nwg) return false;
        int wgid = (int)L; { const int q = nwg / NXCD, r = nwg % NXCD, xcd = wgid % NXCD, off = wgid / NXCD; wgid = (xcd < r ? xcd * (q + 1) : r * (q + 1) + (xcd - r) * q) + off; }
        const int nig = WGM * nN, gid = wgid / nig, fm = gid * WGM, gsz = (nM - fm) < WGM ? (nM - fm) : WGM;
        u.pm = fm + ((wgid % nig) % gsz); u.pn = (wgid % nig) / gsz; u.k0 = 0; u.nt = ntk; u.ks = -1; return true;
    }
};
struct TailSplitOrder {
    StaticOrder so; int c, ntk;
    DEV void init(int K, int c_) { so.init(NPR, D, K, 256, c_); c = c_; ntk = K / BK; }
    DEV bool next(int i, Unit& u) const {
        u.pm = 0; u.pn = 0; u.k0 = 0; u.nt = 4; u.ks = -1;
        if (i == 0) return so.next(0, u);
        if (i > 1) return false;
        const int tt = c >> 3, ks = c & 7; u.pm = 32 + (tt >> 3); u.pn = tt & 7; u.ks = ks;
        const int pairs = ntk >> 1, base = pairs >> 3, rem = pairs & 7;
        const int p0 = ks * base + (ks < rem ? ks : rem), np = base + (ks < rem ? 1 : 0);
        u.k0 = p0 * 128; u.nt = np * 2; return true;
    }
};
struct UpOrder {
    int c, ioff, imax;
    DEV void init(int c_, int ioff_, int imax_) { c = c_; ioff = ioff_; imax = imax_; }
    DEV bool next(int i, Unit& u) const {
        u.pm = 0; u.pn = 0; u.k0 = 0; u.nt = D / BK; u.ks = -1;
        const int r = i + ioff;
        if (r >= imax || r > 6 || (r == 6 && c >= 12)) return false;
        const int wgid = r < 6 ? ((r * 256 + c) % NXCD) * 192 + (r * 256 + c) / NXCD : 1536 + c;
        const int nN = DFF2 / BM, nig = WGM * nN, gid = wgid / nig, fm = gid * WGM, gsz = (36 - fm) < WGM ? (36 - fm) : WGM;
        u.pm = fm + ((wgid % nig) % gsz); u.pn = (wgid % nig) / gsz; return true;
    }
};
DEV unsigned cvt_pk_bf16(float lo, float hi) { unsigned r; asm volatile("v_cvt_pk_bf16_f32 %0, %1, %2" : "=v"(r) : "v"(lo), "v"(hi)); return r; }
struct EpiF32 {
    static constexpr bool PERM = false;
    float* C; int ldc; float* part;
    DEV void operator()(const f32x4 (&acc)[2][2][4][2], const Unit& u, int wr, int wc, int fr, int fq) const {
        const int row0 = u.pm * BM + wr * 64 + fr, col0 = u.pn * BM + wc * 32 + 4 * fq;
        float* Cb = u.ks < 0 ? C : part + (size_t)u.ks * NSM * D - (size_t)NPR * ldc;
#pragma unroll
        for (int ai = 0; ai < 2; ++ai)
#pragma unroll
            for (int m = 0; m < 4; ++m) { float* rowp = Cb + (size_t)(row0 + ai * HALF + m * 16) * ldc + col0;
#pragma unroll
                for (int bj = 0; bj < 2; ++bj)
#pragma unroll
                    for (int n = 0; n < 2; ++n) *(f32x4*)(rowp + bj * HALF + n * 16) = acc[ai][bj][m][n]; }
    }
};
struct EpiBf16 {
    static constexpr bool PERM = true;
    bf16_t* O; int ldc; float* part;
    DEV void operator()(const f32x4 (&acc)[2][2][4][2], const Unit& u, int wr, int wc, int fr, int fq) const {
        const int row0 = u.pm * BM + wr * 64 + fr; const int col0 = u.pn * BM + wc * 32 + 8 * fq;
        if (u.ks >= 0) {
            bf16_t* pb = (bf16_t*)part + (size_t)u.ks * NSM * ldc + (size_t)(row0 - NPR) * ldc + col0;
#pragma unroll
            for (int ai = 0; ai < 2; ++ai)
#pragma unroll
                for (int m = 0; m < 4; ++m)
#pragma unroll
                    for (int bj = 0; bj < 2; ++bj) { const f32x4 v0 = acc[ai][bj][m][0], v1 = acc[ai][bj][m][1];
                        u32x4 w; w.x = cvt_pk_bf16(v0[0], v0[1]); w.y = cvt_pk_bf16(v0[2], v0[3]); w.z = cvt_pk_bf16(v1[0], v1[1]); w.w = cvt_pk_bf16(v1[2], v1[3]);
                        *(u32x4*)(pb + (size_t)(ai * HALF + m * 16) * ldc + bj * HALF) = w; }
            return;
        }
#pragma unroll
        for (int ai = 0; ai < 2; ++ai)
#pragma unroll
            for (int m = 0; m < 4; ++m) { bf16_t* rowp = O + (size_t)(row0 + ai * HALF + m * 16) * ldc + col0;
#pragma unroll
                for (int bj = 0; bj < 2; ++bj) { const f32x4 v0 = acc[ai][bj][m][0], v1 = acc[ai][bj][m][1];
                    u32x4 w; w.x = cvt_pk_bf16(v0[0], v0[1]); w.y = cvt_pk_bf16(v0[2], v0[3]); w.z = cvt_pk_bf16(v1[0], v1[1]); w.w = cvt_pk_bf16(v1[2], v1[3]);
                    *(u32x4*)(rowp + bj * HALF) = w; } }
    }
};

template <class Epi, class Sched>
DEV void gemm_phase(LAS unsigned char* lds, const Gemm g, const Sched& S, const Epi& E) {
    int tid_ = threadIdx.x; asm volatile("" : "+v"(tid_)); const int tid = tid_, wid = __builtin_amdgcn_readfirstlane(tid >> 6), lane = tid & 63, wr = wid >> 2, wc = wid & 3, fr = lane & 15, fq = lane >> 4;
    const int K = g.K;
    unsigned voffA[2], voffB[2];
#pragma unroll
    for (int i = 0; i < 2; ++i) { int R, C; stage_rc(tid * 16 + i * 8192, R, C); const int Rb = Epi::PERM ? ((R & ~31) + perm32(R & 31)) : R;
        voffA[i] = (unsigned)(R * K + C) * 2u; voffB[i] = (unsigned)(Rb * K + C) * 2u; }
    const size_t kstep = (size_t)(BK * 2);
    const size_t hstep = (size_t)HALF * K * 2;
    const size_t tstep = 2 * hstep;
    const unsigned ldsw = (unsigned)wid * 1024u;
    const int aoff = lds_byte(wr * 64 + fr, fq * 8), boff = lds_byte(wc * 32 + fr, fq * 8);
#define PG8_SA(b, h) (((b) * 2 + (h)) * HTB)
#define PG8_SB(b, h) ((4 + (b) * 2 + (h)) * HTB)
#define PG8_STAGE(bufoff, gbase, voff) do { _Pragma("unroll") for (int _i = 0; _i < 2; ++_i) \
        __builtin_amdgcn_global_load_lds((const unsigned*)((const char*)(gbase) + (voff)[_i]), (LAS unsigned*)(lds + (bufoff) + ldsw + _i * 8192), 16, 0, 0); } while (0)
#define PG8_LDA(dst, b, h) do { _Pragma("unroll") for (int m = 0; m < 4; ++m) _Pragma("unroll") for (int k = 0; k < 2; ++k) dst[m][k] = *(const LAS bf16x8*)(lds + PG8_SA(b, h) + aoff + m * 2048 + k * 1024); } while (0)
#define PG8_LDB(dst, b, h) do { _Pragma("unroll") for (int n = 0; n < 2; ++n) _Pragma("unroll") for (int k = 0; k < 2; ++k) dst[n][k] = *(const LAS bf16x8*)(lds + PG8_SB(b, h) + boff + n * 2048 + k * 1024); } while (0)
#define PG8_MMA(ai, bj, At, Bt) do { __builtin_amdgcn_s_setprio(1); _Pragma("unroll") for (int m = 0; m < 4; ++m) _Pragma("unroll") for (int n = 0; n < 2; ++n) _Pragma("unroll") for (int k = 0; k < 2; ++k) \
        acc[ai][bj][m][n] = __builtin_amdgcn_mfma_f32_16x16x32_bf16(Bt[n][k], At[m][k], acc[ai][bj][m][n], 0, 0, 0); __builtin_amdgcn_s_setprio(0); } while (0)
#define PG8_WAIT_V(n) asm volatile("s_waitcnt vmcnt(" #n ")" ::: "memory")
#define PG8_WAIT_L(n) asm volatile("s_waitcnt lgkmcnt(" #n ")" ::: "memory")
#define PG8_BAR __builtin_amdgcn_s_barrier()
#define PG8_SCHED __builtin_amdgcn_sched_barrier(0)
    Unit cur, nxt; int ui = 0;
    if (!S.next(0, cur)) return;
    f32x4 acc[2][2][4][2];
#pragma unroll
    for (int a = 0; a < 2; ++a)
#pragma unroll
        for (int b = 0; b < 2; ++b)
#pragma unroll
            for (int m = 0; m < 4; ++m)
#pragma unroll
                for (int n = 0; n < 2; ++n) acc[a][b][m][n] = (f32x4){0.f, 0.f, 0.f, 0.f};
    bf16x8 At[4][2], B0[2][2], B1[2][2];
    const char* cA = (const char*)g.A + (size_t)cur.pm * tstep + (size_t)cur.k0 * 2; const char* cB = (const char*)g.Bt + (size_t)cur.pn * tstep + (size_t)cur.k0 * 2;
    PG8_STAGE(PG8_SB(0, 0), cB, voffB); PG8_STAGE(PG8_SA(0, 0), cA, voffA); PG8_STAGE(PG8_SB(0, 1), cB + hstep, voffB); PG8_STAGE(PG8_SA(0, 1), cA + hstep, voffA);
    if (wr == 1) PG8_BAR;
    PG8_WAIT_V(4); PG8_BAR;
    PG8_STAGE(PG8_SB(1, 0), cB + kstep, voffB); PG8_STAGE(PG8_SA(1, 0), cA + kstep, voffA); PG8_STAGE(PG8_SB(1, 1), cB + hstep + kstep, voffB);
    PG8_WAIT_V(6); PG8_BAR;
    for (;;) {
        const bool has_next = S.next(ui + 1, nxt);
        const char* nA = has_next ? (const char*)g.A + (size_t)nxt.pm * tstep + (size_t)nxt.k0 * 2 : cA; const char* nB = has_next ? (const char*)g.Bt + (size_t)nxt.pn * tstep + (size_t)nxt.k0 * 2 : cB;
        const int nt = cur.nt;
        for (int t = 0; t < nt; t += 2) {
            const bool last = (t == nt - 2);
            const char* a1 = cA + (size_t)(t + 1) * kstep;
            const char* a2 = last ? nA : cA + (size_t)(t + 2) * kstep; const char* b2 = last ? nB : cB + (size_t)(t + 2) * kstep;
            const char* a3 = a2 + kstep; const char* b3 = b2 + kstep;
            PG8_LDB(B0, 0, 0); PG8_SCHED; PG8_LDA(At, 0, 0); PG8_STAGE(PG8_SA(1, 1), a1 + hstep, voffA);
            PG8_WAIT_L(8); PG8_BAR; PG8_WAIT_L(0); PG8_MMA(0, 0, At, B0); PG8_BAR; PG8_SCHED;
            PG8_LDB(B1, 0, 1); PG8_STAGE(PG8_SB(0, 0), b2, voffB);
            PG8_BAR; PG8_WAIT_L(0); PG8_MMA(0, 1, At, B1); PG8_BAR;
            PG8_LDA(At, 0, 1); PG8_STAGE(PG8_SA(0, 0), a2, voffA);
            PG8_BAR; PG8_WAIT_L(0); PG8_MMA(1, 0, At, B0); PG8_BAR; PG8_SCHED;
            PG8_STAGE(PG8_SB(0, 1), b2 + hstep, voffB);
            PG8_WAIT_V(6); PG8_BAR; PG8_MMA(1, 1, At, B1); PG8_BAR;
            PG8_LDB(B0, 1, 0); PG8_SCHED; PG8_LDA(At, 1, 0); PG8_STAGE(PG8_SA(0, 1), a2 + hstep, voffA);
            PG8_WAIT_L(8); PG8_BAR; PG8_WAIT_L(0); PG8_MMA(0, 0, At, B0); PG8_BAR; PG8_SCHED;
            PG8_LDB(B1, 1, 1); PG8_STAGE(PG8_SB(1, 0), b3, voffB);
            PG8_BAR; PG8_WAIT_L(0); PG8_MMA(0, 1, At, B1); PG8_BAR;
            PG8_LDA(At, 1, 1); PG8_STAGE(PG8_SA(1, 0), a3, voffA);
            PG8_BAR; PG8_WAIT_L(0); PG8_MMA(1, 0, At, B0); PG8_BAR; PG8_SCHED;
            PG8_STAGE(PG8_SB(1, 1), b3 + hstep, voffB);
            PG8_WAIT_V(6); PG8_BAR; PG8_MMA(1, 1, At, B1); PG8_BAR;
        }
        E(acc, cur, wr, wc, fr, fq);
        if (!has_next) break;
#pragma unroll
        for (int a = 0; a < 2; ++a)
#pragma unroll
            for (int b = 0; b < 2; ++b)
#pragma unroll
                for (int m = 0; m < 4; ++m)
#pragma unroll
                    for (int n = 0; n < 2; ++n) acc[a][b][m][n] = (f32x4){0.f, 0.f, 0.f, 0.f};
        cur = nxt; cA = nA; cB = nB; ++ui;
    }
    PG8_WAIT_V(0);
    if (wr == 0) PG8_BAR;
    PG8_BAR;
#undef PG8_SA
#undef PG8_SB
#undef PG8_STAGE
#undef PG8_LDA
#undef PG8_LDB
#undef PG8_MMA
#undef PG8_WAIT_V
#undef PG8_WAIT_L
#undef PG8_BAR
#undef PG8_SCHED
}
}

DEV int win_srccol(int n) { return n < 4096 ? n : (n < 6656 ? n + 8 : (n < 6664 ? n - 2560 : (n < 6680 ? n : -1))); }
DEV void transpose_tile(const float* __restrict__ src, int srcN, bf16_t* __restrict__ dst, int K, int n0, int k0, int mode, float* tile) {
    int tid_ = threadIdx.x; asm volatile("" : "+v"(tid_)); const int tid = tid_;
    f32x4 v[4];
#pragma unroll
    for (int i = 0; i < 4; ++i) {
        const int kk = (tid >> 5) + 16 * i, nn4 = (tid & 31) * 4, n = n0 + nn4;
        const int sc = mode ? win_srccol(n) : n;
        v[i] = (f32x4){0.f, 0.f, 0.f, 0.f};
        if (sc >= 0) v[i] = __builtin_nontemporal_load((const f32x4*)(src + (size_t)(k0 + kk) * srcN + sc));
        if (mode && n >= 1024 && n < 2048) v[i] = v[i] * 0.0625f;
    }
#pragma unroll
    for (int i = 0; i < 4; ++i) {
        const int kk = (tid >> 5) + 16 * i, nn4 = (tid & 31) * 4;
        tile[kk * 129 + nn4 + 0] = v[i][0]; tile[kk * 129 + nn4 + 1] = v[i][1]; tile[kk * 129 + nn4 + 2] = v[i][2]; tile[kk * 129 + nn4 + 3] = v[i][3];
    }
    __syncthreads();
#pragma unroll
    for (int i = 0; i < 2; ++i) {
        const int ch = tid + 512 * i, nn = ch >> 3, kk8 = (ch & 7) * 8;
        u32x4 w;
        w.x = pk2(tile[(kk8 + 0) * 129 + nn], tile[(kk8 + 1) * 129 + nn]); w.y = pk2(tile[(kk8 + 2) * 129 + nn], tile[(kk8 + 3) * 129 + nn]);
        w.z = pk2(tile[(kk8 + 4) * 129 + nn], tile[(kk8 + 5) * 129 + nn]); w.w = pk2(tile[(kk8 + 6) * 129 + nn], tile[(kk8 + 7) * 129 + nn]);
        *(u32x4*)(dst + (size_t)(n0 + nn) * K + k0 + kk8) = w;
    }
    __syncthreads();
}
constexpr int T_WIN = (INP / 128) * (D / 64), T_WOUT = (D / 128) * (D / 64), T_WUP = (DFF2 / 128) * (D / 64), T_WDN = (D / 128) * (DFF / 64);
constexpr int T_L = T_WIN + T_WOUT + T_WUP + T_WDN, T_X = NTOK * D / 4096;
DEV void phase_prologue(const P& p, unsigned char* lds, int l_lo, int l_hi, bool with_x, int b0, int nb, int rlo = 0, int rhi = T_L) {
    float* tile = (float*)lds;
    const int cnt = rhi - rlo;
    const int nw = (l_hi - l_lo) * cnt, total = nw + (with_x ? T_X : 0);
    for (int u = b0; u < total; u += nb) {
        if (u < nw) {
            const int l = l_lo + u / cnt; int r = rlo + u % cnt;
            if (r < T_WIN) { const int nt = r / (D / 64), kt = r % (D / 64);
                transpose_tile(p.w_in + (size_t)l * D * IN_DIM, IN_DIM, (bf16_t*)(p.ws + WS_WIN) + (size_t)l * INP * D, D, nt * 128, kt * 64, 1, tile); }
            else if ((r -= T_WIN) < T_WOUT) { const int nt = r / (D / 64), kt = r % (D / 64);
                transpose_tile(p.w_out + (size_t)l * D * D, D, (bf16_t*)(p.ws + WS_WOUT) + (size_t)l * D * D, D, nt * 128, kt * 64, 0, tile); }
            else if ((r -= T_WOUT) < T_WUP) { const int nt = r / (D / 64), kt = r % (D / 64);
                transpose_tile(p.w_up + (size_t)l * D * DFF2, DFF2, (bf16_t*)(p.ws + WS_WUP) + (size_t)l * DFF2 * D, D, nt * 128, kt * 64, 0, tile); }
            else { r -= T_WUP; const int nt = r / (DFF / 64), kt = r % (DFF / 64);
                transpose_tile(p.w_down + (size_t)l * DFF * D, D, (bf16_t*)(p.ws + WS_WDN) + (size_t)l * D * DFF, DFF, nt * 128, kt * 64, 0, tile); }
        } else {
            const size_t e = (size_t)(u - nw) * 4096 + threadIdx.x * 8;
            const float* s = e < (size_t)NPR * D ? p.x_prompt + e : p.x_sample + (e - (size_t)NPR * D);
            const f32x4 a = *(const f32x4*)s, b = *(const f32x4*)(s + 4);
            u32x4 w; w.x = pk2(a[0], a[1]); w.y = pk2(a[2], a[3]); w.z = pk2(b[0], b[1]); w.w = pk2(b[2], b[3]);
            *(u32x4*)((bf16_t*)(p.ws + WS_XB) + e) = w;
        }
    }
}

DEV void mlstm_local(const P& p, int l, int unit, unsigned char* lds) {
    const int bh = unit >> 5, c = unit & 31, b = bh >> 2, h = bh & 3;
    int tid_ = threadIdx.x; asm volatile("" : "+v"(tid_)); const int tid = tid_, lane = tid & 63, w = tid >> 6, fr = lane & 15, fq = lane >> 4;
    const bf16_t* U = (const bf16_t*)(p.ws + WS_U) + (size_t)(b * 2048 + c * 64) * INP;
    float* wsh = (float*)lds;
    bf16_t* KW = (bf16_t*)(lds + 1024);
    bf16_t* V = KW + 64 * 272;
    float* gstat = (float*)(p.ws + WS_GSTAT);
    if (w == 0) {
        const float ig = bf2f(U[(size_t)lane * INP + UIG + h]) + p.b_i[l * 4 + h];
        const float lf = logsigf_(bf2f(U[(size_t)lane * INP + UFG + h]) + p.b_f[l * 4 + h]);
        const float bs = wave_incl_sum(lf, lane);
        const float a = ig - bs;
        const float amax = wave_max(a);
        const float bsum = __shfl(bs, 63);
        wsh[lane] = __expf(a - amax);
        if (lane == 0) { gstat[(bh * 32 + c) * 2] = bsum; gstat[(bh * 32 + c) * 2 + 1] = bsum + amax; }
    }
    __syncthreads();
#pragma unroll
    for (int i = 0; i < 4; ++i) {
        const int it = tid + 512 * i, s_ = it >> 5, d8 = (it & 31) * 8;
        const uint4 kv = *(const uint4*)(U + (size_t)s_ * INP + UK + h * 256 + d8);
        const uint4 vv = *(const uint4*)(U + (size_t)s_ * INP + UV + h * 256 + d8);
        const float ws_ = wsh[s_];
        float kf[8]; unpack8(kv, kf);
        u32x4 kw; kw.x = pk2(kf[0] * ws_, kf[1] * ws_); kw.y = pk2(kf[2] * ws_, kf[3] * ws_); kw.z = pk2(kf[4] * ws_, kf[5] * ws_); kw.w = pk2(kf[6] * ws_, kf[7] * ws_);
        *(u32x4*)(KW + s_ * 272 + d8) = kw;
        *(uint4*)(V + s_ * 272 + d8) = vv;
    }
    __syncthreads();
    if (tid < 256) { float a = 0.f; for (int s_ = 0; s_ < 64; ++s_) a += bf2f(KW[s_ * 272 + tid]); ((float*)(p.ws + WS_NLOC))[(size_t)(bh * 32 + c) * 256 + tid] = a; }
    f32x4 acc[2][16];
#pragma unroll
    for (int m = 0; m < 2; ++m)
#pragma unroll
        for (int n = 0; n < 16; ++n) acc[m][n] = (f32x4){0.f, 0.f, 0.f, 0.f};
#pragma unroll
    for (int ks = 0; ks < 2; ++ks) {
        bf16x8 vf[2];
#pragma unroll
        for (int m = 0; m < 2; ++m) vf[m] = tr_frag(V, 272, 32 * ks, 32 * w + 16 * m, lane);
#pragma unroll
        for (int n = 0; n < 16; ++n) {
            const bf16x8 kf = tr_frag(KW, 272, 32 * ks, 16 * n, lane);
#pragma unroll
            for (int m = 0; m < 2; ++m) acc[m][n] = mfma16(kf, vf[m], acc[m][n]);
        }
    }
    bf16_t* Dp = (bf16_t*)(p.ws + WS_DBUF) + (size_t)(bh * 32 + c) * 65536;
#pragma unroll
    for (int m = 0; m < 2; ++m)
#pragma unroll
        for (int n = 0; n < 16; ++n) { u32x2 wv; wv.x = pk2(acc[m][n][0], acc[m][n][1]); wv.y = pk2(acc[m][n][2], acc[m][n][3]);
            *(u32x2*)(Dp + (32 * w + 16 * m + fr) * 256 + 16 * n + fq * 4) = wv; }
    __syncthreads();
}

DEV void mlstm_scan(const P& p, int l, int unit, unsigned char* lds) {
    int tid_ = threadIdx.x; asm volatile("" : "+v"(tid_)); const int bh = unit >> 4, slab = unit & 15, tid = tid_;
    float* fA = (float*)lds; float* fB = fA + 32;
    const float* gstat = (const float*)(p.ws + WS_GSTAT);
    if (tid == 0) {
        float m = 0.f;
        for (int c = 0; c < 32; ++c) {
            const float bsum = gstat[(bh * 32 + c) * 2], mloc = gstat[(bh * 32 + c) * 2 + 1];
            const float mn = fmaxf(bsum + m, mloc);
            fA[c] = __expf(bsum + m - mn); fB[c] = __expf(mloc - mn); m = mn;
            if (slab == 0) ((float*)(p.ws + WS_MST))[bh * 32 + c] = mn;
        }
        if (slab == 0) p.out[O_PM + l * 16 + bh] = m;
    }
    __syncthreads();
    const size_t e0 = (size_t)slab * 4096 + tid * 8;
    float run[8];
#pragma unroll
    for (int i = 0; i < 8; ++i) run[i] = 0.f;
    const bf16_t* Dp = (const bf16_t*)(p.ws + WS_DBUF) + (size_t)bh * 32 * 65536 + e0;
    bf16_t* Cp = (bf16_t*)(p.ws + WS_CT) + (size_t)bh * 32 * 65536 + e0;
#pragma unroll 1
    for (int cb = 0; cb < 32; cb += 8) {
        uint4 xx[8];
#pragma unroll
        for (int j = 0; j < 8; ++j) xx[j] = *(const uint4*)(Dp + (size_t)(cb + j) * 65536);
#pragma unroll
        for (int j = 0; j < 8; ++j) {
            const int c = cb + j;
            const float a = fA[c], bq = fB[c];
            float xf[8]; unpack8(xx[j], xf);
#pragma unroll
            for (int i = 0; i < 8; ++i) run[i] = a * run[i] + bq * xf[i];
            u32x4 wv; wv.x = pk2(run[0], run[1]); wv.y = pk2(run[2], run[3]); wv.z = pk2(run[4], run[5]); wv.w = pk2(run[6], run[7]);
            *(u32x4*)(Cp + (size_t)c * 65536) = wv;
        }
    }
    {
        float* o = p.out + O_PC + (size_t)(l * 16 + bh) * 65536;
        const int e = (int)(e0 >> 8), d0 = (int)(e0 & 255);
#pragma unroll
        for (int i = 0; i < 8; ++i) o[(d0 + i) * 256 + e] = run[i];
    }
    if (slab == 0 && tid < 256) {
        float r = 0.f;
        const float* nl = (const float*)(p.ws + WS_NLOC) + (size_t)bh * 32 * 256 + tid;
        float* ns = (float*)(p.ws + WS_NST) + (size_t)bh * 32 * 256 + tid;
        for (int c = 0; c < 32; ++c) { r = fA[c] * r + fB[c] * nl[c * 256]; ns[c * 256] = r; }
        p.out[O_PN + (size_t)(l * 16 + bh) * 256 + tid] = r;
    }
    __syncthreads();
}

DEV void ssd_scan(const P& p, int l, int unit, unsigned char* lds) {
    int tid_ = threadIdx.x; asm volatile("" : "+v"(tid_)); const int bhd = unit >> 2, slab = unit & 3, tid = tid_;
    float* dec = (float*)lds;
    if (tid < 32) dec[tid] = __expf(((const float*)(p.ws + WS_SBSUM))[bhd * 32 + tid]);
    __syncthreads();
    const size_t e0 = (size_t)slab * 2048 + tid * 4;
    f32x4 run = (f32x4){0.f, 0.f, 0.f, 0.f};
    const bf16_t* Sp = (const bf16_t*)(p.ws + WS_SBUF) + (size_t)bhd * 32 * 8192 + e0;
    bf16_t* Tp = (bf16_t*)(p.ws + WS_ST) + (size_t)bhd * 32 * 8192 + e0;
#pragma unroll 1
    for (int cb = 0; cb < 32; cb += 8) {
        uint2 xx[8];
#pragma unroll
        for (int j = 0; j < 8; ++j) xx[j] = *(const uint2*)(Sp + (size_t)(cb + j) * 8192);
#pragma unroll
        for (int j = 0; j < 8; ++j) {
            run = run * dec[cb + j] + (f32x4){bflo(xx[j].x), bfhi(xx[j].x), bflo(xx[j].y), bfhi(xx[j].y)};
            u32x2 wv; wv.x = pk2(run[0], run[1]); wv.y = pk2(run[2], run[3]);
            *(u32x2*)(Tp + (size_t)(cb + j) * 8192) = wv;
        }
    }
    *(f32x4*)(p.out + O_PS + (size_t)(l * 64 + bhd) * 8192 + e0) = run;
    __syncthreads();
}

DEV void convstate_copy(const P& p, int l, int unit) {
    const bf16_t* Ub = (const bf16_t*)(p.ws + WS_U);
    int tid_ = threadIdx.x; asm volatile("" : "+v"(tid_));
    for (int i = tid_; i < 3 * 1536; i += NTHR) {
        const int j = i / 1536, ch = i % 1536;
        if (unit < 4) p.out[O_PSC + ((size_t)(l * 4 + unit) * 3 + j) * 1536 + ch] = bf2f(Ub[(size_t)(unit * 2048 + 2045 + j) * INP + UXS + ch]);
        else { const int b = unit - 4; p.out[O_SSC + ((size_t)(l * 128 + b) * 3 + j) * 1536 + ch] = bf2f(Ub[(size_t)(NPR + b * 8 + 5 + j) * INP + UXS + ch]); }
    }
}

DEV void mlstm_out(const P& p, int l, int unit, unsigned char* lds) {
    const int bh = unit >> 5, c = unit & 31, b = bh >> 2, h = bh & 3;
    int tid_ = threadIdx.x; asm volatile("" : "+v"(tid_)); const int tid = tid_, lane = tid & 63, w = tid >> 6, fr = lane & 15, fq = lane >> 4;
    const int r0 = b * 2048 + c * 64;
    const bf16_t* U = (const bf16_t*)(p.ws + WS_U) + (size_t)r0 * INP;
    bf16_t* Qs = (bf16_t*)lds;
    bf16_t* Ks = Qs + 64 * 264;
    bf16_t* V = Ks + 64 * 264;
    bf16_t* Ss = V + 64 * 272;
    float* fl = (float*)(lds + 113664);
    float* bsh = fl; float* ash = fl + 64; float* mth = fl + 128; float* wint = fl + 192; float* rdn = fl + 256; float* qn = fl + 320; float* nprev = fl + 384; float* red = fl + 640;
    float* stat = fl + 1152;
    if (w == 0) {
        const float ig = bf2f(U[(size_t)lane * INP + UIG + h]) + p.b_i[l * 4 + h];
        const float lf = logsigf_(bf2f(U[(size_t)lane * INP + UFG + h]) + p.b_f[l * 4 + h]);
        const float bs = wave_incl_sum(lf, lane);
        const float a = ig - bs;
        const float cm = wave_incl_max(a, lane);
        const float mprev = c > 0 ? ((const float*)(p.ws + WS_MST))[bh * 32 + c - 1] : 0.f;
        const float mt = bs + fmaxf(mprev, cm);
        bsh[lane] = bs; ash[lane] = a; mth[lane] = mt; wint[lane] = __expf(bs + mprev - mt);
    }
    if (tid >= 256) { const int d = tid - 256; nprev[d] = c > 0 ? ((const float*)(p.ws + WS_NST))[(size_t)(bh * 32 + c - 1) * 256 + d] : 0.f; }
#pragma unroll
    for (int i = 0; i < 4; ++i) {
        const int it = tid + 512 * i, s_ = it >> 5, d8 = (it & 31) * 8;
        *(uint4*)(Qs + s_ * 264 + d8) = *(const uint4*)(U + (size_t)s_ * INP + UQ + h * 256 + d8);
        *(uint4*)(Ks + s_ * 264 + d8) = *(const uint4*)(U + (size_t)s_ * INP + UK + h * 256 + d8);
        *(uint4*)(V + s_ * 272 + d8) = *(const uint4*)(U + (size_t)s_ * INP + UV + h * 256 + d8);
    }
    __syncthreads();
    {
        const int mt_ = w >> 1, nt0 = (w & 1) * 2;
        f32x4 sacc[2] = {(f32x4){0.f, 0.f, 0.f, 0.f}, (f32x4){0.f, 0.f, 0.f, 0.f}};
#pragma unroll
        for (int k0 = 0; k0 < 256; k0 += 32) {
            const bf16x8 a = *(const bf16x8*)(Qs + (16 * mt_ + fr) * 264 + k0 + fq * 8);
#pragma unroll
            for (int n = 0; n < 2; ++n) { const bf16x8 bb = *(const bf16x8*)(Ks + (16 * (nt0 + n) + fr) * 264 + k0 + fq * 8); sacc[n] = mfma16(a, bb, sacc[n]); }
        }
#pragma unroll
        for (int n = 0; n < 2; ++n)
#pragma unroll
            for (int j = 0; j < 4; ++j) {
                const int t = 16 * mt_ + fq * 4 + j, s_ = 16 * (nt0 + n) + fr;
                const float val = (s_ <= t) ? sacc[n][j] * __expf(bsh[t] - mth[t] + ash[s_]) : 0.f;
                Ss[t * 72 + s_] = f2bf(val);
            }
        const int t = tid >> 3, part = tid & 7;
        float a = 0.f;
        for (int d = part * 32; d < part * 32 + 32; ++d) a += bf2f(Qs[t * 264 + d]) * nprev[d];
        a += __shfl_xor(a, 1); a += __shfl_xor(a, 2); a += __shfl_xor(a, 4);
        if (part == 0) qn[t] = a;
    }
    __syncthreads();
    if (tid < 64) {
        float di = 0.f;
        for (int s_ = 0; s_ < 64; ++s_) di += bf2f(Ss[tid * 72 + s_]);
        const float den = di + wint[tid] * qn[tid];
        rdn[tid] = 1.0f / fmaxf(fabsf(den), __expf(-mth[tid]));
    }
    const int e0 = 32 * w;
    f32x4 acc1[4][2], acc2[4][2];
#pragma unroll
    for (int m = 0; m < 4; ++m)
#pragma unroll
        for (int n = 0; n < 2; ++n) { acc1[m][n] = (f32x4){0.f, 0.f, 0.f, 0.f}; acc2[m][n] = (f32x4){0.f, 0.f, 0.f, 0.f}; }
#pragma unroll
    for (int ks = 0; ks < 2; ++ks) {
        bf16x8 sf[4];
#pragma unroll
        for (int m = 0; m < 4; ++m) sf[m] = *(const bf16x8*)(Ss + (16 * m + fr) * 72 + 32 * ks + fq * 8);
#pragma unroll
        for (int n = 0; n < 2; ++n) { const bf16x8 vf = tr_frag(V, 272, 32 * ks, e0 + 16 * n, lane);
#pragma unroll
            for (int m = 0; m < 4; ++m) acc1[m][n] = mfma16(vf, sf[m], acc1[m][n]); }
    }
    if (c > 0) {
        const bf16_t* CTp = (const bf16_t*)(p.ws + WS_CT) + (size_t)(bh * 32 + c - 1) * 65536;
#pragma unroll 2
        for (int k0 = 0; k0 < 256; k0 += 32) {
            bf16x8 a[4];
#pragma unroll
            for (int m = 0; m < 4; ++m) a[m] = *(const bf16x8*)(Qs + (16 * m + fr) * 264 + k0 + fq * 8);
#pragma unroll
            for (int n = 0; n < 2; ++n) { const bf16x8 cf = *(const bf16x8*)(CTp + (size_t)(e0 + 16 * n + fr) * 256 + k0 + fq * 8);
#pragma unroll
                for (int m = 0; m < 4; ++m) acc2[m][n] = mfma16(cf, a[m], acc2[m][n]); }
        }
    }
    __syncthreads();
#pragma unroll
    for (int m = 0; m < 4; ++m) {
        const int t = 16 * m + fr;
        const float wi = wint[t], rd = rdn[t];
        float sm = 0.f;
#pragma unroll
        for (int n = 0; n < 2; ++n)
#pragma unroll
            for (int j = 0; j < 4; ++j) { const float hv = (acc1[m][n][j] + wi * acc2[m][n][j]) * rd; acc1[m][n][j] = hv; sm += hv; }
        sm += __shfl_xor(sm, 16); sm += __shfl_xor(sm, 32);
        if (fq == 0) red[t * 8 + w] = sm;
    }
    __syncthreads();
    if (tid < 64) { float sm = 0.f;
#pragma unroll
        for (int i = 0; i < 8; ++i) sm += red[tid * 8 + i];
        stat[tid] = sm * (1.0f / 256.0f); }
    __syncthreads();
#pragma unroll
    for (int m = 0; m < 4; ++m) {
        const int t = 16 * m + fr;
        const float mu = stat[t];
        float sm = 0.f;
#pragma unroll
        for (int n = 0; n < 2; ++n)
#pragma unroll
            for (int j = 0; j < 4; ++j) { const float dv = acc1[m][n][j] - mu; acc1[m][n][j] = dv; sm += dv * dv; }
        sm += __shfl_xor(sm, 16); sm += __shfl_xor(sm, 32);
        if (fq == 0) red[t * 8 + w] = sm;
    }
    __syncthreads();
    if (tid < 64) { float sm = 0.f;
#pragma unroll
        for (int i = 0; i < 8; ++i) sm += red[tid * 8 + i];
        stat[64 + tid] = rsqrtf(sm * (1.0f / 256.0f) + 1e-6f); }
    __syncthreads();
    bf16_t* MX = (bf16_t*)(p.ws + WS_MIXIN);
#pragma unroll
    for (int m = 0; m < 4; ++m) {
        const int t = 16 * m + fr;
        const float rs = stat[64 + t];
#pragma unroll
        for (int n = 0; n < 2; ++n) {
            const int e4 = e0 + 16 * n + fq * 4;
            const uint2 ov = *(const uint2*)(U + (size_t)t * INP + UO + h * 256 + e4);
            const f32x4 nw = *(const f32x4*)(p.m_norm_w + l * 1024 + h * 256 + e4);
            u32x2 wv;
            wv.x = pk2(acc1[m][n][0] * rs * nw[0] * sigmoidf_(bflo(ov.x)), acc1[m][n][1] * rs * nw[1] * sigmoidf_(bfhi(ov.x)));
            wv.y = pk2(acc1[m][n][2] * rs * nw[2] * sigmoidf_(bflo(ov.y)), acc1[m][n][3] * rs * nw[3] * sigmoidf_(bfhi(ov.y)));
            *(u32x2*)(MX + (size_t)(r0 + t) * D + h * 256 + e4) = wv;
        }
    }
    __syncthreads();
}

DEV void ssd_conv8(const bf16_t* Urow, int tpos, const float* cw, const float* cb, int ch8, float (&o)[8]) {
    const f32x4 b0 = *(const f32x4*)(cb + ch8), b1 = *(const f32x4*)(cb + ch8 + 4);
    o[0] = b0[0]; o[1] = b0[1]; o[2] = b0[2]; o[3] = b0[3]; o[4] = b1[0]; o[5] = b1[1]; o[6] = b1[2]; o[7] = b1[3];
#pragma unroll
    for (int j = 0; j < 4; ++j) {
        const int back = 3 - j;
        if (tpos - back >= 0) {
            const uint4 x = *(const uint4*)(Urow - (size_t)back * INP + UXS + ch8);
            float xf[8]; unpack8(x, xf);
            const f32x4 w0 = *(const f32x4*)(cw + j * 1536 + ch8), w1 = *(const f32x4*)(cw + j * 1536 + ch8 + 4);
            o[0] += w0[0] * xf[0]; o[1] += w0[1] * xf[1]; o[2] += w0[2] * xf[2]; o[3] += w0[3] * xf[3];
            o[4] += w1[0] * xf[4]; o[5] += w1[1] * xf[5]; o[6] += w1[2] * xf[6]; o[7] += w1[3] * xf[7];
        }
    }
#pragma unroll
    for (int i = 0; i < 8; ++i) o[i] = siluf_(o[i]);
}

DEV void ssd_local(const P& p, int l, int unit, unsigned char* lds) {
    const int b = unit >> 6, g = (unit >> 5) & 1, c = unit & 31;
    int tid_ = threadIdx.x; asm volatile("" : "+v"(tid_)); const int tid = tid_, lane = tid & 63, w = tid >> 6, fr = lane & 15, fq = lane >> 4;
    const int r0 = b * 2048 + c * 64;
    const bf16_t* U = (const bf16_t*)(p.ws + WS_U) + (size_t)r0 * INP;
    bf16_t* XW = (bf16_t*)lds;
    bf16_t* Bmn = XW + 64 * 528;
    float* wsh = (float*)(lds + 86016);
    {
        const int head = g * 8 + w;
        const float dt = softplusf_(bf2f(U[(size_t)lane * INP + UDT + head]) + p.dt_bias[l * 16 + head]);
        const float a = -__expf(p.A_log[l * 16 + head]) * dt;
        const float bs = wave_incl_sum(a, lane);
        const float bL = __shfl(bs, 63);
        wsh[w * 64 + lane] = __expf(bL - bs) * dt;
        if (lane == 0) ((float*)(p.ws + WS_SBSUM))[(b * 16 + head) * 32 + c] = bL;
    }
    __syncthreads();
    const float* cw = p.s_conv_w + (size_t)l * 4 * 1536; const float* cb = p.s_conv_b + (size_t)l * 1536;
    bf16_t* XBC = (bf16_t*)(p.ws + WS_XBC) + (size_t)r0 * 1536;
    for (int i = 0; i < 12; ++i) {
        const int it = tid + 512 * i, t = it / 96, gidx = it % 96;
        const int ch8 = gidx < 64 ? g * 512 + gidx * 8 : (gidx < 80 ? 1024 + g * 128 + (gidx - 64) * 8 : 1280 + g * 128 + (gidx - 80) * 8);
        float v[8];
        ssd_conv8(U + (size_t)t * INP, c * 64 + t, cw, cb, ch8, v);
        { u32x4 wr_; wr_.x = pk2(v[0], v[1]); wr_.y = pk2(v[2], v[3]); wr_.z = pk2(v[4], v[5]); wr_.w = pk2(v[6], v[7]); *(u32x4*)(XBC + (size_t)t * 1536 + ch8) = wr_; }
        if (gidx >= 80) continue;
        if (gidx < 64) { const float sc = wsh[(gidx >> 3) * 64 + t];
            u32x4 wv; wv.x = pk2(v[0] * sc, v[1] * sc); wv.y = pk2(v[2] * sc, v[3] * sc); wv.z = pk2(v[4] * sc, v[5] * sc); wv.w = pk2(v[6] * sc, v[7] * sc);
            *(u32x4*)(XW + t * 528 + gidx * 8) = wv; }
        else { u32x4 wv; wv.x = pk2(v[0], v[1]); wv.y = pk2(v[2], v[3]); wv.z = pk2(v[4], v[5]); wv.w = pk2(v[6], v[7]);
            *(u32x4*)(Bmn + t * 144 + (gidx - 64) * 8) = wv; }
    }
    __syncthreads();
    f32x4 acc[4][8];
#pragma unroll
    for (int m = 0; m < 4; ++m)
#pragma unroll
        for (int n = 0; n < 8; ++n) acc[m][n] = (f32x4){0.f, 0.f, 0.f, 0.f};
#pragma unroll
    for (int ks = 0; ks < 2; ++ks) {
        bf16x8 xf[4];
#pragma unroll
        for (int m = 0; m < 4; ++m) xf[m] = tr_frag(XW, 528, 32 * ks, 64 * w + 16 * m, lane);
#pragma unroll
        for (int n = 0; n < 8; ++n) { const bf16x8 bf_ = tr_frag(Bmn, 144, 32 * ks, 16 * n, lane);
#pragma unroll
            for (int m = 0; m < 4; ++m) acc[m][n] = mfma16(bf_, xf[m], acc[m][n]); }
    }
    bf16_t* Sp = (bf16_t*)(p.ws + WS_SBUF) + (size_t)((b * 16 + g * 8 + w) * 32 + c) * 8192;
#pragma unroll
    for (int m = 0; m < 4; ++m)
#pragma unroll
        for (int n = 0; n < 8; ++n) { u32x2 wv; wv.x = pk2(acc[m][n][0], acc[m][n][1]); wv.y = pk2(acc[m][n][2], acc[m][n][3]); *(u32x2*)(Sp + (16 * m + fr) * 128 + 16 * n + fq * 4) = wv; }
    __syncthreads();
}

DEV void ssd_out(const P& p, int l, int unit, unsigned char* lds) {
    const int b = unit >> 6, g = (unit >> 5) & 1, c = unit & 31;
    int tid_ = threadIdx.x; asm volatile("" : "+v"(tid_)); const int tid = tid_, lane = tid & 63, w = tid >> 6, fr = lane & 15, fq = lane >> 4;
    const int r0 = b * 2048 + c * 64;
    const bf16_t* U = (const bf16_t*)(p.ws + WS_U) + (size_t)r0 * INP;
    bf16_t* Xs = (bf16_t*)lds;
    bf16_t* Bm = Xs + 64 * 528;
    bf16_t* Cm = Bm + 64 * 136;
    float* CB = (float*)(lds + 102400);
    float* bsh = (float*)(lds + 119808);
    float* dtsh = bsh + 512;
    float* red = dtsh + 512;
    float* stat = red + 512;
    const int head = g * 8 + w;
    {
        const float dt = softplusf_(bf2f(U[(size_t)lane * INP + UDT + head]) + p.dt_bias[l * 16 + head]);
        const float a = -__expf(p.A_log[l * 16 + head]) * dt;
        const float bs = wave_incl_sum(a, lane);
        bsh[w * 64 + lane] = bs; dtsh[w * 64 + lane] = dt;
    }
    const bf16_t* XBC = (const bf16_t*)(p.ws + WS_XBC) + (size_t)r0 * 1536;
#pragma unroll
    for (int i = 0; i < 12; ++i) {
        const int it = tid + 512 * i, t = it / 96, gidx = it % 96;
        const int ch8 = gidx < 64 ? g * 512 + gidx * 8 : (gidx < 80 ? 1024 + g * 128 + (gidx - 64) * 8 : 1280 + g * 128 + (gidx - 80) * 8);
        const u32x4 wv = *(const u32x4*)(XBC + (size_t)t * 1536 + ch8);
        if (gidx < 64) *(u32x4*)(Xs + t * 528 + gidx * 8) = wv;
        else if (gidx < 80) *(u32x4*)(Bm + t * 136 + (gidx - 64) * 8) = wv;
        else *(u32x4*)(Cm + t * 136 + (gidx - 80) * 8) = wv;
    }
    __syncthreads();
    {
        const int mt_ = w >> 1, nt0 = (w & 1) * 2;
        f32x4 cacc[2] = {(f32x4){0.f, 0.f, 0.f, 0.f}, (f32x4){0.f, 0.f, 0.f, 0.f}};
#pragma unroll
        for (int k0 = 0; k0 < 128; k0 += 32) {
            const bf16x8 a = *(const bf16x8*)(Cm + (16 * mt_ + fr) * 136 + k0 + fq * 8);
#pragma unroll
            for (int n = 0; n < 2; ++n) { const bf16x8 bb = *(const bf16x8*)(Bm + (16 * (nt0 + n) + fr) * 136 + k0 + fq * 8); cacc[n] = mfma16(a, bb, cacc[n]); }
        }
#pragma unroll
        for (int n = 0; n < 2; ++n)
#pragma unroll
            for (int j = 0; j < 4; ++j) CB[(16 * mt_ + fq * 4 + j) * 68 + 16 * (nt0 + n) + fr] = cacc[n][j];
    }
    __syncthreads();
    f32x4 acc1[4][4], acc2[4][4];
#pragma unroll
    for (int m = 0; m < 4; ++m)
#pragma unroll
        for (int n = 0; n < 4; ++n) { acc1[m][n] = (f32x4){0.f, 0.f, 0.f, 0.f}; acc2[m][n] = (f32x4){0.f, 0.f, 0.f, 0.f}; }
#pragma unroll
    for (int ks = 0; ks < 2; ++ks) {
        bf16x8 xf[4];
#pragma unroll
        for (int n = 0; n < 4; ++n) xf[n] = tr_frag(Xs, 528, 32 * ks, 64 * w + 16 * n, lane);
#pragma unroll
        for (int m = 0; m < 4; ++m) {
            if (ks * 32 > 16 * m + 15) continue;
            const int t = 16 * m + fr, s0 = 32 * ks + fq * 8;
            const float bt = bsh[w * 64 + t];
            const f32x4 c0 = *(const f32x4*)(CB + t * 68 + s0), c1 = *(const f32x4*)(CB + t * 68 + s0 + 4);
            float mv[8];
#pragma unroll
            for (int i = 0; i < 8; ++i) { const int s_ = s0 + i; const float cv = i < 4 ? c0[i & 3] : c1[i & 3];
                mv[i] = (s_ <= t) ? cv * __expf(bt - bsh[w * 64 + s_]) * dtsh[w * 64 + s_] : 0.f; }
            union { u32x4 u; bf16x8 v; } af;
            af.u.x = pk2(mv[0], mv[1]); af.u.y = pk2(mv[2], mv[3]); af.u.z = pk2(mv[4], mv[5]); af.u.w = pk2(mv[6], mv[7]);
#pragma unroll
            for (int n = 0; n < 4; ++n) acc1[m][n] = mfma16(xf[n], af.v, acc1[m][n]);
        }
    }
    if (c > 0) {
        const bf16_t* STp = (const bf16_t*)(p.ws + WS_ST) + (size_t)((b * 16 + head) * 32 + c - 1) * 8192;
#pragma unroll
        for (int k0 = 0; k0 < 128; k0 += 32) {
            bf16x8 a[4];
#pragma unroll
            for (int m = 0; m < 4; ++m) a[m] = *(const bf16x8*)(Cm + (16 * m + fr) * 136 + k0 + fq * 8);
#pragma unroll
            for (int n = 0; n < 4; ++n) { const bf16x8 sf = *(const bf16x8*)(STp + (16 * n + fr) * 128 + k0 + fq * 8);
#pragma unroll
                for (int m = 0; m < 4; ++m) acc2[m][n] = mfma16(sf, a[m], acc2[m][n]); }
        }
    }
    const float dsk = p.D_skip[l * 16 + head];
#pragma unroll
    for (int m = 0; m < 4; ++m) {
        const int t = 16 * m + fr;
        const float eb = __expf(bsh[w * 64 + t]);
        float sm = 0.f;
#pragma unroll
        for (int n = 0; n < 4; ++n) {
            const int pp4 = 16 * n + fq * 4;
            const uint2 xv = *(const uint2*)(Xs + t * 528 + 64 * w + pp4);
            const uint2 zv = *(const uint2*)(U + (size_t)t * INP + UZ + g * 512 + w * 64 + pp4);
            const float xs4[4] = {bflo(xv.x), bfhi(xv.x), bflo(xv.y), bfhi(xv.y)};
            const float z4[4] = {bflo(zv.x), bfhi(zv.x), bflo(zv.y), bfhi(zv.y)};
#pragma unroll
            for (int j = 0; j < 4; ++j) {
                const float y = acc1[m][n][j] + eb * acc2[m][n][j] + dsk * xs4[j];
                const float gt = y * z4[j] * sigmoidf_(z4[j]);
                acc1[m][n][j] = gt; sm += gt * gt;
            }
        }
        sm += __shfl_xor(sm, 16); sm += __shfl_xor(sm, 32);
        if (fq == 0) red[t * 8 + w] = sm;
    }
    __syncthreads();
    if (tid < 64) { float sm = 0.f;
#pragma unroll
        for (int i = 0; i < 8; ++i) sm += red[tid * 8 + i];
        stat[tid] = rsqrtf(sm * (1.0f / 512.0f) + 1e-6f); }
    __syncthreads();
    bf16_t* MX = (bf16_t*)(p.ws + WS_MIXIN);
#pragma unroll
    for (int m = 0; m < 4; ++m) {
        const int t = 16 * m + fr;
        const float rs = stat[t];
#pragma unroll
        for (int n = 0; n < 4; ++n) {
            const int ch = g * 512 + w * 64 + 16 * n + fq * 4;
            const f32x4 nw = *(const f32x4*)(p.s_norm_w + l * 1024 + ch);
            u32x2 wv; wv.x = pk2(acc1[m][n][0] * rs * nw[0], acc1[m][n][1] * rs * nw[1]); wv.y = pk2(acc1[m][n][2] * rs * nw[2], acc1[m][n][3] * rs * nw[3]);
            *(u32x2*)(MX + (size_t)(r0 + t) * D + 1024 + ch) = wv;
        }
    }
    __syncthreads();
}

DEV void smp_mlstm(const P& p, int l, int unit, unsigned char* lds) {
    const int b = unit >> 2, h = unit & 3;
    int tid_ = threadIdx.x; asm volatile("" : "+v"(tid_)); const int tid = tid_, lane = tid & 63, w = tid >> 6;
    const int r0 = NPR + b * 8;
    const bf16_t* U = (const bf16_t*)(p.ws + WS_U) + (size_t)r0 * INP;
    float* qn = (float*)lds; float* kn = qn + 2048; float* vn = kn + 2048; float* qT = vn + 2048; float* kwT = qT + 2048; float* sc = kwT + 2048; float* red = sc + 256;
    const size_t sidx = (size_t)(l * 128 + b) * 4 + h;
    const float* C0 = p.st_C + sidx * 65536; const float* n0 = p.st_n + sidx * 256;
    float* Cout = p.out + O_SC + sidx * 65536;
    if (tid == 0) {
        const float m0 = p.st_m[sidx];
        float bs = 0.f, cm = -INFINITY, mt = 0.f;
        for (int t = 0; t < 8; ++t) {
            const float ig = bf2f(U[(size_t)t * INP + UIG + h]) + p.b_i[l * 4 + h];
            const float lf = logsigf_(bf2f(U[(size_t)t * INP + UFG + h]) + p.b_f[l * 4 + h]);
            bs += lf; const float a = ig - bs; cm = fmaxf(cm, a); mt = bs + fmaxf(m0, cm);
            sc[32 + t] = mt; sc[t] = __expf(bs + m0 - mt); sc[40 + t] = a; sc[48 + t] = bs;
        }
        for (int s = 0; s < 8; ++s) sc[16 + s] = __expf(bs + sc[40 + s] - mt);
        sc[24] = __expf(bs + m0 - mt);
        p.out[O_SM + sidx] = mt;
    }
    __syncthreads();
#pragma unroll
    for (int i = 0; i < 4; ++i) {
        const int idx = tid + 512 * i, t = idx >> 8, d = idx & 255;
        const float q = bf2f(U[(size_t)t * INP + UQ + h * 256 + d]), k = bf2f(U[(size_t)t * INP + UK + h * 256 + d]), v = bf2f(U[(size_t)t * INP + UV + h * 256 + d]);
        qn[t * 256 + d] = q; kn[t * 256 + d] = k; vn[t * 256 + d] = v; qT[d * 8 + t] = q; kwT[d * 8 + t] = k * sc[16 + t];
    }
    __syncthreads();
    {
        const int t = w;
        const f32x4 qv = *(const f32x4*)(qn + t * 256 + lane * 4);
        float dot[9];
#pragma unroll
        for (int s = 0; s < 8; ++s) { const f32x4 kv = *(const f32x4*)(kn + s * 256 + lane * 4); dot[s] = qv[0] * kv[0] + qv[1] * kv[1] + qv[2] * kv[2] + qv[3] * kv[3]; }
        { const f32x4 nv = *(const f32x4*)(n0 + lane * 4); dot[8] = qv[0] * nv[0] + qv[1] * nv[1] + qv[2] * nv[2] + qv[3] * nv[3]; }
#pragma unroll
        for (int s = 0; s < 9; ++s) dot[s] = wave_sum(dot[s]);
        float den = 0.f;
#pragma unroll
        for (int s = 0; s < 8; ++s) { const float sv = (s <= t) ? dot[s] * __expf(sc[48 + t] - sc[32 + t] + sc[40 + s]) : 0.f; den += sv; if (lane == 0) sc[64 + t * 8 + s] = sv; }
        den += sc[t] * dot[8];
        if (lane == 0) sc[8 + t] = 1.0f / fmaxf(fabsf(den), __expf(-sc[32 + t]));
    }
    if (tid < 256) {
        float a = sc[24] * n0[tid];
#pragma unroll
        for (int s = 0; s < 8; ++s) a += kwT[tid * 8 + s];
        p.out[O_SN + sidx * 256 + tid] = a;
    }
    const int e4 = lane * 4;
    f32x4 num[8], vv[8];
#pragma unroll
    for (int t = 0; t < 8; ++t) { num[t] = (f32x4){0.f, 0.f, 0.f, 0.f}; vv[t] = *(const f32x4*)(vn + t * 256 + e4); }
    const float decay = sc[24];
    {
        f32x4 cn_[8];
#pragma unroll
        for (int j = 0; j < 8; ++j) cn_[j] = __builtin_nontemporal_load((const f32x4*)(C0 + (size_t)(w + 8 * j) * 256 + e4));
#pragma unroll 1
        for (int ib = 0; ib < 4; ++ib) {
            f32x4 cc[8];
#pragma unroll
            for (int j = 0; j < 8; ++j) cc[j] = cn_[j];
            if (ib < 3) {
#pragma unroll
                for (int j = 0; j < 8; ++j) cn_[j] = __builtin_nontemporal_load((const f32x4*)(C0 + (size_t)(w + 8 * ((ib + 1) * 8 + j)) * 256 + e4));
            }
#pragma unroll
            for (int j = 0; j < 8; ++j) {
                const int d = w + 8 * (ib * 8 + j);
                const f32x4 q0 = *(const f32x4*)(qT + d * 8), q1 = *(const f32x4*)(qT + d * 8 + 4), k0 = *(const f32x4*)(kwT + d * 8), k1 = *(const f32x4*)(kwT + d * 8 + 4);
                f32x4 cn = cc[j] * decay;
#pragma unroll
                for (int t = 0; t < 4; ++t) { num[t] += cc[j] * q0[t]; num[4 + t] += cc[j] * q1[t]; cn += vv[t] * k0[t]; cn += vv[4 + t] * k1[t]; }
                __builtin_nontemporal_store(cn, (f32x4*)(Cout + (size_t)d * 256 + e4));
            }
        }
    }
#pragma unroll
    for (int t = 0; t < 8; ++t) *(f32x4*)(red + (w * 8 + t) * 256 + e4) = num[t];
    __syncthreads();
    {
        const int t = w;
        f32x4 hv = (f32x4){0.f, 0.f, 0.f, 0.f};
#pragma unroll
        for (int ww = 0; ww < 8; ++ww) hv += *(const f32x4*)(red + (ww * 8 + t) * 256 + e4);
        hv = hv * sc[t];
#pragma unroll
        for (int s = 0; s < 8; ++s) hv += vv[s] * sc[64 + t * 8 + s];
        hv = hv * sc[8 + t];
        const float mu = wave_sum(hv[0] + hv[1] + hv[2] + hv[3]) * (1.0f / 256.0f);
        const f32x4 dv = hv - mu;
        const float var = wave_sum(dv[0] * dv[0] + dv[1] * dv[1] + dv[2] * dv[2] + dv[3] * dv[3]) * (1.0f / 256.0f);
        const float rs = rsqrtf(var + 1e-6f);
        const uint2 ov = *(const uint2*)(U + (size_t)t * INP + UO + h * 256 + e4);
        const f32x4 nw = *(const f32x4*)(p.m_norm_w + l * 1024 + h * 256 + e4);
        const float o0 = dv[0] * rs * nw[0] * sigmoidf_(bflo(ov.x)), o1 = dv[1] * rs * nw[1] * sigmoidf_(bfhi(ov.x));
        const float o2 = dv[2] * rs * nw[2] * sigmoidf_(bflo(ov.y)), o3 = dv[3] * rs * nw[3] * sigmoidf_(bfhi(ov.y));
        u32x2 wv; wv.x = pk2(o0, o1); wv.y = pk2(o2, o3);
        *(u32x2*)((bf16_t*)(p.ws + WS_MIXIN) + (size_t)(r0 + t) * D + h * 256 + e4) = wv;
    }
    __syncthreads();
}

DEV void smp_ssd(const P& p, int l, int unit, unsigned char* lds) {
    const int b = unit >> 1, g = unit & 1;
    int tid_ = threadIdx.x; asm volatile("" : "+v"(tid_)); const int tid = tid_, lane = tid & 63, w = tid >> 6, fr = lane & 15, fq = lane >> 4;
    const int r0 = NPR + b * 8;
    const bf16_t* U = (const bf16_t*)(p.ws + WS_U) + (size_t)r0 * INP;
    float* xs = (float*)lds;
    float* xwT = xs + 4096;
    float* Bmf = xwT + 4096;
    float* CBs = Bmf + 1024;
    float* bsh = CBs + 64;
    float* dtsh = bsh + 64;
    float* bLs = dtsh + 64;
    float* MW = bLs + 64;
    float* red = MW + 512;
    float* stat = red + 64;
    bf16_t* Cmb = (bf16_t*)(stat + 64);
    if (tid < 64) {
        const int hd = tid >> 3, t = tid & 7, head = g * 8 + hd;
        const float A = -__expf(p.A_log[l * 16 + head]), dtb = p.dt_bias[l * 16 + head];
        float bs = 0.f, bL = 0.f, dtt = 0.f;
        for (int s = 0; s < 8; ++s) { const float dt = softplusf_(bf2f(U[(size_t)s * INP + UDT + head]) + dtb); bL += dt * A; if (s <= t) bs += dt * A; if (s == t) dtt = dt; }
        bsh[hd * 8 + t] = bs; dtsh[hd * 8 + t] = dtt; if (t == 0) bLs[hd] = bL;
    }
    for (int i = tid; i < 8 * 136 / 2; i += NTHR) ((unsigned*)(Cmb + 8 * 136))[i] = 0u;
    const float* cw = p.s_conv_w + (size_t)l * 4 * 1536; const float* cb = p.s_conv_b + (size_t)l * 1536;
    const float* cv0 = p.st_sconv + (size_t)(l * 128 + b) * 3 * 1536;
    for (int i = 0; i < 2; ++i) {
        const int it = tid + 512 * i;
        if (it < 768) {
            const int t = it / 96, gidx = it % 96;
            const int ch8 = gidx < 64 ? g * 512 + gidx * 8 : (gidx < 80 ? 1024 + g * 128 + (gidx - 64) * 8 : 1280 + g * 128 + (gidx - 80) * 8);
            float o[8];
            { const f32x4 b0 = *(const f32x4*)(cb + ch8), b1 = *(const f32x4*)(cb + ch8 + 4); o[0] = b0[0]; o[1] = b0[1]; o[2] = b0[2]; o[3] = b0[3]; o[4] = b1[0]; o[5] = b1[1]; o[6] = b1[2]; o[7] = b1[3]; }
#pragma unroll
            for (int j = 0; j < 4; ++j) {
                const int idx = t + j;
                float xf[8];
                if (idx < 3) { const f32x4 a0 = *(const f32x4*)(cv0 + idx * 1536 + ch8), a1 = *(const f32x4*)(cv0 + idx * 1536 + ch8 + 4);
                    xf[0] = a0[0]; xf[1] = a0[1]; xf[2] = a0[2]; xf[3] = a0[3]; xf[4] = a1[0]; xf[5] = a1[1]; xf[6] = a1[2]; xf[7] = a1[3]; }
                else { const uint4 x = *(const uint4*)(U + (size_t)(idx - 3) * INP + UXS + ch8); unpack8(x, xf); }
                const f32x4 w0 = *(const f32x4*)(cw + j * 1536 + ch8), w1 = *(const f32x4*)(cw + j * 1536 + ch8 + 4);
                o[0] += w0[0] * xf[0]; o[1] += w0[1] * xf[1]; o[2] += w0[2] * xf[2]; o[3] += w0[3] * xf[3];
                o[4] += w1[0] * xf[4]; o[5] += w1[1] * xf[5]; o[6] += w1[2] * xf[6]; o[7] += w1[3] * xf[7];
            }
#pragma unroll
            for (int k = 0; k < 8; ++k) o[k] = siluf_(o[k]);
            if (gidx < 64) {
#pragma unroll
                for (int k = 0; k < 8; ++k) xs[t * 512 + gidx * 8 + k] = o[k]; }
            else if (gidx < 80) {
#pragma unroll
                for (int k = 0; k < 8; ++k) Bmf[t * 128 + (gidx - 64) * 8 + k] = o[k]; }
            else { u32x4 wv; wv.x = pk2(o[0], o[1]); wv.y = pk2(o[2], o[3]); wv.z = pk2(o[4], o[5]); wv.w = pk2(o[6], o[7]); *(u32x4*)(Cmb + t * 136 + (gidx - 80) * 8) = wv; }
        }
    }
    __syncthreads();
#pragma unroll
    for (int i = 0; i < 8; ++i) {
        const int idx = tid + 512 * i, hp = idx >> 3, s = idx & 7, hd = hp >> 6;
        xwT[hp * 8 + s] = xs[s * 512 + hp] * __expf(bLs[hd] - bsh[hd * 8 + s]) * dtsh[hd * 8 + s];
    }
    if (tid < 64) {
        const int t = tid >> 3, s = tid & 7; float a = 0.f;
        for (int n = 0; n < 128; ++n) a += bf2f(Cmb[t * 136 + n]) * Bmf[s * 128 + n];
        CBs[t * 8 + s] = a;
    }
    __syncthreads();
    { const int hd = tid >> 6, t = (tid >> 3) & 7, s = tid & 7;
      MW[tid] = (s <= t) ? CBs[t * 8 + s] * __expf(bsh[hd * 8 + t] - bsh[hd * 8 + s]) * dtsh[hd * 8 + s] : 0.f; }
    __syncthreads();
    const int head = g * 8 + w;
    const size_t sidx = (size_t)(l * 128 + b) * 16 + head;
    const float* S0 = p.st_ssm + sidx * 8192; float* So = p.out + O_SS + sidx * 8192;
    const float dA = __expf(bLs[w]);
    f32x4 acc[4];
    f32x4 svn[4][2];
#pragma unroll
    for (int ks = 0; ks < 4; ++ks) { svn[ks][0] = __builtin_nontemporal_load((const f32x4*)(S0 + fr * 128 + 32 * ks + fq * 8)); svn[ks][1] = __builtin_nontemporal_load((const f32x4*)(S0 + fr * 128 + 32 * ks + fq * 8 + 4)); }
#pragma unroll
    for (int nt = 0; nt < 4; ++nt) {
        acc[nt] = (f32x4){0.f, 0.f, 0.f, 0.f};
        const int pp = 16 * nt + fr;
        const f32x4 xw0 = *(const f32x4*)(xwT + (64 * w + pp) * 8), xw1 = *(const f32x4*)(xwT + (64 * w + pp) * 8 + 4);
        f32x4 sv[4][2];
#pragma unroll
        for (int ks = 0; ks < 4; ++ks) { sv[ks][0] = svn[ks][0]; sv[ks][1] = svn[ks][1]; }
        if (nt < 3) {
#pragma unroll
            for (int ks = 0; ks < 4; ++ks) { svn[ks][0] = __builtin_nontemporal_load((const f32x4*)(S0 + (pp + 16) * 128 + 32 * ks + fq * 8)); svn[ks][1] = __builtin_nontemporal_load((const f32x4*)(S0 + (pp + 16) * 128 + 32 * ks + fq * 8 + 4)); }
        }
#pragma unroll
        for (int ks = 0; ks < 4; ++ks) {
            const int n0 = 32 * ks + fq * 8;
            const f32x4 s0 = sv[ks][0], s1 = sv[ks][1];
            union { u32x4 u; bf16x8 v; } bfr;
            bfr.u.x = pk2(s0[0], s0[1]); bfr.u.y = pk2(s0[2], s0[3]); bfr.u.z = pk2(s1[0], s1[1]); bfr.u.w = pk2(s1[2], s1[3]);
            const bf16x8 af = *(const bf16x8*)(Cmb + fr * 136 + n0);
            acc[nt] = mfma16(af, bfr.v, acc[nt]);
            f32x4 o0 = s0 * dA, o1 = s1 * dA;
#pragma unroll
            for (int s = 0; s < 8; ++s) {
                const float xv = s < 4 ? xw0[s & 3] : xw1[s & 3];
                const f32x4 bm0 = *(const f32x4*)(Bmf + s * 128 + n0), bm1 = *(const f32x4*)(Bmf + s * 128 + n0 + 4);
                o0 += bm0 * xv; o1 += bm1 * xv;
            }
            __builtin_nontemporal_store(o0, (f32x4*)(So + pp * 128 + n0)); __builtin_nontemporal_store(o1, (f32x4*)(So + pp * 128 + n0 + 4));
        }
        asm volatile("" ::: "memory");
    }
    const float dsk = p.D_skip[l * 16 + head];
    float gts[4][4];
#pragma unroll
    for (int j = 0; j < 4; ++j) {
        const int t = (fq & 1) * 4 + j;
        const float eb = __expf(bsh[w * 8 + t]);
        float ssq = 0.f;
#pragma unroll
        for (int nt = 0; nt < 4; ++nt) {
            const int hp = 64 * w + 16 * nt + fr;
            float y = eb * acc[nt][j] + dsk * xs[t * 512 + hp];
#pragma unroll
            for (int s = 0; s < 8; ++s) y += MW[(w * 8 + t) * 8 + s] * xs[s * 512 + hp];
            const float z = bf2f(U[(size_t)t * INP + UZ + g * 512 + hp]);
            const float gt = y * siluf_(z);
            gts[nt][j] = gt; ssq += gt * gt;
        }
        ssq += __shfl_xor(ssq, 1); ssq += __shfl_xor(ssq, 2); ssq += __shfl_xor(ssq, 4); ssq += __shfl_xor(ssq, 8);
        if (fr == 0 && fq < 2) red[t * 8 + w] = ssq;
    }
    __syncthreads();
    if (tid < 8) { float s = 0.f;
#pragma unroll
        for (int i = 0; i < 8; ++i) s += red[tid * 8 + i];
        stat[tid] = rsqrtf(s * (1.0f / 512.0f) + 1e-6f); }
    __syncthreads();
    if (fq < 2) {
        bf16_t* MX = (bf16_t*)(p.ws + WS_MIXIN);
#pragma unroll
        for (int j = 0; j < 4; ++j) {
            const int t = fq * 4 + j;
#pragma unroll
            for (int nt = 0; nt < 4; ++nt) {
                const int ch = g * 512 + 64 * w + 16 * nt + fr;
                MX[(size_t)(r0 + t) * D + 1024 + ch] = f2bf(gts[nt][j] * stat[t] * p.s_norm_w[l * 1024 + ch]);
            }
        }
    }
    __syncthreads();
}

DEV void phase_ln(const P& p, int l, int which) {
    int tid_ = threadIdx.x; asm volatile("" : "+v"(tid_));
    const int lane = tid_ & 63, w = tid_ >> 6;
    const float* gam = (which ? p.ln2_g : p.ln1_g) + l * D; const float* bet = (which ? p.ln2_b : p.ln1_b) + l * D;
    const bf16_t* mix = (const bf16_t*)(p.ws + WS_MIXF);
    bf16_t* xb = (bf16_t*)(p.ws + WS_XB);
    const bool lastp = (l == 1 && which == 1), split = (gridDim.x == 256);
    for (int r = blockIdx.x * 8 + w; r < NTOK; r += gridDim.x * 8) {
        f32x4 y[8]; float s = 0.f;
#pragma unroll
        for (int i = 0; i < 8; ++i) { const int cidx = i * 256 + lane * 4;
            f32x4 xv, mv;
            { const uint2 t = *(const uint2*)(xb + (size_t)r * D + cidx); xv = (f32x4){bflo(t.x), bfhi(t.x), bflo(t.y), bfhi(t.y)}; }
            if (split && r >= NPR) { const bf16_t* pp = (const bf16_t*)(p.ws + WS_PART) + (size_t)(r - NPR) * D + cidx; mv = (f32x4){0.f, 0.f, 0.f, 0.f};
#pragma unroll
                for (int k = 0; k < 8; ++k) { const uint2 t = *(const uint2*)(pp + (size_t)k * NSM * D); mv += (f32x4){bflo(t.x), bfhi(t.x), bflo(t.y), bfhi(t.y)}; } }
            else { const uint2 t = *(const uint2*)(mix + (size_t)r * D + cidx); mv = (f32x4){bflo(t.x), bfhi(t.x), bflo(t.y), bfhi(t.y)}; }
            y[i] = xv * ALPHA + mv; s += (y[i][0] + y[i][1]) + (y[i][2] + y[i][3]); }
        const float mu = wave_sum(s) * (1.0f / D);
        float q = 0.f;
#pragma unroll
        for (int i = 0; i < 8; ++i) { y[i] = y[i] - mu; q += (y[i][0] * y[i][0] + y[i][1] * y[i][1]) + (y[i][2] * y[i][2] + y[i][3] * y[i][3]); }
        const float rs = rsqrtf(wave_sum(q) * (1.0f / D) + 1e-5f);
#pragma unroll
        for (int i = 0; i < 8; ++i) { const int cidx = i * 256 + lane * 4;
            const f32x4 o = y[i] * rs * *(const f32x4*)(gam + cidx) + *(const f32x4*)(bet + cidx);
            if (lastp) *(f32x4*)(p.out + (size_t)r * D + cidx) = o;
            else { u32x2 wv; wv.x = pk2(o[0], o[1]); wv.y = pk2(o[2], o[3]); *(u32x2*)(xb + (size_t)r * D + cidx) = wv; } }
    }
}

DEV void phase_ffn_gate(const P& p, int l, int part, int b0, int nb) {
    const bf16_t* up = (const bf16_t*)(p.ws + WS_UP); bf16_t* act = (bf16_t*)(p.ws + WS_ACT);
    const float* fw = p.f_conv_w + (size_t)l * 3 * DFF2; const float* fb = p.f_conv_b + (size_t)l * DFF2;
    const int lo = part == 2 ? (NPR / 8) * (DFF / 8) : 0, total = part == 1 ? (NPR / 8) * (DFF / 8) : (NTOK / 8) * (DFF / 8);
    int tid_ = threadIdx.x; asm volatile("" : "+v"(tid_));
    for (int it = lo + b0 * NTHR + tid_; it < total; it += nb * NTHR) {
        const int rb = it / (DFF / 8), j8 = (it % (DFF / 8)) * 8, r0 = rb * 8;
        const bool smp = r0 >= NPR; const int t0 = smp ? 0 : (r0 & 2047); const int sb = (r0 - NPR) >> 3;
        float wg[3][8], wv[3][8], bg[8], bv[8];
#pragma unroll
        for (int k = 0; k < 3; ++k) {
            const f32x4 a0 = *(const f32x4*)(fw + k * DFF2 + j8), a1 = *(const f32x4*)(fw + k * DFF2 + j8 + 4), c0 = *(const f32x4*)(fw + k * DFF2 + DFF + j8), c1 = *(const f32x4*)(fw + k * DFF2 + DFF + j8 + 4);
#pragma unroll
            for (int i = 0; i < 4; ++i) { wg[k][i] = a0[i]; wg[k][4 + i] = a1[i]; wv[k][i] = c0[i]; wv[k][4 + i] = c1[i]; }
        }
        { const f32x4 a0 = *(const f32x4*)(fb + j8), a1 = *(const f32x4*)(fb + j8 + 4), c0 = *(const f32x4*)(fb + DFF + j8), c1 = *(const f32x4*)(fb + DFF + j8 + 4);
#pragma unroll
          for (int i = 0; i < 4; ++i) { bg[i] = a0[i]; bg[4 + i] = a1[i]; bv[i] = c0[i]; bv[4 + i] = c1[i]; } }
        float g0[8], g1[8], v0[8], v1[8];
        if (t0 > 0) {
            unpack8(*(const uint4*)(up + (size_t)(r0 - 2) * DFF2 + j8), g0); unpack8(*(const uint4*)(up + (size_t)(r0 - 2) * DFF2 + DFF + j8), v0);
            unpack8(*(const uint4*)(up + (size_t)(r0 - 1) * DFF2 + j8), g1); unpack8(*(const uint4*)(up + (size_t)(r0 - 1) * DFF2 + DFF + j8), v1);
        } else if (smp) {
            const float* bp = p.st_fconv + (size_t)(l * 128 + sb) * 2 * DFF2;
            const f32x4 a0 = *(const f32x4*)(bp + j8), a1 = *(const f32x4*)(bp + j8 + 4), c0 = *(const f32x4*)(bp + DFF + j8), c1 = *(const f32x4*)(bp + DFF + j8 + 4);
            const f32x4 d0 = *(const f32x4*)(bp + DFF2 + j8), d1 = *(const f32x4*)(bp + DFF2 + j8 + 4), e0 = *(const f32x4*)(bp + DFF2 + DFF + j8), e1 = *(const f32x4*)(bp + DFF2 + DFF + j8 + 4);
#pragma unroll
            for (int i = 0; i < 4; ++i) { g0[i] = a0[i]; g0[4 + i] = a1[i]; v0[i] = c0[i]; v0[4 + i] = c1[i]; g1[i] = d0[i]; g1[4 + i] = d1[i]; v1[i] = e0[i]; v1[4 + i] = e1[i]; }
        } else {
#pragma unroll
            for (int i = 0; i < 8; ++i) { g0[i] = 0.f; g1[i] = 0.f; v0[i] = 0.f; v1[i] = 0.f; }
        }
#pragma unroll
        for (int rr = 0; rr < 8; ++rr) {
            float g2[8], v2[8];
            unpack8(*(const uint4*)(up + (size_t)(r0 + rr) * DFF2 + j8), g2); unpack8(*(const uint4*)(up + (size_t)(r0 + rr) * DFF2 + DFF + j8), v2);
            float o[8];
#pragma unroll
            for (int i = 0; i < 8; ++i) {
                const float ag = bg[i] + wg[0][i] * g0[i] + wg[1][i] * g1[i] + wg[2][i] * g2[i];
                const float av = bv[i] + wv[0][i] * v0[i] + wv[1][i] * v1[i] + wv[2][i] * v2[i];
                o[i] = ag * __builtin_amdgcn_rcpf(1.0f + __expf(-ag)) * av;
                g0[i] = g1[i]; g1[i] = g2[i]; v0[i] = v1[i]; v1[i] = v2[i];
            }
            u32x4 wv4; wv4.x = pk2(o[0], o[1]); wv4.y = pk2(o[2], o[3]); wv4.z = pk2(o[4], o[5]); wv4.w = pk2(o[6], o[7]);
            *(u32x4*)(act + (size_t)(r0 + rr) * DFF + j8) = wv4;
        }
    }
    const int tot2 = part == 1 ? 0 : 132 * 2 * (DFF2 / 8);
    for (int it = b0 * NTHR + tid_; it < tot2; it += nb * NTHR) {
        const int c8 = (it % (DFF2 / 8)) * 8, rr = it / (DFF2 / 8), j = rr & 1, sq = rr >> 1;
        float* o; size_t row;
        if (sq < 4) { o = p.out + O_PFC + ((size_t)(l * 4 + sq) * 2 + j) * DFF2 + c8; row = (size_t)sq * 2048 + 2046 + j; }
        else { const int b = sq - 4; o = p.out + O_SFC + ((size_t)(l * 128 + b) * 2 + j) * DFF2 + c8; row = (size_t)NPR + b * 8 + 6 + j; }
        float xf[8]; unpack8(*(const uint4*)(up + row * DFF2 + c8), xf);
        *(f32x4*)o = (f32x4){xf[0], xf[1], xf[2], xf[3]}; *(f32x4*)(o + 4) = (f32x4){xf[4], xf[5], xf[6], xf[7]};
    }
}


#define XB_TMO      128
#define XB_XCNT(j)  (256  + 64 * (j))
#define XB_XSUB(j)  (1280 + 64 * (j))
#define XB_XGEN(j)  (2304 + 64 * (j))
#define XB_TOP      3328
#define XB_TOPGEN   3392
#define XCD_BAR_WORDS 3456
#define XB_SPIN_CAP (1u << 20)
DEV unsigned xb_ld(unsigned* p)              { return __hip_atomic_load(p, __ATOMIC_RELAXED, __HIP_MEMORY_SCOPE_AGENT); }
DEV unsigned xb_add(unsigned* p, unsigned v) { return __hip_atomic_fetch_add(p, v, __ATOMIC_RELAXED, __HIP_MEMORY_SCOPE_AGENT); }
DEV unsigned xb_xcc_id() { return (unsigned)__builtin_amdgcn_s_getreg((3 << 11) | 20) & 0xFu; }
#define XB_SPIN(cond, bar) do { unsigned _sp = 0; while (cond) { __builtin_amdgcn_s_sleep(1); \
    if ((++_sp & 255u) == 0u) { if (xb_ld(&(bar)[XB_TMO])) break; if (_sp > XB_SPIN_CAP) { atomicAdd(&(bar)[XB_TMO], 1u); break; } } } } while (0)
struct XcdBarrier { unsigned* bar; unsigned x; volatile LAS unsigned* st; };
DEV XcdBarrier xcd_barrier_post(unsigned* bar, volatile LAS unsigned* st) {
    XcdBarrier b; b.bar = bar; b.x = xb_xcc_id(); b.st = st;
    if (threadIdx.x == 0) (void)xb_add(&bar[XB_XCNT(b.x)], 1u);
    return b;
}
DEV void xcd_barrier_complete(unsigned* bar, unsigned x, unsigned& nloc, unsigned& nx) {
    const unsigned G = gridDim.x * gridDim.y * gridDim.z;
    unsigned sum, cnt, mine, sp = 0u;
    for (;;) {
        sum = 0u; cnt = 0u; mine = 0u;
#pragma unroll
        for (unsigned j = 0; j < 16; ++j) { const unsigned c = xb_ld(&bar[XB_XCNT(j)]); sum += c; cnt += (c > 0u) ? 1u : 0u; mine = (j == x) ? c : mine; }
        if (sum == G) break;
        __builtin_amdgcn_s_sleep(1);
        if ((++sp & 255u) == 0u) { if (xb_ld(&bar[XB_TMO])) break; if (sp > XB_SPIN_CAP) { atomicAdd(&bar[XB_TMO], 1u); break; } }
    }
    nloc = mine > 0u ? mine : 1u; nx = cnt > 0u ? cnt : 1u;
}
DEV void xcd_barrier(const XcdBarrier& b) {
    asm volatile("s_waitcnt vmcnt(0)" ::: "memory");
    __syncthreads();
    if (threadIdx.x == 0) {
        unsigned* bar = b.bar;
        __builtin_amdgcn_s_waitcnt(0);
        unsigned nloc = b.st[0], nx = b.st[1];
        if (nloc == 0u) { xcd_barrier_complete(bar, b.x, nloc, nx); b.st[0] = nloc; b.st[1] = nx; }
        const unsigned old = xb_add(&bar[XB_XSUB(b.x)], 1u);
        const unsigned gen = old / nloc;
        if (old + 1u == (gen + 1u) * nloc) {
            __builtin_amdgcn_fence(__ATOMIC_RELEASE, "agent");
            asm volatile("s_waitcnt vmcnt(0)" ::: "memory");
            const unsigned og = xb_add(&bar[XB_TOP], 1u);
            const unsigned tg = og / nx;
            if (og + 1u == (tg + 1u) * nx) xb_add(&bar[XB_TOPGEN], 1u);
            else XB_SPIN(xb_ld(&bar[XB_TOPGEN]) == tg, bar);
            __builtin_amdgcn_fence(__ATOMIC_ACQUIRE, "agent");
            xb_add(&bar[XB_XGEN(b.x)], 1u);
            asm volatile("s_waitcnt vmcnt(0)" ::: "memory");
        } else {
            XB_SPIN(xb_ld(&bar[XB_XGEN(b.x)]) == gen, bar);
            __builtin_amdgcn_fence(__ATOMIC_ACQUIRE, "agent");
            asm volatile("s_waitcnt vmcnt(0)" ::: "memory");
        }
    }
    __syncthreads();
}

constexpr int NPHASE = 21;
DEV void run_phase(const P& p, int l, int q, unsigned char* lds) {
    int bid = blockIdx.x, G = gridDim.x; asm volatile("" : "+s"(bid), "+s"(G));
    if (q == 0) {
        pg8::Gemm g{(const bf16_t*)(p.ws + WS_XB), (const bf16_t*)(p.ws + WS_WIN) + (size_t)l * INP * D, NTOK, INP, D};
        pg8::StaticOrder S; S.init(NTOK, INP, D, G, bid);
        pg8::EpiBf16 E{(bf16_t*)(p.ws + WS_U), INP, nullptr};
        pg8::gemm_phase<pg8::EpiBf16, pg8::StaticOrder>((LAS unsigned char*)lds, g, S, E);
    } else if (q == 1) {
        const int par = bid & 1;
#pragma unroll 1
        for (int half = 0; half < 2; ++half) {
            if ((half ^ par) == 0) {
                for (int u = bid; u < 512; u += G) smp_mlstm(p, l, u, lds);
                for (int u = bid; u < 256; u += G) smp_ssd(p, l, u, lds);
            } else {
                for (int u = bid; u < 512; u += G) mlstm_local(p, l, u, lds);
                for (int u = bid; u < 256; u += G) ssd_local(p, l, u, lds);
            }
        }
    } else if (q == 2) {
        for (int u = bid; u < 256; u += G) mlstm_scan(p, l, u, lds);
        for (int u = bid; u < 256; u += G) ssd_scan(p, l, u, lds);
        for (int u = bid; u < 132; u += G) convstate_copy(p, l, u);
    } else if (q == 3) {
        const bool cvt = (l == 0 && G == 256); const int par3 = bid & 1;
        if (cvt && par3) phase_prologue(p, lds, 0, 1, false, bid, 256, T_WIN, T_L);
        for (int u = bid; u < 512; u += G) mlstm_out(p, l, u, lds);
        for (int u = bid; u < 256; u += G) ssd_out(p, l, u, lds);
        if (cvt && !par3) phase_prologue(p, lds, 0, 1, false, bid, 256, T_WIN, T_L);
    } else if (q == 4) {
        pg8::Gemm g{(const bf16_t*)(p.ws + WS_MIXIN), (const bf16_t*)(p.ws + WS_WOUT) + (size_t)l * D * D, NTOK, D, D};
        pg8::EpiBf16 E{(bf16_t*)(p.ws + WS_MIXF), D, (float*)(p.ws + WS_PART)};
        if (G == 256) { pg8::TailSplitOrder S; S.init(D, bid); pg8::gemm_phase<pg8::EpiBf16, pg8::TailSplitOrder>((LAS unsigned char*)lds, g, S, E); }
        else { pg8::StaticOrder S; S.init(NTOK, D, D, G, bid); pg8::gemm_phase<pg8::EpiBf16, pg8::StaticOrder>((LAS unsigned char*)lds, g, S, E); }
    } else if (q == 5) {
        phase_ln(p, l, 0);
    } else if (q == 6) {
        pg8::Gemm g{(const bf16_t*)(p.ws + WS_XB), (const bf16_t*)(p.ws + WS_WUP) + (size_t)l * DFF2 * D, NTOK, DFF2, D};
        pg8::StaticOrder S; S.init(NTOK, DFF2, D, G, bid);
        pg8::EpiBf16 E{(bf16_t*)(p.ws + WS_UP), DFF2, nullptr};
        pg8::gemm_phase<pg8::EpiBf16, pg8::StaticOrder>((LAS unsigned char*)lds, g, S, E);
        if (l == 0 && G == 256 && bid >= 12) phase_prologue(p, lds, 1, 2, false, bid - 12, 244);
    } else if (q == 16 || q == 26) {
        pg8::Gemm g{(const bf16_t*)(p.ws + WS_XB), (const bf16_t*)(p.ws + WS_WUP) + (size_t)l * DFF2 * D, NTOK, DFF2, D};
        pg8::EpiBf16 E{(bf16_t*)(p.ws + WS_UP), DFF2, nullptr};
        if (q == 16 || bid < 12) { pg8::UpOrder S; S.init(bid, q == 16 ? 0 : 6, q == 16 ? 6 : 7); pg8::gemm_phase<pg8::EpiBf16, pg8::UpOrder>((LAS unsigned char*)lds, g, S, E); }
        else phase_ffn_gate(p, l, 1, bid - 12, 244);
    } else if (q == 17) {
        phase_ffn_gate(p, l, 2, bid, G);
    } else if (q == 7) {
        phase_ffn_gate(p, l, 0, bid, G);
    } else if (q == 8) {
        pg8::Gemm g{(const bf16_t*)(p.ws + WS_ACT), (const bf16_t*)(p.ws + WS_WDN) + (size_t)l * D * DFF, NTOK, D, DFF};
        pg8::EpiBf16 E{(bf16_t*)(p.ws + WS_MIXF), D, (float*)(p.ws + WS_PART)};
        if (G == 256) { pg8::TailSplitOrder S; S.init(DFF, bid); pg8::gemm_phase<pg8::EpiBf16, pg8::TailSplitOrder>((LAS unsigned char*)lds, g, S, E); }
        else { pg8::StaticOrder S; S.init(NTOK, D, DFF, G, bid); pg8::gemm_phase<pg8::EpiBf16, pg8::StaticOrder>((LAS unsigned char*)lds, g, S, E); }
    } else {
        phase_ln(p, l, 1);
    }
}
#if MK_MULTI
template <int T> __global__ void __launch_bounds__(NTHR, 2) k_unit(P p) {
    extern __shared__ __attribute__((aligned(16))) unsigned char lds[];
    const int l = p.ph_lo; int bid = blockIdx.x, G = gridDim.x;
    if (T == 11) for (int u = bid; u < 512; u += G) smp_mlstm(p, l, u, lds);
    if (T == 12) for (int u = bid; u < 256; u += G) smp_ssd(p, l, u, lds);
    if (T == 13) for (int u = bid; u < 512; u += G) mlstm_local(p, l, u, lds);
    if (T == 14) for (int u = bid; u < 256; u += G) ssd_local(p, l, u, lds);
    if (T == 31) for (int u = bid; u < 512; u += G) mlstm_out(p, l, u, lds);
    if (T == 32) for (int u = bid; u < 256; u += G) ssd_out(p, l, u, lds);
    if (T == 21) for (int u = bid; u < 256; u += G) mlstm_scan(p, l, u, lds);
    if (T == 22) for (int u = bid; u < 256; u += G) ssd_scan(p, l, u, lds);
}
template <int Q> __global__ void __launch_bounds__(NTHR, 2) k_phase(P p) {
    extern __shared__ __attribute__((aligned(16))) unsigned char lds[];
    if (Q < 0) { if (gridDim.x == 256) phase_prologue(p, lds, 0, 1, true, blockIdx.x, 256, 0, T_WIN); else phase_prologue(p, lds, 0, 2, true, blockIdx.x, gridDim.x); } else run_phase(p, p.ph_lo, Q, lds);
}
#else
__global__ void __launch_bounds__(NTHR, 2) mk_fwd(P p) {
    extern __shared__ __attribute__((aligned(16))) unsigned char lds[];
    cg::grid_group grid = cg::this_grid();
    if (p.ph_hi < 0) grid.sync();
    if (threadIdx.x < 4) ((unsigned*)(lds + LDS_BYTES - 16))[threadIdx.x] = 0u;
    __syncthreads();
    (void)xcd_barrier_post((unsigned*)(p.ws + WS_BAR), (volatile LAS unsigned*)(lds + LDS_BYTES - 16));
#define GSYNC() do { XcdBarrier b_; b_.bar = (unsigned*)(p.ws + WS_BAR); b_.x = xb_xcc_id(); b_.st = (volatile LAS unsigned*)(lds + LDS_BYTES - 16); xcd_barrier(b_); } while (0)
    if (gridDim.x == 256) phase_prologue(p, lds, 0, 1, true, blockIdx.x, 256, 0, T_WIN); else phase_prologue(p, lds, 0, 2, true, blockIdx.x, gridDim.x);
#pragma unroll 1
    for (int l = 0; l < 2; ++l) {
        GSYNC(); run_phase(p, l, 0, lds);
        GSYNC(); run_phase(p, l, 1, lds);
        GSYNC(); run_phase(p, l, 2, lds);
        GSYNC(); run_phase(p, l, 3, lds);
        GSYNC(); run_phase(p, l, 4, lds);
        GSYNC(); run_phase(p, l, 5, lds);
        if (l == 1 && gridDim.x == 256) {
            GSYNC(); run_phase(p, l, 16, lds);
            GSYNC(); run_phase(p, l, 26, lds);
            GSYNC(); run_phase(p, l, 17, lds);
        } else {
            GSYNC(); run_phase(p, l, 6, lds);
            GSYNC(); run_phase(p, l, 7, lds);
        }
        GSYNC(); run_phase(p, l, 8, lds);
        GSYNC(); run_phase(p, l, 9, lds);
    }
    for (int i = 0; i < PROBE_SYNCS; ++i) GSYNC();
}
#endif

extern "C" void kernel_launch(void* const* d_in, const int* in_sizes, int n_in, void* d_out, int out_size, void* d_ws, size_t ws_size, hipStream_t stream) {
    static int grid = 0;
    if (grid == 0) {
        if (n_in != 27 || ws_size < WS_END) { fprintf(stderr, "kernel_launch: unexpected n_in %d or ws_size %zu (need %zu)\n", n_in, ws_size, (size_t)WS_END); grid = -1; return; }
        int dev = 0, cus = 0, per_cu = 0;
        hipGetDevice(&dev);
        hipDeviceGetAttribute(&cus, hipDeviceAttributeMultiprocessorCount, dev);
#if MK_MULTI
        const void* fns[11] = {(const void*)k_phase<-1>, (const void*)k_phase<0>, (const void*)k_phase<1>, (const void*)k_phase<2>, (const void*)k_phase<3>, (const void*)k_phase<4>, (const void*)k_phase<5>,
                               (const void*)k_phase<6>, (const void*)k_phase<7>, (const void*)k_phase<8>, (const void*)k_phase<9>};
        for (int i = 0; i < 11; ++i) if (hipFuncSetAttribute(fns[i], hipFuncAttributeMaxDynamicSharedMemorySize, LDS_BYTES) != hipSuccess) { fprintf(stderr, "kernel_launch: hipFuncSetAttribute failed\n"); grid = -1; return; }
#else
        if (hipFuncSetAttribute((const void*)mk_fwd, hipFuncAttributeMaxDynamicSharedMemorySize, LDS_BYTES) != hipSuccess) { fprintf(stderr, "kernel_launch: hipFuncSetAttribute failed\n"); grid = -1; return; }
        hipOccupancyMaxActiveBlocksPerMultiprocessor(&per_cu, (const void*)mk_fwd, NTHR, LDS_BYTES);
        (void)hipGetLastError();
#endif
        (void)per_cu;
        grid = cus * 1;
    }
    if (grid < 0) return;
    P p{};
    const float** pp = (const float**)&p;
    for (int i = 0; i < 27; ++i) pp[i] = (const float*)d_in[i];
    p.out = (float*)d_out; p.ws = (unsigned char*)d_ws;
#if MK_MULTI
    p.ph_lo = 0; p.ph_hi = 0;
    if (PROBE_REP == -1) hipLaunchKernelGGL(k_phase<-1>, dim3(grid), dim3(NTHR), LDS_BYTES, stream, p);
    hipLaunchKernelGGL(k_phase<-1>, dim3(grid), dim3(NTHR), LDS_BYTES, stream, p);
    for (int l = 0; l < 2; ++l) {
        p.ph_lo = l;
        for (int rep = 0; rep < 1 + ((PROBE_REP == 0) || (PROBE_REP == 100 && (0 == 0 || 0 == 4 || 0 == 6 || 0 == 8))); ++rep) hipLaunchKernelGGL(k_phase<0>, dim3(grid), dim3(NTHR), LDS_BYTES, stream, p);
        for (int rep = 0; rep < 1 + ((PROBE_REP == 1) || (PROBE_REP == 100 && (1 == 0 || 1 == 4 || 1 == 6 || 1 == 8))); ++rep) hipLaunchKernelGGL(k_phase<1>, dim3(grid), dim3(NTHR), LDS_BYTES, stream, p);
        for (int rep = 0; rep < 1 + ((PROBE_REP == 2) || (PROBE_REP == 100 && (2 == 0 || 2 == 4 || 2 == 6 || 2 == 8))); ++rep) hipLaunchKernelGGL(k_phase<2>, dim3(grid), dim3(NTHR), LDS_BYTES, stream, p);
        for (int rep = 0; rep < 1 + ((PROBE_REP == 3) || (PROBE_REP == 100 && (3 == 0 || 3 == 4 || 3 == 6 || 3 == 8))); ++rep) hipLaunchKernelGGL(k_phase<3>, dim3(grid), dim3(NTHR), LDS_BYTES, stream, p);
        if (PROBE_REP == 11 || PROBE_REP == 12 || PROBE_REP == 13 || PROBE_REP == 14 || PROBE_REP == 31 || PROBE_REP == 32 || PROBE_REP == 21 || PROBE_REP == 22) {
            hipFuncSetAttribute((const void*)k_unit<PROBE_REP>, hipFuncAttributeMaxDynamicSharedMemorySize, LDS_BYTES);
            hipLaunchKernelGGL(k_unit<PROBE_REP>, dim3(grid), dim3(NTHR), LDS_BYTES, stream, p);
        }
        for (int rep = 0; rep < 1 + ((PROBE_REP == 4) || (PROBE_REP == 100 && (4 == 0 || 4 == 4 || 4 == 6 || 4 == 8))); ++rep) hipLaunchKernelGGL(k_phase<4>, dim3(grid), dim3(NTHR), LDS_BYTES, stream, p);
        for (int rep = 0; rep < 1 + ((PROBE_REP == 5) || (PROBE_REP == 100 && (5 == 0 || 5 == 4 || 5 == 6 || 5 == 8))); ++rep) hipLaunchKernelGGL(k_phase<5>, dim3(grid), dim3(NTHR), LDS_BYTES, stream, p);
        for (int rep = 0; rep < 1 + ((PROBE_REP == 6) || (PROBE_REP == 100 && (6 == 0 || 6 == 4 || 6 == 6 || 6 == 8))); ++rep) hipLaunchKernelGGL(k_phase<6>, dim3(grid), dim3(NTHR), LDS_BYTES, stream, p);
        for (int rep = 0; rep < 1 + ((PROBE_REP == 7) || (PROBE_REP == 100 && (7 == 0 || 7 == 4 || 7 == 6 || 7 == 8))); ++rep) hipLaunchKernelGGL(k_phase<7>, dim3(grid), dim3(NTHR), LDS_BYTES, stream, p);
        for (int rep = 0; rep < 1 + ((PROBE_REP == 8) || (PROBE_REP == 100 && (8 == 0 || 8 == 4 || 8 == 6 || 8 == 8))); ++rep) hipLaunchKernelGGL(k_phase<8>, dim3(grid), dim3(NTHR), LDS_BYTES, stream, p);
        for (int rep = 0; rep < 1 + ((PROBE_REP == 9) || (PROBE_REP == 100 && (9 == 0 || 9 == 4 || 9 == 6 || 9 == 8))); ++rep) hipLaunchKernelGGL(k_phase<9>, dim3(grid), dim3(NTHR), LDS_BYTES, stream, p);
    }
#else
    p.ph_lo = 0; p.ph_hi = NPHASE;
    if (hipMemsetAsync((char*)d_ws + WS_BAR, 0, 16384, stream) != hipSuccess) { fprintf(stderr, "kernel_launch: memset failed\n"); return; }
    void* args[] = {&p};
    hipError_t e = hipLaunchCooperativeKernel((const void*)mk_fwd, dim3(grid), dim3(NTHR), args, LDS_BYTES, stream);
    if (e != hipSuccess) fprintf(stderr, "cooperative launch failed: %s (grid %d)\n", hipGetErrorString(e), grid);
#endif
}
```

```cpp
#include <hip/hip_runtime.h>
#include <hip/hip_cooperative_groups.h>
#include <cstdio>
namespace cg = cooperative_groups;

#ifndef MK_MULTI
#define MK_MULTI 0
#endif
#ifndef PROBE_REP
#define PROBE_REP -99
#endif
#ifndef PROBE_SYNCS
#define PROBE_SYNCS 0
#endif

#define DEV __device__ __forceinline__
#define LAS __attribute__((address_space(3)))
typedef unsigned short bf16_t;
typedef short bf16x8 __attribute__((ext_vector_type(8)));
typedef float f32x4 __attribute__((ext_vector_type(4)));
typedef float f32x2 __attribute__((ext_vector_type(2)));
typedef unsigned u32x4 __attribute__((ext_vector_type(4)));
typedef unsigned u32x2 __attribute__((ext_vector_type(2)));

constexpr int D = 2048, NPR = 8192, NSM = 1024, NTOK = 9216, INP = 6912, IN_DIM = 6680, DFF = 5504, DFF2 = 11008;
constexpr int UQ = 0, UK = 1024, UV = 2048, UO = 3072, UZ = 4096, UXS = 5120, UIG = 6656, UFG = 6660, UDT = 6664;
constexpr int NTHR = 512;
constexpr int LDS_BYTES = 136 * 1024;
constexpr float ALPHA = 1.41421356237309515f;

constexpr size_t O_YP = 0;
constexpr size_t O_YS = O_YP + (size_t)4 * 2048 * 2048;
constexpr size_t O_PC = O_YS + (size_t)128 * 8 * 2048;
constexpr size_t O_PN = O_PC + (size_t)2 * 4 * 4 * 256 * 256;
constexpr size_t O_PM = O_PN + (size_t)2 * 4 * 4 * 256;
constexpr size_t O_PS = O_PM + (size_t)2 * 4 * 4;
constexpr size_t O_PSC = O_PS + (size_t)2 * 4 * 16 * 64 * 128;
constexpr size_t O_PFC = O_PSC + (size_t)2 * 4 * 3 * 1536;
constexpr size_t O_SC = O_PFC + (size_t)2 * 4 * 2 * DFF2;
constexpr size_t O_SN = O_SC + (size_t)2 * 128 * 4 * 256 * 256;
constexpr size_t O_SM = O_SN + (size_t)2 * 128 * 4 * 256;
constexpr size_t O_SS = O_SM + (size_t)2 * 128 * 4;
constexpr size_t O_SSC = O_SS + (size_t)2 * 128 * 16 * 64 * 128;
constexpr size_t O_SFC = O_SSC + (size_t)2 * 128 * 3 * 1536;

constexpr size_t WS_WIN = 0;
constexpr size_t WS_WOUT = WS_WIN + (size_t)2 * INP * D * 2;
constexpr size_t WS_WUP = WS_WOUT + (size_t)2 * D * D * 2;
constexpr size_t WS_WDN = WS_WUP + (size_t)2 * DFF2 * D * 2;
constexpr size_t WS_XB = WS_WDN + (size_t)2 * D * DFF * 2;
constexpr size_t WS_XF = WS_XB + (size_t)NTOK * D * 2;
constexpr size_t WS_XBC = WS_XF;
constexpr size_t WS_U = WS_XF + (size_t)NTOK * D * 4;
constexpr size_t WS_MIXIN = WS_U + (size_t)NTOK * INP * 2;
constexpr size_t WS_MIXF = WS_MIXIN + (size_t)NTOK * D * 2;
constexpr size_t WS_UP = WS_MIXF + (size_t)NTOK * D * 4;
constexpr size_t WS_ACT = WS_UP + (size_t)NTOK * DFF2 * 2;
constexpr size_t WS_PART = WS_ACT + (size_t)NTOK * DFF * 2;
constexpr size_t WS_SMALL = WS_PART + (size_t)8 * NSM * D * 4;
constexpr size_t WS_DBUF = WS_UP;
constexpr size_t WS_SBUF = WS_UP + (size_t)512 * 65536 * 4;
constexpr size_t WS_CT = WS_ACT;
constexpr size_t WS_ST = WS_ACT + (size_t)512 * 65536 * 2;
static_assert(WS_SBUF + (size_t)2048 * 8192 * 4 <= WS_ACT, "alias");
static_assert(WS_ST + (size_t)2048 * 8192 * 2 <= WS_PART, "alias");
constexpr size_t WS_NLOC = WS_SMALL;
constexpr size_t WS_NST = WS_NLOC + (size_t)512 * 256 * 4;
constexpr size_t WS_GSTAT = WS_NST + (size_t)512 * 256 * 4;
constexpr size_t WS_MST = WS_GSTAT + 4096;
constexpr size_t WS_SBSUM = WS_MST + 4096;
constexpr size_t WS_BAR = WS_SBSUM + 8192;
constexpr size_t WS_END = WS_BAR + 16384;

struct P {
    const float* x_prompt; const float* x_sample; const float* st_C; const float* st_n; const float* st_m; const float* st_ssm; const float* st_sconv; const float* st_fconv;
    const float* w_in; const float* b_i; const float* b_f; const float* m_norm_w; const float* s_conv_w; const float* s_conv_b; const float* dt_bias; const float* A_log; const float* D_skip;
    const float* s_norm_w; const float* w_out; const float* ln1_g; const float* ln1_b; const float* w_up; const float* f_conv_w; const float* f_conv_b; const float* w_down; const float* ln2_g; const float* ln2_b;
    float* out; unsigned char* ws; int ph_lo, ph_hi;
};

DEV float bf2f(bf16_t v) { return __uint_as_float(((unsigned)v) << 16); }
DEV bf16_t f2bf(float f) { unsigned u = __float_as_uint(f); u += 0x7FFFu + ((u >> 16) & 1u); return (bf16_t)(u >> 16); }
DEV unsigned pk2(float lo, float hi) { return (unsigned)f2bf(lo) | ((unsigned)f2bf(hi) << 16); }
DEV float bflo(unsigned w) { return __uint_as_float(w << 16); }
DEV float bfhi(unsigned w) { return __uint_as_float(w & 0xffff0000u); }
DEV float sigmoidf_(float x) { return __builtin_amdgcn_rcpf(1.0f + __expf(-x)); }
DEV float siluf_(float x) { return x * sigmoidf_(x); }
DEV float softplusf_(float x) { return fmaxf(x, 0.f) + __logf(1.0f + __expf(-fabsf(x))); }
DEV float logsigf_(float x) { return fminf(x, 0.f) - __logf(1.0f + __expf(-fabsf(x))); }
DEV float wave_sum(float v) {
#pragma unroll
    for (int o = 32; o >= 1; o >>= 1) v += __shfl_xor(v, o);
    return v; }
DEV float wave_max(float v) {
#pragma unroll
    for (int o = 32; o >= 1; o >>= 1) v = fmaxf(v, __shfl_xor(v, o));
    return v; }
DEV float wave_incl_sum(float v, int lane) {
#pragma unroll
    for (int o = 1; o < 64; o <<= 1) { float t = __shfl_up(v, o); if (lane >= o) v += t; }
    return v; }
DEV float wave_incl_max(float v, int lane) {
#pragma unroll
    for (int o = 1; o < 64; o <<= 1) { float t = __shfl_up(v, o); if (lane >= o) v = fmaxf(v, t); }
    return v; }
DEV f32x4 mfma16(bf16x8 a, bf16x8 b, f32x4 c) { return __builtin_amdgcn_mfma_f32_16x16x32_bf16(a, b, c, 0, 0, 0); }
DEV void unpack8(uint4 x, float (&f)[8]) { f[0] = bflo(x.x); f[1] = bfhi(x.x); f[2] = bflo(x.y); f[3] = bfhi(x.y); f[4] = bflo(x.z); f[5] = bfhi(x.z); f[6] = bflo(x.w); f[7] = bfhi(x.w); }

typedef short s16x4 __attribute__((ext_vector_type(4)));
DEV bf16x8 tr_frag(const bf16_t* T, int pitch, int krow0, int col0, int lane) {
    const int g = lane >> 4, q = (lane & 15) >> 2, pl = lane & 3;
    const bf16_t* a0 = T + (krow0 + 8 * g + q) * pitch + col0 + 4 * pl;
    const s16x4 lo = __builtin_amdgcn_ds_read_tr16_b64_v4i16((LAS s16x4*)a0);
    const s16x4 hi = __builtin_amdgcn_ds_read_tr16_b64_v4i16((LAS s16x4*)(a0 + 4 * pitch));
    return (bf16x8){lo[0], lo[1], lo[2], lo[3], hi[0], hi[1], hi[2], hi[3]};
}

namespace pg8 {
constexpr int BM = 256, BK = 64, HALF = 128, HTB = HALF * BK * 2, STAGE_BYTES = 8 * HTB, NXCD = 8, WGM = 8;
DEV int lds_byte(int r, int c) { const int st = (r >> 4) * 2 + (c >> 5), rr = r & 15, cc = c & 31, ob = rr * 64 + cc * 2; return st * 1024 + (ob ^ (((ob >> 9) & 1) << 5)); }
DEV void stage_rc(int b, int& R, int& C) { const int st = b / 1024, sb = b % 1024, swz = sb ^ (((sb >> 9) & 1) << 5); R = (st >> 1) * 16 + swz / 64; C = (st & 1) * 32 + (swz % 64) / 2; }
DEV int perm32(int rho) { const int n = rho >> 4, i = rho & 15; return 8 * (i >> 2) + 4 * n + (i & 3); }
struct Unit { int pm, pn, k0, nt, ks; };
struct Gemm { const bf16_t* A; const bf16_t* Bt; int M, N, K; };
struct StaticOrder {
    int nM, nN, nwg, G, c, ntk, ioff, imax;
    DEV void init(int M, int N, int K, int G_, int c_, int ioff_ = 0, int imax_ = 1 << 20) { nM = M / BM; nN = N / BM; nwg = nM * nN; G = G_; c = c_; ntk = K / BK; ioff = ioff_; imax = imax_; }
    DEV bool next(int i, Unit& u) const {
        u.pm = 0; u.pn = 0; u.k0 = 0; u.nt = 4; u.ks = -1;
        if (i + ioff >= imax) return false;
        const long L = (long)(i + ioff) * G + c; if (L >= nwg) return false;
        int wgid = (int)L; { const int q = nwg / NXCD, r = nwg % NXCD, xcd = wgid % NXCD, off = wgid / NXCD; wgid = (xcd < r ? xcd * (q + 1) : r * (q + 1) + (xcd - r) * q) + off; }
        const int nig = WGM * nN, gid = wgid / nig, fm = gid * WGM, gsz = (nM - fm) < WGM ? (nM - fm) : WGM;
        u.pm = fm + ((wgid % nig) % gsz); u.pn = (wgid % nig) / gsz; u.k0 = 0; u.nt = ntk; u.ks = -1; return true;
    }
};
struct TailSplitOrder {
    StaticOrder so; int c, ntk;
    DEV void init(int K, int c_) { so.init(NPR, D, K, 256, c_); c = c_; ntk = K / BK; }
    DEV bool next(int i, Unit& u) const {
        u.pm = 0; u.pn = 0; u.k0 = 0; u.nt = 4; u.ks = -1;
        if (i == 0) return so.next(0, u);
        if (i > 1) return false;
        const int tt = c >> 3, ks = c & 7; u.pm = 32 + (tt >> 3); u.pn = tt & 7; u.ks = ks;
        const int pairs = ntk >> 1, base = pairs >> 3, rem = pairs & 7;
        const int p0 = ks * base + (ks < rem ? ks : rem), np = base + (ks < rem ? 1 : 0);
        u.k0 = p0 * 128; u.nt = np * 2; return true;
    }
};
struct UpOrder {
    int c, ioff, imax;
    DEV void init(int c_, int ioff_, int imax_) { c = c_; ioff = ioff_; imax = imax_; }
    DEV bool next(int i, Unit& u) const {
        u.pm = 0; u.pn = 0; u.k0 = 0; u.nt = D / BK; u.ks = -1;
        const int r = i + ioff;
        if (r >= imax || r > 6 || (r == 6 && c >= 12)) return false;
        const int wgid = r < 6 ? ((r * 256 + c) % NXCD) * 192 + (r * 256 + c) / NXCD : 1536 + c;
        const int nN = DFF2 / BM, nig = WGM * nN, gid = wgid / nig, fm = gid * WGM, gsz = (36 - fm) < WGM ? (36 - fm) : WGM;
        u.pm = fm + ((wgid % nig) % gsz); u.pn = (wgid % nig) / gsz; return true;
    }
};
DEV unsigned cvt_pk_bf16(float lo, float hi) { unsigned r; asm volatile("v_cvt_pk_bf16_f32 %0, %1, %2" : "=v"(r) : "v"(lo), "v"(hi)); return r; }
struct EpiF32 {
    static constexpr bool PERM = false;
    float* C; int ldc; float* part;
    DEV void operator()(const f32x4 (&acc)[2][2][4][2], const Unit& u, int wr, int wc, int fr, int fq) const {
        const int row0 = u.pm * BM + wr * 64 + fr, col0 = u.pn * BM + wc * 32 + 4 * fq;
        float* Cb = u.ks < 0 ? C : part + (size_t)u.ks * NSM * D - (size_t)NPR * ldc;
#pragma unroll
        for (int ai = 0; ai < 2; ++ai)
#pragma unroll
            for (int m = 0; m < 4; ++m) { float* rowp = Cb + (size_t)(row0 + ai * HALF + m * 16) * ldc + col0;
#pragma unroll
                for (int bj = 0; bj < 2; ++bj)
#pragma unroll
                    for (int n = 0; n < 2; ++n) *(f32x4*)(rowp + bj * HALF + n * 16) = acc[ai][bj][m][n]; }
    }
};
struct EpiBf16 {
    static constexpr bool PERM = true;
    bf16_t* O; int ldc; float* part;
    DEV void operator()(const f32x4 (&acc)[2][2][4][2], const Unit& u, int wr, int wc, int fr, int fq) const {
        const int row0 = u.pm * BM + wr * 64 + fr; const int col0 = u.pn * BM + wc * 32 + 8 * fq;
        if (u.ks >= 0) {
            bf16_t* pb = (bf16_t*)part + (size_t)u.ks * NSM * ldc + (size_t)(row0 - NPR) * ldc + col0;
#pragma unroll
            for (int ai = 0; ai < 2; ++ai)
#pragma unroll
                for (int m = 0; m < 4; ++m)
#pragma unroll
                    for (int bj = 0; bj < 2; ++bj) { const f32x4 v0 = acc[ai][bj][m][0], v1 = acc[ai][bj][m][1];
                        u32x4 w; w.x = cvt_pk_bf16(v0[0], v0[1]); w.y = cvt_pk_bf16(v0[2], v0[3]); w.z = cvt_pk_bf16(v1[0], v1[1]); w.w = cvt_pk_bf16(v1[2], v1[3]);
                        *(u32x4*)(pb + (size_t)(ai * HALF + m * 16) * ldc + bj * HALF) = w; }
            return;
        }
#pragma unroll
        for (int ai = 0; ai < 2; ++ai)
#pragma unroll
            for (int m = 0; m < 4; ++m) { bf16_t* rowp = O + (size_t)(row0 + ai * HALF + m * 16) * ldc + col0;
#pragma unroll
                for (int bj = 0; bj < 2; ++bj) { const f32x4 v0 = acc[ai][bj][m][0], v1 = acc[ai][bj][m][1];
                    u32x4 w; w.x = cvt_pk_bf16(v0[0], v0[1]); w.y = cvt_pk_bf16(v0[2], v0[3]); w.z = cvt_pk_bf16(v1[0], v1[1]); w.w = cvt_pk_bf16(v1[2], v1[3]);
                    *(u32x4*)(rowp + bj * HALF) = w; } }
    }
};

template <class Epi, class Sched>
DEV void gemm_phase(LAS unsigned char* lds, const Gemm g, const Sched& S, const Epi& E) {
    int tid_ = threadIdx.x; asm volatile("" : "+v"(tid_)); const int tid = tid_, wid = __builtin_amdgcn_readfirstlane(tid >> 6), lane = tid & 63, wr = wid >> 2, wc = wid & 3, fr = lane & 15, fq = lane >> 4;
    const int K = g.K;
    unsigned voffA[2], voffB[2];
#pragma unroll
    for (int i = 0; i < 2; ++i) { int R, C; stage_rc(tid * 16 + i * 8192, R, C); const int Rb = Epi::PERM ? ((R & ~31) + perm32(R & 31)) : R;
        voffA[i] = (unsigned)(R * K + C) * 2u; voffB[i] = (unsigned)(Rb * K + C) * 2u; }
    const size_t kstep = (size_t)(BK * 2);
    const size_t hstep = (size_t)HALF * K * 2;
    const size_t tstep = 2 * hstep;
    const unsigned ldsw = (unsigned)wid * 1024u;
    const int aoff = lds_byte(wr * 64 + fr, fq * 8), boff = lds_byte(wc * 32 + fr, fq * 8);
#define PG8_SA(b, h) (((b) * 2 + (h)) * HTB)
#define PG8_SB(b, h) ((4 + (b) * 2 + (h)) * HTB)
#define PG8_STAGE(bufoff, gbase, voff) do { _Pragma("unroll") for (int _i = 0; _i < 2; ++_i) \
        __builtin_amdgcn_global_load_lds((const unsigned*)((const char*)(gbase) + (voff)[_i]), (LAS unsigned*)(lds + (bufoff) + ldsw + _i * 8192), 16, 0, 0); } while (0)
#define PG8_LDA(dst, b, h) do { _Pragma("unroll") for (int m = 0; m < 4; ++m) _Pragma("unroll") for (int k = 0; k < 2; ++k) dst[m][k] = *(const LAS bf16x8*)(lds + PG8_SA(b, h) + aoff + m * 2048 + k * 1024); } while (0)
#define PG8_LDB(dst, b, h) do { _Pragma("unroll") for (int n = 0; n < 2; ++n) _Pragma("unroll") for (int k = 0; k < 2; ++k) dst[n][k] = *(const LAS bf16x8*)(lds + PG8_SB(b, h) + boff + n * 2048 + k * 1024); } while (0)
#define PG8_MMA(ai, bj, At, Bt) do { __builtin_amdgcn_s_setprio(1); _Pragma("unroll") for (int m = 0; m < 4; ++m) _Pragma("unroll") for (int n = 0; n < 2; ++n) _Pragma("unroll") for (int k = 0; k < 2; ++k) \
        acc[ai][bj][m][n] = __builtin_amdgcn_mfma_f32_16x16x32_bf16(Bt[n][k], At[m][k], acc[ai][bj][m][n], 0, 0, 0); __builtin_amdgcn_s_setprio(0); } while (0)
#define PG8_WAIT_V(n) asm volatile("s_waitcnt vmcnt(" #n ")" ::: "memory")
#define PG8_WAIT_L(n) asm volatile("s_waitcnt lgkmcnt(" #n ")" ::: "memory")
#define PG8_BAR __builtin_amdgcn_s_barrier()
#define PG8_SCHED __builtin_amdgcn_sched_barrier(0)
    Unit cur, nxt; int ui = 0;
    if (!S.next(0, cur)) return;
    f32x4 acc[2][2][4][2];
#pragma unroll
    for (int a = 0; a < 2; ++a)
#pragma unroll
        for (int b = 0; b < 2; ++b)
#pragma unroll
            for (int m = 0; m < 4; ++m)
#pragma unroll
                for (int n = 0; n < 2; ++n) acc[a][b][m][n] = (f32x4){0.f, 0.f, 0.f, 0.f};
    bf16x8 At[4][2], B0[2][2], B1[2][2];
    const char* cA = (const char*)g.A + (size_t)cur.pm * tstep + (size_t)cur.k0 * 2; const char* cB = (const char*)g.Bt + (size_t)cur.pn * tstep + (size_t)cur.k0 * 2;
    PG8_STAGE(PG8_SB(0, 0), cB, voffB); PG8_STAGE(PG8_SA(0, 0), cA, voffA); PG8_STAGE(PG8_SB(0, 1), cB + hstep, voffB); PG8_STAGE(PG8_SA(0, 1), cA + hstep, voffA);
    if (wr == 1) PG8_BAR;
    PG8_WAIT_V(4); PG8_BAR;
    PG8_STAGE(PG8_SB(1, 0), cB + kstep, voffB); PG8_STAGE(PG8_SA(1, 0), cA + kstep, voffA); PG8_STAGE(PG8_SB(1, 1), cB + hstep + kstep, voffB);
    PG8_WAIT_V(6); PG8_BAR;
    for (;;) {
        const bool has_next = S.next(ui + 1, nxt);
        const char* nA = has_next ? (const char*)g.A + (size_t)nxt.pm * tstep + (size_t)nxt.k0 * 2 : cA; const char* nB = has_next ? (const char*)g.Bt + (size_t)nxt.pn * tstep + (size_t)nxt.k0 * 2 : cB;
        const int nt = cur.nt;
        for (int t = 0; t < nt; t += 2) {
            const bool last = (t == nt - 2);
            const char* a1 = cA + (size_t)(t + 1) * kstep;
            const char* a2 = last ? nA : cA + (size_t)(t + 2) * kstep; const char* b2 = last ? nB : cB + (size_t)(t + 2) * kstep;
            const char* a3 = a2 + kstep; const char* b3 = b2 + kstep;
            PG8_LDB(B0, 0, 0); PG8_SCHED; PG8_LDA(At, 0, 0); PG8_STAGE(PG8_SA(1, 1), a1 + hstep, voffA);
            PG8_WAIT_L(8); PG8_BAR; PG8_WAIT_L(0); PG8_MMA(0, 0, At, B0); PG8_BAR; PG8_SCHED;
            PG8_LDB(B1, 0, 1); PG8_STAGE(PG8_SB(0, 0), b2, voffB);
            PG8_BAR; PG8_WAIT_L(0); PG8_MMA(0, 1, At, B1); PG8_BAR;
            PG8_LDA(At, 0, 1); PG8_STAGE(PG8_SA(0, 0), a2, voffA);
            PG8_BAR; PG8_WAIT_L(0); PG8_MMA(1, 0, At, B0); PG8_BAR; PG8_SCHED;
            PG8_STAGE(PG8_SB(0, 1), b2 + hstep, voffB);
            PG8_WAIT_V(6); PG8_BAR; PG8_MMA(1, 1, At, B1); PG8_BAR;
            PG8_LDB(B0, 1, 0); PG8_SCHED; PG8_LDA(At, 1, 0); PG8_STAGE(PG8_SA(0, 1), a2 + hstep, voffA);
            PG8_WAIT_L(8); PG8_BAR; PG8_WAIT_L(0); PG8_MMA(0, 0, At, B0); PG8_BAR; PG8_SCHED;
            PG8_LDB(B1, 1, 1); PG8_STAGE(PG8_SB(1, 0), b3, voffB);
            PG8_BAR; PG8_WAIT_L(0); PG8_MMA(0, 1, At, B1); PG8_BAR;
            PG8_LDA(At, 1, 1); PG8_STAGE(PG8_SA(1, 0), a3, voffA);
            PG8_BAR; PG8_WAIT_L(0); PG8_MMA(1, 0, At, B0); PG8_BAR; PG8_SCHED;
            PG8_STAGE(PG8_SB(1, 1), b3 + hstep, voffB);
            PG8_WAIT_V(6); PG8_BAR; PG8_MMA(1, 1, At, B1); PG8_BAR;
        }
        E(acc, cur, wr, wc, fr, fq);
        if (!has_next) break;
#pragma unroll
        for (int a = 0; a < 2; ++a)
#pragma unroll
            for (int b = 0; b < 2; ++b)
#pragma unroll
                for (int m = 0; m < 4; ++m)
#pragma unroll
                    for (int n = 0; n < 2; ++n) acc[a][b][m][n] = (f32x4){0.f, 0.f, 0.f, 0.f};
        cur = nxt; cA = nA; cB = nB; ++ui;
    }
    PG8_WAIT_V(0);
    if (wr == 0) PG8_BAR;
    PG8_BAR;
#undef PG8_SA
#undef PG8_SB
#undef PG8_STAGE
#undef PG8_LDA
#undef PG8_LDB
#undef PG8_MMA
#undef PG8_WAIT_V
#undef PG8_WAIT_L
#undef PG8_BAR
#undef PG8_SCHED
}
}

DEV int win_srccol(int n) { return n < 4096 ? n : (n < 6656 ? n + 8 : (n < 6664 ? n - 2560 : (n < 6680 ? n : -1))); }
DEV void transpose_tile(const float* __restrict__ src, int srcN, bf16_t* __restrict__ dst, int K, int n0, int k0, int mode, float* tile) {
    int tid_ = threadIdx.x; asm volatile("" : "+v"(tid_)); const int tid = tid_;
    f32x4 v[4];
#pragma unroll
    for (int i = 0; i < 4; ++i) {
        const int kk = (tid >> 5) + 16 * i, nn4 = (tid & 31) * 4, n = n0 + nn4;
        const int sc = mode ? win_srccol(n) : n;
        v[i] = (f32x4){0.f, 0.f, 0.f, 0.f};
        if (sc >= 0) v[i] = __builtin_nontemporal_load((const f32x4*)(src + (size_t)(k0 + kk) * srcN + sc));
        if (mode && n >= 1024 && n < 2048) v[i] = v[i] * 0.0625f;
    }
#pragma unroll
    for (int i = 0; i < 4; ++i) {
        const int kk = (tid >> 5) + 16 * i, nn4 = (tid & 31) * 4;
        tile[kk * 129 + nn4 + 0] = v[i][0]; tile[kk * 129 + nn4 + 1] = v[i][1]; tile[kk * 129 + nn4 + 2] = v[i][2]; tile[kk * 129 + nn4 + 3] = v[i][3];
    }
    __syncthreads();
#pragma unroll
    for (int i = 0; i < 2; ++i) {
        const int ch = tid + 512 * i, nn = ch >> 3, kk8 = (ch & 7) * 8;
        u32x4 w;
        w.x = pk2(tile[(kk8 + 0) * 129 + nn], tile[(kk8 + 1) * 129 + nn]); w.y = pk2(tile[(kk8 + 2) * 129 + nn], tile[(kk8 + 3) * 129 + nn]);
        w.z = pk2(tile[(kk8 + 4) * 129 + nn], tile[(kk8 + 5) * 129 + nn]); w.w = pk2(tile[(kk8 + 6) * 129 + nn], tile[(kk8 + 7) * 129 + nn]);
        *(u32x4*)(dst + (size_t)(n0 + nn) * K + k0 + kk8) = w;
    }
    __syncthreads();
}
constexpr int T_WIN = (INP / 128) * (D / 64), T_WOUT = (D / 128) * (D / 64), T_WUP = (DFF2 / 128) * (D / 64), T_WDN = (D / 128) * (DFF / 64);
constexpr int T_L = T_WIN + T_WOUT + T_WUP + T_WDN, T_X = NTOK * D / 4096;
DEV void phase_prologue(const P& p, unsigned char* lds, int l_lo, int l_hi, bool with_x, int b0, int nb, int rlo = 0, int rhi = T_L) {
    float* tile = (float*)lds;
    const int cnt = rhi - rlo;
    const int nw = (l_hi - l_lo) * cnt, total = nw + (with_x ? T_X : 0);
    for (int u = b0; u < total; u += nb) {
        if (u < nw) {
            const int l = l_lo + u / cnt; int r = rlo + u % cnt;
            if (r < T_WIN) { const int nt = r / (D / 64), kt = r % (D / 64);
                transpose_tile(p.w_in + (size_t)l * D * IN_DIM, IN_DIM, (bf16_t*)(p.ws + WS_WIN) + (size_t)l * INP * D, D, nt * 128, kt * 64, 1, tile); }
            else if ((r -= T_WIN) < T_WOUT) { const int nt = r / (D / 64), kt = r % (D / 64);
                transpose_tile(p.w_out + (size_t)l * D * D, D, (bf16_t*)(p.ws + WS_WOUT) + (size_t)l * D * D, D, nt * 128, kt * 64, 0, tile); }
            else if ((r -= T_WOUT) < T_WUP) { const int nt = r / (D / 64), kt = r % (D / 64);
                transpose_tile(p.w_up + (size_t)l * D * DFF2, DFF2, (bf16_t*)(p.ws + WS_WUP) + (size_t)l * DFF2 * D, D, nt * 128, kt * 64, 0, tile); }
            else { r -= T_WUP; const int nt = r / (DFF / 64), kt = r % (DFF / 64);
                transpose_tile(p.w_down + (size_t)l * DFF * D, D, (bf16_t*)(p.ws + WS_WDN) + (size_t)l * D * DFF, DFF, nt * 128, kt * 64, 0, tile); }
        } else {
            const size_t e = (size_t)(u - nw) * 4096 + threadIdx.x * 8;
            const float* s = e < (size_t)NPR * D ? p.x_prompt + e : p.x_sample + (e - (size_t)NPR * D);
            const f32x4 a = *(const f32x4*)s, b = *(const f32x4*)(s + 4);
            u32x4 w; w.x = pk2(a[0], a[1]); w.y = pk2(a[2], a[3]); w.z = pk2(b[0], b[1]); w.w = pk2(b[2], b[3]);
            *(u32x4*)((bf16_t*)(p.ws + WS_XB) + e) = w;
        }
    }
}

DEV void mlstm_local(const P& p, int l, int unit, unsigned char* lds) {
    const int bh = unit >> 5, c = unit & 31, b = bh >> 2, h = bh & 3;
    int tid_ = threadIdx.x; asm volatile("" : "+v"(tid_)); const int tid = tid_, lane = tid & 63, w = tid >> 6, fr = lane & 15, fq = lane >> 4;
    const bf16_t* U = (const bf16_t*)(p.ws + WS_U) + (size_t)(b * 2048 + c * 64) * INP;
    float* wsh = (float*)lds;
    bf16_t* KW = (bf16_t*)(lds + 1024);
    bf16_t* V = KW + 64 * 272;
    float* gstat = (float*)(p.ws + WS_GSTAT);
    if (w == 0) {
        const float ig = bf2f(U[(size_t)lane * INP + UIG + h]) + p.b_i[l * 4 + h];
        const float lf = logsigf_(bf2f(U[(size_t)lane * INP + UFG + h]) + p.b_f[l * 4 + h]);
        const float bs = wave_incl_sum(lf, lane);
        const float a = ig - bs;
        const float amax = wave_max(a);
        const float bsum = __shfl(bs, 63);
        wsh[lane] = __expf(a - amax);
        if (lane == 0) { gstat[(bh * 32 + c) * 2] = bsum; gstat[(bh * 32 + c) * 2 + 1] = bsum + amax; }
    }
    __syncthreads();
#pragma unroll
    for (int i = 0; i < 4; ++i) {
        const int it = tid + 512 * i, s_ = it >> 5, d8 = (it & 31) * 8;
        const uint4 kv = *(const uint4*)(U + (size_t)s_ * INP + UK + h * 256 + d8);
        const uint4 vv = *(const uint4*)(U + (size_t)s_ * INP + UV + h * 256 + d8);
        const float ws_ = wsh[s_];
        float kf[8]; unpack8(kv, kf);
        u32x4 kw; kw.x = pk2(kf[0] * ws_, kf[1] * ws_); kw.y = pk2(kf[2] * ws_, kf[3] * ws_); kw.z = pk2(kf[4] * ws_, kf[5] * ws_); kw.w = pk2(kf[6] * ws_, kf[7] * ws_);
        *(u32x4*)(KW + s_ * 272 + d8) = kw;
        *(uint4*)(V + s_ * 272 + d8) = vv;
    }
    __syncthreads();
    if (tid < 256) { float a = 0.f; for (int s_ = 0; s_ < 64; ++s_) a += bf2f(KW[s_ * 272 + tid]); ((float*)(p.ws + WS_NLOC))[(size_t)(bh * 32 + c) * 256 + tid] = a; }
    f32x4 acc[2][16];
#pragma unroll
    for (int m = 0; m < 2; ++m)
#pragma unroll
        for (int n = 0; n < 16; ++n) acc[m][n] = (f32x4){0.f, 0.f, 0.f, 0.f};
#pragma unroll
    for (int ks = 0; ks < 2; ++ks) {
        bf16x8 vf[2];
#pragma unroll
        for (int m = 0; m < 2; ++m) vf[m] = tr_frag(V, 272, 32 * ks, 32 * w + 16 * m, lane);
#pragma unroll
        for (int n = 0; n < 16; ++n) {
            const bf16x8 kf = tr_frag(KW, 272, 32 * ks, 16 * n, lane);
#pragma unroll
            for (int m = 0; m < 2; ++m) acc[m][n] = mfma16(kf, vf[m], acc[m][n]);
        }
    }
    bf16_t* Dp = (bf16_t*)(p.ws + WS_DBUF) + (size_t)(bh * 32 + c) * 65536;
#pragma unroll
    for (int m = 0; m < 2; ++m)
#pragma unroll
        for (int n = 0; n < 16; ++n) { u32x2 wv; wv.x = pk2(acc[m][n][0], acc[m][n][1]); wv.y = pk2(acc[m][n][2], acc[m][n][3]);
            *(u32x2*)(Dp + (32 * w + 16 * m + fr) * 256 + 16 * n + fq * 4) = wv; }
    __syncthreads();
}

DEV void mlstm_scan(const P& p, int l, int unit, unsigned char* lds) {
    int tid_ = threadIdx.x; asm volatile("" : "+v"(tid_)); const int bh = unit >> 4, slab = unit & 15, tid = tid_;
    float* fA = (float*)lds; float* fB = fA + 32;
    const float* gstat = (const float*)(p.ws + WS_GSTAT);
    float* gs = fB + 32;
    if (tid < 64) gs[tid] = gstat[bh * 64 + tid];
    __syncthreads();
    if (tid == 0) {
        float m = 0.f;
        for (int c = 0; c < 32; ++c) {
            const float bsum = gs[c * 2], mloc = gs[c * 2 + 1];
            const float mn = fmaxf(bsum + m, mloc);
            fA[c] = __expf(bsum + m - mn); fB[c] = __expf(mloc - mn); m = mn;
            if (slab == 0) ((float*)(p.ws + WS_MST))[bh * 32 + c] = mn;
        }
        if (slab == 0) p.out[O_PM + l * 16 + bh] = m;
    }
    __syncthreads();
    const size_t e0 = (size_t)slab * 4096 + tid * 8;
    float run[8];
#pragma unroll
    for (int i = 0; i < 8; ++i) run[i] = 0.f;
    const bf16_t* Dp = (const bf16_t*)(p.ws + WS_DBUF) + (size_t)bh * 32 * 65536 + e0;
    bf16_t* Cp = (bf16_t*)(p.ws + WS_CT) + (size_t)bh * 32 * 65536 + e0;
#pragma unroll 1
    for (int cb = 0; cb < 32; cb += 8) {
        uint4 xx[8];
#pragma unroll
        for (int j = 0; j < 8; ++j) xx[j] = *(const uint4*)(Dp + (size_t)(cb + j) * 65536);
#pragma unroll
        for (int j = 0; j < 8; ++j) {
            const int c = cb + j;
            const float a = fA[c], bq = fB[c];
            float xf[8]; unpack8(xx[j], xf);
#pragma unroll
            for (int i = 0; i < 8; ++i) run[i] = a * run[i] + bq * xf[i];
            u32x4 wv; wv.x = pk2(run[0], run[1]); wv.y = pk2(run[2], run[3]); wv.z = pk2(run[4], run[5]); wv.w = pk2(run[6], run[7]);
            *(u32x4*)(Cp + (size_t)c * 65536) = wv;
        }
    }
    {
        float* o = p.out + O_PC + (size_t)(l * 16 + bh) * 65536;
        const int e = (int)(e0 >> 8), d0 = (int)(e0 & 255);
#pragma unroll
        for (int i = 0; i < 8; ++i) o[(d0 + i) * 256 + e] = run[i];
    }
    if (slab == 0 && tid < 256) {
        float r = 0.f;
        const float* nl = (const float*)(p.ws + WS_NLOC) + (size_t)bh * 32 * 256 + tid;
        float* ns = (float*)(p.ws + WS_NST) + (size_t)bh * 32 * 256 + tid;
        for (int c = 0; c < 32; ++c) { r = fA[c] * r + fB[c] * nl[c * 256]; ns[c * 256] = r; }
        p.out[O_PN + (size_t)(l * 16 + bh) * 256 + tid] = r;
    }
    __syncthreads();
}

DEV void ssd_scan(const P& p, int l, int unit, unsigned char* lds) {
    int tid_ = threadIdx.x; asm volatile("" : "+v"(tid_)); const int bhd = unit >> 2, slab = unit & 3, tid = tid_;
    float* dec = (float*)lds;
    if (tid < 32) dec[tid] = __expf(((const float*)(p.ws + WS_SBSUM))[bhd * 32 + tid]);
    __syncthreads();
    const size_t e0 = (size_t)slab * 2048 + tid * 4;
    f32x4 run = (f32x4){0.f, 0.f, 0.f, 0.f};
    const bf16_t* Sp = (const bf16_t*)(p.ws + WS_SBUF) + (size_t)bhd * 32 * 8192 + e0;
    bf16_t* Tp = (bf16_t*)(p.ws + WS_ST) + (size_t)bhd * 32 * 8192 + e0;
#pragma unroll 1
    for (int cb = 0; cb < 32; cb += 8) {
        uint2 xx[8];
#pragma unroll
        for (int j = 0; j < 8; ++j) xx[j] = *(const uint2*)(Sp + (size_t)(cb + j) * 8192);
#pragma unroll
        for (int j = 0; j < 8; ++j) {
            run = run * dec[cb + j] + (f32x4){bflo(xx[j].x), bfhi(xx[j].x), bflo(xx[j].y), bfhi(xx[j].y)};
            u32x2 wv; wv.x = pk2(run[0], run[1]); wv.y = pk2(run[2], run[3]);
            *(u32x2*)(Tp + (size_t)(cb + j) * 8192) = wv;
        }
    }
    *(f32x4*)(p.out + O_PS + (size_t)(l * 64 + bhd) * 8192 + e0) = run;
    __syncthreads();
}

DEV void convstate_copy(const P& p, int l, int unit) {
    const bf16_t* Ub = (const bf16_t*)(p.ws + WS_U);
    int tid_ = threadIdx.x; asm volatile("" : "+v"(tid_));
    for (int i = tid_; i < 3 * 1536; i += NTHR) {
        const int j = i / 1536, ch = i % 1536;
        if (unit < 4) p.out[O_PSC + ((size_t)(l * 4 + unit) * 3 + j) * 1536 + ch] = bf2f(Ub[(size_t)(unit * 2048 + 2045 + j) * INP + UXS + ch]);
        else { const int b = unit - 4; p.out[O_SSC + ((size_t)(l * 128 + b) * 3 + j) * 1536 + ch] = bf2f(Ub[(size_t)(NPR + b * 8 + 5 + j) * INP + UXS + ch]); }
    }
}

DEV void mlstm_out(const P& p, int l, int unit, unsigned char* lds) {
    const int bh = unit >> 5, c = unit & 31, b = bh >> 2, h = bh & 3;
    int tid_ = threadIdx.x; asm volatile("" : "+v"(tid_)); const int tid = tid_, lane = tid & 63, w = tid >> 6, fr = lane & 15, fq = lane >> 4;
    const int r0 = b * 2048 + c * 64;
    const bf16_t* U = (const bf16_t*)(p.ws + WS_U) + (size_t)r0 * INP;
    bf16_t* Qs = (bf16_t*)lds;
    bf16_t* Ks = Qs + 64 * 264;
    bf16_t* V = Ks + 64 * 264;
    bf16_t* Ss = V + 64 * 272;
    float* fl = (float*)(lds + 113664);
    float* bsh = fl; float* ash = fl + 64; float* mth = fl + 128; float* wint = fl + 192; float* rdn = fl + 256; float* qn = fl + 320; float* nprev = fl + 384; float* red = fl + 640;
    float* stat = fl + 1152;
    if (w == 0) {
        const float ig = bf2f(U[(size_t)lane * INP + UIG + h]) + p.b_i[l * 4 + h];
        const float lf = logsigf_(bf2f(U[(size_t)lane * INP + UFG + h]) + p.b_f[l * 4 + h]);
        const float bs = wave_incl_sum(lf, lane);
        const float a = ig - bs;
        const float cm = wave_incl_max(a, lane);
        const float mprev = c > 0 ? ((const float*)(p.ws + WS_MST))[bh * 32 + c - 1] : 0.f;
        const float mt = bs + fmaxf(mprev, cm);
        bsh[lane] = bs; ash[lane] = a; mth[lane] = mt; wint[lane] = __expf(bs + mprev - mt);
    }
    if (tid >= 256) { const int d = tid - 256; nprev[d] = c > 0 ? ((const float*)(p.ws + WS_NST))[(size_t)(bh * 32 + c - 1) * 256 + d] : 0.f; }
#pragma unroll
    for (int i = 0; i < 4; ++i) {
        const int it = tid + 512 * i, s_ = it >> 5, d8 = (it & 31) * 8;
        *(uint4*)(Qs + s_ * 264 + d8) = *(const uint4*)(U + (size_t)s_ * INP + UQ + h * 256 + d8);
        *(uint4*)(Ks + s_ * 264 + d8) = *(const uint4*)(U + (size_t)s_ * INP + UK + h * 256 + d8);
        *(uint4*)(V + s_ * 272 + d8) = *(const uint4*)(U + (size_t)s_ * INP + UV + h * 256 + d8);
    }
    __syncthreads();
    {
        const int mt_ = w >> 1, nt0 = (w & 1) * 2;
        f32x4 sacc[2] = {(f32x4){0.f, 0.f, 0.f, 0.f}, (f32x4){0.f, 0.f, 0.f, 0.f}};
#pragma unroll
        for (int k0 = 0; k0 < 256; k0 += 32) {
            const bf16x8 a = *(const bf16x8*)(Qs + (16 * mt_ + fr) * 264 + k0 + fq * 8);
#pragma unroll
            for (int n = 0; n < 2; ++n) { const bf16x8 bb = *(const bf16x8*)(Ks + (16 * (nt0 + n) + fr) * 264 + k0 + fq * 8); sacc[n] = mfma16(a, bb, sacc[n]); }
        }
#pragma unroll
        for (int n = 0; n < 2; ++n)
#pragma unroll
            for (int j = 0; j < 4; ++j) {
                const int t = 16 * mt_ + fq * 4 + j, s_ = 16 * (nt0 + n) + fr;
                const float val = (s_ <= t) ? sacc[n][j] * __expf(bsh[t] - mth[t] + ash[s_]) : 0.f;
                Ss[t * 72 + s_] = f2bf(val);
            }
        const int t = tid >> 3, part = tid & 7;
        float a = 0.f;
        for (int d = part * 32; d < part * 32 + 32; ++d) a += bf2f(Qs[t * 264 + d]) * nprev[d];
        a += __shfl_xor(a, 1); a += __shfl_xor(a, 2); a += __shfl_xor(a, 4);
        if (part == 0) qn[t] = a;
    }
    __syncthreads();
    {
        const int t = tid >> 3, part = tid & 7;
        float di = 0.f;
#pragma unroll
        for (int s_ = 0; s_ < 8; ++s_) di += bf2f(Ss[t * 72 + part * 8 + s_]);
        di += __shfl_xor(di, 1); di += __shfl_xor(di, 2); di += __shfl_xor(di, 4);
        if (part == 0) { const float den = di + wint[t] * qn[t]; rdn[t] = __builtin_amdgcn_rcpf(fmaxf(fabsf(den), __expf(-mth[t]))); }
    }
    const int e0 = 32 * w;
    f32x4 acc1[4][2], acc2[4][2];
#pragma unroll
    for (int m = 0; m < 4; ++m)
#pragma unroll
        for (int n = 0; n < 2; ++n) { acc1[m][n] = (f32x4){0.f, 0.f, 0.f, 0.f}; acc2[m][n] = (f32x4){0.f, 0.f, 0.f, 0.f}; }
#pragma unroll
    for (int ks = 0; ks < 2; ++ks) {
        bf16x8 sf[4];
#pragma unroll
        for (int m = 0; m < 4; ++m) sf[m] = *(const bf16x8*)(Ss + (16 * m + fr) * 72 + 32 * ks + fq * 8);
#pragma unroll
        for (int n = 0; n < 2; ++n) { const bf16x8 vf = tr_frag(V, 272, 32 * ks, e0 + 16 * n, lane);
#pragma unroll
            for (int m = 0; m < 4; ++m) acc1[m][n] = mfma16(vf, sf[m], acc1[m][n]); }
    }
    if (c > 0) {
        const bf16_t* CTp = (const bf16_t*)(p.ws + WS_CT) + (size_t)(bh * 32 + c - 1) * 65536;
#pragma unroll 2
        for (int k0 = 0; k0 < 256; k0 += 32) {
            bf16x8 a[4];
#pragma unroll
            for (int m = 0; m < 4; ++m) a[m] = *(const bf16x8*)(Qs + (16 * m + fr) * 264 + k0 + fq * 8);
#pragma unroll
            for (int n = 0; n < 2; ++n) { const bf16x8 cf = *(const bf16x8*)(CTp + (size_t)(e0 + 16 * n + fr) * 256 + k0 + fq * 8);
#pragma unroll
                for (int m = 0; m < 4; ++m) acc2[m][n] = mfma16(cf, a[m], acc2[m][n]); }
        }
    }
    __syncthreads();
#pragma unroll
    for (int m = 0; m < 4; ++m) {
        const int t = 16 * m + fr;
        const float wi = wint[t], rd = rdn[t];
        float sm = 0.f;
#pragma unroll
        for (int n = 0; n < 2; ++n)
#pragma unroll
            for (int j = 0; j < 4; ++j) { const float hv = (acc1[m][n][j] + wi * acc2[m][n][j]) * rd; acc1[m][n][j] = hv; sm += hv; }
        sm += __shfl_xor(sm, 16); sm += __shfl_xor(sm, 32);
        if (fq == 0) red[t * 8 + w] = sm;
    }
    __syncthreads();
    if (tid < 64) { float sm = 0.f;
#pragma unroll
        for (int i = 0; i < 8; ++i) sm += red[tid * 8 + i];
        stat[tid] = sm * (1.0f / 256.0f); }
    __syncthreads();
#pragma unroll
    for (int m = 0; m < 4; ++m) {
        const int t = 16 * m + fr;
        const float mu = stat[t];
        float sm = 0.f;
#pragma unroll
        for (int n = 0; n < 2; ++n)
#pragma unroll
            for (int j = 0; j < 4; ++j) { const float dv = acc1[m][n][j] - mu; acc1[m][n][j] = dv; sm += dv * dv; }
        sm += __shfl_xor(sm, 16); sm += __shfl_xor(sm, 32);
        if (fq == 0) red[t * 8 + w] = sm;
    }
    __syncthreads();
    if (tid < 64) { float sm = 0.f;
#pragma unroll
        for (int i = 0; i < 8; ++i) sm += red[tid * 8 + i];
        stat[64 + tid] = rsqrtf(sm * (1.0f / 256.0f) + 1e-6f); }
    __syncthreads();
    bf16_t* MX = (bf16_t*)(p.ws + WS_MIXIN);
#pragma unroll
    for (int m = 0; m < 4; ++m) {
        const int t = 16 * m + fr;
        const float rs = stat[64 + t];
#pragma unroll
        for (int n = 0; n < 2; ++n) {
            const int e4 = e0 + 16 * n + fq * 4;
            const uint2 ov = *(const uint2*)(U + (size_t)t * INP + UO + h * 256 + e4);
            const f32x4 nw = *(const f32x4*)(p.m_norm_w + l * 1024 + h * 256 + e4);
            u32x2 wv;
            wv.x = pk2(acc1[m][n][0] * rs * nw[0] * sigmoidf_(bflo(ov.x)), acc1[m][n][1] * rs * nw[1] * sigmoidf_(bfhi(ov.x)));
            wv.y = pk2(acc1[m][n][2] * rs * nw[2] * sigmoidf_(bflo(ov.y)), acc1[m][n][3] * rs * nw[3] * sigmoidf_(bfhi(ov.y)));
            *(u32x2*)(MX + (size_t)(r0 + t) * D + h * 256 + e4) = wv;
        }
    }
    __syncthreads();
}

DEV void ssd_conv8(const bf16_t* Urow, int tpos, const float* cw, const float* cb, int ch8, float (&o)[8]) {
    const f32x4 b0 = *(const f32x4*)(cb + ch8), b1 = *(const f32x4*)(cb + ch8 + 4);
    o[0] = b0[0]; o[1] = b0[1]; o[2] = b0[2]; o[3] = b0[3]; o[4] = b1[0]; o[5] = b1[1]; o[6] = b1[2]; o[7] = b1[3];
#pragma unroll
    for (int j = 0; j < 4; ++j) {
        const int back = 3 - j;
        if (tpos - back >= 0) {
            const uint4 x = *(const uint4*)(Urow - (size_t)back * INP + UXS + ch8);
            float xf[8]; unpack8(x, xf);
            const f32x4 w0 = *(const f32x4*)(cw + j * 1536 + ch8), w1 = *(const f32x4*)(cw + j * 1536 + ch8 + 4);
            o[0] += w0[0] * xf[0]; o[1] += w0[1] * xf[1]; o[2] += w0[2] * xf[2]; o[3] += w0[3] * xf[3];
            o[4] += w1[0] * xf[4]; o[5] += w1[1] * xf[5]; o[6] += w1[2] * xf[6]; o[7] += w1[3] * xf[7];
        }
    }
#pragma unroll
    for (int i = 0; i < 8; ++i) o[i] = siluf_(o[i]);
}

DEV void ssd_local(const P& p, int l, int unit, unsigned char* lds) {
    const int b = unit >> 6, g = (unit >> 5) & 1, c = unit & 31;
    int tid_ = threadIdx.x; asm volatile("" : "+v"(tid_)); const int tid = tid_, lane = tid & 63, w = tid >> 6, fr = lane & 15, fq = lane >> 4;
    const int r0 = b * 2048 + c * 64;
    const bf16_t* U = (const bf16_t*)(p.ws + WS_U) + (size_t)r0 * INP;
    bf16_t* XW = (bf16_t*)lds;
    bf16_t* Bmn = XW + 64 * 528;
    float* wsh = (float*)(lds + 86016);
    {
        const int head = g * 8 + w;
        const float dt = softplusf_(bf2f(U[(size_t)lane * INP + UDT + head]) + p.dt_bias[l * 16 + head]);
        const float a = -__expf(p.A_log[l * 16 + head]) * dt;
        const float bs = wave_incl_sum(a, lane);
        const float bL = __shfl(bs, 63);
        wsh[w * 64 + lane] = __expf(bL - bs) * dt;
        if (lane == 0) ((float*)(p.ws + WS_SBSUM))[(b * 16 + head) * 32 + c] = bL;
    }
    __syncthreads();
    const float* cw = p.s_conv_w + (size_t)l * 4 * 1536; const float* cb = p.s_conv_b + (size_t)l * 1536;
    bf16_t* XBC = (bf16_t*)(p.ws + WS_XBC) + (size_t)r0 * 1536;
    for (int i = 0; i < 12; ++i) {
        const int it = tid + 512 * i, t = it / 96, gidx = it % 96;
        const int ch8 = gidx < 64 ? g * 512 + gidx * 8 : (gidx < 80 ? 1024 + g * 128 + (gidx - 64) * 8 : 1280 + g * 128 + (gidx - 80) * 8);
        float v[8];
        ssd_conv8(U + (size_t)t * INP, c * 64 + t, cw, cb, ch8, v);
        { u32x4 wr_; wr_.x = pk2(v[0], v[1]); wr_.y = pk2(v[2], v[3]); wr_.z = pk2(v[4], v[5]); wr_.w = pk2(v[6], v[7]); *(u32x4*)(XBC + (size_t)t * 1536 + ch8) = wr_; }
        if (gidx >= 80) continue;
        if (gidx < 64) { const float sc = wsh[(gidx >> 3) * 64 + t];
            u32x4 wv; wv.x = pk2(v[0] * sc, v[1] * sc); wv.y = pk2(v[2] * sc, v[3] * sc); wv.z = pk2(v[4] * sc, v[5] * sc); wv.w = pk2(v[6] * sc, v[7] * sc);
            *(u32x4*)(XW + t * 528 + gidx * 8) = wv; }
        else { u32x4 wv; wv.x = pk2(v[0], v[1]); wv.y = pk2(v[2], v[3]); wv.z = pk2(v[4], v[5]); wv.w = pk2(v[6], v[7]);
            *(u32x4*)(Bmn + t * 144 + (gidx - 64) * 8) = wv; }
    }
    __syncthreads();
    f32x4 acc[4][8];
#pragma unroll
    for (int m = 0; m < 4; ++m)
#pragma unroll
        for (int n = 0; n < 8; ++n) acc[m][n] = (f32x4){0.f, 0.f, 0.f, 0.f};
#pragma unroll
    for (int ks = 0; ks < 2; ++ks) {
        bf16x8 xf[4];
#pragma unroll
        for (int m = 0; m < 4; ++m) xf[m] = tr_frag(XW, 528, 32 * ks, 64 * w + 16 * m, lane);
#pragma unroll
        for (int n = 0; n < 8; ++n) { const bf16x8 bf_ = tr_frag(Bmn, 144, 32 * ks, 16 * n, lane);
#pragma unroll
            for (int m = 0; m < 4; ++m) acc[m][n] = mfma16(bf_, xf[m], acc[m][n]); }
    }
    bf16_t* Sp = (bf16_t*)(p.ws + WS_SBUF) + (size_t)((b * 16 + g * 8 + w) * 32 + c) * 8192;
#pragma unroll
    for (int m = 0; m < 4; ++m)
#pragma unroll
        for (int n = 0; n < 8; ++n) { u32x2 wv; wv.x = pk2(acc[m][n][0], acc[m][n][1]); wv.y = pk2(acc[m][n][2], acc[m][n][3]); *(u32x2*)(Sp + (16 * m + fr) * 128 + 16 * n + fq * 4) = wv; }
    __syncthreads();
}

DEV void ssd_out(const P& p, int l, int unit, unsigned char* lds) {
    const int b = unit >> 6, g = (unit >> 5) & 1, c = unit & 31;
    int tid_ = threadIdx.x; asm volatile("" : "+v"(tid_)); const int tid = tid_, lane = tid & 63, w = tid >> 6, fr = lane & 15, fq = lane >> 4;
    const int r0 = b * 2048 + c * 64;
    const bf16_t* U = (const bf16_t*)(p.ws + WS_U) + (size_t)r0 * INP;
    bf16_t* Xs = (bf16_t*)lds;
    bf16_t* Bm = Xs + 64 * 528;
    bf16_t* Cm = Bm + 64 * 136;
    float* CB = (float*)(lds + 102400);
    float* bsh = (float*)(lds + 119808);
    float* dtsh = bsh + 512;
    float* red = dtsh + 512;
    float* stat = red + 512;
    const int head = g * 8 + w;
    {
        const float dt = softplusf_(bf2f(U[(size_t)lane * INP + UDT + head]) + p.dt_bias[l * 16 + head]);
        const float a = -__expf(p.A_log[l * 16 + head]) * dt;
        const float bs = wave_incl_sum(a, lane);
        bsh[w * 64 + lane] = bs; dtsh[w * 64 + lane] = dt;
    }
    const bf16_t* XBC = (const bf16_t*)(p.ws + WS_XBC) + (size_t)r0 * 1536;
#pragma unroll
    for (int i = 0; i < 12; ++i) {
        const int it = tid + 512 * i, t = it / 96, gidx = it % 96;
        const int ch8 = gidx < 64 ? g * 512 + gidx * 8 : (gidx < 80 ? 1024 + g * 128 + (gidx - 64) * 8 : 1280 + g * 128 + (gidx - 80) * 8);
        const u32x4 wv = *(const u32x4*)(XBC + (size_t)t * 1536 + ch8);
        if (gidx < 64) *(u32x4*)(Xs + t * 528 + gidx * 8) = wv;
        else if (gidx < 80) *(u32x4*)(Bm + t * 136 + (gidx - 64) * 8) = wv;
        else *(u32x4*)(Cm + t * 136 + (gidx - 80) * 8) = wv;
    }
    __syncthreads();
    {
        const int mt_ = w >> 1, nt0 = (w & 1) * 2;
        f32x4 cacc[2] = {(f32x4){0.f, 0.f, 0.f, 0.f}, (f32x4){0.f, 0.f, 0.f, 0.f}};
#pragma unroll
        for (int k0 = 0; k0 < 128; k0 += 32) {
            const bf16x8 a = *(const bf16x8*)(Cm + (16 * mt_ + fr) * 136 + k0 + fq * 8);
#pragma unroll
            for (int n = 0; n < 2; ++n) { const bf16x8 bb = *(const bf16x8*)(Bm + (16 * (nt0 + n) + fr) * 136 + k0 + fq * 8); cacc[n] = mfma16(a, bb, cacc[n]); }
        }
#pragma unroll
        for (int n = 0; n < 2; ++n)
#pragma unroll
            for (int j = 0; j < 4; ++j) CB[(16 * mt_ + fq * 4 + j) * 68 + 16 * (nt0 + n) + fr] = cacc[n][j];
    }
    __syncthreads();
    f32x4 acc1[4][4], acc2[4][4];
#pragma unroll
    for (int m = 0; m < 4; ++m)
#pragma unroll
        for (int n = 0; n < 4; ++n) { acc1[m][n] = (f32x4){0.f, 0.f, 0.f, 0.f}; acc2[m][n] = (f32x4){0.f, 0.f, 0.f, 0.f}; }
#pragma unroll
    for (int ks = 0; ks < 2; ++ks) {
        bf16x8 xf[4];
#pragma unroll
        for (int n = 0; n < 4; ++n) xf[n] = tr_frag(Xs, 528, 32 * ks, 64 * w + 16 * n, lane);
#pragma unroll
        for (int m = 0; m < 4; ++m) {
            if (ks * 32 > 16 * m + 15) continue;
            const int t = 16 * m + fr, s0 = 32 * ks + fq * 8;
            const float bt = bsh[w * 64 + t];
            const f32x4 c0 = *(const f32x4*)(CB + t * 68 + s0), c1 = *(const f32x4*)(CB + t * 68 + s0 + 4);
            float mv[8];
#pragma unroll
            for (int i = 0; i < 8; ++i) { const int s_ = s0 + i; const float cv = i < 4 ? c0[i & 3] : c1[i & 3];
                mv[i] = (s_ <= t) ? cv * __expf(bt - bsh[w * 64 + s_]) * dtsh[w * 64 + s_] : 0.f; }
            union { u32x4 u; bf16x8 v; } af;
            af.u.x = pk2(mv[0], mv[1]); af.u.y = pk2(mv[2], mv[3]); af.u.z = pk2(mv[4], mv[5]); af.u.w = pk2(mv[6], mv[7]);
#pragma unroll
            for (int n = 0; n < 4; ++n) acc1[m][n] = mfma16(xf[n], af.v, acc1[m][n]);
        }
    }
    if (c > 0) {
        const bf16_t* STp = (const bf16_t*)(p.ws + WS_ST) + (size_t)((b * 16 + head) * 32 + c - 1) * 8192;
#pragma unroll
        for (int k0 = 0; k0 < 128; k0 += 32) {
            bf16x8 a[4];
#pragma unroll
            for (int m = 0; m < 4; ++m) a[m] = *(const bf16x8*)(Cm + (16 * m + fr) * 136 + k0 + fq * 8);
#pragma unroll
            for (int n = 0; n < 4; ++n) { const bf16x8 sf = *(const bf16x8*)(STp + (16 * n + fr) * 128 + k0 + fq * 8);
#pragma unroll
                for (int m = 0; m < 4; ++m) acc2[m][n] = mfma16(sf, a[m], acc2[m][n]); }
        }
    }
    const float dsk = p.D_skip[l * 16 + head];
#pragma unroll
    for (int m = 0; m < 4; ++m) {
        const int t = 16 * m + fr;
        const float eb = __expf(bsh[w * 64 + t]);
        float sm = 0.f;
#pragma unroll
        for (int n = 0; n < 4; ++n) {
            const int pp4 = 16 * n + fq * 4;
            const uint2 xv = *(const uint2*)(Xs + t * 528 + 64 * w + pp4);
            const uint2 zv = *(const uint2*)(U + (size_t)t * INP + UZ + g * 512 + w * 64 + pp4);
            const float xs4[4] = {bflo(xv.x), bfhi(xv.x), bflo(xv.y), bfhi(xv.y)};
            const float z4[4] = {bflo(zv.x), bfhi(zv.x), bflo(zv.y), bfhi(zv.y)};
#pragma unroll
            for (int j = 0; j < 4; ++j) {
                const float y = acc1[m][n][j] + eb * acc2[m][n][j] + dsk * xs4[j];
                const float gt = y * z4[j] * sigmoidf_(z4[j]);
                acc1[m][n][j] = gt; sm += gt * gt;
            }
        }
        sm += __shfl_xor(sm, 16); sm += __shfl_xor(sm, 32);
        if (fq == 0) red[t * 8 + w] = sm;
    }
    __syncthreads();
    if (tid < 64) { float sm = 0.f;
#pragma unroll
        for (int i = 0; i < 8; ++i) sm += red[tid * 8 + i];
        stat[tid] = rsqrtf(sm * (1.0f / 512.0f) + 1e-6f); }
    __syncthreads();
    bf16_t* MX = (bf16_t*)(p.ws + WS_MIXIN);
#pragma unroll
    for (int m = 0; m < 4; ++m) {
        const int t = 16 * m + fr;
        const float rs = stat[t];
#pragma unroll
        for (int n = 0; n < 4; ++n) {
            const int ch = g * 512 + w * 64 + 16 * n + fq * 4;
            const f32x4 nw = *(const f32x4*)(p.s_norm_w + l * 1024 + ch);
            u32x2 wv; wv.x = pk2(acc1[m][n][0] * rs * nw[0], acc1[m][n][1] * rs * nw[1]); wv.y = pk2(acc1[m][n][2] * rs * nw[2], acc1[m][n][3] * rs * nw[3]);
            *(u32x2*)(MX + (size_t)(r0 + t) * D + 1024 + ch) = wv;
        }
    }
    __syncthreads();
}

DEV void smp_mlstm(const P& p, int l, int unit, unsigned char* lds) {
    const int b = unit >> 2, h = unit & 3;
    int tid_ = threadIdx.x; asm volatile("" : "+v"(tid_)); const int tid = tid_, lane = tid & 63, w = tid >> 6;
    const int r0 = NPR + b * 8;
    const bf16_t* U = (const bf16_t*)(p.ws + WS_U) + (size_t)r0 * INP;
    float* qn = (float*)lds; float* kn = qn + 2048; float* vn = kn + 2048; float* qT = vn + 2048; float* kwT = qT + 2048; float* sc = kwT + 2048; float* red = sc + 256;
    const size_t sidx = (size_t)(l * 128 + b) * 4 + h;
    const float* C0 = p.st_C + sidx * 65536; const float* n0 = p.st_n + sidx * 256;
    float* Cout = p.out + O_SC + sidx * 65536;
    if (tid == 0) {
        const float m0 = p.st_m[sidx];
        float bs = 0.f, cm = -INFINITY, mt = 0.f;
        float igv[8], fgv[8];
        const float bi_ = p.b_i[l * 4 + h], bf_ = p.b_f[l * 4 + h];
#pragma unroll
        for (int t = 0; t < 8; ++t) { igv[t] = bf2f(U[(size_t)t * INP + UIG + h]); fgv[t] = bf2f(U[(size_t)t * INP + UFG + h]); }
#pragma unroll
        for (int t = 0; t < 8; ++t) {
            const float ig = igv[t] + bi_;
            const float lf = logsigf_(fgv[t] + bf_);
            bs += lf; const float a = ig - bs; cm = fmaxf(cm, a); mt = bs + fmaxf(m0, cm);
            sc[32 + t] = mt; sc[t] = __expf(bs + m0 - mt); sc[40 + t] = a; sc[48 + t] = bs;
        }
        for (int s = 0; s < 8; ++s) sc[16 + s] = __expf(bs + sc[40 + s] - mt);
        sc[24] = __expf(bs + m0 - mt);
        p.out[O_SM + sidx] = mt;
    }
    __syncthreads();
#pragma unroll
    for (int i = 0; i < 4; ++i) {
        const int idx = tid + 512 * i, t = idx >> 8, d = idx & 255;
        const float q = bf2f(U[(size_t)t * INP + UQ + h * 256 + d]), k = bf2f(U[(size_t)t * INP + UK + h * 256 + d]), v = bf2f(U[(size_t)t * INP + UV + h * 256 + d]);
        qn[t * 256 + d] = q; kn[t * 256 + d] = k; vn[t * 256 + d] = v; qT[d * 8 + t] = q; kwT[d * 8 + t] = k * sc[16 + t];
    }
    __syncthreads();
    {
        const int t = w;
        const f32x4 qv = *(const f32x4*)(qn + t * 256 + lane * 4);
        float dot[9];
#pragma unroll
        for (int s = 0; s < 8; ++s) { const f32x4 kv = *(const f32x4*)(kn + s * 256 + lane * 4); dot[s] = qv[0] * kv[0] + qv[1] * kv[1] + qv[2] * kv[2] + qv[3] * kv[3]; }
        { const f32x4 nv = *(const f32x4*)(n0 + lane * 4); dot[8] = qv[0] * nv[0] + qv[1] * nv[1] + qv[2] * nv[2] + qv[3] * nv[3]; }
#pragma unroll
        for (int s = 0; s < 9; ++s) dot[s] = wave_sum(dot[s]);
        float den = 0.f;
#pragma unroll
        for (int s = 0; s < 8; ++s) { const float sv = (s <= t) ? dot[s] * __expf(sc[48 + t] - sc[32 + t] + sc[40 + s]) : 0.f; den += sv; if (lane == 0) sc[64 + t * 8 + s] = sv; }
        den += sc[t] * dot[8];
        if (lane == 0) sc[8 + t] = 1.0f / fmaxf(fabsf(den), __expf(-sc[32 + t]));
    }
    if (tid < 256) {
        float a = sc[24] * n0[tid];
#pragma unroll
        for (int s = 0; s < 8; ++s) a += kwT[tid * 8 + s];
        p.out[O_SN + sidx * 256 + tid] = a;
    }
    const int e4 = lane * 4;
    f32x4 num[8], vv[8];
#pragma unroll
    for (int t = 0; t < 8; ++t) { num[t] = (f32x4){0.f, 0.f, 0.f, 0.f}; vv[t] = *(const f32x4*)(vn + t * 256 + e4); }
    const float decay = sc[24];
    {
        f32x4 cn_[8];
#pragma unroll
        for (int j = 0; j < 8; ++j) cn_[j] = __builtin_nontemporal_load((const f32x4*)(C0 + (size_t)(w + 8 * j) * 256 + e4));
#pragma unroll 1
        for (int ib = 0; ib < 4; ++ib) {
            f32x4 cc[8];
#pragma unroll
            for (int j = 0; j < 8; ++j) cc[j] = cn_[j];
            if (ib < 3) {
#pragma unroll
                for (int j = 0; j < 8; ++j) cn_[j] = __builtin_nontemporal_load((const f32x4*)(C0 + (size_t)(w + 8 * ((ib + 1) * 8 + j)) * 256 + e4));
            }
#pragma unroll
            for (int j = 0; j < 8; ++j) {
                const int d = w + 8 * (ib * 8 + j);
                const f32x4 q0 = *(const f32x4*)(qT + d * 8), q1 = *(const f32x4*)(qT + d * 8 + 4), k0 = *(const f32x4*)(kwT + d * 8), k1 = *(const f32x4*)(kwT + d * 8 + 4);
                f32x4 cn = cc[j] * decay;
#pragma unroll
                for (int t = 0; t < 4; ++t) { num[t] += cc[j] * q0[t]; num[4 + t] += cc[j] * q1[t]; cn += vv[t] * k0[t]; cn += vv[4 + t] * k1[t]; }
                __builtin_nontemporal_store(cn, (f32x4*)(Cout + (size_t)d * 256 + e4));
            }
        }
    }
#pragma unroll
    for (int t = 0; t < 8; ++t) *(f32x4*)(red + (w * 8 + t) * 256 + e4) = num[t];
    __syncthreads();
    {
        const int t = w;
        f32x4 hv = (f32x4){0.f, 0.f, 0.f, 0.f};
#pragma unroll
        for (int ww = 0; ww < 8; ++ww) hv += *(const f32x4*)(red + (ww * 8 + t) * 256 + e4);
        hv = hv * sc[t];
#pragma unroll
        for (int s = 0; s < 8; ++s) hv += vv[s] * sc[64 + t * 8 + s];
        hv = hv * sc[8 + t];
        const float mu = wave_sum(hv[0] + hv[1] + hv[2] + hv[3]) * (1.0f / 256.0f);
        const f32x4 dv = hv - mu;
        const float var = wave_sum(dv[0] * dv[0] + dv[1] * dv[1] + dv[2] * dv[2] + dv[3] * dv[3]) * (1.0f / 256.0f);
        const float rs = rsqrtf(var + 1e-6f);
        const uint2 ov = *(const uint2*)(U + (size_t)t * INP + UO + h * 256 + e4);
        const f32x4 nw = *(const f32x4*)(p.m_norm_w + l * 1024 + h * 256 + e4);
        const float o0 = dv[0] * rs * nw[0] * sigmoidf_(bflo(ov.x)), o1 = dv[1] * rs * nw[1] * sigmoidf_(bfhi(ov.x));
        const float o2 = dv[2] * rs * nw[2] * sigmoidf_(bflo(ov.y)), o3 = dv[3] * rs * nw[3] * sigmoidf_(bfhi(ov.y));
        u32x2 wv; wv.x = pk2(o0, o1); wv.y = pk2(o2, o3);
        *(u32x2*)((bf16_t*)(p.ws + WS_MIXIN) + (size_t)(r0 + t) * D + h * 256 + e4) = wv;
    }
    __syncthreads();
}

DEV void smp_ssd(const P& p, int l, int unit, unsigned char* lds) {
    const int b = unit >> 1, g = unit & 1;
    int tid_ = threadIdx.x; asm volatile("" : "+v"(tid_)); const int tid = tid_, lane = tid & 63, w = tid >> 6, fr = lane & 15, fq = lane >> 4;
    const int r0 = NPR + b * 8;
    const bf16_t* U = (const bf16_t*)(p.ws + WS_U) + (size_t)r0 * INP;
    float* xs = (float*)lds;
    float* xwT = xs + 4096;
    float* Bmf = xwT + 4096;
    float* CBs = Bmf + 1024;
    float* bsh = CBs + 64;
    float* dtsh = bsh + 64;
    float* bLs = dtsh + 64;
    float* MW = bLs + 64;
    float* red = MW + 512;
    float* stat = red + 64;
    bf16_t* Cmb = (bf16_t*)(stat + 64);
    if (tid < 64) {
        const int hd = tid >> 3, t = tid & 7, head = g * 8 + hd;
        const float A = -__expf(p.A_log[l * 16 + head]), dtb = p.dt_bias[l * 16 + head];
        float bs = 0.f, bL = 0.f, dtt = 0.f;
        for (int s = 0; s < 8; ++s) { const float dt = softplusf_(bf2f(U[(size_t)s * INP + UDT + head]) + dtb); bL += dt * A; if (s <= t) bs += dt * A; if (s == t) dtt = dt; }
        bsh[hd * 8 + t] = bs; dtsh[hd * 8 + t] = dtt; if (t == 0) bLs[hd] = bL;
    }
    for (int i = tid; i < 8 * 136 / 2; i += NTHR) ((unsigned*)(Cmb + 8 * 136))[i] = 0u;
    const float* cw = p.s_conv_w + (size_t)l * 4 * 1536; const float* cb = p.s_conv_b + (size_t)l * 1536;
    const float* cv0 = p.st_sconv + (size_t)(l * 128 + b) * 3 * 1536;
    for (int i = 0; i < 2; ++i) {
        const int it = tid + 512 * i;
        if (it < 768) {
            const int t = it / 96, gidx = it % 96;
            const int ch8 = gidx < 64 ? g * 512 + gidx * 8 : (gidx < 80 ? 1024 + g * 128 + (gidx - 64) * 8 : 1280 + g * 128 + (gidx - 80) * 8);
            float o[8];
            { const f32x4 b0 = *(const f32x4*)(cb + ch8), b1 = *(const f32x4*)(cb + ch8 + 4); o[0] = b0[0]; o[1] = b0[1]; o[2] = b0[2]; o[3] = b0[3]; o[4] = b1[0]; o[5] = b1[1]; o[6] = b1[2]; o[7] = b1[3]; }
#pragma unroll
            for (int j = 0; j < 4; ++j) {
                const int idx = t + j;
                float xf[8];
                if (idx < 3) { const f32x4 a0 = *(const f32x4*)(cv0 + idx * 1536 + ch8), a1 = *(const f32x4*)(cv0 + idx * 1536 + ch8 + 4);
                    xf[0] = a0[0]; xf[1] = a0[1]; xf[2] = a0[2]; xf[3] = a0[3]; xf[4] = a1[0]; xf[5] = a1[1]; xf[6] = a1[2]; xf[7] = a1[3]; }
                else { const uint4 x = *(const uint4*)(U + (size_t)(idx - 3) * INP + UXS + ch8); unpack8(x, xf); }
                const f32x4 w0 = *(const f32x4*)(cw + j * 1536 + ch8), w1 = *(const f32x4*)(cw + j * 1536 + ch8 + 4);
                o[0] += w0[0] * xf[0]; o[1] += w0[1] * xf[1]; o[2] += w0[2] * xf[2]; o[3] += w0[3] * xf[3];
                o[4] += w1[0] * xf[4]; o[5] += w1[1] * xf[5]; o[6] += w1[2] * xf[6]; o[7] += w1[3] * xf[7];
            }
#pragma unroll
            for (int k = 0; k < 8; ++k) o[k] = siluf_(o[k]);
            if (gidx < 64) {
#pragma unroll
                for (int k = 0; k < 8; ++k) xs[t * 512 + gidx * 8 + k] = o[k]; }
            else if (gidx < 80) {
#pragma unroll
                for (int k = 0; k < 8; ++k) Bmf[t * 128 + (gidx - 64) * 8 + k] = o[k]; }
            else { u32x4 wv; wv.x = pk2(o[0], o[1]); wv.y = pk2(o[2], o[3]); wv.z = pk2(o[4], o[5]); wv.w = pk2(o[6], o[7]); *(u32x4*)(Cmb + t * 136 + (gidx - 80) * 8) = wv; }
        }
    }
    __syncthreads();
#pragma unroll
    for (int i = 0; i < 8; ++i) {
        const int idx = tid + 512 * i, hp = idx >> 3, s = idx & 7, hd = hp >> 6;
        xwT[hp * 8 + s] = xs[s * 512 + hp] * __expf(bLs[hd] - bsh[hd * 8 + s]) * dtsh[hd * 8 + s];
    }
    {
        const int pr = tid >> 3, part = tid & 7, t = pr >> 3, s_ = pr & 7; float a = 0.f;
#pragma unroll
        for (int n = 0; n < 16; ++n) a += bf2f(Cmb[t * 136 + part * 16 + n]) * Bmf[s_ * 128 + part * 16 + n];
        a += __shfl_xor(a, 1); a += __shfl_xor(a, 2); a += __shfl_xor(a, 4);
        if (part == 0) CBs[t * 8 + s_] = a;
    }
    __syncthreads();
    { const int hd = tid >> 6, t = (tid >> 3) & 7, s = tid & 7;
      MW[tid] = (s <= t) ? CBs[t * 8 + s] * __expf(bsh[hd * 8 + t] - bsh[hd * 8 + s]) * dtsh[hd * 8 + s] : 0.f; }
    __syncthreads();
    const int head = g * 8 + w;
    const size_t sidx = (size_t)(l * 128 + b) * 16 + head;
    const float* S0 = p.st_ssm + sidx * 8192; float* So = p.out + O_SS + sidx * 8192;
    const float dA = __expf(bLs[w]);
    f32x4 acc[4];
    f32x4 svn[4][2];
#pragma unroll
    for (int ks = 0; ks < 4; ++ks) { svn[ks][0] = __builtin_nontemporal_load((const f32x4*)(S0 + fr * 128 + 32 * ks + fq * 8)); svn[ks][1] = __builtin_nontemporal_load((const f32x4*)(S0 + fr * 128 + 32 * ks + fq * 8 + 4)); }
#pragma unroll
    for (int nt = 0; nt < 4; ++nt) {
        acc[nt] = (f32x4){0.f, 0.f, 0.f, 0.f};
        const int pp = 16 * nt + fr;
        const f32x4 xw0 = *(const f32x4*)(xwT + (64 * w + pp) * 8), xw1 = *(const f32x4*)(xwT + (64 * w + pp) * 8 + 4);
        f32x4 sv[4][2];
#pragma unroll
        for (int ks = 0; ks < 4; ++ks) { sv[ks][0] = svn[ks][0]; sv[ks][1] = svn[ks][1]; }
        if (nt < 3) {
#pragma unroll
            for (int ks = 0; ks < 4; ++ks) { svn[ks][0] = __builtin_nontemporal_load((const f32x4*)(S0 + (pp + 16) * 128 + 32 * ks + fq * 8)); svn[ks][1] = __builtin_nontemporal_load((const f32x4*)(S0 + (pp + 16) * 128 + 32 * ks + fq * 8 + 4)); }
        }
#pragma unroll
        for (int ks = 0; ks < 4; ++ks) {
            const int n0 = 32 * ks + fq * 8;
            const f32x4 s0 = sv[ks][0], s1 = sv[ks][1];
            union { u32x4 u; bf16x8 v; } bfr;
            bfr.u.x = pk2(s0[0], s0[1]); bfr.u.y = pk2(s0[2], s0[3]); bfr.u.z = pk2(s1[0], s1[1]); bfr.u.w = pk2(s1[2], s1[3]);
            const bf16x8 af = *(const bf16x8*)(Cmb + fr * 136 + n0);
            acc[nt] = mfma16(af, bfr.v, acc[nt]);
            f32x4 o0 = s0 * dA, o1 = s1 * dA;
#pragma unroll
            for (int s = 0; s < 8; ++s) {
                const float xv = s < 4 ? xw0[s & 3] : xw1[s & 3];
                const f32x4 bm0 = *(const f32x4*)(Bmf + s * 128 + n0), bm1 = *(const f32x4*)(Bmf + s * 128 + n0 + 4);
                o0 += bm0 * xv; o1 += bm1 * xv;
            }
            __builtin_nontemporal_store(o0, (f32x4*)(So + pp * 128 + n0)); __builtin_nontemporal_store(o1, (f32x4*)(So + pp * 128 + n0 + 4));
        }
        asm volatile("" ::: "memory");
    }
    const float dsk = p.D_skip[l * 16 + head];
    float gts[4][4];
#pragma unroll
    for (int j = 0; j < 4; ++j) {
        const int t = (fq & 1) * 4 + j;
        const float eb = __expf(bsh[w * 8 + t]);
        float ssq = 0.f;
#pragma unroll
        for (int nt = 0; nt < 4; ++nt) {
            const int hp = 64 * w + 16 * nt + fr;
            float y = eb * acc[nt][j] + dsk * xs[t * 512 + hp];
#pragma unroll
            for (int s = 0; s < 8; ++s) y += MW[(w * 8 + t) * 8 + s] * xs[s * 512 + hp];
            const float z = bf2f(U[(size_t)t * INP + UZ + g * 512 + hp]);
            const float gt = y * siluf_(z);
            gts[nt][j] = gt; ssq += gt * gt;
        }
        ssq += __shfl_xor(ssq, 1); ssq += __shfl_xor(ssq, 2); ssq += __shfl_xor(ssq, 4); ssq += __shfl_xor(ssq, 8);
        if (fr == 0 && fq < 2) red[t * 8 + w] = ssq;
    }
    __syncthreads();
    if (tid < 8) { float s = 0.f;
#pragma unroll
        for (int i = 0; i < 8; ++i) s += red[tid * 8 + i];
        stat[tid] = rsqrtf(s * (1.0f / 512.0f) + 1e-6f); }
    __syncthreads();
    if (fq < 2) {
        bf16_t* MX = (bf16_t*)(p.ws + WS_MIXIN);
#pragma unroll
        for (int j = 0; j < 4; ++j) {
            const int t = fq * 4 + j;
#pragma unroll
            for (int nt = 0; nt < 4; ++nt) {
                const int ch = g * 512 + 64 * w + 16 * nt + fr;
                MX[(size_t)(r0 + t) * D + 1024 + ch] = f2bf(gts[nt][j] * stat[t] * p.s_norm_w[l * 1024 + ch]);
            }
        }
    }
    __syncthreads();
}

DEV void phase_ln(const P& p, int l, int which) {
    int tid_ = threadIdx.x; asm volatile("" : "+v"(tid_));
    const int lane = tid_ & 63, w = tid_ >> 6;
    const float* gam = (which ? p.ln2_g : p.ln1_g) + l * D; const float* bet = (which ? p.ln2_b : p.ln1_b) + l * D;
    const bf16_t* mix = (const bf16_t*)(p.ws + WS_MIXF);
    bf16_t* xb = (bf16_t*)(p.ws + WS_XB);
    const bool lastp = (l == 1 && which == 1), split = (gridDim.x == 256);
    for (int r = blockIdx.x * 8 + w; r < NTOK; r += gridDim.x * 8) {
        f32x4 y[8]; float s = 0.f;
#pragma unroll
        for (int i = 0; i < 8; ++i) { const int cidx = i * 256 + lane * 4;
            f32x4 xv, mv;
            { const uint2 t = *(const uint2*)(xb + (size_t)r * D + cidx); xv = (f32x4){bflo(t.x), bfhi(t.x), bflo(t.y), bfhi(t.y)}; }
            if (split && r >= NPR) { const bf16_t* pp = (const bf16_t*)(p.ws + WS_PART) + (size_t)(r - NPR) * D + cidx; mv = (f32x4){0.f, 0.f, 0.f, 0.f};
#pragma unroll
                for (int k = 0; k < 8; ++k) { const uint2 t = *(const uint2*)(pp + (size_t)k * NSM * D); mv += (f32x4){bflo(t.x), bfhi(t.x), bflo(t.y), bfhi(t.y)}; } }
            else { const uint2 t = *(const uint2*)(mix + (size_t)r * D + cidx); mv = (f32x4){bflo(t.x), bfhi(t.x), bflo(t.y), bfhi(t.y)}; }
            y[i] = xv * ALPHA + mv; s += (y[i][0] + y[i][1]) + (y[i][2] + y[i][3]); }
        const float mu = wave_sum(s) * (1.0f / D);
        float q = 0.f;
#pragma unroll
        for (int i = 0; i < 8; ++i) { y[i] = y[i] - mu; q += (y[i][0] * y[i][0] + y[i][1] * y[i][1]) + (y[i][2] * y[i][2] + y[i][3] * y[i][3]); }
        const float rs = rsqrtf(wave_sum(q) * (1.0f / D) + 1e-5f);
#pragma unroll
        for (int i = 0; i < 8; ++i) { const int cidx = i * 256 + lane * 4;
            const f32x4 o = y[i] * rs * *(const f32x4*)(gam + cidx) + *(const f32x4*)(bet + cidx);
            if (lastp) *(f32x4*)(p.out + (size_t)r * D + cidx) = o;
            else { u32x2 wv; wv.x = pk2(o[0], o[1]); wv.y = pk2(o[2], o[3]); *(u32x2*)(xb + (size_t)r * D + cidx) = wv; } }
    }
}

DEV void phase_ffn_gate(const P& p, int l, int part, int b0, int nb) {
    const bf16_t* up = (const bf16_t*)(p.ws + WS_UP); bf16_t* act = (bf16_t*)(p.ws + WS_ACT);
    const float* fw = p.f_conv_w + (size_t)l * 3 * DFF2; const float* fb = p.f_conv_b + (size_t)l * DFF2;
    const int lo = part == 2 ? (NPR / 8) * (DFF / 8) : 0, total = part == 1 ? (NPR / 8) * (DFF / 8) : (NTOK / 8) * (DFF / 8);
    int tid_ = threadIdx.x; asm volatile("" : "+v"(tid_));
    for (int it = lo + b0 * NTHR + tid_; it < total; it += nb * NTHR) {
        const int rb = it / (DFF / 8), j8 = (it % (DFF / 8)) * 8, r0 = rb * 8;
        const bool smp = r0 >= NPR; const int t0 = smp ? 0 : (r0 & 2047); const int sb = (r0 - NPR) >> 3;
        float wg[3][8], wv[3][8], bg[8], bv[8];
#pragma unroll
        for (int k = 0; k < 3; ++k) {
            const f32x4 a0 = *(const f32x4*)(fw + k * DFF2 + j8), a1 = *(const f32x4*)(fw + k * DFF2 + j8 + 4), c0 = *(const f32x4*)(fw + k * DFF2 + DFF + j8), c1 = *(const f32x4*)(fw + k * DFF2 + DFF + j8 + 4);
#pragma unroll
            for (int i = 0; i < 4; ++i) { wg[k][i] = a0[i]; wg[k][4 + i] = a1[i]; wv[k][i] = c0[i]; wv[k][4 + i] = c1[i]; }
        }
        { const f32x4 a0 = *(const f32x4*)(fb + j8), a1 = *(const f32x4*)(fb + j8 + 4), c0 = *(const f32x4*)(fb + DFF + j8), c1 = *(const f32x4*)(fb + DFF + j8 + 4);
#pragma unroll
          for (int i = 0; i < 4; ++i) { bg[i] = a0[i]; bg[4 + i] = a1[i]; bv[i] = c0[i]; bv[4 + i] = c1[i]; } }
        float g0[8], g1[8], v0[8], v1[8];
        if (t0 > 0) {
            unpack8(*(const uint4*)(up + (size_t)(r0 - 2) * DFF2 + j8), g0); unpack8(*(const uint4*)(up + (size_t)(r0 - 2) * DFF2 + DFF + j8), v0);
            unpack8(*(const uint4*)(up + (size_t)(r0 - 1) * DFF2 + j8), g1); unpack8(*(const uint4*)(up + (size_t)(r0 - 1) * DFF2 + DFF + j8), v1);
        } else if (smp) {
            const float* bp = p.st_fconv + (size_t)(l * 128 + sb) * 2 * DFF2;
            const f32x4 a0 = *(const f32x4*)(bp + j8), a1 = *(const f32x4*)(bp + j8 + 4), c0 = *(const f32x4*)(bp + DFF + j8), c1 = *(const f32x4*)(bp + DFF + j8 + 4);
            const f32x4 d0 = *(const f32x4*)(bp + DFF2 + j8), d1 = *(const f32x4*)(bp + DFF2 + j8 + 4), e0 = *(const f32x4*)(bp + DFF2 + DFF + j8), e1 = *(const f32x4*)(bp + DFF2 + DFF + j8 + 4);
#pragma unroll
            for (int i = 0; i < 4; ++i) { g0[i] = a0[i]; g0[4 + i] = a1[i]; v0[i] = c0[i]; v0[4 + i] = c1[i]; g1[i] = d0[i]; g1[4 + i] = d1[i]; v1[i] = e0[i]; v1[4 + i] = e1[i]; }
        } else {
#pragma unroll
            for (int i = 0; i < 8; ++i) { g0[i] = 0.f; g1[i] = 0.f; v0[i] = 0.f; v1[i] = 0.f; }
        }
#pragma unroll
        for (int rr = 0; rr < 8; ++rr) {
            float g2[8], v2[8];
            unpack8(*(const uint4*)(up + (size_t)(r0 + rr) * DFF2 + j8), g2); unpack8(*(const uint4*)(up + (size_t)(r0 + rr) * DFF2 + DFF + j8), v2);
            float o[8];
#pragma unroll
            for (int i = 0; i < 8; ++i) {
                const float ag = bg[i] + wg[0][i] * g0[i] + wg[1][i] * g1[i] + wg[2][i] * g2[i];
                const float av = bv[i] + wv[0][i] * v0[i] + wv[1][i] * v1[i] + wv[2][i] * v2[i];
                o[i] = ag * __builtin_amdgcn_rcpf(1.0f + __expf(-ag)) * av;
                g0[i] = g1[i]; g1[i] = g2[i]; v0[i] = v1[i]; v1[i] = v2[i];
            }
            u32x4 wv4; wv4.x = pk2(o[0], o[1]); wv4.y = pk2(o[2], o[3]); wv4.z = pk2(o[4], o[5]); wv4.w = pk2(o[6], o[7]);
            *(u32x4*)(act + (size_t)(r0 + rr) * DFF + j8) = wv4;
        }
    }
    const int tot2 = part == 1 ? 0 : 132 * 2 * (DFF2 / 8);
    for (int it = b0 * NTHR + tid_; it < tot2; it += nb * NTHR) {
        const int c8 = (it % (DFF2 / 8)) * 8, rr = it / (DFF2 / 8), j = rr & 1, sq = rr >> 1;
        float* o; size_t row;
        if (sq < 4) { o = p.out + O_PFC + ((size_t)(l * 4 + sq) * 2 + j) * DFF2 + c8; row = (size_t)sq * 2048 + 2046 + j; }
        else { const int b = sq - 4; o = p.out + O_SFC + ((size_t)(l * 128 + b) * 2 + j) * DFF2 + c8; row = (size_t)NPR + b * 8 + 6 + j; }
        float xf[8]; unpack8(*(const uint4*)(up + row * DFF2 + c8), xf);
        *(f32x4*)o = (f32x4){xf[0], xf[1], xf[2], xf[3]}; *(f32x4*)(o + 4) = (f32x4){xf[4], xf[5], xf[6], xf[7]};
    }
}


#define XB_TMO      128
#define XB_XCNT(j)  (256  + 64 * (j))
#define XB_XSUB(j)  (1280 + 64 * (j))
#define XB_XGEN(j)  (2304 + 64 * (j))
#define XB_TOP      3328
#define XB_TOPGEN   3392
#define XCD_BAR_WORDS 3456
#define XB_SPIN_CAP (1u << 20)
DEV unsigned xb_ld(unsigned* p)              { return __hip_atomic_load(p, __ATOMIC_RELAXED, __HIP_MEMORY_SCOPE_AGENT); }
DEV unsigned xb_add(unsigned* p, unsigned v) { return __hip_atomic_fetch_add(p, v, __ATOMIC_RELAXED, __HIP_MEMORY_SCOPE_AGENT); }
DEV unsigned xb_xcc_id() { return (unsigned)__builtin_amdgcn_s_getreg((3 << 11) | 20) & 0xFu; }
#define XB_SPIN(cond, bar) do { unsigned _sp = 0; while (cond) { __builtin_amdgcn_s_sleep(1); \
    if ((++_sp & 255u) == 0u) { if (xb_ld(&(bar)[XB_TMO])) break; if (_sp > XB_SPIN_CAP) { atomicAdd(&(bar)[XB_TMO], 1u); break; } } } } while (0)
struct XcdBarrier { unsigned* bar; unsigned x; volatile LAS unsigned* st; };
DEV XcdBarrier xcd_barrier_post(unsigned* bar, volatile LAS unsigned* st) {
    XcdBarrier b; b.bar = bar; b.x = xb_xcc_id(); b.st = st;
    if (threadIdx.x == 0) (void)xb_add(&bar[XB_XCNT(b.x)], 1u);
    return b;
}
DEV void xcd_barrier_complete(unsigned* bar, unsigned x, unsigned& nloc, unsigned& nx) {
    const unsigned G = gridDim.x * gridDim.y * gridDim.z;
    unsigned sum, cnt, mine, sp = 0u;
    for (;;) {
        sum = 0u; cnt = 0u; mine = 0u;
#pragma unroll
        for (unsigned j = 0; j < 16; ++j) { const unsigned c = xb_ld(&bar[XB_XCNT(j)]); sum += c; cnt += (c > 0u) ? 1u : 0u; mine = (j == x) ? c : mine; }
        if (sum == G) break;
        __builtin_amdgcn_s_sleep(1);
        if ((++sp & 255u) == 0u) { if (xb_ld(&bar[XB_TMO])) break; if (sp > XB_SPIN_CAP) { atomicAdd(&bar[XB_TMO], 1u); break; } }
    }
    nloc = mine > 0u ? mine : 1u; nx = cnt > 0u ? cnt : 1u;
}
DEV void xcd_barrier(const XcdBarrier& b) {
    asm volatile("s_waitcnt vmcnt(0)" ::: "memory");
    __syncthreads();
    if (threadIdx.x == 0) {
        unsigned* bar = b.bar;
        __builtin_amdgcn_s_waitcnt(0);
        unsigned nloc = b.st[0], nx = b.st[1];
        if (nloc == 0u) { xcd_barrier_complete(bar, b.x, nloc, nx); b.st[0] = nloc; b.st[1] = nx; }
        const unsigned old = xb_add(&bar[XB_XSUB(b.x)], 1u);
        const unsigned gen = old / nloc;
        if (old + 1u == (gen + 1u) * nloc) {
            __builtin_amdgcn_fence(__ATOMIC_RELEASE, "agent");
            asm volatile("s_waitcnt vmcnt(0)" ::: "memory");
            const unsigned og = xb_add(&bar[XB_TOP], 1u);
            const unsigned tg = og / nx;
            if (og + 1u == (tg + 1u) * nx) xb_add(&bar[XB_TOPGEN], 1u);
            else XB_SPIN(xb_ld(&bar[XB_TOPGEN]) == tg, bar);
            __builtin_amdgcn_fence(__ATOMIC_ACQUIRE, "agent");
            xb_add(&bar[XB_XGEN(b.x)], 1u);
            asm volatile("s_waitcnt vmcnt(0)" ::: "memory");
        } else {
            XB_SPIN(xb_ld(&bar[XB_XGEN(b.x)]) == gen, bar);
            __builtin_amdgcn_fence(__ATOMIC_ACQUIRE, "agent");
            asm volatile("s_waitcnt vmcnt(0)" ::: "memory");
        }
    }
    __syncthreads();
}

constexpr int NPHASE = 21;
DEV void run_phase(const P& p, int l, int q, unsigned char* lds) {
    int bid = blockIdx.x, G = gridDim.x; asm volatile("" : "+s"(bid), "+s"(G));
    if (q == 0) {
        pg8::Gemm g{(const bf16_t*)(p.ws + WS_XB), (const bf16_t*)(p.ws + WS_WIN) + (size_t)l * INP * D, NTOK, INP, D};
        pg8::StaticOrder S; S.init(NTOK, INP, D, G, bid);
        pg8::EpiBf16 E{(bf16_t*)(p.ws + WS_U), INP, nullptr};
        pg8::gemm_phase<pg8::EpiBf16, pg8::StaticOrder>((LAS unsigned char*)lds, g, S, E);
    } else if (q == 1) {
        const int par = bid & 1;
#pragma unroll 1
        for (int half = 0; half < 2; ++half) {
            if ((half ^ par) == 0) {
                for (int u = bid; u < 512; u += G) smp_mlstm(p, l, u, lds);
                for (int u = bid; u < 256; u += G) smp_ssd(p, l, u, lds);
            } else {
                for (int u = bid; u < 512; u += G) mlstm_local(p, l, u, lds);
                for (int u = bid; u < 256; u += G) ssd_local(p, l, u, lds);
            }
        }
    } else if (q == 2) {
        for (int u = bid; u < 256; u += G) mlstm_scan(p, l, u, lds);
        for (int u = bid; u < 256; u += G) ssd_scan(p, l, u, lds);
        for (int u = bid; u < 132; u += G) convstate_copy(p, l, u);
    } else if (q == 3) {
        const bool cvt = (l == 0 && G == 256); const int par3 = bid & 1;
        if (cvt && par3) phase_prologue(p, lds, 0, 1, false, bid, 256, T_WIN, T_L);
        for (int u = bid; u < 512; u += G) mlstm_out(p, l, u, lds);
        for (int u = bid; u < 256; u += G) ssd_out(p, l, u, lds);
        if (cvt && !par3) phase_prologue(p, lds, 0, 1, false, bid, 256, T_WIN, T_L);
    } else if (q == 4) {
        pg8::Gemm g{(const bf16_t*)(p.ws + WS_MIXIN), (const bf16_t*)(p.ws + WS_WOUT) + (size_t)l * D * D, NTOK, D, D};
        pg8::EpiBf16 E{(bf16_t*)(p.ws + WS_MIXF), D, (float*)(p.ws + WS_PART)};
        if (G == 256) { pg8::TailSplitOrder S; S.init(D, bid); pg8::gemm_phase<pg8::EpiBf16, pg8::TailSplitOrder>((LAS unsigned char*)lds, g, S, E); }
        else { pg8::StaticOrder S; S.init(NTOK, D, D, G, bid); pg8::gemm_phase<pg8::EpiBf16, pg8::StaticOrder>((LAS unsigned char*)lds, g, S, E); }
    } else if (q == 5) {
        phase_ln(p, l, 0);
    } else if (q == 6) {
        pg8::Gemm g{(const bf16_t*)(p.ws + WS_XB), (const bf16_t*)(p.ws + WS_WUP) + (size_t)l * DFF2 * D, NTOK, DFF2, D};
        pg8::StaticOrder S; S.init(NTOK, DFF2, D, G, bid);
        pg8::EpiBf16 E{(bf16_t*)(p.ws + WS_UP), DFF2, nullptr};
        pg8::gemm_phase<pg8::EpiBf16, pg8::StaticOrder>((LAS unsigned char*)lds, g, S, E);
        if (l == 0 && G == 256 && bid >= 12) phase_prologue(p, lds, 1, 2, false, bid - 12, 244);
    } else if (q == 16 || q == 26) {
        pg8::Gemm g{(const bf16_t*)(p.ws + WS_XB), (const bf16_t*)(p.ws + WS_WUP) + (size_t)l * DFF2 * D, NTOK, DFF2, D};
        pg8::EpiBf16 E{(bf16_t*)(p.ws + WS_UP), DFF2, nullptr};
        if (q == 16 || bid < 12) { pg8::UpOrder S; S.init(bid, q == 16 ? 0 : 6, q == 16 ? 6 : 7); pg8::gemm_phase<pg8::EpiBf16, pg8::UpOrder>((LAS unsigned char*)lds, g, S, E); }
        else phase_ffn_gate(p, l, 1, bid - 12, 244);
    } else if (q == 17) {
        phase_ffn_gate(p, l, 2, bid, G);
    } else if (q == 7) {
        phase_ffn_gate(p, l, 0, bid, G);
    } else if (q == 8) {
        pg8::Gemm g{(const bf16_t*)(p.ws + WS_ACT), (const bf16_t*)(p.ws + WS_WDN) + (size_t)l * D * DFF, NTOK, D, DFF};
        pg8::EpiBf16 E{(bf16_t*)(p.ws + WS_MIXF), D, (float*)(p.ws + WS_PART)};
        if (G == 256) { pg8::TailSplitOrder S; S.init(DFF, bid); pg8::gemm_phase<pg8::EpiBf16, pg8::TailSplitOrder>((LAS unsigned char*)lds, g, S, E); }
        else { pg8::StaticOrder S; S.init(NTOK, D, DFF, G, bid); pg8::gemm_phase<pg8::EpiBf16, pg8::StaticOrder>((LAS unsigned char*)lds, g, S, E); }
    } else {
        phase_ln(p, l, 1);
    }
}
#if MK_MULTI
template <int T> __global__ void __launch_bounds__(NTHR, 2) k_unit(P p) {
    extern __shared__ __attribute__((aligned(16))) unsigned char lds[];
    const int l = p.ph_lo; int bid = blockIdx.x, G = gridDim.x;
    if (T == 11) for (int u = bid; u < 512; u += G) smp_mlstm(p, l, u, lds);
    if (T == 12) for (int u = bid; u < 256; u += G) smp_ssd(p, l, u, lds);
    if (T == 13) for (int u = bid; u < 512; u += G) mlstm_local(p, l, u, lds);
    if (T == 14) for (int u = bid; u < 256; u += G) ssd_local(p, l, u, lds);
    if (T == 31) for (int u = bid; u < 512; u += G) mlstm_out(p, l, u, lds);
    if (T == 32) for (int u = bid; u < 256; u += G) ssd_out(p, l, u, lds);
    if (T == 21) for (int u = bid; u < 256; u += G) mlstm_scan(p, l, u, lds);
    if (T == 22) for (int u = bid; u < 256; u += G) ssd_scan(p, l, u, lds);
}
template <int Q> __global__ void __launch_bounds__(NTHR, 2) k_phase(P p) {
    extern __shared__ __attribute__((aligned(16))) unsigned char lds[];
    if (Q < 0) { if (gridDim.x == 256) phase_prologue(p, lds, 0, 1, true, blockIdx.x, 256, 0, T_WIN); else phase_prologue(p, lds, 0, 2, true, blockIdx.x, gridDim.x); } else run_phase(p, p.ph_lo, Q, lds);
}
#else
__global__ void __launch_bounds__(NTHR, 2) mk_fwd(P p) {
    extern __shared__ __attribute__((aligned(16))) unsigned char lds[];
    cg::grid_group grid = cg::this_grid();
    if (p.ph_hi < 0) grid.sync();
    if (threadIdx.x < 4) ((unsigned*)(lds + LDS_BYTES - 16))[threadIdx.x] = 0u;
    __syncthreads();
    (void)xcd_barrier_post((unsigned*)(p.ws + WS_BAR), (volatile LAS unsigned*)(lds + LDS_BYTES - 16));
#define GSYNC() do { XcdBarrier b_; b_.bar = (unsigned*)(p.ws + WS_BAR); b_.x = xb_xcc_id(); b_.st = (volatile LAS unsigned*)(lds + LDS_BYTES - 16); xcd_barrier(b_); } while (0)
    if (gridDim.x == 256) phase_prologue(p, lds, 0, 1, true, blockIdx.x, 256, 0, T_WIN); else phase_prologue(p, lds, 0, 2, true, blockIdx.x, gridDim.x);
#pragma unroll 1
    for (int l = 0; l < 2; ++l) {
        GSYNC(); run_phase(p, l, 0, lds);
        GSYNC(); run_phase(p, l, 1, lds);
        GSYNC(); run_phase(p, l, 2, lds);
        GSYNC(); run_phase(p, l, 3, lds);
        GSYNC(); run_phase(p, l, 4, lds);
        GSYNC(); run_phase(p, l, 5, lds);
        if (l == 1 && gridDim.x == 256) {
            GSYNC(); run_phase(p, l, 16, lds);
            GSYNC(); run_phase(p, l, 26, lds);
            GSYNC(); run_phase(p, l, 17, lds);
        } else {
            GSYNC(); run_phase(p, l, 6, lds);
            GSYNC(); run_phase(p, l, 7, lds);
        }
        GSYNC(); run_phase(p, l, 8, lds);
        GSYNC(); run_phase(p, l, 9, lds);
    }
    for (int i = 0; i < PROBE_SYNCS; ++i) GSYNC();
}
#endif

extern "C" void kernel_launch(void* const* d_in, const int* in_sizes, int n_in, void* d_out, int out_size, void* d_ws, size_t ws_size, hipStream_t stream) {
    static int grid = 0;
    if (grid == 0) {
        if (n_in != 27 || ws_size < WS_END) { fprintf(stderr, "kernel_launch: unexpected n_in %d or ws_size %zu (need %zu)\n", n_in, ws_size, (size_t)WS_END); grid = -1; return; }
        int dev = 0, cus = 0, per_cu = 0;
        hipGetDevice(&dev);
        hipDeviceGetAttribute(&cus, hipDeviceAttributeMultiprocessorCount, dev);
#if MK_MULTI
        const void* fns[11] = {(const void*)k_phase<-1>, (const void*)k_phase<0>, (const void*)k_phase<1>, (const void*)k_phase<2>, (const void*)k_phase<3>, (const void*)k_phase<4>, (const void*)k_phase<5>,
                               (const void*)k_phase<6>, (const void*)k_phase<7>, (const void*)k_phase<8>, (const void*)k_phase<9>};
        for (int i = 0; i < 11; ++i) if (hipFuncSetAttribute(fns[i], hipFuncAttributeMaxDynamicSharedMemorySize, LDS_BYTES) != hipSuccess) { fprintf(stderr, "kernel_launch: hipFuncSetAttribute failed\n"); grid = -1; return; }
#else
        if (hipFuncSetAttribute((const void*)mk_fwd, hipFuncAttributeMaxDynamicSharedMemorySize, LDS_BYTES) != hipSuccess) { fprintf(stderr, "kernel_launch: hipFuncSetAttribute failed\n"); grid = -1; return; }
        hipOccupancyMaxActiveBlocksPerMultiprocessor(&per_cu, (const void*)mk_fwd, NTHR, LDS_BYTES);
        (void)hipGetLastError();
#endif
        (void)per_cu;
        grid = cus * 1;
    }
    if (grid < 0) return;
    P p{};
    const float** pp = (const float**)&p;
    for (int i = 0; i < 27; ++i) pp[i] = (const float*)d_in[i];
    p.out = (float*)d_out; p.ws = (unsigned char*)d_ws;
#if MK_MULTI
    p.ph_lo = 0; p.ph_hi = 0;
    if (PROBE_REP == -1) hipLaunchKernelGGL(k_phase<-1>, dim3(grid), dim3(NTHR), LDS_BYTES, stream, p);
    hipLaunchKernelGGL(k_phase<-1>, dim3(grid), dim3(NTHR), LDS_BYTES, stream, p);
    for (int l = 0; l < 2; ++l) {
        p.ph_lo = l;
        for (int rep = 0; rep < 1 + ((PROBE_REP == 0) || (PROBE_REP == 100 && (0 == 0 || 0 == 4 || 0 == 6 || 0 == 8))); ++rep) hipLaunchKernelGGL(k_phase<0>, dim3(grid), dim3(NTHR), LDS_BYTES, stream, p);
        for (int rep = 0; rep < 1 + ((PROBE_REP == 1) || (PROBE_REP == 100 && (1 == 0 || 1 == 4 || 1 == 6 || 1 == 8))); ++rep) hipLaunchKernelGGL(k_phase<1>, dim3(grid), dim3(NTHR), LDS_BYTES, stream, p);
        for (int rep = 0; rep < 1 + ((PROBE_REP == 2) || (PROBE_REP == 100 && (2 == 0 || 2 == 4 || 2 == 6 || 2 == 8))); ++rep) hipLaunchKernelGGL(k_phase<2>, dim3(grid), dim3(NTHR), LDS_BYTES, stream, p);
        for (int rep = 0; rep < 1 + ((PROBE_REP == 3) || (PROBE_REP == 100 && (3 == 0 || 3 == 4 || 3 == 6 || 3 == 8))); ++rep) hipLaunchKernelGGL(k_phase<3>, dim3(grid), dim3(NTHR), LDS_BYTES, stream, p);
        if (PROBE_REP == 11 || PROBE_REP == 12 || PROBE_REP == 13 || PROBE_REP == 14 || PROBE_REP == 31 || PROBE_REP == 32 || PROBE_REP == 21 || PROBE_REP == 22) {
            hipFuncSetAttribute((const void*)k_unit<PROBE_REP>, hipFuncAttributeMaxDynamicSharedMemorySize, LDS_BYTES);
            hipLaunchKernelGGL(k_unit<PROBE_REP>, dim3(grid), dim3(NTHR), LDS_BYTES, stream, p);
        }
        for (int rep = 0; rep < 1 + ((PROBE_REP == 4) || (PROBE_REP == 100 && (4 == 0 || 4 == 4 || 4 == 6 || 4 == 8))); ++rep) hipLaunchKernelGGL(k_phase<4>, dim3(grid), dim3(NTHR), LDS_BYTES, stream, p);
        for (int rep = 0; rep < 1 + ((PROBE_REP == 5) || (PROBE_REP == 100 && (5 == 0 || 5 == 4 || 5 == 6 || 5 == 8))); ++rep) hipLaunchKernelGGL(k_phase<5>, dim3(grid), dim3(NTHR), LDS_BYTES, stream, p);
        for (int rep = 0; rep < 1 + ((PROBE_REP == 6) || (PROBE_REP == 100 && (6 == 0 || 6 == 4 || 6 == 6 || 6 == 8))); ++rep) hipLaunchKernelGGL(k_phase<6>, dim3(grid), dim3(NTHR), LDS_BYTES, stream, p);
        for (int rep = 0; rep < 1 + ((PROBE_REP == 7) || (PROBE_REP == 100 && (7 == 0 || 7 == 4 || 7 == 6 || 7 == 8))); ++rep) hipLaunchKernelGGL(k_phase<7>, dim3(grid), dim3(NTHR), LDS_BYTES, stream, p);
        for (int rep = 0; rep < 1 + ((PROBE_REP == 8) || (PROBE_REP == 100 && (8 == 0 || 8 == 4 || 8 == 6 || 8 == 8))); ++rep) hipLaunchKernelGGL(k_phase<8>, dim3(grid), dim3(NTHR), LDS_BYTES, stream, p);
        for (int rep = 0; rep < 1 + ((PROBE_REP == 9) || (PROBE_REP == 100 && (9 == 0 || 9 == 4 || 9 == 6 || 9 == 8))); ++rep) hipLaunchKernelGGL(k_phase<9>, dim3(grid), dim3(NTHR), LDS_BYTES, stream, p);
    }
#else
    p.ph_lo = 0; p.ph_hi = NPHASE;
    if (hipMemsetAsync((char*)d_ws + WS_BAR, 0, 16384, stream) != hipSuccess) { fprintf(stderr, "kernel_launch: memset failed\n"); return; }
    void* args[] = {&p};
    hipError_t e = hipLaunchCooperativeKernel((const void*)mk_fwd, dim3(grid), dim3(NTHR), args, LDS_BYTES, stream);
    if (e != hipSuccess) fprintf(stderr, "cooperative launch failed: %s (grid %d)\n", hipGetErrorString(e), grid);
#endif
}
```

```cpp
#include <hip/hip_runtime.h>
#include <hip/hip_cooperative_groups.h>
#include <cstdio>
namespace cg = cooperative_groups;

#ifndef MK_MULTI
#define MK_MULTI 0
#endif
#ifndef PROBE_REP
#define PROBE_REP -99
#endif
#ifndef PROBE_SYNCS
#define PROBE_SYNCS 0
#endif

#define DEV __device__ __forceinline__
#define LAS __attribute__((address_space(3)))
typedef unsigned short bf16_t;
typedef short bf16x8 __attribute__((ext_vector_type(8)));
typedef float f32x4 __attribute__((ext_vector_type(4)));
typedef float f32x2 __attribute__((ext_vector_type(2)));
typedef unsigned u32x4 __attribute__((ext_vector_type(4)));
typedef unsigned u32x2 __attribute__((ext_vector_type(2)));

constexpr int D = 2048, NPR = 8192, NSM = 1024, NTOK = 9216, INP = 6912, IN_DIM = 6680, DFF = 5504, DFF2 = 11008;
constexpr int UQ = 0, UK = 1024, UV = 2048, UO = 3072, UZ = 4096, UXS = 5120, UIG = 6656, UFG = 6660, UDT = 6664;
constexpr int NTHR = 512;
constexpr int LDS_BYTES = 136 * 1024;
constexpr float ALPHA = 1.41421356237309515f;

constexpr size_t O_YP = 0;
constexpr size_t O_YS = O_YP + (size_t)4 * 2048 * 2048;
constexpr size_t O_PC = O_YS + (size_t)128 * 8 * 2048;
constexpr size_t O_PN = O_PC + (size_t)2 * 4 * 4 * 256 * 256;
constexpr size_t O_PM = O_PN + (size_t)2 * 4 * 4 * 256;
constexpr size_t O_PS = O_PM + (size_t)2 * 4 * 4;
constexpr size_t O_PSC = O_PS + (size_t)2 * 4 * 16 * 64 * 128;
constexpr size_t O_PFC = O_PSC + (size_t)2 * 4 * 3 * 1536;
constexpr size_t O_SC = O_PFC + (size_t)2 * 4 * 2 * DFF2;
constexpr size_t O_SN = O_SC + (size_t)2 * 128 * 4 * 256 * 256;
constexpr size_t O_SM = O_SN + (size_t)2 * 128 * 4 * 256;
constexpr size_t O_SS = O_SM + (size_t)2 * 128 * 4;
constexpr size_t O_SSC = O_SS + (size_t)2 * 128 * 16 * 64 * 128;
constexpr size_t O_SFC = O_SSC + (size_t)2 * 128 * 3 * 1536;

constexpr size_t WS_WIN = 0;
constexpr size_t WS_WOUT = WS_WIN + (size_t)2 * INP * D * 2;
constexpr size_t WS_WUP = WS_WOUT + (size_t)2 * D * D * 2;
constexpr size_t WS_WDN = WS_WUP + (size_t)2 * DFF2 * D * 2;
constexpr size_t WS_XB = WS_WDN + (size_t)2 * D * DFF * 2;
constexpr size_t WS_XF = WS_XB + (size_t)NTOK * D * 2;
constexpr size_t WS_XBC = WS_XF;
constexpr size_t WS_U = WS_XF + (size_t)NTOK * D * 4;
constexpr size_t WS_MIXIN = WS_U + (size_t)NTOK * INP * 2;
constexpr size_t WS_MIXF = WS_MIXIN + (size_t)NTOK * D * 2;
constexpr size_t WS_UP = WS_MIXF + (size_t)NTOK * D * 4;
constexpr size_t WS_ACT = WS_UP + (size_t)NTOK * DFF2 * 2;
constexpr size_t WS_PART = WS_ACT + (size_t)NTOK * DFF * 2;
constexpr size_t WS_SMALL = WS_PART + (size_t)8 * NSM * D * 4;
constexpr size_t WS_DBUF = WS_UP;
constexpr size_t WS_SBUF = WS_UP + (size_t)512 * 65536 * 4;
constexpr size_t WS_CT = WS_ACT;
constexpr size_t WS_ST = WS_ACT + (size_t)512 * 65536 * 2;
static_assert(WS_SBUF + (size_t)2048 * 8192 * 4 <= WS_ACT, "alias");
static_assert(WS_ST + (size_t)2048 * 8192 * 2 <= WS_PART, "alias");
constexpr size_t WS_NLOC = WS_SMALL;
constexpr size_t WS_NST = WS_NLOC + (size_t)512 * 256 * 4;
constexpr size_t WS_GSTAT = WS_NST + (size_t)512 * 256 * 4;
constexpr size_t WS_MST = WS_GSTAT + 4096;
constexpr size_t WS_SBSUM = WS_MST + 4096;
constexpr size_t WS_BAR = WS_SBSUM + 8192;
constexpr size_t WS_END = WS_BAR + 16384;

struct P {
    const float* x_prompt; const float* x_sample; const float* st_C; const float* st_n; const float* st_m; const float* st_ssm; const float* st_sconv; const float* st_fconv;
    const float* w_in; const float* b_i; const float* b_f; const float* m_norm_w; const float* s_conv_w; const float* s_conv_b; const float* dt_bias; const float* A_log; const float* D_skip;
    const float* s_norm_w; const float* w_out; const float* ln1_g; const float* ln1_b; const float* w_up; const float* f_conv_w; const float* f_conv_b; const float* w_down; const float* ln2_g; const float* ln2_b;
    float* out; unsigned char* ws; int ph_lo, ph_hi;
};

DEV float bf2f(bf16_t v) { return __uint_as_float(((unsigned)v) << 16); }
DEV bf16_t f2bf(float f) { unsigned u = __float_as_uint(f); u += 0x7FFFu + ((u >> 16) & 1u); return (bf16_t)(u >> 16); }
typedef __bf16 bf16x2_t __attribute__((ext_vector_type(2)));
DEV unsigned pk2(float lo, float hi) { const f32x2 v = {lo, hi}; const bf16x2_t b = __builtin_convertvector(v, bf16x2_t); return __builtin_bit_cast(unsigned, b); }
DEV float bflo(unsigned w) { return __uint_as_float(w << 16); }
DEV float bfhi(unsigned w) { return __uint_as_float(w & 0xffff0000u); }
DEV float sigmoidf_(float x) { return __builtin_amdgcn_rcpf(1.0f + __expf(-x)); }
DEV float siluf_(float x) { return x * sigmoidf_(x); }
DEV float softplusf_(float x) { return fmaxf(x, 0.f) + __logf(1.0f + __expf(-fabsf(x))); }
DEV float logsigf_(float x) { return fminf(x, 0.f) - __logf(1.0f + __expf(-fabsf(x))); }
DEV float wave_sum(float v) {
#pragma unroll
    for (int o = 32; o >= 1; o >>= 1) v += __shfl_xor(v, o);
    return v; }
DEV float wave_max(float v) {
#pragma unroll
    for (int o = 32; o >= 1; o >>= 1) v = fmaxf(v, __shfl_xor(v, o));
    return v; }
DEV float wave_incl_sum(float v, int lane) {
#pragma unroll
    for (int o = 1; o < 64; o <<= 1) { float t = __shfl_up(v, o); if (lane >= o) v += t; }
    return v; }
DEV float wave_incl_max(float v, int lane) {
#pragma unroll
    for (int o = 1; o < 64; o <<= 1) { float t = __shfl_up(v, o); if (lane >= o) v = fmaxf(v, t); }
    return v; }
DEV f32x4 mfma16(bf16x8 a, bf16x8 b, f32x4 c) { return __builtin_amdgcn_mfma_f32_16x16x32_bf16(a, b, c, 0, 0, 0); }
DEV void unpack8(uint4 x, float (&f)[8]) { f[0] = bflo(x.x); f[1] = bfhi(x.x); f[2] = bflo(x.y); f[3] = bfhi(x.y); f[4] = bflo(x.z); f[5] = bfhi(x.z); f[6] = bflo(x.w); f[7] = bfhi(x.w); }

typedef short s16x4 __attribute__((ext_vector_type(4)));
DEV bf16x8 tr_frag(const bf16_t* T, int pitch, int krow0, int col0, int lane) {
    const int g = lane >> 4, q = (lane & 15) >> 2, pl = lane & 3;
    const bf16_t* a0 = T + (krow0 + 8 * g + q) * pitch + col0 + 4 * pl;
    const s16x4 lo = __builtin_amdgcn_ds_read_tr16_b64_v4i16((LAS s16x4*)a0);
    const s16x4 hi = __builtin_amdgcn_ds_read_tr16_b64_v4i16((LAS s16x4*)(a0 + 4 * pitch));
    return (bf16x8){lo[0], lo[1], lo[2], lo[3], hi[0], hi[1], hi[2], hi[3]};
}

namespace pg8 {
constexpr int BM = 256, BK = 64, HALF = 128, HTB = HALF * BK * 2, STAGE_BYTES = 8 * HTB, NXCD = 8, WGM = 8;
DEV int lds_byte(int r, int c) { const int st = (r >> 4) * 2 + (c >> 5), rr = r & 15, cc = c & 31, ob = rr * 64 + cc * 2; return st * 1024 + (ob ^ (((ob >> 9) & 1) << 5)); }
DEV void stage_rc(int b, int& R, int& C) { const int st = b / 1024, sb = b % 1024, swz = sb ^ (((sb >> 9) & 1) << 5); R = (st >> 1) * 16 + swz / 64; C = (st & 1) * 32 + (swz % 64) / 2; }
DEV int perm32(int rho) { const int n = rho >> 4, i = rho & 15; return 8 * (i >> 2) + 4 * n + (i & 3); }
struct Unit { int pm, pn, k0, nt, ks; };
struct Gemm { const bf16_t* A; const bf16_t* Bt; int M, N, K; };
struct StaticOrder {
    int nM, nN, nwg, G, c, ntk, ioff, imax;
    DEV void init(int M, int N, int K, int G_, int c_, int ioff_ = 0, int imax_ = 1 << 20) { nM = M / BM; nN = N / BM; nwg = nM * nN; G = G_; c = c_; ntk = K / BK; ioff = ioff_; imax = imax_; }
    DEV bool next(int i, Unit& u) const {
        u.pm = 0; u.pn = 0; u.k0 = 0; u.nt = 4; u.ks = -1;
        if (i + ioff >= imax) return false;
        const long L = (long)(i + ioff) * G + c; if (L >= nwg) return false;
        int wgid = (int)L; { const int q = nwg / NXCD, r = nwg % NXCD, xcd = wgid % NXCD, off = wgid / NXCD; wgid = (xcd < r ? xcd * (q + 1) : r * (q + 1) + (xcd - r) * q) + off; }
        const int nig = WGM * nN, gid = wgid / nig, fm = gid * WGM, gsz = (nM - fm) < WGM ? (nM - fm) : WGM;
        u.pm = fm + ((wgid % nig) % gsz); u.pn = (wgid % nig) / gsz; u.k0 = 0; u.nt = ntk; u.ks = -1; return true;
    }
};
struct TailSplitOrder {
    StaticOrder so; int c, ntk;
    DEV void init(int K, int c_) { so.init(NPR, D, K, 256, c_); c = c_; ntk = K / BK; }
    DEV bool next(int i, Unit& u) const {
        u.pm = 0; u.pn = 0; u.k0 = 0; u.nt = 4; u.ks = -1;
        if (i == 0) return so.next(0, u);
        if (i > 1) return false;
        const int tt = c >> 3, ks = c & 7; u.pm = 32 + (tt >> 3); u.pn = tt & 7; u.ks = ks;
        const int pairs = ntk >> 1, base = pairs >> 3, rem = pairs & 7;
        const int p0 = ks * base + (ks < rem ? ks : rem), np = base + (ks < rem ? 1 : 0);
        u.k0 = p0 * 128; u.nt = np * 2; return true;
    }
};
struct UpOrder {
    int c, ioff, imax;
    DEV void init(int c_, int ioff_, int imax_) { c = c_; ioff = ioff_; imax = imax_; }
    DEV bool next(int i, Unit& u) const {
        u.pm = 0; u.pn = 0; u.k0 = 0; u.nt = D / BK; u.ks = -1;
        const int r = i + ioff;
        if (r >= imax || r > 6 || (r == 6 && c >= 12)) return false;
        const int wgid = r < 6 ? ((r * 256 + c) % NXCD) * 192 + (r * 256 + c) / NXCD : 1536 + c;
        const int nN = DFF2 / BM, nig = WGM * nN, gid = wgid / nig, fm = gid * WGM, gsz = (36 - fm) < WGM ? (36 - fm) : WGM;
        u.pm = fm + ((wgid % nig) % gsz); u.pn = (wgid % nig) / gsz; return true;
    }
};
DEV unsigned cvt_pk_bf16(float lo, float hi) { unsigned r; asm volatile("v_cvt_pk_bf16_f32 %0, %1, %2" : "=v"(r) : "v"(lo), "v"(hi)); return r; }
struct EpiF32 {
    static constexpr bool PERM = false;
    float* C; int ldc; float* part;
    DEV void operator()(const f32x4 (&acc)[2][2][4][2], const Unit& u, int wr, int wc, int fr, int fq) const {
        const int row0 = u.pm * BM + wr * 64 + fr, col0 = u.pn * BM + wc * 32 + 4 * fq;
        float* Cb = u.ks < 0 ? C : part + (size_t)u.ks * NSM * D - (size_t)NPR * ldc;
#pragma unroll
        for (int ai = 0; ai < 2; ++ai)
#pragma unroll
            for (int m = 0; m < 4; ++m) { float* rowp = Cb + (size_t)(row0 + ai * HALF + m * 16) * ldc + col0;
#pragma unroll
                for (int bj = 0; bj < 2; ++bj)
#pragma unroll
                    for (int n = 0; n < 2; ++n) *(f32x4*)(rowp + bj * HALF + n * 16) = acc[ai][bj][m][n]; }
    }
};
struct EpiBf16 {
    static constexpr bool PERM = true;
    bf16_t* O; int ldc; float* part;
    DEV void operator()(const f32x4 (&acc)[2][2][4][2], const Unit& u, int wr, int wc, int fr, int fq) const {
        const int row0 = u.pm * BM + wr * 64 + fr; const int col0 = u.pn * BM + wc * 32 + 8 * fq;
        if (u.ks >= 0) {
            bf16_t* pb = (bf16_t*)part + (size_t)u.ks * NSM * ldc + (size_t)(row0 - NPR) * ldc + col0;
#pragma unroll
            for (int ai = 0; ai < 2; ++ai)
#pragma unroll
                for (int m = 0; m < 4; ++m)
#pragma unroll
                    for (int bj = 0; bj < 2; ++bj) { const f32x4 v0 = acc[ai][bj][m][0], v1 = acc[ai][bj][m][1];
                        u32x4 w; w.x = cvt_pk_bf16(v0[0], v0[1]); w.y = cvt_pk_bf16(v0[2], v0[3]); w.z = cvt_pk_bf16(v1[0], v1[1]); w.w = cvt_pk_bf16(v1[2], v1[3]);
                        *(u32x4*)(pb + (size_t)(ai * HALF + m * 16) * ldc + bj * HALF) = w; }
            return;
        }
#pragma unroll
        for (int ai = 0; ai < 2; ++ai)
#pragma unroll
            for (int m = 0; m < 4; ++m) { bf16_t* rowp = O + (size_t)(row0 + ai * HALF + m * 16) * ldc + col0;
#pragma unroll
                for (int bj = 0; bj < 2; ++bj) { const f32x4 v0 = acc[ai][bj][m][0], v1 = acc[ai][bj][m][1];
                    u32x4 w; w.x = cvt_pk_bf16(v0[0], v0[1]); w.y = cvt_pk_bf16(v0[2], v0[3]); w.z = cvt_pk_bf16(v1[0], v1[1]); w.w = cvt_pk_bf16(v1[2], v1[3]);
                    *(u32x4*)(rowp + bj * HALF) = w; } }
    }
};

template <class Epi, class Sched>
DEV void gemm_phase(LAS unsigned char* lds, const Gemm g, const Sched& S, const Epi& E) {
    int tid_ = threadIdx.x; asm volatile("" : "+v"(tid_)); const int tid = tid_, wid = __builtin_amdgcn_readfirstlane(tid >> 6), lane = tid & 63, wr = wid >> 2, wc = wid & 3, fr = lane & 15, fq = lane >> 4;
    const int K = g.K;
    unsigned voffA[2], voffB[2];
#pragma unroll
    for (int i = 0; i < 2; ++i) { int R, C; stage_rc(tid * 16 + i * 8192, R, C); const int Rb = Epi::PERM ? ((R & ~31) + perm32(R & 31)) : R;
        voffA[i] = (unsigned)(R * K + C) * 2u; voffB[i] = (unsigned)(Rb * K + C) * 2u; }
    const size_t kstep = (size_t)(BK * 2);
    const size_t hstep = (size_t)HALF * K * 2;
    const size_t tstep = 2 * hstep;
    const unsigned ldsw = (unsigned)wid * 1024u;
    const int aoff = lds_byte(wr * 64 + fr, fq * 8), boff = lds_byte(wc * 32 + fr, fq * 8);
#define PG8_SA(b, h) (((b) * 2 + (h)) * HTB)
#define PG8_SB(b, h) ((4 + (b) * 2 + (h)) * HTB)
#define PG8_STAGE(bufoff, gbase, voff) do { _Pragma("unroll") for (int _i = 0; _i < 2; ++_i) \
        __builtin_amdgcn_global_load_lds((const unsigned*)((const char*)(gbase) + (voff)[_i]), (LAS unsigned*)(lds + (bufoff) + ldsw + _i * 8192), 16, 0, 0); } while (0)
#define PG8_LDA(dst, b, h) do { _Pragma("unroll") for (int m = 0; m < 4; ++m) _Pragma("unroll") for (int k = 0; k < 2; ++k) dst[m][k] = *(const LAS bf16x8*)(lds + PG8_SA(b, h) + aoff + m * 2048 + k * 1024); } while (0)
#define PG8_LDB(dst, b, h) do { _Pragma("unroll") for (int n = 0; n < 2; ++n) _Pragma("unroll") for (int k = 0; k < 2; ++k) dst[n][k] = *(const LAS bf16x8*)(lds + PG8_SB(b, h) + boff + n * 2048 + k * 1024); } while (0)
#define PG8_MMA(ai, bj, At, Bt) do { __builtin_amdgcn_s_setprio(1); _Pragma("unroll") for (int m = 0; m < 4; ++m) _Pragma("unroll") for (int n = 0; n < 2; ++n) _Pragma("unroll") for (int k = 0; k < 2; ++k) \
        acc[ai][bj][m][n] = __builtin_amdgcn_mfma_f32_16x16x32_bf16(Bt[n][k], At[m][k], acc[ai][bj][m][n], 0, 0, 0); __builtin_amdgcn_s_setprio(0); } while (0)
#define PG8_WAIT_V(n) asm volatile("s_waitcnt vmcnt(" #n ")" ::: "memory")
#define PG8_WAIT_L(n) asm volatile("s_waitcnt lgkmcnt(" #n ")" ::: "memory")
#define PG8_BAR __builtin_amdgcn_s_barrier()
#define PG8_SCHED __builtin_amdgcn_sched_barrier(0)
    Unit cur, nxt; int ui = 0;
    if (!S.next(0, cur)) return;
    f32x4 acc[2][2][4][2];
#pragma unroll
    for (int a = 0; a < 2; ++a)
#pragma unroll
        for (int b = 0; b < 2; ++b)
#pragma unroll
            for (int m = 0; m < 4; ++m)
#pragma unroll
                for (int n = 0; n < 2; ++n) acc[a][b][m][n] = (f32x4){0.f, 0.f, 0.f, 0.f};
    bf16x8 At[4][2], B0[2][2], B1[2][2];
    const char* cA = (const char*)g.A + (size_t)cur.pm * tstep + (size_t)cur.k0 * 2; const char* cB = (const char*)g.Bt + (size_t)cur.pn * tstep + (size_t)cur.k0 * 2;
    PG8_STAGE(PG8_SB(0, 0), cB, voffB); PG8_STAGE(PG8_SA(0, 0), cA, voffA); PG8_STAGE(PG8_SB(0, 1), cB + hstep, voffB); PG8_STAGE(PG8_SA(0, 1), cA + hstep, voffA);
    if (wr == 1) PG8_BAR;
    PG8_WAIT_V(4); PG8_BAR;
    PG8_STAGE(PG8_SB(1, 0), cB + kstep, voffB); PG8_STAGE(PG8_SA(1, 0), cA + kstep, voffA); PG8_STAGE(PG8_SB(1, 1), cB + hstep + kstep, voffB);
    PG8_WAIT_V(6); PG8_BAR;
    for (;;) {
        const bool has_next = S.next(ui + 1, nxt);
        const char* nA = has_next ? (const char*)g.A + (size_t)nxt.pm * tstep + (size_t)nxt.k0 * 2 : cA; const char* nB = has_next ? (const char*)g.Bt + (size_t)nxt.pn * tstep + (size_t)nxt.k0 * 2 : cB;
        const int nt = cur.nt;
        for (int t = 0; t < nt; t += 2) {
            const bool last = (t == nt - 2);
            const char* a1 = cA + (size_t)(t + 1) * kstep;
            const char* a2 = last ? nA : cA + (size_t)(t + 2) * kstep; const char* b2 = last ? nB : cB + (size_t)(t + 2) * kstep;
            const char* a3 = a2 + kstep; const char* b3 = b2 + kstep;
            PG8_LDB(B0, 0, 0); PG8_SCHED; PG8_LDA(At, 0, 0); PG8_STAGE(PG8_SA(1, 1), a1 + hstep, voffA);
            PG8_WAIT_L(8); PG8_BAR; PG8_WAIT_L(0); PG8_MMA(0, 0, At, B0); PG8_BAR; PG8_SCHED;
            PG8_LDB(B1, 0, 1); PG8_STAGE(PG8_SB(0, 0), b2, voffB);
            PG8_BAR; PG8_WAIT_L(0); PG8_MMA(0, 1, At, B1); PG8_BAR;
            PG8_LDA(At, 0, 1); PG8_STAGE(PG8_SA(0, 0), a2, voffA);
            PG8_BAR; PG8_WAIT_L(0); PG8_MMA(1, 0, At, B0); PG8_BAR; PG8_SCHED;
            PG8_STAGE(PG8_SB(0, 1), b2 + hstep, voffB);
            PG8_WAIT_V(6); PG8_BAR; PG8_MMA(1, 1, At, B1); PG8_BAR;
            PG8_LDB(B0, 1, 0); PG8_SCHED; PG8_LDA(At, 1, 0); PG8_STAGE(PG8_SA(0, 1), a2 + hstep, voffA);
            PG8_WAIT_L(8); PG8_BAR; PG8_WAIT_L(0); PG8_MMA(0, 0, At, B0); PG8_BAR; PG8_SCHED;
            PG8_LDB(B1, 1, 1); PG8_STAGE(PG8_SB(1, 0), b3, voffB);
            PG8_BAR; PG8_WAIT_L(0); PG8_MMA(0, 1, At, B1); PG8_BAR;
            PG8_LDA(At, 1, 1); PG8_STAGE(PG8_SA(1, 0), a3, voffA);
            PG8_BAR; PG8_WAIT_L(0); PG8_MMA(1, 0, At, B0); PG8_BAR; PG8_SCHED;
            PG8_STAGE(PG8_SB(1, 1), b3 + hstep, voffB);
            PG8_WAIT_V(6); PG8_BAR; PG8_MMA(1, 1, At, B1); PG8_BAR;
        }
        E(acc, cur, wr, wc, fr, fq);
        if (!has_next) break;
#pragma unroll
        for (int a = 0; a < 2; ++a)
#pragma unroll
            for (int b = 0; b < 2; ++b)
#pragma unroll
                for (int m = 0; m < 4; ++m)
#pragma unroll
                    for (int n = 0; n < 2; ++n) acc[a][b][m][n] = (f32x4){0.f, 0.f, 0.f, 0.f};
        cur = nxt; cA = nA; cB = nB; ++ui;
    }
    PG8_WAIT_V(0);
    if (wr == 0) PG8_BAR;
    PG8_BAR;
#undef PG8_SA
#undef PG8_SB
#undef PG8_STAGE
#undef PG8_LDA
#undef PG8_LDB
#undef PG8_MMA
#undef PG8_WAIT_V
#undef PG8_WAIT_L
#undef PG8_BAR
#undef PG8_SCHED
}
}

DEV int win_srccol(int n) { return n < 4096 ? n : (n < 6656 ? n + 8 : (n < 6664 ? n - 2560 : (n < 6680 ? n : -1))); }
DEV void transpose_tile(const float* __restrict__ src, int srcN, bf16_t* __restrict__ dst, int K, int n0, int k0, int mode, float* tile) {
    int tid_ = threadIdx.x; asm volatile("" : "+v"(tid_)); const int tid = tid_;
    f32x4 v[4];
#pragma unroll
    for (int i = 0; i < 4; ++i) {
        const int kk = (tid >> 5) + 16 * i, nn4 = (tid & 31) * 4, n = n0 + nn4;
        const int sc = mode ? win_srccol(n) : n;
        v[i] = (f32x4){0.f, 0.f, 0.f, 0.f};
        if (sc >= 0) v[i] = __builtin_nontemporal_load((const f32x4*)(src + (size_t)(k0 + kk) * srcN + sc));
        if (mode && n >= 1024 && n < 2048) v[i] = v[i] * 0.0625f;
    }
#pragma unroll
    for (int i = 0; i < 4; ++i) {
        const int kk = (tid >> 5) + 16 * i, nn4 = (tid & 31) * 4;
        tile[kk * 129 + nn4 + 0] = v[i][0]; tile[kk * 129 + nn4 + 1] = v[i][1]; tile[kk * 129 + nn4 + 2] = v[i][2]; tile[kk * 129 + nn4 + 3] = v[i][3];
    }
    __syncthreads();
#pragma unroll
    for (int i = 0; i < 2; ++i) {
        const int ch = tid + 512 * i, nn = ch >> 3, kk8 = (ch & 7) * 8;
        u32x4 w;
        w.x = pk2(tile[(kk8 + 0) * 129 + nn], tile[(kk8 + 1) * 129 + nn]); w.y = pk2(tile[(kk8 + 2) * 129 + nn], tile[(kk8 + 3) * 129 + nn]);
        w.z = pk2(tile[(kk8 + 4) * 129 + nn], tile[(kk8 + 5) * 129 + nn]); w.w = pk2(tile[(kk8 + 6) * 129 + nn], tile[(kk8 + 7) * 129 + nn]);
        *(u32x4*)(dst + (size_t)(n0 + nn) * K + k0 + kk8) = w;
    }
    __syncthreads();
}
constexpr int T_WIN = (INP / 128) * (D / 64), T_WOUT = (D / 128) * (D / 64), T_WUP = (DFF2 / 128) * (D / 64), T_WDN = (D / 128) * (DFF / 64);
constexpr int T_L = T_WIN + T_WOUT + T_WUP + T_WDN, T_X = NTOK * D / 4096;
DEV void phase_prologue(const P& p, unsigned char* lds, int l_lo, int l_hi, bool with_x, int b0, int nb, int rlo = 0, int rhi = T_L) {
    float* tile = (float*)lds;
    const int cnt = rhi - rlo;
    const int nw = (l_hi - l_lo) * cnt, total = nw + (with_x ? T_X : 0);
    for (int u = b0; u < total; u += nb) {
        if (u < nw) {
            const int l = l_lo + u / cnt; int r = rlo + u % cnt;
            if (r < T_WIN) { const int nt = r / (D / 64), kt = r % (D / 64);
                transpose_tile(p.w_in + (size_t)l * D * IN_DIM, IN_DIM, (bf16_t*)(p.ws + WS_WIN) + (size_t)l * INP * D, D, nt * 128, kt * 64, 1, tile); }
            else if ((r -= T_WIN) < T_WOUT) { const int nt = r / (D / 64), kt = r % (D / 64);
                transpose_tile(p.w_out + (size_t)l * D * D, D, (bf16_t*)(p.ws + WS_WOUT) + (size_t)l * D * D, D, nt * 128, kt * 64, 0, tile); }
            else if ((r -= T_WOUT) < T_WUP) { const int nt = r / (D / 64), kt = r % (D / 64);
                transpose_tile(p.w_up + (size_t)l * D * DFF2, DFF2, (bf16_t*)(p.ws + WS_WUP) + (size_t)l * DFF2 * D, D, nt * 128, kt * 64, 0, tile); }
            else { r -= T_WUP; const int nt = r / (DFF / 64), kt = r % (DFF / 64);
                transpose_tile(p.w_down + (size_t)l * DFF * D, D, (bf16_t*)(p.ws + WS_WDN) + (size_t)l * D * DFF, DFF, nt * 128, kt * 64, 0, tile); }
        } else {
            const size_t e = (size_t)(u - nw) * 4096 + threadIdx.x * 8;
            const float* s = e < (size_t)NPR * D ? p.x_prompt + e : p.x_sample + (e - (size_t)NPR * D);
            const f32x4 a = *(const f32x4*)s, b = *(const f32x4*)(s + 4);
            u32x4 w; w.x = pk2(a[0], a[1]); w.y = pk2(a[2], a[3]); w.z = pk2(b[0], b[1]); w.w = pk2(b[2], b[3]);
            *(u32x4*)((bf16_t*)(p.ws + WS_XB) + e) = w;
        }
    }
}

DEV void mlstm_local(const P& p, int l, int unit, unsigned char* lds) {
    const int bh = unit >> 5, c = unit & 31, b = bh >> 2, h = bh & 3;
    int tid_ = threadIdx.x; asm volatile("" : "+v"(tid_)); const int tid = tid_, lane = tid & 63, w = tid >> 6, fr = lane & 15, fq = lane >> 4;
    const bf16_t* U = (const bf16_t*)(p.ws + WS_U) + (size_t)(b * 2048 + c * 64) * INP;
    float* wsh = (float*)lds;
    bf16_t* KW = (bf16_t*)(lds + 1024);
    bf16_t* V = KW + 64 * 272;
    float* gstat = (float*)(p.ws + WS_GSTAT);
    if (w == 0) {
        const float ig = bf2f(U[(size_t)lane * INP + UIG + h]) + p.b_i[l * 4 + h];
        const float lf = logsigf_(bf2f(U[(size_t)lane * INP + UFG + h]) + p.b_f[l * 4 + h]);
        const float bs = wave_incl_sum(lf, lane);
        const float a = ig - bs;
        const float amax = wave_max(a);
        const float bsum = __shfl(bs, 63);
        wsh[lane] = __expf(a - amax);
        if (lane == 0) { gstat[(bh * 32 + c) * 2] = bsum; gstat[(bh * 32 + c) * 2 + 1] = bsum + amax; }
    }
    __syncthreads();
#pragma unroll
    for (int i = 0; i < 4; ++i) {
        const int it = tid + 512 * i, s_ = it >> 5, d8 = (it & 31) * 8;
        const uint4 kv = *(const uint4*)(U + (size_t)s_ * INP + UK + h * 256 + d8);
        const uint4 vv = *(const uint4*)(U + (size_t)s_ * INP + UV + h * 256 + d8);
        const float ws_ = wsh[s_];
        float kf[8]; unpack8(kv, kf);
        u32x4 kw; kw.x = pk2(kf[0] * ws_, kf[1] * ws_); kw.y = pk2(kf[2] * ws_, kf[3] * ws_); kw.z = pk2(kf[4] * ws_, kf[5] * ws_); kw.w = pk2(kf[6] * ws_, kf[7] * ws_);
        *(u32x4*)(KW + s_ * 272 + d8) = kw;
        *(uint4*)(V + s_ * 272 + d8) = vv;
    }
    __syncthreads();
    if (tid < 256) { float a = 0.f; for (int s_ = 0; s_ < 64; ++s_) a += bf2f(KW[s_ * 272 + tid]); ((float*)(p.ws + WS_NLOC))[(size_t)(bh * 32 + c) * 256 + tid] = a; }
    f32x4 acc[2][16];
#pragma unroll
    for (int m = 0; m < 2; ++m)
#pragma unroll
        for (int n = 0; n < 16; ++n) acc[m][n] = (f32x4){0.f, 0.f, 0.f, 0.f};
#pragma unroll
    for (int ks = 0; ks < 2; ++ks) {
        bf16x8 vf[2];
#pragma unroll
        for (int m = 0; m < 2; ++m) vf[m] = tr_frag(V, 272, 32 * ks, 32 * w + 16 * m, lane);
#pragma unroll
        for (int n = 0; n < 16; ++n) {
            const bf16x8 kf = tr_frag(KW, 272, 32 * ks, 16 * n, lane);
#pragma unroll
            for (int m = 0; m < 2; ++m) acc[m][n] = mfma16(kf, vf[m], acc[m][n]);
        }
    }
    bf16_t* Dp = (bf16_t*)(p.ws + WS_DBUF) + (size_t)(bh * 32 + c) * 65536;
#pragma unroll
    for (int m = 0; m < 2; ++m)
#pragma unroll
        for (int n = 0; n < 16; ++n) { u32x2 wv; wv.x = pk2(acc[m][n][0], acc[m][n][1]); wv.y = pk2(acc[m][n][2], acc[m][n][3]);
            *(u32x2*)(Dp + (32 * w + 16 * m + fr) * 256 + 16 * n + fq * 4) = wv; }
    __syncthreads();
}

DEV void mlstm_scan(const P& p, int l, int unit, unsigned char* lds) {
    int tid_ = threadIdx.x; asm volatile("" : "+v"(tid_)); const int bh = unit >> 4, slab = unit & 15, tid = tid_;
    float* fA = (float*)lds; float* fB = fA + 32;
    const float* gstat = (const float*)(p.ws + WS_GSTAT);
    float* gs = fB + 32;
    if (tid < 64) gs[tid] = gstat[bh * 64 + tid];
    __syncthreads();
    if (tid == 0) {
        float m = 0.f;
        for (int c = 0; c < 32; ++c) {
            const float bsum = gs[c * 2], mloc = gs[c * 2 + 1];
            const float mn = fmaxf(bsum + m, mloc);
            fA[c] = __expf(bsum + m - mn); fB[c] = __expf(mloc - mn); m = mn;
            if (slab == 0) ((float*)(p.ws + WS_MST))[bh * 32 + c] = mn;
        }
        if (slab == 0) p.out[O_PM + l * 16 + bh] = m;
    }
    __syncthreads();
    const size_t e0 = (size_t)slab * 4096 + tid * 8;
    float run[8];
#pragma unroll
    for (int i = 0; i < 8; ++i) run[i] = 0.f;
    const bf16_t* Dp = (const bf16_t*)(p.ws + WS_DBUF) + (size_t)bh * 32 * 65536 + e0;
    bf16_t* Cp = (bf16_t*)(p.ws + WS_CT) + (size_t)bh * 32 * 65536 + e0;
#pragma unroll 1
    for (int cb = 0; cb < 32; cb += 8) {
        uint4 xx[8];
#pragma unroll
        for (int j = 0; j < 8; ++j) xx[j] = *(const uint4*)(Dp + (size_t)(cb + j) * 65536);
#pragma unroll
        for (int j = 0; j < 8; ++j) {
            const int c = cb + j;
            const float a = fA[c], bq = fB[c];
            float xf[8]; unpack8(xx[j], xf);
#pragma unroll
            for (int i = 0; i < 8; ++i) run[i] = a * run[i] + bq * xf[i];
            u32x4 wv; wv.x = pk2(run[0], run[1]); wv.y = pk2(run[2], run[3]); wv.z = pk2(run[4], run[5]); wv.w = pk2(run[6], run[7]);
            *(u32x4*)(Cp + (size_t)c * 65536) = wv;
        }
    }
    {
        float* o = p.out + O_PC + (size_t)(l * 16 + bh) * 65536;
        const int e = (int)(e0 >> 8), d0 = (int)(e0 & 255);
#pragma unroll
        for (int i = 0; i < 8; ++i) o[(d0 + i) * 256 + e] = run[i];
    }
    if (slab == 0 && tid < 256) {
        float r = 0.f;
        const float* nl = (const float*)(p.ws + WS_NLOC) + (size_t)bh * 32 * 256 + tid;
        float* ns = (float*)(p.ws + WS_NST) + (size_t)bh * 32 * 256 + tid;
        for (int c = 0; c < 32; ++c) { r = fA[c] * r + fB[c] * nl[c * 256]; ns[c * 256] = r; }
        p.out[O_PN + (size_t)(l * 16 + bh) * 256 + tid] = r;
    }
    __syncthreads();
}

DEV void ssd_scan(const P& p, int l, int unit, unsigned char* lds) {
    int tid_ = threadIdx.x; asm volatile("" : "+v"(tid_)); const int bhd = unit >> 2, slab = unit & 3, tid = tid_;
    float* dec = (float*)lds;
    if (tid < 32) dec[tid] = __expf(((const float*)(p.ws + WS_SBSUM))[bhd * 32 + tid]);
    __syncthreads();
    const size_t e0 = (size_t)slab * 2048 + tid * 4;
    f32x4 run = (f32x4){0.f, 0.f, 0.f, 0.f};
    const bf16_t* Sp = (const bf16_t*)(p.ws + WS_SBUF) + (size_t)bhd * 32 * 8192 + e0;
    bf16_t* Tp = (bf16_t*)(p.ws + WS_ST) + (size_t)bhd * 32 * 8192 + e0;
#pragma unroll 1
    for (int cb = 0; cb < 32; cb += 8) {
        uint2 xx[8];
#pragma unroll
        for (int j = 0; j < 8; ++j) xx[j] = *(const uint2*)(Sp + (size_t)(cb + j) * 8192);
#pragma unroll
        for (int j = 0; j < 8; ++j) {
            run = run * dec[cb + j] + (f32x4){bflo(xx[j].x), bfhi(xx[j].x), bflo(xx[j].y), bfhi(xx[j].y)};
            u32x2 wv; wv.x = pk2(run[0], run[1]); wv.y = pk2(run[2], run[3]);
            *(u32x2*)(Tp + (size_t)(cb + j) * 8192) = wv;
        }
    }
    *(f32x4*)(p.out + O_PS + (size_t)(l * 64 + bhd) * 8192 + e0) = run;
    __syncthreads();
}

DEV void convstate_copy(const P& p, int l, int unit) {
    const bf16_t* Ub = (const bf16_t*)(p.ws + WS_U);
    int tid_ = threadIdx.x; asm volatile("" : "+v"(tid_));
    for (int i = tid_; i < 3 * 1536; i += NTHR) {
        const int j = i / 1536, ch = i % 1536;
        if (unit < 4) p.out[O_PSC + ((size_t)(l * 4 + unit) * 3 + j) * 1536 + ch] = bf2f(Ub[(size_t)(unit * 2048 + 2045 + j) * INP + UXS + ch]);
        else { const int b = unit - 4; p.out[O_SSC + ((size_t)(l * 128 + b) * 3 + j) * 1536 + ch] = bf2f(Ub[(size_t)(NPR + b * 8 + 5 + j) * INP + UXS + ch]); }
    }
}

DEV void mlstm_out(const P& p, int l, int unit, unsigned char* lds) {
    const int bh = unit >> 5, c = unit & 31, b = bh >> 2, h = bh & 3;
    int tid_ = threadIdx.x; asm volatile("" : "+v"(tid_)); const int tid = tid_, lane = tid & 63, w = tid >> 6, fr = lane & 15, fq = lane >> 4;
    const int r0 = b * 2048 + c * 64;
    const bf16_t* U = (const bf16_t*)(p.ws + WS_U) + (size_t)r0 * INP;
    bf16_t* Qs = (bf16_t*)lds;
    bf16_t* Ks = Qs + 64 * 264;
    bf16_t* V = Ks + 64 * 264;
    bf16_t* Ss = V + 64 * 272;
    float* fl = (float*)(lds + 113664);
    float* bsh = fl; float* ash = fl + 64; float* mth = fl + 128; float* wint = fl + 192; float* rdn = fl + 256; float* qn = fl + 320; float* nprev = fl + 384; float* red = fl + 640;
    float* stat = fl + 1152;
    if (w == 0) {
        const float ig = bf2f(U[(size_t)lane * INP + UIG + h]) + p.b_i[l * 4 + h];
        const float lf = logsigf_(bf2f(U[(size_t)lane * INP + UFG + h]) + p.b_f[l * 4 + h]);
        const float bs = wave_incl_sum(lf, lane);
        const float a = ig - bs;
        const float cm = wave_incl_max(a, lane);
        const float mprev = c > 0 ? ((const float*)(p.ws + WS_MST))[bh * 32 + c - 1] : 0.f;
        const float mt = bs + fmaxf(mprev, cm);
        bsh[lane] = bs; ash[lane] = a; mth[lane] = mt; wint[lane] = __expf(bs + mprev - mt);
    }
    if (tid >= 256) { const int d = tid - 256; nprev[d] = c > 0 ? ((const float*)(p.ws + WS_NST))[(size_t)(bh * 32 + c - 1) * 256 + d] : 0.f; }
#pragma unroll
    for (int i = 0; i < 4; ++i) {
        const int it = tid + 512 * i, s_ = it >> 5, d8 = (it & 31) * 8;
        *(uint4*)(Qs + s_ * 264 + d8) = *(const uint4*)(U + (size_t)s_ * INP + UQ + h * 256 + d8);
        *(uint4*)(Ks + s_ * 264 + d8) = *(const uint4*)(U + (size_t)s_ * INP + UK + h * 256 + d8);
        *(uint4*)(V + s_ * 272 + d8) = *(const uint4*)(U + (size_t)s_ * INP + UV + h * 256 + d8);
    }
    __syncthreads();
    {
        const int mt_ = w >> 1, nt0 = (w & 1) * 2;
        f32x4 sacc[2] = {(f32x4){0.f, 0.f, 0.f, 0.f}, (f32x4){0.f, 0.f, 0.f, 0.f}};
#pragma unroll
        for (int k0 = 0; k0 < 256; k0 += 32) {
            const bf16x8 a = *(const bf16x8*)(Qs + (16 * mt_ + fr) * 264 + k0 + fq * 8);
#pragma unroll
            for (int n = 0; n < 2; ++n) { const bf16x8 bb = *(const bf16x8*)(Ks + (16 * (nt0 + n) + fr) * 264 + k0 + fq * 8); sacc[n] = mfma16(a, bb, sacc[n]); }
        }
#pragma unroll
        for (int n = 0; n < 2; ++n)
#pragma unroll
            for (int j = 0; j < 4; ++j) {
                const int t = 16 * mt_ + fq * 4 + j, s_ = 16 * (nt0 + n) + fr;
                const float val = (s_ <= t) ? sacc[n][j] * __expf(bsh[t] - mth[t] + ash[s_]) : 0.f;
                Ss[t * 72 + s_] = f2bf(val);
            }
        const int t = tid >> 3, part = tid & 7;
        float a = 0.f;
        for (int d = part * 32; d < part * 32 + 32; ++d) a += bf2f(Qs[t * 264 + d]) * nprev[d];
        a += __shfl_xor(a, 1); a += __shfl_xor(a, 2); a += __shfl_xor(a, 4);
        if (part == 0) qn[t] = a;
    }
    __syncthreads();
    {
        const int t = tid >> 3, part = tid & 7;
        float di = 0.f;
#pragma unroll
        for (int s_ = 0; s_ < 8; ++s_) di += bf2f(Ss[t * 72 + part * 8 + s_]);
        di += __shfl_xor(di, 1); di += __shfl_xor(di, 2); di += __shfl_xor(di, 4);
        if (part == 0) { const float den = di + wint[t] * qn[t]; rdn[t] = __builtin_amdgcn_rcpf(fmaxf(fabsf(den), __expf(-mth[t]))); }
    }
    const int e0 = 32 * w;
    f32x4 acc1[4][2], acc2[4][2];
#pragma unroll
    for (int m = 0; m < 4; ++m)
#pragma unroll
        for (int n = 0; n < 2; ++n) { acc1[m][n] = (f32x4){0.f, 0.f, 0.f, 0.f}; acc2[m][n] = (f32x4){0.f, 0.f, 0.f, 0.f}; }
#pragma unroll
    for (int ks = 0; ks < 2; ++ks) {
        bf16x8 sf[4];
#pragma unroll
        for (int m = 0; m < 4; ++m) sf[m] = *(const bf16x8*)(Ss + (16 * m + fr) * 72 + 32 * ks + fq * 8);
#pragma unroll
        for (int n = 0; n < 2; ++n) { const bf16x8 vf = tr_frag(V, 272, 32 * ks, e0 + 16 * n, lane);
#pragma unroll
            for (int m = 0; m < 4; ++m) acc1[m][n] = mfma16(vf, sf[m], acc1[m][n]); }
    }
    if (c > 0) {
        const bf16_t* CTp = (const bf16_t*)(p.ws + WS_CT) + (size_t)(bh * 32 + c - 1) * 65536;
#pragma unroll 2
        for (int k0 = 0; k0 < 256; k0 += 32) {
            bf16x8 a[4];
#pragma unroll
            for (int m = 0; m < 4; ++m) a[m] = *(const bf16x8*)(Qs + (16 * m + fr) * 264 + k0 + fq * 8);
#pragma unroll
            for (int n = 0; n < 2; ++n) { const bf16x8 cf = *(const bf16x8*)(CTp + (size_t)(e0 + 16 * n + fr) * 256 + k0 + fq * 8);
#pragma unroll
                for (int m = 0; m < 4; ++m) acc2[m][n] = mfma16(cf, a[m], acc2[m][n]); }
        }
    }
    __syncthreads();
#pragma unroll
    for (int m = 0; m < 4; ++m) {
        const int t = 16 * m + fr;
        const float wi = wint[t], rd = rdn[t];
        float sm = 0.f;
#pragma unroll
        for (int n = 0; n < 2; ++n)
#pragma unroll
            for (int j = 0; j < 4; ++j) { const float hv = (acc1[m][n][j] + wi * acc2[m][n][j]) * rd; acc1[m][n][j] = hv; sm += hv; }
        sm += __shfl_xor(sm, 16); sm += __shfl_xor(sm, 32);
        if (fq == 0) red[t * 8 + w] = sm;
    }
    __syncthreads();
    if (tid < 64) { float sm = 0.f;
#pragma unroll
        for (int i = 0; i < 8; ++i) sm += red[tid * 8 + i];
        stat[tid] = sm * (1.0f / 256.0f); }
    __syncthreads();
#pragma unroll
    for (int m = 0; m < 4; ++m) {
        const int t = 16 * m + fr;
        const float mu = stat[t];
        float sm = 0.f;
#pragma unroll
        for (int n = 0; n < 2; ++n)
#pragma unroll
            for (int j = 0; j < 4; ++j) { const float dv = acc1[m][n][j] - mu; acc1[m][n][j] = dv; sm += dv * dv; }
        sm += __shfl_xor(sm, 16); sm += __shfl_xor(sm, 32);
        if (fq == 0) red[t * 8 + w] = sm;
    }
    __syncthreads();
    if (tid < 64) { float sm = 0.f;
#pragma unroll
        for (int i = 0; i < 8; ++i) sm += red[tid * 8 + i];
        stat[64 + tid] = rsqrtf(sm * (1.0f / 256.0f) + 1e-6f); }
    __syncthreads();
    bf16_t* MX = (bf16_t*)(p.ws + WS_MIXIN);
#pragma unroll
    for (int m = 0; m < 4; ++m) {
        const int t = 16 * m + fr;
        const float rs = stat[64 + t];
#pragma unroll
        for (int n = 0; n < 2; ++n) {
            const int e4 = e0 + 16 * n + fq * 4;
            const uint2 ov = *(const uint2*)(U + (size_t)t * INP + UO + h * 256 + e4);
            const f32x4 nw = *(const f32x4*)(p.m_norm_w + l * 1024 + h * 256 + e4);
            u32x2 wv;
            wv.x = pk2(acc1[m][n][0] * rs * nw[0] * sigmoidf_(bflo(ov.x)), acc1[m][n][1] * rs * nw[1] * sigmoidf_(bfhi(ov.x)));
            wv.y = pk2(acc1[m][n][2] * rs * nw[2] * sigmoidf_(bflo(ov.y)), acc1[m][n][3] * rs * nw[3] * sigmoidf_(bfhi(ov.y)));
            *(u32x2*)(MX + (size_t)(r0 + t) * D + h * 256 + e4) = wv;
        }
    }
    __syncthreads();
}

DEV void ssd_conv8(const bf16_t* Urow, int tpos, const float* cw, const float* cb, int ch8, float (&o)[8]) {
    const f32x4 b0 = *(const f32x4*)(cb + ch8), b1 = *(const f32x4*)(cb + ch8 + 4);
    o[0] = b0[0]; o[1] = b0[1]; o[2] = b0[2]; o[3] = b0[3]; o[4] = b1[0]; o[5] = b1[1]; o[6] = b1[2]; o[7] = b1[3];
#pragma unroll
    for (int j = 0; j < 4; ++j) {
        const int back = 3 - j;
        if (tpos - back >= 0) {
            const uint4 x = *(const uint4*)(Urow - (size_t)back * INP + UXS + ch8);
            float xf[8]; unpack8(x, xf);
            const f32x4 w0 = *(const f32x4*)(cw + j * 1536 + ch8), w1 = *(const f32x4*)(cw + j * 1536 + ch8 + 4);
            o[0] += w0[0] * xf[0]; o[1] += w0[1] * xf[1]; o[2] += w0[2] * xf[2]; o[3] += w0[3] * xf[3];
            o[4] += w1[0] * xf[4]; o[5] += w1[1] * xf[5]; o[6] += w1[2] * xf[6]; o[7] += w1[3] * xf[7];
        }
    }
#pragma unroll
    for (int i = 0; i < 8; ++i) o[i] = siluf_(o[i]);
}

DEV void ssd_local(const P& p, int l, int unit, unsigned char* lds) {
    const int b = unit >> 6, g = (unit >> 5) & 1, c = unit & 31;
    int tid_ = threadIdx.x; asm volatile("" : "+v"(tid_)); const int tid = tid_, lane = tid & 63, w = tid >> 6, fr = lane & 15, fq = lane >> 4;
    const int r0 = b * 2048 + c * 64;
    const bf16_t* U = (const bf16_t*)(p.ws + WS_U) + (size_t)r0 * INP;
    bf16_t* XW = (bf16_t*)lds;
    bf16_t* Bmn = XW + 64 * 528;
    float* wsh = (float*)(lds + 86016);
    {
        const int head = g * 8 + w;
        const float dt = softplusf_(bf2f(U[(size_t)lane * INP + UDT + head]) + p.dt_bias[l * 16 + head]);
        const float a = -__expf(p.A_log[l * 16 + head]) * dt;
        const float bs = wave_incl_sum(a, lane);
        const float bL = __shfl(bs, 63);
        wsh[w * 64 + lane] = __expf(bL - bs) * dt;
        if (lane == 0) ((float*)(p.ws + WS_SBSUM))[(b * 16 + head) * 32 + c] = bL;
    }
    __syncthreads();
    const float* cw = p.s_conv_w + (size_t)l * 4 * 1536; const float* cb = p.s_conv_b + (size_t)l * 1536;
    bf16_t* XBC = (bf16_t*)(p.ws + WS_XBC) + (size_t)r0 * 1536;
    for (int i = 0; i < 12; ++i) {
        const int it = tid + 512 * i, t = it / 96, gidx = it % 96;
        const int ch8 = gidx < 64 ? g * 512 + gidx * 8 : (gidx < 80 ? 1024 + g * 128 + (gidx - 64) * 8 : 1280 + g * 128 + (gidx - 80) * 8);
        float v[8];
        ssd_conv8(U + (size_t)t * INP, c * 64 + t, cw, cb, ch8, v);
        { u32x4 wr_; wr_.x = pk2(v[0], v[1]); wr_.y = pk2(v[2], v[3]); wr_.z = pk2(v[4], v[5]); wr_.w = pk2(v[6], v[7]); *(u32x4*)(XBC + (size_t)t * 1536 + ch8) = wr_; }
        if (gidx >= 80) continue;
        if (gidx < 64) { const float sc = wsh[(gidx >> 3) * 64 + t];
            u32x4 wv; wv.x = pk2(v[0] * sc, v[1] * sc); wv.y = pk2(v[2] * sc, v[3] * sc); wv.z = pk2(v[4] * sc, v[5] * sc); wv.w = pk2(v[6] * sc, v[7] * sc);
            *(u32x4*)(XW + t * 528 + gidx * 8) = wv; }
        else { u32x4 wv; wv.x = pk2(v[0], v[1]); wv.y = pk2(v[2], v[3]); wv.z = pk2(v[4], v[5]); wv.w = pk2(v[6], v[7]);
            *(u32x4*)(Bmn + t * 144 + (gidx - 64) * 8) = wv; }
    }
    __syncthreads();
    f32x4 acc[4][8];
#pragma unroll
    for (int m = 0; m < 4; ++m)
#pragma unroll
        for (int n = 0; n < 8; ++n) acc[m][n] = (f32x4){0.f, 0.f, 0.f, 0.f};
#pragma unroll
    for (int ks = 0; ks < 2; ++ks) {
        bf16x8 xf[4];
#pragma unroll
        for (int m = 0; m < 4; ++m) xf[m] = tr_frag(XW, 528, 32 * ks, 64 * w + 16 * m, lane);
#pragma unroll
        for (int n = 0; n < 8; ++n) { const bf16x8 bf_ = tr_frag(Bmn, 144, 32 * ks, 16 * n, lane);
#pragma unroll
            for (int m = 0; m < 4; ++m) acc[m][n] = mfma16(bf_, xf[m], acc[m][n]); }
    }
    bf16_t* Sp = (bf16_t*)(p.ws + WS_SBUF) + (size_t)((b * 16 + g * 8 + w) * 32 + c) * 8192;
#pragma unroll
    for (int m = 0; m < 4; ++m)
#pragma unroll
        for (int n = 0; n < 8; ++n) { u32x2 wv; wv.x = pk2(acc[m][n][0], acc[m][n][1]); wv.y = pk2(acc[m][n][2], acc[m][n][3]); *(u32x2*)(Sp + (16 * m + fr) * 128 + 16 * n + fq * 4) = wv; }
    __syncthreads();
}

DEV void ssd_out(const P& p, int l, int unit, unsigned char* lds) {
    const int b = unit >> 6, g = (unit >> 5) & 1, c = unit & 31;
    int tid_ = threadIdx.x; asm volatile("" : "+v"(tid_)); const int tid = tid_, lane = tid & 63, w = tid >> 6, fr = lane & 15, fq = lane >> 4;
    const int r0 = b * 2048 + c * 64;
    const bf16_t* U = (const bf16_t*)(p.ws + WS_U) + (size_t)r0 * INP;
    bf16_t* Xs = (bf16_t*)lds;
    bf16_t* Bm = Xs + 64 * 528;
    bf16_t* Cm = Bm + 64 * 136;
    float* CB = (float*)(lds + 102400);
    float* bsh = (float*)(lds + 119808);
    float* dtsh = bsh + 512;
    float* red = dtsh + 512;
    float* stat = red + 512;
    const int head = g * 8 + w;
    {
        const float dt = softplusf_(bf2f(U[(size_t)lane * INP + UDT + head]) + p.dt_bias[l * 16 + head]);
        const float a = -__expf(p.A_log[l * 16 + head]) * dt;
        const float bs = wave_incl_sum(a, lane);
        bsh[w * 64 + lane] = bs; dtsh[w * 64 + lane] = dt;
    }
    const bf16_t* XBC = (const bf16_t*)(p.ws + WS_XBC) + (size_t)r0 * 1536;
#pragma unroll
    for (int i = 0; i < 12; ++i) {
        const int it = tid + 512 * i, t = it / 96, gidx = it % 96;
        const int ch8 = gidx < 64 ? g * 512 + gidx * 8 : (gidx < 80 ? 1024 + g * 128 + (gidx - 64) * 8 : 1280 + g * 128 + (gidx - 80) * 8);
        const u32x4 wv = *(const u32x4*)(XBC + (size_t)t * 1536 + ch8);
        if (gidx < 64) *(u32x4*)(Xs + t * 528 + gidx * 8) = wv;
        else if (gidx < 80) *(u32x4*)(Bm + t * 136 + (gidx - 64) * 8) = wv;
        else *(u32x4*)(Cm + t * 136 + (gidx - 80) * 8) = wv;
    }
    __syncthreads();
    {
        const int mt_ = w >> 1, nt0 = (w & 1) * 2;
        f32x4 cacc[2] = {(f32x4){0.f, 0.f, 0.f, 0.f}, (f32x4){0.f, 0.f, 0.f, 0.f}};
#pragma unroll
        for (int k0 = 0; k0 < 128; k0 += 32) {
            const bf16x8 a = *(const bf16x8*)(Cm + (16 * mt_ + fr) * 136 + k0 + fq * 8);
#pragma unroll
            for (int n = 0; n < 2; ++n) { const bf16x8 bb = *(const bf16x8*)(Bm + (16 * (nt0 + n) + fr) * 136 + k0 + fq * 8); cacc[n] = mfma16(a, bb, cacc[n]); }
        }
#pragma unroll
        for (int n = 0; n < 2; ++n)
#pragma unroll
            for (int j = 0; j < 4; ++j) CB[(16 * mt_ + fq * 4 + j) * 68 + 16 * (nt0 + n) + fr] = cacc[n][j];
    }
    __syncthreads();
    f32x4 acc1[4][4], acc2[4][4];
#pragma unroll
    for (int m = 0; m < 4; ++m)
#pragma unroll
        for (int n = 0; n < 4; ++n) { acc1[m][n] = (f32x4){0.f, 0.f, 0.f, 0.f}; acc2[m][n] = (f32x4){0.f, 0.f, 0.f, 0.f}; }
#pragma unroll
    for (int ks = 0; ks < 2; ++ks) {
        bf16x8 xf[4];
#pragma unroll
        for (int n = 0; n < 4; ++n) xf[n] = tr_frag(Xs, 528, 32 * ks, 64 * w + 16 * n, lane);
#pragma unroll
        for (int m = 0; m < 4; ++m) {
            if (ks * 32 > 16 * m + 15) continue;
            const int t = 16 * m + fr, s0 = 32 * ks + fq * 8;
            const float bt = bsh[w * 64 + t];
            const f32x4 c0 = *(const f32x4*)(CB + t * 68 + s0), c1 = *(const f32x4*)(CB + t * 68 + s0 + 4);
            float mv[8];
#pragma unroll
            for (int i = 0; i < 8; ++i) { const int s_ = s0 + i; const float cv = i < 4 ? c0[i & 3] : c1[i & 3];
                mv[i] = (s_ <= t) ? cv * __expf(bt - bsh[w * 64 + s_]) * dtsh[w * 64 + s_] : 0.f; }
            union { u32x4 u; bf16x8 v; } af;
            af.u.x = pk2(mv[0], mv[1]); af.u.y = pk2(mv[2], mv[3]); af.u.z = pk2(mv[4], mv[5]); af.u.w = pk2(mv[6], mv[7]);
#pragma unroll
            for (int n = 0; n < 4; ++n) acc1[m][n] = mfma16(xf[n], af.v, acc1[m][n]);
        }
    }
    if (c > 0) {
        const bf16_t* STp = (const bf16_t*)(p.ws + WS_ST) + (size_t)((b * 16 + head) * 32 + c - 1) * 8192;
#pragma unroll
        for (int k0 = 0; k0 < 128; k0 += 32) {
            bf16x8 a[4];
#pragma unroll
            for (int m = 0; m < 4; ++m) a[m] = *(const bf16x8*)(Cm + (16 * m + fr) * 136 + k0 + fq * 8);
#pragma unroll
            for (int n = 0; n < 4; ++n) { const bf16x8 sf = *(const bf16x8*)(STp + (16 * n + fr) * 128 + k0 + fq * 8);
#pragma unroll
                for (int m = 0; m < 4; ++m) acc2[m][n] = mfma16(sf, a[m], acc2[m][n]); }
        }
    }
    const float dsk = p.D_skip[l * 16 + head];
#pragma unroll
    for (int m = 0; m < 4; ++m) {
        const int t = 16 * m + fr;
        const float eb = __expf(bsh[w * 64 + t]);
        float sm = 0.f;
#pragma unroll
        for (int n = 0; n < 4; ++n) {
            const int pp4 = 16 * n + fq * 4;
            const uint2 xv = *(const uint2*)(Xs + t * 528 + 64 * w + pp4);
            const uint2 zv = *(const uint2*)(U + (size_t)t * INP + UZ + g * 512 + w * 64 + pp4);
            const float xs4[4] = {bflo(xv.x), bfhi(xv.x), bflo(xv.y), bfhi(xv.y)};
            const float z4[4] = {bflo(zv.x), bfhi(zv.x), bflo(zv.y), bfhi(zv.y)};
#pragma unroll
            for (int j = 0; j < 4; ++j) {
                const float y = acc1[m][n][j] + eb * acc2[m][n][j] + dsk * xs4[j];
                const float gt = y * z4[j] * sigmoidf_(z4[j]);
                acc1[m][n][j] = gt; sm += gt * gt;
            }
        }
        sm += __shfl_xor(sm, 16); sm += __shfl_xor(sm, 32);
        if (fq == 0) red[t * 8 + w] = sm;
    }
    __syncthreads();
    if (tid < 64) { float sm = 0.f;
#pragma unroll
        for (int i = 0; i < 8; ++i) sm += red[tid * 8 + i];
        stat[tid] = rsqrtf(sm * (1.0f / 512.0f) + 1e-6f); }
    __syncthreads();
    bf16_t* MX = (bf16_t*)(p.ws + WS_MIXIN);
#pragma unroll
    for (int m = 0; m < 4; ++m) {
        const int t = 16 * m + fr;
        const float rs = stat[t];
#pragma unroll
        for (int n = 0; n < 4; ++n) {
            const int ch = g * 512 + w * 64 + 16 * n + fq * 4;
            const f32x4 nw = *(const f32x4*)(p.s_norm_w + l * 1024 + ch);
            u32x2 wv; wv.x = pk2(acc1[m][n][0] * rs * nw[0], acc1[m][n][1] * rs * nw[1]); wv.y = pk2(acc1[m][n][2] * rs * nw[2], acc1[m][n][3] * rs * nw[3]);
            *(u32x2*)(MX + (size_t)(r0 + t) * D + 1024 + ch) = wv;
        }
    }
    __syncthreads();
}

DEV void smp_mlstm(const P& p, int l, int unit, unsigned char* lds) {
    const int b = unit >> 2, h = unit & 3;
    int tid_ = threadIdx.x; asm volatile("" : "+v"(tid_)); const int tid = tid_, lane = tid & 63, w = tid >> 6;
    const int r0 = NPR + b * 8;
    const bf16_t* U = (const bf16_t*)(p.ws + WS_U) + (size_t)r0 * INP;
    float* qn = (float*)lds; float* kn = qn + 2048; float* vn = kn + 2048; float* qT = vn + 2048; float* kwT = qT + 2048; float* sc = kwT + 2048; float* red = sc + 256;
    const size_t sidx = (size_t)(l * 128 + b) * 4 + h;
    const float* C0 = p.st_C + sidx * 65536; const float* n0 = p.st_n + sidx * 256;
    float* Cout = p.out + O_SC + sidx * 65536;
    if (tid == 0) {
        const float m0 = p.st_m[sidx];
        float bs = 0.f, cm = -INFINITY, mt = 0.f;
        float igv[8], fgv[8];
        const float bi_ = p.b_i[l * 4 + h], bf_ = p.b_f[l * 4 + h];
#pragma unroll
        for (int t = 0; t < 8; ++t) { igv[t] = bf2f(U[(size_t)t * INP + UIG + h]); fgv[t] = bf2f(U[(size_t)t * INP + UFG + h]); }
#pragma unroll
        for (int t = 0; t < 8; ++t) {
            const float ig = igv[t] + bi_;
            const float lf = logsigf_(fgv[t] + bf_);
            bs += lf; const float a = ig - bs; cm = fmaxf(cm, a); mt = bs + fmaxf(m0, cm);
            sc[32 + t] = mt; sc[t] = __expf(bs + m0 - mt); sc[40 + t] = a; sc[48 + t] = bs;
        }
        for (int s = 0; s < 8; ++s) sc[16 + s] = __expf(bs + sc[40 + s] - mt);
        sc[24] = __expf(bs + m0 - mt);
        p.out[O_SM + sidx] = mt;
    }
    __syncthreads();
#pragma unroll
    for (int i = 0; i < 4; ++i) {
        const int idx = tid + 512 * i, t = idx >> 8, d = idx & 255;
        const float q = bf2f(U[(size_t)t * INP + UQ + h * 256 + d]), k = bf2f(U[(size_t)t * INP + UK + h * 256 + d]), v = bf2f(U[(size_t)t * INP + UV + h * 256 + d]);
        qn[t * 256 + d] = q; kn[t * 256 + d] = k; vn[t * 256 + d] = v; qT[d * 8 + t] = q; kwT[d * 8 + t] = k * sc[16 + t];
    }
    __syncthreads();
    {
        const int t = w;
        const f32x4 qv = *(const f32x4*)(qn + t * 256 + lane * 4);
        float dot[9];
#pragma unroll
        for (int s = 0; s < 8; ++s) { const f32x4 kv = *(const f32x4*)(kn + s * 256 + lane * 4); dot[s] = qv[0] * kv[0] + qv[1] * kv[1] + qv[2] * kv[2] + qv[3] * kv[3]; }
        { const f32x4 nv = *(const f32x4*)(n0 + lane * 4); dot[8] = qv[0] * nv[0] + qv[1] * nv[1] + qv[2] * nv[2] + qv[3] * nv[3]; }
#pragma unroll
        for (int s = 0; s < 9; ++s) dot[s] = wave_sum(dot[s]);
        float den = 0.f;
#pragma unroll
        for (int s = 0; s < 8; ++s) { const float sv = (s <= t) ? dot[s] * __expf(sc[48 + t] - sc[32 + t] + sc[40 + s]) : 0.f; den += sv; if (lane == 0) sc[64 + t * 8 + s] = sv; }
        den += sc[t] * dot[8];
        if (lane == 0) sc[8 + t] = 1.0f / fmaxf(fabsf(den), __expf(-sc[32 + t]));
    }
    if (tid < 256) {
        float a = sc[24] * n0[tid];
#pragma unroll
        for (int s = 0; s < 8; ++s) a += kwT[tid * 8 + s];
        p.out[O_SN + sidx * 256 + tid] = a;
    }
    const int e4 = lane * 4;
    f32x4 num[8], vv[8];
#pragma unroll
    for (int t = 0; t < 8; ++t) { num[t] = (f32x4){0.f, 0.f, 0.f, 0.f}; vv[t] = *(const f32x4*)(vn + t * 256 + e4); }
    const float decay = sc[24];
    {
        f32x4 cn_[8];
#pragma unroll
        for (int j = 0; j < 8; ++j) cn_[j] = __builtin_nontemporal_load((const f32x4*)(C0 + (size_t)(w + 8 * j) * 256 + e4));
#pragma unroll 1
        for (int ib = 0; ib < 4; ++ib) {
            f32x4 cc[8];
#pragma unroll
            for (int j = 0; j < 8; ++j) cc[j] = cn_[j];
            if (ib < 3) {
#pragma unroll
                for (int j = 0; j < 8; ++j) cn_[j] = __builtin_nontemporal_load((const f32x4*)(C0 + (size_t)(w + 8 * ((ib + 1) * 8 + j)) * 256 + e4));
            }
#pragma unroll
            for (int j = 0; j < 8; ++j) {
                const int d = w + 8 * (ib * 8 + j);
                const f32x4 q0 = *(const f32x4*)(qT + d * 8), q1 = *(const f32x4*)(qT + d * 8 + 4), k0 = *(const f32x4*)(kwT + d * 8), k1 = *(const f32x4*)(kwT + d * 8 + 4);
                f32x4 cn = cc[j] * decay;
#pragma unroll
                for (int t = 0; t < 4; ++t) { num[t] += cc[j] * q0[t]; num[4 + t] += cc[j] * q1[t]; cn += vv[t] * k0[t]; cn += vv[4 + t] * k1[t]; }
                __builtin_nontemporal_store(cn, (f32x4*)(Cout + (size_t)d * 256 + e4));
            }
        }
    }
#pragma unroll
    for (int t = 0; t < 8; ++t) *(f32x4*)(red + (w * 8 + t) * 256 + e4) = num[t];
    __syncthreads();
    {
        const int t = w;
        f32x4 hv = (f32x4){0.f, 0.f, 0.f, 0.f};
#pragma unroll
        for (int ww = 0; ww < 8; ++ww) hv += *(const f32x4*)(red + (ww * 8 + t) * 256 + e4);
        hv = hv * sc[t];
#pragma unroll
        for (int s = 0; s < 8; ++s) hv += vv[s] * sc[64 + t * 8 + s];
        hv = hv * sc[8 + t];
        const float mu = wave_sum(hv[0] + hv[1] + hv[2] + hv[3]) * (1.0f / 256.0f);
        const f32x4 dv = hv - mu;
        const float var = wave_sum(dv[0] * dv[0] + dv[1] * dv[1] + dv[2] * dv[2] + dv[3] * dv[3]) * (1.0f / 256.0f);
        const float rs = rsqrtf(var + 1e-6f);
        const uint2 ov = *(const uint2*)(U + (size_t)t * INP + UO + h * 256 + e4);
        const f32x4 nw = *(const f32x4*)(p.m_norm_w + l * 1024 + h * 256 + e4);
        const float o0 = dv[0] * rs * nw[0] * sigmoidf_(bflo(ov.x)), o1 = dv[1] * rs * nw[1] * sigmoidf_(bfhi(ov.x));
        const float o2 = dv[2] * rs * nw[2] * sigmoidf_(bflo(ov.y)), o3 = dv[3] * rs * nw[3] * sigmoidf_(bfhi(ov.y));
        u32x2 wv; wv.x = pk2(o0, o1); wv.y = pk2(o2, o3);
        *(u32x2*)((bf16_t*)(p.ws + WS_MIXIN) + (size_t)(r0 + t) * D + h * 256 + e4) = wv;
    }
    __syncthreads();
}

DEV void smp_ssd(const P& p, int l, int unit, unsigned char* lds) {
    const int b = unit >> 1, g = unit & 1;
    int tid_ = threadIdx.x; asm volatile("" : "+v"(tid_)); const int tid = tid_, lane = tid & 63, w = tid >> 6, fr = lane & 15, fq = lane >> 4;
    const int r0 = NPR + b * 8;
    const bf16_t* U = (const bf16_t*)(p.ws + WS_U) + (size_t)r0 * INP;
    float* xs = (float*)lds;
    float* xwT = xs + 4096;
    float* Bmf = xwT + 4096;
    float* CBs = Bmf + 1024;
    float* bsh = CBs + 64;
    float* dtsh = bsh + 64;
    float* bLs = dtsh + 64;
    float* MW = bLs + 64;
    float* red = MW + 512;
    float* stat = red + 64;
    bf16_t* Cmb = (bf16_t*)(stat + 64);
    if (tid < 64) {
        const int hd = tid >> 3, t = tid & 7, head = g * 8 + hd;
        const float A = -__expf(p.A_log[l * 16 + head]), dtb = p.dt_bias[l * 16 + head];
        float bs = 0.f, bL = 0.f, dtt = 0.f;
        for (int s = 0; s < 8; ++s) { const float dt = softplusf_(bf2f(U[(size_t)s * INP + UDT + head]) + dtb); bL += dt * A; if (s <= t) bs += dt * A; if (s == t) dtt = dt; }
        bsh[hd * 8 + t] = bs; dtsh[hd * 8 + t] = dtt; if (t == 0) bLs[hd] = bL;
    }
    for (int i = tid; i < 8 * 136 / 2; i += NTHR) ((unsigned*)(Cmb + 8 * 136))[i] = 0u;
    const float* cw = p.s_conv_w + (size_t)l * 4 * 1536; const float* cb = p.s_conv_b + (size_t)l * 1536;
    const float* cv0 = p.st_sconv + (size_t)(l * 128 + b) * 3 * 1536;
    for (int i = 0; i < 2; ++i) {
        const int it = tid + 512 * i;
        if (it < 768) {
            const int t = it / 96, gidx = it % 96;
            const int ch8 = gidx < 64 ? g * 512 + gidx * 8 : (gidx < 80 ? 1024 + g * 128 + (gidx - 64) * 8 : 1280 + g * 128 + (gidx - 80) * 8);
            float o[8];
            { const f32x4 b0 = *(const f32x4*)(cb + ch8), b1 = *(const f32x4*)(cb + ch8 + 4); o[0] = b0[0]; o[1] = b0[1]; o[2] = b0[2]; o[3] = b0[3]; o[4] = b1[0]; o[5] = b1[1]; o[6] = b1[2]; o[7] = b1[3]; }
#pragma unroll
            for (int j = 0; j < 4; ++j) {
                const int idx = t + j;
                float xf[8];
                if (idx < 3) { const f32x4 a0 = *(const f32x4*)(cv0 + idx * 1536 + ch8), a1 = *(const f32x4*)(cv0 + idx * 1536 + ch8 + 4);
                    xf[0] = a0[0]; xf[1] = a0[1]; xf[2] = a0[2]; xf[3] = a0[3]; xf[4] = a1[0]; xf[5] = a1[1]; xf[6] = a1[2]; xf[7] = a1[3]; }
                else { const uint4 x = *(const uint4*)(U + (size_t)(idx - 3) * INP + UXS + ch8); unpack8(x, xf); }
                const f32x4 w0 = *(const f32x4*)(cw + j * 1536 + ch8), w1 = *(const f32x4*)(cw + j * 1536 + ch8 + 4);
                o[0] += w0[0] * xf[0]; o[1] += w0[1] * xf[1]; o[2] += w0[2] * xf[2]; o[3] += w0[3] * xf[3];
                o[4] += w1[0] * xf[4]; o[5] += w1[1] * xf[5]; o[6] += w1[2] * xf[6]; o[7] += w1[3] * xf[7];
            }
#pragma unroll
            for (int k = 0; k < 8; ++k) o[k] = siluf_(o[k]);
            if (gidx < 64) {
#pragma unroll
                for (int k = 0; k < 8; ++k) xs[t * 512 + gidx * 8 + k] = o[k]; }
            else if (gidx < 80) {
#pragma unroll
                for (int k = 0; k < 8; ++k) Bmf[t * 128 + (gidx - 64) * 8 + k] = o[k]; }
            else { u32x4 wv; wv.x = pk2(o[0], o[1]); wv.y = pk2(o[2], o[3]); wv.z = pk2(o[4], o[5]); wv.w = pk2(o[6], o[7]); *(u32x4*)(Cmb + t * 136 + (gidx - 80) * 8) = wv; }
        }
    }
    __syncthreads();
#pragma unroll
    for (int i = 0; i < 8; ++i) {
        const int idx = tid + 512 * i, hp = idx >> 3, s = idx & 7, hd = hp >> 6;
        xwT[hp * 8 + s] = xs[s * 512 + hp] * __expf(bLs[hd] - bsh[hd * 8 + s]) * dtsh[hd * 8 + s];
    }
    {
        const int pr = tid >> 3, part = tid & 7, t = pr >> 3, s_ = pr & 7; float a = 0.f;
#pragma unroll
        for (int n = 0; n < 16; ++n) a += bf2f(Cmb[t * 136 + part * 16 + n]) * Bmf[s_ * 128 + part * 16 + n];
        a += __shfl_xor(a, 1); a += __shfl_xor(a, 2); a += __shfl_xor(a, 4);
        if (part == 0) CBs[t * 8 + s_] = a;
    }
    __syncthreads();
    { const int hd = tid >> 6, t = (tid >> 3) & 7, s = tid & 7;
      MW[tid] = (s <= t) ? CBs[t * 8 + s] * __expf(bsh[hd * 8 + t] - bsh[hd * 8 + s]) * dtsh[hd * 8 + s] : 0.f; }
    __syncthreads();
    const int head = g * 8 + w;
    const size_t sidx = (size_t)(l * 128 + b) * 16 + head;
    const float* S0 = p.st_ssm + sidx * 8192; float* So = p.out + O_SS + sidx * 8192;
    const float dA = __expf(bLs[w]);
    f32x4 acc[4];
    f32x4 svn[4][2];
#pragma unroll
    for (int ks = 0; ks < 4; ++ks) { svn[ks][0] = __builtin_nontemporal_load((const f32x4*)(S0 + fr * 128 + 32 * ks + fq * 8)); svn[ks][1] = __builtin_nontemporal_load((const f32x4*)(S0 + fr * 128 + 32 * ks + fq * 8 + 4)); }
#pragma unroll
    for (int nt = 0; nt < 4; ++nt) {
        acc[nt] = (f32x4){0.f, 0.f, 0.f, 0.f};
        const int pp = 16 * nt + fr;
        const f32x4 xw0 = *(const f32x4*)(xwT + (64 * w + pp) * 8), xw1 = *(const f32x4*)(xwT + (64 * w + pp) * 8 + 4);
        f32x4 sv[4][2];
#pragma unroll
        for (int ks = 0; ks < 4; ++ks) { sv[ks][0] = svn[ks][0]; sv[ks][1] = svn[ks][1]; }
        if (nt < 3) {
#pragma unroll
            for (int ks = 0; ks < 4; ++ks) { svn[ks][0] = __builtin_nontemporal_load((const f32x4*)(S0 + (pp + 16) * 128 + 32 * ks + fq * 8)); svn[ks][1] = __builtin_nontemporal_load((const f32x4*)(S0 + (pp + 16) * 128 + 32 * ks + fq * 8 + 4)); }
        }
#pragma unroll
        for (int ks = 0; ks < 4; ++ks) {
            const int n0 = 32 * ks + fq * 8;
            const f32x4 s0 = sv[ks][0], s1 = sv[ks][1];
            union { u32x4 u; bf16x8 v; } bfr;
            bfr.u.x = pk2(s0[0], s0[1]); bfr.u.y = pk2(s0[2], s0[3]); bfr.u.z = pk2(s1[0], s1[1]); bfr.u.w = pk2(s1[2], s1[3]);
            const bf16x8 af = *(const bf16x8*)(Cmb + fr * 136 + n0);
            acc[nt] = mfma16(af, bfr.v, acc[nt]);
            f32x4 o0 = s0 * dA, o1 = s1 * dA;
#pragma unroll
            for (int s = 0; s < 8; ++s) {
                const float xv = s < 4 ? xw0[s & 3] : xw1[s & 3];
                const f32x4 bm0 = *(const f32x4*)(Bmf + s * 128 + n0), bm1 = *(const f32x4*)(Bmf + s * 128 + n0 + 4);
                o0 += bm0 * xv; o1 += bm1 * xv;
            }
            __builtin_nontemporal_store(o0, (f32x4*)(So + pp * 128 + n0)); __builtin_nontemporal_store(o1, (f32x4*)(So + pp * 128 + n0 + 4));
        }
        asm volatile("" ::: "memory");
    }
    const float dsk = p.D_skip[l * 16 + head];
    float gts[4][4];
#pragma unroll
    for (int j = 0; j < 4; ++j) {
        const int t = (fq & 1) * 4 + j;
        const float eb = __expf(bsh[w * 8 + t]);
        float ssq = 0.f;
#pragma unroll
        for (int nt = 0; nt < 4; ++nt) {
            const int hp = 64 * w + 16 * nt + fr;
            float y = eb * acc[nt][j] + dsk * xs[t * 512 + hp];
#pragma unroll
            for (int s = 0; s < 8; ++s) y += MW[(w * 8 + t) * 8 + s] * xs[s * 512 + hp];
            const float z = bf2f(U[(size_t)t * INP + UZ + g * 512 + hp]);
            const float gt = y * siluf_(z);
            gts[nt][j] = gt; ssq += gt * gt;
        }
        ssq += __shfl_xor(ssq, 1); ssq += __shfl_xor(ssq, 2); ssq += __shfl_xor(ssq, 4); ssq += __shfl_xor(ssq, 8);
        if (fr == 0 && fq < 2) red[t * 8 + w] = ssq;
    }
    __syncthreads();
    if (tid < 8) { float s = 0.f;
#pragma unroll
        for (int i = 0; i < 8; ++i) s += red[tid * 8 + i];
        stat[tid] = rsqrtf(s * (1.0f / 512.0f) + 1e-6f); }
    __syncthreads();
    if (fq < 2) {
        bf16_t* MX = (bf16_t*)(p.ws + WS_MIXIN);
#pragma unroll
        for (int j = 0; j < 4; ++j) {
            const int t = fq * 4 + j;
#pragma unroll
            for (int nt = 0; nt < 4; ++nt) {
                const int ch = g * 512 + 64 * w + 16 * nt + fr;
                MX[(size_t)(r0 + t) * D + 1024 + ch] = f2bf(gts[nt][j] * stat[t] * p.s_norm_w[l * 1024 + ch]);
            }
        }
    }
    __syncthreads();
}

DEV void phase_ln(const P& p, int l, int which) {
    int tid_ = threadIdx.x; asm volatile("" : "+v"(tid_));
    const int lane = tid_ & 63, w = tid_ >> 6;
    const float* gam = (which ? p.ln2_g : p.ln1_g) + l * D; const float* bet = (which ? p.ln2_b : p.ln1_b) + l * D;
    const bf16_t* mix = (const bf16_t*)(p.ws + WS_MIXF);
    bf16_t* xb = (bf16_t*)(p.ws + WS_XB);
    const bool lastp = (l == 1 && which == 1), split = (gridDim.x == 256);
    for (int r = blockIdx.x * 8 + w; r < NTOK; r += gridDim.x * 8) {
        f32x4 y[8]; float s = 0.f;
#pragma unroll
        for (int i = 0; i < 8; ++i) { const int cidx = i * 256 + lane * 4;
            f32x4 xv, mv;
            { const uint2 t = *(const uint2*)(xb + (size_t)r * D + cidx); xv = (f32x4){bflo(t.x), bfhi(t.x), bflo(t.y), bfhi(t.y)}; }
            if (split && r >= NPR) { const bf16_t* pp = (const bf16_t*)(p.ws + WS_PART) + (size_t)(r - NPR) * D + cidx; mv = (f32x4){0.f, 0.f, 0.f, 0.f};
#pragma unroll
                for (int k = 0; k < 8; ++k) { const uint2 t = *(const uint2*)(pp + (size_t)k * NSM * D); mv += (f32x4){bflo(t.x), bfhi(t.x), bflo(t.y), bfhi(t.y)}; } }
            else { const uint2 t = *(const uint2*)(mix + (size_t)r * D + cidx); mv = (f32x4){bflo(t.x), bfhi(t.x), bflo(t.y), bfhi(t.y)}; }
            y[i] = xv * ALPHA + mv; s += (y[i][0] + y[i][1]) + (y[i][2] + y[i][3]); }
        const float mu = wave_sum(s) * (1.0f / D);
        float q = 0.f;
#pragma unroll
        for (int i = 0; i < 8; ++i) { y[i] = y[i] - mu; q += (y[i][0] * y[i][0] + y[i][1] * y[i][1]) + (y[i][2] * y[i][2] + y[i][3] * y[i][3]); }
        const float rs = rsqrtf(wave_sum(q) * (1.0f / D) + 1e-5f);
#pragma unroll
        for (int i = 0; i < 8; ++i) { const int cidx = i * 256 + lane * 4;
            const f32x4 o = y[i] * rs * *(const f32x4*)(gam + cidx) + *(const f32x4*)(bet + cidx);
            if (lastp) *(f32x4*)(p.out + (size_t)r * D + cidx) = o;
            else { u32x2 wv; wv.x = pk2(o[0], o[1]); wv.y = pk2(o[2], o[3]); *(u32x2*)(xb + (size_t)r * D + cidx) = wv; } }
    }
}

DEV void phase_ffn_gate(const P& p, int l, int part, int b0, int nb) {
    const bf16_t* up = (const bf16_t*)(p.ws + WS_UP); bf16_t* act = (bf16_t*)(p.ws + WS_ACT);
    const float* fw = p.f_conv_w + (size_t)l * 3 * DFF2; const float* fb = p.f_conv_b + (size_t)l * DFF2;
    const int lo = part == 2 ? (NPR / 8) * (DFF / 8) : 0, total = part == 1 ? (NPR / 8) * (DFF / 8) : (NTOK / 8) * (DFF / 8);
    int tid_ = threadIdx.x; asm volatile("" : "+v"(tid_));
    for (int it = lo + b0 * NTHR + tid_; it < total; it += nb * NTHR) {
        const int rb = it / (DFF / 8), j8 = (it % (DFF / 8)) * 8, r0 = rb * 8;
        const bool smp = r0 >= NPR; const int t0 = smp ? 0 : (r0 & 2047); const int sb = (r0 - NPR) >> 3;
        float wg[3][8], wv[3][8], bg[8], bv[8];
#pragma unroll
        for (int k = 0; k < 3; ++k) {
            const f32x4 a0 = *(const f32x4*)(fw + k * DFF2 + j8), a1 = *(const f32x4*)(fw + k * DFF2 + j8 + 4), c0 = *(const f32x4*)(fw + k * DFF2 + DFF + j8), c1 = *(const f32x4*)(fw + k * DFF2 + DFF + j8 + 4);
#pragma unroll
            for (int i = 0; i < 4; ++i) { wg[k][i] = a0[i]; wg[k][4 + i] = a1[i]; wv[k][i] = c0[i]; wv[k][4 + i] = c1[i]; }
        }
        { const f32x4 a0 = *(const f32x4*)(fb + j8), a1 = *(const f32x4*)(fb + j8 + 4), c0 = *(const f32x4*)(fb + DFF + j8), c1 = *(const f32x4*)(fb + DFF + j8 + 4);
#pragma unroll
          for (int i = 0; i < 4; ++i) { bg[i] = a0[i]; bg[4 + i] = a1[i]; bv[i] = c0[i]; bv[4 + i] = c1[i]; } }
        float g0[8], g1[8], v0[8], v1[8];
        if (t0 > 0) {
            unpack8(*(const uint4*)(up + (size_t)(r0 - 2) * DFF2 + j8), g0); unpack8(*(const uint4*)(up + (size_t)(r0 - 2) * DFF2 + DFF + j8), v0);
            unpack8(*(const uint4*)(up + (size_t)(r0 - 1) * DFF2 + j8), g1); unpack8(*(const uint4*)(up + (size_t)(r0 - 1) * DFF2 + DFF + j8), v1);
        } else if (smp) {
            const float* bp = p.st_fconv + (size_t)(l * 128 + sb) * 2 * DFF2;
            const f32x4 a0 = *(const f32x4*)(bp + j8), a1 = *(const f32x4*)(bp + j8 + 4), c0 = *(const f32x4*)(bp + DFF + j8), c1 = *(const f32x4*)(bp + DFF + j8 + 4);
            const f32x4 d0 = *(const f32x4*)(bp + DFF2 + j8), d1 = *(const f32x4*)(bp + DFF2 + j8 + 4), e0 = *(const f32x4*)(bp + DFF2 + DFF + j8), e1 = *(const f32x4*)(bp + DFF2 + DFF + j8 + 4);
#pragma unroll
            for (int i = 0; i < 4; ++i) { g0[i] = a0[i]; g0[4 + i] = a1[i]; v0[i] = c0[i]; v0[4 + i] = c1[i]; g1[i] = d0[i]; g1[4 + i] = d1[i]; v1[i] = e0[i]; v1[4 + i] = e1[i]; }
        } else {
#pragma unroll
            for (int i = 0; i < 8; ++i) { g0[i] = 0.f; g1[i] = 0.f; v0[i] = 0.f; v1[i] = 0.f; }
        }
#pragma unroll
        for (int rr = 0; rr < 8; ++rr) {
            float g2[8], v2[8];
            unpack8(*(const uint4*)(up + (size_t)(r0 + rr) * DFF2 + j8), g2); unpack8(*(const uint4*)(up + (size_t)(r0 + rr) * DFF2 + DFF + j8), v2);
            float o[8];
#pragma unroll
            for (int i = 0; i < 8; ++i) {
                const float ag = bg[i] + wg[0][i] * g0[i] + wg[1][i] * g1[i] + wg[2][i] * g2[i];
                const float av = bv[i] + wv[0][i] * v0[i] + wv[1][i] * v1[i] + wv[2][i] * v2[i];
                o[i] = ag * __builtin_amdgcn_rcpf(1.0f + __expf(-ag)) * av;
                g0[i] = g1[i]; g1[i] = g2[i]; v0[i] = v1[i]; v1[i] = v2[i];
            }
            u32x4 wv4; wv4.x = pk2(o[0], o[1]); wv4.y = pk2(o[2], o[3]); wv4.z = pk2(o[4], o[5]); wv4.w = pk2(o[6], o[7]);
            *(u32x4*)(act + (size_t)(r0 + rr) * DFF + j8) = wv4;
        }
    }
    const int tot2 = part == 1 ? 0 : 132 * 2 * (DFF2 / 8);
    for (int it = b0 * NTHR + tid_; it < tot2; it += nb * NTHR) {
        const int c8 = (it % (DFF2 / 8)) * 8, rr = it / (DFF2 / 8), j = rr & 1, sq = rr >> 1;
        float* o; size_t row;
        if (sq < 4) { o = p.out + O_PFC + ((size_t)(l * 4 + sq) * 2 + j) * DFF2 + c8; row = (size_t)sq * 2048 + 2046 + j; }
        else { const int b = sq - 4; o = p.out + O_SFC + ((size_t)(l * 128 + b) * 2 + j) * DFF2 + c8; row = (size_t)NPR + b * 8 + 6 + j; }
        float xf[8]; unpack8(*(const uint4*)(up + row * DFF2 + c8), xf);
        *(f32x4*)o = (f32x4){xf[0], xf[1], xf[2], xf[3]}; *(f32x4*)(o + 4) = (f32x4){xf[4], xf[5], xf[6], xf[7]};
    }
}


#define XB_TMO      128
#define XB_XCNT(j)  (256  + 64 * (j))
#define XB_XSUB(j)  (1280 + 64 * (j))
#define XB_XGEN(j)  (2304 + 64 * (j))
#define XB_TOP      3328
#define XB_TOPGEN   3392
#define XCD_BAR_WORDS 3456
#define XB_SPIN_CAP (1u << 20)
DEV unsigned xb_ld(unsigned* p)              { return __hip_atomic_load(p, __ATOMIC_RELAXED, __HIP_MEMORY_SCOPE_AGENT); }
DEV unsigned xb_add(unsigned* p, unsigned v) { return __hip_atomic_fetch_add(p, v, __ATOMIC_RELAXED, __HIP_MEMORY_SCOPE_AGENT); }
DEV unsigned xb_xcc_id() { return (unsigned)__builtin_amdgcn_s_getreg((3 << 11) | 20) & 0xFu; }
#define XB_SPIN(cond, bar) do { unsigned _sp = 0; while (cond) { __builtin_amdgcn_s_sleep(1); \
    if ((++_sp & 255u) == 0u) { if (xb_ld(&(bar)[XB_TMO])) break; if (_sp > XB_SPIN_CAP) { atomicAdd(&(bar)[XB_TMO], 1u); break; } } } } while (0)
struct XcdBarrier { unsigned* bar; unsigned x; volatile LAS unsigned* st; };
DEV XcdBarrier xcd_barrier_post(unsigned* bar, volatile LAS unsigned* st) {
    XcdBarrier b; b.bar = bar; b.x = xb_xcc_id(); b.st = st;
    if (threadIdx.x == 0) (void)xb_add(&bar[XB_XCNT(b.x)], 1u);
    return b;
}
DEV void xcd_barrier_complete(unsigned* bar, unsigned x, unsigned& nloc, unsigned& nx) {
    const unsigned G = gridDim.x * gridDim.y * gridDim.z;
    unsigned sum, cnt, mine, sp = 0u;
    for (;;) {
        sum = 0u; cnt = 0u; mine = 0u;
#pragma unroll
        for (unsigned j = 0; j < 16; ++j) { const unsigned c = xb_ld(&bar[XB_XCNT(j)]); sum += c; cnt += (c > 0u) ? 1u : 0u; mine = (j == x) ? c : mine; }
        if (sum == G) break;
        __builtin_amdgcn_s_sleep(1);
        if ((++sp & 255u) == 0u) { if (xb_ld(&bar[XB_TMO])) break; if (sp > XB_SPIN_CAP) { atomicAdd(&bar[XB_TMO], 1u); break; } }
    }
    nloc = mine > 0u ? mine : 1u; nx = cnt > 0u ? cnt : 1u;
}
DEV void xcd_barrier(const XcdBarrier& b) {
    asm volatile("s_waitcnt vmcnt(0)" ::: "memory");
    __syncthreads();
    if (threadIdx.x == 0) {
        unsigned* bar = b.bar;
        __builtin_amdgcn_s_waitcnt(0);
        unsigned nloc = b.st[0], nx = b.st[1];
        if (nloc == 0u) { xcd_barrier_complete(bar, b.x, nloc, nx); b.st[0] = nloc; b.st[1] = nx; }
        const unsigned old = xb_add(&bar[XB_XSUB(b.x)], 1u);
        const unsigned gen = old / nloc;
        if (old + 1u == (gen + 1u) * nloc) {
            __builtin_amdgcn_fence(__ATOMIC_RELEASE, "agent");
            asm volatile("s_waitcnt vmcnt(0)" ::: "memory");
            const unsigned og = xb_add(&bar[XB_TOP], 1u);
            const unsigned tg = og / nx;
            if (og + 1u == (tg + 1u) * nx) xb_add(&bar[XB_TOPGEN], 1u);
            else XB_SPIN(xb_ld(&bar[XB_TOPGEN]) == tg, bar);
            __builtin_amdgcn_fence(__ATOMIC_ACQUIRE, "agent");
            xb_add(&bar[XB_XGEN(b.x)], 1u);
            asm volatile("s_waitcnt vmcnt(0)" ::: "memory");
        } else {
            XB_SPIN(xb_ld(&bar[XB_XGEN(b.x)]) == gen, bar);
            __builtin_amdgcn_fence(__ATOMIC_ACQUIRE, "agent");
            asm volatile("s_waitcnt vmcnt(0)" ::: "memory");
        }
    }
    __syncthreads();
}

constexpr int NPHASE = 21;
DEV void run_phase(const P& p, int l, int q, unsigned char* lds) {
    int bid = blockIdx.x, G = gridDim.x; asm volatile("" : "+s"(bid), "+s"(G));
    if (q == 0) {
        pg8::Gemm g{(const bf16_t*)(p.ws + WS_XB), (const bf16_t*)(p.ws + WS_WIN) + (size_t)l * INP * D, NTOK, INP, D};
        pg8::StaticOrder S; S.init(NTOK, INP, D, G, bid);
        pg8::EpiBf16 E{(bf16_t*)(p.ws + WS_U), INP, nullptr};
        pg8::gemm_phase<pg8::EpiBf16, pg8::StaticOrder>((LAS unsigned char*)lds, g, S, E);
    } else if (q == 1) {
        const int par = bid & 1;
#pragma unroll 1
        for (int half = 0; half < 2; ++half) {
            if ((half ^ par) == 0) {
                for (int u = bid; u < 512; u += G) smp_mlstm(p, l, u, lds);
                for (int u = bid; u < 256; u += G) smp_ssd(p, l, u, lds);
            } else {
                for (int u = bid; u < 512; u += G) mlstm_local(p, l, u, lds);
                for (int u = bid; u < 256; u += G) ssd_local(p, l, u, lds);
            }
        }
    } else if (q == 2) {
        for (int u = bid; u < 256; u += G) mlstm_scan(p, l, u, lds);
        for (int u = bid; u < 256; u += G) ssd_scan(p, l, u, lds);
        for (int u = bid; u < 132; u += G) convstate_copy(p, l, u);
    } else if (q == 3) {
        const bool cvt = (l == 0 && G == 256); const int par3 = bid & 1;
        if (cvt && par3) phase_prologue(p, lds, 0, 1, false, bid, 256, T_WIN, T_L);
        for (int u = bid; u < 512; u += G) mlstm_out(p, l, u, lds);
        for (int u = bid; u < 256; u += G) ssd_out(p, l, u, lds);
        if (cvt && !par3) phase_prologue(p, lds, 0, 1, false, bid, 256, T_WIN, T_L);
    } else if (q == 4) {
        pg8::Gemm g{(const bf16_t*)(p.ws + WS_MIXIN), (const bf16_t*)(p.ws + WS_WOUT) + (size_t)l * D * D, NTOK, D, D};
        pg8::EpiBf16 E{(bf16_t*)(p.ws + WS_MIXF), D, (float*)(p.ws + WS_PART)};
        if (G == 256) { pg8::TailSplitOrder S; S.init(D, bid); pg8::gemm_phase<pg8::EpiBf16, pg8::TailSplitOrder>((LAS unsigned char*)lds, g, S, E); }
        else { pg8::StaticOrder S; S.init(NTOK, D, D, G, bid); pg8::gemm_phase<pg8::EpiBf16, pg8::StaticOrder>((LAS unsigned char*)lds, g, S, E); }
    } else if (q == 5) {
        phase_ln(p, l, 0);
    } else if (q == 6) {
        pg8::Gemm g{(const bf16_t*)(p.ws + WS_XB), (const bf16_t*)(p.ws + WS_WUP) + (size_t)l * DFF2 * D, NTOK, DFF2, D};
        pg8::StaticOrder S; S.init(NTOK, DFF2, D, G, bid);
        pg8::EpiBf16 E{(bf16_t*)(p.ws + WS_UP), DFF2, nullptr};
        pg8::gemm_phase<pg8::EpiBf16, pg8::StaticOrder>((LAS unsigned char*)lds, g, S, E);
        if (l == 0 && G == 256 && bid >= 12) phase_prologue(p, lds, 1, 2, false, bid - 12, 244);
    } else if (q == 16 || q == 26) {
        pg8::Gemm g{(const bf16_t*)(p.ws + WS_XB), (const bf16_t*)(p.ws + WS_WUP) + (size_t)l * DFF2 * D, NTOK, DFF2, D};
        pg8::EpiBf16 E{(bf16_t*)(p.ws + WS_UP), DFF2, nullptr};
        if (q == 16 || bid < 12) { pg8::UpOrder S; S.init(bid, q == 16 ? 0 : 6, q == 16 ? 6 : 7); pg8::gemm_phase<pg8::EpiBf16, pg8::UpOrder>((LAS unsigned char*)lds, g, S, E); }
        else phase_ffn_gate(p, l, 1, bid - 12, 244);
    } else if (q == 17) {
        phase_ffn_gate(p, l, 2, bid, G);
    } else if (q == 7) {
        phase_ffn_gate(p, l, 0, bid, G);
    } else if (q == 8) {
        pg8::Gemm g{(const bf16_t*)(p.ws + WS_ACT), (const bf16_t*)(p.ws + WS_WDN) + (size_t)l * D * DFF, NTOK, D, DFF};
        pg8::EpiBf16 E{(bf16_t*)(p.ws + WS_MIXF), D, (float*)(p.ws + WS_PART)};
        if (G == 256) { pg8::TailSplitOrder S; S.init(DFF, bid); pg8::gemm_phase<pg8::EpiBf16, pg8::TailSplitOrder>((LAS unsigned char*)lds, g, S, E); }
        else { pg8::StaticOrder S; S.init(NTOK, D, DFF, G, bid); pg8::gemm_phase<pg8::EpiBf16, pg8::StaticOrder>((LAS unsigned char*)lds, g, S, E); }
    } else {
        phase_ln(p, l, 1);
    }
}
#if MK_MULTI
template <int T> __global__ void __launch_bounds__(NTHR, 2) k_unit(P p) {
    extern __shared__ __attribute__((aligned(16))) unsigned char lds[];
    const int l = p.ph_lo; int bid = blockIdx.x, G = gridDim.x;
    if (T == 11) for (int u = bid; u < 512; u += G) smp_mlstm(p, l, u, lds);
    if (T == 12) for (int u = bid; u < 256; u += G) smp_ssd(p, l, u, lds);
    if (T == 13) for (int u = bid; u < 512; u += G) mlstm_local(p, l, u, lds);
    if (T == 14) for (int u = bid; u < 256; u += G) ssd_local(p, l, u, lds);
    if (T == 31) for (int u = bid; u < 512; u += G) mlstm_out(p, l, u, lds);
    if (T == 32) for (int u = bid; u < 256; u += G) ssd_out(p, l, u, lds);
    if (T == 21) for (int u = bid; u < 256; u += G) mlstm_scan(p, l, u, lds);
    if (T == 22) for (int u = bid; u < 256; u += G) ssd_scan(p, l, u, lds);
}
template <int Q> __global__ void __launch_bounds__(NTHR, 2) k_phase(P p) {
    extern __shared__ __attribute__((aligned(16))) unsigned char lds[];
    if (Q < 0) { if (gridDim.x == 256) phase_prologue(p, lds, 0, 1, true, blockIdx.x, 256, 0, T_WIN); else phase_prologue(p, lds, 0, 2, true, blockIdx.x, gridDim.x); } else run_phase(p, p.ph_lo, Q, lds);
}
#else
__global__ void __launch_bounds__(NTHR, 2) mk_fwd(P p) {
    extern __shared__ __attribute__((aligned(16))) unsigned char lds[];
    cg::grid_group grid = cg::this_grid();
    if (p.ph_hi < 0) grid.sync();
    if (threadIdx.x < 4) ((unsigned*)(lds + LDS_BYTES - 16))[threadIdx.x] = 0u;
    __syncthreads();
    (void)xcd_barrier_post((unsigned*)(p.ws + WS_BAR), (volatile LAS unsigned*)(lds + LDS_BYTES - 16));
#define GSYNC() do { XcdBarrier b_; b_.bar = (unsigned*)(p.ws + WS_BAR); b_.x = xb_xcc_id(); b_.st = (volatile LAS unsigned*)(lds + LDS_BYTES - 16); xcd_barrier(b_); } while (0)
    if (gridDim.x == 256) phase_prologue(p, lds, 0, 1, true, blockIdx.x, 256, 0, T_WIN); else phase_prologue(p, lds, 0, 2, true, blockIdx.x, gridDim.x);
#pragma unroll 1
    for (int l = 0; l < 2; ++l) {
        GSYNC(); run_phase(p, l, 0, lds);
        GSYNC(); run_phase(p, l, 1, lds);
        GSYNC(); run_phase(p, l, 2, lds);
        GSYNC(); run_phase(p, l, 3, lds);
        GSYNC(); run_phase(p, l, 4, lds);
        GSYNC(); run_phase(p, l, 5, lds);
        if (l == 1 && gridDim.x == 256) {
            GSYNC(); run_phase(p, l, 16, lds);
            GSYNC(); run_phase(p, l, 26, lds);
            GSYNC(); run_phase(p, l, 17, lds);
        } else {
            GSYNC(); run_phase(p, l, 6, lds);
            GSYNC(); run_phase(p, l, 7, lds);
        }
        GSYNC(); run_phase(p, l, 8, lds);
        GSYNC(); run_phase(p, l, 9, lds);
    }
    for (int i = 0; i < PROBE_SYNCS; ++i) GSYNC();
}
#endif

extern "C" void kernel_launch(void* const* d_in, const int* in_sizes, int n_in, void* d_out, int out_size, void* d_ws, size_t ws_size, hipStream_t stream) {
    static int grid = 0;
    if (grid == 0) {
        if (n_in != 27 || ws_size < WS_END) { fprintf(stderr, "kernel_launch: unexpected n_in %d or ws_size %zu (need %zu)\n", n_in, ws_size, (size_t)WS_END); grid = -1; return; }
        int dev = 0, cus = 0, per_cu = 0;
        hipGetDevice(&dev);
        hipDeviceGetAttribute(&cus, hipDeviceAttributeMultiprocessorCount, dev);
#if MK_MULTI
        const void* fns[11] = {(const void*)k_phase<-1>, (const void*)k_phase<0>, (const void*)k_phase<1>, (const void*)k_phase<2>, (const void*)k_phase<3>, (const void*)k_phase<4>, (const void*)k_phase<5>,
                               (const void*)k_phase<6>, (const void*)k_phase<7>, (const void*)k_phase<8>, (const void*)k_phase<9>};
        for (int i = 0; i < 11; ++i) if (hipFuncSetAttribute(fns[i], hipFuncAttributeMaxDynamicSharedMemorySize, LDS_BYTES) != hipSuccess) { fprintf(stderr, "kernel_launch: hipFuncSetAttribute failed\n"); grid = -1; return; }
#else
        if (hipFuncSetAttribute((const void*)mk_fwd, hipFuncAttributeMaxDynamicSharedMemorySize, LDS_BYTES) != hipSuccess) { fprintf(stderr, "kernel_launch: hipFuncSetAttribute failed\n"); grid = -1; return; }
        hipOccupancyMaxActiveBlocksPerMultiprocessor(&per_cu, (const void*)mk_fwd, NTHR, LDS_BYTES);
        (void)hipGetLastError();
#endif
        (void)per_cu;
        grid = cus * 1;
    }
    if (grid < 0) return;
    P p{};
    const float** pp = (const float**)&p;
    for (int i = 0; i < 27; ++i) pp[i] = (const float*)d_in[i];
    p.out = (float*)d_out; p.ws = (unsigned char*)d_ws;
#if MK_MULTI
    p.ph_lo = 0; p.ph_hi = 0;
    if (PROBE_REP == -1) hipLaunchKernelGGL(k_phase<-1>, dim3(grid), dim3(NTHR), LDS_BYTES, stream, p);
    hipLaunchKernelGGL(k_phase<-1>, dim3(grid), dim3(NTHR), LDS_BYTES, stream, p);
    for (int l = 0; l < 2; ++l) {
        p.ph_lo = l;
        for (int rep = 0; rep < 1 + ((PROBE_REP == 0) || (PROBE_REP == 100 && (0 == 0 || 0 == 4 || 0 == 6 || 0 == 8))); ++rep) hipLaunchKernelGGL(k_phase<0>, dim3(grid), dim3(NTHR), LDS_BYTES, stream, p);
        for (int rep = 0; rep < 1 + ((PROBE_REP == 1) || (PROBE_REP == 100 && (1 == 0 || 1 == 4 || 1 == 6 || 1 == 8))); ++rep) hipLaunchKernelGGL(k_phase<1>, dim3(grid), dim3(NTHR), LDS_BYTES, stream, p);
        for (int rep = 0; rep < 1 + ((PROBE_REP == 2) || (PROBE_REP == 100 && (2 == 0 || 2 == 4 || 2 == 6 || 2 == 8))); ++rep) hipLaunchKernelGGL(k_phase<2>, dim3(grid), dim3(NTHR), LDS_BYTES, stream, p);
        for (int rep = 0; rep < 1 + ((PROBE_REP == 3) || (PROBE_REP == 100 && (3 == 0 || 3 == 4 || 3 == 6 || 3 == 8))); ++rep) hipLaunchKernelGGL(k_phase<3>, dim3(grid), dim3(NTHR), LDS_BYTES, stream, p);
        if (PROBE_REP == 11 || PROBE_REP == 12 || PROBE_REP == 13 || PROBE_REP == 14 || PROBE_REP == 31 || PROBE_REP == 32 || PROBE_REP == 21 || PROBE_REP == 22) {
            hipFuncSetAttribute((const void*)k_unit<PROBE_REP>, hipFuncAttributeMaxDynamicSharedMemorySize, LDS_BYTES);
            hipLaunchKernelGGL(k_unit<PROBE_REP>, dim3(grid), dim3(NTHR), LDS_BYTES, stream, p);
        }
        for (int rep = 0; rep < 1 + ((PROBE_REP == 4) || (PROBE_REP == 100 && (4 == 0 || 4 == 4 || 4 == 6 || 4 == 8))); ++rep) hipLaunchKernelGGL(k_phase<4>, dim3(grid), dim3(NTHR), LDS_BYTES, stream, p);
        for (int rep = 0; rep < 1 + ((PROBE_REP == 5) || (PROBE_REP == 100 && (5 == 0 || 5 == 4 || 5 == 6 || 5 == 8))); ++rep) hipLaunchKernelGGL(k_phase<5>, dim3(grid), dim3(NTHR), LDS_BYTES, stream, p);
        for (int rep = 0; rep < 1 + ((PROBE_REP == 6) || (PROBE_REP == 100 && (6 == 0 || 6 == 4 || 6 == 6 || 6 == 8))); ++rep) hipLaunchKernelGGL(k_phase<6>, dim3(grid), dim3(NTHR), LDS_BYTES, stream, p);
        for (int rep = 0; rep < 1 + ((PROBE_REP == 7) || (PROBE_REP == 100 && (7 == 0 || 7 == 4 || 7 == 6 || 7 == 8))); ++rep) hipLaunchKernelGGL(k_phase<7>, dim3(grid), dim3(NTHR), LDS_BYTES, stream, p);
        for (int rep = 0; rep < 1 + ((PROBE_REP == 8) || (PROBE_REP == 100 && (8 == 0 || 8 == 4 || 8 == 6 || 8 == 8))); ++rep) hipLaunchKernelGGL(k_phase<8>, dim3(grid), dim3(NTHR), LDS_BYTES, stream, p);
        for (int rep = 0; rep < 1 + ((PROBE_REP == 9) || (PROBE_REP == 100 && (9 == 0 || 9 == 4 || 9 == 6 || 9 == 8))); ++rep) hipLaunchKernelGGL(k_phase<9>, dim3(grid), dim3(NTHR), LDS_BYTES, stream, p);
    }
#else
    p.ph_lo = 0; p.ph_hi = NPHASE;
    if (hipMemsetAsync((char*)d_ws + WS_BAR, 0, 16384, stream) != hipSuccess) { fprintf(stderr, "kernel_launch: memset failed\n"); return; }
    void* args[] = {&p};
    hipError_t e = hipLaunchCooperativeKernel((const void*)mk_fwd, dim3(grid), dim3(NTHR), args, LDS_BYTES, stream);
    if (e != hipSuccess) fprintf(stderr, "cooperative launch failed: %s (grid %d)\n", hipGetErrorString(e), grid);
#endif
}
```
